# Optimizing an MI355X kernel written in HIP

```python
import math
import jax, jax.numpy as jnp
from jax import lax
import numpy as np

D_MODEL = 1024
BATCH = 8
SEQ = 4096
DEPTH = 1

PLE_DIM = 256
RMS_EPS = 1e-6

RWKV_HEADS = 8
RWKV_HEAD_DIM = 64
RWKV_WIDTH = RWKV_HEADS * RWKV_HEAD_DIM
DECAY_LORA = 64
AAA_LORA = 64
GATE_LORA = 128
GN_EPS = 64e-5
RWKV_COLS = 3 * RWKV_WIDTH + DECAY_LORA + AAA_LORA + GATE_LORA

DIFF_HEADS = 4
DIFF_HEAD_DIM = 64
DIFF_QK_WIDTH = DIFF_HEADS * 2 * DIFF_HEAD_DIM
DIFF_V_DIM = 2 * DIFF_HEAD_DIM
DIFF_V_WIDTH = DIFF_HEADS * DIFF_V_DIM
DIFF_COLS = 2 * DIFF_QK_WIDTH + DIFF_V_WIDTH
ROPE_THETA = 10000.0
Q_BLOCK = 128

GATE_COLS = 2 * D_MODEL
IN_COLS = RWKV_COLS + DIFF_COLS + GATE_COLS

N_GROUPS = 4
EXPERTS_PER_GROUP = 8
N_EXPERTS = N_GROUPS * EXPERTS_PER_GROUP
TOP_K = 2
EXPERT_FF = 512
ROW_BLOCK = 128

kernel_name = 'hybrid_rwkv7_diffattn_hmoe_block'


def rms_norm(x, gain, eps=RMS_EPS):
    xf = x.astype(jnp.float32)
    y = xf * lax.rsqrt(jnp.mean(xf * xf, axis=-1, keepdims=True) + eps)
    return (y * gain.astype(jnp.float32)).astype(x.dtype)


def rope_tables(seq, dim):
    inv = ROPE_THETA ** (-jnp.arange(0, dim, 2, dtype=jnp.float32) / dim)
    ang = jnp.arange(seq, dtype=jnp.float32)[:, None] * inv[None, :]
    ang = jnp.concatenate([ang, ang], axis=-1)
    return jnp.cos(ang), jnp.sin(ang)


def apply_rope(x, cos, sin):
    c = cos[:, None, None, :]
    s = sin[:, None, None, :]
    x1, x2 = jnp.split(x, 2, axis=-1)
    rot = jnp.concatenate([-x2, x1], axis=-1)
    return (x.astype(jnp.float32) * c + rot.astype(jnp.float32) * s).astype(x.dtype)


def wkv7_scan(r, decay, k, kk, a, v):
    b, s, h, n = r.shape

    def step(state, inp):
        r_t, w_t, k_t, kk_t, a_t, v_t = inp
        sa = jnp.einsum('bhvk,bhk->bhv', state, -kk_t)
        state = (state * w_t[:, :, None, :]
                 + sa[..., None] * (kk_t * a_t)[:, :, None, :]
                 + v_t[..., None] * k_t[:, :, None, :])
        return state, jnp.einsum('bhvk,bhk->bhv', state, r_t)

    s0 = jnp.zeros((b, h, n, n), jnp.float32)
    xs = (jnp.swapaxes(r, 0, 1), jnp.swapaxes(decay, 0, 1), jnp.swapaxes(k, 0, 1),
          jnp.swapaxes(kk, 0, 1), jnp.swapaxes(a, 0, 1), jnp.swapaxes(v, 0, 1))
    _, y = lax.scan(step, s0, xs)
    return jnp.swapaxes(y, 0, 1)


def rwkv7_branch(pr, mu, w0, w2, a0, a2, g2, k_k, k_a, r_k, ln_w, ln_b):
    b, s, _ = pr.shape
    f32 = jnp.float32
    prev = jnp.pad(pr[:, :-1], ((0, 0), (1, 0), (0, 0)))
    xs = pr + (prev - pr) * mu
    c0 = RWKV_WIDTH
    r, k, v, xw, xa, xg = jnp.split(
        xs, [c0, 2 * c0, 3 * c0, 3 * c0 + DECAY_LORA, 3 * c0 + DECAY_LORA + AAA_LORA], axis=-1)
    w_log = -jax.nn.softplus(-(w0 + jnp.tanh(xw) @ w2).astype(f32)) - 0.5
    decay = jnp.exp(-jnp.exp(w_log))
    a = jax.nn.sigmoid((a0 + xa @ a2).astype(f32))
    g = jax.nn.sigmoid(xg) @ g2

    def heads(t):
        return t.reshape(b, s, RWKV_HEADS, RWKV_HEAD_DIM).astype(f32)

    kk = heads(k * k_k)
    kk = kk / jnp.maximum(jnp.sqrt(jnp.sum(kk * kk, axis=-1, keepdims=True)), 1e-12)
    k_mod = k.astype(f32) * (1.0 + (a - 1.0) * k_a.astype(f32))
    r_h, k_h, v_h = heads(r), heads(k_mod), heads(v)
    y = wkv7_scan(r_h, heads(decay), k_h, kk, heads(a), v_h)
    mean = jnp.mean(y, axis=-1, keepdims=True)
    var = jnp.mean(jnp.square(y - mean), axis=-1, keepdims=True)
    y = ((y - mean) * lax.rsqrt(var + GN_EPS)).reshape(b, s, RWKV_WIDTH)
    y = y * ln_w.astype(f32) + ln_b.astype(f32)
    bonus = jnp.sum(r_h * k_h * r_k.astype(f32), axis=-1, keepdims=True) * v_h
    out = (y + bonus.reshape(b, s, RWKV_WIDTH)) * g.astype(f32)
    return out.astype(pr.dtype)


def diff_attention_branch(pd, q_gain, k_gain, lq1, lk1, lq2, lk2, subln_w, lam_init, cos, sin):
    b, s, _ = pd.shape
    f32 = jnp.float32
    q, k, v = jnp.split(pd, [DIFF_QK_WIDTH, 2 * DIFF_QK_WIDTH], axis=-1)
    q = apply_rope(rms_norm(q.reshape(b, s, DIFF_HEADS, 2, DIFF_HEAD_DIM), q_gain), cos, sin)
    k = apply_rope(rms_norm(k.reshape(b, s, DIFF_HEADS, 2, DIFF_HEAD_DIM), k_gain), cos, sin)
    q = q.transpose(0, 2, 3, 1, 4)
    k = k.transpose(0, 2, 3, 1, 4)
    v = v.reshape(b, s, DIFF_HEADS, DIFF_V_DIM).transpose(0, 2, 1, 3)
    lam = (jnp.exp(jnp.sum(lq1.astype(f32) * lk1.astype(f32)))
           - jnp.exp(jnp.sum(lq2.astype(f32) * lk2.astype(f32))) + lam_init)
    scale = DIFF_HEAD_DIM ** -0.5
    neg = jnp.finfo(f32).min
    blocks = []
    for i in range(s // Q_BLOCK):
        q0 = i * Q_BLOCK
        end = q0 + Q_BLOCK
        sc = jnp.einsum('bhcqd,bhckd->bhcqk', q[:, :, :, q0:end], k[:, :, :, :end]).astype(f32) * scale
        causal = jnp.arange(end)[None, :] <= (q0 + jnp.arange(Q_BLOCK))[:, None]
        prob = jax.nn.softmax(jnp.where(causal, sc, neg), axis=-1)
        attn = prob[:, :, 0] - lam * prob[:, :, 1]
        blocks.append(jnp.einsum('bhqk,bhkv->bhqv', attn.astype(v.dtype), v[:, :, :end]))
    o = jnp.concatenate(blocks, axis=2)
    o = rms_norm(o, subln_w) * (1.0 - lam_init)
    return o.transpose(0, 2, 1, 3).reshape(b, s, DIFF_V_WIDTH)


def hierarchical_moe(h, w_group, b_group, w_er, b_er, w_gate, w_up, w_down):
    b, s, d = h.shape
    t = b * s
    f32 = jnp.float32
    hf = h.reshape(t, d)
    g_prob = jax.nn.softmax((hf @ w_group).astype(f32) + b_group.astype(f32), axis=-1)
    g_top, g_idx = lax.top_k(g_prob, 1)
    e_logits = ((hf @ w_er).astype(f32) + b_er.astype(f32)).reshape(t, N_GROUPS, EXPERTS_PER_GROUP)
    sel = jnp.broadcast_to(g_idx[:, :, None], (t, 1, EXPERTS_PER_GROUP))
    e_logits = jnp.take_along_axis(e_logits, sel, axis=1)[:, 0]
    e_top, e_idx = lax.top_k(e_logits, TOP_K)
    weights = g_top * jax.nn.softmax(e_top, axis=-1)
    expert_id = g_idx * EXPERTS_PER_GROUP + e_idx

    n_assign = t * TOP_K
    eid = expert_id.reshape(n_assign).astype(jnp.int32)
    tid = jnp.repeat(jnp.arange(t, dtype=jnp.int32), TOP_K)
    wt = weights.reshape(n_assign)
    order = jnp.argsort(eid)
    se = eid[order]
    counts = jnp.bincount(eid, length=N_EXPERTS).astype(jnp.int32)
    starts = jnp.cumsum(counts) - counts
    pcounts = ((counts + ROW_BLOCK - 1) // ROW_BLOCK) * ROW_BLOCK
    pends = jnp.cumsum(pcounts)
    pstarts = pends - pcounts
    dest = pstarts[se] + (jnp.arange(n_assign, dtype=jnp.int32) - starts[se])
    rows = n_assign + N_EXPERTS * ROW_BLOCK
    n_blocks = rows // ROW_BLOCK
    buf_tok = jnp.full((rows,), t, jnp.int32).at[dest].set(tid[order])
    buf_w = jnp.zeros((rows,), wt.dtype).at[dest].set(wt[order])
    blk_e = jnp.minimum(jnp.searchsorted(pends, jnp.arange(n_blocks, dtype=jnp.int32) * ROW_BLOCK,
                                         side='right'), N_EXPERTS - 1)
    hpad = jnp.concatenate([hf, jnp.zeros((1, d), hf.dtype)], axis=0)
    xs = hpad[buf_tok].reshape(n_blocks, ROW_BLOCK, d)

    def expert_block(args):
        xb, e = args
        return (jax.nn.silu(xb @ w_gate[e]) * (xb @ w_up[e])) @ w_down[e]

    yb = lax.map(expert_block, (xs, blk_e)).reshape(rows, d)
    yb = yb * buf_w[:, None].astype(yb.dtype)
    out = jax.ops.segment_sum(yb, buf_tok, num_segments=t + 1)[:t]
    return out.reshape(b, s, d)


def setup_inputs(seed: int = 0) -> dict:
    key = jax.random.key(seed)
    ks = iter(jax.random.split(key, 40))
    L = DEPTH
    f32 = jnp.float32

    def nrm(shape, scale):
        return scale * jax.random.normal(next(ks), shape, f32)

    def gain(shape, base=1.0):
        return base + 0.1 * jax.random.normal(next(ks), shape, f32)

    return {
        'x': nrm((BATCH, SEQ, D_MODEL), 1.0),
        'p': nrm((L, BATCH, SEQ, PLE_DIM), 1.0),
        'norm_mix': gain((L, D_MODEL)),
        'w_in': nrm((L, D_MODEL, IN_COLS), D_MODEL ** -0.5),
        'rwkv_mu': jax.random.uniform(next(ks), (L, RWKV_COLS), f32),
        'rwkv_w0': jax.random.uniform(next(ks), (L, RWKV_WIDTH), f32, -6.0, 0.0),
        'rwkv_w2': nrm((L, DECAY_LORA, RWKV_WIDTH), DECAY_LORA ** -0.5),
        'rwkv_a0': nrm((L, RWKV_WIDTH), 0.5),
        'rwkv_a2': nrm((L, AAA_LORA, RWKV_WIDTH), AAA_LORA ** -0.5),
        'rwkv_g2': nrm((L, GATE_LORA, RWKV_WIDTH), GATE_LORA ** -0.5),
        'rwkv_k_k': gain((L, RWKV_WIDTH), 0.85),
        'rwkv_k_a': gain((L, RWKV_WIDTH)),
        'rwkv_r_k': gain((L, RWKV_HEADS, RWKV_HEAD_DIM), 0.5),
        'rwkv_ln_w': gain((L, RWKV_WIDTH)),
        'rwkv_ln_b': nrm((L, RWKV_WIDTH), 0.02),
        'q_norm': gain((L, DIFF_HEAD_DIM)),
        'k_norm': gain((L, DIFF_HEAD_DIM)),
        'lambda_q1': nrm((L, DIFF_HEAD_DIM), 0.1),
        'lambda_k1': nrm((L, DIFF_HEAD_DIM), 0.1),
        'lambda_q2': nrm((L, DIFF_HEAD_DIM), 0.1),
        'lambda_k2': nrm((L, DIFF_HEAD_DIM), 0.1),
        'subln_w': gain((L, DIFF_V_DIM)),
        'w_branch_rwkv': nrm((L, RWKV_WIDTH, D_MODEL), RWKV_WIDTH ** -0.5),
        'w_branch_diff': nrm((L, DIFF_V_WIDTH, D_MODEL), DIFF_V_WIDTH ** -0.5),
        'w_out': nrm((L, D_MODEL, D_MODEL), D_MODEL ** -0.5),
        'norm_ffn': gain((L, D_MODEL)),
        'w_group': nrm((L, D_MODEL, N_GROUPS), D_MODEL ** -0.5),
        'b_group': nrm((L, N_GROUPS), 0.01),
        'w_expert_router': nrm((L, D_MODEL, N_EXPERTS), D_MODEL ** -0.5),
        'b_expert_router': nrm((L, N_EXPERTS), 0.01),
        'w_gate': nrm((L, N_EXPERTS, D_MODEL, EXPERT_FF), D_MODEL ** -0.5),
        'w_up': nrm((L, N_EXPERTS, D_MODEL, EXPERT_FF), D_MODEL ** -0.5),
        'w_down': nrm((L, N_EXPERTS, EXPERT_FF, D_MODEL), EXPERT_FF ** -0.5),
        'norm_ple': gain((L, D_MODEL)),
        'w_ple_gate': nrm((L, D_MODEL, D_MODEL), D_MODEL ** -0.5),
        'w_ple_proj': nrm((L, PLE_DIM, D_MODEL), PLE_DIM ** -0.5),
    }


def reference(x, p, norm_mix, w_in, rwkv_mu, rwkv_w0, rwkv_w2, rwkv_a0, rwkv_a2, rwkv_g2,
              rwkv_k_k, rwkv_k_a, rwkv_r_k, rwkv_ln_w, rwkv_ln_b, q_norm, k_norm,
              lambda_q1, lambda_k1, lambda_q2, lambda_k2, subln_w, w_branch_rwkv,
              w_branch_diff, w_out, norm_ffn, w_group, b_group, w_expert_router,
              b_expert_router, w_gate, w_up, w_down, norm_ple, w_ple_gate, w_ple_proj):
    seq = x.shape[1]
    cos, sin = rope_tables(seq, DIFF_HEAD_DIM)
    for l in range(DEPTH):
        lam_init = 0.8 - 0.6 * math.exp(-0.3 * l)
        h = rms_norm(x, norm_mix[l])
        proj = h @ w_in[l]
        p_rwkv = proj[..., :RWKV_COLS]
        p_diff = proj[..., RWKV_COLS:RWKV_COLS + DIFF_COLS]
        g_rwkv, g_diff = jnp.split(proj[..., RWKV_COLS + DIFF_COLS:], 2, axis=-1)
        o_rwkv = rwkv7_branch(p_rwkv, rwkv_mu[l], rwkv_w0[l], rwkv_w2[l], rwkv_a0[l], rwkv_a2[l],
                              rwkv_g2[l], rwkv_k_k[l], rwkv_k_a[l], rwkv_r_k[l], rwkv_ln_w[l],
                              rwkv_ln_b[l])
        o_diff = diff_attention_branch(p_diff, q_norm[l], k_norm[l], lambda_q1[l], lambda_k1[l],
                                       lambda_q2[l], lambda_k2[l], subln_w[l], lam_init, cos, sin)
        mixed = (jax.nn.sigmoid(g_rwkv) * (o_rwkv @ w_branch_rwkv[l])
                 + jax.nn.sigmoid(g_diff) * (o_diff @ w_branch_diff[l]))
        x = x + mixed @ w_out[l]
        x = x + hierarchical_moe(rms_norm(x, norm_ffn[l]), w_group[l], b_group[l],
                                 w_expert_router[l], b_expert_router[l], w_gate[l], w_up[l],
                                 w_down[l])
        ple_gate = jax.nn.sigmoid(rms_norm(x, norm_ple[l]) @ w_ple_gate[l])
        x = x + ple_gate * (p[l] @ w_ple_proj[l])
    return x
```

```cpp
#include <hip/hip_runtime.h>
#include <hip/hip_cooperative_groups.h>
#include <cstdio>
#include <cstdint>
namespace cg = cooperative_groups;
namespace pg8 {
#define PG8_LAS __attribute__((address_space(3)))
typedef unsigned short bf16_t;
typedef short bf16x8 __attribute__((ext_vector_type(8)));
typedef float f32x4 __attribute__((ext_vector_type(4)));
typedef unsigned u32x4 __attribute__((ext_vector_type(4)));
constexpr int BM = 256, BK = 64, HALF = 128, HTB = HALF * BK * 2  , STAGE_BYTES = 8 * HTB, NXCD = 8, WGM = 8;

__host__ __device__ __forceinline__ int lds_byte(int r, int c) { const int st = (r >> 4) * 2 + (c >> 5), rr = r & 15, cc = c & 31, ob = rr * 64 + cc * 2; return st * 1024 + (ob ^ (((ob >> 9) & 1) << 5)); }
__host__ __device__ __forceinline__ void stage_rc(int b, int& R, int& C) { const int st = b / 1024, sb = b % 1024, swz = sb ^ (((sb >> 9) & 1) << 5); R = (st >> 1) * 16 + swz / 64; C = (st & 1) * 32 + (swz % 64) / 2; }
__host__ __device__ __forceinline__ int perm32(int rho) { const int n = rho >> 4, i = rho & 15; return 8 * (i >> 2) + 4 * n + (i & 3); }

struct Unit { int pm, pn; };
struct Gemm { const bf16_t* A; const bf16_t* Bt; int M, N, K; };

struct StaticOrder {
    int nM, nN, nwg, G, c;
    __host__ __device__ void init(int M, int N, int G_, int c_) { nM = M / BM; nN = N / BM; nwg = nM * nN; G = G_; c = c_; }
    __host__ __device__ bool next(int i, Unit& u) const {
        const long L = (long)i * G + c; if (L >= nwg) return false;
        int wgid = (int)L; { const int q = nwg / NXCD, r = nwg % NXCD, xcd = wgid % NXCD, off = wgid / NXCD; wgid = (xcd < r ? xcd * (q + 1) : r * (q + 1) + (xcd - r) * q) + off; }
        const int nig = WGM * nN, gid = wgid / nig, fm = gid * WGM, gsz = (nM - fm) < WGM ? (nM - fm) : WGM;
        u.pm = fm + ((wgid % nig) % gsz); u.pn = (wgid % nig) / gsz; return true;
    }
    __device__ __forceinline__ void a_ready(const Unit&) const {}
    __device__ __forceinline__ void done(const Unit&) const {}
};

__device__ __forceinline__ unsigned cvt_pk_bf16(float lo, float hi) { unsigned r; asm volatile("v_cvt_pk_bf16_f32 %0, %1, %2" : "=v"(r) : "v"(lo), "v"(hi)); return r; }
template <class Epi, class Sched, bool ALIGN_EPI = false, bool SP2 = false>
__device__ __forceinline__ void gemm_phase(PG8_LAS unsigned char* lds, const Gemm g, const Sched& S, const Epi& E) {
    const int tid = threadIdx.x, wid = __builtin_amdgcn_readfirstlane(tid >> 6), lane = tid & 63, wr = wid >> 2, wc = wid & 3, fr = lane & 15, fq = lane >> 4;
    const int K = g.K, nt = K / BK;
    unsigned voffA[2], voffB[2];
#pragma unroll
    for (int i = 0; i < 2; ++i) { int R, C; stage_rc(tid * 16 + i * 8192, R, C); const int Rb = Epi::PERM ? ((R & ~31) + perm32(R & 31)) : R;
        voffA[i] = (unsigned)(R * K + C) * 2u; voffB[i] = (unsigned)(Rb * K + C) * 2u; }
    const size_t kstep = (size_t)(BK * 2);
    const size_t hstep = (size_t)HALF * K * 2;
    const size_t tstep = 2 * hstep;
    const unsigned ldsw = (unsigned)wid * 1024u;
    const int aoff = lds_byte(wr * 64 + fr, fq * 8), boff = lds_byte(wc * 32 + fr, fq * 8);
#define PG8_SA(b, h) (((b) * 2 + (h)) * HTB)
#define PG8_SB(b, h) ((4 + (b) * 2 + (h)) * HTB)
#define PG8_STAGE(bufoff, gbase, voff) do { _Pragma("unroll") for (int _i = 0; _i < 2; ++_i) \
        __builtin_amdgcn_global_load_lds((const unsigned*)((const char*)(gbase) + (voff)[_i]), (PG8_LAS unsigned*)(lds + (bufoff) + ldsw + _i * 8192), 16, 0, 0); } while (0)
#define PG8_LDA(dst, b, h) do { _Pragma("unroll") for (int m = 0; m < 4; ++m) _Pragma("unroll") for (int k = 0; k < 2; ++k) dst[m][k] = *(const PG8_LAS bf16x8*)(lds + PG8_SA(b, h) + aoff + m * 2048 + k * 1024); } while (0)
#define PG8_LDB(dst, b, h) do { _Pragma("unroll") for (int n = 0; n < 2; ++n) _Pragma("unroll") for (int k = 0; k < 2; ++k) dst[n][k] = *(const PG8_LAS bf16x8*)(lds + PG8_SB(b, h) + boff + n * 2048 + k * 1024); } while (0)
#define PG8_MMA(ai, bj, At, Bt) do { __builtin_amdgcn_s_setprio(1); _Pragma("unroll") for (int m = 0; m < 4; ++m) _Pragma("unroll") for (int n = 0; n < 2; ++n) _Pragma("unroll") for (int k = 0; k < 2; ++k) \
        acc[ai][bj][m][n] = __builtin_amdgcn_mfma_f32_16x16x32_bf16(Bt[n][k], At[m][k], acc[ai][bj][m][n], 0, 0, 0); __builtin_amdgcn_s_setprio(0); } while (0)
#define PG8_WAIT_V(n) asm volatile("s_waitcnt vmcnt(" #n ")" ::: "memory")
#define PG8_WAIT_L(n) asm volatile("s_waitcnt lgkmcnt(" #n ")" ::: "memory")
#define PG8_BAR __builtin_amdgcn_s_barrier()
#define PG8_SCHED __builtin_amdgcn_sched_barrier(0)
    Unit cur, nxt; int ui = 0;
    if (!S.next(0, cur)) return;
    f32x4 acc[2][2][4][2];
#pragma unroll
    for (int a = 0; a < 2; ++a)
#pragma unroll
        for (int b = 0; b < 2; ++b)
#pragma unroll
            for (int m = 0; m < 4; ++m)
#pragma unroll
                for (int n = 0; n < 2; ++n) acc[a][b][m][n] = (f32x4){0.f, 0.f, 0.f, 0.f};
    bf16x8 At[4][2], B0[2][2], B1[2][2];
    const char* cA = (const char*)g.A + (size_t)cur.pm * tstep; const char* cB = (const char*)g.Bt + (size_t)cur.pn * tstep;
    S.a_ready(cur);
    if constexpr (SP2) {
        PG8_STAGE(PG8_SB(0, 0), cB, voffB); PG8_STAGE(PG8_SB(0, 1), cB + hstep, voffB); PG8_STAGE(PG8_SA(0, 0), cA, voffA); PG8_STAGE(PG8_SA(0, 1), cA + hstep, voffA);
        if (wr == 1) PG8_BAR;
        PG8_WAIT_V(2); PG8_BAR;
        PG8_STAGE(PG8_SB(1, 0), cB + kstep, voffB); PG8_STAGE(PG8_SA(1, 0), cA + kstep, voffA); PG8_STAGE(PG8_SB(1, 1), cB + hstep + kstep, voffB);
        PG8_WAIT_V(6); PG8_BAR;
    } else {
        PG8_STAGE(PG8_SB(0, 0), cB, voffB); PG8_STAGE(PG8_SA(0, 0), cA, voffA); PG8_STAGE(PG8_SB(0, 1), cB + hstep, voffB); PG8_STAGE(PG8_SA(0, 1), cA + hstep, voffA);
        if (wr == 1) PG8_BAR;
        PG8_WAIT_V(4); PG8_BAR;
        PG8_STAGE(PG8_SB(1, 0), cB + kstep, voffB); PG8_STAGE(PG8_SA(1, 0), cA + kstep, voffA); PG8_STAGE(PG8_SB(1, 1), cB + hstep + kstep, voffB);
        PG8_WAIT_V(6); PG8_BAR;
    }
    for (;;) {
        const bool has_next = S.next(ui + 1, nxt);
        const char* nA = has_next ? (const char*)g.A + (size_t)nxt.pm * tstep : cA; const char* nB = has_next ? (const char*)g.Bt + (size_t)nxt.pn * tstep : cB;
        for (int t = 0; t < nt; t += 2) {
            const bool last = (t == nt - 2);
            const char* a1 = cA + (size_t)(t + 1) * kstep;
            const char* a2 = last ? nA : cA + (size_t)(t + 2) * kstep; const char* b2 = last ? nB : cB + (size_t)(t + 2) * kstep;
            const char* a3 = a2 + kstep; const char* b3 = b2 + kstep;
            if (last && has_next) S.a_ready(nxt);
            if constexpr (SP2) {
            PG8_LDB(B0, 0, 0); PG8_LDB(B1, 0, 1); PG8_SCHED; PG8_LDA(At, 0, 0); PG8_STAGE(PG8_SA(1, 1), a1 + hstep, voffA);
            PG8_WAIT_V(8); PG8_WAIT_L(0); PG8_BAR; PG8_MMA(0, 0, At, B0); PG8_MMA(0, 1, At, B1); PG8_BAR; PG8_SCHED;
            PG8_LDA(At, 0, 1); PG8_STAGE(PG8_SB(0, 0), b2, voffB); PG8_STAGE(PG8_SB(0, 1), b2 + hstep, voffB); PG8_STAGE(PG8_SA(0, 0), a2, voffA);
            PG8_WAIT_V(8); PG8_WAIT_L(0); PG8_BAR; PG8_MMA(1, 0, At, B0); PG8_MMA(1, 1, At, B1); PG8_BAR; PG8_SCHED;
            PG8_LDB(B0, 1, 0); PG8_LDB(B1, 1, 1); PG8_SCHED; PG8_LDA(At, 1, 0); PG8_STAGE(PG8_SA(0, 1), a2 + hstep, voffA);
            PG8_WAIT_V(8); PG8_WAIT_L(0); PG8_BAR; PG8_MMA(0, 0, At, B0); PG8_MMA(0, 1, At, B1); PG8_BAR; PG8_SCHED;
            PG8_LDA(At, 1, 1); PG8_STAGE(PG8_SB(1, 0), b3, voffB); PG8_STAGE(PG8_SB(1, 1), b3 + hstep, voffB); PG8_STAGE(PG8_SA(1, 0), a3, voffA);
            PG8_WAIT_V(8); PG8_WAIT_L(0); PG8_BAR; PG8_MMA(1, 0, At, B0); PG8_MMA(1, 1, At, B1); PG8_BAR; PG8_SCHED;
            } else {
            PG8_LDB(B0, 0, 0); PG8_SCHED; PG8_LDA(At, 0, 0); PG8_STAGE(PG8_SA(1, 1), a1 + hstep, voffA);
            PG8_WAIT_L(8); PG8_BAR; PG8_WAIT_L(0); PG8_MMA(0, 0, At, B0); PG8_BAR; PG8_SCHED;
            PG8_LDB(B1, 0, 1); PG8_STAGE(PG8_SB(0, 0), b2, voffB);
            PG8_BAR; PG8_WAIT_L(0); PG8_MMA(0, 1, At, B1); PG8_BAR;
            PG8_LDA(At, 0, 1); PG8_STAGE(PG8_SA(0, 0), a2, voffA);
            PG8_BAR; PG8_WAIT_L(0); PG8_MMA(1, 0, At, B0); PG8_BAR; PG8_SCHED;
            PG8_STAGE(PG8_SB(0, 1), b2 + hstep, voffB);
            PG8_WAIT_V(6); PG8_BAR; PG8_MMA(1, 1, At, B1); PG8_BAR;
            PG8_LDB(B0, 1, 0); PG8_SCHED; PG8_LDA(At, 1, 0); PG8_STAGE(PG8_SA(0, 1), a2 + hstep, voffA);
            PG8_WAIT_L(8); PG8_BAR; PG8_WAIT_L(0); PG8_MMA(0, 0, At, B0); PG8_BAR; PG8_SCHED;
            PG8_LDB(B1, 1, 1); PG8_STAGE(PG8_SB(1, 0), b3, voffB);
            PG8_BAR; PG8_WAIT_L(0); PG8_MMA(0, 1, At, B1); PG8_BAR;
            PG8_LDA(At, 1, 1); PG8_STAGE(PG8_SA(1, 0), a3, voffA);
            PG8_BAR; PG8_WAIT_L(0); PG8_MMA(1, 0, At, B0); PG8_BAR; PG8_SCHED;
            PG8_STAGE(PG8_SB(1, 1), b3 + hstep, voffB);
            PG8_WAIT_V(6); PG8_BAR; PG8_MMA(1, 1, At, B1); PG8_BAR;
            }
        }
        if constexpr (ALIGN_EPI) { if (wr == 0) PG8_BAR; }
        if constexpr (!Epi::AFTER_DRAIN) { E(acc, cur, wr, wc, fr, fq); S.done(cur); }
        if (!has_next) break;
#pragma unroll
        for (int a = 0; a < 2; ++a)
#pragma unroll
            for (int b = 0; b < 2; ++b)
#pragma unroll
                for (int m = 0; m < 4; ++m)
#pragma unroll
                    for (int n = 0; n < 2; ++n) acc[a][b][m][n] = (f32x4){0.f, 0.f, 0.f, 0.f};
        cur = nxt; cA = nA; cB = nB; ++ui;
        if constexpr (ALIGN_EPI) { if (wr == 1) PG8_BAR; }
    }
    PG8_WAIT_V(0);
    if constexpr (!ALIGN_EPI) { if (wr == 0) PG8_BAR; }
    PG8_BAR;
    if constexpr (Epi::AFTER_DRAIN) { E.fused(acc, cur, wr, wc, fr, fq, lds, wid, lane); S.done(cur); }
#undef PG8_SA
#undef PG8_SB
#undef PG8_STAGE
#undef PG8_LDA
#undef PG8_LDB
#undef PG8_MMA
#undef PG8_WAIT_V
#undef PG8_WAIT_L
#undef PG8_BAR
#undef PG8_SCHED
}
}

constexpr int NB = 8, SEQ = 4096, DM = 1024, T = NB * SEQ;
constexpr int RW = 512, NHR = 8;
constexpr int NPROJ = 5376;
constexpr int FF = 512, NEXP = 32;
constexpr float C2 = 0.125f * 1.4426950408889634f;
constexpr float LAM_INIT = 0.2f;
constexpr int MAXROWS = 2 * T + NEXP * 256;

constexpr size_t MiB = 1u << 20;
constexpr size_t WS_CTL = 0, CTL_ZERO_BYTES = 1 * MiB;
constexpr size_t WS_WLORA = 1 * MiB;
constexpr size_t WS_WBRD = 2 * MiB;
constexpr size_t WS_WO = 4 * MiB;
constexpr size_t WS_WR = 6 * MiB;
constexpr size_t WS_WPG = 7 * MiB;
constexpr size_t WS_WPP = 9 * MiB;
constexpr size_t WS_TOKE = 10 * MiB;
constexpr size_t WS_TOKW = 10 * MiB + 256 * 1024;
constexpr size_t WS_POS = 10 * MiB + 512 * 1024;
constexpr size_t WS_ROWW = 10 * MiB + 768 * 1024;
constexpr size_t WS_TILECNT = 11 * MiB + 256 * 1024;
constexpr size_t WS_DISP = 11 * MiB + 512 * 1024;
constexpr size_t WS_BON = 12 * MiB;
constexpr size_t WS_WIN = 16 * MiB;
constexpr size_t WS_LA = 16 * MiB;
constexpr size_t WS_LOGITS = 16 * MiB;
constexpr size_t WS_XN = 32 * MiB;
constexpr size_t WS_QN = 32 * MiB;
constexpr size_t WS_KN = 64 * MiB;
constexpr size_t WS_WGU = 32 * MiB;
constexpr size_t WS_RKV = 96 * MiB;
constexpr size_t WS_MIXED = 96 * MiB;
constexpr size_t WS_WD = 96 * MiB;
constexpr size_t WS_HS = 128 * MiB;
constexpr size_t WS_H3 = 128 * MiB;
constexpr size_t WS_PROJB = 192 * MiB;
constexpr size_t WS_E = 192 * MiB;
constexpr size_t WS_A = 224 * MiB;
constexpr size_t WS_G = 256 * MiB;
constexpr size_t WS_P16 = 192 * MiB;
constexpr size_t WS_PP = 208 * MiB;
constexpr size_t WS_Y2 = 272 * MiB;
constexpr size_t WS_GATES = 304 * MiB;
constexpr size_t WS_H2X = 304 * MiB;
constexpr size_t WS_VT = 432 * MiB;
constexpr size_t WS_ACT = 432 * MiB;
constexpr size_t WS_PART = 176 * MiB;
constexpr size_t WS_END = 512 * MiB;
constexpr size_t OUT_STASH = 0, OUT_ORWDF = 32 * MiB;
static_assert(WS_ACT + (size_t)MAXROWS * 512 * 2 <= WS_END && WS_Y2 + (size_t)MAXROWS * 1024 * 2 <= WS_ACT && WS_HS + (size_t)MAXROWS * 1024 * 2 <= WS_Y2, "ws map");
static_assert(WS_PART + (size_t)T * 1024 * 4 <= WS_GATES && WS_MIXED + (size_t)T * 1024 * 2 <= WS_PART, "ws map");
constexpr int CW_QUEUE = 64;
constexpr int CW_BAR = 4096;

constexpr int RING_BYTES = 131072;
constexpr int MISC_OFF = RING_BYTES;
constexpr int LDS_BYTES = 147456;
constexpr int NWAVES = 8, NTHR = 512;

#define GAS __attribute__((address_space(1)))
#define LAS __attribute__((address_space(3)))
typedef unsigned short bf16;
typedef unsigned v4u __attribute__((ext_vector_type(4)));
typedef unsigned v2u __attribute__((ext_vector_type(2)));
typedef float f32x4 __attribute__((ext_vector_type(4)));
typedef float f32x16 __attribute__((ext_vector_type(16)));
typedef short s16x8 __attribute__((ext_vector_type(8)));
typedef short s16x4 __attribute__((ext_vector_type(4)));
#define LDS_WAIT() asm volatile("s_waitcnt lgkmcnt(0)" ::: "memory")
#define VM_WAIT() asm volatile("s_waitcnt vmcnt(0)" ::: "memory")

__device__ __forceinline__ unsigned f2bf(float f) { unsigned u = __builtin_bit_cast(unsigned, f); return (u + 0x7fffu + ((u >> 16) & 1u)) >> 16; }
__device__ __forceinline__ unsigned pk2(float lo, float hi) { return f2bf(lo) | (f2bf(hi) << 16); }
__device__ __forceinline__ float bflo(unsigned w) { return __builtin_bit_cast(float, w << 16); }
__device__ __forceinline__ float bfhi(unsigned w) { return __builtin_bit_cast(float, w & 0xffff0000u); }
__device__ __forceinline__ float sigm(float x) { return __builtin_amdgcn_rcpf(1.0f + __builtin_amdgcn_exp2f(-1.4426950408889634f * x)); }
__device__ __forceinline__ float wave_sum(float v) {
#pragma unroll
    for (int o = 1; o < 64; o <<= 1) v += __shfl_xor(v, o);
    return v;
}
__device__ __forceinline__ float xhalf_max(float m) { auto rr = __builtin_amdgcn_permlane32_swap(__builtin_bit_cast(unsigned, m), __builtin_bit_cast(unsigned, m), false, false);
    return fmaxf(__builtin_bit_cast(float, rr[0]), __builtin_bit_cast(float, rr[1])); }
__device__ __forceinline__ float xhalf_sum(float m) { auto rr = __builtin_amdgcn_permlane32_swap(__builtin_bit_cast(unsigned, m), __builtin_bit_cast(unsigned, m), false, false);
    return __builtin_bit_cast(float, rr[0]) + __builtin_bit_cast(float, rr[1]); }

namespace pg8 {
struct EpiStore {
    static constexpr bool PERM = true, AFTER_DRAIN = false;
    bf16_t* O; int ldc;
    __device__ __forceinline__ void operator()(const f32x4 (&acc)[2][2][4][2], const Unit& u, int wr, int wc, int fr, int fq) const {
        const int row0 = u.pm * BM + wr * 64 + fr, col0 = u.pn * BM + wc * 32 + 8 * fq;
#pragma unroll
        for (int ai = 0; ai < 2; ++ai)
#pragma unroll
            for (int m = 0; m < 4; ++m) { bf16_t* rowp = O + (size_t)(row0 + ai * HALF + m * 16) * ldc + col0;
#pragma unroll
                for (int bj = 0; bj < 2; ++bj) { const f32x4 v0 = acc[ai][bj][m][0], v1 = acc[ai][bj][m][1]; u32x4 w;
                    w.x = cvt_pk_bf16(v0[0], v0[1]); w.y = cvt_pk_bf16(v0[2], v0[3]); w.z = cvt_pk_bf16(v1[0], v1[1]); w.w = cvt_pk_bf16(v1[2], v1[3]);
                    *(u32x4*)(rowp + bj * HALF) = w; } }
    }
};
struct EpiProj {
    static constexpr bool PERM = true, AFTER_DRAIN = false;
    bf16_t *rkv, *projb, *gates;
    __device__ __forceinline__ void operator()(const f32x4 (&acc)[2][2][4][2], const Unit& u, int wr, int wc, int fr, int fq) const {
        bf16_t* base; int ldc, ct;
        if (u.pn < 6) { base = rkv; ldc = 1536; ct = u.pn; } else if (u.pn < 11) { base = projb; ldc = 1280; ct = u.pn - 6; } else { base = gates; ldc = 2048; ct = u.pn - 13; }
        const int row0 = u.pm * BM + wr * 64 + fr, col0 = ct * BM + wc * 32 + 8 * fq;
#pragma unroll
        for (int ai = 0; ai < 2; ++ai)
#pragma unroll
            for (int m = 0; m < 4; ++m) { bf16_t* rowp = base + (size_t)(row0 + ai * HALF + m * 16) * ldc + col0;
#pragma unroll
                for (int bj = 0; bj < 2; ++bj) { const f32x4 v0 = acc[ai][bj][m][0], v1 = acc[ai][bj][m][1]; u32x4 w;
                    w.x = cvt_pk_bf16(v0[0], v0[1]); w.y = cvt_pk_bf16(v0[2], v0[3]); w.z = cvt_pk_bf16(v1[0], v1[1]); w.w = cvt_pk_bf16(v1[2], v1[3]);
                    *(u32x4*)(rowp + bj * HALF) = w; } }
    }
};
struct EpiLora {
    static constexpr bool PERM = true, AFTER_DRAIN = false;
    bf16_t *E, *A, *G; const float *w0, *a0;
    template <int KIND> __device__ __forceinline__ void body(const f32x4 (&acc)[2][2][4][2], bf16_t* base, const float* bias, int row0, int col0) const {
#pragma unroll
        for (int bj = 0; bj < 2; ++bj)
#pragma unroll
            for (int ai = 0; ai < 2; ++ai)
#pragma unroll
                for (int m = 0; m < 4; ++m) { bf16_t* rowp = base + (size_t)(row0 + ai * HALF + m * 16) * 512 + col0 + bj * HALF;
                    f32x4 v0 = acc[ai][bj][m][0], v1 = acc[ai][bj][m][1];
                    if (KIND < 2) { const f32x4 b0 = *(const f32x4*)(bias + col0 + bj * HALF), b1 = *(const f32x4*)(bias + col0 + bj * HALF + 4); const float sc = KIND == 0 ? 0.60653065971263342f : 1.0f;
                        v0 += b0; v1 += b1;
#pragma unroll
                        for (int e = 0; e < 4; ++e) { v0[e] = sc * sigm(v0[e]); v1[e] = sc * sigm(v1[e]); } }
                    u32x4 w; w.x = cvt_pk_bf16(v0[0], v0[1]); w.y = cvt_pk_bf16(v0[2], v0[3]); w.z = cvt_pk_bf16(v1[0], v1[1]); w.w = cvt_pk_bf16(v1[2], v1[3]);
                    *(u32x4*)rowp = w; asm volatile("" ::: "memory"); }
    }
    __device__ __forceinline__ void operator()(const f32x4 (&acc)[2][2][4][2], const Unit& u, int wr, int wc, int fr, int fq) const {
        const int kind = u.pn >> 1; const int row0 = u.pm * BM + wr * 64 + fr, col0 = (u.pn & 1) * BM + wc * 32 + 8 * fq;
        if (kind == 0) body<0>(acc, E, w0, row0, col0); else if (kind == 1) body<1>(acc, A, a0, row0, col0); else body<2>(acc, G, w0, row0, col0);
    }
};
struct EpiMix {
    static constexpr bool PERM = true, AFTER_DRAIN = false;
    const bf16_t* gates; float* part; bf16_t* mixed;
    __device__ __forceinline__ void operator()(const f32x4 (&acc)[2][2][4][2], const Unit& u, int wr, int wc, int fr, int fq) const {
        const bool second = u.pm >= 128; const int pm = second ? u.pm - 128 : u.pm, pn = second ? u.pn - 4 : u.pn;
        const int row0 = pm * BM + wr * 64 + fr, col0 = pn * BM + wc * 32 + 8 * fq;
#pragma unroll
        for (int ai = 0; ai < 2; ++ai)
#pragma unroll
            for (int m = 0; m < 4; ++m) { const size_t r = (size_t)(row0 + ai * HALF + m * 16);
#pragma unroll
                for (int bj = 0; bj < 2; ++bj) { const int c = col0 + bj * HALF;
                    const u32x4 gw = *(const u32x4*)(gates + r * 2048 + (second ? 1024 : 0) + c);
                    f32x4 v0 = acc[ai][bj][m][0], v1 = acc[ai][bj][m][1];
                    v0[0] *= sigm(bflo(gw.x)); v0[1] *= sigm(bfhi(gw.x)); v0[2] *= sigm(bflo(gw.y)); v0[3] *= sigm(bfhi(gw.y));
                    v1[0] *= sigm(bflo(gw.z)); v1[1] *= sigm(bfhi(gw.z)); v1[2] *= sigm(bflo(gw.w)); v1[3] *= sigm(bfhi(gw.w));
                    float* pp = part + r * 1024 + c;
                    if (!second) { *(f32x4*)pp = v0; *(f32x4*)(pp + 4) = v1; }
                    else { v0 += *(const f32x4*)pp; v1 += *(const f32x4*)(pp + 4); u32x4 w;
                        w.x = cvt_pk_bf16(v0[0], v0[1]); w.y = cvt_pk_bf16(v0[2], v0[3]); w.z = cvt_pk_bf16(v1[0], v1[1]); w.w = cvt_pk_bf16(v1[2], v1[3]);
                        *(u32x4*)(mixed + r * 1024 + c) = w; } } }
    }
};
struct EpiRes {
    static constexpr bool PERM = false, AFTER_DRAIN = false;
    const float* x; float* out;
    __device__ __forceinline__ void operator()(const f32x4 (&acc)[2][2][4][2], const Unit& u, int wr, int wc, int fr, int fq) const {
        const int row0 = u.pm * BM + wr * 64 + fr, col0 = u.pn * BM + wc * 32 + 4 * fq;
#pragma unroll
        for (int ai = 0; ai < 2; ++ai)
#pragma unroll
            for (int m = 0; m < 4; ++m) { const size_t off = (size_t)(row0 + ai * HALF + m * 16) * 1024 + col0;
#pragma unroll
                for (int bj = 0; bj < 2; ++bj)
#pragma unroll
                    for (int n = 0; n < 2; ++n) *(f32x4*)(out + off + bj * HALF + n * 16) = *(const f32x4*)(x + off + bj * HALF + n * 16) + acc[ai][bj][m][n]; }
    }
};
struct EpiLogits {
    static constexpr bool PERM = false, AFTER_DRAIN = false;
    float* L;
    __device__ __forceinline__ void operator()(const f32x4 (&acc)[2][2][4][2], const Unit& u, int wr, int wc, int fr, int fq) const {
        const int row0 = u.pm * BM + wr * 64 + fr, col0 = wc * 32 + 4 * fq;
#pragma unroll
        for (int ai = 0; ai < 2; ++ai)
#pragma unroll
            for (int m = 0; m < 4; ++m) { float* rowp = L + (size_t)(row0 + ai * HALF + m * 16) * 128 + col0;
#pragma unroll
                for (int n = 0; n < 2; ++n) *(f32x4*)(rowp + n * 16) = acc[ai][0][m][n]; }
    }
};
struct EpiAct {
    static constexpr bool PERM = true, AFTER_DRAIN = false;
    bf16_t* act;
    __device__ __forceinline__ void operator()(const f32x4 (&acc)[2][2][4][2], const Unit& u, int wr, int wc, int fr, int fq) const {
        const int row0 = u.pm * BM + wr * 64 + fr, col0 = (u.pn & 3) * HALF + wc * 32 + 8 * fq;
#pragma unroll
        for (int ai = 0; ai < 2; ++ai)
#pragma unroll
            for (int m = 0; m < 4; ++m) { bf16_t* rowp = act + (size_t)(row0 + ai * HALF + m * 16) * 512 + col0; float o[8];
#pragma unroll
                for (int n = 0; n < 2; ++n)
#pragma unroll
                    for (int e = 0; e < 4; ++e) { const float g = acc[ai][0][m][n][e], up = acc[ai][1][m][n][e]; o[n * 4 + e] = g * sigm(g) * up; }
                u32x4 w; w.x = cvt_pk_bf16(o[0], o[1]); w.y = cvt_pk_bf16(o[2], o[3]); w.z = cvt_pk_bf16(o[4], o[5]); w.w = cvt_pk_bf16(o[6], o[7]);
                *(u32x4*)rowp = w; }
    }
};
struct EpiDown {
    static constexpr bool PERM = true, AFTER_DRAIN = false;
    bf16_t* y2; const float* roww;
    __device__ __forceinline__ void operator()(const f32x4 (&acc)[2][2][4][2], const Unit& u, int wr, int wc, int fr, int fq) const {
        const int row0 = u.pm * BM + wr * 64 + fr, col0 = (u.pn & 3) * BM + wc * 32 + 8 * fq;
#pragma unroll
        for (int ai = 0; ai < 2; ++ai)
#pragma unroll
            for (int m = 0; m < 4; ++m) { const int r = row0 + ai * HALF + m * 16; const float w8 = roww[r]; bf16_t* rowp = y2 + (size_t)r * 1024 + col0;
#pragma unroll
                for (int bj = 0; bj < 2; ++bj) { const f32x4 v0 = acc[ai][bj][m][0] * w8, v1 = acc[ai][bj][m][1] * w8; u32x4 w;
                    w.x = cvt_pk_bf16(v0[0], v0[1]); w.y = cvt_pk_bf16(v0[2], v0[3]); w.z = cvt_pk_bf16(v1[0], v1[1]); w.w = cvt_pk_bf16(v1[2], v1[3]);
                    *(u32x4*)(rowp + bj * HALF) = w; } }
    }
};
struct EpiFinal {
    static constexpr bool PERM = true, AFTER_DRAIN = false;
    const bf16_t* pp; float* out;
    __device__ __forceinline__ void operator()(const f32x4 (&acc)[2][2][4][2], const Unit& u, int wr, int wc, int fr, int fq) const {
        const int row0 = u.pm * BM + wr * 64 + fr, col0 = u.pn * BM + wc * 32 + 8 * fq;
#pragma unroll
        for (int ai = 0; ai < 2; ++ai)
#pragma unroll
            for (int m = 0; m < 4; ++m) { const size_t r = (size_t)(row0 + ai * HALF + m * 16);
#pragma unroll
                for (int bj = 0; bj < 2; ++bj) { const int c = col0 + bj * HALF;
                    const u32x4 pw = *(const u32x4*)(pp + r * 1024 + c); float* op = out + r * 1024 + c;
                    f32x4 x0 = *(const f32x4*)op, x1 = *(const f32x4*)(op + 4); const f32x4 a0 = acc[ai][bj][m][0], a1 = acc[ai][bj][m][1];
                    x0[0] += sigm(a0[0]) * bflo(pw.x); x0[1] += sigm(a0[1]) * bfhi(pw.x); x0[2] += sigm(a0[2]) * bflo(pw.y); x0[3] += sigm(a0[3]) * bfhi(pw.y);
                    x1[0] += sigm(a1[0]) * bflo(pw.z); x1[1] += sigm(a1[1]) * bfhi(pw.z); x1[2] += sigm(a1[2]) * bflo(pw.w); x1[3] += sigm(a1[3]) * bfhi(pw.w);
                    *(f32x4*)op = x0; *(f32x4*)(op + 4) = x1; asm volatile("" ::: "memory"); } }
    }
};
struct OrderSkipV : StaticOrder {
    __device__ __forceinline__ bool next(int i, Unit& u) const { if (!StaticOrder::next(i, u)) return false; if (u.pn >= 11) u.pn += 2; return true; }
};
struct OrderPair : StaticOrder {
    __device__ __forceinline__ bool next(int i, Unit& u) const { if (!StaticOrder::next(i >> 1, u)) return false; if (i & 1) { u.pm += 128; u.pn += 4; } return true; }
};
struct OrderMoe {
    int nwg, G, c; const PG8_LAS int* tile_e;
    __device__ __forceinline__ bool next(int i, Unit& u) const { const long L = (long)i * G + c; if (L >= nwg) return false; const int rt = (int)(L >> 2); u.pm = rt; u.pn = tile_e[rt] * 4 + (int)(L & 3); return true; }
    __device__ __forceinline__ void a_ready(const Unit&) const {}
    __device__ __forceinline__ void done(const Unit&) const {}
};
}

struct Args { const float* in[36]; float* out; unsigned char* ws; int ph_lo, ph_hi; };

__device__ __forceinline__ void tr_item(const float* W, int N, bf16* WT, int ld, int k0, int n0, size_t dst_row0, int k_off, LAS float* scr, int lane) {
#pragma unroll 8
    for (int i = 0; i < 32; ++i) { const int kk = 2 * i + (lane >> 5); scr[kk * 33 + (lane & 31)] = W[(size_t)(k0 + kk) * N + n0 + (lane & 31)]; }
    LDS_WAIT(); asm volatile("" ::: "memory");
    const int c = lane & 7;
#pragma unroll
    for (int j = 0; j < 4; ++j) { const int n = (lane >> 3) + 8 * j; const LAS float* s = scr + (8 * c) * 33 + n;
        v4u o; o.x = pk2(s[0 * 33], s[1 * 33]); o.y = pk2(s[2 * 33], s[3 * 33]); o.z = pk2(s[4 * 33], s[5 * 33]); o.w = pk2(s[6 * 33], s[7 * 33]);
        *(v4u*)(WT + (dst_row0 + n) * ld + k_off + k0 + 8 * c) = o; }
    LDS_WAIT(); asm volatile("" ::: "memory");
}
__device__ __forceinline__ void tr_matrix(const float* W, int K, int N, bf16* WT, int ld, size_t dst_row0, int k_off, LAS float* scr, int lane, int gw, int NGW) {
    const int nblk = N / 32, nitems = (K / 64) * nblk;
    for (int it = gw; it < nitems; it += NGW) { const int kb = it / nblk, nb = it % nblk; tr_item(W, N, WT, ld, 64 * kb, 32 * nb, dst_row0 + 32 * nb, k_off, scr, lane); }
}
__device__ __forceinline__ void rms_row_to_bf16(const float* xrow, const float* gain, bf16* orow, int lane) {
    const f32x4* xr = (const f32x4*)xrow + lane; f32x4 v[4]; float s = 0.f;
#pragma unroll
    for (int j = 0; j < 4; ++j) { v[j] = xr[64 * j]; s += (v[j].x * v[j].x + v[j].y * v[j].y) + (v[j].z * v[j].z + v[j].w * v[j].w); }
    const float rstd = 1.0f / sqrtf(wave_sum(s) * (1.f / 1024.f) + 1e-6f);
    v2u* o8 = (v2u*)orow + lane;
#pragma unroll
    for (int j = 0; j < 4; ++j) { const f32x4 g = ((const f32x4*)gain)[lane + 64 * j]; v2u o; o.x = pk2(v[j].x * rstd * g.x, v[j].y * rstd * g.y); o.y = pk2(v[j].z * rstd * g.z, v[j].w * rstd * g.w); o8[64 * j] = o; }
}

__device__ __forceinline__ void phase0(const Args& a, LAS unsigned char* lds, int tid, int lane, int wave, int vcu, int G) {
    unsigned char* ws = a.ws;
    LAS float* scr = (LAS float*)(lds + wave * 16384);
    const int gw = vcu * NWAVES + wave, NGW = G * NWAVES; const int gt = vcu * NTHR + tid, NGT = G * NTHR;
    tr_matrix(a.in[3], 1024, NPROJ, (bf16*)(ws + WS_WIN), 1024, 0, 0, scr, lane, gw, NGW);
    tr_matrix(a.in[6], 64, 512, (bf16*)(ws + WS_WLORA), 256, 0, 0, scr, lane, gw, NGW);
    tr_matrix(a.in[8], 64, 512, (bf16*)(ws + WS_WLORA), 256, 512, 64, scr, lane, gw, NGW);
    tr_matrix(a.in[9], 128, 512, (bf16*)(ws + WS_WLORA), 256, 1024, 128, scr, lane, gw, NGW);
    tr_matrix(a.in[22], 512, 1024, (bf16*)(ws + WS_WBRD), 512, 0, 0, scr, lane, gw, NGW);
    tr_matrix(a.in[23], 512, 1024, (bf16*)(ws + WS_WBRD), 512, 1024, 0, scr, lane, gw, NGW);
    tr_matrix(a.in[24], 1024, 1024, (bf16*)(ws + WS_WO), 1024, 0, 0, scr, lane, gw, NGW);
    tr_matrix(a.in[34], 1024, 1024, (bf16*)(ws + WS_WPG), 1024, 0, 0, scr, lane, gw, NGW);
    tr_matrix(a.in[35], 256, 1024, (bf16*)(ws + WS_WPP), 256, 0, 0, scr, lane, gw, NGW);
    { v4u* wl = (v4u*)(ws + WS_WLORA); const v4u z = (v4u){0u, 0u, 0u, 0u};
      for (int i = gt; i < 1536 * 32; i += NGT) { const int row = i >> 5, kc = (i & 31) * 8; const int blk = row >> 9;
          const bool diag = blk == 0 ? (kc < 64) : (blk == 1 ? (kc >= 64 && kc < 128) : (kc >= 128)); if (!diag) wl[i] = z; } }
    { bf16* wr = (bf16*)(ws + WS_WR); const float* wg = a.in[26]; const float* we = a.in[28];
      for (int i = gt; i < 256 * 1024; i += NGT) { const int row = i >> 10, k = i & 1023; unsigned short v = 0;
          const int n = row < 64 ? row : row - 64;
          if ((row < 36) || (row >= 64 && row < 100)) { const float w = n < 32 ? we[k * 32 + n] : wg[k * 4 + (n - 32)]; const unsigned h = f2bf(w);
              v = (unsigned short)(row < 64 ? h : f2bf(w - __builtin_bit_cast(float, h << 16))); }
          wr[(size_t)row * 2048 + k] = v; wr[(size_t)row * 2048 + 1024 + k] = v; } }
    for (int m = gw; m < T; m += NGW) rms_row_to_bf16(a.in[0] + (size_t)m * DM, a.in[2], (bf16*)(ws + WS_XN) + (size_t)m * DM, lane);
}

__device__ __forceinline__ void phase2(const Args& a, LAS unsigned char* lds, int tid, int vcu, int G) {
    unsigned char* ws = a.ws;
    const bf16* projb = (const bf16*)(ws + WS_PROJB); const float* mu = a.in[4];
    bf16* la = (bf16*)(ws + WS_LA); bf16* qn = (bf16*)(ws + WS_QN); bf16* kn = (bf16*)(ws + WS_KN);
    LAS float* cs = (LAS float*)lds;
    for (int tile = vcu; tile < T / 64; tile += G) {
        const int t0 = tile * 64;
        __syncthreads();
#pragma unroll
        for (int i = 0; i < 4; ++i) { const int idx = tid + 512 * i, tok = idx >> 5, i32 = idx & 31; const int s = (t0 + tok) & (SEQ - 1);
            const float inv = powf(10000.0f, -(float)i32 * (1.0f / 32.0f)); const float ang = (float)s * inv; float sn, c; sincosf(ang, &sn, &c);
            cs[(tok * 32 + i32) * 2] = c; cs[(tok * 32 + i32) * 2 + 1] = sn; }
#pragma unroll
        for (int i = 0; i < 4; ++i) { const int idx = tid + 512 * i, tok = idx >> 5, ch = idx & 31, t = t0 + tok, j0 = ch * 8; const bool first = (t & (SEQ - 1)) == 0;
            const v4u cur = *(const v4u*)(projb + (size_t)t * 1280 + j0); v4u prv = (v4u){0u, 0u, 0u, 0u}; if (!first) prv = *(const v4u*)(projb + (size_t)(t - 1) * 1280 + j0);
            const f32x4 m0 = *(const f32x4*)(mu + 1536 + j0), m1 = *(const f32x4*)(mu + 1536 + j0 + 4);
            float x[8]; const unsigned cw[4] = {cur.x, cur.y, cur.z, cur.w}, pw[4] = {prv.x, prv.y, prv.z, prv.w}; const float mm[8] = {m0.x, m0.y, m0.z, m0.w, m1.x, m1.y, m1.z, m1.w};
#pragma unroll
            for (int e = 0; e < 4; ++e) { const float c0 = bflo(cw[e]), c1 = bfhi(cw[e]), p0 = bflo(pw[e]), p1 = bfhi(pw[e]); x[2 * e] = c0 + (p0 - c0) * mm[2 * e]; x[2 * e + 1] = c1 + (p1 - c1) * mm[2 * e + 1]; }
            if (ch < 8) {
#pragma unroll
                for (int e = 0; e < 8; ++e) x[e] = tanhf(x[e]);
            } else if (ch >= 16) {
#pragma unroll
                for (int e = 0; e < 8; ++e) x[e] = sigm(x[e]);
            }
            v4u o; o.x = pk2(x[0], x[1]); o.y = pk2(x[2], x[3]); o.z = pk2(x[4], x[5]); o.w = pk2(x[6], x[7]);
            *(v4u*)(la + (size_t)t * 256 + j0) = o; }
        __syncthreads();
        for (int i = 0; i < 16; ++i) { const int idx = tid + 512 * i, tok = idx >> 7, grp = (idx >> 3) & 15, l8 = idx & 7, t = t0 + tok;
            const v4u w = *(const v4u*)(projb + (size_t)t * 1280 + 256 + grp * 64 + l8 * 8);
            float x[8] = {bflo(w.x), bfhi(w.x), bflo(w.y), bfhi(w.y), bflo(w.z), bfhi(w.z), bflo(w.w), bfhi(w.w)};
            float ss = 0.f;
#pragma unroll
            for (int e = 0; e < 8; ++e) ss += x[e] * x[e];
            ss += __shfl_xor(ss, 1); ss += __shfl_xor(ss, 2); ss += __shfl_xor(ss, 4);
            const float rs = 1.0f / sqrtf(ss * (1.f / 64.f) + 1e-6f);
            const float* gn = (grp < 8 ? a.in[15] : a.in[16]) + l8 * 8;
            const f32x4 g0 = *(const f32x4*)gn, g1 = *(const f32x4*)(gn + 4); const float gg[8] = {g0.x, g0.y, g0.z, g0.w, g1.x, g1.y, g1.z, g1.w};
            float y[8], o[8];
#pragma unroll
            for (int e = 0; e < 8; ++e) y[e] = x[e] * rs * gg[e];
            const float sgn = l8 < 4 ? -1.f : 1.f; const float sc = grp < 8 ? C2 : 1.f;
#pragma unroll
            for (int e = 0; e < 8; ++e) { const float yp = __shfl_xor(y[e], 4); const int ci = (tok * 32 + (l8 & 3) * 8 + e) * 2; const float c = cs[ci], sn = cs[ci + 1]; o[e] = (y[e] * c + sgn * yp * sn) * sc; }
            const int b = t >> 12, s = t & (SEQ - 1); bf16* dst = (grp < 8 ? qn : kn) + ((size_t)(b * 8 + (grp & 7)) * SEQ + s) * 64 + l8 * 8;
            v4u ov; ov.x = pk2(o[0], o[1]); ov.y = pk2(o[2], o[3]); ov.z = pk2(o[4], o[5]); ov.w = pk2(o[6], o[7]);
            *(v4u*)dst = ov; }
    }
}

constexpr int SC_NB = 32, SC_REC = 392;
constexpr int SC_BUF = SC_NB * SC_REC * 4;
constexpr int SC_YOFF = 2 * SC_BUF;
struct ScanIn { v2u r0, k0, v0, r1, k1, v1, e, av, g; };
__device__ __forceinline__ void scan_unit(const Args& a, LAS unsigned char* lds, int tid, int bh) {
    unsigned char* ws = a.ws;
    const int b = bh >> 3, hd = bh & 7; const int lane = tid & 63, wave = tid >> 6;
    const bf16* rkv = (const bf16*)(ws + WS_RKV); const bf16* E = (const bf16*)(ws + WS_E); const bf16* Aa = (const bf16*)(ws + WS_A); const bf16* Gg = (const bf16*)(ws + WS_G);
    bf16* orw = (bf16*)((unsigned char*)a.out + OUT_ORWDF); float* bon = (float*)(ws + WS_BON); (void)bon;
    const int st = tid >> 4, c4 = tid & 15, ch = hd * 64 + c4 * 4;
    const f32x4 mur = *(const f32x4*)(a.in[4] + ch), muk = *(const f32x4*)(a.in[4] + 512 + ch), muv = *(const f32x4*)(a.in[4] + 1024 + ch);
    const f32x4 kkw = *(const f32x4*)(a.in[10] + ch), kaw = *(const f32x4*)(a.in[11] + ch), rkw = *(const f32x4*)(a.in[12] + ch), lnw = *(const f32x4*)(a.in[13] + ch), lnb = *(const f32x4*)(a.in[14] + ch);
    const int row = wave * 8 + (lane >> 3), ks = lane & 7;
    float sreg[8];
#pragma unroll
    for (int j = 0; j < 8; ++j) sreg[j] = 0.f;
    const size_t tb = (size_t)b * SEQ;
    auto load_batch = [&](int s0, ScanIn& L) {
        const size_t t = tb + s0 + st; const bool first = (s0 + st) == 0;
        L.r0 = *(const v2u*)(rkv + t * 1536 + ch); L.k0 = *(const v2u*)(rkv + t * 1536 + 512 + ch); L.v0 = *(const v2u*)(rkv + t * 1536 + 1024 + ch);
        const size_t tp = first ? t : t - 1;
        L.r1 = *(const v2u*)(rkv + tp * 1536 + ch); L.k1 = *(const v2u*)(rkv + tp * 1536 + 512 + ch); L.v1 = *(const v2u*)(rkv + tp * 1536 + 1024 + ch);
        if (first) { L.r1 = (v2u){0u, 0u}; L.k1 = L.r1; L.v1 = L.r1; }
        L.e = *(const v2u*)(E + t * 512 + ch); L.av = *(const v2u*)(Aa + t * 512 + ch); L.g = *(const v2u*)(Gg + t * 512 + ch);
    };
    float keep_v[4], keep_g[4], keep_bonus;
    auto convert = [&](const ScanIn& L, int buf) {
        const unsigned r0w[2] = {L.r0.x, L.r0.y}, r1w[2] = {L.r1.x, L.r1.y}, k0w[2] = {L.k0.x, L.k0.y}, k1w[2] = {L.k1.x, L.k1.y}, v0w[2] = {L.v0.x, L.v0.y}, v1w[2] = {L.v1.x, L.v1.y};
        const unsigned ew[2] = {L.e.x, L.e.y}, aw[2] = {L.av.x, L.av.y}, gw[2] = {L.g.x, L.g.y};
        float r[4], k[4], v[4], e[4], av[4], kk[4];
#pragma unroll
        for (int i = 0; i < 4; ++i) { const int w = i >> 1; const bool hi = i & 1;
            const float rc = hi ? bfhi(r0w[w]) : bflo(r0w[w]), rp = hi ? bfhi(r1w[w]) : bflo(r1w[w]);
            const float kc = hi ? bfhi(k0w[w]) : bflo(k0w[w]), kp = hi ? bfhi(k1w[w]) : bflo(k1w[w]);
            const float vc = hi ? bfhi(v0w[w]) : bflo(v0w[w]), vp = hi ? bfhi(v1w[w]) : bflo(v1w[w]);
            r[i] = rc + (rp - rc) * mur[i]; k[i] = kc + (kp - kc) * muk[i]; v[i] = vc + (vp - vc) * muv[i];
            e[i] = hi ? bfhi(ew[w]) : bflo(ew[w]); av[i] = hi ? bfhi(aw[w]) : bflo(aw[w]); keep_g[i] = hi ? bfhi(gw[w]) : bflo(gw[w]); keep_v[i] = v[i];
            kk[i] = k[i] * kkw[i]; }
        float ss = kk[0] * kk[0] + kk[1] * kk[1] + kk[2] * kk[2] + kk[3] * kk[3];
        ss += __shfl_xor(ss, 1); ss += __shfl_xor(ss, 2); ss += __shfl_xor(ss, 4); ss += __shfl_xor(ss, 8);
        const float inv = 1.0f / fmaxf(sqrtf(ss), 1e-12f);
        f32x4 w4, aa4, bb4, km4, wr4, vv4; float br = 0.f, kr = 0.f, bo = 0.f;
#pragma unroll
        for (int i = 0; i < 4; ++i) { const float kki = kk[i] * inv; const float km = k[i] * (1.0f + (av[i] - 1.0f) * kaw[i]); const float w = __expf(-e[i]);
            w4[i] = w; aa4[i] = -kki; bb4[i] = kki * av[i]; km4[i] = km; wr4[i] = w * r[i]; vv4[i] = v[i];
            br += bb4[i] * r[i]; kr += km * r[i]; bo += r[i] * km * rkw[i]; }
        br += __shfl_xor(br, 1); br += __shfl_xor(br, 2); br += __shfl_xor(br, 4); br += __shfl_xor(br, 8);
        kr += __shfl_xor(kr, 1); kr += __shfl_xor(kr, 2); kr += __shfl_xor(kr, 4); kr += __shfl_xor(kr, 8);
        bo += __shfl_xor(bo, 1); bo += __shfl_xor(bo, 2); bo += __shfl_xor(bo, 4); bo += __shfl_xor(bo, 8);
        keep_bonus = bo;
        LAS float* rec = (LAS float*)(lds + buf * SC_BUF) + st * SC_REC + c4 * 4;
        *(LAS f32x4*)(rec) = w4; *(LAS f32x4*)(rec + 64) = aa4; *(LAS f32x4*)(rec + 128) = bb4; *(LAS f32x4*)(rec + 192) = km4; *(LAS f32x4*)(rec + 256) = wr4; *(LAS f32x4*)(rec + 320) = vv4;
        if (c4 == 0) { rec[384] = br; rec[385] = kr; }
    };
    ScanIn L; load_batch(0, L);
    __syncthreads();
    convert(L, 0);
    __syncthreads();
    for (int bi = 0; bi < SEQ / SC_NB; ++bi) {
        const int cur = bi & 1;
        if (bi + 1 < SEQ / SC_NB) load_batch((bi + 1) * SC_NB, L);
        const LAS float* base = (const LAS float*)(lds + cur * SC_BUF);
        LAS float* ybuf = (LAS float*)(lds + SC_YOFF);
#pragma unroll 2
        for (int i = 0; i < SC_NB; ++i) { const LAS float* rec = base + i * SC_REC;
            const f32x4 w0 = *(const LAS f32x4*)(rec + ks * 8), w1 = *(const LAS f32x4*)(rec + ks * 8 + 4);
            const f32x4 a0 = *(const LAS f32x4*)(rec + 64 + ks * 8), a1 = *(const LAS f32x4*)(rec + 64 + ks * 8 + 4);
            const f32x4 b0 = *(const LAS f32x4*)(rec + 128 + ks * 8), b1 = *(const LAS f32x4*)(rec + 128 + ks * 8 + 4);
            const f32x4 k0 = *(const LAS f32x4*)(rec + 192 + ks * 8), k1 = *(const LAS f32x4*)(rec + 192 + ks * 8 + 4);
            const f32x4 q0 = *(const LAS f32x4*)(rec + 256 + ks * 8), q1 = *(const LAS f32x4*)(rec + 256 + ks * 8 + 4);
            const float vv = rec[320 + row], br = rec[384], kr = rec[385];
            float sa = (sreg[0] * a0[0] + sreg[1] * a0[1]) + (sreg[2] * a0[2] + sreg[3] * a0[3]) + (sreg[4] * a1[0] + sreg[5] * a1[1]) + (sreg[6] * a1[2] + sreg[7] * a1[3]);
            float z = (sreg[0] * q0[0] + sreg[1] * q0[1]) + (sreg[2] * q0[2] + sreg[3] * q0[3]) + (sreg[4] * q1[0] + sreg[5] * q1[1]) + (sreg[6] * q1[2] + sreg[7] * q1[3]);
            sa += __shfl_xor(sa, 1); z += __shfl_xor(z, 1); sa += __shfl_xor(sa, 2); z += __shfl_xor(z, 2); sa += __shfl_xor(sa, 4); z += __shfl_xor(z, 4);
            const float y = z + sa * br + vv * kr;
            if (ks == 0) ybuf[i * 64 + row] = y;
            sreg[0] = sreg[0] * w0[0] + sa * b0[0] + vv * k0[0]; sreg[1] = sreg[1] * w0[1] + sa * b0[1] + vv * k0[1]; sreg[2] = sreg[2] * w0[2] + sa * b0[2] + vv * k0[2]; sreg[3] = sreg[3] * w0[3] + sa * b0[3] + vv * k0[3];
            sreg[4] = sreg[4] * w1[0] + sa * b1[0] + vv * k1[0]; sreg[5] = sreg[5] * w1[1] + sa * b1[1] + vv * k1[1]; sreg[6] = sreg[6] * w1[2] + sa * b1[2] + vv * k1[2]; sreg[7] = sreg[7] * w1[3] + sa * b1[3] + vv * k1[3];
        }
        __syncthreads();
        { const f32x4 y4 = *(const LAS f32x4*)(ybuf + st * 64 + c4 * 4);
          float sm = (y4[0] + y4[1]) + (y4[2] + y4[3]); sm += __shfl_xor(sm, 1); sm += __shfl_xor(sm, 2); sm += __shfl_xor(sm, 4); sm += __shfl_xor(sm, 8);
          const float mean = sm * (1.f / 64.f); const f32x4 d = y4 - mean;
          float vs = (d[0] * d[0] + d[1] * d[1]) + (d[2] * d[2] + d[3] * d[3]); vs += __shfl_xor(vs, 1); vs += __shfl_xor(vs, 2); vs += __shfl_xor(vs, 4); vs += __shfl_xor(vs, 8);
          const float rstd = 1.0f / sqrtf(vs * (1.f / 64.f) + 64e-5f); float o[4];
#pragma unroll
          for (int i = 0; i < 4; ++i) o[i] = ((d[i] * rstd * lnw[i] + lnb[i]) + keep_bonus * keep_v[i]) * keep_g[i];
          v2u ov; ov.x = pk2(o[0], o[1]); ov.y = pk2(o[2], o[3]);
          *(v2u*)(orw + (tb + bi * SC_NB + st) * 512 + ch) = ov; }
        if (bi + 1 < SEQ / SC_NB) convert(L, cur ^ 1);
        __syncthreads();
    }
}

__device__ __forceinline__ int crow(int r, int hi) { return (r & 3) + 8 * (r >> 2) + 4 * hi; }
constexpr int AT_BUF = 24576;
__device__ __forceinline__ int at_addr(int row, int ch) { return row * 128 + ((ch ^ ((row >> 1) & 7)) << 4); }
__device__ __forceinline__ void attn_pass(const bf16* qn, const bf16* kn, const bf16* vt, int b, int head, int c, int qb, LAS unsigned char* lds, int tid, f32x16 (&o)[4]) {
    const int lane = tid & 63, wave = __builtin_amdgcn_readfirstlane(tid >> 6), r32 = lane & 31, hi = lane >> 5;
    const int vh = b * 8 + head * 2 + c; const int q0 = qb * 256, qw0 = q0 + wave * 32, qrow = qw0 + r32;
    const bf16* Qp = qn + ((size_t)vh * SEQ + qrow) * 64;
    s16x8 qf[4];
#pragma unroll
    for (int ks = 0; ks < 4; ++ks) qf[ks] = *(const s16x8*)(Qp + 16 * ks + 8 * hi);
    const int k_row = tid >> 3, k_ch = tid & 7;
    const bf16* ksrc = kn + (size_t)vh * SEQ * 64 + k_row * 64 + k_ch * 8; const int kdst = at_addr(k_row, k_ch);
    const int dv0 = tid >> 3, dv1 = 64 + (tid >> 3);
    const bf16* vsrc0 = vt + (size_t)(head * 128 + dv0) * T + (size_t)b * SEQ + k_ch * 8; const bf16* vsrc1 = vsrc0 + (size_t)64 * T;
    const int vdst0 = 8192 + at_addr(dv0, k_ch), vdst1 = 8192 + at_addr(dv1, k_ch);
    const int NT = 4 * qb + 4;
    v4u kreg = *(const v4u*)ksrc, vreg0 = *(const v4u*)vsrc0, vreg1 = *(const v4u*)vsrc1;
    __syncthreads();
    *(LAS v4u*)(lds + kdst) = kreg; *(LAS v4u*)(lds + vdst0) = vreg0; *(LAS v4u*)(lds + vdst1) = vreg1;
    __syncthreads();
    float m = -1e30f, l = 0.f;
#pragma unroll
    for (int db = 0; db < 4; ++db)
#pragma unroll
        for (int i = 0; i < 16; ++i) o[db][i] = 0.f;
    for (int j = 0; j < NT; ++j) {
        const int cur = (j & 1) * AT_BUF, nxt = AT_BUF - cur; const bool more = j + 1 < NT;
        if (more) { kreg = *(const v4u*)(ksrc + (size_t)(j + 1) * 64 * 64); vreg0 = *(const v4u*)(vsrc0 + (j + 1) * 64); vreg1 = *(const v4u*)(vsrc1 + (j + 1) * 64); }
        const int kv0 = j * 64;
        if (kv0 <= qw0 + 31) {
            f32x16 s0, s1;
#pragma unroll
            for (int i = 0; i < 16; ++i) { s0[i] = 0.f; s1[i] = 0.f; }
#pragma unroll
            for (int ks = 0; ks < 4; ++ks) {
                const s16x8 a0 = *(const LAS s16x8*)(lds + cur + at_addr(r32, 2 * ks + hi));
                const s16x8 a1 = *(const LAS s16x8*)(lds + cur + at_addr(32 + r32, 2 * ks + hi));
                s0 = __builtin_amdgcn_mfma_f32_32x32x16_bf16(a0, qf[ks], s0, 0, 0, 0);
                s1 = __builtin_amdgcn_mfma_f32_32x32x16_bf16(a1, qf[ks], s1, 0, 0, 0);
            }
            if (kv0 + 63 > qw0) {
#pragma unroll
                for (int i = 0; i < 16; ++i) { const int kv = kv0 + crow(i, hi); if (kv > qrow) s0[i] = -1e30f; if (kv + 32 > qrow) s1[i] = -1e30f; }
            }
            float rm = fmaxf(s0[0], s1[0]);
#pragma unroll
            for (int i = 1; i < 16; ++i) rm = fmaxf(rm, fmaxf(s0[i], s1[i]));
            rm = xhalf_max(rm);
            const float mn = fmaxf(m, rm); const float f = __builtin_amdgcn_exp2f(m - mn); m = mn;
            float ps = 0.f;
#pragma unroll
            for (int i = 0; i < 16; ++i) { s0[i] = __builtin_amdgcn_exp2f(s0[i] - mn); s1[i] = __builtin_amdgcn_exp2f(s1[i] - mn); ps += s0[i] + s1[i]; }
            l = l * f + ps;
            if (__any(f != 1.0f)) {
#pragma unroll
                for (int db = 0; db < 4; ++db)
#pragma unroll
                    for (int i = 0; i < 16; ++i) o[db][i] *= f;
            }
            v4u pw[4];
            pw[0] = (v4u){pk2(s0[0], s0[1]), pk2(s0[2], s0[3]), pk2(s0[4], s0[5]), pk2(s0[6], s0[7])};
            pw[1] = (v4u){pk2(s0[8], s0[9]), pk2(s0[10], s0[11]), pk2(s0[12], s0[13]), pk2(s0[14], s0[15])};
            pw[2] = (v4u){pk2(s1[0], s1[1]), pk2(s1[2], s1[3]), pk2(s1[4], s1[5]), pk2(s1[6], s1[7])};
            pw[3] = (v4u){pk2(s1[8], s1[9]), pk2(s1[10], s1[11]), pk2(s1[12], s1[13]), pk2(s1[14], s1[15])};
#pragma unroll
            for (int db = 0; db < 4; ++db) { const int dv = 32 * db + r32; const int vb = cur + 8192 + dv * 128 + 8 * hi, sw = (dv >> 1) & 7;
#pragma unroll
                for (int s4 = 0; s4 < 4; ++s4) {
                    const s16x4 lo = *(const LAS s16x4*)(lds + vb + (((2 * s4) ^ sw) << 4));
                    const s16x4 hh = *(const LAS s16x4*)(lds + vb + (((2 * s4 + 1) ^ sw) << 4));
                    const s16x8 av = (s16x8){lo[0], lo[1], lo[2], lo[3], hh[0], hh[1], hh[2], hh[3]};
                    o[db] = __builtin_amdgcn_mfma_f32_32x32x16_bf16(av, __builtin_bit_cast(s16x8, pw[s4]), o[db], 0, 0, 0);
                }
                __builtin_amdgcn_sched_barrier(0); }
        }
        if (more) { *(LAS v4u*)(lds + nxt + kdst) = kreg; *(LAS v4u*)(lds + nxt + vdst0) = vreg0; *(LAS v4u*)(lds + nxt + vdst1) = vreg1; }
        __syncthreads();
    }
    l = xhalf_sum(l);
    const float il = 1.0f / l;
#pragma unroll
    for (int db = 0; db < 4; ++db)
#pragma unroll
        for (int i = 0; i < 16; ++i) o[db][i] *= il;
}
__device__ __forceinline__ void attn_unit(const Args& a, LAS unsigned char* lds, int tid, int b, int head, int qb, float* stash  ) {
    unsigned char* ws = a.ws;
    const bf16* qn = (const bf16*)(ws + WS_QN); const bf16* kn = (const bf16*)(ws + WS_KN); const bf16* vt = (const bf16*)(ws + WS_VT);
    bf16* odf = (bf16*)((unsigned char*)a.out + OUT_ORWDF) + (size_t)T * 512;
    const int lane = tid & 63, wave = tid >> 6, r32 = lane & 31, hi = lane >> 5;
    const float d1 = wave_sum(a.in[17][lane] * a.in[18][lane]), d2 = wave_sum(a.in[19][lane] * a.in[20][lane]);
    const float lam = __expf(d1) - __expf(d2) + LAM_INIT;
    f32x16 o[4];
    attn_pass(qn, kn, vt, b, head, 0, qb, lds, tid, o);
    float* st = stash + tid * 64;
#pragma unroll
    for (int db = 0; db < 4; ++db)
#pragma unroll
        for (int g = 0; g < 4; ++g) *(f32x4*)(st + db * 16 + g * 4) = (f32x4){o[db][4 * g], o[db][4 * g + 1], o[db][4 * g + 2], o[db][4 * g + 3]};
    attn_pass(qn, kn, vt, b, head, 1, qb, lds, tid, o);
    float ss = 0.f;
#pragma unroll
    for (int db = 0; db < 4; ++db)
#pragma unroll
        for (int g = 0; g < 4; ++g) { const f32x4 s4 = *(const f32x4*)(st + db * 16 + g * 4);
#pragma unroll
            for (int e = 0; e < 4; ++e) { const float d = s4[e] - lam * o[db][4 * g + e]; o[db][4 * g + e] = d; ss += d * d; } }
    ss = xhalf_sum(ss);
    const float rs = (1.0f / sqrtf(ss * (1.f / 128.f) + 1e-6f)) * (1.0f - LAM_INIT);
    const size_t t = (size_t)b * SEQ + qb * 256 + wave * 32 + r32; const float* sw = a.in[21];
#pragma unroll
    for (int db = 0; db < 4; ++db)
#pragma unroll
        for (int g = 0; g < 4; ++g) { const int dv = 32 * db + 8 * g + 4 * hi; const f32x4 w4 = *(const f32x4*)(sw + dv);
            v2u ov; ov.x = pk2(o[db][4 * g] * rs * w4[0], o[db][4 * g + 1] * rs * w4[1]); ov.y = pk2(o[db][4 * g + 2] * rs * w4[2], o[db][4 * g + 3] * rs * w4[3]);
            *(v2u*)(odf + t * 512 + head * 128 + dv) = ov; }
}

__device__ __forceinline__ void phase7(const Args& a, LAS unsigned char* lds, int tid, int lane, int wave, int vcu, int G) {
    unsigned char* ws = a.ws;
    const int gw = vcu * NWAVES + wave, NGW = G * NWAVES;
    const float* x1 = a.out; const float* gain = a.in[25]; bf16* h2x = (bf16*)(ws + WS_H2X);
    for (int m = gw; m < T; m += NGW) {
        const f32x4* xr = (const f32x4*)(x1 + (size_t)m * DM) + lane; f32x4 v[4]; float s = 0.f;
#pragma unroll
        for (int j = 0; j < 4; ++j) { v[j] = xr[64 * j]; s += (v[j].x * v[j].x + v[j].y * v[j].y) + (v[j].z * v[j].z + v[j].w * v[j].w); }
        const float rstd = 1.0f / sqrtf(wave_sum(s) * (1.f / 1024.f) + 1e-6f);
        v2u* oh = (v2u*)(h2x + (size_t)m * 2048) + lane; v2u* ol = (v2u*)(h2x + (size_t)m * 2048 + 1024) + lane;
#pragma unroll
        for (int j = 0; j < 4; ++j) { const f32x4 g = ((const f32x4*)gain)[lane + 64 * j]; float h[4], lo[4]; unsigned hb[4];
#pragma unroll
            for (int e = 0; e < 4; ++e) { h[e] = v[j][e] * rstd * g[e]; hb[e] = f2bf(h[e]); lo[e] = h[e] - __builtin_bit_cast(float, hb[e] << 16); }
            v2u o; o.x = hb[0] | (hb[1] << 16); o.y = hb[2] | (hb[3] << 16); oh[64 * j] = o;
            v2u p; p.x = pk2(lo[0], lo[1]); p.y = pk2(lo[2], lo[3]); ol[64 * j] = p; }
    }
    LAS float* scr = (LAS float*)(lds + wave * 16384);
    bf16* wgu = (bf16*)(ws + WS_WGU); bf16* wd = (bf16*)(ws + WS_WD);
    constexpr int IGU = (1024 / 64) * (512 / 32);
    constexpr int IDN = (512 / 64) * (1024 / 32);
    for (int it = gw; it < NEXP * (2 * IGU + IDN); it += NGW) {
        const int e = it / (2 * IGU + IDN); int r = it % (2 * IGU + IDN);
        if (r < 2 * IGU) { const int up = r >= IGU; if (up) r -= IGU; const int kb = r / 16, nb = r % 16, n0 = 32 * nb;
            const float* W = (up ? a.in[31] : a.in[30]) + (size_t)e * 1024 * 512;
            tr_item(W, 512, wgu, 1024, 64 * kb, n0, (size_t)e * 1024 + (n0 >> 7) * 256 + (up ? 128 : 0) + (n0 & 127), 0, scr, lane);
        } else { r -= 2 * IGU; const int kb = r / 32, nb = r % 32;
            tr_item(a.in[32] + (size_t)e * 512 * 1024, 1024, wd, 512, 64 * kb, 32 * nb, (size_t)e * 1024 + 32 * nb, 0, scr, lane); }
    }
}

__device__ __forceinline__ void route_tile(const Args& a, LAS unsigned char* lds, int tid, int pm) {
    unsigned char* ws = a.ws;
    const float* LG = (const float*)(ws + WS_LOGITS); int* toke = (int*)(ws + WS_TOKE); float* tokw = (float*)(ws + WS_TOKW); int* tilecnt = (int*)(ws + WS_TILECNT);
    LAS int* cnt = (LAS int*)lds;
    if (tid < 32) cnt[tid] = 0;
    __syncthreads();
    if (tid < 256) {
        const int t = pm * 256 + tid; const float* lr = LG + (size_t)t * 128;
        float gl[4];
#pragma unroll
        for (int j = 0; j < 4; ++j) gl[j] = (lr[32 + j] + lr[96 + j]) + a.in[27][j];
        int gi = 0; float gm = gl[0];
#pragma unroll
        for (int j = 1; j < 4; ++j) if (gl[j] > gm) { gm = gl[j]; gi = j; }
        float gs = 0.f;
#pragma unroll
        for (int j = 0; j < 4; ++j) gs += __expf(gl[j] - gm);
        const float gtop = 1.0f / gs;
        float el[8];
#pragma unroll
        for (int j = 0; j < 8; ++j) el[j] = (lr[gi * 8 + j] + lr[64 + gi * 8 + j]) + a.in[29][gi * 8 + j];
        int i1 = 0; float e1 = el[0];
#pragma unroll
        for (int j = 1; j < 8; ++j) if (el[j] > e1) { e1 = el[j]; i1 = j; }
        int i2 = -1; float e2 = -3.0e38f;
#pragma unroll
        for (int j = 0; j < 8; ++j) if (j != i1 && el[j] > e2) { e2 = el[j]; i2 = j; }
        const float ex = __expf(e2 - e1); const float w1 = gtop / (1.0f + ex), w2 = gtop * ex / (1.0f + ex);
        const int x1 = gi * 8 + i1, x2 = gi * 8 + i2;
        toke[t * 2] = x1; toke[t * 2 + 1] = x2; tokw[t * 2] = w1; tokw[t * 2 + 1] = w2;
        atomicAdd((int*)&cnt[x1], 1); atomicAdd((int*)&cnt[x2], 1);
    }
    __syncthreads();
    if (tid < 32) tilecnt[pm * 32 + tid] = cnt[tid];
    __syncthreads();
}

__device__ __forceinline__ void phase9(const Args& a, LAS unsigned char* lds, int tid, int lane, int wave) {
    unsigned char* ws = a.ws;
    const int tile = blockIdx.x;
    if (tile >= 128) return;
    const int* tilecnt = (const int*)(ws + WS_TILECNT); const int* toke = (const int*)(ws + WS_TOKE); const float* tokw = (const float*)(ws + WS_TOKW);
    int* pos = (int*)(ws + WS_POS); float* roww = (float*)(ws + WS_ROWW); int* disp = (int*)(ws + WS_DISP);
    const bf16* h2x = (const bf16*)(ws + WS_H2X); bf16* hs = (bf16*)(ws + WS_HS);
    LAS int* tc = (LAS int*)lds;
    LAS int* tot = tc + 4096;
    LAS int* bef = tot + 32;
    LAS int* base = bef + 32;
    LAS int* pst = base + 32;
    LAS int* earr = pst + 32;
    LAS int* parr = earr + 512;
    for (int i = tid; i < 4096; i += NTHR) tc[i] = tilecnt[i];
    earr[tid] = toke[tile * 512 + tid];
    __syncthreads();
    if (tid < 32) { int s = 0, b = 0; for (int t = 0; t < 128; ++t) { const int c = tc[t * 32 + tid]; s += c; if (t < tile) b += c; } tot[tid] = s; bef[tid] = b; }
    __syncthreads();
    if (tid == 0) { int p = 0; for (int e = 0; e < 32; ++e) { pst[e] = p; base[e] = p + bef[e]; const int nt = (tot[e] + 255) >> 8;
                        if (tile == 0) { for (int k = 0; k < nt; ++k) disp[16 + (p >> 8) + k] = e; disp[512 + e] = p; disp[576 + e] = tot[e]; }
                        p += nt << 8; }
                    if (tile == 0) disp[0] = p >> 8; }
    __syncthreads();
    for (int q = 0; q < 4; ++q) { const int e = wave * 4 + q; int running = 0;
        for (int c8 = 0; c8 < 8; ++c8) { const int ai = c8 * 64 + lane; const bool mt = earr[ai] == e; const unsigned long long mk = __ballot(mt);
            if (mt) parr[ai] = base[e] + running + __popcll(mk & ((1ull << lane) - 1ull));
            running += __popcll(mk); } }
    __syncthreads();
    { const int ai = tid, p = parr[ai], t = tile * 256 + (ai >> 1); pos[t * 2 + (ai & 1)] = p; roww[p] = tokw[t * 2 + (ai & 1)]; }
    for (int i = 0; i < 64; ++i) { const int ai = wave * 64 + i, p = parr[ai], t = tile * 256 + (ai >> 1);
        const v4u* src = (const v4u*)(h2x + (size_t)t * 2048); v4u* dst = (v4u*)(hs + (size_t)p * 1024);
        dst[lane] = src[lane]; dst[lane + 64] = src[lane + 64]; }
    if (tile < 32) { const int p0 = pst[tile] + tot[tile], p1 = pst[tile] + (((tot[tile] + 255) >> 8) << 8); const v4u z = (v4u){0u, 0u, 0u, 0u};
        for (int r = p0 + wave; r < p1; r += NWAVES) { v4u* dst = (v4u*)(hs + (size_t)r * 1024); dst[lane] = z; dst[lane + 64] = z; if (lane == 0) roww[r] = 0.f; } }
}

__device__ __forceinline__ void phase12(const Args& a, int tid, int lane, int wave, int vcu, int G) {
    unsigned char* ws = a.ws;
    const int gw = vcu * NWAVES + wave, NGW = G * NWAVES; const int gt = vcu * NTHR + tid, NGT = G * NTHR;
    float* x = a.out; const bf16* y2 = (const bf16*)(ws + WS_Y2); const int* pos = (const int*)(ws + WS_POS); const float* gain = a.in[33]; bf16* h3 = (bf16*)(ws + WS_H3);
    for (int m = gw; m < T; m += NGW) {
        const int pa = pos[m * 2], pb = pos[m * 2 + 1];
        f32x4* xr = (f32x4*)(x + (size_t)m * DM) + lane; const v2u* ya = (const v2u*)(y2 + (size_t)pa * 1024) + lane; const v2u* yb = (const v2u*)(y2 + (size_t)pb * 1024) + lane;
        f32x4 v[4]; float s = 0.f;
#pragma unroll
        for (int j = 0; j < 4; ++j) { v[j] = xr[64 * j]; const v2u wa = ya[64 * j], wb = yb[64 * j];
            v[j].x += bflo(wa.x) + bflo(wb.x); v[j].y += bfhi(wa.x) + bfhi(wb.x); v[j].z += bflo(wa.y) + bflo(wb.y); v[j].w += bfhi(wa.y) + bfhi(wb.y);
            xr[64 * j] = v[j]; s += (v[j].x * v[j].x + v[j].y * v[j].y) + (v[j].z * v[j].z + v[j].w * v[j].w); }
        const float rstd = 1.0f / sqrtf(wave_sum(s) * (1.f / 1024.f) + 1e-6f);
        v2u* o8 = (v2u*)(h3 + (size_t)m * DM) + lane;
#pragma unroll
        for (int j = 0; j < 4; ++j) { const f32x4 g = ((const f32x4*)gain)[lane + 64 * j]; v2u o; o.x = pk2(v[j].x * rstd * g.x, v[j].y * rstd * g.y); o.y = pk2(v[j].z * rstd * g.z, v[j].w * rstd * g.w); o8[64 * j] = o; }
    }
    const f32x4* p = (const f32x4*)a.in[1]; v2u* p16 = (v2u*)(ws + WS_P16);
    for (int i = gt; i < T * 256 / 4; i += NGT) { const f32x4 v = p[i]; v2u o; o.x = pk2(v.x, v.y); o.y = pk2(v.z, v.w); p16[i] = o; }
}

#ifndef MK_N_LAUNCHES
#define MK_N_LAUNCHES 14
#endif
constexpr int NPHASE = 14;
__global__ void __launch_bounds__(NTHR, 2) mk_fwd(Args args) {
    extern __shared__ __attribute__((aligned(16))) unsigned char lds_raw[];
    LAS unsigned char* lds = (LAS unsigned char*)lds_raw;
    const int tid = threadIdx.x, lane = tid & 63, wave = __builtin_amdgcn_readfirstlane(tid >> 6);
    const int G = gridDim.x; const int bx = blockIdx.x; const int vcu = (G % 8 == 0) ? (bx % 8) * (G / 8) + bx / 8 : bx;
    unsigned char* ws = args.ws;
    const int lo = args.ph_lo, hi = args.ph_hi;
#ifdef ONLY_PHASE
#define IN(k) ((k) == ONLY_PHASE && lo <= (k) && (k) < hi)
#else
#define IN(k) (lo <= (k) && (k) < hi)
#endif
#if MK_N_LAUNCHES == 1
#define SEAM(k) do { if (IN(k) && IN((k) + 1)) { __threadfence(); cg::this_grid().sync(); __threadfence(); } } while (0)
#else
#define SEAM(k) do { } while (0)
#endif
    typedef pg8::bf16_t pbf;
    int K256 = 256, K512 = 512, K1024 = 1024, K2048 = 2048;
    asm volatile("" : "+s"(K256), "+s"(K512), "+s"(K1024), "+s"(K2048));
    if (IN(0)) { phase0(args, lds, tid, lane, wave, vcu, G); }
    SEAM(0);
    if (IN(1)) {
        { pg8::Gemm g{(const pbf*)(ws + WS_XN), (const pbf*)(ws + WS_WIN), T, 19 * 256, K1024}; pg8::OrderSkipV S; S.init(T, 19 * 256, G, bx);
          pg8::EpiProj E{(pbf*)(ws + WS_RKV), (pbf*)(ws + WS_PROJB), (pbf*)(ws + WS_GATES)};
          pg8::gemm_phase<pg8::EpiProj, pg8::OrderSkipV, true, true>(lds, g, S, E); }
        { pg8::Gemm g{(const pbf*)(ws + WS_WIN) + (size_t)2816 * 1024, (const pbf*)(ws + WS_XN), 512, T, K1024}; pg8::StaticOrder S; S.init(512, T, G, bx);
          pg8::EpiStore E{(pbf*)(ws + WS_VT), T};
          pg8::gemm_phase<pg8::EpiStore, pg8::StaticOrder, true, true>(lds, g, S, E); }
    }
    SEAM(1);
    if (IN(2)) { phase2(args, lds, tid, vcu, G); }
    SEAM(2);
    if (IN(3)) {
        pg8::Gemm g{(const pbf*)(ws + WS_LA), (const pbf*)(ws + WS_WLORA), T, 1536, K256}; pg8::StaticOrder S; S.init(T, 1536, G, bx);
        pg8::EpiLora E{(pbf*)(ws + WS_E), (pbf*)(ws + WS_A), (pbf*)(ws + WS_G), args.in[5], args.in[7]};
        pg8::gemm_phase<pg8::EpiLora, pg8::StaticOrder, true, true>(lds, g, S, E);
    }
    SEAM(3);
    if (IN(4)) {
        unsigned* qhead = (unsigned*)(ws + WS_CTL) + CW_QUEUE; LAS unsigned* ubox = (LAS unsigned*)(lds + MISC_OFF);
        float* stash = (float*)((unsigned char*)args.out + OUT_STASH) + (size_t)bx * 64 * 512;
        for (;;) {
            __syncthreads();
            if (tid == 0) ubox[0] = atomicAdd(qhead, 1u);
            __syncthreads();
            const int u = (int)ubox[0];
            if (u >= 64 + 512) break;
            if (u < 64) scan_unit(args, lds, tid, u);
            else { const int au = u - 64; attn_unit(args, lds, tid, (au & 31) >> 2, au & 3, 15 - (au >> 5), stash); }
        }
    }
    SEAM(4);
    if (IN(5)) {
        pg8::Gemm g{(const pbf*)((unsigned char*)args.out + OUT_ORWDF), (const pbf*)(ws + WS_WBRD), 2 * T, 2048, K512}; pg8::OrderPair S; S.init(T, 1024, G, bx);
        pg8::EpiMix E{(const pbf*)(ws + WS_GATES), (float*)(ws + WS_PART), (pbf*)(ws + WS_MIXED)};
        pg8::gemm_phase<pg8::EpiMix, pg8::OrderPair, true, true>(lds, g, S, E);
    }
    SEAM(5);
    if (IN(6)) {
        pg8::Gemm g{(const pbf*)(ws + WS_MIXED), (const pbf*)(ws + WS_WO), T, 1024, K1024}; pg8::StaticOrder S; S.init(T, 1024, G, bx);
        pg8::EpiRes E{args.in[0], args.out};
        pg8::gemm_phase<pg8::EpiRes, pg8::StaticOrder, true, true>(lds, g, S, E);
    }
    SEAM(6);
    if (IN(7)) { phase7(args, lds, tid, lane, wave, vcu, G); }
    SEAM(7);
    if (IN(8)) {
        pg8::Gemm g{(const pbf*)(ws + WS_H2X), (const pbf*)(ws + WS_WR), T, 256, K2048}; pg8::StaticOrder S; S.init(T, 256, G, bx);
        pg8::EpiLogits E{(float*)(ws + WS_LOGITS)};
        pg8::gemm_phase<pg8::EpiLogits, pg8::StaticOrder, true, true>(lds, g, S, E);
        VM_WAIT(); __syncthreads();
        pg8::Unit u;
        for (int i = 0; S.next(i, u); ++i) route_tile(args, lds, tid, u.pm);
    }
    SEAM(8);
    if (IN(9)) { phase9(args, lds, tid, lane, wave); }
    SEAM(9);
    if (IN(10) || IN(11)) {
        const int* disp = (const int*)(ws + WS_DISP); LAS int* tile_e = (LAS int*)(lds + MISC_OFF + 64);
        __syncthreads();
        const int NT = disp[0];
        for (int i = tid; i < NT && i < 320; i += NTHR) tile_e[i] = disp[16 + i];
        __syncthreads();
        if (IN(10)) {
            pg8::Gemm g{(const pbf*)(ws + WS_HS), (const pbf*)(ws + WS_WGU), MAXROWS, NEXP * 1024, K1024}; pg8::OrderMoe S{NT * 4, G, bx, tile_e};
            pg8::EpiAct E{(pbf*)(ws + WS_ACT)};
            pg8::gemm_phase<pg8::EpiAct, pg8::OrderMoe, true, true>(lds, g, S, E);
        }
        SEAM(10);
        if (IN(11)) {
            pg8::Gemm g{(const pbf*)(ws + WS_ACT), (const pbf*)(ws + WS_WD), MAXROWS, NEXP * 1024, K512}; pg8::OrderMoe S{NT * 4, G, bx, tile_e};
            pg8::EpiDown E{(pbf*)(ws + WS_Y2), (const float*)(ws + WS_ROWW)};
            pg8::gemm_phase<pg8::EpiDown, pg8::OrderMoe, true, true>(lds, g, S, E);
        }
    }
    SEAM(11);
    if (IN(12)) { phase12(args, tid, lane, wave, vcu, G); }
    SEAM(12);
    if (IN(13)) {
        { pg8::Gemm g{(const pbf*)(ws + WS_P16), (const pbf*)(ws + WS_WPP), T, 1024, K256}; pg8::StaticOrder S; S.init(T, 1024, G, bx);
          pg8::EpiStore E{(pbf*)(ws + WS_PP), 1024};
          pg8::gemm_phase<pg8::EpiStore, pg8::StaticOrder, true, true>(lds, g, S, E); }
        { pg8::Gemm g{(const pbf*)(ws + WS_H3), (const pbf*)(ws + WS_WPG), T, 1024, K1024}; pg8::StaticOrder S; S.init(T, 1024, G, bx);
          pg8::EpiFinal E{(const pbf*)(ws + WS_PP), args.out};
          pg8::gemm_phase<pg8::EpiFinal, pg8::StaticOrder, true, true>(lds, g, S, E); }
    }
#undef IN
#undef SEAM
}

extern "C" void kernel_launch(void* const* d_in, const int* in_sizes, int n_in, void* d_out, int out_size, void* d_ws, size_t ws_size, hipStream_t stream) {
    static int grid = 0;
    if (grid == 0) {
        if (n_in != 36 || in_sizes[0] != T * DM || out_size != T * DM || ws_size < WS_END) {
            fprintf(stderr, "kernel_launch: unexpected problem: n_in %d in0 %d out %d ws %zu (need %zu)\n", n_in, n_in > 0 ? in_sizes[0] : -1, out_size, ws_size, (size_t)WS_END); grid = -1; return; }
        int dev = 0, cus = 0, per_cu = 0;
        if (hipGetDevice(&dev) != hipSuccess || hipDeviceGetAttribute(&cus, hipDeviceAttributeMultiprocessorCount, dev) != hipSuccess) { grid = -1; return; }
        if (hipFuncSetAttribute((const void*)mk_fwd, hipFuncAttributeMaxDynamicSharedMemorySize, LDS_BYTES) != hipSuccess) { fprintf(stderr, "kernel_launch: hipFuncSetAttribute failed\n"); grid = -1; return; }
        if (hipOccupancyMaxActiveBlocksPerMultiprocessor(&per_cu, (const void*)mk_fwd, NTHR, LDS_BYTES) != hipSuccess || per_cu < 1) { fprintf(stderr, "kernel_launch: occupancy query says %d blocks per CU\n", per_cu); (void)hipGetLastError(); grid = -1; return; }
        grid = cus;
        if (grid > 256) grid = 256;
    }
    if (grid < 0) return;
    (void)hipMemsetAsync((char*)d_ws + WS_CTL, 0, CTL_ZERO_BYTES, stream);
    Args a{};
    for (int i = 0; i < 36; ++i) a.in[i] = (const float*)d_in[i];
    a.out = (float*)d_out; a.ws = (unsigned char*)d_ws;
#if MK_N_LAUNCHES == 1
    a.ph_lo = 0; a.ph_hi = NPHASE;
    void* kargs[] = {&a};
    const hipError_t e = hipLaunchCooperativeKernel((const void*)mk_fwd, dim3(grid), dim3(NTHR), kargs, LDS_BYTES, stream);
    if (e != hipSuccess) fprintf(stderr, "kernel_launch: cooperative launch failed: %s (grid %d)\n", hipGetErrorString(e), grid);
#else
    for (int ph = 0; ph < NPHASE; ++ph) { a.ph_lo = ph; a.ph_hi = ph + 1; hipLaunchKernelGGL(mk_fwd, dim3(grid), dim3(NTHR), LDS_BYTES, stream, a); }
#endif
}
```

```cpp
#include <hip/hip_runtime.h>
#include <hip/hip_cooperative_groups.h>
#include <cstdio>
#include <cstdint>
namespace cg = cooperative_groups;
namespace pg8 {
#define PG8_LAS __attribute__((address_space(3)))
typedef unsigned short bf16_t;
typedef short bf16x8 __attribute__((ext_vector_type(8)));
typedef float f32x4 __attribute__((ext_vector_type(4)));
typedef unsigned u32x4 __attribute__((ext_vector_type(4)));
constexpr int BM = 256, BK = 64, HALF = 128, HTB = HALF * BK * 2  , STAGE_BYTES = 8 * HTB, NXCD = 8, WGM = 8;

__host__ __device__ __forceinline__ int lds_byte(int r, int c) { const int st = (r >> 4) * 2 + (c >> 5), rr = r & 15, cc = c & 31, ob = rr * 64 + cc * 2; return st * 1024 + (ob ^ (((ob >> 9) & 1) << 5)); }
__host__ __device__ __forceinline__ void stage_rc(int b, int& R, int& C) { const int st = b / 1024, sb = b % 1024, swz = sb ^ (((sb >> 9) & 1) << 5); R = (st >> 1) * 16 + swz / 64; C = (st & 1) * 32 + (swz % 64) / 2; }
__host__ __device__ __forceinline__ int perm32(int rho) { const int n = rho >> 4, i = rho & 15; return 8 * (i >> 2) + 4 * n + (i & 3); }

struct Unit { int pm, pn; };
struct Gemm { const bf16_t* A; const bf16_t* Bt; int M, N, K; };

struct StaticOrder {
    int nM, nN, nwg, G, c;
    __host__ __device__ void init(int M, int N, int G_, int c_) { nM = M / BM; nN = N / BM; nwg = nM * nN; G = G_; c = c_; }
    __host__ __device__ bool next(int i, Unit& u) const {
        const long L = (long)i * G + c; if (L >= nwg) return false;
        int wgid = (int)L; { const int q = nwg / NXCD, r = nwg % NXCD, xcd = wgid % NXCD, off = wgid / NXCD; wgid = (xcd < r ? xcd * (q + 1) : r * (q + 1) + (xcd - r) * q) + off; }
        const int nig = WGM * nN, gid = wgid / nig, fm = gid * WGM, gsz = (nM - fm) < WGM ? (nM - fm) : WGM;
        u.pm = fm + ((wgid % nig) % gsz); u.pn = (wgid % nig) / gsz; return true;
    }
    __device__ __forceinline__ void a_ready(const Unit&) const {}
    __device__ __forceinline__ void done(const Unit&) const {}
};

__device__ __forceinline__ unsigned cvt_pk_bf16(float lo, float hi) { unsigned r; asm volatile("v_cvt_pk_bf16_f32 %0, %1, %2" : "=v"(r) : "v"(lo), "v"(hi)); return r; }
template <class Epi, class Sched, bool ALIGN_EPI = false, bool SP2 = false>
__device__ __forceinline__ void gemm_phase(PG8_LAS unsigned char* lds, const Gemm g, const Sched& S, const Epi& E) {
    const int tid = threadIdx.x, wid = __builtin_amdgcn_readfirstlane(tid >> 6), lane = tid & 63, wr = wid >> 2, wc = wid & 3, fr = lane & 15, fq = lane >> 4;
    const int K = g.K, nt = K / BK;
    unsigned voffA[2], voffB[2];
#pragma unroll
    for (int i = 0; i < 2; ++i) { int R, C; stage_rc(tid * 16 + i * 8192, R, C); const int Rb = Epi::PERM ? ((R & ~31) + perm32(R & 31)) : R;
        voffA[i] = (unsigned)(R * K + C) * 2u; voffB[i] = (unsigned)(Rb * K + C) * 2u; }
    const size_t kstep = (size_t)(BK * 2);
    const size_t hstep = (size_t)HALF * K * 2;
    const size_t tstep = 2 * hstep;
    const unsigned ldsw = (unsigned)wid * 1024u;
    const int aoff = lds_byte(wr * 64 + fr, fq * 8), boff = lds_byte(wc * 32 + fr, fq * 8);
#define PG8_SA(b, h) (((b) * 2 + (h)) * HTB)
#define PG8_SB(b, h) ((4 + (b) * 2 + (h)) * HTB)
#define PG8_STAGE(bufoff, gbase, voff) do { _Pragma("unroll") for (int _i = 0; _i < 2; ++_i) \
        __builtin_amdgcn_global_load_lds((const unsigned*)((const char*)(gbase) + (voff)[_i]), (PG8_LAS unsigned*)(lds + (bufoff) + ldsw + _i * 8192), 16, 0, 0); } while (0)
#define PG8_LDA(dst, b, h) do { _Pragma("unroll") for (int m = 0; m < 4; ++m) _Pragma("unroll") for (int k = 0; k < 2; ++k) dst[m][k] = *(const PG8_LAS bf16x8*)(lds + PG8_SA(b, h) + aoff + m * 2048 + k * 1024); } while (0)
#define PG8_LDB(dst, b, h) do { _Pragma("unroll") for (int n = 0; n < 2; ++n) _Pragma("unroll") for (int k = 0; k < 2; ++k) dst[n][k] = *(const PG8_LAS bf16x8*)(lds + PG8_SB(b, h) + boff + n * 2048 + k * 1024); } while (0)
#define PG8_MMA(ai, bj, At, Bt) do { __builtin_amdgcn_s_setprio(1); _Pragma("unroll") for (int m = 0; m < 4; ++m) _Pragma("unroll") for (int n = 0; n < 2; ++n) _Pragma("unroll") for (int k = 0; k < 2; ++k) \
        acc[ai][bj][m][n] = __builtin_amdgcn_mfma_f32_16x16x32_bf16(Bt[n][k], At[m][k], acc[ai][bj][m][n], 0, 0, 0); __builtin_amdgcn_s_setprio(0); } while (0)
#define PG8_WAIT_V(n) asm volatile("s_waitcnt vmcnt(" #n ")" ::: "memory")
#define PG8_WAIT_L(n) asm volatile("s_waitcnt lgkmcnt(" #n ")" ::: "memory")
#define PG8_BAR __builtin_amdgcn_s_barrier()
#define PG8_SCHED __builtin_amdgcn_sched_barrier(0)
    Unit cur, nxt; int ui = 0;
    if (!S.next(0, cur)) return;
    f32x4 acc[2][2][4][2];
#pragma unroll
    for (int a = 0; a < 2; ++a)
#pragma unroll
        for (int b = 0; b < 2; ++b)
#pragma unroll
            for (int m = 0; m < 4; ++m)
#pragma unroll
                for (int n = 0; n < 2; ++n) acc[a][b][m][n] = (f32x4){0.f, 0.f, 0.f, 0.f};
    bf16x8 At[4][2], B0[2][2], B1[2][2];
    const char* cA = (const char*)g.A + (size_t)cur.pm * tstep; const char* cB = (const char*)g.Bt + (size_t)cur.pn * tstep;
    S.a_ready(cur);
    if constexpr (SP2) {
        PG8_STAGE(PG8_SB(0, 0), cB, voffB); PG8_STAGE(PG8_SB(0, 1), cB + hstep, voffB); PG8_STAGE(PG8_SA(0, 0), cA, voffA); PG8_STAGE(PG8_SA(0, 1), cA + hstep, voffA);
        if (wr == 1) PG8_BAR;
        PG8_WAIT_V(2); PG8_BAR;
        PG8_STAGE(PG8_SB(1, 0), cB + kstep, voffB); PG8_STAGE(PG8_SA(1, 0), cA + kstep, voffA); PG8_STAGE(PG8_SB(1, 1), cB + hstep + kstep, voffB);
        PG8_WAIT_V(6); PG8_BAR;
    } else {
        PG8_STAGE(PG8_SB(0, 0), cB, voffB); PG8_STAGE(PG8_SA(0, 0), cA, voffA); PG8_STAGE(PG8_SB(0, 1), cB + hstep, voffB); PG8_STAGE(PG8_SA(0, 1), cA + hstep, voffA);
        if (wr == 1) PG8_BAR;
        PG8_WAIT_V(4); PG8_BAR;
        PG8_STAGE(PG8_SB(1, 0), cB + kstep, voffB); PG8_STAGE(PG8_SA(1, 0), cA + kstep, voffA); PG8_STAGE(PG8_SB(1, 1), cB + hstep + kstep, voffB);
        PG8_WAIT_V(6); PG8_BAR;
    }
    for (;;) {
        const bool has_next = S.next(ui + 1, nxt);
        const char* nA = has_next ? (const char*)g.A + (size_t)nxt.pm * tstep : cA; const char* nB = has_next ? (const char*)g.Bt + (size_t)nxt.pn * tstep : cB;
        for (int t = 0; t < nt; t += 2) {
            const bool last = (t == nt - 2);
            const char* a1 = cA + (size_t)(t + 1) * kstep;
            const char* a2 = last ? nA : cA + (size_t)(t + 2) * kstep; const char* b2 = last ? nB : cB + (size_t)(t + 2) * kstep;
            const char* a3 = a2 + kstep; const char* b3 = b2 + kstep;
            if (last && has_next) S.a_ready(nxt);
            if constexpr (SP2) {
            PG8_LDB(B0, 0, 0); PG8_LDB(B1, 0, 1); PG8_SCHED; PG8_LDA(At, 0, 0); PG8_STAGE(PG8_SA(1, 1), a1 + hstep, voffA);
            PG8_WAIT_V(8); PG8_WAIT_L(0); PG8_BAR; PG8_MMA(0, 0, At, B0); PG8_MMA(0, 1, At, B1); PG8_BAR; PG8_SCHED;
            PG8_LDA(At, 0, 1); PG8_STAGE(PG8_SB(0, 0), b2, voffB); PG8_STAGE(PG8_SB(0, 1), b2 + hstep, voffB); PG8_STAGE(PG8_SA(0, 0), a2, voffA);
            PG8_WAIT_V(8); PG8_WAIT_L(0); PG8_BAR; PG8_MMA(1, 0, At, B0); PG8_MMA(1, 1, At, B1); PG8_BAR; PG8_SCHED;
            PG8_LDB(B0, 1, 0); PG8_LDB(B1, 1, 1); PG8_SCHED; PG8_LDA(At, 1, 0); PG8_STAGE(PG8_SA(0, 1), a2 + hstep, voffA);
            PG8_WAIT_V(8); PG8_WAIT_L(0); PG8_BAR; PG8_MMA(0, 0, At, B0); PG8_MMA(0, 1, At, B1); PG8_BAR; PG8_SCHED;
            PG8_LDA(At, 1, 1); PG8_STAGE(PG8_SB(1, 0), b3, voffB); PG8_STAGE(PG8_SB(1, 1), b3 + hstep, voffB); PG8_STAGE(PG8_SA(1, 0), a3, voffA);
            PG8_WAIT_V(8); PG8_WAIT_L(0); PG8_BAR; PG8_MMA(1, 0, At, B0); PG8_MMA(1, 1, At, B1); PG8_BAR; PG8_SCHED;
            } else {
            PG8_LDB(B0, 0, 0); PG8_SCHED; PG8_LDA(At, 0, 0); PG8_STAGE(PG8_SA(1, 1), a1 + hstep, voffA);
            PG8_WAIT_L(8); PG8_BAR; PG8_WAIT_L(0); PG8_MMA(0, 0, At, B0); PG8_BAR; PG8_SCHED;
            PG8_LDB(B1, 0, 1); PG8_STAGE(PG8_SB(0, 0), b2, voffB);
            PG8_BAR; PG8_WAIT_L(0); PG8_MMA(0, 1, At, B1); PG8_BAR;
            PG8_LDA(At, 0, 1); PG8_STAGE(PG8_SA(0, 0), a2, voffA);
            PG8_BAR; PG8_WAIT_L(0); PG8_MMA(1, 0, At, B0); PG8_BAR; PG8_SCHED;
            PG8_STAGE(PG8_SB(0, 1), b2 + hstep, voffB);
            PG8_WAIT_V(6); PG8_BAR; PG8_MMA(1, 1, At, B1); PG8_BAR;
            PG8_LDB(B0, 1, 0); PG8_SCHED; PG8_LDA(At, 1, 0); PG8_STAGE(PG8_SA(0, 1), a2 + hstep, voffA);
            PG8_WAIT_L(8); PG8_BAR; PG8_WAIT_L(0); PG8_MMA(0, 0, At, B0); PG8_BAR; PG8_SCHED;
            PG8_LDB(B1, 1, 1); PG8_STAGE(PG8_SB(1, 0), b3, voffB);
            PG8_BAR; PG8_WAIT_L(0); PG8_MMA(0, 1, At, B1); PG8_BAR;
            PG8_LDA(At, 1, 1); PG8_STAGE(PG8_SA(1, 0), a3, voffA);
            PG8_BAR; PG8_WAIT_L(0); PG8_MMA(1, 0, At, B0); PG8_BAR; PG8_SCHED;
            PG8_STAGE(PG8_SB(1, 1), b3 + hstep, voffB);
            PG8_WAIT_V(6); PG8_BAR; PG8_MMA(1, 1, At, B1); PG8_BAR;
            }
        }
        if constexpr (ALIGN_EPI) { if (wr == 0) PG8_BAR; }
        if constexpr (!Epi::AFTER_DRAIN) { E(acc, cur, wr, wc, fr, fq); S.done(cur); }
        if (!has_next) break;
#pragma unroll
        for (int a = 0; a < 2; ++a)
#pragma unroll
            for (int b = 0; b < 2; ++b)
#pragma unroll
                for (int m = 0; m < 4; ++m)
#pragma unroll
                    for (int n = 0; n < 2; ++n) acc[a][b][m][n] = (f32x4){0.f, 0.f, 0.f, 0.f};
        cur = nxt; cA = nA; cB = nB; ++ui;
        if constexpr (ALIGN_EPI) { if (wr == 1) PG8_BAR; }
    }
    PG8_WAIT_V(0);
    if constexpr (!ALIGN_EPI) { if (wr == 0) PG8_BAR; }
    PG8_BAR;
    if constexpr (Epi::AFTER_DRAIN) { E.fused(acc, cur, wr, wc, fr, fq, lds, wid, lane); S.done(cur); }
#undef PG8_SA
#undef PG8_SB
#undef PG8_STAGE
#undef PG8_LDA
#undef PG8_LDB
#undef PG8_MMA
#undef PG8_WAIT_V
#undef PG8_WAIT_L
#undef PG8_BAR
#undef PG8_SCHED
}
}

constexpr int NB = 8, SEQ = 4096, DM = 1024, T = NB * SEQ;
constexpr int RW = 512, NHR = 8;
constexpr int NPROJ = 5376;
constexpr int FF = 512, NEXP = 32;
constexpr float C2 = 0.125f * 1.4426950408889634f;
constexpr float LAM_INIT = 0.2f;
constexpr int MAXROWS = 2 * T + NEXP * 256;

constexpr size_t MiB = 1u << 20;
constexpr size_t WS_CTL = 0, CTL_ZERO_BYTES = 1 * MiB;
constexpr size_t WS_WLORA = 1 * MiB;
constexpr size_t WS_WBRD = 2 * MiB;
constexpr size_t WS_WO = 4 * MiB;
constexpr size_t WS_WR = 6 * MiB;
constexpr size_t WS_WPG = 7 * MiB;
constexpr size_t WS_WPP = 9 * MiB;
constexpr size_t WS_TOKE = 10 * MiB;
constexpr size_t WS_TOKW = 10 * MiB + 256 * 1024;
constexpr size_t WS_POS = 10 * MiB + 512 * 1024;
constexpr size_t WS_ROWW = 10 * MiB + 768 * 1024;
constexpr size_t WS_TILECNT = 11 * MiB + 256 * 1024;
constexpr size_t WS_DISP = 11 * MiB + 512 * 1024;
constexpr size_t WS_BON = 12 * MiB;
constexpr size_t WS_WIN = 16 * MiB;
constexpr size_t WS_LA = 16 * MiB;
constexpr size_t WS_LOGITS = 16 * MiB;
constexpr size_t WS_XN = 32 * MiB;
constexpr size_t WS_QN = 32 * MiB;
constexpr size_t WS_KN = 64 * MiB;
constexpr size_t WS_WGU = 32 * MiB;
constexpr size_t WS_RKV = 96 * MiB;
constexpr size_t WS_MIXED = 96 * MiB;
constexpr size_t WS_WD = 96 * MiB;
constexpr size_t WS_HS = 128 * MiB;
constexpr size_t WS_H3 = 128 * MiB;
constexpr size_t WS_PROJB = 192 * MiB;
constexpr size_t WS_E = 192 * MiB;
constexpr size_t WS_A = 224 * MiB;
constexpr size_t WS_G = 256 * MiB;
constexpr size_t WS_P16 = 192 * MiB;
constexpr size_t WS_PP = 208 * MiB;
constexpr size_t WS_Y2 = 272 * MiB;
constexpr size_t WS_GATES = 304 * MiB;
constexpr size_t WS_H2X = 304 * MiB;
constexpr size_t WS_VT = 432 * MiB;
constexpr size_t WS_ACT = 432 * MiB;
constexpr size_t WS_PART = 176 * MiB;
constexpr size_t WS_END = 512 * MiB;
constexpr size_t OUT_STASH = 0, OUT_ORWDF = 32 * MiB;
static_assert(WS_ACT + (size_t)MAXROWS * 512 * 2 <= WS_END && WS_Y2 + (size_t)MAXROWS * 1024 * 2 <= WS_ACT && WS_HS + (size_t)MAXROWS * 1024 * 2 <= WS_Y2, "ws map");
static_assert(WS_PART + (size_t)T * 1024 * 4 <= WS_GATES && WS_MIXED + (size_t)T * 1024 * 2 <= WS_PART, "ws map");
constexpr int CW_QUEUE = 64;
constexpr int CW_BAR = 4096;

constexpr int RING_BYTES = 131072;
constexpr int MISC_OFF = RING_BYTES;
constexpr int LDS_BYTES = 147456;
constexpr int NWAVES = 8, NTHR = 512;

#define GAS __attribute__((address_space(1)))
#define LAS __attribute__((address_space(3)))
typedef unsigned short bf16;
typedef unsigned v4u __attribute__((ext_vector_type(4)));
typedef unsigned v2u __attribute__((ext_vector_type(2)));
typedef float f32x4 __attribute__((ext_vector_type(4)));
typedef float f32x16 __attribute__((ext_vector_type(16)));
typedef short s16x8 __attribute__((ext_vector_type(8)));
typedef short s16x4 __attribute__((ext_vector_type(4)));
#define LDS_WAIT() asm volatile("s_waitcnt lgkmcnt(0)" ::: "memory")
#define VM_WAIT() asm volatile("s_waitcnt vmcnt(0)" ::: "memory")

__device__ __forceinline__ unsigned f2bf(float f) { unsigned u = __builtin_bit_cast(unsigned, f); return (u + 0x7fffu + ((u >> 16) & 1u)) >> 16; }
__device__ __forceinline__ unsigned pk2(float lo, float hi) { return f2bf(lo) | (f2bf(hi) << 16); }
__device__ __forceinline__ float bflo(unsigned w) { return __builtin_bit_cast(float, w << 16); }
__device__ __forceinline__ float bfhi(unsigned w) { return __builtin_bit_cast(float, w & 0xffff0000u); }
__device__ __forceinline__ float sigm(float x) { return __builtin_amdgcn_rcpf(1.0f + __builtin_amdgcn_exp2f(-1.4426950408889634f * x)); }
__device__ __forceinline__ float wave_sum(float v) {
#pragma unroll
    for (int o = 1; o < 64; o <<= 1) v += __shfl_xor(v, o);
    return v;
}
__device__ __forceinline__ float xhalf_max(float m) { auto rr = __builtin_amdgcn_permlane32_swap(__builtin_bit_cast(unsigned, m), __builtin_bit_cast(unsigned, m), false, false);
    return fmaxf(__builtin_bit_cast(float, rr[0]), __builtin_bit_cast(float, rr[1])); }
__device__ __forceinline__ float xhalf_sum(float m) { auto rr = __builtin_amdgcn_permlane32_swap(__builtin_bit_cast(unsigned, m), __builtin_bit_cast(unsigned, m), false, false);
    return __builtin_bit_cast(float, rr[0]) + __builtin_bit_cast(float, rr[1]); }

namespace pg8 {
struct EpiStore {
    static constexpr bool PERM = true, AFTER_DRAIN = false;
    bf16_t* O; int ldc;
    __device__ __forceinline__ void operator()(const f32x4 (&acc)[2][2][4][2], const Unit& u, int wr, int wc, int fr, int fq) const {
        const int row0 = u.pm * BM + wr * 64 + fr, col0 = u.pn * BM + wc * 32 + 8 * fq;
#pragma unroll
        for (int ai = 0; ai < 2; ++ai)
#pragma unroll
            for (int m = 0; m < 4; ++m) { bf16_t* rowp = O + (size_t)(row0 + ai * HALF + m * 16) * ldc + col0;
#pragma unroll
                for (int bj = 0; bj < 2; ++bj) { const f32x4 v0 = acc[ai][bj][m][0], v1 = acc[ai][bj][m][1]; u32x4 w;
                    w.x = cvt_pk_bf16(v0[0], v0[1]); w.y = cvt_pk_bf16(v0[2], v0[3]); w.z = cvt_pk_bf16(v1[0], v1[1]); w.w = cvt_pk_bf16(v1[2], v1[3]);
                    *(u32x4*)(rowp + bj * HALF) = w; } }
    }
};
struct EpiProj {
    static constexpr bool PERM = true, AFTER_DRAIN = false;
    bf16_t *rkv, *projb, *gates;
    __device__ __forceinline__ void operator()(const f32x4 (&acc)[2][2][4][2], const Unit& u, int wr, int wc, int fr, int fq) const {
        bf16_t* base; int ldc, ct;
        if (u.pn < 6) { base = rkv; ldc = 1536; ct = u.pn; } else if (u.pn < 11) { base = projb; ldc = 1280; ct = u.pn - 6; } else { base = gates; ldc = 2048; ct = u.pn - 13; }
        const int row0 = u.pm * BM + wr * 64 + fr, col0 = ct * BM + wc * 32 + 8 * fq;
#pragma unroll
        for (int ai = 0; ai < 2; ++ai)
#pragma unroll
            for (int m = 0; m < 4; ++m) { bf16_t* rowp = base + (size_t)(row0 + ai * HALF + m * 16) * ldc + col0;
#pragma unroll
                for (int bj = 0; bj < 2; ++bj) { const f32x4 v0 = acc[ai][bj][m][0], v1 = acc[ai][bj][m][1]; u32x4 w;
                    w.x = cvt_pk_bf16(v0[0], v0[1]); w.y = cvt_pk_bf16(v0[2], v0[3]); w.z = cvt_pk_bf16(v1[0], v1[1]); w.w = cvt_pk_bf16(v1[2], v1[3]);
                    *(u32x4*)(rowp + bj * HALF) = w; } }
    }
};
struct EpiLora {
    static constexpr bool PERM = true, AFTER_DRAIN = false;
    bf16_t *E, *A, *G; const float *w0, *a0;
    template <int KIND> __device__ __forceinline__ void body(const f32x4 (&acc)[2][2][4][2], bf16_t* base, const float* bias, int row0, int col0) const {
#pragma unroll
        for (int bj = 0; bj < 2; ++bj)
#pragma unroll
            for (int ai = 0; ai < 2; ++ai)
#pragma unroll
                for (int m = 0; m < 4; ++m) { bf16_t* rowp = base + (size_t)(row0 + ai * HALF + m * 16) * 512 + col0 + bj * HALF;
                    f32x4 v0 = acc[ai][bj][m][0], v1 = acc[ai][bj][m][1];
                    if (KIND < 2) { const f32x4 b0 = *(const f32x4*)(bias + col0 + bj * HALF), b1 = *(const f32x4*)(bias + col0 + bj * HALF + 4); const float sc = KIND == 0 ? 0.60653065971263342f : 1.0f;
                        v0 += b0; v1 += b1;
#pragma unroll
                        for (int e = 0; e < 4; ++e) { v0[e] = sc * sigm(v0[e]); v1[e] = sc * sigm(v1[e]); } }
                    u32x4 w; w.x = cvt_pk_bf16(v0[0], v0[1]); w.y = cvt_pk_bf16(v0[2], v0[3]); w.z = cvt_pk_bf16(v1[0], v1[1]); w.w = cvt_pk_bf16(v1[2], v1[3]);
                    *(u32x4*)rowp = w; asm volatile("" ::: "memory"); }
    }
    __device__ __forceinline__ void operator()(const f32x4 (&acc)[2][2][4][2], const Unit& u, int wr, int wc, int fr, int fq) const {
        const int kind = u.pn >> 1; const int row0 = u.pm * BM + wr * 64 + fr, col0 = (u.pn & 1) * BM + wc * 32 + 8 * fq;
        if (kind == 0) body<0>(acc, E, w0, row0, col0); else if (kind == 1) body<1>(acc, A, a0, row0, col0); else body<2>(acc, G, w0, row0, col0);
    }
};
struct EpiMix {
    static constexpr bool PERM = true, AFTER_DRAIN = false;
    const bf16_t* gates; float* part; bf16_t* mixed;
    __device__ __forceinline__ void operator()(const f32x4 (&acc)[2][2][4][2], const Unit& u, int wr, int wc, int fr, int fq) const {
        const bool second = u.pm >= 128; const int pm = second ? u.pm - 128 : u.pm, pn = second ? u.pn - 4 : u.pn;
        const int row0 = pm * BM + wr * 64 + fr, col0 = pn * BM + wc * 32 + 8 * fq;
#pragma unroll
        for (int ai = 0; ai < 2; ++ai)
#pragma unroll
            for (int m = 0; m < 4; ++m) { const size_t r = (size_t)(row0 + ai * HALF + m * 16);
#pragma unroll
                for (int bj = 0; bj < 2; ++bj) { const int c = col0 + bj * HALF;
                    const u32x4 gw = *(const u32x4*)(gates + r * 2048 + (second ? 1024 : 0) + c);
                    f32x4 v0 = acc[ai][bj][m][0], v1 = acc[ai][bj][m][1];
                    v0[0] *= sigm(bflo(gw.x)); v0[1] *= sigm(bfhi(gw.x)); v0[2] *= sigm(bflo(gw.y)); v0[3] *= sigm(bfhi(gw.y));
                    v1[0] *= sigm(bflo(gw.z)); v1[1] *= sigm(bfhi(gw.z)); v1[2] *= sigm(bflo(gw.w)); v1[3] *= sigm(bfhi(gw.w));
                    float* pp = part + r * 1024 + c;
                    if (!second) { *(f32x4*)pp = v0; *(f32x4*)(pp + 4) = v1; }
                    else { v0 += *(const f32x4*)pp; v1 += *(const f32x4*)(pp + 4); u32x4 w;
                        w.x = cvt_pk_bf16(v0[0], v0[1]); w.y = cvt_pk_bf16(v0[2], v0[3]); w.z = cvt_pk_bf16(v1[0], v1[1]); w.w = cvt_pk_bf16(v1[2], v1[3]);
                        *(u32x4*)(mixed + r * 1024 + c) = w; } } }
    }
};
struct EpiRes {
    static constexpr bool PERM = false, AFTER_DRAIN = false;
    const float* x; float* out;
    __device__ __forceinline__ void operator()(const f32x4 (&acc)[2][2][4][2], const Unit& u, int wr, int wc, int fr, int fq) const {
        const int row0 = u.pm * BM + wr * 64 + fr, col0 = u.pn * BM + wc * 32 + 4 * fq;
#pragma unroll
        for (int ai = 0; ai < 2; ++ai)
#pragma unroll
            for (int m = 0; m < 4; ++m) { const size_t off = (size_t)(row0 + ai * HALF + m * 16) * 1024 + col0;
#pragma unroll
                for (int bj = 0; bj < 2; ++bj)
#pragma unroll
                    for (int n = 0; n < 2; ++n) *(f32x4*)(out + off + bj * HALF + n * 16) = *(const f32x4*)(x + off + bj * HALF + n * 16) + acc[ai][bj][m][n]; }
    }
};
struct EpiLogits {
    static constexpr bool PERM = false, AFTER_DRAIN = false;
    float* L;
    __device__ __forceinline__ void operator()(const f32x4 (&acc)[2][2][4][2], const Unit& u, int wr, int wc, int fr, int fq) const {
        const int row0 = u.pm * BM + wr * 64 + fr, col0 = wc * 32 + 4 * fq;
#pragma unroll
        for (int ai = 0; ai < 2; ++ai)
#pragma unroll
            for (int m = 0; m < 4; ++m) { float* rowp = L + (size_t)(row0 + ai * HALF + m * 16) * 128 + col0;
#pragma unroll
                for (int n = 0; n < 2; ++n) *(f32x4*)(rowp + n * 16) = acc[ai][0][m][n]; }
    }
};
struct EpiAct {
    static constexpr bool PERM = true, AFTER_DRAIN = false;
    bf16_t* act;
    __device__ __forceinline__ void operator()(const f32x4 (&acc)[2][2][4][2], const Unit& u, int wr, int wc, int fr, int fq) const {
        const int row0 = u.pm * BM + wr * 64 + fr, col0 = (u.pn & 3) * HALF + wc * 32 + 8 * fq;
#pragma unroll
        for (int ai = 0; ai < 2; ++ai)
#pragma unroll
            for (int m = 0; m < 4; ++m) { bf16_t* rowp = act + (size_t)(row0 + ai * HALF + m * 16) * 512 + col0; float o[8];
#pragma unroll
                for (int n = 0; n < 2; ++n)
#pragma unroll
                    for (int e = 0; e < 4; ++e) { const float g = acc[ai][0][m][n][e], up = acc[ai][1][m][n][e]; o[n * 4 + e] = g * sigm(g) * up; }
                u32x4 w; w.x = cvt_pk_bf16(o[0], o[1]); w.y = cvt_pk_bf16(o[2], o[3]); w.z = cvt_pk_bf16(o[4], o[5]); w.w = cvt_pk_bf16(o[6], o[7]);
                *(u32x4*)rowp = w; }
    }
};
struct EpiDown {
    static constexpr bool PERM = true, AFTER_DRAIN = false;
    bf16_t* y2; const float* roww;
    __device__ __forceinline__ void operator()(const f32x4 (&acc)[2][2][4][2], const Unit& u, int wr, int wc, int fr, int fq) const {
        const int row0 = u.pm * BM + wr * 64 + fr, col0 = (u.pn & 3) * BM + wc * 32 + 8 * fq;
#pragma unroll
        for (int ai = 0; ai < 2; ++ai)
#pragma unroll
            for (int m = 0; m < 4; ++m) { const int r = row0 + ai * HALF + m * 16; const float w8 = roww[r]; bf16_t* rowp = y2 + (size_t)r * 1024 + col0;
#pragma unroll
                for (int bj = 0; bj < 2; ++bj) { const f32x4 v0 = acc[ai][bj][m][0] * w8, v1 = acc[ai][bj][m][1] * w8; u32x4 w;
                    w.x = cvt_pk_bf16(v0[0], v0[1]); w.y = cvt_pk_bf16(v0[2], v0[3]); w.z = cvt_pk_bf16(v1[0], v1[1]); w.w = cvt_pk_bf16(v1[2], v1[3]);
                    *(u32x4*)(rowp + bj * HALF) = w; } }
    }
};
struct EpiFinal {
    static constexpr bool PERM = true, AFTER_DRAIN = false;
    const bf16_t* pp; float* out;
    __device__ __forceinline__ void operator()(const f32x4 (&acc)[2][2][4][2], const Unit& u, int wr, int wc, int fr, int fq) const {
        const int row0 = u.pm * BM + wr * 64 + fr, col0 = u.pn * BM + wc * 32 + 8 * fq;
#pragma unroll
        for (int ai = 0; ai < 2; ++ai)
#pragma unroll
            for (int m = 0; m < 4; ++m) { const size_t r = (size_t)(row0 + ai * HALF + m * 16);
#pragma unroll
                for (int bj = 0; bj < 2; ++bj) { const int c = col0 + bj * HALF;
                    const u32x4 pw = *(const u32x4*)(pp + r * 1024 + c); float* op = out + r * 1024 + c;
                    f32x4 x0 = *(const f32x4*)op, x1 = *(const f32x4*)(op + 4); const f32x4 a0 = acc[ai][bj][m][0], a1 = acc[ai][bj][m][1];
                    x0[0] += sigm(a0[0]) * bflo(pw.x); x0[1] += sigm(a0[1]) * bfhi(pw.x); x0[2] += sigm(a0[2]) * bflo(pw.y); x0[3] += sigm(a0[3]) * bfhi(pw.y);
                    x1[0] += sigm(a1[0]) * bflo(pw.z); x1[1] += sigm(a1[1]) * bfhi(pw.z); x1[2] += sigm(a1[2]) * bflo(pw.w); x1[3] += sigm(a1[3]) * bfhi(pw.w);
                    *(f32x4*)op = x0; *(f32x4*)(op + 4) = x1; asm volatile("" ::: "memory"); } }
    }
};
struct OrderSkipV : StaticOrder {
    __device__ __forceinline__ bool next(int i, Unit& u) const { if (!StaticOrder::next(i, u)) return false; if (u.pn >= 11) u.pn += 2; return true; }
};
struct OrderPair : StaticOrder {
    __device__ __forceinline__ bool next(int i, Unit& u) const { if (!StaticOrder::next(i >> 1, u)) return false; if (i & 1) { u.pm += 128; u.pn += 4; } return true; }
};
struct OrderMoe {
    int nwg, G, c; const PG8_LAS int* tile_e;
    __device__ __forceinline__ bool next(int i, Unit& u) const { const long L = (long)i * G + c; if (L >= nwg) return false; const int rt = (int)(L >> 2); u.pm = rt; u.pn = tile_e[rt] * 4 + (int)(L & 3); return true; }
    __device__ __forceinline__ void a_ready(const Unit&) const {}
    __device__ __forceinline__ void done(const Unit&) const {}
};
}

struct Args { const float* in[36]; float* out; unsigned char* ws; int ph_lo, ph_hi; };

__device__ __forceinline__ void tr_item(const float* W, int N, bf16* WT, int ld, int k0, int n0, size_t dst_row0, int k_off, LAS float* scr, int lane) {
#pragma unroll 8
    for (int i = 0; i < 32; ++i) { const int kk = 2 * i + (lane >> 5); scr[kk * 33 + (lane & 31)] = W[(size_t)(k0 + kk) * N + n0 + (lane & 31)]; }
    LDS_WAIT(); asm volatile("" ::: "memory");
    const int c = lane & 7;
#pragma unroll
    for (int j = 0; j < 4; ++j) { const int n = (lane >> 3) + 8 * j; const LAS float* s = scr + (8 * c) * 33 + n;
        v4u o; o.x = pk2(s[0 * 33], s[1 * 33]); o.y = pk2(s[2 * 33], s[3 * 33]); o.z = pk2(s[4 * 33], s[5 * 33]); o.w = pk2(s[6 * 33], s[7 * 33]);
        *(v4u*)(WT + (dst_row0 + n) * ld + k_off + k0 + 8 * c) = o; }
    LDS_WAIT(); asm volatile("" ::: "memory");
}
__device__ __forceinline__ void tr_matrix(const float* W, int K, int N, bf16* WT, int ld, size_t dst_row0, int k_off, LAS float* scr, int lane, int gw, int NGW) {
    const int nblk = N / 32, nitems = (K / 64) * nblk;
    for (int it = gw; it < nitems; it += NGW) { const int kb = it / nblk, nb = it % nblk; tr_item(W, N, WT, ld, 64 * kb, 32 * nb, dst_row0 + 32 * nb, k_off, scr, lane); }
}
__device__ __forceinline__ void rms_row_to_bf16(const float* xrow, const float* gain, bf16* orow, int lane) {
    const f32x4* xr = (const f32x4*)xrow + lane; f32x4 v[4]; float s = 0.f;
#pragma unroll
    for (int j = 0; j < 4; ++j) { v[j] = xr[64 * j]; s += (v[j].x * v[j].x + v[j].y * v[j].y) + (v[j].z * v[j].z + v[j].w * v[j].w); }
    const float rstd = 1.0f / sqrtf(wave_sum(s) * (1.f / 1024.f) + 1e-6f);
    v2u* o8 = (v2u*)orow + lane;
#pragma unroll
    for (int j = 0; j < 4; ++j) { const f32x4 g = ((const f32x4*)gain)[lane + 64 * j]; v2u o; o.x = pk2(v[j].x * rstd * g.x, v[j].y * rstd * g.y); o.y = pk2(v[j].z * rstd * g.z, v[j].w * rstd * g.w); o8[64 * j] = o; }
}

__device__ __forceinline__ void phase0(const Args& a, LAS unsigned char* lds, int tid, int lane, int wave, int vcu, int G) {
    unsigned char* ws = a.ws;
    LAS float* scr = (LAS float*)(lds + wave * 16384);
    const int gw = vcu * NWAVES + wave, NGW = G * NWAVES; const int gt = vcu * NTHR + tid, NGT = G * NTHR;
    tr_matrix(a.in[3], 1024, NPROJ, (bf16*)(ws + WS_WIN), 1024, 0, 0, scr, lane, gw, NGW);
    tr_matrix(a.in[6], 64, 512, (bf16*)(ws + WS_WLORA), 256, 0, 0, scr, lane, gw, NGW);
    tr_matrix(a.in[8], 64, 512, (bf16*)(ws + WS_WLORA), 256, 512, 64, scr, lane, gw, NGW);
    tr_matrix(a.in[9], 128, 512, (bf16*)(ws + WS_WLORA), 256, 1024, 128, scr, lane, gw, NGW);
    tr_matrix(a.in[22], 512, 1024, (bf16*)(ws + WS_WBRD), 512, 0, 0, scr, lane, gw, NGW);
    tr_matrix(a.in[23], 512, 1024, (bf16*)(ws + WS_WBRD), 512, 1024, 0, scr, lane, gw, NGW);
    tr_matrix(a.in[24], 1024, 1024, (bf16*)(ws + WS_WO), 1024, 0, 0, scr, lane, gw, NGW);
    tr_matrix(a.in[34], 1024, 1024, (bf16*)(ws + WS_WPG), 1024, 0, 0, scr, lane, gw, NGW);
    tr_matrix(a.in[35], 256, 1024, (bf16*)(ws + WS_WPP), 256, 0, 0, scr, lane, gw, NGW);
    { v4u* wl = (v4u*)(ws + WS_WLORA); const v4u z = (v4u){0u, 0u, 0u, 0u};
      for (int i = gt; i < 1536 * 32; i += NGT) { const int row = i >> 5, kc = (i & 31) * 8; const int blk = row >> 9;
          const bool diag = blk == 0 ? (kc < 64) : (blk == 1 ? (kc >= 64 && kc < 128) : (kc >= 128)); if (!diag) wl[i] = z; } }
    { bf16* wr = (bf16*)(ws + WS_WR); const float* wg = a.in[26]; const float* we = a.in[28];
      for (int i = gt; i < 256 * 1024; i += NGT) { const int row = i >> 10, k = i & 1023; unsigned short v = 0;
          const int n = row < 64 ? row : row - 64;
          if ((row < 36) || (row >= 64 && row < 100)) { const float w = n < 32 ? we[k * 32 + n] : wg[k * 4 + (n - 32)]; const unsigned h = f2bf(w);
              v = (unsigned short)(row < 64 ? h : f2bf(w - __builtin_bit_cast(float, h << 16))); }
          wr[(size_t)row * 2048 + k] = v; wr[(size_t)row * 2048 + 1024 + k] = v; } }
    for (int m = gw; m < T; m += NGW) rms_row_to_bf16(a.in[0] + (size_t)m * DM, a.in[2], (bf16*)(ws + WS_XN) + (size_t)m * DM, lane);
}

__device__ __forceinline__ void phase2(const Args& a, LAS unsigned char* lds, int tid, int vcu, int G) {
    unsigned char* ws = a.ws;
    const bf16* projb = (const bf16*)(ws + WS_PROJB); const float* mu = a.in[4];
    bf16* la = (bf16*)(ws + WS_LA); bf16* qn = (bf16*)(ws + WS_QN); bf16* kn = (bf16*)(ws + WS_KN);
    LAS float* cs = (LAS float*)lds;
    for (int tile = vcu; tile < T / 64; tile += G) {
        const int t0 = tile * 64;
        __syncthreads();
#pragma unroll
        for (int i = 0; i < 4; ++i) { const int idx = tid + 512 * i, tok = idx >> 5, i32 = idx & 31; const int s = (t0 + tok) & (SEQ - 1);
            const float inv = powf(10000.0f, -(float)i32 * (1.0f / 32.0f)); const float ang = (float)s * inv; float sn, c; sincosf(ang, &sn, &c);
            cs[(tok * 32 + i32) * 2] = c; cs[(tok * 32 + i32) * 2 + 1] = sn; }
#pragma unroll
        for (int i = 0; i < 4; ++i) { const int idx = tid + 512 * i, tok = idx >> 5, ch = idx & 31, t = t0 + tok, j0 = ch * 8; const bool first = (t & (SEQ - 1)) == 0;
            const v4u cur = *(const v4u*)(projb + (size_t)t * 1280 + j0); v4u prv = (v4u){0u, 0u, 0u, 0u}; if (!first) prv = *(const v4u*)(projb + (size_t)(t - 1) * 1280 + j0);
            const f32x4 m0 = *(const f32x4*)(mu + 1536 + j0), m1 = *(const f32x4*)(mu + 1536 + j0 + 4);
            float x[8]; const unsigned cw[4] = {cur.x, cur.y, cur.z, cur.w}, pw[4] = {prv.x, prv.y, prv.z, prv.w}; const float mm[8] = {m0.x, m0.y, m0.z, m0.w, m1.x, m1.y, m1.z, m1.w};
#pragma unroll
            for (int e = 0; e < 4; ++e) { const float c0 = bflo(cw[e]), c1 = bfhi(cw[e]), p0 = bflo(pw[e]), p1 = bfhi(pw[e]); x[2 * e] = c0 + (p0 - c0) * mm[2 * e]; x[2 * e + 1] = c1 + (p1 - c1) * mm[2 * e + 1]; }
            if (ch < 8) {
#pragma unroll
                for (int e = 0; e < 8; ++e) x[e] = tanhf(x[e]);
            } else if (ch >= 16) {
#pragma unroll
                for (int e = 0; e < 8; ++e) x[e] = sigm(x[e]);
            }
            v4u o; o.x = pk2(x[0], x[1]); o.y = pk2(x[2], x[3]); o.z = pk2(x[4], x[5]); o.w = pk2(x[6], x[7]);
            *(v4u*)(la + (size_t)t * 256 + j0) = o; }
        __syncthreads();
        for (int i = 0; i < 16; ++i) { const int idx = tid + 512 * i, tok = idx >> 7, grp = (idx >> 3) & 15, l8 = idx & 7, t = t0 + tok;
            const v4u w = *(const v4u*)(projb + (size_t)t * 1280 + 256 + grp * 64 + l8 * 8);
            float x[8] = {bflo(w.x), bfhi(w.x), bflo(w.y), bfhi(w.y), bflo(w.z), bfhi(w.z), bflo(w.w), bfhi(w.w)};
            float ss = 0.f;
#pragma unroll
            for (int e = 0; e < 8; ++e) ss += x[e] * x[e];
            ss += __shfl_xor(ss, 1); ss += __shfl_xor(ss, 2); ss += __shfl_xor(ss, 4);
            const float rs = 1.0f / sqrtf(ss * (1.f / 64.f) + 1e-6f);
            const float* gn = (grp < 8 ? a.in[15] : a.in[16]) + l8 * 8;
            const f32x4 g0 = *(const f32x4*)gn, g1 = *(const f32x4*)(gn + 4); const float gg[8] = {g0.x, g0.y, g0.z, g0.w, g1.x, g1.y, g1.z, g1.w};
            float y[8], o[8];
#pragma unroll
            for (int e = 0; e < 8; ++e) y[e] = x[e] * rs * gg[e];
            const float sgn = l8 < 4 ? -1.f : 1.f; const float sc = grp < 8 ? C2 : 1.f;
#pragma unroll
            for (int e = 0; e < 8; ++e) { const float yp = __shfl_xor(y[e], 4); const int ci = (tok * 32 + (l8 & 3) * 8 + e) * 2; const float c = cs[ci], sn = cs[ci + 1]; o[e] = (y[e] * c + sgn * yp * sn) * sc; }
            const int b = t >> 12, s = t & (SEQ - 1); bf16* dst = (grp < 8 ? qn : kn) + ((size_t)(b * 8 + (grp & 7)) * SEQ + s) * 64 + l8 * 8;
            v4u ov; ov.x = pk2(o[0], o[1]); ov.y = pk2(o[2], o[3]); ov.z = pk2(o[4], o[5]); ov.w = pk2(o[6], o[7]);
            *(v4u*)dst = ov; }
    }
}

constexpr int SC_NB = 32, SC_REC = 392;
constexpr int SC_BUF = SC_NB * SC_REC * 4;
constexpr int SC_YOFF = 2 * SC_BUF;
struct ScanIn { v2u r0, k0, v0, r1, k1, v1, e, av, g; };
__device__ __forceinline__ void scan_unit(const Args& a, LAS unsigned char* lds, int tid, int bh) {
    unsigned char* ws = a.ws;
    const int b = bh >> 3, hd = bh & 7; const int lane = tid & 63, wave = tid >> 6;
    const bf16* rkv = (const bf16*)(ws + WS_RKV); const bf16* E = (const bf16*)(ws + WS_E); const bf16* Aa = (const bf16*)(ws + WS_A); const bf16* Gg = (const bf16*)(ws + WS_G);
    bf16* orw = (bf16*)((unsigned char*)a.out + OUT_ORWDF); float* bon = (float*)(ws + WS_BON); (void)bon;
    const int st = tid >> 4, c4 = tid & 15, ch = hd * 64 + c4 * 4;
    const f32x4 mur = *(const f32x4*)(a.in[4] + ch), muk = *(const f32x4*)(a.in[4] + 512 + ch), muv = *(const f32x4*)(a.in[4] + 1024 + ch);
    const f32x4 kkw = *(const f32x4*)(a.in[10] + ch), kaw = *(const f32x4*)(a.in[11] + ch), rkw = *(const f32x4*)(a.in[12] + ch), lnw = *(const f32x4*)(a.in[13] + ch), lnb = *(const f32x4*)(a.in[14] + ch);
    const int row = wave * 8 + (lane >> 3), ks = lane & 7;
    float sreg[8];
#pragma unroll
    for (int j = 0; j < 8; ++j) sreg[j] = 0.f;
    const size_t tb = (size_t)b * SEQ;
    auto load_batch = [&](int s0, ScanIn& L) {
        const size_t t = tb + s0 + st; const bool first = (s0 + st) == 0;
        L.r0 = *(const v2u*)(rkv + t * 1536 + ch); L.k0 = *(const v2u*)(rkv + t * 1536 + 512 + ch); L.v0 = *(const v2u*)(rkv + t * 1536 + 1024 + ch);
        const size_t tp = first ? t : t - 1;
        L.r1 = *(const v2u*)(rkv + tp * 1536 + ch); L.k1 = *(const v2u*)(rkv + tp * 1536 + 512 + ch); L.v1 = *(const v2u*)(rkv + tp * 1536 + 1024 + ch);
        if (first) { L.r1 = (v2u){0u, 0u}; L.k1 = L.r1; L.v1 = L.r1; }
        L.e = *(const v2u*)(E + t * 512 + ch); L.av = *(const v2u*)(Aa + t * 512 + ch); L.g = *(const v2u*)(Gg + t * 512 + ch);
    };
    float keep_v[4], keep_g[4], keep_bonus;
    auto convert = [&](const ScanIn& L, int buf) {
        const unsigned r0w[2] = {L.r0.x, L.r0.y}, r1w[2] = {L.r1.x, L.r1.y}, k0w[2] = {L.k0.x, L.k0.y}, k1w[2] = {L.k1.x, L.k1.y}, v0w[2] = {L.v0.x, L.v0.y}, v1w[2] = {L.v1.x, L.v1.y};
        const unsigned ew[2] = {L.e.x, L.e.y}, aw[2] = {L.av.x, L.av.y}, gw[2] = {L.g.x, L.g.y};
        float r[4], k[4], v[4], e[4], av[4], kk[4];
#pragma unroll
        for (int i = 0; i < 4; ++i) { const int w = i >> 1; const bool hi = i & 1;
            const float rc = hi ? bfhi(r0w[w]) : bflo(r0w[w]), rp = hi ? bfhi(r1w[w]) : bflo(r1w[w]);
            const float kc = hi ? bfhi(k0w[w]) : bflo(k0w[w]), kp = hi ? bfhi(k1w[w]) : bflo(k1w[w]);
            const float vc = hi ? bfhi(v0w[w]) : bflo(v0w[w]), vp = hi ? bfhi(v1w[w]) : bflo(v1w[w]);
            r[i] = rc + (rp - rc) * mur[i]; k[i] = kc + (kp - kc) * muk[i]; v[i] = vc + (vp - vc) * muv[i];
            e[i] = hi ? bfhi(ew[w]) : bflo(ew[w]); av[i] = hi ? bfhi(aw[w]) : bflo(aw[w]); keep_g[i] = hi ? bfhi(gw[w]) : bflo(gw[w]); keep_v[i] = v[i];
            kk[i] = k[i] * kkw[i]; }
        float ss = kk[0] * kk[0] + kk[1] * kk[1] + kk[2] * kk[2] + kk[3] * kk[3];
        ss += __shfl_xor(ss, 1); ss += __shfl_xor(ss, 2); ss += __shfl_xor(ss, 4); ss += __shfl_xor(ss, 8);
        const float inv = 1.0f / fmaxf(sqrtf(ss), 1e-12f);
        f32x4 w4, aa4, bb4, km4, wr4, vv4; float br = 0.f, kr = 0.f, bo = 0.f;
#pragma unroll
        for (int i = 0; i < 4; ++i) { const float kki = kk[i] * inv; const float km = k[i] * (1.0f + (av[i] - 1.0f) * kaw[i]); const float w = __expf(-e[i]);
            w4[i] = w; aa4[i] = -kki; bb4[i] = kki * av[i]; km4[i] = km; wr4[i] = w * r[i]; vv4[i] = v[i];
            br += bb4[i] * r[i]; kr += km * r[i]; bo += r[i] * km * rkw[i]; }
        br += __shfl_xor(br, 1); br += __shfl_xor(br, 2); br += __shfl_xor(br, 4); br += __shfl_xor(br, 8);
        kr += __shfl_xor(kr, 1); kr += __shfl_xor(kr, 2); kr += __shfl_xor(kr, 4); kr += __shfl_xor(kr, 8);
        bo += __shfl_xor(bo, 1); bo += __shfl_xor(bo, 2); bo += __shfl_xor(bo, 4); bo += __shfl_xor(bo, 8);
        keep_bonus = bo;
        LAS float* rec = (LAS float*)(lds + buf * SC_BUF) + st * SC_REC + c4 * 4;
        *(LAS f32x4*)(rec) = w4; *(LAS f32x4*)(rec + 64) = aa4; *(LAS f32x4*)(rec + 128) = bb4; *(LAS f32x4*)(rec + 192) = km4; *(LAS f32x4*)(rec + 256) = wr4; *(LAS f32x4*)(rec + 320) = vv4;
        if (c4 == 0) { rec[384] = br; rec[385] = kr; }
    };
    ScanIn L; load_batch(0, L);
    __syncthreads();
    convert(L, 0);
    __syncthreads();
    for (int bi = 0; bi < SEQ / SC_NB; ++bi) {
        const int cur = bi & 1;
        if (bi + 1 < SEQ / SC_NB) load_batch((bi + 1) * SC_NB, L);
        const LAS float* base = (const LAS float*)(lds + cur * SC_BUF);
        LAS float* ybuf = (LAS float*)(lds + SC_YOFF);
#pragma unroll 2
        for (int i = 0; i < SC_NB; ++i) { const LAS float* rec = base + i * SC_REC;
            const f32x4 w0 = *(const LAS f32x4*)(rec + ks * 8), w1 = *(const LAS f32x4*)(rec + ks * 8 + 4);
            const f32x4 a0 = *(const LAS f32x4*)(rec + 64 + ks * 8), a1 = *(const LAS f32x4*)(rec + 64 + ks * 8 + 4);
            const f32x4 b0 = *(const LAS f32x4*)(rec + 128 + ks * 8), b1 = *(const LAS f32x4*)(rec + 128 + ks * 8 + 4);
            const f32x4 k0 = *(const LAS f32x4*)(rec + 192 + ks * 8), k1 = *(const LAS f32x4*)(rec + 192 + ks * 8 + 4);
            const f32x4 q0 = *(const LAS f32x4*)(rec + 256 + ks * 8), q1 = *(const LAS f32x4*)(rec + 256 + ks * 8 + 4);
            const float vv = rec[320 + row], br = rec[384], kr = rec[385];
            float sa = (sreg[0] * a0[0] + sreg[1] * a0[1]) + (sreg[2] * a0[2] + sreg[3] * a0[3]) + (sreg[4] * a1[0] + sreg[5] * a1[1]) + (sreg[6] * a1[2] + sreg[7] * a1[3]);
            float z = (sreg[0] * q0[0] + sreg[1] * q0[1]) + (sreg[2] * q0[2] + sreg[3] * q0[3]) + (sreg[4] * q1[0] + sreg[5] * q1[1]) + (sreg[6] * q1[2] + sreg[7] * q1[3]);
            sa += __shfl_xor(sa, 1); z += __shfl_xor(z, 1); sa += __shfl_xor(sa, 2); z += __shfl_xor(z, 2); sa += __shfl_xor(sa, 4); z += __shfl_xor(z, 4);
            const float y = z + sa * br + vv * kr;
            if (ks == 0) ybuf[i * 64 + row] = y;
            sreg[0] = sreg[0] * w0[0] + sa * b0[0] + vv * k0[0]; sreg[1] = sreg[1] * w0[1] + sa * b0[1] + vv * k0[1]; sreg[2] = sreg[2] * w0[2] + sa * b0[2] + vv * k0[2]; sreg[3] = sreg[3] * w0[3] + sa * b0[3] + vv * k0[3];
            sreg[4] = sreg[4] * w1[0] + sa * b1[0] + vv * k1[0]; sreg[5] = sreg[5] * w1[1] + sa * b1[1] + vv * k1[1]; sreg[6] = sreg[6] * w1[2] + sa * b1[2] + vv * k1[2]; sreg[7] = sreg[7] * w1[3] + sa * b1[3] + vv * k1[3];
        }
        __syncthreads();
        { const f32x4 y4 = *(const LAS f32x4*)(ybuf + st * 64 + c4 * 4);
          float sm = (y4[0] + y4[1]) + (y4[2] + y4[3]); sm += __shfl_xor(sm, 1); sm += __shfl_xor(sm, 2); sm += __shfl_xor(sm, 4); sm += __shfl_xor(sm, 8);
          const float mean = sm * (1.f / 64.f); const f32x4 d = y4 - mean;
          float vs = (d[0] * d[0] + d[1] * d[1]) + (d[2] * d[2] + d[3] * d[3]); vs += __shfl_xor(vs, 1); vs += __shfl_xor(vs, 2); vs += __shfl_xor(vs, 4); vs += __shfl_xor(vs, 8);
          const float rstd = 1.0f / sqrtf(vs * (1.f / 64.f) + 64e-5f); float o[4];
#pragma unroll
          for (int i = 0; i < 4; ++i) o[i] = ((d[i] * rstd * lnw[i] + lnb[i]) + keep_bonus * keep_v[i]) * keep_g[i];
          v2u ov; ov.x = pk2(o[0], o[1]); ov.y = pk2(o[2], o[3]);
          *(v2u*)(orw + (tb + bi * SC_NB + st) * 512 + ch) = ov; }
        if (bi + 1 < SEQ / SC_NB) convert(L, cur ^ 1);
        __syncthreads();
    }
}

__device__ __forceinline__ int crow(int r, int hi) { return (r & 3) + 8 * (r >> 2) + 4 * hi; }
constexpr int AT_BUF = 24576;
__device__ __forceinline__ int at_addr(int row, int ch) { return row * 128 + ((ch ^ ((row >> 1) & 7)) << 4); }
__device__ __forceinline__ void attn_pass(const bf16* qn, const bf16* kn, const bf16* vt, int b, int head, int c, int qb, LAS unsigned char* lds, int tid, f32x16 (&o)[4]) {
    const int lane = tid & 63, wave = __builtin_amdgcn_readfirstlane(tid >> 6), r32 = lane & 31, hi = lane >> 5;
    const int vh = b * 8 + head * 2 + c; const int q0 = qb * 256, qw0 = q0 + wave * 32, qrow = qw0 + r32;
    const bf16* Qp = qn + ((size_t)vh * SEQ + qrow) * 64;
    s16x8 qf[4];
#pragma unroll
    for (int ks = 0; ks < 4; ++ks) qf[ks] = *(const s16x8*)(Qp + 16 * ks + 8 * hi);
    const int k_row = tid >> 3, k_ch = tid & 7;
    const bf16* ksrc = kn + (size_t)vh * SEQ * 64 + k_row * 64 + k_ch * 8; const int kdst = at_addr(k_row, k_ch);
    const int dv0 = tid >> 3, dv1 = 64 + (tid >> 3);
    const bf16* vsrc0 = vt + (size_t)(head * 128 + dv0) * T + (size_t)b * SEQ + k_ch * 8; const bf16* vsrc1 = vsrc0 + (size_t)64 * T;
    const int vdst0 = 8192 + at_addr(dv0, k_ch), vdst1 = 8192 + at_addr(dv1, k_ch);
    const int NT = 4 * qb + 4;
    v4u kreg = *(const v4u*)ksrc, vreg0 = *(const v4u*)vsrc0, vreg1 = *(const v4u*)vsrc1;
    __syncthreads();
    *(LAS v4u*)(lds + kdst) = kreg; *(LAS v4u*)(lds + vdst0) = vreg0; *(LAS v4u*)(lds + vdst1) = vreg1;
    __syncthreads();
    float m = -1e30f, l = 0.f;
#pragma unroll
    for (int db = 0; db < 4; ++db)
#pragma unroll
        for (int i = 0; i < 16; ++i) o[db][i] = 0.f;
    for (int j = 0; j < NT; ++j) {
        const int cur = (j & 1) * AT_BUF, nxt = AT_BUF - cur; const bool more = j + 1 < NT;
        if (more) { kreg = *(const v4u*)(ksrc + (size_t)(j + 1) * 64 * 64); vreg0 = *(const v4u*)(vsrc0 + (j + 1) * 64); vreg1 = *(const v4u*)(vsrc1 + (j + 1) * 64); }
        const int kv0 = j * 64;
        if (kv0 <= qw0 + 31) {
            f32x16 s0, s1;
#pragma unroll
            for (int i = 0; i < 16; ++i) { s0[i] = 0.f; s1[i] = 0.f; }
#pragma unroll
            for (int ks = 0; ks < 4; ++ks) {
                const s16x8 a0 = *(const LAS s16x8*)(lds + cur + at_addr(r32, 2 * ks + hi));
                const s16x8 a1 = *(const LAS s16x8*)(lds + cur + at_addr(32 + r32, 2 * ks + hi));
                s0 = __builtin_amdgcn_mfma_f32_32x32x16_bf16(a0, qf[ks], s0, 0, 0, 0);
                s1 = __builtin_amdgcn_mfma_f32_32x32x16_bf16(a1, qf[ks], s1, 0, 0, 0);
            }
            if (kv0 + 63 > qw0) {
#pragma unroll
                for (int i = 0; i < 16; ++i) { const int kv = kv0 + crow(i, hi); if (kv > qrow) s0[i] = -1e30f; if (kv + 32 > qrow) s1[i] = -1e30f; }
            }
            float rm = fmaxf(s0[0], s1[0]);
#pragma unroll
            for (int i = 1; i < 16; ++i) rm = fmaxf(rm, fmaxf(s0[i], s1[i]));
            rm = xhalf_max(rm);
            const float mn = fmaxf(m, rm); const float f = __builtin_amdgcn_exp2f(m - mn); m = mn;
            float ps = 0.f;
#pragma unroll
            for (int i = 0; i < 16; ++i) { s0[i] = __builtin_amdgcn_exp2f(s0[i] - mn); s1[i] = __builtin_amdgcn_exp2f(s1[i] - mn); ps += s0[i] + s1[i]; }
            l = l * f + ps;
            if (__any(f != 1.0f)) {
#pragma unroll
                for (int db = 0; db < 4; ++db)
#pragma unroll
                    for (int i = 0; i < 16; ++i) o[db][i] *= f;
            }
            v4u pw[4];
            pw[0] = (v4u){pk2(s0[0], s0[1]), pk2(s0[2], s0[3]), pk2(s0[4], s0[5]), pk2(s0[6], s0[7])};
            pw[1] = (v4u){pk2(s0[8], s0[9]), pk2(s0[10], s0[11]), pk2(s0[12], s0[13]), pk2(s0[14], s0[15])};
            pw[2] = (v4u){pk2(s1[0], s1[1]), pk2(s1[2], s1[3]), pk2(s1[4], s1[5]), pk2(s1[6], s1[7])};
            pw[3] = (v4u){pk2(s1[8], s1[9]), pk2(s1[10], s1[11]), pk2(s1[12], s1[13]), pk2(s1[14], s1[15])};
#pragma unroll
            for (int db = 0; db < 4; ++db) { const int dv = 32 * db + r32; const int vb = cur + 8192 + dv * 128 + 8 * hi, sw = (dv >> 1) & 7;
#pragma unroll
                for (int s4 = 0; s4 < 4; ++s4) {
                    const s16x4 lo = *(const LAS s16x4*)(lds + vb + (((2 * s4) ^ sw) << 4));
                    const s16x4 hh = *(const LAS s16x4*)(lds + vb + (((2 * s4 + 1) ^ sw) << 4));
                    const s16x8 av = (s16x8){lo[0], lo[1], lo[2], lo[3], hh[0], hh[1], hh[2], hh[3]};
                    o[db] = __builtin_amdgcn_mfma_f32_32x32x16_bf16(av, __builtin_bit_cast(s16x8, pw[s4]), o[db], 0, 0, 0);
                }
                __builtin_amdgcn_sched_barrier(0); }
        }
        if (more) { *(LAS v4u*)(lds + nxt + kdst) = kreg; *(LAS v4u*)(lds + nxt + vdst0) = vreg0; *(LAS v4u*)(lds + nxt + vdst1) = vreg1; }
        __syncthreads();
    }
    l = xhalf_sum(l);
    const float il = 1.0f / l;
#pragma unroll
    for (int db = 0; db < 4; ++db)
#pragma unroll
        for (int i = 0; i < 16; ++i) o[db][i] *= il;
}
__device__ __forceinline__ void attn_unit(const Args& a, LAS unsigned char* lds, int tid, int b, int head, int qb, float* stash  ) {
    unsigned char* ws = a.ws;
    const bf16* qn = (const bf16*)(ws + WS_QN); const bf16* kn = (const bf16*)(ws + WS_KN); const bf16* vt = (const bf16*)(ws + WS_VT);
    bf16* odf = (bf16*)((unsigned char*)a.out + OUT_ORWDF) + (size_t)T * 512;
    const int lane = tid & 63, wave = tid >> 6, r32 = lane & 31, hi = lane >> 5;
    const float d1 = wave_sum(a.in[17][lane] * a.in[18][lane]), d2 = wave_sum(a.in[19][lane] * a.in[20][lane]);
    const float lam = __expf(d1) - __expf(d2) + LAM_INIT;
    f32x16 o[4];
    attn_pass(qn, kn, vt, b, head, 0, qb, lds, tid, o);
    float* st = stash + tid * 64;
#pragma unroll
    for (int db = 0; db < 4; ++db)
#pragma unroll
        for (int g = 0; g < 4; ++g) *(f32x4*)(st + db * 16 + g * 4) = (f32x4){o[db][4 * g], o[db][4 * g + 1], o[db][4 * g + 2], o[db][4 * g + 3]};
    attn_pass(qn, kn, vt, b, head, 1, qb, lds, tid, o);
    float ss = 0.f;
#pragma unroll
    for (int db = 0; db < 4; ++db)
#pragma unroll
        for (int g = 0; g < 4; ++g) { const f32x4 s4 = *(const f32x4*)(st + db * 16 + g * 4);
#pragma unroll
            for (int e = 0; e < 4; ++e) { const float d = s4[e] - lam * o[db][4 * g + e]; o[db][4 * g + e] = d; ss += d * d; } }
    ss = xhalf_sum(ss);
    const float rs = (1.0f / sqrtf(ss * (1.f / 128.f) + 1e-6f)) * (1.0f - LAM_INIT);
    const size_t t = (size_t)b * SEQ + qb * 256 + wave * 32 + r32; const float* sw = a.in[21];
#pragma unroll
    for (int db = 0; db < 4; ++db)
#pragma unroll
        for (int g = 0; g < 4; ++g) { const int dv = 32 * db + 8 * g + 4 * hi; const f32x4 w4 = *(const f32x4*)(sw + dv);
            v2u ov; ov.x = pk2(o[db][4 * g] * rs * w4[0], o[db][4 * g + 1] * rs * w4[1]); ov.y = pk2(o[db][4 * g + 2] * rs * w4[2], o[db][4 * g + 3] * rs * w4[3]);
            *(v2u*)(odf + t * 512 + head * 128 + dv) = ov; }
}

__device__ __forceinline__ void phase7(const Args& a, LAS unsigned char* lds, int tid, int lane, int wave, int vcu, int G) {
    unsigned char* ws = a.ws;
    const int gw = vcu * NWAVES + wave, NGW = G * NWAVES;
    const float* x1 = a.out; const float* gain = a.in[25]; bf16* h2x = (bf16*)(ws + WS_H2X);
    for (int m = gw; m < T; m += NGW) {
        const f32x4* xr = (const f32x4*)(x1 + (size_t)m * DM) + lane; f32x4 v[4]; float s = 0.f;
#pragma unroll
        for (int j = 0; j < 4; ++j) { v[j] = xr[64 * j]; s += (v[j].x * v[j].x + v[j].y * v[j].y) + (v[j].z * v[j].z + v[j].w * v[j].w); }
        const float rstd = 1.0f / sqrtf(wave_sum(s) * (1.f / 1024.f) + 1e-6f);
        v2u* oh = (v2u*)(h2x + (size_t)m * 2048) + lane; v2u* ol = (v2u*)(h2x + (size_t)m * 2048 + 1024) + lane;
#pragma unroll
        for (int j = 0; j < 4; ++j) { const f32x4 g = ((const f32x4*)gain)[lane + 64 * j]; float h[4], lo[4]; unsigned hb[4];
#pragma unroll
            for (int e = 0; e < 4; ++e) { h[e] = v[j][e] * rstd * g[e]; hb[e] = f2bf(h[e]); lo[e] = h[e] - __builtin_bit_cast(float, hb[e] << 16); }
            v2u o; o.x = hb[0] | (hb[1] << 16); o.y = hb[2] | (hb[3] << 16); oh[64 * j] = o;
            v2u p; p.x = pk2(lo[0], lo[1]); p.y = pk2(lo[2], lo[3]); ol[64 * j] = p; }
    }
    LAS float* scr = (LAS float*)(lds + wave * 16384);
    bf16* wgu = (bf16*)(ws + WS_WGU); bf16* wd = (bf16*)(ws + WS_WD);
    constexpr int IGU = (1024 / 64) * (512 / 32);
    constexpr int IDN = (512 / 64) * (1024 / 32);
    for (int it = gw; it < NEXP * (2 * IGU + IDN); it += NGW) {
        const int e = it / (2 * IGU + IDN); int r = it % (2 * IGU + IDN);
        if (r < 2 * IGU) { const int up = r >= IGU; if (up) r -= IGU; const int kb = r / 16, nb = r % 16, n0 = 32 * nb;
            const float* W = (up ? a.in[31] : a.in[30]) + (size_t)e * 1024 * 512;
            tr_item(W, 512, wgu, 1024, 64 * kb, n0, (size_t)e * 1024 + (n0 >> 7) * 256 + (up ? 128 : 0) + (n0 & 127), 0, scr, lane);
        } else { r -= 2 * IGU; const int kb = r / 32, nb = r % 32;
            tr_item(a.in[32] + (size_t)e * 512 * 1024, 1024, wd, 512, 64 * kb, 32 * nb, (size_t)e * 1024 + 32 * nb, 0, scr, lane); }
    }
}

__device__ __forceinline__ void route_tile(const Args& a, LAS unsigned char* lds, int tid, int pm) {
    unsigned char* ws = a.ws;
    const float* LG = (const float*)(ws + WS_LOGITS); int* toke = (int*)(ws + WS_TOKE); float* tokw = (float*)(ws + WS_TOKW); int* tilecnt = (int*)(ws + WS_TILECNT);
    LAS int* cnt = (LAS int*)lds;
    if (tid < 32) cnt[tid] = 0;
    __syncthreads();
    if (tid < 256) {
        const int t = pm * 256 + tid; const float* lr = LG + (size_t)t * 128;
        float gl[4];
#pragma unroll
        for (int j = 0; j < 4; ++j) gl[j] = (lr[32 + j] + lr[96 + j]) + a.in[27][j];
        int gi = 0; float gm = gl[0];
#pragma unroll
        for (int j = 1; j < 4; ++j) if (gl[j] > gm) { gm = gl[j]; gi = j; }
        float gs = 0.f;
#pragma unroll
        for (int j = 0; j < 4; ++j) gs += __expf(gl[j] - gm);
        const float gtop = 1.0f / gs;
        float el[8];
#pragma unroll
        for (int j = 0; j < 8; ++j) el[j] = (lr[gi * 8 + j] + lr[64 + gi * 8 + j]) + a.in[29][gi * 8 + j];
        int i1 = 0; float e1 = el[0];
#pragma unroll
        for (int j = 1; j < 8; ++j) if (el[j] > e1) { e1 = el[j]; i1 = j; }
        int i2 = -1; float e2 = -3.0e38f;
#pragma unroll
        for (int j = 0; j < 8; ++j) if (j != i1 && el[j] > e2) { e2 = el[j]; i2 = j; }
        const float ex = __expf(e2 - e1); const float w1 = gtop / (1.0f + ex), w2 = gtop * ex / (1.0f + ex);
        const int x1 = gi * 8 + i1, x2 = gi * 8 + i2;
        toke[t * 2] = x1; toke[t * 2 + 1] = x2; tokw[t * 2] = w1; tokw[t * 2 + 1] = w2;
        atomicAdd((int*)&cnt[x1], 1); atomicAdd((int*)&cnt[x2], 1);
    }
    __syncthreads();
    if (tid < 32) tilecnt[pm * 32 + tid] = cnt[tid];
    __syncthreads();
}

__device__ __forceinline__ void phase9(const Args& a, LAS unsigned char* lds, int tid, int lane, int wave) {
    unsigned char* ws = a.ws;
    const int tile = blockIdx.x;
    if (tile >= 128) return;
    const int* tilecnt = (const int*)(ws + WS_TILECNT); const int* toke = (const int*)(ws + WS_TOKE); const float* tokw = (const float*)(ws + WS_TOKW);
    int* pos = (int*)(ws + WS_POS); float* roww = (float*)(ws + WS_ROWW); int* disp = (int*)(ws + WS_DISP);
    const bf16* h2x = (const bf16*)(ws + WS_H2X); bf16* hs = (bf16*)(ws + WS_HS);
    LAS int* tc = (LAS int*)lds;
    LAS int* tot = tc + 4096;
    LAS int* bef = tot + 32;
    LAS int* base = bef + 32;
    LAS int* pst = base + 32;
    LAS int* earr = pst + 32;
    LAS int* parr = earr + 512;
    for (int i = tid; i < 4096; i += NTHR) tc[i] = tilecnt[i];
    earr[tid] = toke[tile * 512 + tid];
    __syncthreads();
    if (tid < 32) { int s = 0, b = 0; for (int t = 0; t < 128; ++t) { const int c = tc[t * 32 + tid]; s += c; if (t < tile) b += c; } tot[tid] = s; bef[tid] = b; }
    __syncthreads();
    if (tid == 0) { int p = 0; for (int e = 0; e < 32; ++e) { pst[e] = p; base[e] = p + bef[e]; const int nt = (tot[e] + 255) >> 8;
                        if (tile == 0) { for (int k = 0; k < nt; ++k) disp[16 + (p >> 8) + k] = e; disp[512 + e] = p; disp[576 + e] = tot[e]; }
                        p += nt << 8; }
                    if (tile == 0) disp[0] = p >> 8; }
    __syncthreads();
    for (int q = 0; q < 4; ++q) { const int e = wave * 4 + q; int running = 0;
        for (int c8 = 0; c8 < 8; ++c8) { const int ai = c8 * 64 + lane; const bool mt = earr[ai] == e; const unsigned long long mk = __ballot(mt);
            if (mt) parr[ai] = base[e] + running + __popcll(mk & ((1ull << lane) - 1ull));
            running += __popcll(mk); } }
    __syncthreads();
    { const int ai = tid, p = parr[ai], t = tile * 256 + (ai >> 1); pos[t * 2 + (ai & 1)] = p; roww[p] = tokw[t * 2 + (ai & 1)]; }
    for (int i = 0; i < 64; ++i) { const int ai = wave * 64 + i, p = parr[ai], t = tile * 256 + (ai >> 1);
        const v4u* src = (const v4u*)(h2x + (size_t)t * 2048); v4u* dst = (v4u*)(hs + (size_t)p * 1024);
        dst[lane] = src[lane]; dst[lane + 64] = src[lane + 64]; }
    if (tile < 32) { const int p0 = pst[tile] + tot[tile], p1 = pst[tile] + (((tot[tile] + 255) >> 8) << 8); const v4u z = (v4u){0u, 0u, 0u, 0u};
        for (int r = p0 + wave; r < p1; r += NWAVES) { v4u* dst = (v4u*)(hs + (size_t)r * 1024); dst[lane] = z; dst[lane + 64] = z; if (lane == 0) roww[r] = 0.f; } }
}

__device__ __forceinline__ void phase12(const Args& a, int tid, int lane, int wave, int vcu, int G) {
    unsigned char* ws = a.ws;
    const int gw = vcu * NWAVES + wave, NGW = G * NWAVES; const int gt = vcu * NTHR + tid, NGT = G * NTHR;
    float* x = a.out; const bf16* y2 = (const bf16*)(ws + WS_Y2); const int* pos = (const int*)(ws + WS_POS); const float* gain = a.in[33]; bf16* h3 = (bf16*)(ws + WS_H3);
    for (int m = gw; m < T; m += NGW) {
        const int pa = pos[m * 2], pb = pos[m * 2 + 1];
        f32x4* xr = (f32x4*)(x + (size_t)m * DM) + lane; const v2u* ya = (const v2u*)(y2 + (size_t)pa * 1024) + lane; const v2u* yb = (const v2u*)(y2 + (size_t)pb * 1024) + lane;
        f32x4 v[4]; float s = 0.f;
#pragma unroll
        for (int j = 0; j < 4; ++j) { v[j] = xr[64 * j]; const v2u wa = ya[64 * j], wb = yb[64 * j];
            v[j].x += bflo(wa.x) + bflo(wb.x); v[j].y += bfhi(wa.x) + bfhi(wb.x); v[j].z += bflo(wa.y) + bflo(wb.y); v[j].w += bfhi(wa.y) + bfhi(wb.y);
            xr[64 * j] = v[j]; s += (v[j].x * v[j].x + v[j].y * v[j].y) + (v[j].z * v[j].z + v[j].w * v[j].w); }
        const float rstd = 1.0f / sqrtf(wave_sum(s) * (1.f / 1024.f) + 1e-6f);
        v2u* o8 = (v2u*)(h3 + (size_t)m * DM) + lane;
#pragma unroll
        for (int j = 0; j < 4; ++j) { const f32x4 g = ((const f32x4*)gain)[lane + 64 * j]; v2u o; o.x = pk2(v[j].x * rstd * g.x, v[j].y * rstd * g.y); o.y = pk2(v[j].z * rstd * g.z, v[j].w * rstd * g.w); o8[64 * j] = o; }
    }
    const f32x4* p = (const f32x4*)a.in[1]; v2u* p16 = (v2u*)(ws + WS_P16);
    for (int i = gt; i < T * 256 / 4; i += NGT) { const f32x4 v = p[i]; v2u o; o.x = pk2(v.x, v.y); o.y = pk2(v.z, v.w); p16[i] = o; }
}

#ifndef MK_N_LAUNCHES
#define MK_N_LAUNCHES 1
#endif
constexpr int NPHASE = 14;
__global__ void __launch_bounds__(NTHR, 2) mk_fwd(Args args) {
    extern __shared__ __attribute__((aligned(16))) unsigned char lds_raw[];
    LAS unsigned char* lds = (LAS unsigned char*)lds_raw;
    const int tid = threadIdx.x, lane = tid & 63, wave = __builtin_amdgcn_readfirstlane(tid >> 6);
    const int G = gridDim.x; const int bx = blockIdx.x; const int vcu = (G % 8 == 0) ? (bx % 8) * (G / 8) + bx / 8 : bx;
    unsigned char* ws = args.ws;
    const int lo = args.ph_lo, hi = args.ph_hi;
#ifdef ONLY_PHASE
#define IN(k) ((k) == ONLY_PHASE && lo <= (k) && (k) < hi)
#else
#define IN(k) (lo <= (k) && (k) < hi)
#endif
#if MK_N_LAUNCHES == 1
#define SEAM(k) do { if (IN(k) && IN((k) + 1)) { __threadfence(); cg::this_grid().sync(); __threadfence(); } } while (0)
#else
#define SEAM(k) do { } while (0)
#endif
    typedef pg8::bf16_t pbf;
    int K256 = 256, K512 = 512, K1024 = 1024, K2048 = 2048;
    asm volatile("" : "+s"(K256), "+s"(K512), "+s"(K1024), "+s"(K2048));
    if (IN(0)) { phase0(args, lds, tid, lane, wave, vcu, G); }
    SEAM(0);
    if (IN(1)) {
        { pg8::Gemm g{(const pbf*)(ws + WS_XN), (const pbf*)(ws + WS_WIN), T, 19 * 256, K1024}; pg8::OrderSkipV S; S.init(T, 19 * 256, G, bx);
          pg8::EpiProj E{(pbf*)(ws + WS_RKV), (pbf*)(ws + WS_PROJB), (pbf*)(ws + WS_GATES)};
          pg8::gemm_phase<pg8::EpiProj, pg8::OrderSkipV, true, true>(lds, g, S, E); }
        { pg8::Gemm g{(const pbf*)(ws + WS_WIN) + (size_t)2816 * 1024, (const pbf*)(ws + WS_XN), 512, T, K1024}; pg8::StaticOrder S; S.init(512, T, G, bx);
          pg8::EpiStore E{(pbf*)(ws + WS_VT), T};
          pg8::gemm_phase<pg8::EpiStore, pg8::StaticOrder, true, true>(lds, g, S, E); }
    }
    SEAM(1);
    if (IN(2)) { phase2(args, lds, tid, vcu, G); }
    SEAM(2);
    if (IN(3)) {
        pg8::Gemm g{(const pbf*)(ws + WS_LA), (const pbf*)(ws + WS_WLORA), T, 1536, K256}; pg8::StaticOrder S; S.init(T, 1536, G, bx);
        pg8::EpiLora E{(pbf*)(ws + WS_E), (pbf*)(ws + WS_A), (pbf*)(ws + WS_G), args.in[5], args.in[7]};
        pg8::gemm_phase<pg8::EpiLora, pg8::StaticOrder, true, true>(lds, g, S, E);
    }
    SEAM(3);
    if (IN(4)) {
        unsigned* qhead = (unsigned*)(ws + WS_CTL) + CW_QUEUE; LAS unsigned* ubox = (LAS unsigned*)(lds + MISC_OFF);
        float* stash = (float*)((unsigned char*)args.out + OUT_STASH) + (size_t)bx * 64 * 512;
        for (;;) {
            __syncthreads();
            if (tid == 0) ubox[0] = atomicAdd(qhead, 1u);
            __syncthreads();
            const int u = (int)ubox[0];
            if (u >= 64 + 512) break;
            if (u < 64) scan_unit(args, lds, tid, u);
            else { const int au = u - 64; attn_unit(args, lds, tid, (au & 31) >> 2, au & 3, 15 - (au >> 5), stash); }
        }
    }
    SEAM(4);
    if (IN(5)) {
        pg8::Gemm g{(const pbf*)((unsigned char*)args.out + OUT_ORWDF), (const pbf*)(ws + WS_WBRD), 2 * T, 2048, K512}; pg8::OrderPair S; S.init(T, 1024, G, bx);
        pg8::EpiMix E{(const pbf*)(ws + WS_GATES), (float*)(ws + WS_PART), (pbf*)(ws + WS_MIXED)};
        pg8::gemm_phase<pg8::EpiMix, pg8::OrderPair, true, true>(lds, g, S, E);
    }
    SEAM(5);
    if (IN(6)) {
        pg8::Gemm g{(const pbf*)(ws + WS_MIXED), (const pbf*)(ws + WS_WO), T, 1024, K1024}; pg8::StaticOrder S; S.init(T, 1024, G, bx);
        pg8::EpiRes E{args.in[0], args.out};
        pg8::gemm_phase<pg8::EpiRes, pg8::StaticOrder, true, true>(lds, g, S, E);
    }
    SEAM(6);
    if (IN(7)) { phase7(args, lds, tid, lane, wave, vcu, G); }
    SEAM(7);
    if (IN(8)) {
        pg8::Gemm g{(const pbf*)(ws + WS_H2X), (const pbf*)(ws + WS_WR), T, 256, K2048}; pg8::StaticOrder S; S.init(T, 256, G, bx);
        pg8::EpiLogits E{(float*)(ws + WS_LOGITS)};
        pg8::gemm_phase<pg8::EpiLogits, pg8::StaticOrder, true, true>(lds, g, S, E);
        VM_WAIT(); __syncthreads();
        pg8::Unit u;
        for (int i = 0; S.next(i, u); ++i) route_tile(args, lds, tid, u.pm);
    }
    SEAM(8);
    if (IN(9)) { phase9(args, lds, tid, lane, wave); }
    SEAM(9);
    if (IN(10) || IN(11)) {
        const int* disp = (const int*)(ws + WS_DISP); LAS int* tile_e = (LAS int*)(lds + MISC_OFF + 64);
        __syncthreads();
        const int NT = disp[0];
        for (int i = tid; i < NT && i < 320; i += NTHR) tile_e[i] = disp[16 + i];
        __syncthreads();
        if (IN(10)) {
            pg8::Gemm g{(const pbf*)(ws + WS_HS), (const pbf*)(ws + WS_WGU), MAXROWS, NEXP * 1024, K1024}; pg8::OrderMoe S{NT * 4, G, bx, tile_e};
            pg8::EpiAct E{(pbf*)(ws + WS_ACT)};
            pg8::gemm_phase<pg8::EpiAct, pg8::OrderMoe, true, true>(lds, g, S, E);
        }
        SEAM(10);
        if (IN(11)) {
            pg8::Gemm g{(const pbf*)(ws + WS_ACT), (const pbf*)(ws + WS_WD), MAXROWS, NEXP * 1024, K512}; pg8::OrderMoe S{NT * 4, G, bx, tile_e};
            pg8::EpiDown E{(pbf*)(ws + WS_Y2), (const float*)(ws + WS_ROWW)};
            pg8::gemm_phase<pg8::EpiDown, pg8::OrderMoe, true, true>(lds, g, S, E);
        }
    }
    SEAM(11);
    if (IN(12)) { phase12(args, tid, lane, wave, vcu, G); }
    SEAM(12);
    if (IN(13)) {
        { pg8::Gemm g{(const pbf*)(ws + WS_P16), (const pbf*)(ws + WS_WPP), T, 1024, K256}; pg8::StaticOrder S; S.init(T, 1024, G, bx);
          pg8::EpiStore E{(pbf*)(ws + WS_PP), 1024};
          pg8::gemm_phase<pg8::EpiStore, pg8::StaticOrder, true, true>(lds, g, S, E); }
        { pg8::Gemm g{(const pbf*)(ws + WS_H3), (const pbf*)(ws + WS_WPG), T, 1024, K1024}; pg8::StaticOrder S; S.init(T, 1024, G, bx);
          pg8::EpiFinal E{(const pbf*)(ws + WS_PP), args.out};
          pg8::gemm_phase<pg8::EpiFinal, pg8::StaticOrder, true, true>(lds, g, S, E); }
    }
#undef IN
#undef SEAM
}

extern "C" void kernel_launch(void* const* d_in, const int* in_sizes, int n_in, void* d_out, int out_size, void* d_ws, size_t ws_size, hipStream_t stream) {
    static int grid = 0;
    if (grid == 0) {
        if (n_in != 36 || in_sizes[0] != T * DM || out_size != T * DM || ws_size < WS_END) {
            fprintf(stderr, "kernel_launch: unexpected problem: n_in %d in0 %d out %d ws %zu (need %zu)\n", n_in, n_in > 0 ? in_sizes[0] : -1, out_size, ws_size, (size_t)WS_END); grid = -1; return; }
        int dev = 0, cus = 0, per_cu = 0;
        if (hipGetDevice(&dev) != hipSuccess || hipDeviceGetAttribute(&cus, hipDeviceAttributeMultiprocessorCount, dev) != hipSuccess) { grid = -1; return; }
        if (hipFuncSetAttribute((const void*)mk_fwd, hipFuncAttributeMaxDynamicSharedMemorySize, LDS_BYTES) != hipSuccess) { fprintf(stderr, "kernel_launch: hipFuncSetAttribute failed\n"); grid = -1; return; }
        if (hipOccupancyMaxActiveBlocksPerMultiprocessor(&per_cu, (const void*)mk_fwd, NTHR, LDS_BYTES) != hipSuccess || per_cu < 1) { fprintf(stderr, "kernel_launch: occupancy query says %d blocks per CU\n", per_cu); (void)hipGetLastError(); grid = -1; return; }
        grid = cus;
        if (grid > 256) grid = 256;
    }
    if (grid < 0) return;
    (void)hipMemsetAsync((char*)d_ws + WS_CTL, 0, CTL_ZERO_BYTES, stream);
    Args a{};
    for (int i = 0; i < 36; ++i) a.in[i] = (const float*)d_in[i];
    a.out = (float*)d_out; a.ws = (unsigned char*)d_ws;
#if MK_N_LAUNCHES == 1
    a.ph_lo = 0; a.ph_hi = NPHASE;
    void* kargs[] = {&a};
    const hipError_t e = hipLaunchCooperativeKernel((const void*)mk_fwd, dim3(grid), dim3(NTHR), kargs, LDS_BYTES, stream);
    if (e != hipSuccess) fprintf(stderr, "kernel_launch: cooperative launch failed: %s (grid %d)\n", hipGetErrorString(e), grid);
#else
    for (int ph = 0; ph < NPHASE; ++ph) { a.ph_lo = ph; a.ph_hi = ph + 1; hipLaunchKernelGGL(mk_fwd, dim3(grid), dim3(NTHR), LDS_BYTES, stream, a); }
#endif
}
```

```cpp
#include <hip/hip_runtime.h>
#include <hip/hip_cooperative_groups.h>
#include <cstdio>
#include <cstdint>
namespace cg = cooperative_groups;
namespace pg8 {
#define PG8_LAS __attribute__((address_space(3)))
typedef unsigned short bf16_t;
typedef short bf16x8 __attribute__((ext_vector_type(8)));
typedef float f32x4 __attribute__((ext_vector_type(4)));
typedef unsigned u32x4 __attribute__((ext_vector_type(4)));
constexpr int BM = 256, BK = 64, HALF = 128, HTB = HALF * BK * 2  , STAGE_BYTES = 8 * HTB, NXCD = 8, WGM = 8;

__host__ __device__ __forceinline__ int lds_byte(int r, int c) { const int st = (r >> 4) * 2 + (c >> 5), rr = r & 15, cc = c & 31, ob = rr * 64 + cc * 2; return st * 1024 + (ob ^ (((ob >> 9) & 1) << 5)); }
__host__ __device__ __forceinline__ void stage_rc(int b, int& R, int& C) { const int st = b / 1024, sb = b % 1024, swz = sb ^ (((sb >> 9) & 1) << 5); R = (st >> 1) * 16 + swz / 64; C = (st & 1) * 32 + (swz % 64) / 2; }
__host__ __device__ __forceinline__ int perm32(int rho) { const int n = rho >> 4, i = rho & 15; return 8 * (i >> 2) + 4 * n + (i & 3); }

struct Unit { int pm, pn; };
struct Gemm { const bf16_t* A; const bf16_t* Bt; int M, N, K; };

struct StaticOrder {
    int nM, nN, nwg, G, c;
    __host__ __device__ void init(int M, int N, int G_, int c_) { nM = M / BM; nN = N / BM; nwg = nM * nN; G = G_; c = c_; }
    __host__ __device__ bool next(int i, Unit& u) const {
        const long L = (long)i * G + c; if (L >= nwg) return false;
        int wgid = (int)L; { const int q = nwg / NXCD, r = nwg % NXCD, xcd = wgid % NXCD, off = wgid / NXCD; wgid = (xcd < r ? xcd * (q + 1) : r * (q + 1) + (xcd - r) * q) + off; }
        const int nig = WGM * nN, gid = wgid / nig, fm = gid * WGM, gsz = (nM - fm) < WGM ? (nM - fm) : WGM;
        u.pm = fm + ((wgid % nig) % gsz); u.pn = (wgid % nig) / gsz; return true;
    }
    __device__ __forceinline__ void a_ready(const Unit&) const {}
    __device__ __forceinline__ void done(const Unit&) const {}
};

__device__ __forceinline__ unsigned cvt_pk_bf16(float lo, float hi) { unsigned r; asm volatile("v_cvt_pk_bf16_f32 %0, %1, %2" : "=v"(r) : "v"(lo), "v"(hi)); return r; }
template <class Epi, class Sched, bool ALIGN_EPI = false, bool SP2 = false>
__device__ __forceinline__ void gemm_phase(PG8_LAS unsigned char* lds, const Gemm g, const Sched& S, const Epi& E) {
    const int tid = threadIdx.x, wid = __builtin_amdgcn_readfirstlane(tid >> 6), lane = tid & 63, wr = wid >> 2, wc = wid & 3, fr = lane & 15, fq = lane >> 4;
    const int K = g.K, nt = K / BK;
    unsigned voffA[2], voffB[2];
#pragma unroll
    for (int i = 0; i < 2; ++i) { int R, C; stage_rc(tid * 16 + i * 8192, R, C); const int Rb = Epi::PERM ? ((R & ~31) + perm32(R & 31)) : R;
        voffA[i] = (unsigned)(R * K + C) * 2u; voffB[i] = (unsigned)(Rb * K + C) * 2u; }
    const size_t kstep = (size_t)(BK * 2);
    const size_t hstep = (size_t)HALF * K * 2;
    const size_t tstep = 2 * hstep;
    const unsigned ldsw = (unsigned)wid * 1024u;
    const int aoff = lds_byte(wr * 64 + fr, fq * 8), boff = lds_byte(wc * 32 + fr, fq * 8);
#define PG8_SA(b, h) (((b) * 2 + (h)) * HTB)
#define PG8_SB(b, h) ((4 + (b) * 2 + (h)) * HTB)
#define PG8_STAGE(bufoff, gbase, voff) do { _Pragma("unroll") for (int _i = 0; _i < 2; ++_i) \
        __builtin_amdgcn_global_load_lds((const unsigned*)((const char*)(gbase) + (voff)[_i]), (PG8_LAS unsigned*)(lds + (bufoff) + ldsw + _i * 8192), 16, 0, 0); } while (0)
#define PG8_LDA(dst, b, h) do { _Pragma("unroll") for (int m = 0; m < 4; ++m) _Pragma("unroll") for (int k = 0; k < 2; ++k) dst[m][k] = *(const PG8_LAS bf16x8*)(lds + PG8_SA(b, h) + aoff + m * 2048 + k * 1024); } while (0)
#define PG8_LDB(dst, b, h) do { _Pragma("unroll") for (int n = 0; n < 2; ++n) _Pragma("unroll") for (int k = 0; k < 2; ++k) dst[n][k] = *(const PG8_LAS bf16x8*)(lds + PG8_SB(b, h) + boff + n * 2048 + k * 1024); } while (0)
#define PG8_MMA(ai, bj, At, Bt) do { __builtin_amdgcn_s_setprio(1); _Pragma("unroll") for (int m = 0; m < 4; ++m) _Pragma("unroll") for (int n = 0; n < 2; ++n) _Pragma("unroll") for (int k = 0; k < 2; ++k) \
        acc[ai][bj][m][n] = __builtin_amdgcn_mfma_f32_16x16x32_bf16(Bt[n][k], At[m][k], acc[ai][bj][m][n], 0, 0, 0); __builtin_amdgcn_s_setprio(0); } while (0)
#define PG8_WAIT_V(n) asm volatile("s_waitcnt vmcnt(" #n ")" ::: "memory")
#define PG8_WAIT_L(n) asm volatile("s_waitcnt lgkmcnt(" #n ")" ::: "memory")
#define PG8_BAR __builtin_amdgcn_s_barrier()
#define PG8_SCHED __builtin_amdgcn_sched_barrier(0)
    Unit cur, nxt; int ui = 0;
    if (!S.next(0, cur)) return;
    f32x4 acc[2][2][4][2];
#pragma unroll
    for (int a = 0; a < 2; ++a)
#pragma unroll
        for (int b = 0; b < 2; ++b)
#pragma unroll
            for (int m = 0; m < 4; ++m)
#pragma unroll
                for (int n = 0; n < 2; ++n) acc[a][b][m][n] = (f32x4){0.f, 0.f, 0.f, 0.f};
    bf16x8 At[4][2], B0[2][2], B1[2][2];
    const char* cA = (const char*)g.A + (size_t)cur.pm * tstep; const char* cB = (const char*)g.Bt + (size_t)cur.pn * tstep;
    S.a_ready(cur);
    if constexpr (SP2) {
        PG8_STAGE(PG8_SB(0, 0), cB, voffB); PG8_STAGE(PG8_SB(0, 1), cB + hstep, voffB); PG8_STAGE(PG8_SA(0, 0), cA, voffA); PG8_STAGE(PG8_SA(0, 1), cA + hstep, voffA);
        if (wr == 1) PG8_BAR;
        PG8_WAIT_V(2); PG8_BAR;
        PG8_STAGE(PG8_SB(1, 0), cB + kstep, voffB); PG8_STAGE(PG8_SA(1, 0), cA + kstep, voffA); PG8_STAGE(PG8_SB(1, 1), cB + hstep + kstep, voffB);
        PG8_WAIT_V(6); PG8_BAR;
    } else {
        PG8_STAGE(PG8_SB(0, 0), cB, voffB); PG8_STAGE(PG8_SA(0, 0), cA, voffA); PG8_STAGE(PG8_SB(0, 1), cB + hstep, voffB); PG8_STAGE(PG8_SA(0, 1), cA + hstep, voffA);
        if (wr == 1) PG8_BAR;
        PG8_WAIT_V(4); PG8_BAR;
        PG8_STAGE(PG8_SB(1, 0), cB + kstep, voffB); PG8_STAGE(PG8_SA(1, 0), cA + kstep, voffA); PG8_STAGE(PG8_SB(1, 1), cB + hstep + kstep, voffB);
        PG8_WAIT_V(6); PG8_BAR;
    }
    for (;;) {
        const bool has_next = S.next(ui + 1, nxt);
        const char* nA = has_next ? (const char*)g.A + (size_t)nxt.pm * tstep : cA; const char* nB = has_next ? (const char*)g.Bt + (size_t)nxt.pn * tstep : cB;
        for (int t = 0; t < nt; t += 2) {
            const bool last = (t == nt - 2);
            const char* a1 = cA + (size_t)(t + 1) * kstep;
            const char* a2 = last ? nA : cA + (size_t)(t + 2) * kstep; const char* b2 = last ? nB : cB + (size_t)(t + 2) * kstep;
            const char* a3 = a2 + kstep; const char* b3 = b2 + kstep;
            if (last && has_next) S.a_ready(nxt);
            if constexpr (SP2) {
            PG8_LDB(B0, 0, 0); PG8_LDB(B1, 0, 1); PG8_SCHED; PG8_LDA(At, 0, 0); PG8_STAGE(PG8_SA(1, 1), a1 + hstep, voffA);
            PG8_WAIT_V(8); PG8_WAIT_L(0); PG8_BAR; PG8_MMA(0, 0, At, B0); PG8_MMA(0, 1, At, B1); PG8_BAR; PG8_SCHED;
            PG8_LDA(At, 0, 1); PG8_STAGE(PG8_SB(0, 0), b2, voffB); PG8_STAGE(PG8_SB(0, 1), b2 + hstep, voffB); PG8_STAGE(PG8_SA(0, 0), a2, voffA);
            PG8_WAIT_V(8); PG8_WAIT_L(0); PG8_BAR; PG8_MMA(1, 0, At, B0); PG8_MMA(1, 1, At, B1); PG8_BAR; PG8_SCHED;
            PG8_LDB(B0, 1, 0); PG8_LDB(B1, 1, 1); PG8_SCHED; PG8_LDA(At, 1, 0); PG8_STAGE(PG8_SA(0, 1), a2 + hstep, voffA);
            PG8_WAIT_V(8); PG8_WAIT_L(0); PG8_BAR; PG8_MMA(0, 0, At, B0); PG8_MMA(0, 1, At, B1); PG8_BAR; PG8_SCHED;
            PG8_LDA(At, 1, 1); PG8_STAGE(PG8_SB(1, 0), b3, voffB); PG8_STAGE(PG8_SB(1, 1), b3 + hstep, voffB); PG8_STAGE(PG8_SA(1, 0), a3, voffA);
            PG8_WAIT_V(8); PG8_WAIT_L(0); PG8_BAR; PG8_MMA(1, 0, At, B0); PG8_MMA(1, 1, At, B1); PG8_BAR; PG8_SCHED;
            } else {
            PG8_LDB(B0, 0, 0); PG8_SCHED; PG8_LDA(At, 0, 0); PG8_STAGE(PG8_SA(1, 1), a1 + hstep, voffA);
            PG8_WAIT_L(8); PG8_BAR; PG8_WAIT_L(0); PG8_MMA(0, 0, At, B0); PG8_BAR; PG8_SCHED;
            PG8_LDB(B1, 0, 1); PG8_STAGE(PG8_SB(0, 0), b2, voffB);
            PG8_BAR; PG8_WAIT_L(0); PG8_MMA(0, 1, At, B1); PG8_BAR;
            PG8_LDA(At, 0, 1); PG8_STAGE(PG8_SA(0, 0), a2, voffA);
            PG8_BAR; PG8_WAIT_L(0); PG8_MMA(1, 0, At, B0); PG8_BAR; PG8_SCHED;
            PG8_STAGE(PG8_SB(0, 1), b2 + hstep, voffB);
            PG8_WAIT_V(6); PG8_BAR; PG8_MMA(1, 1, At, B1); PG8_BAR;
            PG8_LDB(B0, 1, 0); PG8_SCHED; PG8_LDA(At, 1, 0); PG8_STAGE(PG8_SA(0, 1), a2 + hstep, voffA);
            PG8_WAIT_L(8); PG8_BAR; PG8_WAIT_L(0); PG8_MMA(0, 0, At, B0); PG8_BAR; PG8_SCHED;
            PG8_LDB(B1, 1, 1); PG8_STAGE(PG8_SB(1, 0), b3, voffB);
            PG8_BAR; PG8_WAIT_L(0); PG8_MMA(0, 1, At, B1); PG8_BAR;
            PG8_LDA(At, 1, 1); PG8_STAGE(PG8_SA(1, 0), a3, voffA);
            PG8_BAR; PG8_WAIT_L(0); PG8_MMA(1, 0, At, B0); PG8_BAR; PG8_SCHED;
            PG8_STAGE(PG8_SB(1, 1), b3 + hstep, voffB);
            PG8_WAIT_V(6); PG8_BAR; PG8_MMA(1, 1, At, B1); PG8_BAR;
            }
        }
        if constexpr (ALIGN_EPI) { if (wr == 0) PG8_BAR; }
        if constexpr (!Epi::AFTER_DRAIN) { E(acc, cur, wr, wc, fr, fq); S.done(cur); }
        if (!has_next) break;
#pragma unroll
        for (int a = 0; a < 2; ++a)
#pragma unroll
            for (int b = 0; b < 2; ++b)
#pragma unroll
                for (int m = 0; m < 4; ++m)
#pragma unroll
                    for (int n = 0; n < 2; ++n) acc[a][b][m][n] = (f32x4){0.f, 0.f, 0.f, 0.f};
        cur = nxt; cA = nA; cB = nB; ++ui;
        if constexpr (ALIGN_EPI) { if (wr == 1) PG8_BAR; }
    }
    PG8_WAIT_V(0);
    if constexpr (!ALIGN_EPI) { if (wr == 0) PG8_BAR; }
    PG8_BAR;
    if constexpr (Epi::AFTER_DRAIN) { E.fused(acc, cur, wr, wc, fr, fq, lds, wid, lane); S.done(cur); }
#undef PG8_SA
#undef PG8_SB
#undef PG8_STAGE
#undef PG8_LDA
#undef PG8_LDB
#undef PG8_MMA
#undef PG8_WAIT_V
#undef PG8_WAIT_L
#undef PG8_BAR
#undef PG8_SCHED
}
}

constexpr int NB = 8, SEQ = 4096, DM = 1024, T = NB * SEQ;
constexpr int RW = 512, NHR = 8;
constexpr int NPROJ = 5376;
constexpr int FF = 512, NEXP = 32;
constexpr float C2 = 0.125f * 1.4426950408889634f;
constexpr float LAM_INIT = 0.2f;
constexpr int MAXROWS = 2 * T + NEXP * 256;

constexpr size_t MiB = 1u << 20;
constexpr size_t WS_CTL = 0, CTL_ZERO_BYTES = 1 * MiB;
constexpr size_t WS_WLORA = 1 * MiB;
constexpr size_t WS_WBRD = 2 * MiB;
constexpr size_t WS_WO = 4 * MiB;
constexpr size_t WS_WR = 6 * MiB;
constexpr size_t WS_WPG = 7 * MiB;
constexpr size_t WS_WPP = 9 * MiB;
constexpr size_t WS_TOKE = 10 * MiB;
constexpr size_t WS_TOKW = 10 * MiB + 256 * 1024;
constexpr size_t WS_POS = 10 * MiB + 512 * 1024;
constexpr size_t WS_ROWW = 10 * MiB + 768 * 1024;
constexpr size_t WS_TILECNT = 11 * MiB + 256 * 1024;
constexpr size_t WS_DISP = 11 * MiB + 512 * 1024;
constexpr size_t WS_BON = 12 * MiB;
constexpr size_t WS_WIN = 16 * MiB;
constexpr size_t WS_LA = 16 * MiB;
constexpr size_t WS_LOGITS = 16 * MiB;
constexpr size_t WS_XN = 32 * MiB;
constexpr size_t WS_QN = 32 * MiB;
constexpr size_t WS_KN = 64 * MiB;
constexpr size_t WS_WGU = 32 * MiB;
constexpr size_t WS_RKV = 96 * MiB;
constexpr size_t WS_MIXED = 96 * MiB;
constexpr size_t WS_WD = 96 * MiB;
constexpr size_t WS_HS = 128 * MiB;
constexpr size_t WS_H3 = 128 * MiB;
constexpr size_t WS_PROJB = 192 * MiB;
constexpr size_t WS_E = 192 * MiB;
constexpr size_t WS_A = 224 * MiB;
constexpr size_t WS_G = 256 * MiB;
constexpr size_t WS_P16 = 192 * MiB;
constexpr size_t WS_PP = 208 * MiB;
constexpr size_t WS_Y2 = 272 * MiB;
constexpr size_t WS_GATES = 304 * MiB;
constexpr size_t WS_H2X = 304 * MiB;
constexpr size_t WS_VT = 432 * MiB;
constexpr size_t WS_ACT = 432 * MiB;
constexpr size_t WS_PART = 176 * MiB;
constexpr size_t WS_END = 512 * MiB;
constexpr size_t OUT_STASH = 0, OUT_ORWDF = 32 * MiB;
static_assert(WS_ACT + (size_t)MAXROWS * 512 * 2 <= WS_END && WS_Y2 + (size_t)MAXROWS * 1024 * 2 <= WS_ACT && WS_HS + (size_t)MAXROWS * 1024 * 2 <= WS_Y2, "ws map");
static_assert(WS_PART + (size_t)T * 1024 * 4 <= WS_GATES && WS_MIXED + (size_t)T * 1024 * 2 <= WS_PART, "ws map");
constexpr int CW_QUEUE = 64;
constexpr int CW_BAR = 4096;

constexpr int RING_BYTES = 131072;
constexpr int MISC_OFF = RING_BYTES;
constexpr int LDS_BYTES = 147456;
constexpr int NWAVES = 8, NTHR = 512;

#define GAS __attribute__((address_space(1)))
#define LAS __attribute__((address_space(3)))
typedef unsigned short bf16;
typedef unsigned v4u __attribute__((ext_vector_type(4)));
typedef unsigned v2u __attribute__((ext_vector_type(2)));
typedef float f32x4 __attribute__((ext_vector_type(4)));
typedef float f32x16 __attribute__((ext_vector_type(16)));
typedef short s16x8 __attribute__((ext_vector_type(8)));
typedef short s16x4 __attribute__((ext_vector_type(4)));
#define LDS_WAIT() asm volatile("s_waitcnt lgkmcnt(0)" ::: "memory")
#define VM_WAIT() asm volatile("s_waitcnt vmcnt(0)" ::: "memory")

__device__ __forceinline__ unsigned f2bf(float f) { unsigned u = __builtin_bit_cast(unsigned, f); return (u + 0x7fffu + ((u >> 16) & 1u)) >> 16; }
__device__ __forceinline__ unsigned pk2(float lo, float hi) { return f2bf(lo) | (f2bf(hi) << 16); }
__device__ __forceinline__ float bflo(unsigned w) { return __builtin_bit_cast(float, w << 16); }
__device__ __forceinline__ float bfhi(unsigned w) { return __builtin_bit_cast(float, w & 0xffff0000u); }
__device__ __forceinline__ float sigm(float x) { return __builtin_amdgcn_rcpf(1.0f + __builtin_amdgcn_exp2f(-1.4426950408889634f * x)); }
__device__ __forceinline__ float wave_sum(float v) {
#pragma unroll
    for (int o = 1; o < 64; o <<= 1) v += __shfl_xor(v, o);
    return v;
}
__device__ __forceinline__ float xhalf_max(float m) { auto rr = __builtin_amdgcn_permlane32_swap(__builtin_bit_cast(unsigned, m), __builtin_bit_cast(unsigned, m), false, false);
    return fmaxf(__builtin_bit_cast(float, rr[0]), __builtin_bit_cast(float, rr[1])); }
__device__ __forceinline__ float xhalf_sum(float m) { auto rr = __builtin_amdgcn_permlane32_swap(__builtin_bit_cast(unsigned, m), __builtin_bit_cast(unsigned, m), false, false);
    return __builtin_bit_cast(float, rr[0]) + __builtin_bit_cast(float, rr[1]); }

namespace pg8 {
struct EpiStore {
    static constexpr bool PERM = true, AFTER_DRAIN = false;
    bf16_t* O; int ldc;
    __device__ __forceinline__ void operator()(const f32x4 (&acc)[2][2][4][2], const Unit& u, int wr, int wc, int fr, int fq) const {
        const int row0 = u.pm * BM + wr * 64 + fr, col0 = u.pn * BM + wc * 32 + 8 * fq;
#pragma unroll
        for (int ai = 0; ai < 2; ++ai)
#pragma unroll
            for (int m = 0; m < 4; ++m) { bf16_t* rowp = O + (size_t)(row0 + ai * HALF + m * 16) * ldc + col0;
#pragma unroll
                for (int bj = 0; bj < 2; ++bj) { const f32x4 v0 = acc[ai][bj][m][0], v1 = acc[ai][bj][m][1]; u32x4 w;
                    w.x = cvt_pk_bf16(v0[0], v0[1]); w.y = cvt_pk_bf16(v0[2], v0[3]); w.z = cvt_pk_bf16(v1[0], v1[1]); w.w = cvt_pk_bf16(v1[2], v1[3]);
                    *(u32x4*)(rowp + bj * HALF) = w; } }
    }
};
struct EpiProj {
    static constexpr bool PERM = true, AFTER_DRAIN = false;
    bf16_t *rkv, *projb, *gates;
    __device__ __forceinline__ void operator()(const f32x4 (&acc)[2][2][4][2], const Unit& u, int wr, int wc, int fr, int fq) const {
        bf16_t* base; int ldc, ct;
        if (u.pn < 6) { base = rkv; ldc = 1536; ct = u.pn; } else if (u.pn < 11) { base = projb; ldc = 1280; ct = u.pn - 6; } else { base = gates; ldc = 2048; ct = u.pn - 13; }
        const int row0 = u.pm * BM + wr * 64 + fr, col0 = ct * BM + wc * 32 + 8 * fq;
#pragma unroll
        for (int ai = 0; ai < 2; ++ai)
#pragma unroll
            for (int m = 0; m < 4; ++m) { bf16_t* rowp = base + (size_t)(row0 + ai * HALF + m * 16) * ldc + col0;
#pragma unroll
                for (int bj = 0; bj < 2; ++bj) { const f32x4 v0 = acc[ai][bj][m][0], v1 = acc[ai][bj][m][1]; u32x4 w;
                    w.x = cvt_pk_bf16(v0[0], v0[1]); w.y = cvt_pk_bf16(v0[2], v0[3]); w.z = cvt_pk_bf16(v1[0], v1[1]); w.w = cvt_pk_bf16(v1[2], v1[3]);
                    *(u32x4*)(rowp + bj * HALF) = w; } }
    }
};
struct EpiLora {
    static constexpr bool PERM = true, AFTER_DRAIN = false;
    bf16_t *E, *A, *G; const float *w0, *a0;
    template <int KIND> __device__ __forceinline__ void body(const f32x4 (&acc)[2][2][4][2], bf16_t* base, const float* bias, int row0, int col0) const {
#pragma unroll
        for (int bj = 0; bj < 2; ++bj)
#pragma unroll
            for (int ai = 0; ai < 2; ++ai)
#pragma unroll
                for (int m = 0; m < 4; ++m) { bf16_t* rowp = base + (size_t)(row0 + ai * HALF + m * 16) * 512 + col0 + bj * HALF;
                    f32x4 v0 = acc[ai][bj][m][0], v1 = acc[ai][bj][m][1];
                    if (KIND < 2) { const f32x4 b0 = *(const f32x4*)(bias + col0 + bj * HALF), b1 = *(const f32x4*)(bias + col0 + bj * HALF + 4); const float sc = KIND == 0 ? 0.60653065971263342f : 1.0f;
                        v0 += b0; v1 += b1;
#pragma unroll
                        for (int e = 0; e < 4; ++e) { v0[e] = sc * sigm(v0[e]); v1[e] = sc * sigm(v1[e]); } }
                    u32x4 w; w.x = cvt_pk_bf16(v0[0], v0[1]); w.y = cvt_pk_bf16(v0[2], v0[3]); w.z = cvt_pk_bf16(v1[0], v1[1]); w.w = cvt_pk_bf16(v1[2], v1[3]);
                    *(u32x4*)rowp = w; asm volatile("" ::: "memory"); }
    }
    __device__ __forceinline__ void operator()(const f32x4 (&acc)[2][2][4][2], const Unit& u, int wr, int wc, int fr, int fq) const {
        const int kind = u.pn >> 1; const int row0 = u.pm * BM + wr * 64 + fr, col0 = (u.pn & 1) * BM + wc * 32 + 8 * fq;
        if (kind == 0) body<0>(acc, E, w0, row0, col0); else if (kind == 1) body<1>(acc, A, a0, row0, col0); else body<2>(acc, G, w0, row0, col0);
    }
};
struct EpiMix {
    static constexpr bool PERM = true, AFTER_DRAIN = false;
    const bf16_t* gates; float* part; bf16_t* mixed;
    __device__ __forceinline__ void operator()(const f32x4 (&acc)[2][2][4][2], const Unit& u, int wr, int wc, int fr, int fq) const {
        const bool second = u.pm >= 128; const int pm = second ? u.pm - 128 : u.pm, pn = second ? u.pn - 4 : u.pn;
        const int row0 = pm * BM + wr * 64 + fr, col0 = pn * BM + wc * 32 + 8 * fq;
#pragma unroll
        for (int ai = 0; ai < 2; ++ai)
#pragma unroll
            for (int m = 0; m < 4; ++m) { const size_t r = (size_t)(row0 + ai * HALF + m * 16);
#pragma unroll
                for (int bj = 0; bj < 2; ++bj) { const int c = col0 + bj * HALF;
                    const u32x4 gw = *(const u32x4*)(gates + r * 2048 + (second ? 1024 : 0) + c);
                    f32x4 v0 = acc[ai][bj][m][0], v1 = acc[ai][bj][m][1];
                    v0[0] *= sigm(bflo(gw.x)); v0[1] *= sigm(bfhi(gw.x)); v0[2] *= sigm(bflo(gw.y)); v0[3] *= sigm(bfhi(gw.y));
                    v1[0] *= sigm(bflo(gw.z)); v1[1] *= sigm(bfhi(gw.z)); v1[2] *= sigm(bflo(gw.w)); v1[3] *= sigm(bfhi(gw.w));
                    float* pp = part + r * 1024 + c;
                    if (!second) { *(f32x4*)pp = v0; *(f32x4*)(pp + 4) = v1; }
                    else { v0 += *(const f32x4*)pp; v1 += *(const f32x4*)(pp + 4); u32x4 w;
                        w.x = cvt_pk_bf16(v0[0], v0[1]); w.y = cvt_pk_bf16(v0[2], v0[3]); w.z = cvt_pk_bf16(v1[0], v1[1]); w.w = cvt_pk_bf16(v1[2], v1[3]);
                        *(u32x4*)(mixed + r * 1024 + c) = w; } } }
    }
};
struct EpiRes {
    static constexpr bool PERM = false, AFTER_DRAIN = false;
    const float* x; float* out;
    __device__ __forceinline__ void operator()(const f32x4 (&acc)[2][2][4][2], const Unit& u, int wr, int wc, int fr, int fq) const {
        const int row0 = u.pm * BM + wr * 64 + fr, col0 = u.pn * BM + wc * 32 + 4 * fq;
#pragma unroll
        for (int ai = 0; ai < 2; ++ai)
#pragma unroll
            for (int m = 0; m < 4; ++m) { const size_t off = (size_t)(row0 + ai * HALF + m * 16) * 1024 + col0;
#pragma unroll
                for (int bj = 0; bj < 2; ++bj)
#pragma unroll
                    for (int n = 0; n < 2; ++n) *(f32x4*)(out + off + bj * HALF + n * 16) = *(const f32x4*)(x + off + bj * HALF + n * 16) + acc[ai][bj][m][n]; }
    }
};
struct EpiLogits {
    static constexpr bool PERM = false, AFTER_DRAIN = false;
    float* L;
    __device__ __forceinline__ void operator()(const f32x4 (&acc)[2][2][4][2], const Unit& u, int wr, int wc, int fr, int fq) const {
        const int row0 = u.pm * BM + wr * 64 + fr, col0 = wc * 32 + 4 * fq;
#pragma unroll
        for (int ai = 0; ai < 2; ++ai)
#pragma unroll
            for (int m = 0; m < 4; ++m) { float* rowp = L + (size_t)(row0 + ai * HALF + m * 16) * 128 + col0;
#pragma unroll
                for (int n = 0; n < 2; ++n) *(f32x4*)(rowp + n * 16) = acc[ai][0][m][n]; }
    }
};
struct EpiAct {
    static constexpr bool PERM = true, AFTER_DRAIN = false;
    bf16_t* act;
    __device__ __forceinline__ void operator()(const f32x4 (&acc)[2][2][4][2], const Unit& u, int wr, int wc, int fr, int fq) const {
        const int row0 = u.pm * BM + wr * 64 + fr, col0 = (u.pn & 3) * HALF + wc * 32 + 8 * fq;
#pragma unroll
        for (int ai = 0; ai < 2; ++ai)
#pragma unroll
            for (int m = 0; m < 4; ++m) { bf16_t* rowp = act + (size_t)(row0 + ai * HALF + m * 16) * 512 + col0; float o[8];
#pragma unroll
                for (int n = 0; n < 2; ++n)
#pragma unroll
                    for (int e = 0; e < 4; ++e) { const float g = acc[ai][0][m][n][e], up = acc[ai][1][m][n][e]; o[n * 4 + e] = g * sigm(g) * up; }
                u32x4 w; w.x = cvt_pk_bf16(o[0], o[1]); w.y = cvt_pk_bf16(o[2], o[3]); w.z = cvt_pk_bf16(o[4], o[5]); w.w = cvt_pk_bf16(o[6], o[7]);
                *(u32x4*)rowp = w; }
    }
};
struct EpiDown {
    static constexpr bool PERM = true, AFTER_DRAIN = false;
    bf16_t* y2; const float* roww;
    __device__ __forceinline__ void operator()(const f32x4 (&acc)[2][2][4][2], const Unit& u, int wr, int wc, int fr, int fq) const {
        const int row0 = u.pm * BM + wr * 64 + fr, col0 = (u.pn & 3) * BM + wc * 32 + 8 * fq;
#pragma unroll
        for (int ai = 0; ai < 2; ++ai)
#pragma unroll
            for (int m = 0; m < 4; ++m) { const int r = row0 + ai * HALF + m * 16; const float w8 = roww[r]; bf16_t* rowp = y2 + (size_t)r * 1024 + col0;
#pragma unroll
                for (int bj = 0; bj < 2; ++bj) { const f32x4 v0 = acc[ai][bj][m][0] * w8, v1 = acc[ai][bj][m][1] * w8; u32x4 w;
                    w.x = cvt_pk_bf16(v0[0], v0[1]); w.y = cvt_pk_bf16(v0[2], v0[3]); w.z = cvt_pk_bf16(v1[0], v1[1]); w.w = cvt_pk_bf16(v1[2], v1[3]);
                    *(u32x4*)(rowp + bj * HALF) = w; } }
    }
};
struct EpiFinal {
    static constexpr bool PERM = true, AFTER_DRAIN = false;
    const bf16_t* pp; float* out;
    __device__ __forceinline__ void operator()(const f32x4 (&acc)[2][2][4][2], const Unit& u, int wr, int wc, int fr, int fq) const {
        const int row0 = u.pm * BM + wr * 64 + fr, col0 = u.pn * BM + wc * 32 + 8 * fq;
#pragma unroll
        for (int ai = 0; ai < 2; ++ai)
#pragma unroll
            for (int m = 0; m < 4; ++m) { const size_t r = (size_t)(row0 + ai * HALF + m * 16);
#pragma unroll
                for (int bj = 0; bj < 2; ++bj) { const int c = col0 + bj * HALF;
                    const u32x4 pw = *(const u32x4*)(pp + r * 1024 + c); float* op = out + r * 1024 + c;
                    f32x4 x0 = *(const f32x4*)op, x1 = *(const f32x4*)(op + 4); const f32x4 a0 = acc[ai][bj][m][0], a1 = acc[ai][bj][m][1];
                    x0[0] += sigm(a0[0]) * bflo(pw.x); x0[1] += sigm(a0[1]) * bfhi(pw.x); x0[2] += sigm(a0[2]) * bflo(pw.y); x0[3] += sigm(a0[3]) * bfhi(pw.y);
                    x1[0] += sigm(a1[0]) * bflo(pw.z); x1[1] += sigm(a1[1]) * bfhi(pw.z); x1[2] += sigm(a1[2]) * bflo(pw.w); x1[3] += sigm(a1[3]) * bfhi(pw.w);
                    *(f32x4*)op = x0; *(f32x4*)(op + 4) = x1; asm volatile("" ::: "memory"); } }
    }
};
struct OrderSkipV : StaticOrder {
    __device__ __forceinline__ bool next(int i, Unit& u) const { if (!StaticOrder::next(i, u)) return false; if (u.pn >= 11) u.pn += 2; return true; }
};
struct OrderPair : StaticOrder {
    __device__ __forceinline__ bool next(int i, Unit& u) const { if (!StaticOrder::next(i >> 1, u)) return false; if (i & 1) { u.pm += 128; u.pn += 4; } return true; }
};
struct OrderMoe {
    int nwg, G, c; const PG8_LAS int* tile_e;
    __device__ __forceinline__ bool next(int i, Unit& u) const { const long L = (long)i * G + c; if (L >= nwg) return false; const int rt = (int)(L >> 2); u.pm = rt; u.pn = tile_e[rt] * 4 + (int)(L & 3); return true; }
    __device__ __forceinline__ void a_ready(const Unit&) const {}
    __device__ __forceinline__ void done(const Unit&) const {}
};
}

struct Args { const float* in[36]; float* out; unsigned char* ws; int ph_lo, ph_hi; };

__device__ __forceinline__ void tr_item(const float* W, int N, bf16* WT, int ld, int k0, int n0, size_t dst_row0, int k_off, LAS float* scr, int lane) {
#pragma unroll 8
    for (int i = 0; i < 32; ++i) { const int kk = 2 * i + (lane >> 5); scr[kk * 33 + (lane & 31)] = W[(size_t)(k0 + kk) * N + n0 + (lane & 31)]; }
    LDS_WAIT(); asm volatile("" ::: "memory");
    const int c = lane & 7;
#pragma unroll
    for (int j = 0; j < 4; ++j) { const int n = (lane >> 3) + 8 * j; const LAS float* s = scr + (8 * c) * 33 + n;
        v4u o; o.x = pk2(s[0 * 33], s[1 * 33]); o.y = pk2(s[2 * 33], s[3 * 33]); o.z = pk2(s[4 * 33], s[5 * 33]); o.w = pk2(s[6 * 33], s[7 * 33]);
        *(v4u*)(WT + (dst_row0 + n) * ld + k_off + k0 + 8 * c) = o; }
    LDS_WAIT(); asm volatile("" ::: "memory");
}
__device__ __forceinline__ void tr_matrix(const float* W, int K, int N, bf16* WT, int ld, size_t dst_row0, int k_off, LAS float* scr, int lane, int gw, int NGW) {
    const int nblk = N / 32, nitems = (K / 64) * nblk;
    for (int it = gw; it < nitems; it += NGW) { const int kb = it / nblk, nb = it % nblk; tr_item(W, N, WT, ld, 64 * kb, 32 * nb, dst_row0 + 32 * nb, k_off, scr, lane); }
}
__device__ __forceinline__ void rms_row_to_bf16(const float* xrow, const float* gain, bf16* orow, int lane) {
    const f32x4* xr = (const f32x4*)xrow + lane; f32x4 v[4]; float s = 0.f;
#pragma unroll
    for (int j = 0; j < 4; ++j) { v[j] = xr[64 * j]; s += (v[j].x * v[j].x + v[j].y * v[j].y) + (v[j].z * v[j].z + v[j].w * v[j].w); }
    const float rstd = 1.0f / sqrtf(wave_sum(s) * (1.f / 1024.f) + 1e-6f);
    v2u* o8 = (v2u*)orow + lane;
#pragma unroll
    for (int j = 0; j < 4; ++j) { const f32x4 g = ((const f32x4*)gain)[lane + 64 * j]; v2u o; o.x = pk2(v[j].x * rstd * g.x, v[j].y * rstd * g.y); o.y = pk2(v[j].z * rstd * g.z, v[j].w * rstd * g.w); o8[64 * j] = o; }
}

__device__ __forceinline__ void phase0(const Args& a, LAS unsigned char* lds, int tid, int lane, int wave, int vcu, int G) {
    unsigned char* ws = a.ws;
    LAS float* scr = (LAS float*)(lds + wave * 16384);
    const int gw = vcu * NWAVES + wave, NGW = G * NWAVES; const int gt = vcu * NTHR + tid, NGT = G * NTHR;
    tr_matrix(a.in[3], 1024, NPROJ, (bf16*)(ws + WS_WIN), 1024, 0, 0, scr, lane, gw, NGW);
    tr_matrix(a.in[6], 64, 512, (bf16*)(ws + WS_WLORA), 256, 0, 0, scr, lane, gw, NGW);
    tr_matrix(a.in[8], 64, 512, (bf16*)(ws + WS_WLORA), 256, 512, 64, scr, lane, gw, NGW);
    tr_matrix(a.in[9], 128, 512, (bf16*)(ws + WS_WLORA), 256, 1024, 128, scr, lane, gw, NGW);
    tr_matrix(a.in[22], 512, 1024, (bf16*)(ws + WS_WBRD), 512, 0, 0, scr, lane, gw, NGW);
    tr_matrix(a.in[23], 512, 1024, (bf16*)(ws + WS_WBRD), 512, 1024, 0, scr, lane, gw, NGW);
    tr_matrix(a.in[24], 1024, 1024, (bf16*)(ws + WS_WO), 1024, 0, 0, scr, lane, gw, NGW);
    tr_matrix(a.in[34], 1024, 1024, (bf16*)(ws + WS_WPG), 1024, 0, 0, scr, lane, gw, NGW);
    tr_matrix(a.in[35], 256, 1024, (bf16*)(ws + WS_WPP), 256, 0, 0, scr, lane, gw, NGW);
    { v4u* wl = (v4u*)(ws + WS_WLORA); const v4u z = (v4u){0u, 0u, 0u, 0u};
      for (int i = gt; i < 1536 * 32; i += NGT) { const int row = i >> 5, kc = (i & 31) * 8; const int blk = row >> 9;
          const bool diag = blk == 0 ? (kc < 64) : (blk == 1 ? (kc >= 64 && kc < 128) : (kc >= 128)); if (!diag) wl[i] = z; } }
    { bf16* wr = (bf16*)(ws + WS_WR); const float* wg = a.in[26]; const float* we = a.in[28];
      for (int i = gt; i < 256 * 1024; i += NGT) { const int row = i >> 10, k = i & 1023; unsigned short v = 0;
          const int n = row < 64 ? row : row - 64;
          if ((row < 36) || (row >= 64 && row < 100)) { const float w = n < 32 ? we[k * 32 + n] : wg[k * 4 + (n - 32)]; const unsigned h = f2bf(w);
              v = (unsigned short)(row < 64 ? h : f2bf(w - __builtin_bit_cast(float, h << 16))); }
          wr[(size_t)row * 2048 + k] = v; wr[(size_t)row * 2048 + 1024 + k] = v; } }
    for (int m = gw; m < T; m += NGW) rms_row_to_bf16(a.in[0] + (size_t)m * DM, a.in[2], (bf16*)(ws + WS_XN) + (size_t)m * DM, lane);
}

__device__ __forceinline__ void phase2(const Args& a, LAS unsigned char* lds, int tid, int vcu, int G) {
    unsigned char* ws = a.ws;
    const bf16* projb = (const bf16*)(ws + WS_PROJB); const float* mu = a.in[4];
    bf16* la = (bf16*)(ws + WS_LA); bf16* qn = (bf16*)(ws + WS_QN); bf16* kn = (bf16*)(ws + WS_KN);
    LAS float* cs = (LAS float*)lds;
    for (int tile = vcu; tile < T / 64; tile += G) {
        const int t0 = tile * 64;
        __syncthreads();
#pragma unroll
        for (int i = 0; i < 4; ++i) { const int idx = tid + 512 * i, tok = idx >> 5, i32 = idx & 31; const int s = (t0 + tok) & (SEQ - 1);
            const float inv = powf(10000.0f, -(float)i32 * (1.0f / 32.0f)); const float ang = (float)s * inv; float sn, c; sincosf(ang, &sn, &c);
            cs[(tok * 32 + i32) * 2] = c; cs[(tok * 32 + i32) * 2 + 1] = sn; }
#pragma unroll
        for (int i = 0; i < 4; ++i) { const int idx = tid + 512 * i, tok = idx >> 5, ch = idx & 31, t = t0 + tok, j0 = ch * 8; const bool first = (t & (SEQ - 1)) == 0;
            const v4u cur = *(const v4u*)(projb + (size_t)t * 1280 + j0); v4u prv = (v4u){0u, 0u, 0u, 0u}; if (!first) prv = *(const v4u*)(projb + (size_t)(t - 1) * 1280 + j0);
            const f32x4 m0 = *(const f32x4*)(mu + 1536 + j0), m1 = *(const f32x4*)(mu + 1536 + j0 + 4);
            float x[8]; const unsigned cw[4] = {cur.x, cur.y, cur.z, cur.w}, pw[4] = {prv.x, prv.y, prv.z, prv.w}; const float mm[8] = {m0.x, m0.y, m0.z, m0.w, m1.x, m1.y, m1.z, m1.w};
#pragma unroll
            for (int e = 0; e < 4; ++e) { const float c0 = bflo(cw[e]), c1 = bfhi(cw[e]), p0 = bflo(pw[e]), p1 = bfhi(pw[e]); x[2 * e] = c0 + (p0 - c0) * mm[2 * e]; x[2 * e + 1] = c1 + (p1 - c1) * mm[2 * e + 1]; }
            if (ch < 8) {
#pragma unroll
                for (int e = 0; e < 8; ++e) x[e] = tanhf(x[e]);
            } else if (ch >= 16) {
#pragma unroll
                for (int e = 0; e < 8; ++e) x[e] = sigm(x[e]);
            }
            v4u o; o.x = pk2(x[0], x[1]); o.y = pk2(x[2], x[3]); o.z = pk2(x[4], x[5]); o.w = pk2(x[6], x[7]);
            *(v4u*)(la + (size_t)t * 256 + j0) = o; }
        __syncthreads();
        for (int i = 0; i < 16; ++i) { const int idx = tid + 512 * i, tok = idx >> 7, grp = (idx >> 3) & 15, l8 = idx & 7, t = t0 + tok;
            const v4u w = *(const v4u*)(projb + (size_t)t * 1280 + 256 + grp * 64 + l8 * 8);
            float x[8] = {bflo(w.x), bfhi(w.x), bflo(w.y), bfhi(w.y), bflo(w.z), bfhi(w.z), bflo(w.w), bfhi(w.w)};
            float ss = 0.f;
#pragma unroll
            for (int e = 0; e < 8; ++e) ss += x[e] * x[e];
            ss += __shfl_xor(ss, 1); ss += __shfl_xor(ss, 2); ss += __shfl_xor(ss, 4);
            const float rs = 1.0f / sqrtf(ss * (1.f / 64.f) + 1e-6f);
            const float* gn = (grp < 8 ? a.in[15] : a.in[16]) + l8 * 8;
            const f32x4 g0 = *(const f32x4*)gn, g1 = *(const f32x4*)(gn + 4); const float gg[8] = {g0.x, g0.y, g0.z, g0.w, g1.x, g1.y, g1.z, g1.w};
            float y[8], o[8];
#pragma unroll
            for (int e = 0; e < 8; ++e) y[e] = x[e] * rs * gg[e];
            const float sgn = l8 < 4 ? -1.f : 1.f; const float sc = grp < 8 ? C2 : 1.f;
#pragma unroll
            for (int e = 0; e < 8; ++e) { const float yp = __shfl_xor(y[e], 4); const int ci = (tok * 32 + (l8 & 3) * 8 + e) * 2; const float c = cs[ci], sn = cs[ci + 1]; o[e] = (y[e] * c + sgn * yp * sn) * sc; }
            const int b = t >> 12, s = t & (SEQ - 1); bf16* dst = (grp < 8 ? qn : kn) + ((size_t)(b * 8 + (grp & 7)) * SEQ + s) * 64 + l8 * 8;
            v4u ov; ov.x = pk2(o[0], o[1]); ov.y = pk2(o[2], o[3]); ov.z = pk2(o[4], o[5]); ov.w = pk2(o[6], o[7]);
            *(v4u*)dst = ov; }
    }
}

constexpr int SC_NB = 32, SC_REC = 392;
constexpr int SC_BUF = SC_NB * SC_REC * 4;
constexpr int SC_YOFF = 2 * SC_BUF;
struct ScanIn { v2u r0, k0, v0, r1, k1, v1, e, av, g; };
__device__ __forceinline__ void scan_unit(const Args& a, LAS unsigned char* lds, int tid, int bh) {
    unsigned char* ws = a.ws;
    const int b = bh >> 3, hd = bh & 7; const int lane = tid & 63, wave = tid >> 6;
    const bf16* rkv = (const bf16*)(ws + WS_RKV); const bf16* E = (const bf16*)(ws + WS_E); const bf16* Aa = (const bf16*)(ws + WS_A); const bf16* Gg = (const bf16*)(ws + WS_G);
    bf16* orw = (bf16*)((unsigned char*)a.out + OUT_ORWDF); float* bon = (float*)(ws + WS_BON); (void)bon;
    const int st = tid >> 4, c4 = tid & 15, ch = hd * 64 + c4 * 4;
    const f32x4 mur = *(const f32x4*)(a.in[4] + ch), muk = *(const f32x4*)(a.in[4] + 512 + ch), muv = *(const f32x4*)(a.in[4] + 1024 + ch);
    const f32x4 kkw = *(const f32x4*)(a.in[10] + ch), kaw = *(const f32x4*)(a.in[11] + ch), rkw = *(const f32x4*)(a.in[12] + ch), lnw = *(const f32x4*)(a.in[13] + ch), lnb = *(const f32x4*)(a.in[14] + ch);
    const int row = wave * 8 + (lane >> 3), ks = lane & 7;
    float sreg[8];
#pragma unroll
    for (int j = 0; j < 8; ++j) sreg[j] = 0.f;
    const size_t tb = (size_t)b * SEQ;
    auto load_batch = [&](int s0, ScanIn& L) {
        const size_t t = tb + s0 + st; const bool first = (s0 + st) == 0;
        L.r0 = *(const v2u*)(rkv + t * 1536 + ch); L.k0 = *(const v2u*)(rkv + t * 1536 + 512 + ch); L.v0 = *(const v2u*)(rkv + t * 1536 + 1024 + ch);
        const size_t tp = first ? t : t - 1;
        L.r1 = *(const v2u*)(rkv + tp * 1536 + ch); L.k1 = *(const v2u*)(rkv + tp * 1536 + 512 + ch); L.v1 = *(const v2u*)(rkv + tp * 1536 + 1024 + ch);
        if (first) { L.r1 = (v2u){0u, 0u}; L.k1 = L.r1; L.v1 = L.r1; }
        L.e = *(const v2u*)(E + t * 512 + ch); L.av = *(const v2u*)(Aa + t * 512 + ch); L.g = *(const v2u*)(Gg + t * 512 + ch);
    };
    float keep_v[4], keep_g[4], keep_bonus;
    auto convert = [&](const ScanIn& L, int buf) {
        const unsigned r0w[2] = {L.r0.x, L.r0.y}, r1w[2] = {L.r1.x, L.r1.y}, k0w[2] = {L.k0.x, L.k0.y}, k1w[2] = {L.k1.x, L.k1.y}, v0w[2] = {L.v0.x, L.v0.y}, v1w[2] = {L.v1.x, L.v1.y};
        const unsigned ew[2] = {L.e.x, L.e.y}, aw[2] = {L.av.x, L.av.y}, gw[2] = {L.g.x, L.g.y};
        float r[4], k[4], v[4], e[4], av[4], kk[4];
#pragma unroll
        for (int i = 0; i < 4; ++i) { const int w = i >> 1; const bool hi = i & 1;
            const float rc = hi ? bfhi(r0w[w]) : bflo(r0w[w]), rp = hi ? bfhi(r1w[w]) : bflo(r1w[w]);
            const float kc = hi ? bfhi(k0w[w]) : bflo(k0w[w]), kp = hi ? bfhi(k1w[w]) : bflo(k1w[w]);
            const float vc = hi ? bfhi(v0w[w]) : bflo(v0w[w]), vp = hi ? bfhi(v1w[w]) : bflo(v1w[w]);
            r[i] = rc + (rp - rc) * mur[i]; k[i] = kc + (kp - kc) * muk[i]; v[i] = vc + (vp - vc) * muv[i];
            e[i] = hi ? bfhi(ew[w]) : bflo(ew[w]); av[i] = hi ? bfhi(aw[w]) : bflo(aw[w]); keep_g[i] = hi ? bfhi(gw[w]) : bflo(gw[w]); keep_v[i] = v[i];
            kk[i] = k[i] * kkw[i]; }
        float ss = kk[0] * kk[0] + kk[1] * kk[1] + kk[2] * kk[2] + kk[3] * kk[3];
        ss += __shfl_xor(ss, 1); ss += __shfl_xor(ss, 2); ss += __shfl_xor(ss, 4); ss += __shfl_xor(ss, 8);
        const float inv = 1.0f / fmaxf(sqrtf(ss), 1e-12f);
        f32x4 w4, aa4, bb4, km4, wr4, vv4; float br = 0.f, kr = 0.f, bo = 0.f;
#pragma unroll
        for (int i = 0; i < 4; ++i) { const float kki = kk[i] * inv; const float km = k[i] * (1.0f + (av[i] - 1.0f) * kaw[i]); const float w = __expf(-e[i]);
            w4[i] = w; aa4[i] = -kki; bb4[i] = kki * av[i]; km4[i] = km; wr4[i] = w * r[i]; vv4[i] = v[i];
            br += bb4[i] * r[i]; kr += km * r[i]; bo += r[i] * km * rkw[i]; }
        br += __shfl_xor(br, 1); br += __shfl_xor(br, 2); br += __shfl_xor(br, 4); br += __shfl_xor(br, 8);
        kr += __shfl_xor(kr, 1); kr += __shfl_xor(kr, 2); kr += __shfl_xor(kr, 4); kr += __shfl_xor(kr, 8);
        bo += __shfl_xor(bo, 1); bo += __shfl_xor(bo, 2); bo += __shfl_xor(bo, 4); bo += __shfl_xor(bo, 8);
        keep_bonus = bo;
        LAS float* rec = (LAS float*)(lds + buf * SC_BUF) + st * SC_REC + c4 * 4;
        *(LAS f32x4*)(rec) = w4; *(LAS f32x4*)(rec + 64) = aa4; *(LAS f32x4*)(rec + 128) = bb4; *(LAS f32x4*)(rec + 192) = km4; *(LAS f32x4*)(rec + 256) = wr4; *(LAS f32x4*)(rec + 320) = vv4;
        if (c4 == 0) { rec[384] = br; rec[385] = kr; }
    };
    ScanIn L; load_batch(0, L);
    __syncthreads();
    convert(L, 0);
    __syncthreads();
    for (int bi = 0; bi < SEQ / SC_NB; ++bi) {
        const int cur = bi & 1;
        if (bi + 1 < SEQ / SC_NB) load_batch((bi + 1) * SC_NB, L);
        const LAS float* base = (const LAS float*)(lds + cur * SC_BUF);
        LAS float* ybuf = (LAS float*)(lds + SC_YOFF);
#pragma unroll 2
        for (int i = 0; i < SC_NB; ++i) { const LAS float* rec = base + i * SC_REC;
            const f32x4 w0 = *(const LAS f32x4*)(rec + ks * 8), w1 = *(const LAS f32x4*)(rec + ks * 8 + 4);
            const f32x4 a0 = *(const LAS f32x4*)(rec + 64 + ks * 8), a1 = *(const LAS f32x4*)(rec + 64 + ks * 8 + 4);
            const f32x4 b0 = *(const LAS f32x4*)(rec + 128 + ks * 8), b1 = *(const LAS f32x4*)(rec + 128 + ks * 8 + 4);
            const f32x4 k0 = *(const LAS f32x4*)(rec + 192 + ks * 8), k1 = *(const LAS f32x4*)(rec + 192 + ks * 8 + 4);
            const f32x4 q0 = *(const LAS f32x4*)(rec + 256 + ks * 8), q1 = *(const LAS f32x4*)(rec + 256 + ks * 8 + 4);
            const float vv = rec[320 + row], br = rec[384], kr = rec[385];
            float sa = (sreg[0] * a0[0] + sreg[1] * a0[1]) + (sreg[2] * a0[2] + sreg[3] * a0[3]) + (sreg[4] * a1[0] + sreg[5] * a1[1]) + (sreg[6] * a1[2] + sreg[7] * a1[3]);
            float z = (sreg[0] * q0[0] + sreg[1] * q0[1]) + (sreg[2] * q0[2] + sreg[3] * q0[3]) + (sreg[4] * q1[0] + sreg[5] * q1[1]) + (sreg[6] * q1[2] + sreg[7] * q1[3]);
            sa += __shfl_xor(sa, 1); z += __shfl_xor(z, 1); sa += __shfl_xor(sa, 2); z += __shfl_xor(z, 2); sa += __shfl_xor(sa, 4); z += __shfl_xor(z, 4);
            const float y = z + sa * br + vv * kr;
            if (ks == 0) ybuf[i * 64 + row] = y;
            sreg[0] = sreg[0] * w0[0] + sa * b0[0] + vv * k0[0]; sreg[1] = sreg[1] * w0[1] + sa * b0[1] + vv * k0[1]; sreg[2] = sreg[2] * w0[2] + sa * b0[2] + vv * k0[2]; sreg[3] = sreg[3] * w0[3] + sa * b0[3] + vv * k0[3];
            sreg[4] = sreg[4] * w1[0] + sa * b1[0] + vv * k1[0]; sreg[5] = sreg[5] * w1[1] + sa * b1[1] + vv * k1[1]; sreg[6] = sreg[6] * w1[2] + sa * b1[2] + vv * k1[2]; sreg[7] = sreg[7] * w1[3] + sa * b1[3] + vv * k1[3];
        }
        __syncthreads();
        { const f32x4 y4 = *(const LAS f32x4*)(ybuf + st * 64 + c4 * 4);
          float sm = (y4[0] + y4[1]) + (y4[2] + y4[3]); sm += __shfl_xor(sm, 1); sm += __shfl_xor(sm, 2); sm += __shfl_xor(sm, 4); sm += __shfl_xor(sm, 8);
          const float mean = sm * (1.f / 64.f); const f32x4 d = y4 - mean;
          float vs = (d[0] * d[0] + d[1] * d[1]) + (d[2] * d[2] + d[3] * d[3]); vs += __shfl_xor(vs, 1); vs += __shfl_xor(vs, 2); vs += __shfl_xor(vs, 4); vs += __shfl_xor(vs, 8);
          const float rstd = 1.0f / sqrtf(vs * (1.f / 64.f) + 64e-5f); float o[4];
#pragma unroll
          for (int i = 0; i < 4; ++i) o[i] = ((d[i] * rstd * lnw[i] + lnb[i]) + keep_bonus * keep_v[i]) * keep_g[i];
          v2u ov; ov.x = pk2(o[0], o[1]); ov.y = pk2(o[2], o[3]);
          *(v2u*)(orw + (tb + bi * SC_NB + st) * 512 + ch) = ov; }
        if (bi + 1 < SEQ / SC_NB) convert(L, cur ^ 1);
        __syncthreads();
    }
}

__device__ __forceinline__ int crow(int r, int hi) { return (r & 3) + 8 * (r >> 2) + 4 * hi; }
constexpr int AT_BUF = 24576;
__device__ __forceinline__ int at_addr(int row, int ch) { return row * 128 + ((ch ^ ((row >> 1) & 7)) << 4); }
__device__ __forceinline__ void attn_pass(const bf16* qn, const bf16* kn, const bf16* vt, int b, int head, int c, int qb, LAS unsigned char* lds, int tid, f32x16 (&o)[4]) {
    const int lane = tid & 63, wave = __builtin_amdgcn_readfirstlane(tid >> 6), r32 = lane & 31, hi = lane >> 5;
    const int vh = b * 8 + head * 2 + c; const int q0 = qb * 256, qw0 = q0 + wave * 32, qrow = qw0 + r32;
    const bf16* Qp = qn + ((size_t)vh * SEQ + qrow) * 64;
    s16x8 qf[4];
#pragma unroll
    for (int ks = 0; ks < 4; ++ks) qf[ks] = *(const s16x8*)(Qp + 16 * ks + 8 * hi);
    const int k_row = tid >> 3, k_ch = tid & 7;
    const bf16* ksrc = kn + (size_t)vh * SEQ * 64 + k_row * 64 + k_ch * 8; const int kdst = at_addr(k_row, k_ch);
    const int dv0 = tid >> 3, dv1 = 64 + (tid >> 3);
    const bf16* vsrc0 = vt + (size_t)(head * 128 + dv0) * T + (size_t)b * SEQ + k_ch * 8; const bf16* vsrc1 = vsrc0 + (size_t)64 * T;
    const int vdst0 = 8192 + at_addr(dv0, k_ch), vdst1 = 8192 + at_addr(dv1, k_ch);
    const int NT = 4 * qb + 4;
    v4u kreg = *(const v4u*)ksrc, vreg0 = *(const v4u*)vsrc0, vreg1 = *(const v4u*)vsrc1;
    __syncthreads();
    *(LAS v4u*)(lds + kdst) = kreg; *(LAS v4u*)(lds + vdst0) = vreg0; *(LAS v4u*)(lds + vdst1) = vreg1;
    __syncthreads();
    float m = -1e30f, l = 0.f;
#pragma unroll
    for (int db = 0; db < 4; ++db)
#pragma unroll
        for (int i = 0; i < 16; ++i) o[db][i] = 0.f;
    for (int j = 0; j < NT; ++j) {
        const int cur = (j & 1) * AT_BUF, nxt = AT_BUF - cur; const bool more = j + 1 < NT;
        if (more) { kreg = *(const v4u*)(ksrc + (size_t)(j + 1) * 64 * 64); vreg0 = *(const v4u*)(vsrc0 + (j + 1) * 64); vreg1 = *(const v4u*)(vsrc1 + (j + 1) * 64); }
        const int kv0 = j * 64;
        if (kv0 <= qw0 + 31) {
            f32x16 s0, s1;
#pragma unroll
            for (int i = 0; i < 16; ++i) { s0[i] = 0.f; s1[i] = 0.f; }
#pragma unroll
            for (int ks = 0; ks < 4; ++ks) {
                const s16x8 a0 = *(const LAS s16x8*)(lds + cur + at_addr(r32, 2 * ks + hi));
                const s16x8 a1 = *(const LAS s16x8*)(lds + cur + at_addr(32 + r32, 2 * ks + hi));
                s0 = __builtin_amdgcn_mfma_f32_32x32x16_bf16(a0, qf[ks], s0, 0, 0, 0);
                s1 = __builtin_amdgcn_mfma_f32_32x32x16_bf16(a1, qf[ks], s1, 0, 0, 0);
            }
            if (kv0 + 63 > qw0) {
#pragma unroll
                for (int i = 0; i < 16; ++i) { const int kv = kv0 + crow(i, hi); if (kv > qrow) s0[i] = -1e30f; if (kv + 32 > qrow) s1[i] = -1e30f; }
            }
            float rm = fmaxf(s0[0], s1[0]);
#pragma unroll
            for (int i = 1; i < 16; ++i) rm = fmaxf(rm, fmaxf(s0[i], s1[i]));
            rm = xhalf_max(rm);
            const float mn = fmaxf(m, rm); const float f = __builtin_amdgcn_exp2f(m - mn); m = mn;
            float ps = 0.f;
#pragma unroll
            for (int i = 0; i < 16; ++i) { s0[i] = __builtin_amdgcn_exp2f(s0[i] - mn); s1[i] = __builtin_amdgcn_exp2f(s1[i] - mn); ps += s0[i] + s1[i]; }
            l = l * f + ps;
            if (__any(f != 1.0f)) {
#pragma unroll
                for (int db = 0; db < 4; ++db)
#pragma unroll
                    for (int i = 0; i < 16; ++i) o[db][i] *= f;
            }
            v4u pw[4];
            pw[0] = (v4u){pk2(s0[0], s0[1]), pk2(s0[2], s0[3]), pk2(s0[4], s0[5]), pk2(s0[6], s0[7])};
            pw[1] = (v4u){pk2(s0[8], s0[9]), pk2(s0[10], s0[11]), pk2(s0[12], s0[13]), pk2(s0[14], s0[15])};
            pw[2] = (v4u){pk2(s1[0], s1[1]), pk2(s1[2], s1[3]), pk2(s1[4], s1[5]), pk2(s1[6], s1[7])};
            pw[3] = (v4u){pk2(s1[8], s1[9]), pk2(s1[10], s1[11]), pk2(s1[12], s1[13]), pk2(s1[14], s1[15])};
#pragma unroll
            for (int db = 0; db < 4; ++db) { const int dv = 32 * db + r32; const int vb = cur + 8192 + dv * 128 + 8 * hi, sw = (dv >> 1) & 7;
#pragma unroll
                for (int s4 = 0; s4 < 4; ++s4) {
                    const s16x4 lo = *(const LAS s16x4*)(lds + vb + (((2 * s4) ^ sw) << 4));
                    const s16x4 hh = *(const LAS s16x4*)(lds + vb + (((2 * s4 + 1) ^ sw) << 4));
                    const s16x8 av = (s16x8){lo[0], lo[1], lo[2], lo[3], hh[0], hh[1], hh[2], hh[3]};
                    o[db] = __builtin_amdgcn_mfma_f32_32x32x16_bf16(av, __builtin_bit_cast(s16x8, pw[s4]), o[db], 0, 0, 0);
                }
                __builtin_amdgcn_sched_barrier(0); }
        }
        if (more) { *(LAS v4u*)(lds + nxt + kdst) = kreg; *(LAS v4u*)(lds + nxt + vdst0) = vreg0; *(LAS v4u*)(lds + nxt + vdst1) = vreg1; }
        __syncthreads();
    }
    l = xhalf_sum(l);
    const float il = 1.0f / l;
#pragma unroll
    for (int db = 0; db < 4; ++db)
#pragma unroll
        for (int i = 0; i < 16; ++i) o[db][i] *= il;
}
__device__ __forceinline__ void attn_unit(const Args& a, LAS unsigned char* lds, int tid, int b, int head, int qb, float* stash  ) {
    unsigned char* ws = a.ws;
    const bf16* qn = (const bf16*)(ws + WS_QN); const bf16* kn = (const bf16*)(ws + WS_KN); const bf16* vt = (const bf16*)(ws + WS_VT);
    bf16* odf = (bf16*)((unsigned char*)a.out + OUT_ORWDF) + (size_t)T * 512;
    const int lane = tid & 63, wave = tid >> 6, r32 = lane & 31, hi = lane >> 5;
    const float d1 = wave_sum(a.in[17][lane] * a.in[18][lane]), d2 = wave_sum(a.in[19][lane] * a.in[20][lane]);
    const float lam = __expf(d1) - __expf(d2) + LAM_INIT;
    f32x16 o[4];
    attn_pass(qn, kn, vt, b, head, 0, qb, lds, tid, o);
    float* st = stash + tid * 64;
#pragma unroll
    for (int db = 0; db < 4; ++db)
#pragma unroll
        for (int g = 0; g < 4; ++g) *(f32x4*)(st + db * 16 + g * 4) = (f32x4){o[db][4 * g], o[db][4 * g + 1], o[db][4 * g + 2], o[db][4 * g + 3]};
    attn_pass(qn, kn, vt, b, head, 1, qb, lds, tid, o);
    float ss = 0.f;
#pragma unroll
    for (int db = 0; db < 4; ++db)
#pragma unroll
        for (int g = 0; g < 4; ++g) { const f32x4 s4 = *(const f32x4*)(st + db * 16 + g * 4);
#pragma unroll
            for (int e = 0; e < 4; ++e) { const float d = s4[e] - lam * o[db][4 * g + e]; o[db][4 * g + e] = d; ss += d * d; } }
    ss = xhalf_sum(ss);
    const float rs = (1.0f / sqrtf(ss * (1.f / 128.f) + 1e-6f)) * (1.0f - LAM_INIT);
    const size_t t = (size_t)b * SEQ + qb * 256 + wave * 32 + r32; const float* sw = a.in[21];
#pragma unroll
    for (int db = 0; db < 4; ++db)
#pragma unroll
        for (int g = 0; g < 4; ++g) { const int dv = 32 * db + 8 * g + 4 * hi; const f32x4 w4 = *(const f32x4*)(sw + dv);
            v2u ov; ov.x = pk2(o[db][4 * g] * rs * w4[0], o[db][4 * g + 1] * rs * w4[1]); ov.y = pk2(o[db][4 * g + 2] * rs * w4[2], o[db][4 * g + 3] * rs * w4[3]);
            *(v2u*)(odf + t * 512 + head * 128 + dv) = ov; }
}
#define XB_TMO      128
#define XB_XCNT(j)  (256  + 64 * (j))
#define XB_XSUB(j)  (1280 + 64 * (j))
#define XB_XGEN(j)  (2304 + 64 * (j))
#define XB_TOP      3328
#define XB_TOPGEN   3392
#define XCD_BAR_WORDS 3456
#define XB_SPIN_CAP (1u << 18)

__device__ __forceinline__ unsigned xb_ld(unsigned* p)              { return __hip_atomic_load(p, __ATOMIC_RELAXED, __HIP_MEMORY_SCOPE_AGENT); }
__device__ __forceinline__ unsigned xb_add(unsigned* p, unsigned v) { return __hip_atomic_fetch_add(p, v, __ATOMIC_RELAXED, __HIP_MEMORY_SCOPE_AGENT); }
__device__ __forceinline__ unsigned xb_xcc_id() { return (unsigned)__builtin_amdgcn_s_getreg((3 << 11) | 20) & 0xFu; }
#define XB_SPIN(cond, bar) do { unsigned _sp = 0; while (cond) { __builtin_amdgcn_s_sleep(1); \
    if ((++_sp & 255u) == 0u) { if (xb_ld(&(bar)[XB_TMO])) break; if (_sp > XB_SPIN_CAP) { atomicAdd(&(bar)[XB_TMO], 1u); break; } } } } while (0)

struct XcdBarrier {
    unsigned* bar; unsigned x;
    volatile LAS unsigned* st;
};

__device__ __forceinline__ XcdBarrier xcd_barrier_post(unsigned* bar, volatile LAS unsigned* st) {
    XcdBarrier b; b.bar = bar; b.x = xb_xcc_id(); b.st = st;
    if (threadIdx.x == 0) (void)xb_add(&bar[XB_XCNT(b.x)], 1u);
    return b;
}
__device__ __forceinline__ void xcd_barrier_complete(unsigned* bar, unsigned x, unsigned& nloc, unsigned& nx) {
    const unsigned G = gridDim.x * gridDim.y * gridDim.z;
    unsigned sum, cnt, mine, sp = 0u;
    for (;;) {
        sum = 0u; cnt = 0u; mine = 0u;
#pragma unroll
        for (unsigned j = 0; j < 16; ++j) { const unsigned c = xb_ld(&bar[XB_XCNT(j)]); sum += c; cnt += (c > 0u) ? 1u : 0u; mine = (j == x) ? c : mine; }
        if (sum == G) break;
        __builtin_amdgcn_s_sleep(1);
        if ((++sp & 255u) == 0u) { if (xb_ld(&bar[XB_TMO])) break; if (sp > XB_SPIN_CAP) { atomicAdd(&bar[XB_TMO], 1u); break; } }
    }
    nloc = mine > 0u ? mine : 1u; nx = cnt > 0u ? cnt : 1u;
}

__device__ __forceinline__ void xcd_barrier(const XcdBarrier& b) {
    asm volatile("s_waitcnt vmcnt(0)" ::: "memory");
    __syncthreads();
    if (threadIdx.x == 0) {
        unsigned* bar = b.bar;
        __builtin_amdgcn_s_waitcnt(0);
        unsigned nloc = b.st[0], nx = b.st[1];
        if (nloc == 0u) { xcd_barrier_complete(bar, b.x, nloc, nx); b.st[0] = nloc; b.st[1] = nx; }
        const unsigned old = xb_add(&bar[XB_XSUB(b.x)], 1u);
        const unsigned gen = old / nloc;
        if (old + 1u == (gen + 1u) * nloc) {
            __builtin_amdgcn_fence(__ATOMIC_RELEASE, "agent");
            asm volatile("s_waitcnt vmcnt(0)" ::: "memory");
            const unsigned og = xb_add(&bar[XB_TOP], 1u);
            const unsigned tg = og / nx;
            if (og + 1u == (tg + 1u) * nx) xb_add(&bar[XB_TOPGEN], 1u);
            else XB_SPIN(xb_ld(&bar[XB_TOPGEN]) == tg, bar);
            __builtin_amdgcn_fence(__ATOMIC_ACQUIRE, "agent");
            xb_add(&bar[XB_XGEN(b.x)], 1u);
            asm volatile("s_waitcnt vmcnt(0)" ::: "memory");
        } else {
            XB_SPIN(xb_ld(&bar[XB_XGEN(b.x)]) == gen, bar);
            __builtin_amdgcn_fence(__ATOMIC_ACQUIRE, "agent");
            asm volatile("s_waitcnt vmcnt(0)" ::: "memory");
        }
    }
    __syncthreads();
}

__device__ __forceinline__ void phase7(const Args& a, LAS unsigned char* lds, int tid, int lane, int wave, int vcu, int G) {
    unsigned char* ws = a.ws;
    const int gw = vcu * NWAVES + wave, NGW = G * NWAVES;
    const float* x1 = a.out; const float* gain = a.in[25]; bf16* h2x = (bf16*)(ws + WS_H2X);
    for (int m = gw; m < T; m += NGW) {
        const f32x4* xr = (const f32x4*)(x1 + (size_t)m * DM) + lane; f32x4 v[4]; float s = 0.f;
#pragma unroll
        for (int j = 0; j < 4; ++j) { v[j] = xr[64 * j]; s += (v[j].x * v[j].x + v[j].y * v[j].y) + (v[j].z * v[j].z + v[j].w * v[j].w); }
        const float rstd = 1.0f / sqrtf(wave_sum(s) * (1.f / 1024.f) + 1e-6f);
        v2u* oh = (v2u*)(h2x + (size_t)m * 2048) + lane; v2u* ol = (v2u*)(h2x + (size_t)m * 2048 + 1024) + lane;
#pragma unroll
        for (int j = 0; j < 4; ++j) { const f32x4 g = ((const f32x4*)gain)[lane + 64 * j]; float h[4], lo[4]; unsigned hb[4];
#pragma unroll
            for (int e = 0; e < 4; ++e) { h[e] = v[j][e] * rstd * g[e]; hb[e] = f2bf(h[e]); lo[e] = h[e] - __builtin_bit_cast(float, hb[e] << 16); }
            v2u o; o.x = hb[0] | (hb[1] << 16); o.y = hb[2] | (hb[3] << 16); oh[64 * j] = o;
            v2u p; p.x = pk2(lo[0], lo[1]); p.y = pk2(lo[2], lo[3]); ol[64 * j] = p; }
    }
    LAS float* scr = (LAS float*)(lds + wave * 16384);
    bf16* wgu = (bf16*)(ws + WS_WGU); bf16* wd = (bf16*)(ws + WS_WD);
    constexpr int IGU = (1024 / 64) * (512 / 32);
    constexpr int IDN = (512 / 64) * (1024 / 32);
    for (int it = gw; it < NEXP * (2 * IGU + IDN); it += NGW) {
        const int e = it / (2 * IGU + IDN); int r = it % (2 * IGU + IDN);
        if (r < 2 * IGU) { const int up = r >= IGU; if (up) r -= IGU; const int kb = r / 16, nb = r % 16, n0 = 32 * nb;
            const float* W = (up ? a.in[31] : a.in[30]) + (size_t)e * 1024 * 512;
            tr_item(W, 512, wgu, 1024, 64 * kb, n0, (size_t)e * 1024 + (n0 >> 7) * 256 + (up ? 128 : 0) + (n0 & 127), 0, scr, lane);
        } else { r -= 2 * IGU; const int kb = r / 32, nb = r % 32;
            tr_item(a.in[32] + (size_t)e * 512 * 1024, 1024, wd, 512, 64 * kb, 32 * nb, (size_t)e * 1024 + 32 * nb, 0, scr, lane); }
    }
}

__device__ __forceinline__ void route_tile(const Args& a, LAS unsigned char* lds, int tid, int pm) {
    unsigned char* ws = a.ws;
    const float* LG = (const float*)(ws + WS_LOGITS); int* toke = (int*)(ws + WS_TOKE); float* tokw = (float*)(ws + WS_TOKW); int* tilecnt = (int*)(ws + WS_TILECNT);
    LAS int* cnt = (LAS int*)lds;
    if (tid < 32) cnt[tid] = 0;
    __syncthreads();
    if (tid < 256) {
        const int t = pm * 256 + tid; const float* lr = LG + (size_t)t * 128;
        float gl[4];
#pragma unroll
        for (int j = 0; j < 4; ++j) gl[j] = (lr[32 + j] + lr[96 + j]) + a.in[27][j];
        int gi = 0; float gm = gl[0];
#pragma unroll
        for (int j = 1; j < 4; ++j) if (gl[j] > gm) { gm = gl[j]; gi = j; }
        float gs = 0.f;
#pragma unroll
        for (int j = 0; j < 4; ++j) gs += __expf(gl[j] - gm);
        const float gtop = 1.0f / gs;
        float el[8];
#pragma unroll
        for (int j = 0; j < 8; ++j) el[j] = (lr[gi * 8 + j] + lr[64 + gi * 8 + j]) + a.in[29][gi * 8 + j];
        int i1 = 0; float e1 = el[0];
#pragma unroll
        for (int j = 1; j < 8; ++j) if (el[j] > e1) { e1 = el[j]; i1 = j; }
        int i2 = -1; float e2 = -3.0e38f;
#pragma unroll
        for (int j = 0; j < 8; ++j) if (j != i1 && el[j] > e2) { e2 = el[j]; i2 = j; }
        const float ex = __expf(e2 - e1); const float w1 = gtop / (1.0f + ex), w2 = gtop * ex / (1.0f + ex);
        const int x1 = gi * 8 + i1, x2 = gi * 8 + i2;
        toke[t * 2] = x1; toke[t * 2 + 1] = x2; tokw[t * 2] = w1; tokw[t * 2 + 1] = w2;
        atomicAdd((int*)&cnt[x1], 1); atomicAdd((int*)&cnt[x2], 1);
    }
    __syncthreads();
    if (tid < 32) tilecnt[pm * 32 + tid] = cnt[tid];
    __syncthreads();
}

__device__ __forceinline__ void phase9(const Args& a, LAS unsigned char* lds, int tid, int lane, int wave) {
    unsigned char* ws = a.ws;
    const int tile = blockIdx.x;
    if (tile >= 128) return;
    const int* tilecnt = (const int*)(ws + WS_TILECNT); const int* toke = (const int*)(ws + WS_TOKE); const float* tokw = (const float*)(ws + WS_TOKW);
    int* pos = (int*)(ws + WS_POS); float* roww = (float*)(ws + WS_ROWW); int* disp = (int*)(ws + WS_DISP);
    const bf16* h2x = (const bf16*)(ws + WS_H2X); bf16* hs = (bf16*)(ws + WS_HS);
    LAS int* tc = (LAS int*)lds;
    LAS int* tot = tc + 4096;
    LAS int* bef = tot + 32;
    LAS int* base = bef + 32;
    LAS int* pst = base + 32;
    LAS int* earr = pst + 32;
    LAS int* parr = earr + 512;
    for (int i = tid; i < 4096; i += NTHR) tc[i] = tilecnt[i];
    earr[tid] = toke[tile * 512 + tid];
    __syncthreads();
    if (tid < 32) { int s = 0, b = 0; for (int t = 0; t < 128; ++t) { const int c = tc[t * 32 + tid]; s += c; if (t < tile) b += c; } tot[tid] = s; bef[tid] = b; }
    __syncthreads();
    if (tid == 0) { int p = 0; for (int e = 0; e < 32; ++e) { pst[e] = p; base[e] = p + bef[e]; const int nt = (tot[e] + 255) >> 8;
                        if (tile == 0) { for (int k = 0; k < nt; ++k) disp[16 + (p >> 8) + k] = e; disp[512 + e] = p; disp[576 + e] = tot[e]; }
                        p += nt << 8; }
                    if (tile == 0) disp[0] = p >> 8; }
    __syncthreads();
    for (int q = 0; q < 4; ++q) { const int e = wave * 4 + q; int running = 0;
        for (int c8 = 0; c8 < 8; ++c8) { const int ai = c8 * 64 + lane; const bool mt = earr[ai] == e; const unsigned long long mk = __ballot(mt);
            if (mt) parr[ai] = base[e] + running + __popcll(mk & ((1ull << lane) - 1ull));
            running += __popcll(mk); } }
    __syncthreads();
    { const int ai = tid, p = parr[ai], t = tile * 256 + (ai >> 1); pos[t * 2 + (ai & 1)] = p; roww[p] = tokw[t * 2 + (ai & 1)]; }
    for (int i = 0; i < 64; ++i) { const int ai = wave * 64 + i, p = parr[ai], t = tile * 256 + (ai >> 1);
        const v4u* src = (const v4u*)(h2x + (size_t)t * 2048); v4u* dst = (v4u*)(hs + (size_t)p * 1024);
        dst[lane] = src[lane]; dst[lane + 64] = src[lane + 64]; }
    if (tile < 32) { const int p0 = pst[tile] + tot[tile], p1 = pst[tile] + (((tot[tile] + 255) >> 8) << 8); const v4u z = (v4u){0u, 0u, 0u, 0u};
        for (int r = p0 + wave; r < p1; r += NWAVES) { v4u* dst = (v4u*)(hs + (size_t)r * 1024); dst[lane] = z; dst[lane + 64] = z; if (lane == 0) roww[r] = 0.f; } }
}

__device__ __forceinline__ void phase12(const Args& a, int tid, int lane, int wave, int vcu, int G) {
    unsigned char* ws = a.ws;
    const int gw = vcu * NWAVES + wave, NGW = G * NWAVES; const int gt = vcu * NTHR + tid, NGT = G * NTHR;
    float* x = a.out; const bf16* y2 = (const bf16*)(ws + WS_Y2); const int* pos = (const int*)(ws + WS_POS); const float* gain = a.in[33]; bf16* h3 = (bf16*)(ws + WS_H3);
    for (int m = gw; m < T; m += NGW) {
        const int pa = pos[m * 2], pb = pos[m * 2 + 1];
        f32x4* xr = (f32x4*)(x + (size_t)m * DM) + lane; const v2u* ya = (const v2u*)(y2 + (size_t)pa * 1024) + lane; const v2u* yb = (const v2u*)(y2 + (size_t)pb * 1024) + lane;
        f32x4 v[4]; float s = 0.f;
#pragma unroll
        for (int j = 0; j < 4; ++j) { v[j] = xr[64 * j]; const v2u wa = ya[64 * j], wb = yb[64 * j];
            v[j].x += bflo(wa.x) + bflo(wb.x); v[j].y += bfhi(wa.x) + bfhi(wb.x); v[j].z += bflo(wa.y) + bflo(wb.y); v[j].w += bfhi(wa.y) + bfhi(wb.y);
            xr[64 * j] = v[j]; s += (v[j].x * v[j].x + v[j].y * v[j].y) + (v[j].z * v[j].z + v[j].w * v[j].w); }
        const float rstd = 1.0f / sqrtf(wave_sum(s) * (1.f / 1024.f) + 1e-6f);
        v2u* o8 = (v2u*)(h3 + (size_t)m * DM) + lane;
#pragma unroll
        for (int j = 0; j < 4; ++j) { const f32x4 g = ((const f32x4*)gain)[lane + 64 * j]; v2u o; o.x = pk2(v[j].x * rstd * g.x, v[j].y * rstd * g.y); o.y = pk2(v[j].z * rstd * g.z, v[j].w * rstd * g.w); o8[64 * j] = o; }
    }
    const f32x4* p = (const f32x4*)a.in[1]; v2u* p16 = (v2u*)(ws + WS_P16);
    for (int i = gt; i < T * 256 / 4; i += NGT) { const f32x4 v = p[i]; v2u o; o.x = pk2(v.x, v.y); o.y = pk2(v.z, v.w); p16[i] = o; }
}

#ifndef MK_N_LAUNCHES
#define MK_N_LAUNCHES 1
#endif
constexpr int NPHASE = 14;
__global__ void __launch_bounds__(NTHR, 2) mk_fwd(Args args) {
    extern __shared__ __attribute__((aligned(16))) unsigned char lds_raw[];
    LAS unsigned char* lds = (LAS unsigned char*)lds_raw;
    const int tid = threadIdx.x, lane = tid & 63, wave = __builtin_amdgcn_readfirstlane(tid >> 6);
    const int G = gridDim.x; const int bx = blockIdx.x; const int vcu = (G % 8 == 0) ? (bx % 8) * (G / 8) + bx / 8 : bx;
    unsigned char* ws = args.ws;
    const int lo = args.ph_lo, hi = args.ph_hi;
#ifdef ONLY_PHASE
#define IN(k) ((k) == ONLY_PHASE && lo <= (k) && (k) < hi)
#else
#define IN(k) (lo <= (k) && (k) < hi)
#endif
#if MK_N_LAUNCHES == 1
    volatile LAS unsigned* MISC = (volatile LAS unsigned*)(lds + MISC_OFF);
    for (int u = tid; u < 64; u += NTHR) MISC[u] = 0u;
    __syncthreads();
    XcdBarrier xbar = xcd_barrier_post((unsigned*)(ws + WS_CTL) + CW_BAR, MISC + 8);
#define SEAM(k) do { if (IN(k) && IN((k) + 1)) { if ((k) == 0) { __threadfence(); cg::this_grid().sync(); __threadfence(); } else xcd_barrier(xbar); } } while (0)
#else
#define SEAM(k) do { } while (0)
#endif
    typedef pg8::bf16_t pbf;
    int K256 = 256, K512 = 512, K1024 = 1024, K2048 = 2048;
    asm volatile("" : "+s"(K256), "+s"(K512), "+s"(K1024), "+s"(K2048));
    if (IN(0)) { phase0(args, lds, tid, lane, wave, vcu, G); }
    SEAM(0);
    if (IN(1)) {
        { pg8::Gemm g{(const pbf*)(ws + WS_XN), (const pbf*)(ws + WS_WIN), T, 19 * 256, K1024}; pg8::OrderSkipV S; S.init(T, 19 * 256, G, bx);
          pg8::EpiProj E{(pbf*)(ws + WS_RKV), (pbf*)(ws + WS_PROJB), (pbf*)(ws + WS_GATES)};
          pg8::gemm_phase<pg8::EpiProj, pg8::OrderSkipV, true, true>(lds, g, S, E); }
        { pg8::Gemm g{(const pbf*)(ws + WS_WIN) + (size_t)2816 * 1024, (const pbf*)(ws + WS_XN), 512, T, K1024}; pg8::StaticOrder S; S.init(512, T, G, bx);
          pg8::EpiStore E{(pbf*)(ws + WS_VT), T};
          pg8::gemm_phase<pg8::EpiStore, pg8::StaticOrder, true, true>(lds, g, S, E); }
    }
    SEAM(1);
    if (IN(2)) { phase2(args, lds, tid, vcu, G); }
    SEAM(2);
    if (IN(3)) {
        pg8::Gemm g{(const pbf*)(ws + WS_LA), (const pbf*)(ws + WS_WLORA), T, 1536, K256}; pg8::StaticOrder S; S.init(T, 1536, G, bx);
        pg8::EpiLora E{(pbf*)(ws + WS_E), (pbf*)(ws + WS_A), (pbf*)(ws + WS_G), args.in[5], args.in[7]};
        pg8::gemm_phase<pg8::EpiLora, pg8::StaticOrder, true, true>(lds, g, S, E);
    }
    SEAM(3);
    if (IN(4)) {
        unsigned* qhead = (unsigned*)(ws + WS_CTL) + CW_QUEUE; LAS unsigned* ubox = (LAS unsigned*)(lds + MISC_OFF);
        float* stash = (float*)((unsigned char*)args.out + OUT_STASH) + (size_t)bx * 64 * 512;
        for (;;) {
            __syncthreads();
            if (tid == 0) ubox[0] = atomicAdd(qhead, 1u);
            __syncthreads();
            const int u = (int)ubox[0];
            if (u >= 64 + 512) break;
            if (u < 64) scan_unit(args, lds, tid, u);
            else { const int au = u - 64; attn_unit(args, lds, tid, (au & 31) >> 2, au & 3, 15 - (au >> 5), stash); }
        }
    }
    SEAM(4);
    if (IN(5)) {
        pg8::Gemm g{(const pbf*)((unsigned char*)args.out + OUT_ORWDF), (const pbf*)(ws + WS_WBRD), 2 * T, 2048, K512}; pg8::OrderPair S; S.init(T, 1024, G, bx);
        pg8::EpiMix E{(const pbf*)(ws + WS_GATES), (float*)(ws + WS_PART), (pbf*)(ws + WS_MIXED)};
        pg8::gemm_phase<pg8::EpiMix, pg8::OrderPair, true, true>(lds, g, S, E);
    }
    SEAM(5);
    if (IN(6)) {
        pg8::Gemm g{(const pbf*)(ws + WS_MIXED), (const pbf*)(ws + WS_WO), T, 1024, K1024}; pg8::StaticOrder S; S.init(T, 1024, G, bx);
        pg8::EpiRes E{args.in[0], args.out};
        pg8::gemm_phase<pg8::EpiRes, pg8::StaticOrder, true, true>(lds, g, S, E);
    }
    SEAM(6);
    if (IN(7)) { phase7(args, lds, tid, lane, wave, vcu, G); }
    SEAM(7);
    if (IN(8)) {
        pg8::Gemm g{(const pbf*)(ws + WS_H2X), (const pbf*)(ws + WS_WR), T, 256, K2048}; pg8::StaticOrder S; S.init(T, 256, G, bx);
        pg8::EpiLogits E{(float*)(ws + WS_LOGITS)};
        pg8::gemm_phase<pg8::EpiLogits, pg8::StaticOrder, true, true>(lds, g, S, E);
        VM_WAIT(); __syncthreads();
        pg8::Unit u;
        for (int i = 0; S.next(i, u); ++i) route_tile(args, lds, tid, u.pm);
    }
    SEAM(8);
    if (IN(9)) { phase9(args, lds, tid, lane, wave); }
    SEAM(9);
    if (IN(10) || IN(11)) {
        const int* disp = (const int*)(ws + WS_DISP); LAS int* tile_e = (LAS int*)(lds + MISC_OFF + 64);
        __syncthreads();
        const int NT = disp[0];
        for (int i = tid; i < NT && i < 320; i += NTHR) tile_e[i] = disp[16 + i];
        __syncthreads();
        if (IN(10)) {
            pg8::Gemm g{(const pbf*)(ws + WS_HS), (const pbf*)(ws + WS_WGU), MAXROWS, NEXP * 1024, K1024}; pg8::OrderMoe S{NT * 4, G, bx, tile_e};
            pg8::EpiAct E{(pbf*)(ws + WS_ACT)};
            pg8::gemm_phase<pg8::EpiAct, pg8::OrderMoe, true, true>(lds, g, S, E);
        }
        SEAM(10);
        if (IN(11)) {
            pg8::Gemm g{(const pbf*)(ws + WS_ACT), (const pbf*)(ws + WS_WD), MAXROWS, NEXP * 1024, K512}; pg8::OrderMoe S{NT * 4, G, bx, tile_e};
            pg8::EpiDown E{(pbf*)(ws + WS_Y2), (const float*)(ws + WS_ROWW)};
            pg8::gemm_phase<pg8::EpiDown, pg8::OrderMoe, true, true>(lds, g, S, E);
        }
    }
    SEAM(11);
    if (IN(12)) { phase12(args, tid, lane, wave, vcu, G); }
    SEAM(12);
    if (IN(13)) {
        { pg8::Gemm g{(const pbf*)(ws + WS_P16), (const pbf*)(ws + WS_WPP), T, 1024, K256}; pg8::StaticOrder S; S.init(T, 1024, G, bx);
          pg8::EpiStore E{(pbf*)(ws + WS_PP), 1024};
          pg8::gemm_phase<pg8::EpiStore, pg8::StaticOrder, true, true>(lds, g, S, E); }
        { pg8::Gemm g{(const pbf*)(ws + WS_H3), (const pbf*)(ws + WS_WPG), T, 1024, K1024}; pg8::StaticOrder S; S.init(T, 1024, G, bx);
          pg8::EpiFinal E{(const pbf*)(ws + WS_PP), args.out};
          pg8::gemm_phase<pg8::EpiFinal, pg8::StaticOrder, true, true>(lds, g, S, E); }
    }
#undef IN
#undef SEAM
}

extern "C" void kernel_launch(void* const* d_in, const int* in_sizes, int n_in, void* d_out, int out_size, void* d_ws, size_t ws_size, hipStream_t stream) {
    static int grid = 0;
    if (grid == 0) {
        if (n_in != 36 || in_sizes[0] != T * DM || out_size != T * DM || ws_size < WS_END) {
            fprintf(stderr, "kernel_launch: unexpected problem: n_in %d in0 %d out %d ws %zu (need %zu)\n", n_in, n_in > 0 ? in_sizes[0] : -1, out_size, ws_size, (size_t)WS_END); grid = -1; return; }
        int dev = 0, cus = 0, per_cu = 0;
        if (hipGetDevice(&dev) != hipSuccess || hipDeviceGetAttribute(&cus, hipDeviceAttributeMultiprocessorCount, dev) != hipSuccess) { grid = -1; return; }
        if (hipFuncSetAttribute((const void*)mk_fwd, hipFuncAttributeMaxDynamicSharedMemorySize, LDS_BYTES) != hipSuccess) { fprintf(stderr, "kernel_launch: hipFuncSetAttribute failed\n"); grid = -1; return; }
        if (hipOccupancyMaxActiveBlocksPerMultiprocessor(&per_cu, (const void*)mk_fwd, NTHR, LDS_BYTES) != hipSuccess || per_cu < 1) { fprintf(stderr, "kernel_launch: occupancy query says %d blocks per CU\n", per_cu); (void)hipGetLastError(); grid = -1; return; }
        grid = cus;
        if (grid > 256) grid = 256;
    }
    if (grid < 0) return;
    (void)hipMemsetAsync((char*)d_ws + WS_CTL, 0, CTL_ZERO_BYTES, stream);
    Args a{};
    for (int i = 0; i < 36; ++i) a.in[i] = (const float*)d_in[i];
    a.out = (float*)d_out; a.ws = (unsigned char*)d_ws;
#if MK_N_LAUNCHES == 1
    a.ph_lo = 0; a.ph_hi = NPHASE;
    void* kargs[] = {&a};
    const hipError_t e = hipLaunchCooperativeKernel((const void*)mk_fwd, dim3(grid), dim3(NTHR), kargs, LDS_BYTES, stream);
    if (e != hipSuccess) fprintf(stderr, "kernel_launch: cooperative launch failed: %s (grid %d)\n", hipGetErrorString(e), grid);
#else
    for (int ph = 0; ph < NPHASE; ++ph) { a.ph_lo = ph; a.ph_hi = ph + 1; hipLaunchKernelGGL(mk_fwd, dim3(grid), dim3(NTHR), LDS_BYTES, stream, a); }
#endif
}
```

```cpp
#include <hip/hip_runtime.h>
#include <hip/hip_cooperative_groups.h>
#include <cstdio>
#include <cstdint>
namespace cg = cooperative_groups;
namespace pg8 {
#define PG8_LAS __attribute__((address_space(3)))
typedef unsigned short bf16_t;
typedef short bf16x8 __attribute__((ext_vector_type(8)));
typedef float f32x4 __attribute__((ext_vector_type(4)));
typedef unsigned u32x4 __attribute__((ext_vector_type(4)));
constexpr int BM = 256, BK = 64, HALF = 128, HTB = HALF * BK * 2  , STAGE_BYTES = 8 * HTB, NXCD = 8, WGM = 8;

__host__ __device__ __forceinline__ int lds_byte(int r, int c) { const int st = (r >> 4) * 2 + (c >> 5), rr = r & 15, cc = c & 31, ob = rr * 64 + cc * 2; return st * 1024 + (ob ^ (((ob >> 9) & 1) << 5)); }
__host__ __device__ __forceinline__ void stage_rc(int b, int& R, int& C) { const int st = b / 1024, sb = b % 1024, swz = sb ^ (((sb >> 9) & 1) << 5); R = (st >> 1) * 16 + swz / 64; C = (st & 1) * 32 + (swz % 64) / 2; }
__host__ __device__ __forceinline__ int perm32(int rho) { const int n = rho >> 4, i = rho & 15; return 8 * (i >> 2) + 4 * n + (i & 3); }

struct Unit { int pm, pn; };
struct Gemm { const bf16_t* A; const bf16_t* Bt; int M, N, K; };

struct StaticOrder {
    int nM, nN, nwg, G, c;
    __host__ __device__ __forceinline__ void init(int M, int N, int G_, int c_) { nM = M / BM; nN = N / BM; nwg = nM * nN; G = G_; c = c_; }
    __host__ __device__ __forceinline__ bool next(int i, Unit& u) const {
        const long L = (long)i * G + c; if (L >= nwg) return false;
        int wgid = (int)L; { const int q = nwg / NXCD, r = nwg % NXCD, xcd = wgid % NXCD, off = wgid / NXCD; wgid = (xcd < r ? xcd * (q + 1) : r * (q + 1) + (xcd - r) * q) + off; }
        const int nig = WGM * nN, gid = wgid / nig, fm = gid * WGM, gsz = (nM - fm) < WGM ? (nM - fm) : WGM;
        u.pm = fm + ((wgid % nig) % gsz); u.pn = (wgid % nig) / gsz; return true;
    }
    __device__ __forceinline__ void a_ready(const Unit&) const {}
    __device__ __forceinline__ void done(const Unit&) const {}
};

__device__ __forceinline__ unsigned cvt_pk_bf16(float lo, float hi) { unsigned r; asm volatile("v_cvt_pk_bf16_f32 %0, %1, %2" : "=v"(r) : "v"(lo), "v"(hi)); return r; }
template <class Epi, class Sched, bool ALIGN_EPI = false, bool SP2 = false>
__device__ __forceinline__ void gemm_phase(PG8_LAS unsigned char* lds, const Gemm g, const Sched& S, const Epi& E, const int tz = 0  ) {
    const int tid = threadIdx.x + tz, wid = __builtin_amdgcn_readfirstlane(tid >> 6), lane = tid & 63, wr = wid >> 2, wc = wid & 3, fr = lane & 15, fq = lane >> 4;
    const int K = g.K, nt = K / BK;
    unsigned voffA[2], voffB[2];
#pragma unroll
    for (int i = 0; i < 2; ++i) { int R, C; stage_rc(tid * 16 + i * 8192, R, C); const int Rb = Epi::PERM ? ((R & ~31) + perm32(R & 31)) : R;
        voffA[i] = (unsigned)(R * K + C) * 2u; voffB[i] = (unsigned)(Rb * K + C) * 2u; }
    const size_t kstep = (size_t)(BK * 2);
    const size_t hstep = (size_t)HALF * K * 2;
    const size_t tstep = 2 * hstep;
    const unsigned ldsw = (unsigned)wid * 1024u;
    const int aoff = lds_byte(wr * 64 + fr, fq * 8), boff = lds_byte(wc * 32 + fr, fq * 8);
#define PG8_SA(b, h) (((b) * 2 + (h)) * HTB)
#define PG8_SB(b, h) ((4 + (b) * 2 + (h)) * HTB)
#define PG8_STAGE(bufoff, gbase, voff) do { _Pragma("unroll") for (int _i = 0; _i < 2; ++_i) \
        __builtin_amdgcn_global_load_lds((const unsigned*)((const char*)(gbase) + (voff)[_i]), (PG8_LAS unsigned*)(lds + (bufoff) + ldsw + _i * 8192), 16, 0, 0); } while (0)
#define PG8_LDA(dst, b, h) do { _Pragma("unroll") for (int m = 0; m < 4; ++m) _Pragma("unroll") for (int k = 0; k < 2; ++k) dst[m][k] = *(const PG8_LAS bf16x8*)(lds + PG8_SA(b, h) + aoff + m * 2048 + k * 1024); } while (0)
#define PG8_LDB(dst, b, h) do { _Pragma("unroll") for (int n = 0; n < 2; ++n) _Pragma("unroll") for (int k = 0; k < 2; ++k) dst[n][k] = *(const PG8_LAS bf16x8*)(lds + PG8_SB(b, h) + boff + n * 2048 + k * 1024); } while (0)
#define PG8_MMA(ai, bj, At, Bt) do { __builtin_amdgcn_s_setprio(1); _Pragma("unroll") for (int m = 0; m < 4; ++m) _Pragma("unroll") for (int n = 0; n < 2; ++n) _Pragma("unroll") for (int k = 0; k < 2; ++k) \
        acc[ai][bj][m][n] = __builtin_amdgcn_mfma_f32_16x16x32_bf16(Bt[n][k], At[m][k], acc[ai][bj][m][n], 0, 0, 0); __builtin_amdgcn_s_setprio(0); } while (0)
#define PG8_WAIT_V(n) asm volatile("s_waitcnt vmcnt(" #n ")" ::: "memory")
#define PG8_WAIT_L(n) asm volatile("s_waitcnt lgkmcnt(" #n ")" ::: "memory")
#define PG8_BAR __builtin_amdgcn_s_barrier()
#define PG8_SCHED __builtin_amdgcn_sched_barrier(0)
    Unit cur, nxt; int ui = 0;
    if (!S.next(0, cur)) return;
    f32x4 acc[2][2][4][2];
#pragma unroll
    for (int a = 0; a < 2; ++a)
#pragma unroll
        for (int b = 0; b < 2; ++b)
#pragma unroll
            for (int m = 0; m < 4; ++m)
#pragma unroll
                for (int n = 0; n < 2; ++n) acc[a][b][m][n] = (f32x4){0.f, 0.f, 0.f, 0.f};
    bf16x8 At[4][2], B0[2][2], B1[2][2];
    const char* cA = (const char*)g.A + (size_t)cur.pm * tstep; const char* cB = (const char*)g.Bt + (size_t)cur.pn * tstep;
    S.a_ready(cur);
    if constexpr (SP2) {
        PG8_STAGE(PG8_SB(0, 0), cB, voffB); PG8_STAGE(PG8_SB(0, 1), cB + hstep, voffB); PG8_STAGE(PG8_SA(0, 0), cA, voffA); PG8_STAGE(PG8_SA(0, 1), cA + hstep, voffA);
        if (wr == 1) PG8_BAR;
        PG8_WAIT_V(2); PG8_BAR;
        PG8_STAGE(PG8_SB(1, 0), cB + kstep, voffB); PG8_STAGE(PG8_SA(1, 0), cA + kstep, voffA); PG8_STAGE(PG8_SB(1, 1), cB + hstep + kstep, voffB);
        PG8_WAIT_V(6); PG8_BAR;
    } else {
        PG8_STAGE(PG8_SB(0, 0), cB, voffB); PG8_STAGE(PG8_SA(0, 0), cA, voffA); PG8_STAGE(PG8_SB(0, 1), cB + hstep, voffB); PG8_STAGE(PG8_SA(0, 1), cA + hstep, voffA);
        if (wr == 1) PG8_BAR;
        PG8_WAIT_V(4); PG8_BAR;
        PG8_STAGE(PG8_SB(1, 0), cB + kstep, voffB); PG8_STAGE(PG8_SA(1, 0), cA + kstep, voffA); PG8_STAGE(PG8_SB(1, 1), cB + hstep + kstep, voffB);
        PG8_WAIT_V(6); PG8_BAR;
    }
    for (;;) {
        const bool has_next = S.next(ui + 1, nxt);
        const char* nA = has_next ? (const char*)g.A + (size_t)nxt.pm * tstep : cA; const char* nB = has_next ? (const char*)g.Bt + (size_t)nxt.pn * tstep : cB;
        for (int t = 0; t < nt; t += 2) {
            if constexpr (Epi::HAS_MID) { if (t == (nt >> 1)) E.mid(acc, cur, wr, wc, fr, fq); }
            const bool last = (t == nt - 2);
            const char* a1 = cA + (size_t)(t + 1) * kstep;
            const char* a2 = last ? nA : cA + (size_t)(t + 2) * kstep; const char* b2 = last ? nB : cB + (size_t)(t + 2) * kstep;
            const char* a3 = a2 + kstep; const char* b3 = b2 + kstep;
            if (last && has_next) S.a_ready(nxt);
            if constexpr (SP2) {
            PG8_LDB(B0, 0, 0); PG8_LDB(B1, 0, 1); PG8_SCHED; PG8_LDA(At, 0, 0); PG8_STAGE(PG8_SA(1, 1), a1 + hstep, voffA);
            PG8_WAIT_V(8); PG8_WAIT_L(0); PG8_BAR; PG8_MMA(0, 0, At, B0); PG8_MMA(0, 1, At, B1); PG8_BAR; PG8_SCHED;
            PG8_LDA(At, 0, 1); PG8_STAGE(PG8_SB(0, 0), b2, voffB); PG8_STAGE(PG8_SB(0, 1), b2 + hstep, voffB); PG8_STAGE(PG8_SA(0, 0), a2, voffA);
            PG8_WAIT_V(8); PG8_WAIT_L(0); PG8_BAR; PG8_MMA(1, 0, At, B0); PG8_MMA(1, 1, At, B1); PG8_BAR; PG8_SCHED;
            PG8_LDB(B0, 1, 0); PG8_LDB(B1, 1, 1); PG8_SCHED; PG8_LDA(At, 1, 0); PG8_STAGE(PG8_SA(0, 1), a2 + hstep, voffA);
            PG8_WAIT_V(8); PG8_WAIT_L(0); PG8_BAR; PG8_MMA(0, 0, At, B0); PG8_MMA(0, 1, At, B1); PG8_BAR; PG8_SCHED;
            PG8_LDA(At, 1, 1); PG8_STAGE(PG8_SB(1, 0), b3, voffB); PG8_STAGE(PG8_SB(1, 1), b3 + hstep, voffB); PG8_STAGE(PG8_SA(1, 0), a3, voffA);
            PG8_WAIT_V(8); PG8_WAIT_L(0); PG8_BAR; PG8_MMA(1, 0, At, B0); PG8_MMA(1, 1, At, B1); PG8_BAR; PG8_SCHED;
            } else {
            PG8_LDB(B0, 0, 0); PG8_SCHED; PG8_LDA(At, 0, 0); PG8_STAGE(PG8_SA(1, 1), a1 + hstep, voffA);
            PG8_WAIT_L(8); PG8_BAR; PG8_WAIT_L(0); PG8_MMA(0, 0, At, B0); PG8_BAR; PG8_SCHED;
            PG8_LDB(B1, 0, 1); PG8_STAGE(PG8_SB(0, 0), b2, voffB);
            PG8_BAR; PG8_WAIT_L(0); PG8_MMA(0, 1, At, B1); PG8_BAR;
            PG8_LDA(At, 0, 1); PG8_STAGE(PG8_SA(0, 0), a2, voffA);
            PG8_BAR; PG8_WAIT_L(0); PG8_MMA(1, 0, At, B0); PG8_BAR; PG8_SCHED;
            PG8_STAGE(PG8_SB(0, 1), b2 + hstep, voffB);
            PG8_WAIT_V(6); PG8_BAR; PG8_MMA(1, 1, At, B1); PG8_BAR;
            PG8_LDB(B0, 1, 0); PG8_SCHED; PG8_LDA(At, 1, 0); PG8_STAGE(PG8_SA(0, 1), a2 + hstep, voffA);
            PG8_WAIT_L(8); PG8_BAR; PG8_WAIT_L(0); PG8_MMA(0, 0, At, B0); PG8_BAR; PG8_SCHED;
            PG8_LDB(B1, 1, 1); PG8_STAGE(PG8_SB(1, 0), b3, voffB);
            PG8_BAR; PG8_WAIT_L(0); PG8_MMA(0, 1, At, B1); PG8_BAR;
            PG8_LDA(At, 1, 1); PG8_STAGE(PG8_SA(1, 0), a3, voffA);
            PG8_BAR; PG8_WAIT_L(0); PG8_MMA(1, 0, At, B0); PG8_BAR; PG8_SCHED;
            PG8_STAGE(PG8_SB(1, 1), b3 + hstep, voffB);
            PG8_WAIT_V(6); PG8_BAR; PG8_MMA(1, 1, At, B1); PG8_BAR;
            }
        }
        if constexpr (ALIGN_EPI) { if (wr == 0) PG8_BAR; }
        if constexpr (!Epi::AFTER_DRAIN) { E(acc, cur, wr, wc, fr, fq); S.done(cur); }
        if (!has_next) break;
#pragma unroll
        for (int a = 0; a < 2; ++a)
#pragma unroll
            for (int b = 0; b < 2; ++b)
#pragma unroll
                for (int m = 0; m < 4; ++m)
#pragma unroll
                    for (int n = 0; n < 2; ++n) acc[a][b][m][n] = (f32x4){0.f, 0.f, 0.f, 0.f};
        cur = nxt; cA = nA; cB = nB; ++ui;
        if constexpr (ALIGN_EPI) { if (wr == 1) PG8_BAR; }
    }
    PG8_WAIT_V(0);
    if constexpr (!ALIGN_EPI) { if (wr == 0) PG8_BAR; }
    PG8_BAR;
    if constexpr (Epi::AFTER_DRAIN) { E.fused(acc, cur, wr, wc, fr, fq, lds, wid, lane); S.done(cur); }
#undef PG8_SA
#undef PG8_SB
#undef PG8_STAGE
#undef PG8_LDA
#undef PG8_LDB
#undef PG8_MMA
#undef PG8_WAIT_V
#undef PG8_WAIT_L
#undef PG8_BAR
#undef PG8_SCHED
}
}

constexpr int NB = 8, SEQ = 4096, DM = 1024, T = NB * SEQ;
constexpr int RW = 512, NHR = 8;
constexpr int NPROJ = 5376;
constexpr int FF = 512, NEXP = 32;
constexpr float C2 = 0.125f * 1.4426950408889634f;
constexpr float LAM_INIT = 0.2f;
constexpr int MAXROWS = 2 * T + NEXP * 256;

constexpr size_t MiB = 1u << 20;
constexpr size_t WS_CTL = 0, CTL_ZERO_BYTES = 1 * MiB;
constexpr size_t WS_WLORA = 1 * MiB;
constexpr size_t WS_WBRD = 2 * MiB;
constexpr size_t WS_WO = 4 * MiB;
constexpr size_t WS_WR = 6 * MiB;
constexpr size_t WS_WPG = 7 * MiB;
constexpr size_t WS_WPP = 9 * MiB;
constexpr size_t WS_TOKE = 10 * MiB;
constexpr size_t WS_TOKW = 10 * MiB + 256 * 1024;
constexpr size_t WS_POS = 10 * MiB + 512 * 1024;
constexpr size_t WS_ROWW = 10 * MiB + 768 * 1024;
constexpr size_t WS_TILECNT = 11 * MiB + 256 * 1024;
constexpr size_t WS_DISP = 11 * MiB + 512 * 1024;
constexpr size_t WS_BON = 12 * MiB;
constexpr size_t WS_WIN = 16 * MiB;
constexpr size_t WS_LOGITS = 16 * MiB;
constexpr size_t WS_XN = 32 * MiB;
constexpr size_t WS_WGU = 32 * MiB;
constexpr size_t WS_RKV = 96 * MiB;
constexpr size_t WS_MIXED = 96 * MiB;
constexpr size_t WS_WD = 96 * MiB;
constexpr size_t WS_HS = 128 * MiB;
constexpr size_t WS_H3 = 128 * MiB;
constexpr size_t WS_PROJB = 192 * MiB;
constexpr size_t WS_E = 192 * MiB;
constexpr size_t WS_A = 224 * MiB;
constexpr size_t WS_G = 256 * MiB;
constexpr size_t WS_P16 = 192 * MiB;
constexpr size_t WS_PP = 208 * MiB;
constexpr size_t WS_Y2 = 272 * MiB;
constexpr size_t WS_GATES = 304 * MiB;
constexpr size_t WS_H2X = 304 * MiB;
constexpr size_t WS_VT = 432 * MiB;
constexpr size_t WS_ACT = 432 * MiB;
constexpr size_t WS_X2 = 432 * MiB;
constexpr size_t WS_PART = 176 * MiB;
constexpr size_t WS_END = 512 * MiB;
constexpr size_t OUT_STASH = 0, OUT_ORWDF = 32 * MiB, OUT_Y = 96 * MiB  , OUT_LA = 0  ;
static_assert(WS_ACT + (size_t)MAXROWS * 512 * 2 <= WS_END && WS_Y2 + (size_t)MAXROWS * 1024 * 2 <= WS_ACT && WS_HS + (size_t)MAXROWS * 1024 * 2 <= WS_Y2, "ws map");
static_assert(WS_PART + (size_t)T * 1024 * 4 <= WS_GATES && WS_MIXED + (size_t)T * 1024 * 2 <= WS_PART, "ws map");
constexpr int CW_QUEUE = 64;
constexpr int CW_BAR = 4096;

constexpr int RING_BYTES = 131072;
constexpr int MISC_OFF = 158720;
constexpr int LDS_BYTES = 160768;
constexpr int NWAVES = 8, NTHR = 512;

#define GAS __attribute__((address_space(1)))
#define LAS __attribute__((address_space(3)))
typedef unsigned short bf16;
typedef unsigned v4u __attribute__((ext_vector_type(4)));
typedef unsigned v2u __attribute__((ext_vector_type(2)));
typedef float f32x4 __attribute__((ext_vector_type(4)));
typedef float f32x16 __attribute__((ext_vector_type(16)));
typedef short s16x8 __attribute__((ext_vector_type(8)));
typedef short s16x4 __attribute__((ext_vector_type(4)));
#define LDS_WAIT() asm volatile("s_waitcnt lgkmcnt(0)" ::: "memory")
#define VM_WAIT() asm volatile("s_waitcnt vmcnt(0)" ::: "memory")

__device__ __forceinline__ bf16* y_ptr(float* out, int b) { return (bf16*)((unsigned char*)out + OUT_Y) + (size_t)b * SEQ * 512; }
__device__ __forceinline__ bf16* qn_ptr(unsigned char* ws, int b) { return (bf16*)(ws + (b < 4 ? (288 + 4 * (size_t)b) * MiB : (464 + 4 * (size_t)(b - 4)) * MiB)); }
__device__ __forceinline__ bf16* kn_ptr(unsigned char* ws, int b) { return (bf16*)(ws + (480 + 4 * (size_t)b) * MiB); }
__device__ __forceinline__ unsigned f2bf(float f) { unsigned u = __builtin_bit_cast(unsigned, f); return (u + 0x7fffu + ((u >> 16) & 1u)) >> 16; }
typedef float f32x2_t __attribute__((ext_vector_type(2))); typedef __bf16 bf16x2_t __attribute__((ext_vector_type(2)));
__device__ __forceinline__ unsigned pk2(float lo, float hi) { f32x2_t v = {lo, hi}; bf16x2_t b = __builtin_convertvector(v, bf16x2_t); return __builtin_bit_cast(unsigned, b); }
__device__ __forceinline__ float bflo(unsigned w) { return __builtin_bit_cast(float, w << 16); }
__device__ __forceinline__ float bfhi(unsigned w) { return __builtin_bit_cast(float, w & 0xffff0000u); }
__device__ __forceinline__ float sigm(float x) { return __builtin_amdgcn_rcpf(1.0f + __builtin_amdgcn_exp2f(-1.4426950408889634f * x)); }
template <int CTRL> __device__ __forceinline__ float dpp_mov(float v) { return __builtin_bit_cast(float, __builtin_amdgcn_update_dpp(0, __builtin_bit_cast(int, v), CTRL, 0xF, 0xF, false)); }
__device__ __forceinline__ float red8(float v) { v += dpp_mov<0xB1>(v); v += dpp_mov<0x4E>(v); v += dpp_mov<0x141>(v); return v; }
__device__ __forceinline__ float red16(float v) { v = red8(v); v += dpp_mov<0x140>(v); return v; }
__device__ __forceinline__ void swap32(unsigned& a, unsigned& b) { asm volatile("s_nop 1\n\tv_permlane32_swap_b32 %0, %1\n\ts_nop 1" : "+v"(a), "+v"(b)); }
__device__ __forceinline__ float xhalf_max(float m) { unsigned a = __builtin_bit_cast(unsigned, m), b = a; swap32(a, b); return fmaxf(__builtin_bit_cast(float, a), __builtin_bit_cast(float, b)); }
__device__ __forceinline__ float xhalf_sum(float m) { unsigned a = __builtin_bit_cast(unsigned, m), b = a; swap32(a, b); return __builtin_bit_cast(float, a) + __builtin_bit_cast(float, b); }
__device__ __forceinline__ float wave_sum(float v) { v = red16(v); v += __shfl_xor(v, 16); return xhalf_sum(v); }

namespace pg8 {
struct EpiStore {
    static constexpr bool PERM = true, AFTER_DRAIN = false, HAS_MID = false;
    bf16_t* O; int ldc;
    __device__ __forceinline__ void operator()(const f32x4 (&acc)[2][2][4][2], const Unit& u, int wr, int wc, int fr, int fq) const {
        const int row0 = u.pm * BM + wr * 64 + fr, col0 = u.pn * BM + wc * 32 + 8 * fq;
#pragma unroll
        for (int ai = 0; ai < 2; ++ai)
#pragma unroll
            for (int m = 0; m < 4; ++m) { bf16_t* rowp = O + (size_t)(row0 + ai * HALF + m * 16) * ldc + col0;
#pragma unroll
                for (int bj = 0; bj < 2; ++bj) { const f32x4 v0 = acc[ai][bj][m][0], v1 = acc[ai][bj][m][1]; u32x4 w;
                    w.x = cvt_pk_bf16(v0[0], v0[1]); w.y = cvt_pk_bf16(v0[2], v0[3]); w.z = cvt_pk_bf16(v1[0], v1[1]); w.w = cvt_pk_bf16(v1[2], v1[3]);
                    *(u32x4*)(rowp + bj * HALF) = w; } }
    }
};
struct EpiProj {
    static constexpr bool PERM = true, AFTER_DRAIN = false, HAS_MID = false;
    bf16_t *rkv, *projb, *gates;
    __device__ __forceinline__ void operator()(const f32x4 (&acc)[2][2][4][2], const Unit& u, int wr, int wc, int fr, int fq) const {
        bf16_t* base; int ldc, ct;
        if (u.pn < 6) { base = rkv; ldc = 1536; ct = u.pn; } else if (u.pn < 11) { base = projb; ldc = 1280; ct = u.pn - 6; } else { base = gates; ldc = 2048; ct = u.pn - 13; }
        const int row0 = u.pm * BM + wr * 64 + fr, col0 = ct * BM + wc * 32 + 8 * fq;
#pragma unroll
        for (int ai = 0; ai < 2; ++ai)
#pragma unroll
            for (int m = 0; m < 4; ++m) { bf16_t* rowp = base + (size_t)(row0 + ai * HALF + m * 16) * ldc + col0;
#pragma unroll
                for (int bj = 0; bj < 2; ++bj) { f32x4 v0 = acc[ai][bj][m][0], v1 = acc[ai][bj][m][1]; u32x4 w;
                    if (u.pn >= 13) {
#pragma unroll
                        for (int e = 0; e < 4; ++e) { v0[e] = fmaxf(sigm(v0[e]), 1e-6f); v1[e] = fmaxf(sigm(v1[e]), 1e-6f); } }
                    w.x = cvt_pk_bf16(v0[0], v0[1]); w.y = cvt_pk_bf16(v0[2], v0[3]); w.z = cvt_pk_bf16(v1[0], v1[1]); w.w = cvt_pk_bf16(v1[2], v1[3]);
                    *(u32x4*)(rowp + bj * HALF) = w; } }
    }
};
struct EpiLora {
    static constexpr bool PERM = true, AFTER_DRAIN = false, HAS_MID = false;
    bf16_t *E, *A, *G; const float *w0, *a0;
    template <int KIND> __device__ __forceinline__ void body(const f32x4 (&acc)[2][2][4][2], bf16_t* base, const float* bias, int row0, int col0) const {
#pragma unroll
        for (int bj = 0; bj < 2; ++bj)
#pragma unroll
            for (int ai = 0; ai < 2; ++ai)
#pragma unroll
                for (int m = 0; m < 4; ++m) { bf16_t* rowp = base + (size_t)(row0 + ai * HALF + m * 16) * 512 + col0 + bj * HALF;
                    f32x4 v0 = acc[ai][bj][m][0], v1 = acc[ai][bj][m][1];
                    if (KIND < 2) { const f32x4 b0 = *(const f32x4*)(bias + col0 + bj * HALF), b1 = *(const f32x4*)(bias + col0 + bj * HALF + 4); const float sc = KIND == 0 ? 0.60653065971263342f : 1.0f;
                        v0 += b0; v1 += b1;
#pragma unroll
                        for (int e = 0; e < 4; ++e) { v0[e] = sc * sigm(v0[e]); v1[e] = sc * sigm(v1[e]); } }
                    u32x4 w; w.x = cvt_pk_bf16(v0[0], v0[1]); w.y = cvt_pk_bf16(v0[2], v0[3]); w.z = cvt_pk_bf16(v1[0], v1[1]); w.w = cvt_pk_bf16(v1[2], v1[3]);
                    *(u32x4*)rowp = w; asm volatile("" ::: "memory"); }
    }
    __device__ __forceinline__ void operator()(const f32x4 (&acc)[2][2][4][2], const Unit& u, int wr, int wc, int fr, int fq) const {
        const int kind = u.pn >> 1; const int row0 = u.pm * BM + wr * 64 + fr, col0 = (u.pn & 1) * BM + wc * 32 + 8 * fq;
        if (kind == 0) body<0>(acc, E, w0, row0, col0); else if (kind == 1) body<1>(acc, A, a0, row0, col0); else body<2>(acc, G, w0, row0, col0);
    }
};
struct EpiMix {
    static constexpr bool PERM = true, AFTER_DRAIN = false, HAS_MID = true;
    const bf16_t* gates; bf16_t* mixed;
    __device__ __forceinline__ void mid(f32x4 (&acc)[2][2][4][2], const Unit& u, int wr, int wc, int fr, int fq) const {
        const int row0 = u.pm * BM + wr * 64 + fr, col0 = u.pn * BM + wc * 32 + 8 * fq;
#pragma unroll
        for (int ai = 0; ai < 2; ++ai)
#pragma unroll
            for (int m = 0; m < 4; ++m) { const size_t r = (size_t)(row0 + ai * HALF + m * 16);
#pragma unroll
                for (int bj = 0; bj < 2; ++bj) { const int c = col0 + bj * HALF;
                    const u32x4 gr = *(const u32x4*)(gates + r * 2048 + c), gd = *(const u32x4*)(gates + r * 2048 + 1024 + c);
                    f32x4& v0 = acc[ai][bj][m][0]; f32x4& v1 = acc[ai][bj][m][1];
                    v0[0] *= bflo(gr.x) * __builtin_amdgcn_rcpf(bflo(gd.x)); v0[1] *= bfhi(gr.x) * __builtin_amdgcn_rcpf(bfhi(gd.x)); v0[2] *= bflo(gr.y) * __builtin_amdgcn_rcpf(bflo(gd.y)); v0[3] *= bfhi(gr.y) * __builtin_amdgcn_rcpf(bfhi(gd.y));
                    v1[0] *= bflo(gr.z) * __builtin_amdgcn_rcpf(bflo(gd.z)); v1[1] *= bfhi(gr.z) * __builtin_amdgcn_rcpf(bfhi(gd.z)); v1[2] *= bflo(gr.w) * __builtin_amdgcn_rcpf(bflo(gd.w)); v1[3] *= bfhi(gr.w) * __builtin_amdgcn_rcpf(bfhi(gd.w)); }
                asm volatile("" ::: "memory"); }
    }
    __device__ __forceinline__ void operator()(const f32x4 (&acc)[2][2][4][2], const Unit& u, int wr, int wc, int fr, int fq) const {
        const int row0 = u.pm * BM + wr * 64 + fr, col0 = u.pn * BM + wc * 32 + 8 * fq;
#pragma unroll
        for (int ai = 0; ai < 2; ++ai)
#pragma unroll
            for (int m = 0; m < 4; ++m) { const size_t r = (size_t)(row0 + ai * HALF + m * 16);
#pragma unroll
                for (int bj = 0; bj < 2; ++bj) { const int c = col0 + bj * HALF;
                    const u32x4 gd = *(const u32x4*)(gates + r * 2048 + 1024 + c);
                    f32x4 v0 = acc[ai][bj][m][0], v1 = acc[ai][bj][m][1];
                    v0[0] *= bflo(gd.x); v0[1] *= bfhi(gd.x); v0[2] *= bflo(gd.y); v0[3] *= bfhi(gd.y); v1[0] *= bflo(gd.z); v1[1] *= bfhi(gd.z); v1[2] *= bflo(gd.w); v1[3] *= bfhi(gd.w);
                    u32x4 w; w.x = cvt_pk_bf16(v0[0], v0[1]); w.y = cvt_pk_bf16(v0[2], v0[3]); w.z = cvt_pk_bf16(v1[0], v1[1]); w.w = cvt_pk_bf16(v1[2], v1[3]);
                    *(u32x4*)(mixed + r * 1024 + c) = w; } }
    }
};
struct EpiRes {
    static constexpr bool PERM = true, AFTER_DRAIN = false, HAS_MID = false;
    const float* x; bf16_t* x1;
    __device__ __forceinline__ void operator()(const f32x4 (&acc)[2][2][4][2], const Unit& u, int wr, int wc, int fr, int fq) const {
        const int row0 = u.pm * BM + wr * 64 + fr, col0 = u.pn * BM + wc * 32 + 8 * fq;
#pragma unroll
        for (int ai = 0; ai < 2; ++ai)
#pragma unroll
            for (int m = 0; m < 4; ++m) { const size_t off = (size_t)(row0 + ai * HALF + m * 16) * 1024 + col0;
#pragma unroll
                for (int bj = 0; bj < 2; ++bj) { const f32x4 v0 = *(const f32x4*)(x + off + bj * HALF) + acc[ai][bj][m][0], v1 = *(const f32x4*)(x + off + bj * HALF + 4) + acc[ai][bj][m][1]; u32x4 w;
                    w.x = cvt_pk_bf16(v0[0], v0[1]); w.y = cvt_pk_bf16(v0[2], v0[3]); w.z = cvt_pk_bf16(v1[0], v1[1]); w.w = cvt_pk_bf16(v1[2], v1[3]);
                    *(u32x4*)(x1 + off + bj * HALF) = w; } }
    }
};
struct EpiLogits {
    static constexpr bool PERM = false, AFTER_DRAIN = false, HAS_MID = false;
    float* L;
    __device__ __forceinline__ void operator()(const f32x4 (&acc)[2][2][4][2], const Unit& u, int wr, int wc, int fr, int fq) const {
        const int row0 = u.pm * BM + wr * 64 + fr, col0 = wc * 32 + 4 * fq;
#pragma unroll
        for (int ai = 0; ai < 2; ++ai)
#pragma unroll
            for (int m = 0; m < 4; ++m) { float* rowp = L + (size_t)(row0 + ai * HALF + m * 16) * 128 + col0;
#pragma unroll
                for (int n = 0; n < 2; ++n) *(f32x4*)(rowp + n * 16) = acc[ai][0][m][n]; }
    }
};
struct EpiAct {
    static constexpr bool PERM = true, AFTER_DRAIN = false, HAS_MID = false;
    bf16_t* act;
    __device__ __forceinline__ void operator()(const f32x4 (&acc)[2][2][4][2], const Unit& u, int wr, int wc, int fr, int fq) const {
        const int row0 = u.pm * BM + wr * 64 + fr, col0 = (u.pn & 3) * HALF + wc * 32 + 8 * fq;
#pragma unroll
        for (int ai = 0; ai < 2; ++ai)
#pragma unroll
            for (int m = 0; m < 4; ++m) { bf16_t* rowp = act + (size_t)(row0 + ai * HALF + m * 16) * 512 + col0; float o[8];
#pragma unroll
                for (int n = 0; n < 2; ++n)
#pragma unroll
                    for (int e = 0; e < 4; ++e) { const float g = acc[ai][0][m][n][e], up = acc[ai][1][m][n][e]; o[n * 4 + e] = g * sigm(g) * up; }
                u32x4 w; w.x = cvt_pk_bf16(o[0], o[1]); w.y = cvt_pk_bf16(o[2], o[3]); w.z = cvt_pk_bf16(o[4], o[5]); w.w = cvt_pk_bf16(o[6], o[7]);
                *(u32x4*)rowp = w; }
    }
};
struct EpiDown {
    static constexpr bool PERM = true, AFTER_DRAIN = false, HAS_MID = false;
    bf16_t* y2; const float* roww;
    __device__ __forceinline__ void operator()(const f32x4 (&acc)[2][2][4][2], const Unit& u, int wr, int wc, int fr, int fq) const {
        const int row0 = u.pm * BM + wr * 64 + fr, col0 = (u.pn & 3) * BM + wc * 32 + 8 * fq;
#pragma unroll
        for (int ai = 0; ai < 2; ++ai)
#pragma unroll
            for (int m = 0; m < 4; ++m) { const int r = row0 + ai * HALF + m * 16; const float w8 = roww[r]; bf16_t* rowp = y2 + (size_t)r * 1024 + col0;
#pragma unroll
                for (int bj = 0; bj < 2; ++bj) { const f32x4 v0 = acc[ai][bj][m][0] * w8, v1 = acc[ai][bj][m][1] * w8; u32x4 w;
                    w.x = cvt_pk_bf16(v0[0], v0[1]); w.y = cvt_pk_bf16(v0[2], v0[3]); w.z = cvt_pk_bf16(v1[0], v1[1]); w.w = cvt_pk_bf16(v1[2], v1[3]);
                    *(u32x4*)(rowp + bj * HALF) = w; } }
    }
};
struct EpiFinal {
    static constexpr bool PERM = true, AFTER_DRAIN = false, HAS_MID = false;
    const bf16_t* pp; const bf16_t* x2; float* out;
    __device__ __forceinline__ void operator()(const f32x4 (&acc)[2][2][4][2], const Unit& u, int wr, int wc, int fr, int fq) const {
        const int row0 = u.pm * BM + wr * 64 + fr, col0 = u.pn * BM + wc * 32 + 8 * fq;
#pragma unroll
        for (int ai = 0; ai < 2; ++ai)
#pragma unroll
            for (int m = 0; m < 4; ++m) { const size_t r = (size_t)(row0 + ai * HALF + m * 16);
#pragma unroll
                for (int bj = 0; bj < 2; ++bj) { const int c = col0 + bj * HALF;
                    const u32x4 pw = *(const u32x4*)(pp + r * 1024 + c), xw = *(const u32x4*)(x2 + r * 1024 + c); float* op = out + r * 1024 + c;
                    const f32x4 a0 = acc[ai][bj][m][0], a1 = acc[ai][bj][m][1]; f32x4 x0, x1;
                    x0[0] = bflo(xw.x) + sigm(a0[0]) * bflo(pw.x); x0[1] = bfhi(xw.x) + sigm(a0[1]) * bfhi(pw.x); x0[2] = bflo(xw.y) + sigm(a0[2]) * bflo(pw.y); x0[3] = bfhi(xw.y) + sigm(a0[3]) * bfhi(pw.y);
                    x1[0] = bflo(xw.z) + sigm(a1[0]) * bflo(pw.z); x1[1] = bfhi(xw.z) + sigm(a1[1]) * bfhi(pw.z); x1[2] = bflo(xw.w) + sigm(a1[2]) * bflo(pw.w); x1[3] = bfhi(xw.w) + sigm(a1[3]) * bfhi(pw.w);
                    *(f32x4*)op = x0; *(f32x4*)(op + 4) = x1; asm volatile("" ::: "memory"); } }
    }
};
struct EpiGates {
    static constexpr bool PERM = true, AFTER_DRAIN = false, HAS_MID = false;
    bf16_t* gates;
    __device__ __forceinline__ void operator()(const f32x4 (&acc)[2][2][4][2], const Unit& u, int wr, int wc, int fr, int fq) const {
        const int row0 = u.pm * BM + wr * 64 + fr, col0 = u.pn * BM + wc * 32 + 8 * fq;
#pragma unroll
        for (int ai = 0; ai < 2; ++ai)
#pragma unroll
            for (int m = 0; m < 4; ++m) { bf16_t* rowp = gates + (size_t)(row0 + ai * HALF + m * 16) * 2048 + col0;
#pragma unroll
                for (int bj = 0; bj < 2; ++bj) { f32x4 v0 = acc[ai][bj][m][0], v1 = acc[ai][bj][m][1]; u32x4 w;
#pragma unroll
                    for (int e = 0; e < 4; ++e) { v0[e] = fmaxf(sigm(v0[e]), 1e-6f); v1[e] = fmaxf(sigm(v1[e]), 1e-6f); }
                    w.x = cvt_pk_bf16(v0[0], v0[1]); w.y = cvt_pk_bf16(v0[2], v0[3]); w.z = cvt_pk_bf16(v1[0], v1[1]); w.w = cvt_pk_bf16(v1[2], v1[3]);
                    *(u32x4*)(rowp + bj * HALF) = w; } }
    }
};
struct OrderItem {
    int pm, pn0, n;
    __device__ __forceinline__ bool next(int i, Unit& u) const { if (i >= n) return false; u.pm = pm; u.pn = pn0 + i; return true; }
    __device__ __forceinline__ void a_ready(const Unit&) const {}
    __device__ __forceinline__ void done(const Unit&) const {}
};
struct OrderSkipV : StaticOrder {
    __device__ __forceinline__ bool next(int i, Unit& u) const { if (!StaticOrder::next(i, u)) return false; if (u.pn >= 11) u.pn += 2; return true; }
};
struct OrderPair : StaticOrder {
    __device__ __forceinline__ bool next(int i, Unit& u) const { if (!StaticOrder::next(i >> 1, u)) return false; if (i & 1) { u.pm += 128; u.pn += 4; } return true; }
};
struct OrderMoe {
    int nwg, G, c; const PG8_LAS int* tile_e;
    __device__ __forceinline__ bool next(int i, Unit& u) const { const long L = (long)i * G + c; if (L >= nwg) return false; const int rt = (int)(L >> 2); u.pm = rt; u.pn = tile_e[rt] * 4 + (int)(L & 3); return true; }
    __device__ __forceinline__ void a_ready(const Unit&) const {}
    __device__ __forceinline__ void done(const Unit&) const {}
};
}

struct Args { const float* in[36]; float* out; unsigned char* ws; int ph_lo, ph_hi; };

__device__ __forceinline__ void tr_item(const float* W, int N, bf16* WT, int ld, int k0, int n0, size_t dst_row0, int k_off, LAS float* scr, int lane) {
#pragma unroll 8
    for (int i = 0; i < 32; ++i) { const int kk = 2 * i + (lane >> 5); scr[kk * 33 + (lane & 31)] = W[(size_t)(k0 + kk) * N + n0 + (lane & 31)]; }
    LDS_WAIT(); asm volatile("" ::: "memory");
    const int c = lane & 7;
#pragma unroll
    for (int j = 0; j < 4; ++j) { const int n = (lane >> 3) + 8 * j; const LAS float* s = scr + (8 * c) * 33 + n;
        v4u o; o.x = pk2(s[0 * 33], s[1 * 33]); o.y = pk2(s[2 * 33], s[3 * 33]); o.z = pk2(s[4 * 33], s[5 * 33]); o.w = pk2(s[6 * 33], s[7 * 33]);
        *(v4u*)(WT + (dst_row0 + n) * ld + k_off + k0 + 8 * c) = o; }
    LDS_WAIT(); asm volatile("" ::: "memory");
}
__device__ __forceinline__ void tr_matrix(const float* W, int K, int N, bf16* WT, int ld, size_t dst_row0, int k_off, LAS float* scr, int lane, int gw, int NGW) {
    const int nblk = N / 32, nitems = (K / 64) * nblk;
    for (int it = gw; it < nitems; it += NGW) { const int kb = it / nblk, nb = it % nblk; tr_item(W, N, WT, ld, 64 * kb, 32 * nb, dst_row0 + 32 * nb, k_off, scr, lane); }
}
__device__ __forceinline__ void rms_row_to_bf16(const float* xrow, const float* gain, bf16* orow, int lane) {
    const f32x4* xr = (const f32x4*)xrow + lane; f32x4 v[4]; float s = 0.f;
#pragma unroll
    for (int j = 0; j < 4; ++j) { v[j] = xr[64 * j]; s += (v[j].x * v[j].x + v[j].y * v[j].y) + (v[j].z * v[j].z + v[j].w * v[j].w); }
    const float rstd = 1.0f / sqrtf(wave_sum(s) * (1.f / 1024.f) + 1e-6f);
    v2u* o8 = (v2u*)orow + lane;
#pragma unroll
    for (int j = 0; j < 4; ++j) { const f32x4 g = ((const f32x4*)gain)[lane + 64 * j]; v2u o; o.x = pk2(v[j].x * rstd * g.x, v[j].y * rstd * g.y); o.y = pk2(v[j].z * rstd * g.z, v[j].w * rstd * g.w); o8[64 * j] = o; }
}

__device__ __forceinline__ void phase0(const Args& a, LAS unsigned char* lds, int tid, int lane, int wave, int vcu, int G) {
    unsigned char* ws = a.ws;
    LAS float* scr = (LAS float*)(lds + wave * 16384);
    const int gw = vcu * NWAVES + wave, NGW = G * NWAVES; const int gt = vcu * NTHR + tid, NGT = G * NTHR;
    tr_matrix(a.in[3], 1024, NPROJ, (bf16*)(ws + WS_WIN), 1024, 0, 0, scr, lane, gw, NGW);
    tr_matrix(a.in[6], 64, 512, (bf16*)(ws + WS_WLORA), 256, 0, 0, scr, lane, gw, NGW);
    tr_matrix(a.in[8], 64, 512, (bf16*)(ws + WS_WLORA), 256, 512, 64, scr, lane, gw, NGW);
    tr_matrix(a.in[9], 128, 512, (bf16*)(ws + WS_WLORA), 256, 1024, 128, scr, lane, gw, NGW);
    tr_matrix(a.in[22], 512, 1024, (bf16*)(ws + WS_WBRD), 1024, 0, 0, scr, lane, gw, NGW);
    tr_matrix(a.in[23], 512, 1024, (bf16*)(ws + WS_WBRD), 1024, 0, 512, scr, lane, gw, NGW);
    tr_matrix(a.in[24], 1024, 1024, (bf16*)(ws + WS_WO), 1024, 0, 0, scr, lane, gw, NGW);
    tr_matrix(a.in[34], 1024, 1024, (bf16*)(ws + WS_WPG), 1024, 0, 0, scr, lane, gw, NGW);
    tr_matrix(a.in[35], 256, 1024, (bf16*)(ws + WS_WPP), 256, 0, 0, scr, lane, gw, NGW);
    { v4u* wl = (v4u*)(ws + WS_WLORA); const v4u z = (v4u){0u, 0u, 0u, 0u};
      for (int i = gt; i < 1536 * 32; i += NGT) { const int row = i >> 5, kc = (i & 31) * 8; const int blk = row >> 9;
          const bool diag = blk == 0 ? (kc < 64) : (blk == 1 ? (kc >= 64 && kc < 128) : (kc >= 128)); if (!diag) wl[i] = z; } }
    { bf16* wr = (bf16*)(ws + WS_WR); const float* wg = a.in[26]; const float* we = a.in[28];
      for (int i = gt; i < 256 * 1024; i += NGT) { const int row = i >> 10, kk = i & 1023; unsigned short v = 0;
          if (row < 36) v = (unsigned short)f2bf(row < 32 ? we[kk * 32 + row] : wg[kk * 4 + (row - 32)]);
          wr[(size_t)row * 1024 + kk] = v; } }
    for (int m = gw; m < T; m += NGW) rms_row_to_bf16(a.in[0] + (size_t)m * DM, a.in[2], (bf16*)(ws + WS_XN) + (size_t)m * DM, lane);
}

__device__ __forceinline__ void phase2(const Args& a, LAS unsigned char* lds, int tid, int vcu, int G) {
    unsigned char* ws = a.ws;
    const bf16* projb = (const bf16*)(ws + WS_PROJB); const float* mu = a.in[4];
    bf16* la = (bf16*)((unsigned char*)a.out + OUT_LA);
    LAS float* cs = (LAS float*)lds;
    for (int tile = vcu; tile < T / 64; tile += G) {
        const int t0 = tile * 64;
        __syncthreads();
#pragma unroll
        for (int i = 0; i < 4; ++i) { const int idx = tid + 512 * i, tok = idx >> 5, i32 = idx & 31; const int s = (t0 + tok) & (SEQ - 1);
            const float inv = exp2f(-(float)i32 * (13.287712379549449f / 32.0f)); const float ang = (float)s * inv;
            const float rev = ang * 0.15915494309189535f, fr = rev - floorf(rev);
            cs[(tok * 32 + i32) * 2] = __builtin_amdgcn_cosf(fr); cs[(tok * 32 + i32) * 2 + 1] = __builtin_amdgcn_sinf(fr); }
#pragma unroll
        for (int i = 0; i < 4; ++i) { const int idx = tid + 512 * i, tok = idx >> 5, ch = idx & 31, t = t0 + tok, j0 = ch * 8; const bool first = (t & (SEQ - 1)) == 0;
            const v4u cur = *(const v4u*)(projb + (size_t)t * 1280 + j0); v4u prv = (v4u){0u, 0u, 0u, 0u}; if (!first) prv = *(const v4u*)(projb + (size_t)(t - 1) * 1280 + j0);
            const f32x4 m0 = *(const f32x4*)(mu + 1536 + j0), m1 = *(const f32x4*)(mu + 1536 + j0 + 4);
            float x[8]; const unsigned cw[4] = {cur.x, cur.y, cur.z, cur.w}, pw[4] = {prv.x, prv.y, prv.z, prv.w}; const float mm[8] = {m0.x, m0.y, m0.z, m0.w, m1.x, m1.y, m1.z, m1.w};
#pragma unroll
            for (int e = 0; e < 4; ++e) { const float c0 = bflo(cw[e]), c1 = bfhi(cw[e]), p0 = bflo(pw[e]), p1 = bfhi(pw[e]); x[2 * e] = c0 + (p0 - c0) * mm[2 * e]; x[2 * e + 1] = c1 + (p1 - c1) * mm[2 * e + 1]; }
            if (ch < 8) {
#pragma unroll
                for (int e = 0; e < 8; ++e) x[e] = tanhf(x[e]);
            } else if (ch >= 16) {
#pragma unroll
                for (int e = 0; e < 8; ++e) x[e] = sigm(x[e]);
            }
            v4u o; o.x = pk2(x[0], x[1]); o.y = pk2(x[2], x[3]); o.z = pk2(x[4], x[5]); o.w = pk2(x[6], x[7]);
            *(v4u*)(la + (size_t)t * 256 + j0) = o; }
        __syncthreads();
        for (int i = 0; i < 16; ++i) { const int idx = tid + 512 * i, tok = idx >> 7, grp = (idx >> 3) & 15, l8 = idx & 7, t = t0 + tok;
            const bf16* src = projb + (size_t)t * 1280 + 256 + grp * 64 + l8 * 4;
            const v2u wl = *(const v2u*)src, wh = *(const v2u*)(src + 32);
            float xl[4] = {bflo(wl.x), bfhi(wl.x), bflo(wl.y), bfhi(wl.y)}, xh[4] = {bflo(wh.x), bfhi(wh.x), bflo(wh.y), bfhi(wh.y)};
            float ss = 0.f;
#pragma unroll
            for (int e = 0; e < 4; ++e) ss += xl[e] * xl[e] + xh[e] * xh[e];
            ss = red8(ss);
            const float rs = (1.0f / sqrtf(ss * (1.f / 64.f) + 1e-6f)) * (grp < 8 ? C2 : 1.f);
            const float* gn = (grp < 8 ? a.in[15] : a.in[16]) + l8 * 4;
            const f32x4 gl = *(const f32x4*)gn, gh = *(const f32x4*)(gn + 32);
            float ol[4], oh[4];
#pragma unroll
            for (int e = 0; e < 4; ++e) { const float yl = xl[e] * rs * gl[e], yh = xh[e] * rs * gh[e]; const int ci = (tok * 32 + l8 * 4 + e) * 2; const float c = cs[ci], sn = cs[ci + 1];
                ol[e] = yl * c - yh * sn; oh[e] = yh * c + yl * sn; }
            const int b = t >> 12, s = t & (SEQ - 1); bf16* dst = (grp < 8 ? qn_ptr(ws, b) : kn_ptr(ws, b)) + ((size_t)(grp & 7) * SEQ + s) * 64 + l8 * 4;
            *(v2u*)dst = (v2u){pk2(ol[0], ol[1]), pk2(ol[2], ol[3])}; *(v2u*)(dst + 32) = (v2u){pk2(oh[0], oh[1]), pk2(oh[2], oh[3])}; }
    }
}

constexpr int SC_NB = 32, SC_REC = 392;
constexpr int SC_BUF = SC_NB * SC_REC * 4;
constexpr int SC_YOFF = 2 * SC_BUF;
struct ScanIn { v2u r0, k0, v0, r1, k1, v1, e, av; };
__device__ __forceinline__ void scan_unit(const Args& a, LAS unsigned char* lds, int tid, int unit) {
    unsigned char* ws = a.ws;
    const int bh = unit >> 1, half = unit & 1, b = bh >> 3, hd = bh & 7;
    const bf16* rkv = (const bf16*)(ws + WS_RKV); const bf16* E = (const bf16*)(ws + WS_E); const bf16* Aa = (const bf16*)(ws + WS_A);
    float* bon = (float*)(ws + WS_BON); bf16* Y = y_ptr(a.out, b);
    const int st = tid >> 4, c4 = tid & 15, ch = hd * 64 + c4 * 4;
    const f32x4 mur = *(const f32x4*)(a.in[4] + ch), muk = *(const f32x4*)(a.in[4] + 512 + ch), muv = *(const f32x4*)(a.in[4] + 1024 + ch);
    const f32x4 kkw = *(const f32x4*)(a.in[10] + ch), kaw = *(const f32x4*)(a.in[11] + ch), rkw = *(const f32x4*)(a.in[12] + ch);
    f32x4 sA = (f32x4){0.f, 0.f, 0.f, 0.f};
    const size_t tb = (size_t)b * SEQ;
    auto load_batch = [&](int s0, ScanIn& L) {
        const size_t t = tb + s0 + st; const bool first = (s0 + st) == 0;
        L.r0 = *(const v2u*)(rkv + t * 1536 + ch); L.k0 = *(const v2u*)(rkv + t * 1536 + 512 + ch); L.v0 = *(const v2u*)(rkv + t * 1536 + 1024 + ch);
        const size_t tp = first ? t : t - 1;
        L.r1 = *(const v2u*)(rkv + tp * 1536 + ch); L.k1 = *(const v2u*)(rkv + tp * 1536 + 512 + ch); L.v1 = *(const v2u*)(rkv + tp * 1536 + 1024 + ch);
        if (first) { L.r1 = (v2u){0u, 0u}; L.k1 = L.r1; L.v1 = L.r1; }
        L.e = *(const v2u*)(E + t * 512 + ch); L.av = *(const v2u*)(Aa + t * 512 + ch);
    };
    auto convert = [&](const ScanIn& L, int buf, int s0) {
        const unsigned r0w[2] = {L.r0.x, L.r0.y}, r1w[2] = {L.r1.x, L.r1.y}, k0w[2] = {L.k0.x, L.k0.y}, k1w[2] = {L.k1.x, L.k1.y}, v0w[2] = {L.v0.x, L.v0.y}, v1w[2] = {L.v1.x, L.v1.y};
        const unsigned ew[2] = {L.e.x, L.e.y}, aw[2] = {L.av.x, L.av.y};
        float r[4], k[4], v[4], e[4], av[4], kk[4];
#pragma unroll
        for (int i = 0; i < 4; ++i) { const int w = i >> 1; const bool hi = i & 1;
            const float rc = hi ? bfhi(r0w[w]) : bflo(r0w[w]), rp = hi ? bfhi(r1w[w]) : bflo(r1w[w]);
            const float kc = hi ? bfhi(k0w[w]) : bflo(k0w[w]), kp = hi ? bfhi(k1w[w]) : bflo(k1w[w]);
            const float vc = hi ? bfhi(v0w[w]) : bflo(v0w[w]), vp = hi ? bfhi(v1w[w]) : bflo(v1w[w]);
            r[i] = rc + (rp - rc) * mur[i]; k[i] = kc + (kp - kc) * muk[i]; v[i] = vc + (vp - vc) * muv[i];
            e[i] = hi ? bfhi(ew[w]) : bflo(ew[w]); av[i] = hi ? bfhi(aw[w]) : bflo(aw[w]);
            kk[i] = k[i] * kkw[i]; }
        const float ss = red16(kk[0] * kk[0] + kk[1] * kk[1] + kk[2] * kk[2] + kk[3] * kk[3]);
        const float inv = 1.0f / fmaxf(sqrtf(ss), 1e-12f);
        f32x4 w4, aa4, bb4, km4, wr4, vv4; float br = 0.f, kr = 0.f, bo = 0.f;
#pragma unroll
        for (int i = 0; i < 4; ++i) { const float kki = kk[i] * inv; const float km = k[i] * (1.0f + (av[i] - 1.0f) * kaw[i]); const float w = __expf(-e[i]);
            w4[i] = w; aa4[i] = -kki; bb4[i] = kki * av[i]; km4[i] = km; wr4[i] = w * r[i]; vv4[i] = v[i];
            br += bb4[i] * r[i]; kr += km * r[i]; bo += r[i] * km * rkw[i]; }
        br = red16(br); kr = red16(kr); bo = red16(bo);
        LAS float* rec = (LAS float*)(lds + buf * SC_BUF) + st * SC_REC + c4 * 4;
        *(LAS f32x4*)(rec) = w4; *(LAS f32x4*)(rec + 64) = aa4; *(LAS f32x4*)(rec + 128) = bb4; *(LAS f32x4*)(rec + 192) = km4; *(LAS f32x4*)(rec + 256) = wr4; *(LAS f32x4*)(rec + 320) = vv4;
        if (c4 == 0) { rec[384] = br; rec[385] = kr; if (half == 0) bon[(tb + s0 + st) * 8 + hd] = bo; }
    };
    auto write_out = [&](int bi) {
        typedef float f32x2 __attribute__((ext_vector_type(2)));
        const LAS float* yp = (const LAS float*)(lds + SC_YOFF) + (bi & 1) * (SC_NB * 32) + st * 32 + c4 * 2;
        const f32x2 yv = *(const LAS f32x2*)yp; *(unsigned*)(Y + (size_t)(bi * SC_NB + st) * 512 + hd * 64 + 32 * half + 2 * c4) = pk2(yv[0], yv[1]); };
    constexpr int NBATCH = SEQ / SC_NB;
    ScanIn L; load_batch(0, L);
    __syncthreads();
    convert(L, 0, 0);
    load_batch(SC_NB, L);
    __syncthreads();
    for (int bi = 0; bi < NBATCH; ++bi) {
        const int cur = bi & 1;
        if (bi + 1 < NBATCH) convert(L, cur ^ 1, (bi + 1) * SC_NB);
        if (bi + 2 < NBATCH) load_batch((bi + 2) * SC_NB, L);
        if (bi > 0) write_out(bi - 1);
        LAS float* ybuf = (LAS float*)(lds + SC_YOFF) + cur * (SC_NB * 32);
        const LAS float* base = (const LAS float*)(lds + cur * SC_BUF) + c4 * 4;
        const LAS float* vbase = (const LAS float*)(lds + cur * SC_BUF) + 320 + 32 * half + st;
        const LAS float* sbase = (const LAS float*)(lds + cur * SC_BUF) + 384;
        f32x4 nw = *(const LAS f32x4*)(base), na = *(const LAS f32x4*)(base + 64), nb = *(const LAS f32x4*)(base + 128), nk = *(const LAS f32x4*)(base + 192), nq = *(const LAS f32x4*)(base + 256);
        float nvA = vbase[0]; typedef float f32x2 __attribute__((ext_vector_type(2))); f32x2 ns = *(const LAS f32x2*)(sbase);
        float ykA = 0.f;
#pragma unroll
        for (int i = 0; i < SC_NB; ++i) {
            const f32x4 w4 = nw, a4 = na, b4 = nb, k4 = nk, q4 = nq; const float vA = nvA, br = ns[0], kr = ns[1];
            if (i + 1 < SC_NB) { const LAS float* rec = base + (i + 1) * SC_REC;
                nw = *(const LAS f32x4*)(rec); na = *(const LAS f32x4*)(rec + 64); nb = *(const LAS f32x4*)(rec + 128); nk = *(const LAS f32x4*)(rec + 192); nq = *(const LAS f32x4*)(rec + 256);
                nvA = vbase[(i + 1) * SC_REC]; ns = *(const LAS f32x2*)(sbase + (i + 1) * SC_REC); }
            float saA = fmaf(sA[0], a4[0], fmaf(sA[1], a4[1], fmaf(sA[2], a4[2], sA[3] * a4[3])));
            float zA = fmaf(sA[0], q4[0], fmaf(sA[1], q4[1], fmaf(sA[2], q4[2], sA[3] * q4[3])));
            saA = red16(saA); zA = red16(zA);
            const float yA = zA + saA * br + vA * kr;
            ykA = (c4 == (i & 15)) ? yA : ykA;
            sA = sA * w4 + saA * b4 + vA * k4;
            if ((i & 15) == 15) ybuf[(i - 15 + c4) * 32 + st] = ykA;
        }
        __syncthreads();
    }
    write_out(NBATCH - 1);
}
namespace wkv {
constexpr int P = 144, PF = 272, U = 64 * P  , F = 64 * PF  ;
constexpr int O_S = 0, O_B = F;
constexpr int O_AT = O_B + 0 * U, O_BTL = O_B + 1 * U, O_KTL = O_B + 2 * U, O_RT = O_B + 3 * U, O_BHT = O_B + 4 * U, O_KHT = O_B + 5 * U, O_VRT = O_B + 6 * U, O_RHST = O_B + 7 * U  , O_MABH = O_B + 9 * U, O_MRB = O_B + 10 * U, O_MRK = O_B + 11 * U, O_Z2 = O_B + 12 * U;
constexpr int O_XT = O_AT  , O_G1 = O_MABH, O_Z1 = O_KTL, O_G2 = O_RHST  , O_EP = O_Z2  ;
constexpr int O_END = O_B + 13 * U;
constexpr int PO = 80, O_OUTB = O_END  , O_TII = O_OUTB + 8 * 16 * PO  , O_DIAG = O_TII + 4 * 16 * PO  , O_GC = O_DIAG + 4096  , O_CONST = O_GC + 256  , O_TOP = O_CONST + 1536;
static_assert(O_TOP <= 158720, "wkv LDS map");
typedef short bf16x8 __attribute__((ext_vector_type(8)));
__device__ __forceinline__ f32x4 mfma16(bf16x8 a, bf16x8 b, f32x4 c) { return __builtin_amdgcn_mfma_f32_16x16x32_bf16(a, b, c, 0, 0, 0); }
template <int K> __device__ __forceinline__ f32x4 mm_blk(LAS unsigned char* lds, int aoff, int pa, int boff, int pb, int m0, int n0, int lane, f32x4 acc) {
    const int r = lane & 15, kg = lane >> 4;
#pragma unroll
    for (int ks = 0; ks < K / 32; ++ks) { const bf16x8 a = *(const LAS bf16x8*)(lds + aoff + (m0 + r) * pa + (32 * ks + 8 * kg) * 2); const bf16x8 b = *(const LAS bf16x8*)(lds + boff + (n0 + r) * pb + (32 * ks + 8 * kg) * 2); acc = mfma16(a, b, acc); }
    return acc;
}
__device__ __forceinline__ void split8(const LAS float* p, bf16x8& hi, bf16x8& lo) {
    const f32x4 x0 = *(const LAS f32x4*)p, x1 = *(const LAS f32x4*)(p + 4); const float x[8] = {x0[0], x0[1], x0[2], x0[3], x1[0], x1[1], x1[2], x1[3]}; unsigned h[8], l[8];
#pragma unroll
    for (int i = 0; i < 8; ++i) { h[i] = f2bf(x[i]); l[i] = f2bf(x[i] - __builtin_bit_cast(float, h[i] << 16)); }
    hi = (bf16x8){(short)h[0], (short)h[1], (short)h[2], (short)h[3], (short)h[4], (short)h[5], (short)h[6], (short)h[7]}; lo = (bf16x8){(short)l[0], (short)l[1], (short)l[2], (short)l[3], (short)l[4], (short)l[5], (short)l[6], (short)l[7]};
}
__device__ __forceinline__ void st_bf(LAS unsigned char* lds, int off, float v) { *(LAS unsigned short*)(lds + off) = (unsigned short)f2bf(v); }
__device__ __forceinline__ float ld_bf(const LAS unsigned char* lds, int off) { return __builtin_bit_cast(float, (unsigned)*(const LAS unsigned short*)(lds + off) << 16); }
struct Raw { v4u r0, k0, v0, r1, k1, v1, e, av; };
}
__device__ __forceinline__ void st4_bf(LAS unsigned char* lds, int off, f32x4 v) { *(LAS v2u*)(lds + off) = (v2u){pk2(v[0], v[1]), pk2(v[2], v[3])}; }
__device__ __forceinline__ f32x4 ld4_bf(const LAS unsigned char* lds, int off) { const v2u w = *(const LAS v2u*)(lds + off); return (f32x4){bflo(w.x), bfhi(w.x), bflo(w.y), bfhi(w.y)}; }
__device__ __forceinline__ wkv::bf16x8 ident_frag(int n, int ks, int kg) { wkv::bf16x8 f; const int k0 = 32 * ks + 8 * kg;
#pragma unroll
    for (int j = 0; j < 8; ++j) f[j] = (k0 + j == n) ? (short)0x3F80 : (short)0; return f; }
__device__ __forceinline__ void scan_unit_chunked(const Args& a, LAS unsigned char* lds, int tid, int bh) {
    using namespace wkv;
    unsigned char* ws = a.ws;
    const int b = bh >> 3, hd = bh & 7, wave = __builtin_amdgcn_readfirstlane(tid >> 6);
    const bf16* rkv = (const bf16*)(ws + WS_RKV); const bf16* E = (const bf16*)(ws + WS_E); const bf16* Aa = (const bf16*)(ws + WS_A);
    float* bon = (float*)(ws + WS_BON); bf16* Y = y_ptr(a.out, b);
    const size_t tb = (size_t)b * SEQ;
    int oz = 0;
#define WKV_TAINT() asm volatile("" : "+v"(oz))
    const int gch = hd * 64 + (tid & 7) * 8;
    if (tid < 384) { const int vsel = tid >> 6, cc = tid & 63; const float* src = vsel == 0 ? a.in[4] : vsel == 1 ? a.in[4] + 512 : vsel == 2 ? a.in[4] + 1024 : vsel == 3 ? a.in[10] : vsel == 4 ? a.in[11] : a.in[12];
        ((LAS float*)(lds + O_CONST))[vsel * 64 + cc] = src[hd * 64 + cc]; }
    auto load_raw = [&](int c, Raw& L) { const int tt = tid >> 3; const size_t t = tb + c * 64 + tt; const bool first = (c * 64 + tt) == 0; const size_t tp = first ? t : t - 1;
        L.r0 = *(const v4u*)(rkv + t * 1536 + gch); L.k0 = *(const v4u*)(rkv + t * 1536 + 512 + gch); L.v0 = *(const v4u*)(rkv + t * 1536 + 1024 + gch);
        L.r1 = *(const v4u*)(rkv + tp * 1536 + gch); L.k1 = *(const v4u*)(rkv + tp * 1536 + 512 + gch); L.v1 = *(const v4u*)(rkv + tp * 1536 + 1024 + gch);
        if (first) { L.r1 = (v4u){0u, 0u, 0u, 0u}; L.k1 = L.r1; L.v1 = L.r1; }
        L.e = *(const v4u*)(E + t * 512 + gch); L.av = *(const v4u*)(Aa + t * 512 + gch); };
    const int mb = wave >> 1, nb0 = (wave & 1) * 2;
    WKV_TAINT();
#pragma unroll 1
    for (int i = tid + oz; i < 64 * 64; i += NTHR) *(LAS float*)(lds + O_S + (i >> 6) * PF + (i & 63) * 4) = 0.f;
#if defined(PROBE_PHASE) && PROBE_PHASE >= 300 && PROBE_PHASE < 310
    unsigned long long tlast = __builtin_amdgcn_s_memrealtime(); unsigned tacc[6] = {0u, 0u, 0u, 0u, 0u, 0u};
#define WKV_STAMP(k) do { const unsigned long long tn = __builtin_amdgcn_s_memrealtime(); tacc[k] += (unsigned)(tn - tlast); tlast = tn; } while (0)
#else
#define WKV_STAMP(k) do { } while (0)
#endif
    Raw L; load_raw(0, L);
    for (int c = 0; c < SEQ / 64; ++c) {
        __syncthreads();
        WKV_TAINT(); const int td0 = tid + oz, tt = td0 >> 3, kq = td0 & 7, ch0 = kq * 8;
        float e8[8], lr8[8], r8[8], k8[8], v8[8];
        { const unsigned ew[4] = {L.e.x, L.e.y, L.e.z, L.e.w}, aw[4] = {L.av.x, L.av.y, L.av.z, L.av.w};
          const unsigned r0[4] = {L.r0.x, L.r0.y, L.r0.z, L.r0.w}, r1[4] = {L.r1.x, L.r1.y, L.r1.z, L.r1.w}, k0[4] = {L.k0.x, L.k0.y, L.k0.z, L.k0.w}, k1[4] = {L.k1.x, L.k1.y, L.k1.z, L.k1.w}, v0[4] = {L.v0.x, L.v0.y, L.v0.z, L.v0.w}, v1[4] = {L.v1.x, L.v1.y, L.v1.z, L.v1.w};
#pragma unroll
          for (int i = 0; i < 8; ++i) { const int w = i >> 1; const bool hi = i & 1;
              e8[i] = hi ? bfhi(ew[w]) : bflo(ew[w]); lr8[i] = hi ? bfhi(aw[w]) : bflo(aw[w]);
              const float rc = hi ? bfhi(r0[w]) : bflo(r0[w]), rp = hi ? bfhi(r1[w]) : bflo(r1[w]), kc = hi ? bfhi(k0[w]) : bflo(k0[w]), kp = hi ? bfhi(k1[w]) : bflo(k1[w]), vc = hi ? bfhi(v0[w]) : bflo(v0[w]), vp = hi ? bfhi(v1[w]) : bflo(v1[w]);
              const LAS float* cst = (const LAS float*)(lds + O_CONST) + ch0 + i;
              r8[i] = rc + (rp - rc) * cst[0]; k8[i] = kc + (kp - kc) * cst[64]; v8[i] = vc + (vp - vc) * cst[128]; } }
        if (c + 1 < SEQ / 64) load_raw(c + 1, L);
        { LAS float* ep = (LAS float*)(lds + O_EP) + tt * 68 + ch0; *(LAS f32x4*)ep = (f32x4){e8[0], e8[1], e8[2], e8[3]}; *(LAS f32x4*)(ep + 4) = (f32x4){e8[4], e8[5], e8[6], e8[7]}; }
        __syncthreads();
        { const int k = td0 & 63, seg = td0 >> 6; LAS float* col = (LAS float*)(lds + O_EP) + (seg * 8) * 68 + k; float pre[8], run = 0.f;
#pragma unroll
          for (int i = 0; i < 8; ++i) { run += col[i * 68]; pre[i] = run; }
          LAS float* tots = (LAS float*)(lds + O_EP) + 64 * 68;
          tots[seg * 64 + k] = run;
          __syncthreads();
          float base = 0.f;
#pragma unroll
          for (int s2 = 0; s2 < 7; ++s2) base += (s2 < seg) ? tots[s2 * 64 + k] : 0.f;
#pragma unroll
          for (int i = 0; i < 8; ++i) col[i * 68] = pre[i] + base; }
        __syncthreads();
        float ce[8], cep[8], cec[8];
        { const LAS float* epb = (const LAS float*)(lds + O_EP);
          const f32x4 c0 = *(const LAS f32x4*)(epb + tt * 68 + ch0), c1 = *(const LAS f32x4*)(epb + tt * 68 + ch0 + 4);
          const int tq = tt > 0 ? tt - 1 : 0; f32x4 p0 = *(const LAS f32x4*)(epb + tq * 68 + ch0), p1 = *(const LAS f32x4*)(epb + tq * 68 + ch0 + 4); if (tt == 0) { p0 = (f32x4){0.f, 0.f, 0.f, 0.f}; p1 = p0; }
          const f32x4 q0 = *(const LAS f32x4*)(epb + 63 * 68 + ch0), q1 = *(const LAS f32x4*)(epb + 63 * 68 + ch0 + 4);
#pragma unroll
          for (int i = 0; i < 4; ++i) { ce[i] = c0[i]; ce[4 + i] = c1[i]; cep[i] = p0[i]; cep[4 + i] = p1[i]; cec[i] = q0[i]; cec[4 + i] = q1[i]; } }
        { float kk[8], ss = 0.f;
#pragma unroll
          for (int i = 0; i < 8; ++i) { kk[i] = k8[i] * ((const LAS float*)(lds + O_CONST))[192 + ch0 + i]; ss += kk[i] * kk[i]; }
          ss = red8(ss); const float inv = 1.0f / fmaxf(sqrtf(ss), 1e-12f);
          float at[8], bt[8], kt[8], rt[8], bh8[8], kh8[8], bo = 0.f;
#pragma unroll
          for (int i = 0; i < 8; ++i) { const float kaw_i = ((const LAS float*)(lds + O_CONST))[256 + ch0 + i], rkw_i = ((const LAS float*)(lds + O_CONST))[320 + ch0 + i];
              const float kki = kk[i] * inv, km = k8[i] * (1.0f + (lr8[i] - 1.0f) * kaw_i), bbv = kki * lr8[i];
              const float gp = __expf(-cep[i]), gi = __expf(ce[i]), gt = __expf(-ce[i]), gcj = __expf(ce[i] - cec[i]);
              at[i] = -kki * gp; bt[i] = bbv * gi; kt[i] = km * gi; rt[i] = r8[i] * gt; bh8[i] = bbv * gcj; kh8[i] = km * gcj; bo += r8[i] * km * rkw_i; }
          bo = red8(bo);
          if (kq == 0) bon[(tb + c * 64 + tt) * 8 + hd] = bo;
          if (tt == 63) { LAS float* gc = (LAS float*)(lds + O_GC) + ch0;
#pragma unroll
              for (int i = 0; i < 8; ++i) gc[i] = __expf(-cec[i]); }
          const int ro = tt * P + ch0 * 2;
          *(LAS v4u*)(lds + O_AT + ro) = (v4u){pk2(at[0], at[1]), pk2(at[2], at[3]), pk2(at[4], at[5]), pk2(at[6], at[7])};
          *(LAS v4u*)(lds + O_BTL + ro) = (v4u){pk2(bt[0], bt[1]), pk2(bt[2], bt[3]), pk2(bt[4], bt[5]), pk2(bt[6], bt[7])};
          *(LAS v4u*)(lds + O_KTL + ro) = (v4u){pk2(kt[0], kt[1]), pk2(kt[2], kt[3]), pk2(kt[4], kt[5]), pk2(kt[6], kt[7])};
          *(LAS v4u*)(lds + O_RT + ro) = (v4u){pk2(rt[0], rt[1]), pk2(rt[2], rt[3]), pk2(rt[4], rt[5]), pk2(rt[6], rt[7])};
          *(LAS v4u*)(lds + O_MABH + ro) = (v4u){pk2(bh8[0], bh8[1]), pk2(bh8[2], bh8[3]), pk2(bh8[4], bh8[5]), pk2(bh8[6], bh8[7])};
          *(LAS v4u*)(lds + O_MRB + ro) = (v4u){pk2(kh8[0], kh8[1]), pk2(kh8[2], kh8[3]), pk2(kh8[4], kh8[5]), pk2(kh8[6], kh8[7])};
          *(LAS v4u*)(lds + O_MRK + ro) = (v4u){pk2(v8[0], v8[1]), pk2(v8[2], v8[3]), pk2(v8[4], v8[5]), pk2(v8[6], v8[7])}; }
        __syncthreads();
        { WKV_TAINT(); const int lane = (tid & 63) + oz, c16 = lane & 15, rg = lane >> 4;
#pragma unroll
          for (int j = 0; j < 2; ++j) { const int nb = nb0 + j; f32x4 d0 = (f32x4){0.f, 0.f, 0.f, 0.f}, d1 = d0, d2 = d0, d3 = d0;
#pragma unroll
              for (int ks = 0; ks < 2; ++ks) { const bf16x8 idf = ident_frag(16 * nb + c16, ks, rg); const int ao = (16 * mb + c16) * P + (32 * ks + 8 * rg) * 2;
                  d0 = mfma16(*(const LAS bf16x8*)(lds + O_AT + ao), idf, d0); d1 = mfma16(*(const LAS bf16x8*)(lds + O_MABH + ao), idf, d1);
                  d2 = mfma16(*(const LAS bf16x8*)(lds + O_MRB + ao), idf, d2); d3 = mfma16(*(const LAS bf16x8*)(lds + O_MRK + ao), idf, d3); }
              const int to = (16 * nb + c16) * P + (16 * mb + 4 * rg) * 2;
              st4_bf(lds, O_RHST + to, d0); st4_bf(lds, O_BHT + to, d1); st4_bf(lds, O_KHT + to, d2); st4_bf(lds, O_VRT + to, d3); } }
        __syncthreads(); WKV_STAMP(0);
        { WKV_TAINT(); const int lane = (tid & 63) + oz, c16 = lane & 15, rg = lane >> 4; f32x4 acc[4][2];
#pragma unroll
          for (int j = 0; j < 2; ++j) { const int nb = nb0 + j; const f32x4 z = (f32x4){0.f, 0.f, 0.f, 0.f};
              acc[0][j] = mm_blk<64>(lds, O_BTL, P, O_AT, P, 16 * mb, 16 * nb, lane, z);
              acc[1][j] = mm_blk<64>(lds, O_AT, P, O_KTL, P, 16 * mb, 16 * nb, lane, z);
              acc[2][j] = mm_blk<64>(lds, O_BTL, P, O_RT, P, 16 * mb, 16 * nb, lane, z);
              acc[3][j] = mm_blk<64>(lds, O_KTL, P, O_RT, P, 16 * mb, 16 * nb, lane, z); }
#pragma unroll
          for (int j = 0; j < 2; ++j) { const int nb = nb0 + j, n = 16 * nb + c16, m0 = 16 * mb + 4 * rg; f32x4 mab, mak, mrb, mrk;
#pragma unroll
              for (int e = 0; e < 4; ++e) { const int m = m0 + e; mab[e] = m < n ? acc[0][j][e] : 0.f; mak[e] = n < m ? acc[1][j][e] : 0.f; mrb[e] = m <= n ? acc[2][j][e] : 0.f; mrk[e] = m <= n ? acc[3][j][e] : 0.f; }
              st4_bf(lds, O_MABH + n * P + m0 * 2, mab);
              if (mb == nb) *(LAS f32x4*)(lds + O_DIAG + ((mb * 16 + c16) * 16 + 4 * rg) * 4) = mab;
              st4_bf(lds, O_RHST + U + n * P + m0 * 2, mak);
              st4_bf(lds, O_MRB + n * P + m0 * 2, mrb); st4_bf(lds, O_MRK + n * P + m0 * 2, mrk); } }
        __syncthreads(); WKV_STAMP(1);
        WKV_TAINT();
        if (tid < 64) { const int td2 = tid + oz, blk = td2 >> 4, cc = td2 & 15; const LAS float* D = (const LAS float*)(lds + O_DIAG) + blk * 256; float Tc[16];
#pragma unroll
            for (int r4 = 0; r4 < 4; ++r4) { f32x4 dr[4][4];
#pragma unroll
                for (int rr = 0; rr < 4; ++rr)
#pragma unroll
                    for (int q = 0; q <= r4; ++q) dr[rr][q] = *(const LAS f32x4*)(D + (4 * r4 + rr) * 16 + 4 * q);
#pragma unroll
                for (int rr = 0; rr < 4; ++rr) { const int r = 4 * r4 + rr; float sacc = (r == cc) ? 1.f : 0.f;
#pragma unroll
                    for (int j = 0; j < r; ++j) sacc += dr[rr][j >> 2][j & 3] * Tc[j];
                    Tc[r] = sacc; } }
#pragma unroll
            for (int r4 = 0; r4 < 4; ++r4) { const f32x4 tv = (f32x4){Tc[4 * r4], Tc[4 * r4 + 1], Tc[4 * r4 + 2], Tc[4 * r4 + 3]};
                (void)tv; }
#pragma unroll
            for (int r = 0; r < 16; ++r) { st_bf(lds, O_TII + (blk * 16 + r) * PO + cc * 2, Tc[r]); st_bf(lds, O_TII + (blk * 16 + r) * PO + (16 + cc) * 2, 0.f); } }
        { const int lane = (tid & 63) + oz; const v4u z = (v4u){0u, 0u, 0u, 0u};
#pragma unroll
          for (int i = 0; i < 3; ++i) { const int idx = lane + 64 * i; if (idx < 16 * 9) *(LAS v4u*)(lds + O_XT + (16 * wave + idx / 9) * P + (idx % 9) * 16) = z; }
          if (lane < 32) *(LAS v4u*)(lds + O_OUTB + wave * 16 * PO + (lane >> 1) * PO + 32 + (lane & 1) * 16) = z; }
        __syncthreads(); WKV_STAMP(2);
#pragma unroll 1
        for (int i = 0; i < 4; ++i) { WKV_TAINT(); const int lane = (tid & 63) + oz, c16 = lane & 15, rg = lane >> 4;
            f32x4 acc = (f32x4){0.f, 0.f, 0.f, 0.f};
            if (i > 0) acc = mm_blk<64>(lds, O_MABH, P, O_XT, P, 16 * i, 16 * wave, lane, acc);
            acc += ld4_bf(lds, O_RHST + (16 * wave + c16) * P + (16 * i + 4 * rg) * 2);
            st4_bf(lds, O_OUTB + wave * 16 * PO + c16 * PO + (4 * rg) * 2, acc);
            LDS_WAIT();
            f32x4 x = mm_blk<32>(lds, O_TII + i * 16 * PO, PO, O_OUTB + wave * 16 * PO, PO, 0, 0, lane, (f32x4){0.f, 0.f, 0.f, 0.f});
            st4_bf(lds, O_XT + (16 * wave + c16) * P + (16 * i + 4 * rg) * 2, x);
            LDS_WAIT();
        }
        __syncthreads(); WKV_STAMP(3);
        { WKV_TAINT(); const int lane = (tid & 63) + oz, c16 = lane & 15, rg = lane >> 4; f32x4 acc[4][2];
#pragma unroll
          for (int j = 0; j < 2; ++j) { const int nb = nb0 + j; const f32x4 z = (f32x4){0.f, 0.f, 0.f, 0.f};
              acc[0][j] = mm_blk<64>(lds, O_XT, P, O_MRB, P, 16 * mb, 16 * nb, lane, z);
              acc[1][j] = mm_blk<64>(lds, O_XT + U, P, O_MRB, P, 16 * mb, 16 * nb, lane, z);
              acc[2][j] = mm_blk<64>(lds, O_XT, P, O_BHT, P, 16 * mb, 16 * nb, lane, z);
              acc[3][j] = mm_blk<64>(lds, O_XT + U, P, O_BHT, P, 16 * mb, 16 * nb, lane, z); }
#pragma unroll
          for (int j = 0; j < 2; ++j) { const int n = 16 * (nb0 + j) + c16, m0 = 16 * mb + 4 * rg; const int o = n * P + m0 * 2;
              acc[0][j] += ld4_bf(lds, O_RT + o); acc[1][j] += ld4_bf(lds, O_MRK + o); acc[3][j] += ld4_bf(lds, O_KHT + o);
              if (n >= m0 && n < m0 + 4) acc[2][j][n - m0] += *(const LAS float*)(lds + O_GC + n * 4); }
          __syncthreads();
#pragma unroll
          for (int j = 0; j < 2; ++j) { const int n = 16 * (nb0 + j) + c16, m0 = 16 * mb + 4 * rg; const int o = n * P + m0 * 2;
              st4_bf(lds, O_G1 + o, acc[0][j]); st4_bf(lds, O_Z1 + o, acc[1][j]); st4_bf(lds, O_Z2 + o, acc[3][j]);
              f32x4 hi4, lo4;
#pragma unroll
              for (int e = 0; e < 4; ++e) { hi4[e] = __builtin_bit_cast(float, f2bf(acc[2][j][e]) << 16); lo4[e] = acc[2][j][e] - hi4[e]; }
              st4_bf(lds, O_RT + o, hi4); st4_bf(lds, O_KHT + o, lo4); } }
        { WKV_TAINT(); const int td5 = tid + oz, v = td5 >> 3, kq5 = (td5 & 7) * 8; const LAS float* sp = (const LAS float*)(lds + O_S + v * PF) + kq5;
          const f32x4 x0 = *(const LAS f32x4*)sp, x1 = *(const LAS f32x4*)(sp + 4); f32x4 h0, h1, l0, l1;
#pragma unroll
          for (int e = 0; e < 4; ++e) { h0[e] = __builtin_bit_cast(float, f2bf(x0[e]) << 16); l0[e] = x0[e] - h0[e]; h1[e] = __builtin_bit_cast(float, f2bf(x1[e]) << 16); l1[e] = x1[e] - h1[e]; }
          st4_bf(lds, O_MRB + v * P + kq5 * 2, h0); st4_bf(lds, O_MRB + v * P + kq5 * 2 + 8, h1); st4_bf(lds, O_MRK + v * P + kq5 * 2, l0); st4_bf(lds, O_MRK + v * P + kq5 * 2 + 8, l1); }
        __syncthreads(); WKV_STAMP(4);
        { WKV_TAINT(); const int lane = (tid & 63) + oz, c16 = lane & 15, rg = lane >> 4; f32x4 ay[2], as[2];
#pragma unroll
          for (int j = 0; j < 2; ++j) { const int nb = nb0 + j; const f32x4 z = (f32x4){0.f, 0.f, 0.f, 0.f};
              ay[j] = mm_blk<64>(lds, O_VRT, P, O_Z1, P, 16 * mb, 16 * nb, lane, z);
              ay[j] = mm_blk<64>(lds, O_MRB, P, O_G1, P, 16 * mb, 16 * nb, lane, ay[j]);
              ay[j] = mm_blk<64>(lds, O_MRK, P, O_G1, P, 16 * mb, 16 * nb, lane, ay[j]);
              as[j] = mm_blk<64>(lds, O_Z2, P, O_VRT, P, 16 * mb, 16 * nb, lane, z);
              as[j] = mm_blk<64>(lds, O_RT, P, O_MRB, P, 16 * mb, 16 * nb, lane, as[j]);
              as[j] = mm_blk<64>(lds, O_KHT, P, O_MRB, P, 16 * mb, 16 * nb, lane, as[j]);
              as[j] = mm_blk<64>(lds, O_RT, P, O_MRK, P, 16 * mb, 16 * nb, lane, as[j]); }
#pragma unroll
          for (int j = 0; j < 2; ++j) { const int t = 16 * (nb0 + j) + c16, v0 = 16 * mb + 4 * rg;
              *(v2u*)(Y + (size_t)(c * 64 + t) * 512 + hd * 64 + v0) = (v2u){pk2(ay[j][0], ay[j][1]), pk2(ay[j][2], ay[j][3])};
              *(LAS f32x4*)(lds + O_S + t * PF + v0 * 4) = as[j]; } }
        WKV_STAMP(5);
    }
#if defined(PROBE_PHASE) && PROBE_PHASE >= 300 && PROBE_PHASE < 310
    if (tid == 0) atomicAdd((unsigned*)(ws + WS_CTL) + 96, tacc[PROBE_PHASE - 300]);
#endif
}
__device__ __forceinline__ void phase_orw(const Args& a, int lane, int wave, int vcu, int G) {
    unsigned char* ws = a.ws;
    const int gw = vcu * NWAVES + wave, NGW = G * NWAVES;
    const bf16* rkv = (const bf16*)(ws + WS_RKV); const bf16* Gg = (const bf16*)(ws + WS_G); const float* bon = (const float*)(ws + WS_BON);
    bf16* orw = (bf16*)((unsigned char*)a.out + OUT_ORWDF);
    const int ch = lane * 8;
    const f32x4 mv0 = *(const f32x4*)(a.in[4] + 1024 + ch), mv1 = *(const f32x4*)(a.in[4] + 1024 + ch + 4);
    const f32x4 lw0 = *(const f32x4*)(a.in[13] + ch), lw1 = *(const f32x4*)(a.in[13] + ch + 4), lb0 = *(const f32x4*)(a.in[14] + ch), lb1 = *(const f32x4*)(a.in[14] + ch + 4);
    const float muv[8] = {mv0[0], mv0[1], mv0[2], mv0[3], mv1[0], mv1[1], mv1[2], mv1[3]}, lnw[8] = {lw0[0], lw0[1], lw0[2], lw0[3], lw1[0], lw1[1], lw1[2], lw1[3]}, lnb[8] = {lb0[0], lb0[1], lb0[2], lb0[3], lb1[0], lb1[1], lb1[2], lb1[3]};
    for (int t = gw; t < T; t += NGW) {
        const int b = t >> 12, s = t & (SEQ - 1); const v4u yw = *(const v4u*)(y_ptr(a.out, b) + (size_t)s * 512 + ch);
        const f32x4 y0 = (f32x4){bflo(yw.x), bfhi(yw.x), bflo(yw.y), bfhi(yw.y)}, y1 = (f32x4){bflo(yw.z), bfhi(yw.z), bflo(yw.w), bfhi(yw.w)};
        const v4u vc = *(const v4u*)(rkv + (size_t)t * 1536 + 1024 + ch); v4u vp = (v4u){0u, 0u, 0u, 0u}; if (s != 0) vp = *(const v4u*)(rkv + (size_t)(t - 1) * 1536 + 1024 + ch);
        const v4u gw4 = *(const v4u*)(Gg + (size_t)t * 512 + ch); const float bo = bon[(size_t)t * 8 + (lane >> 3)];
        float y[8] = {y0[0], y0[1], y0[2], y0[3], y1[0], y1[1], y1[2], y1[3]};
        float sm = 0.f;
#pragma unroll
        for (int e = 0; e < 8; ++e) sm += y[e];
        const float mean = red8(sm) * (1.f / 64.f); float vs = 0.f;
#pragma unroll
        for (int e = 0; e < 8; ++e) { y[e] -= mean; vs += y[e] * y[e]; }
        const float rstd = 1.0f / sqrtf(red8(vs) * (1.f / 64.f) + 64e-5f);
        const unsigned vcw[4] = {vc.x, vc.y, vc.z, vc.w}, vpw[4] = {vp.x, vp.y, vp.z, vp.w}, gww[4] = {gw4.x, gw4.y, gw4.z, gw4.w}; float o[8];
#pragma unroll
        for (int e = 0; e < 8; ++e) { const int w = e >> 1; const bool hi = e & 1; const float c = hi ? bfhi(vcw[w]) : bflo(vcw[w]), p = hi ? bfhi(vpw[w]) : bflo(vpw[w]), g = hi ? bfhi(gww[w]) : bflo(gww[w]);
            const float v = c + (p - c) * muv[e]; o[e] = ((y[e] * rstd * lnw[e] + lnb[e]) + bo * v) * g; }
        v4u ov; ov.x = pk2(o[0], o[1]); ov.y = pk2(o[2], o[3]); ov.z = pk2(o[4], o[5]); ov.w = pk2(o[6], o[7]);
        *(v4u*)(orw + (size_t)t * 1024 + ch) = ov;
    }
}

__device__ __forceinline__ int crow(int r, int hi) { return (r & 3) + 8 * (r >> 2) + 4 * hi; }
constexpr int AT_BUF = 24576;
__device__ __forceinline__ int at_addr(int row, int ch) { return row * 128 + ((ch ^ ((row >> 1) & 7)) << 4); }
__device__ __forceinline__ void attn_pass(const bf16* qn, const bf16* kn, const bf16* vt, int b, int head, int c, int qb, LAS unsigned char* lds, int tid, f32x16 (&o)[4]) {
    const int lane = tid & 63, wave = __builtin_amdgcn_readfirstlane(tid >> 6), r32 = lane & 31, hi = lane >> 5;
    const int vh = b * 8 + head * 2 + c; const int q0 = qb * 256, qw0 = q0 + wave * 32, qrow = qw0 + r32;
    const bf16* Qp = qn + ((size_t)(vh & 7) * SEQ + qrow) * 64;
    s16x8 qf[4];
#pragma unroll
    for (int ks = 0; ks < 4; ++ks) qf[ks] = *(const s16x8*)(Qp + 16 * ks + 8 * hi);
    const int k_row = tid >> 3, k_ch = tid & 7;
    const bf16* ksrc = kn + (size_t)(vh & 7) * SEQ * 64 + k_row * 64 + k_ch * 8; const int kdst = at_addr(k_row, k_ch);
    const int dv0 = tid >> 3, dv1 = 64 + (tid >> 3);
    const bf16* vsrc0 = vt + (size_t)(head * 128 + dv0) * T + (size_t)b * SEQ + k_ch * 8; const bf16* vsrc1 = vsrc0 + (size_t)64 * T;
    const int vdst0 = 8192 + at_addr(dv0, k_ch), vdst1 = 8192 + at_addr(dv1, k_ch); const bool vsw0 = (dv0 & 16) != 0, vsw1 = (dv1 & 16) != 0;
    const int NT = 4 * qb + 4;
    v4u kreg = *(const v4u*)ksrc, vreg0 = *(const v4u*)vsrc0, vreg1 = *(const v4u*)vsrc1;
    __syncthreads();
    *(LAS v4u*)(lds + kdst) = kreg; *(LAS v4u*)(lds + vdst0) = vsw0 ? (v4u){vreg0.z, vreg0.w, vreg0.x, vreg0.y} : vreg0; *(LAS v4u*)(lds + vdst1) = vsw1 ? (v4u){vreg1.z, vreg1.w, vreg1.x, vreg1.y} : vreg1;
    __syncthreads();
    float m = -1e30f, l = 0.f;
#pragma unroll
    for (int db = 0; db < 4; ++db)
#pragma unroll
        for (int i = 0; i < 16; ++i) o[db][i] = 0.f;
    for (int j = 0; j < NT; ++j) {
        const int cur = (j & 1) * AT_BUF, nxt = AT_BUF - cur; const bool more = j + 1 < NT;
        if (more) { kreg = *(const v4u*)(ksrc + (size_t)(j + 1) * 64 * 64); vreg0 = *(const v4u*)(vsrc0 + (j + 1) * 64); vreg1 = *(const v4u*)(vsrc1 + (j + 1) * 64); }
        const int kv0 = j * 64;
        if (kv0 <= qw0 + 31) {
            f32x16 s0, s1;
#pragma unroll
            for (int i = 0; i < 16; ++i) { s0[i] = 0.f; s1[i] = 0.f; }
            __builtin_amdgcn_s_setprio(1);
#pragma unroll
            for (int ks = 0; ks < 4; ++ks) {
                const s16x8 a0 = *(const LAS s16x8*)(lds + cur + at_addr(r32, 2 * ks + hi));
                const s16x8 a1 = *(const LAS s16x8*)(lds + cur + at_addr(32 + r32, 2 * ks + hi));
                s0 = __builtin_amdgcn_mfma_f32_32x32x16_bf16(a0, qf[ks], s0, 0, 0, 0);
                s1 = __builtin_amdgcn_mfma_f32_32x32x16_bf16(a1, qf[ks], s1, 0, 0, 0);
            }
            __builtin_amdgcn_s_setprio(0);
            if (kv0 + 63 > qw0) {
#pragma unroll
                for (int i = 0; i < 16; ++i) { const int kv = kv0 + crow(i, hi); if (kv > qrow) s0[i] = -1e30f; if (kv + 32 > qrow) s1[i] = -1e30f; }
            }
            float rm = fmaxf(s0[0], s1[0]);
#pragma unroll
            for (int i = 1; i < 16; ++i) rm = fmaxf(rm, fmaxf(s0[i], s1[i]));
            rm = xhalf_max(rm);
            const float mn = fmaxf(m, rm); const float f = __builtin_amdgcn_exp2f(m - mn); m = mn;
            float ps = 0.f;
#pragma unroll
            for (int i = 0; i < 16; ++i) { s0[i] = __builtin_amdgcn_exp2f(s0[i] - mn); s1[i] = __builtin_amdgcn_exp2f(s1[i] - mn); ps += s0[i] + s1[i]; }
            l = l * f + ps;
            if (__any(f != 1.0f)) {
#pragma unroll
                for (int db = 0; db < 4; ++db)
#pragma unroll
                    for (int i = 0; i < 16; ++i) o[db][i] *= f;
            }
            v4u pw[4];
            pw[0] = (v4u){pk2(s0[0], s0[1]), pk2(s0[2], s0[3]), pk2(s0[4], s0[5]), pk2(s0[6], s0[7])};
            pw[1] = (v4u){pk2(s0[8], s0[9]), pk2(s0[10], s0[11]), pk2(s0[12], s0[13]), pk2(s0[14], s0[15])};
            pw[2] = (v4u){pk2(s1[0], s1[1]), pk2(s1[2], s1[3]), pk2(s1[4], s1[5]), pk2(s1[6], s1[7])};
            pw[3] = (v4u){pk2(s1[8], s1[9]), pk2(s1[10], s1[11]), pk2(s1[12], s1[13]), pk2(s1[14], s1[15])};
#pragma unroll
            for (int db = 0; db < 4; ++db) { const int dv = 32 * db + r32; const int vb = cur + 8192 + dv * 128 + 8 * (hi ^ ((dv >> 4) & 1)), sw = (dv >> 1) & 7;
#pragma unroll
                for (int s4 = 0; s4 < 4; ++s4) {
                    const s16x4 lo = *(const LAS s16x4*)(lds + vb + (((2 * s4) ^ sw) << 4));
                    const s16x4 hh = *(const LAS s16x4*)(lds + vb + (((2 * s4 + 1) ^ sw) << 4));
                    const s16x8 av = (s16x8){lo[0], lo[1], lo[2], lo[3], hh[0], hh[1], hh[2], hh[3]};
                    o[db] = __builtin_amdgcn_mfma_f32_32x32x16_bf16(av, __builtin_bit_cast(s16x8, pw[s4]), o[db], 0, 0, 0);
                }
                __builtin_amdgcn_sched_barrier(0); }
        }
        if (more) { *(LAS v4u*)(lds + nxt + kdst) = kreg; *(LAS v4u*)(lds + nxt + vdst0) = vsw0 ? (v4u){vreg0.z, vreg0.w, vreg0.x, vreg0.y} : vreg0; *(LAS v4u*)(lds + nxt + vdst1) = vsw1 ? (v4u){vreg1.z, vreg1.w, vreg1.x, vreg1.y} : vreg1; }
        __syncthreads();
    }
    l = xhalf_sum(l);
    const float il = 1.0f / l;
#pragma unroll
    for (int db = 0; db < 4; ++db)
#pragma unroll
        for (int i = 0; i < 16; ++i) o[db][i] *= il;
}
__device__ __forceinline__ void attn_unit(const Args& a, LAS unsigned char* lds, int tid, int b, int head, int qb, float* stash  ) {
    unsigned char* ws = a.ws;
    const bf16* qn = qn_ptr(ws, b); const bf16* kn = kn_ptr(ws, b); const bf16* vt = (const bf16*)(ws + WS_VT);
    bf16* odf = (bf16*)((unsigned char*)a.out + OUT_ORWDF) + 512;
    const int lane = tid & 63, wave = tid >> 6, r32 = lane & 31, hi = lane >> 5;
    int oz = 0; asm volatile("" : "+v"(oz)); const int ll = lane + oz;
    const float d1 = wave_sum(a.in[17][ll] * a.in[18][ll]), d2 = wave_sum(a.in[19][ll] * a.in[20][ll]);
    const float lam = __expf(d1) - __expf(d2) + LAM_INIT;
    f32x16 o[4];
    attn_pass(qn, kn, vt, b, head, 0, qb, lds, tid, o);
    float* st = stash + tid * 64;
#pragma unroll
    for (int db = 0; db < 4; ++db)
#pragma unroll
        for (int g = 0; g < 4; ++g) *(f32x4*)(st + db * 16 + g * 4) = (f32x4){o[db][4 * g], o[db][4 * g + 1], o[db][4 * g + 2], o[db][4 * g + 3]};
#if defined(PROBE_PHASE) && PROBE_PHASE == 215
    if (head == 0) { bf16* dbg = (bf16*)(ws + 496 * MiB); const size_t tq = (size_t)b * SEQ + qb * 256 + wave * 32 + r32;
#pragma unroll
        for (int db = 0; db < 4; ++db)
#pragma unroll
            for (int g = 0; g < 4; ++g) { const int dv = 32 * db + 8 * g + 4 * hi; v2u ov; ov.x = pk2(o[db][4 * g], o[db][4 * g + 1]); ov.y = pk2(o[db][4 * g + 2], o[db][4 * g + 3]); *(v2u*)(dbg + tq * 128 + dv) = ov; } }
#endif
    attn_pass(qn, kn, vt, b, head, 1, qb, lds, tid, o);
    float ss = 0.f;
#pragma unroll
    for (int db = 0; db < 4; ++db)
#pragma unroll
        for (int g = 0; g < 4; ++g) { const f32x4 s4 = *(const f32x4*)(st + db * 16 + g * 4);
#pragma unroll
            for (int e = 0; e < 4; ++e) { const float d = s4[e] - lam * o[db][4 * g + e]; o[db][4 * g + e] = d; ss += d * d; } }
    ss = xhalf_sum(ss);
    const float rs = (1.0f / sqrtf(ss * (1.f / 128.f) + 1e-6f)) * (1.0f - LAM_INIT);
    const size_t t = (size_t)b * SEQ + qb * 256 + wave * 32 + r32; const float* sw = a.in[21];
#pragma unroll
    for (int db = 0; db < 4; ++db)
#pragma unroll
        for (int g = 0; g < 4; ++g) { const int dv = 32 * db + 8 * g + 4 * hi; const f32x4 w4 = *(const f32x4*)(sw + dv);
            v2u ov; ov.x = pk2(o[db][4 * g] * rs * w4[0], o[db][4 * g + 1] * rs * w4[1]); ov.y = pk2(o[db][4 * g + 2] * rs * w4[2], o[db][4 * g + 3] * rs * w4[3]);
            *(v2u*)(odf + t * 1024 + head * 128 + dv) = ov; }
}
#define XB_TMO      128
#define XB_XCNT(j)  (256  + 64 * (j))
#define XB_XSUB(j)  (1280 + 64 * (j))
#define XB_XGEN(j)  (2304 + 64 * (j))
#define XB_TOP      3328
#define XB_TOPGEN   3392
#define XCD_BAR_WORDS 3456
#define XB_SPIN_CAP (1u << 18)

__device__ __forceinline__ unsigned xb_ld(unsigned* p)              { return __hip_atomic_load(p, __ATOMIC_RELAXED, __HIP_MEMORY_SCOPE_AGENT); }
__device__ __forceinline__ unsigned xb_add(unsigned* p, unsigned v) { return __hip_atomic_fetch_add(p, v, __ATOMIC_RELAXED, __HIP_MEMORY_SCOPE_AGENT); }
__device__ __forceinline__ unsigned xb_xcc_id() { return (unsigned)__builtin_amdgcn_s_getreg((3 << 11) | 20) & 0xFu; }
#define XB_SPIN(cond, bar) do { unsigned _sp = 0; while (cond) { __builtin_amdgcn_s_sleep(1); \
    if ((++_sp & 255u) == 0u) { if (xb_ld(&(bar)[XB_TMO])) break; if (_sp > XB_SPIN_CAP) { atomicAdd(&(bar)[XB_TMO], 1u); break; } } } } while (0)

struct XcdBarrier {
    unsigned* bar; unsigned x;
    volatile LAS unsigned* st;
};

__device__ __forceinline__ XcdBarrier xcd_barrier_post(unsigned* bar, volatile LAS unsigned* st) {
    XcdBarrier b; b.bar = bar; b.x = xb_xcc_id(); b.st = st;
    if (threadIdx.x == 0) (void)xb_add(&bar[XB_XCNT(b.x)], 1u);
    return b;
}
__device__ __forceinline__ void xcd_barrier_complete(unsigned* bar, unsigned x, unsigned& nloc, unsigned& nx) {
    const unsigned G = gridDim.x * gridDim.y * gridDim.z;
    unsigned sum, cnt, mine, sp = 0u;
    for (;;) {
        sum = 0u; cnt = 0u; mine = 0u;
#pragma unroll
        for (unsigned j = 0; j < 16; ++j) { const unsigned c = xb_ld(&bar[XB_XCNT(j)]); sum += c; cnt += (c > 0u) ? 1u : 0u; mine = (j == x) ? c : mine; }
        if (sum == G) break;
        __builtin_amdgcn_s_sleep(1);
        if ((++sp & 255u) == 0u) { if (xb_ld(&bar[XB_TMO])) break; if (sp > XB_SPIN_CAP) { atomicAdd(&bar[XB_TMO], 1u); break; } }
    }
    nloc = mine > 0u ? mine : 1u; nx = cnt > 0u ? cnt : 1u;
}

__device__ __forceinline__ void xcd_barrier(const XcdBarrier& b) {
    asm volatile("s_waitcnt vmcnt(0)" ::: "memory");
    __syncthreads();
    if (threadIdx.x == 0) {
        unsigned* bar = b.bar;
        __builtin_amdgcn_s_waitcnt(0);
        unsigned nloc = b.st[0], nx = b.st[1];
        if (nloc == 0u) { xcd_barrier_complete(bar, b.x, nloc, nx); b.st[0] = nloc; b.st[1] = nx; }
        const unsigned old = xb_add(&bar[XB_XSUB(b.x)], 1u);
        const unsigned gen = old / nloc;
        if (old + 1u == (gen + 1u) * nloc) {
            __builtin_amdgcn_fence(__ATOMIC_RELEASE, "agent");
            asm volatile("s_waitcnt vmcnt(0)" ::: "memory");
            const unsigned og = xb_add(&bar[XB_TOP], 1u);
            const unsigned tg = og / nx;
            if (og + 1u == (tg + 1u) * nx) xb_add(&bar[XB_TOPGEN], 1u);
            else XB_SPIN(xb_ld(&bar[XB_TOPGEN]) == tg, bar);
            __builtin_amdgcn_fence(__ATOMIC_ACQUIRE, "agent");
            xb_add(&bar[XB_XGEN(b.x)], 1u);
            asm volatile("s_waitcnt vmcnt(0)" ::: "memory");
        } else {
            XB_SPIN(xb_ld(&bar[XB_XGEN(b.x)]) == gen, bar);
            __builtin_amdgcn_fence(__ATOMIC_ACQUIRE, "agent");
            asm volatile("s_waitcnt vmcnt(0)" ::: "memory");
        }
    }
    __syncthreads();
}

__device__ __forceinline__ void phase7(const Args& a, LAS unsigned char* lds, int tid, int lane, int wave, int vcu, int G) {
    unsigned char* ws = a.ws;
    const int gw = vcu * NWAVES + wave, NGW = G * NWAVES;
    const bf16* x1 = (const bf16*)a.out; const float* gain = a.in[25]; bf16* h2x = (bf16*)(ws + WS_H2X);
    for (int m = gw; m < T; m += NGW) {
        const v2u* xr = (const v2u*)(x1 + (size_t)m * DM) + lane; f32x4 v[4]; float s = 0.f;
#pragma unroll
        for (int j = 0; j < 4; ++j) { const v2u w = xr[64 * j]; v[j] = (f32x4){bflo(w.x), bfhi(w.x), bflo(w.y), bfhi(w.y)}; s += (v[j].x * v[j].x + v[j].y * v[j].y) + (v[j].z * v[j].z + v[j].w * v[j].w); }
        const float rstd = 1.0f / sqrtf(wave_sum(s) * (1.f / 1024.f) + 1e-6f);
        v2u* oh = (v2u*)(h2x + (size_t)m * 1024) + lane;
#pragma unroll
        for (int j = 0; j < 4; ++j) { const f32x4 g = ((const f32x4*)gain)[lane + 64 * j]; v2u o; o.x = pk2(v[j][0] * rstd * g[0], v[j][1] * rstd * g[1]); o.y = pk2(v[j][2] * rstd * g[2], v[j][3] * rstd * g[3]); oh[64 * j] = o; }
    }
    LAS float* scr = (LAS float*)(lds + wave * 16384);
    bf16* wgu = (bf16*)(ws + WS_WGU); bf16* wd = (bf16*)(ws + WS_WD);
    constexpr int IGU = (1024 / 64) * (512 / 32);
    constexpr int IDN = (512 / 64) * (1024 / 32);
    for (int it = gw; it < NEXP * (2 * IGU + IDN); it += NGW) {
        const int e = it / (2 * IGU + IDN); int r = it % (2 * IGU + IDN);
        if (r < 2 * IGU) { const int up = r >= IGU; if (up) r -= IGU; const int kb = r / 16, nb = r % 16, n0 = 32 * nb;
            const float* W = (up ? a.in[31] : a.in[30]) + (size_t)e * 1024 * 512;
            tr_item(W, 512, wgu, 1024, 64 * kb, n0, (size_t)e * 1024 + (n0 >> 7) * 256 + (up ? 128 : 0) + (n0 & 127), 0, scr, lane);
        } else { r -= 2 * IGU; const int kb = r / 32, nb = r % 32;
            tr_item(a.in[32] + (size_t)e * 512 * 1024, 1024, wd, 512, 64 * kb, 32 * nb, (size_t)e * 1024 + 32 * nb, 0, scr, lane); }
    }
}

__device__ __forceinline__ void route_tile(const Args& a, LAS unsigned char* lds, int tid, int pm) {
    unsigned char* ws = a.ws;
    const float* LG = (const float*)(ws + WS_LOGITS); int* toke = (int*)(ws + WS_TOKE); float* tokw = (float*)(ws + WS_TOKW); int* tilecnt = (int*)(ws + WS_TILECNT);
    LAS int* cnt = (LAS int*)lds;
    if (tid < 32) cnt[tid] = 0;
    __syncthreads();
    if (tid < 256) {
        const int t = pm * 256 + tid; const float* lr = LG + (size_t)t * 128;
        float gl[4];
#pragma unroll
        for (int j = 0; j < 4; ++j) gl[j] = lr[32 + j] + a.in[27][j];
        int gi = 0; float gm = gl[0];
#pragma unroll
        for (int j = 1; j < 4; ++j) if (gl[j] > gm) { gm = gl[j]; gi = j; }
        float gs = 0.f;
#pragma unroll
        for (int j = 0; j < 4; ++j) gs += __expf(gl[j] - gm);
        const float gtop = 1.0f / gs;
        float el[8];
#pragma unroll
        for (int j = 0; j < 8; ++j) el[j] = lr[gi * 8 + j] + a.in[29][gi * 8 + j];
        int i1 = 0; float e1 = el[0];
#pragma unroll
        for (int j = 1; j < 8; ++j) if (el[j] > e1) { e1 = el[j]; i1 = j; }
        int i2 = -1; float e2 = -3.0e38f;
#pragma unroll
        for (int j = 0; j < 8; ++j) if (j != i1 && el[j] > e2) { e2 = el[j]; i2 = j; }
        const float ex = __expf(e2 - e1); const float w1 = gtop / (1.0f + ex), w2 = gtop * ex / (1.0f + ex);
        const int x1 = gi * 8 + i1, x2 = gi * 8 + i2;
        toke[t * 2] = x1; toke[t * 2 + 1] = x2; tokw[t * 2] = w1; tokw[t * 2 + 1] = w2;
        atomicAdd((int*)&cnt[x1], 1); atomicAdd((int*)&cnt[x2], 1);
    }
    __syncthreads();
    if (tid < 32) tilecnt[pm * 32 + tid] = cnt[tid];
    __syncthreads();
}

__device__ __forceinline__ void phase9(const Args& a, LAS unsigned char* lds, int tid, int lane, int wave) {
    unsigned char* ws = a.ws;
    const int tile = blockIdx.x;
    if (tile >= 128) return;
    const int* tilecnt = (const int*)(ws + WS_TILECNT); const int* toke = (const int*)(ws + WS_TOKE); const float* tokw = (const float*)(ws + WS_TOKW);
    int* pos = (int*)(ws + WS_POS); float* roww = (float*)(ws + WS_ROWW); int* disp = (int*)(ws + WS_DISP);
    const bf16* h2x = (const bf16*)(ws + WS_H2X); bf16* hs = (bf16*)(ws + WS_HS);
    LAS int* tc = (LAS int*)lds;
    LAS int* tot = tc + 4096;
    LAS int* bef = tot + 32;
    LAS int* base = bef + 32;
    LAS int* pst = base + 32;
    LAS int* earr = pst + 32;
    LAS int* parr = earr + 512;
    for (int i = tid; i < 4096; i += NTHR) tc[i] = tilecnt[i];
    earr[tid] = toke[tile * 512 + tid];
    __syncthreads();
    if (tid < 32) { int s = 0, b = 0; for (int t = 0; t < 128; ++t) { const int c = tc[t * 32 + tid]; s += c; if (t < tile) b += c; } tot[tid] = s; bef[tid] = b; }
    __syncthreads();
    if (tid == 0) { int p = 0; for (int e = 0; e < 32; ++e) { pst[e] = p; base[e] = p + bef[e]; const int nt = (tot[e] + 255) >> 8;
                        if (tile == 0) { for (int k = 0; k < nt; ++k) disp[16 + (p >> 8) + k] = e; disp[512 + e] = p; disp[576 + e] = tot[e]; }
                        p += nt << 8; }
                    if (tile == 0) disp[0] = p >> 8; }
    __syncthreads();
    for (int q = 0; q < 4; ++q) { const int e = wave * 4 + q; int running = 0;
        for (int c8 = 0; c8 < 8; ++c8) { const int ai = c8 * 64 + lane; const bool mt = earr[ai] == e; const unsigned long long mk = __ballot(mt);
            if (mt) parr[ai] = base[e] + running + __popcll(mk & ((1ull << lane) - 1ull));
            running += __popcll(mk); } }
    __syncthreads();
    { const int ai = tid, p = parr[ai], t = tile * 256 + (ai >> 1); pos[t * 2 + (ai & 1)] = p; roww[p] = tokw[t * 2 + (ai & 1)]; }
    for (int i = 0; i < 64; ++i) { const int ai = wave * 64 + i, p = parr[ai], t = tile * 256 + (ai >> 1);
        const v4u* src = (const v4u*)(h2x + (size_t)t * 1024); v4u* dst = (v4u*)(hs + (size_t)p * 1024);
        dst[lane] = src[lane]; dst[lane + 64] = src[lane + 64]; }
    if (tile < 32) { const int p0 = pst[tile] + tot[tile], p1 = pst[tile] + (((tot[tile] + 255) >> 8) << 8); const v4u z = (v4u){0u, 0u, 0u, 0u};
        for (int r = p0 + wave; r < p1; r += NWAVES) { v4u* dst = (v4u*)(hs + (size_t)r * 1024); dst[lane] = z; dst[lane + 64] = z; if (lane == 0) roww[r] = 0.f; } }
}

__device__ __forceinline__ void phase12(const Args& a, int tid, int lane, int wave, int vcu, int G) {
    unsigned char* ws = a.ws;
    const int gw = vcu * NWAVES + wave, NGW = G * NWAVES; const int gt = vcu * NTHR + tid, NGT = G * NTHR;
    const bf16* x1 = (const bf16*)a.out; bf16* x2 = (bf16*)(ws + WS_X2); const bf16* y2 = (const bf16*)(ws + WS_Y2); const int* pos = (const int*)(ws + WS_POS); const float* gain = a.in[33]; bf16* h3 = (bf16*)(ws + WS_H3);
    for (int m = gw; m < T; m += NGW) {
        const int pa = pos[m * 2], pb = pos[m * 2 + 1];
        const v2u* xr = (const v2u*)(x1 + (size_t)m * DM) + lane; v2u* xo = (v2u*)(x2 + (size_t)m * DM) + lane; const v2u* ya = (const v2u*)(y2 + (size_t)pa * 1024) + lane; const v2u* yb = (const v2u*)(y2 + (size_t)pb * 1024) + lane;
        f32x4 v[4]; float s = 0.f;
#pragma unroll
        for (int j = 0; j < 4; ++j) { const v2u wx = xr[64 * j], wa = ya[64 * j], wb = yb[64 * j];
            v[j].x = bflo(wx.x) + bflo(wa.x) + bflo(wb.x); v[j].y = bfhi(wx.x) + bfhi(wa.x) + bfhi(wb.x); v[j].z = bflo(wx.y) + bflo(wa.y) + bflo(wb.y); v[j].w = bfhi(wx.y) + bfhi(wa.y) + bfhi(wb.y);
            v2u o; o.x = pk2(v[j].x, v[j].y); o.y = pk2(v[j].z, v[j].w); xo[64 * j] = o;
            s += (v[j].x * v[j].x + v[j].y * v[j].y) + (v[j].z * v[j].z + v[j].w * v[j].w); }
        const float rstd = 1.0f / sqrtf(wave_sum(s) * (1.f / 1024.f) + 1e-6f);
        v2u* o8 = (v2u*)(h3 + (size_t)m * DM) + lane;
#pragma unroll
        for (int j = 0; j < 4; ++j) { const f32x4 g = ((const f32x4*)gain)[lane + 64 * j]; v2u o; o.x = pk2(v[j].x * rstd * g.x, v[j].y * rstd * g.y); o.y = pk2(v[j].z * rstd * g.z, v[j].w * rstd * g.w); o8[64 * j] = o; }
    }
    const f32x4* p = (const f32x4*)a.in[1]; v2u* p16 = (v2u*)(ws + WS_P16);
    for (int i = gt; i < T * 256 / 4; i += NGT) { const f32x4 v = p[i]; v2u o; o.x = pk2(v.x, v.y); o.y = pk2(v.z, v.w); p16[i] = o; }
}

#if defined(PROBE_PHASE) && (PROBE_PHASE == 200 || PROBE_PHASE == 201)
__device__ __forceinline__ float blk_sum(float v, LAS float* red, int tid) { v = wave_sum(v); __syncthreads(); if ((tid & 63) == 0) red[tid >> 6] = v; __syncthreads(); float s = 0.f; for (int i = 0; i < 8; ++i) s += red[i]; __syncthreads(); return s; }
__device__ __forceinline__ void check_moe(const Args& a, LAS unsigned char* lds, int tid, float* res) {
    unsigned char* ws = a.ws;
    LAS float* hb = (LAS float*)lds; LAS float* hf = hb + 1024; LAS float* act = hf + 1024; LAS float* lg = act + 512; LAS float* red = lg + 64; LAS int* sel = (LAS int*)(red + 16);
    const int* toke = (const int*)(ws + WS_TOKE); const float* tokw = (const float*)(ws + WS_TOKW); const int* pos = (const int*)(ws + WS_POS); const bf16* y2 = (const bf16*)(ws + WS_Y2);
    float errsum = 0.f, refsum = 0.f; int mism = 0;
    for (int si = 0; si < 24; ++si) { const int t = si * 1361 + 17;
        const bf16* xr = (const bf16*)a.out + (size_t)t * DM; const float x0 = __builtin_bit_cast(float, (unsigned)xr[tid] << 16), x1 = __builtin_bit_cast(float, (unsigned)xr[tid + 512] << 16);
        const float rstd = 1.0f / sqrtf(blk_sum(x0 * x0 + x1 * x1, red, tid) * (1.f / 1024.f) + 1e-6f);
        const float h0 = x0 * rstd * a.in[25][tid], h1 = x1 * rstd * a.in[25][tid + 512];
        hf[tid] = h0; hf[tid + 512] = h1; hb[tid] = __builtin_bit_cast(float, f2bf(h0) << 16); hb[tid + 512] = __builtin_bit_cast(float, f2bf(h1) << 16);
        __syncthreads();
        if (tid < 36) { float s = 0.f; for (int k = 0; k < 1024; ++k) s += hf[k] * (tid < 32 ? a.in[28][k * 32 + tid] : a.in[26][k * 4 + (tid - 32)]); lg[tid] = s + (tid < 32 ? a.in[29][tid] : a.in[27][tid - 32]); }
        __syncthreads();
        if (tid == 0) { int gi = 0; for (int j = 1; j < 4; ++j) if (lg[32 + j] > lg[32 + gi]) gi = j;
            int i1 = 0; for (int j = 1; j < 8; ++j) if (lg[gi * 8 + j] > lg[gi * 8 + i1]) i1 = j;
            int i2 = -1; for (int j = 0; j < 8; ++j) if (j != i1 && (i2 < 0 || lg[gi * 8 + j] > lg[gi * 8 + i2])) i2 = j;
            sel[0] = gi * 8 + i1; sel[1] = gi * 8 + i2; }
        __syncthreads();
        if (sel[0] != toke[t * 2] || sel[1] != toke[t * 2 + 1]) mism++;
        float o0 = 0.f, o1 = 0.f;
        for (int kx = 0; kx < 2; ++kx) { const int e = toke[t * 2 + kx]; const float w = tokw[t * 2 + kx];
            const float* Wg = a.in[30] + (size_t)e * 1024 * 512; const float* Wu = a.in[31] + (size_t)e * 1024 * 512; const float* Wd = a.in[32] + (size_t)e * 512 * 1024;
            float gg = 0.f, uu = 0.f; for (int k = 0; k < 1024; ++k) { const float hk = hb[k]; gg += hk * Wg[(size_t)k * 512 + tid]; uu += hk * Wu[(size_t)k * 512 + tid]; }
            __syncthreads(); act[tid] = gg / (1.0f + __expf(-gg)) * uu; __syncthreads();
            float s0 = 0.f, s1 = 0.f; for (int f = 0; f < 512; ++f) { const float af = act[f]; s0 += af * Wd[(size_t)f * 1024 + tid]; s1 += af * Wd[(size_t)f * 1024 + tid + 512]; }
            o0 += s0 * w; o1 += s1 * w; }
        const int pa = pos[t * 2], pb = pos[t * 2 + 1];
        const float m0 = __builtin_bit_cast(float, (unsigned)y2[(size_t)pa * 1024 + tid] << 16) + __builtin_bit_cast(float, (unsigned)y2[(size_t)pb * 1024 + tid] << 16);
        const float m1 = __builtin_bit_cast(float, (unsigned)y2[(size_t)pa * 1024 + tid + 512] << 16) + __builtin_bit_cast(float, (unsigned)y2[(size_t)pb * 1024 + tid + 512] << 16);
        errsum += (m0 - o0) * (m0 - o0) + (m1 - o1) * (m1 - o1); refsum += o0 * o0 + o1 * o1;
    }
    const float es = blk_sum(errsum, red, tid), rs = blk_sum(refsum, red, tid);
    if (tid == 0) *res = (PROBE_PHASE == 200) ? sqrtf(es / rs) : (float)mism / 24.f;
}
#endif

#ifndef PROBE_KAPPA
#define PROBE_KAPPA 0
#endif
#ifndef CHK_S0
#define CHK_S0 0
#define CHK_SN 4096
#endif
#if defined(PROBE_PHASE) && (PROBE_PHASE == 210 || PROBE_PHASE == 211 || PROBE_PHASE == 215)
__device__ __forceinline__ void check_attn(const Args& a, LAS unsigned char* lds, int tid, float* res) {
    unsigned char* ws = a.ws;
    const bf16* vt = (const bf16*)(ws + WS_VT);
    const bf16* odf = (const bf16*)((unsigned char*)a.out + OUT_ORWDF) + 512;
    LAS float* sc = (LAS float*)lds; LAS float* part = sc + 4096; LAS float* oc = part + 512; LAS float* red = oc + 256;
    const float d1 = wave_sum(a.in[17][tid & 63] * a.in[18][tid & 63]), d2 = wave_sum(a.in[19][tid & 63] * a.in[20][tid & 63]);
    const float lam = __expf(d1) - __expf(d2) + LAM_INIT;
    float errsum = 0.f, refsum = 0.f;
    for (int si = 0; si < 24; ++si) { const int b = si & 7, head = (PROBE_PHASE == 215) ? 0 : ((si >> 1) & 3), s = CHK_S0 + ((si * 977 + 31 * (si & 3)) % CHK_SN);
        for (int c = 0; c < 2; ++c) { const int vh = b * 8 + head * 2 + c;
            const bf16* qn = qn_ptr(ws, b); const bf16* kn = kn_ptr(ws, b); const bf16* qp = qn + ((size_t)(vh & 7) * SEQ + s) * 64; float mx = -3e38f;
            for (int j = tid; j <= s; j += NTHR) { const bf16* kp = kn + ((size_t)(vh & 7) * SEQ + j) * 64; float d = 0.f;
                for (int e = 0; e < 64; ++e) d += __builtin_bit_cast(float, (unsigned)qp[e] << 16) * __builtin_bit_cast(float, (unsigned)kp[e] << 16);
                sc[j] = d; mx = fmaxf(mx, d); }
            __syncthreads();
            for (int o = 1; o < 64; o <<= 1) mx = fmaxf(mx, __shfl_xor(mx, o));
            if ((tid & 63) == 0) red[tid >> 6] = mx;
            __syncthreads();
            mx = red[0]; for (int i = 1; i < 8; ++i) mx = fmaxf(mx, red[i]);
            __syncthreads();
            float ls = 0.f;
            for (int j = tid; j <= s; j += NTHR) { const float p = exp2f(sc[j] - mx); sc[j] = p; ls += p; }
            ls = wave_sum(ls); if ((tid & 63) == 0) red[tid >> 6] = ls;
            __syncthreads();
            float l = 0.f; for (int i = 0; i < 8; ++i) l += red[i];
            { const int dv = tid & 127, pr = tid >> 7; const bf16* vp = vt + (size_t)(head * 128 + dv) * T + (size_t)b * SEQ; float acc = 0.f;
              for (int j = pr; j <= s; j += 4) acc += sc[j] * __builtin_bit_cast(float, (unsigned)vp[j] << 16);
              part[tid] = acc; }
            __syncthreads();
            if (tid < 128) oc[c * 128 + tid] = (part[tid] + part[tid + 128] + part[tid + 256] + part[tid + 384]) / l;
            __syncthreads(); }
#if PROBE_PHASE == 215
        if (tid < 128) { const float ref = oc[tid]; const float got = __builtin_bit_cast(float, (unsigned)((const bf16*)(ws + 496 * MiB))[((size_t)b * SEQ + s) * 128 + tid] << 16); errsum += (PROBE_KAPPA ? got * ref : (got - ref) * (got - ref)); refsum += ref * ref; }
        __syncthreads(); continue;
#endif
        float dd = 0.f, sq = 0.f; if (tid < 128) { dd = oc[tid] - lam * oc[128 + tid]; sq = dd * dd; }
        sq = wave_sum(sq); __syncthreads(); if ((tid & 63) == 0) red[tid >> 6] = sq; __syncthreads();
        const float rs = (1.0f / sqrtf((red[0] + red[1]) * (1.f / 128.f) + 1e-6f)) * (1.0f - LAM_INIT);
        if (tid < 128) { const float ref = dd * rs * a.in[21][tid]; const float got = __builtin_bit_cast(float, (unsigned)odf[((size_t)b * SEQ + s) * 1024 + head * 128 + tid] << 16);
            errsum += (got - ref) * (got - ref); refsum += ref * ref; }
        __syncthreads(); }
    errsum = wave_sum(errsum); refsum = wave_sum(refsum);
    __syncthreads(); if ((tid & 63) == 0) { red[tid >> 6] = errsum; red[8 + (tid >> 6)] = refsum; } __syncthreads();
    if (tid == 0) *res = PROBE_KAPPA ? fabsf((red[0] + red[1]) / (red[8] + red[9])) : sqrtf((red[0] + red[1]) / (red[8] + red[9]));
}
__device__ __forceinline__ void check_scan(const Args& a, LAS unsigned char* lds, int tid, float* res) {
    unsigned char* ws = a.ws; const int b = 1, hd = 3, NS = 384;
    const bf16* rkv = (const bf16*)(ws + WS_RKV); const bf16* E = (const bf16*)(ws + WS_E); const bf16* Aa = (const bf16*)(ws + WS_A); const bf16* Y = y_ptr(a.out, b);
    LAS float* vw = (LAS float*)lds; LAS float* vaa = vw + 64; LAS float* vbb = vaa + 64; LAS float* vkm = vbb + 64; LAS float* vr = vkm + 64; LAS float* vv = vr + 64; LAS float* red = vv + 64;
    const int row = tid >> 3, cg = tid & 7; float st[8]; for (int j = 0; j < 8; ++j) st[j] = 0.f;
    float errsum = 0.f, refsum = 0.f;
    for (int s = 0; s < NS; ++s) { const size_t t = (size_t)b * SEQ + s;
        if (tid < 64) { const int ch = hd * 64 + tid;
            auto ld = [&](size_t tt, int off) { return __builtin_bit_cast(float, (unsigned)rkv[tt * 1536 + off + ch] << 16); };
            const float rc = ld(t, 0), kc = ld(t, 512), vc = ld(t, 1024); const float rp = s ? ld(t - 1, 0) : 0.f, kp = s ? ld(t - 1, 512) : 0.f, vp = s ? ld(t - 1, 1024) : 0.f;
            const float r = rc + (rp - rc) * a.in[4][ch], k = kc + (kp - kc) * a.in[4][512 + ch], v = vc + (vp - vc) * a.in[4][1024 + ch];
            const float e = __builtin_bit_cast(float, (unsigned)E[t * 512 + ch] << 16), av = __builtin_bit_cast(float, (unsigned)Aa[t * 512 + ch] << 16);
            float kk = k * a.in[10][ch]; const float nn = sqrtf(wave_sum(kk * kk)); kk = kk / fmaxf(nn, 1e-12f);
            vw[tid] = expf(-e); vaa[tid] = -kk; vbb[tid] = kk * av; vkm[tid] = k * (1.0f + (av - 1.0f) * a.in[11][ch]); vr[tid] = r; vv[tid] = v; }
        __syncthreads();
        float sa = 0.f; for (int j = 0; j < 8; ++j) sa += st[j] * vaa[cg * 8 + j];
        sa += __shfl_xor(sa, 1); sa += __shfl_xor(sa, 2); sa += __shfl_xor(sa, 4);
        float y = 0.f; for (int j = 0; j < 8; ++j) { const int c = cg * 8 + j; st[j] = st[j] * vw[c] + sa * vbb[c] + vv[row] * vkm[c]; y += st[j] * vr[c]; }
        y += __shfl_xor(y, 1); y += __shfl_xor(y, 2); y += __shfl_xor(y, 4);
        if (cg == 0) { const float got = __builtin_bit_cast(float, (unsigned)Y[(size_t)s * 512 + hd * 64 + row] << 16); errsum += (got - y) * (got - y); refsum += y * y; }
        __syncthreads(); }
    errsum = wave_sum(errsum); refsum = wave_sum(refsum);
    if ((tid & 63) == 0) { red[tid >> 6] = errsum; red[8 + (tid >> 6)] = refsum; } __syncthreads();
    if (tid == 0) { float es = 0.f, rs = 0.f; for (int i = 0; i < 8; ++i) { es += red[i]; rs += red[8 + i]; } *res = sqrtf(es / rs); }
}
#endif
#ifndef MK_N_LAUNCHES
#define MK_N_LAUNCHES 1
#endif
#ifndef SCAN_CHUNKED
#define SCAN_CHUNKED 1
#endif
constexpr int NSCAN = SCAN_CHUNKED ? 64 : 128;
constexpr int NGATE = 256;
constexpr int NPHASE = 15;
__global__ void __launch_bounds__(NTHR, 2) mk_fwd(Args args) {
    extern __shared__ __attribute__((aligned(16))) unsigned char lds_raw[];
    LAS unsigned char* lds = (LAS unsigned char*)lds_raw;
    const int tid = threadIdx.x, lane = tid & 63, wave = __builtin_amdgcn_readfirstlane(tid >> 6);
    const int G = gridDim.x; const int bx = blockIdx.x; const int vcu = (G % 8 == 0) ? (bx % 8) * (G / 8) + bx / 8 : bx;
    unsigned char* ws = args.ws;
    const int lo = args.ph_lo, hi = args.ph_hi;
#ifdef ONLY_PHASE
#define IN(k) ((k) == ONLY_PHASE && lo <= (k) && (k) < hi)
#else
#define IN(k) (lo <= (k) && (k) < hi)
#endif
#if MK_N_LAUNCHES == 1
    volatile LAS unsigned* MISC = (volatile LAS unsigned*)(lds + MISC_OFF);
    for (int u = tid; u < 64; u += NTHR) MISC[u] = 0u;
    __syncthreads();
    XcdBarrier xbar = xcd_barrier_post((unsigned*)(ws + WS_CTL) + CW_BAR, MISC + 8);
    if (lo < 0) { __threadfence(); cg::this_grid().sync(); }
#define SEAM(k) do { if (IN(k) && IN((k) + 1)) xcd_barrier(xbar); } while (0)
#else
#define SEAM(k) do { } while (0)
#endif
#ifdef PROBE_PHASE
    volatile LAS unsigned long long* ptw = (volatile LAS unsigned long long*)(lds + MISC_OFF + 1536);
#define pt0 ptw[0]
#define pt1 ptw[1]
    if (tid == 0) { pt0 = 0ull; pt1 = 0ull; }
#define PB(k) do { if ((k) == PROBE_PHASE && bx == 0 && tid == 0) pt0 = __builtin_amdgcn_s_memrealtime(); } while (0)
#define PE(k) do { if ((k) == PROBE_PHASE && bx == 0 && tid == 0) pt1 = __builtin_amdgcn_s_memrealtime(); } while (0)
#else
#define PB(k) do { } while (0)
#define PE(k) do { } while (0)
#endif
    typedef pg8::bf16_t pbf;
    int K256 = 256, K512 = 512, K1024 = 1024, K2048 = 2048;
    asm volatile("" : "+s"(K256), "+s"(K512), "+s"(K1024), "+s"(K2048));
    PB(0);
    if (IN(0)) { phase0(args, lds, tid, lane, wave, vcu, G); }
    SEAM(0); PE(0);
    PB(1);
    if (IN(1)) {
        { pg8::Gemm g{(const pbf*)(ws + WS_XN), (const pbf*)(ws + WS_WIN), T, 11 * 256, K1024}; pg8::StaticOrder S; S.init(T, 11 * 256, G, bx);
          pg8::EpiProj E{(pbf*)(ws + WS_RKV), (pbf*)(ws + WS_PROJB), (pbf*)(ws + WS_GATES)};
          pg8::gemm_phase<pg8::EpiProj, pg8::StaticOrder, true, true>(lds, g, S, E); }
        { pg8::Gemm g{(const pbf*)(ws + WS_WIN) + (size_t)2816 * 1024, (const pbf*)(ws + WS_XN), 512, T, K1024}; pg8::StaticOrder S; S.init(512, T, G, bx);
          pg8::EpiStore E{(pbf*)(ws + WS_VT), T};
          pg8::gemm_phase<pg8::EpiStore, pg8::StaticOrder, true, true>(lds, g, S, E); }
    }
    SEAM(1); PE(1);
    PB(2);
    if (IN(2)) { phase2(args, lds, tid, vcu, G); }
    SEAM(2); PE(2);
    PB(3);
    if (IN(3)) {
        pg8::Gemm g{(const pbf*)((unsigned char*)args.out + OUT_LA), (const pbf*)(ws + WS_WLORA), T, 1536, K256}; pg8::StaticOrder S; S.init(T, 1536, G, bx);
        pg8::EpiLora E{(pbf*)(ws + WS_E), (pbf*)(ws + WS_A), (pbf*)(ws + WS_G), args.in[5], args.in[7]};
        pg8::gemm_phase<pg8::EpiLora, pg8::StaticOrder, true, true>(lds, g, S, E);
    }
    SEAM(3); PE(3);
    PB(4);
    if (IN(4)) {
        unsigned* qhead = (unsigned*)(ws + WS_CTL) + CW_QUEUE; LAS unsigned* ubox = (LAS unsigned*)(lds + MISC_OFF);
        float* stash = (float*)((unsigned char*)args.out + OUT_STASH) + (size_t)bx * 64 * 512;
        for (;;) {
            __syncthreads();
            if (tid == 0) ubox[0] = atomicAdd(qhead, 1u);
            __syncthreads();
            const int u = (int)ubox[0];
            int oq = 0; asm volatile("" : "+v"(oq)); const int tq = tid + oq;
            if (u >= NSCAN + NGATE + 512) break;
#if defined(PROBE_PHASE) && PROBE_PHASE == 100
            if (u < NSCAN) { if (tid == 0) ptw[2] = __builtin_amdgcn_s_memrealtime(); if (SCAN_CHUNKED) scan_unit_chunked(args, lds, tq, u); else scan_unit(args, lds, tq, u);
                if (tid == 0) atomicMax((unsigned*)(ws + WS_CTL) + 96, (unsigned)(__builtin_amdgcn_s_memrealtime() - ptw[2])); }
#else
            if (u < NSCAN) { if (SCAN_CHUNKED) scan_unit_chunked(args, lds, tq, u); else scan_unit(args, lds, tq, u); }
#endif
#if defined(PROBE_PHASE) && PROBE_PHASE == 101
            else if (u < NSCAN + NGATE) { } else { const int au = u - NSCAN - NGATE; const unsigned long long q0 = __builtin_amdgcn_s_memrealtime(); attn_unit(args, lds, tid, (au & 31) >> 2, au & 3, 15 - (au >> 5), stash); const unsigned long long q1 = __builtin_amdgcn_s_memrealtime();
                if (tid == 0) atomicAdd((unsigned*)(ws + WS_CTL) + 96, (unsigned)(q1 - q0)); }
#else
            else if (u < NSCAN + NGATE) { const int it = u - NSCAN;
                pg8::Gemm g{(const pbf*)(ws + WS_XN), (const pbf*)(ws + WS_WIN) + (size_t)3328 * 1024, T, 2048, K1024}; pg8::OrderItem S{it >> 1, (it & 1) * 4, 4};
                pg8::EpiGates E{(pbf*)(ws + WS_GATES)};
                pg8::gemm_phase<pg8::EpiGates, pg8::OrderItem, true, true>(lds, g, S, E, oq); }
            else { const int au = u - NSCAN - NGATE; attn_unit(args, lds, tq, (au & 31) >> 2, au & 3, 15 - (au >> 5), stash); }
#endif
        }
    }
    SEAM(4); PE(4);
#if defined(PROBE_PHASE) && (PROBE_PHASE == 210 || PROBE_PHASE == 211 || PROBE_PHASE == 215)
    if (bx == 0) { float* res = (float*)(ws + WS_CTL) + 100; if (PROBE_PHASE != 211) check_attn(args, lds, tid, res); else check_scan(args, lds, tid, res); __syncthreads(); if (tid == 0) { pt0 = 0ull; pt1 = (unsigned long long)(*(volatile float*)res * 1.0e6f); } }
    xcd_barrier(xbar);
#endif
#if defined(PROBE_PHASE) && PROBE_PHASE == 100
    if (bx == 0 && tid == 0) { pt0 = 0ull; pt1 = (unsigned long long)__hip_atomic_load((unsigned*)(ws + WS_CTL) + 96, __ATOMIC_RELAXED, __HIP_MEMORY_SCOPE_AGENT); }
#endif
#if defined(PROBE_PHASE) && PROBE_PHASE >= 300 && PROBE_PHASE < 310
    if (bx == 0 && tid == 0) { pt0 = 0ull; pt1 = (unsigned long long)__hip_atomic_load((unsigned*)(ws + WS_CTL) + 96, __ATOMIC_RELAXED, __HIP_MEMORY_SCOPE_AGENT) / 64ull; }
#endif
#if defined(PROBE_PHASE) && PROBE_PHASE == 101
    if (bx == 0 && tid == 0) { pt0 = 0ull; pt1 = (unsigned long long)__hip_atomic_load((unsigned*)(ws + WS_CTL) + 96, __ATOMIC_RELAXED, __HIP_MEMORY_SCOPE_AGENT) / 256ull; }
#endif
    PB(5);
    if (IN(5)) { phase_orw(args, lane, wave, vcu, G); }
    SEAM(5); PE(5);
    PB(6);
    if (IN(6)) {
        pg8::Gemm g{(const pbf*)((unsigned char*)args.out + OUT_ORWDF), (const pbf*)(ws + WS_WBRD), T, 1024, K1024}; pg8::StaticOrder S; S.init(T, 1024, G, bx);
        pg8::EpiMix E{(const pbf*)(ws + WS_GATES), (pbf*)(ws + WS_MIXED)};
        pg8::gemm_phase<pg8::EpiMix, pg8::StaticOrder, true, true>(lds, g, S, E);
    }
    SEAM(6); PE(6);
    PB(7);
    if (IN(7)) {
        pg8::Gemm g{(const pbf*)(ws + WS_MIXED), (const pbf*)(ws + WS_WO), T, 1024, K1024}; pg8::StaticOrder S; S.init(T, 1024, G, bx);
        pg8::EpiRes E{args.in[0], (pbf*)args.out};
        pg8::gemm_phase<pg8::EpiRes, pg8::StaticOrder, true, true>(lds, g, S, E);
    }
    SEAM(7); PE(7);
    PB(8);
    if (IN(8)) { phase7(args, lds, tid, lane, wave, vcu, G); }
    SEAM(8); PE(8);
    PB(9);
    if (IN(9)) {
        pg8::Gemm g{(const pbf*)(ws + WS_H2X), (const pbf*)(ws + WS_WR), T, 256, K1024}; pg8::StaticOrder S; S.init(T, 256, G, bx);
        pg8::EpiLogits E{(float*)(ws + WS_LOGITS)};
        pg8::gemm_phase<pg8::EpiLogits, pg8::StaticOrder, true, true>(lds, g, S, E);
        VM_WAIT(); __syncthreads();
        pg8::Unit u;
        for (int i = 0; S.next(i, u); ++i) route_tile(args, lds, tid, u.pm);
    }
    SEAM(9); PE(9);
    PB(10);
    if (IN(10)) { phase9(args, lds, tid, lane, wave); }
    SEAM(10); PE(10);
    PB(11);
    if (IN(11) || IN(12)) {
        const int* disp = (const int*)(ws + WS_DISP); LAS int* tile_e = (LAS int*)(lds + MISC_OFF + 64);
        __syncthreads();
        const int NT = disp[0];
        for (int i = tid; i < NT && i < 320; i += NTHR) tile_e[i] = disp[16 + i];
        __syncthreads();
        if (IN(11)) {
            pg8::Gemm g{(const pbf*)(ws + WS_HS), (const pbf*)(ws + WS_WGU), MAXROWS, NEXP * 1024, K1024}; pg8::OrderMoe S{NT * 4, G, bx, tile_e};
            pg8::EpiAct E{(pbf*)(ws + WS_ACT)};
            pg8::gemm_phase<pg8::EpiAct, pg8::OrderMoe, true, true>(lds, g, S, E);
        }
        SEAM(11); PE(11); PB(12);
        if (IN(12)) {
            pg8::Gemm g{(const pbf*)(ws + WS_ACT), (const pbf*)(ws + WS_WD), MAXROWS, NEXP * 1024, K512}; pg8::OrderMoe S{NT * 4, G, bx, tile_e};
            pg8::EpiDown E{(pbf*)(ws + WS_Y2), (const float*)(ws + WS_ROWW)};
            pg8::gemm_phase<pg8::EpiDown, pg8::OrderMoe, true, true>(lds, g, S, E);
        }
    }
    SEAM(12); PE(12);
#if defined(PROBE_PHASE) && (PROBE_PHASE == 200 || PROBE_PHASE == 201)
    if (bx == 0) { float* res = (float*)(ws + WS_CTL) + 100; check_moe(args, lds, tid, res); __syncthreads(); if (tid == 0) { pt0 = 0ull; pt1 = (unsigned long long)(*(volatile float*)res * 1.0e6f); } }
    xcd_barrier(xbar);
#endif
    PB(13);
    if (IN(13)) { phase12(args, tid, lane, wave, vcu, G); }
    SEAM(13); PE(13);
    PB(14);
    if (IN(14)) {
        { pg8::Gemm g{(const pbf*)(ws + WS_P16), (const pbf*)(ws + WS_WPP), T, 1024, K256}; pg8::StaticOrder S; S.init(T, 1024, G, bx);
          pg8::EpiStore E{(pbf*)(ws + WS_PP), 1024};
          pg8::gemm_phase<pg8::EpiStore, pg8::StaticOrder, true, true>(lds, g, S, E); }
        { pg8::Gemm g{(const pbf*)(ws + WS_H3), (const pbf*)(ws + WS_WPG), T, 1024, K1024}; pg8::StaticOrder S; S.init(T, 1024, G, bx);
          pg8::EpiFinal E{(const pbf*)(ws + WS_PP), (const pbf*)(ws + WS_X2), args.out};
          pg8::gemm_phase<pg8::EpiFinal, pg8::StaticOrder, true, true>(lds, g, S, E); }
    }
#ifdef PROBE_PHASE
    if (PROBE_PHASE == 14 && bx == 0 && tid == 0) { pt1 = __builtin_amdgcn_s_memrealtime(); }
    if (bx == 0 && tid == 0) { const unsigned long long te = __builtin_amdgcn_s_memrealtime(), w = (unsigned long long)PROBE_MULT * (pt1 - pt0);
        while (__builtin_amdgcn_s_memrealtime() - te < w) __builtin_amdgcn_s_sleep(32); }
#endif
#undef IN
#undef SEAM
}

extern "C" void kernel_launch(void* const* d_in, const int* in_sizes, int n_in, void* d_out, int out_size, void* d_ws, size_t ws_size, hipStream_t stream) {
    static int grid = 0;
    if (grid == 0) {
        if (n_in != 36 || in_sizes[0] != T * DM || out_size != T * DM || ws_size < WS_END) {
            fprintf(stderr, "kernel_launch: unexpected problem: n_in %d in0 %d out %d ws %zu (need %zu)\n", n_in, n_in > 0 ? in_sizes[0] : -1, out_size, ws_size, (size_t)WS_END); grid = -1; return; }
        int dev = 0, cus = 0, per_cu = 0;
        if (hipGetDevice(&dev) != hipSuccess || hipDeviceGetAttribute(&cus, hipDeviceAttributeMultiprocessorCount, dev) != hipSuccess) { grid = -1; return; }
        if (hipFuncSetAttribute((const void*)mk_fwd, hipFuncAttributeMaxDynamicSharedMemorySize, LDS_BYTES) != hipSuccess) { fprintf(stderr, "kernel_launch: hipFuncSetAttribute failed\n"); grid = -1; return; }
        if (hipOccupancyMaxActiveBlocksPerMultiprocessor(&per_cu, (const void*)mk_fwd, NTHR, LDS_BYTES) != hipSuccess || per_cu < 1) { fprintf(stderr, "kernel_launch: occupancy query says %d blocks per CU\n", per_cu); (void)hipGetLastError(); grid = -1; return; }
        grid = cus;
        if (grid > 256) grid = 256;
    }
    if (grid < 0) return;
    (void)hipMemsetAsync((char*)d_ws + WS_CTL, 0, CTL_ZERO_BYTES, stream);
    Args a{};
    for (int i = 0; i < 36; ++i) a.in[i] = (const float*)d_in[i];
    a.out = (float*)d_out; a.ws = (unsigned char*)d_ws;
#if MK_N_LAUNCHES == 1
    a.ph_lo = 0; a.ph_hi = NPHASE;
    void* kargs[] = {&a};
    const hipError_t e = hipLaunchCooperativeKernel((const void*)mk_fwd, dim3(grid), dim3(NTHR), kargs, LDS_BYTES, stream);
    if (e != hipSuccess) fprintf(stderr, "kernel_launch: cooperative launch failed: %s (grid %d)\n", hipGetErrorString(e), grid);
#else
    for (int ph = 0; ph < NPHASE; ++ph) { a.ph_lo = ph; a.ph_hi = ph + 1; hipLaunchKernelGGL(mk_fwd, dim3(grid), dim3(NTHR), LDS_BYTES, stream, a); }
#endif
}
```

```cpp
#include <hip/hip_runtime.h>
#include <hip/hip_cooperative_groups.h>
#include <cstdio>
#include <cstdint>
namespace cg = cooperative_groups;
namespace pg8 {
#define PG8_LAS __attribute__((address_space(3)))
typedef unsigned short bf16_t;
typedef short bf16x8 __attribute__((ext_vector_type(8)));
typedef float f32x4 __attribute__((ext_vector_type(4)));
typedef unsigned u32x4 __attribute__((ext_vector_type(4)));
constexpr int BM = 256, BK = 64, HALF = 128, HTB = HALF * BK * 2  , STAGE_BYTES = 8 * HTB, NXCD = 8, WGM = 8;

__host__ __device__ __forceinline__ int lds_byte(int r, int c) { const int st = (r >> 4) * 2 + (c >> 5), rr = r & 15, cc = c & 31, ob = rr * 64 + cc * 2; return st * 1024 + (ob ^ (((ob >> 9) & 1) << 5)); }
__host__ __device__ __forceinline__ void stage_rc(int b, int& R, int& C) { const int st = b / 1024, sb = b % 1024, swz = sb ^ (((sb >> 9) & 1) << 5); R = (st >> 1) * 16 + swz / 64; C = (st & 1) * 32 + (swz % 64) / 2; }
__host__ __device__ __forceinline__ int perm32(int rho) { const int n = rho >> 4, i = rho & 15; return 8 * (i >> 2) + 4 * n + (i & 3); }

struct Unit { int pm, pn; };
struct Gemm { const bf16_t* A; const bf16_t* Bt; int M, N, K; };

struct StaticOrder {
    int nM, nN, nwg, G, c;
    __host__ __device__ __forceinline__ void init(int M, int N, int G_, int c_) { nM = M / BM; nN = N / BM; nwg = nM * nN; G = G_; c = c_; }
    __host__ __device__ __forceinline__ bool next(int i, Unit& u) const {
        const long L = (long)i * G + c; if (L >= nwg) return false;
        int wgid = (int)L; { const int q = nwg / NXCD, r = nwg % NXCD, xcd = wgid % NXCD, off = wgid / NXCD; wgid = (xcd < r ? xcd * (q + 1) : r * (q + 1) + (xcd - r) * q) + off; }
        const int nig = WGM * nN, gid = wgid / nig, fm = gid * WGM, gsz = (nM - fm) < WGM ? (nM - fm) : WGM;
        u.pm = fm + ((wgid % nig) % gsz); u.pn = (wgid % nig) / gsz; return true;
    }
    __device__ __forceinline__ void a_ready(const Unit&) const {}
    __device__ __forceinline__ void done(const Unit&) const {}
};

__device__ __forceinline__ unsigned cvt_pk_bf16(float lo, float hi) { unsigned r; asm volatile("v_cvt_pk_bf16_f32 %0, %1, %2" : "=v"(r) : "v"(lo), "v"(hi)); return r; }
template <class Epi, class Sched, bool ALIGN_EPI = false, bool SP2 = false>
__device__ __forceinline__ void gemm_phase(PG8_LAS unsigned char* lds, const Gemm g, const Sched& S, const Epi& E, const int tz = 0  ) {
    const int tid = threadIdx.x + tz, wid = __builtin_amdgcn_readfirstlane(tid >> 6), lane = tid & 63, wr = wid >> 2, wc = wid & 3, fr = lane & 15, fq = lane >> 4;
    const int K = g.K, nt = K / BK;
    unsigned voffA[2], voffB[2];
#pragma unroll
    for (int i = 0; i < 2; ++i) { int R, C; stage_rc(tid * 16 + i * 8192, R, C); const int Rb = Epi::PERM ? ((R & ~31) + perm32(R & 31)) : R;
        voffA[i] = (unsigned)(R * K + C) * 2u; voffB[i] = (unsigned)(Rb * K + C) * 2u; }
    const size_t kstep = (size_t)(BK * 2);
    const size_t hstep = (size_t)HALF * K * 2;
    const size_t tstep = 2 * hstep;
    const unsigned ldsw = (unsigned)wid * 1024u;
    const int aoff = lds_byte(wr * 64 + fr, fq * 8), boff = lds_byte(wc * 32 + fr, fq * 8);
#define PG8_SA(b, h) (((b) * 2 + (h)) * HTB)
#define PG8_SB(b, h) ((4 + (b) * 2 + (h)) * HTB)
#define PG8_STAGE(bufoff, gbase, voff) do { _Pragma("unroll") for (int _i = 0; _i < 2; ++_i) \
        __builtin_amdgcn_global_load_lds((const unsigned*)((const char*)(gbase) + (voff)[_i]), (PG8_LAS unsigned*)(lds + (bufoff) + ldsw + _i * 8192), 16, 0, 0); } while (0)
#define PG8_LDA(dst, b, h) do { _Pragma("unroll") for (int m = 0; m < 4; ++m) _Pragma("unroll") for (int k = 0; k < 2; ++k) dst[m][k] = *(const PG8_LAS bf16x8*)(lds + PG8_SA(b, h) + aoff + m * 2048 + k * 1024); } while (0)
#define PG8_LDB(dst, b, h) do { _Pragma("unroll") for (int n = 0; n < 2; ++n) _Pragma("unroll") for (int k = 0; k < 2; ++k) dst[n][k] = *(const PG8_LAS bf16x8*)(lds + PG8_SB(b, h) + boff + n * 2048 + k * 1024); } while (0)
#define PG8_MMA(ai, bj, At, Bt) do { __builtin_amdgcn_s_setprio(1); _Pragma("unroll") for (int m = 0; m < 4; ++m) _Pragma("unroll") for (int n = 0; n < 2; ++n) _Pragma("unroll") for (int k = 0; k < 2; ++k) \
        acc[ai][bj][m][n] = __builtin_amdgcn_mfma_f32_16x16x32_bf16(Bt[n][k], At[m][k], acc[ai][bj][m][n], 0, 0, 0); __builtin_amdgcn_s_setprio(0); } while (0)
#define PG8_WAIT_V(n) asm volatile("s_waitcnt vmcnt(" #n ")" ::: "memory")
#define PG8_WAIT_L(n) asm volatile("s_waitcnt lgkmcnt(" #n ")" ::: "memory")
#define PG8_BAR __builtin_amdgcn_s_barrier()
#define PG8_SCHED __builtin_amdgcn_sched_barrier(0)
    Unit cur, nxt; int ui = 0;
    if (!S.next(0, cur)) return;
    f32x4 acc[2][2][4][2];
#pragma unroll
    for (int a = 0; a < 2; ++a)
#pragma unroll
        for (int b = 0; b < 2; ++b)
#pragma unroll
            for (int m = 0; m < 4; ++m)
#pragma unroll
                for (int n = 0; n < 2; ++n) acc[a][b][m][n] = (f32x4){0.f, 0.f, 0.f, 0.f};
    bf16x8 At[4][2], B0[2][2], B1[2][2];
    const char* cA = (const char*)g.A + (size_t)cur.pm * tstep; const char* cB = (const char*)g.Bt + (size_t)cur.pn * tstep;
    S.a_ready(cur);
    if constexpr (SP2) {
        PG8_STAGE(PG8_SB(0, 0), cB, voffB); PG8_STAGE(PG8_SB(0, 1), cB + hstep, voffB); PG8_STAGE(PG8_SA(0, 0), cA, voffA); PG8_STAGE(PG8_SA(0, 1), cA + hstep, voffA);
        if (wr == 1) PG8_BAR;
        PG8_WAIT_V(2); PG8_BAR;
        PG8_STAGE(PG8_SB(1, 0), cB + kstep, voffB); PG8_STAGE(PG8_SA(1, 0), cA + kstep, voffA); PG8_STAGE(PG8_SB(1, 1), cB + hstep + kstep, voffB);
        PG8_WAIT_V(6); PG8_BAR;
    } else {
        PG8_STAGE(PG8_SB(0, 0), cB, voffB); PG8_STAGE(PG8_SA(0, 0), cA, voffA); PG8_STAGE(PG8_SB(0, 1), cB + hstep, voffB); PG8_STAGE(PG8_SA(0, 1), cA + hstep, voffA);
        if (wr == 1) PG8_BAR;
        PG8_WAIT_V(4); PG8_BAR;
        PG8_STAGE(PG8_SB(1, 0), cB + kstep, voffB); PG8_STAGE(PG8_SA(1, 0), cA + kstep, voffA); PG8_STAGE(PG8_SB(1, 1), cB + hstep + kstep, voffB);
        PG8_WAIT_V(6); PG8_BAR;
    }
    for (;;) {
        const bool has_next = S.next(ui + 1, nxt);
        const char* nA = has_next ? (const char*)g.A + (size_t)nxt.pm * tstep : cA; const char* nB = has_next ? (const char*)g.Bt + (size_t)nxt.pn * tstep : cB;
        for (int t = 0; t < nt; t += 2) {
            if constexpr (Epi::HAS_MID) { if (t == (nt >> 1)) E.mid(acc, cur, wr, wc, fr, fq); }
            const bool last = (t == nt - 2);
            const char* a1 = cA + (size_t)(t + 1) * kstep;
            const char* a2 = last ? nA : cA + (size_t)(t + 2) * kstep; const char* b2 = last ? nB : cB + (size_t)(t + 2) * kstep;
            const char* a3 = a2 + kstep; const char* b3 = b2 + kstep;
            if (last && has_next) S.a_ready(nxt);
            if constexpr (SP2) {
            PG8_LDB(B0, 0, 0); PG8_LDB(B1, 0, 1); PG8_SCHED; PG8_LDA(At, 0, 0); PG8_STAGE(PG8_SA(1, 1), a1 + hstep, voffA);
            PG8_WAIT_V(8); PG8_WAIT_L(0); PG8_BAR; PG8_MMA(0, 0, At, B0); PG8_MMA(0, 1, At, B1); PG8_BAR; PG8_SCHED;
            PG8_LDA(At, 0, 1); PG8_STAGE(PG8_SB(0, 0), b2, voffB); PG8_STAGE(PG8_SB(0, 1), b2 + hstep, voffB); PG8_STAGE(PG8_SA(0, 0), a2, voffA);
            PG8_WAIT_V(8); PG8_WAIT_L(0); PG8_BAR; PG8_MMA(1, 0, At, B0); PG8_MMA(1, 1, At, B1); PG8_BAR; PG8_SCHED;
            PG8_LDB(B0, 1, 0); PG8_LDB(B1, 1, 1); PG8_SCHED; PG8_LDA(At, 1, 0); PG8_STAGE(PG8_SA(0, 1), a2 + hstep, voffA);
            PG8_WAIT_V(8); PG8_WAIT_L(0); PG8_BAR; PG8_MMA(0, 0, At, B0); PG8_MMA(0, 1, At, B1); PG8_BAR; PG8_SCHED;
            PG8_LDA(At, 1, 1); PG8_STAGE(PG8_SB(1, 0), b3, voffB); PG8_STAGE(PG8_SB(1, 1), b3 + hstep, voffB); PG8_STAGE(PG8_SA(1, 0), a3, voffA);
            PG8_WAIT_V(8); PG8_WAIT_L(0); PG8_BAR; PG8_MMA(1, 0, At, B0); PG8_MMA(1, 1, At, B1); PG8_BAR; PG8_SCHED;
            } else {
            PG8_LDB(B0, 0, 0); PG8_SCHED; PG8_LDA(At, 0, 0); PG8_STAGE(PG8_SA(1, 1), a1 + hstep, voffA);
            PG8_WAIT_L(8); PG8_BAR; PG8_WAIT_L(0); PG8_MMA(0, 0, At, B0); PG8_BAR; PG8_SCHED;
            PG8_LDB(B1, 0, 1); PG8_STAGE(PG8_SB(0, 0), b2, voffB);
            PG8_BAR; PG8_WAIT_L(0); PG8_MMA(0, 1, At, B1); PG8_BAR;
            PG8_LDA(At, 0, 1); PG8_STAGE(PG8_SA(0, 0), a2, voffA);
            PG8_BAR; PG8_WAIT_L(0); PG8_MMA(1, 0, At, B0); PG8_BAR; PG8_SCHED;
            PG8_STAGE(PG8_SB(0, 1), b2 + hstep, voffB);
            PG8_WAIT_V(6); PG8_BAR; PG8_MMA(1, 1, At, B1); PG8_BAR;
            PG8_LDB(B0, 1, 0); PG8_SCHED; PG8_LDA(At, 1, 0); PG8_STAGE(PG8_SA(0, 1), a2 + hstep, voffA);
            PG8_WAIT_L(8); PG8_BAR; PG8_WAIT_L(0); PG8_MMA(0, 0, At, B0); PG8_BAR; PG8_SCHED;
            PG8_LDB(B1, 1, 1); PG8_STAGE(PG8_SB(1, 0), b3, voffB);
            PG8_BAR; PG8_WAIT_L(0); PG8_MMA(0, 1, At, B1); PG8_BAR;
            PG8_LDA(At, 1, 1); PG8_STAGE(PG8_SA(1, 0), a3, voffA);
            PG8_BAR; PG8_WAIT_L(0); PG8_MMA(1, 0, At, B0); PG8_BAR; PG8_SCHED;
            PG8_STAGE(PG8_SB(1, 1), b3 + hstep, voffB);
            PG8_WAIT_V(6); PG8_BAR; PG8_MMA(1, 1, At, B1); PG8_BAR;
            }
        }
        if constexpr (ALIGN_EPI) { if (wr == 0) PG8_BAR; }
        if constexpr (!Epi::AFTER_DRAIN) { E(acc, cur, wr, wc, fr, fq); S.done(cur); }
        if (!has_next) break;
#pragma unroll
        for (int a = 0; a < 2; ++a)
#pragma unroll
            for (int b = 0; b < 2; ++b)
#pragma unroll
                for (int m = 0; m < 4; ++m)
#pragma unroll
                    for (int n = 0; n < 2; ++n) acc[a][b][m][n] = (f32x4){0.f, 0.f, 0.f, 0.f};
        cur = nxt; cA = nA; cB = nB; ++ui;
        if constexpr (ALIGN_EPI) { if (wr == 1) PG8_BAR; }
    }
    PG8_WAIT_V(0);
    if constexpr (!ALIGN_EPI) { if (wr == 0) PG8_BAR; }
    PG8_BAR;
    if constexpr (Epi::AFTER_DRAIN) { E.fused(acc, cur, wr, wc, fr, fq, lds, wid, lane); S.done(cur); }
#undef PG8_SA
#undef PG8_SB
#undef PG8_STAGE
#undef PG8_LDA
#undef PG8_LDB
#undef PG8_MMA
#undef PG8_WAIT_V
#undef PG8_WAIT_L
#undef PG8_BAR
#undef PG8_SCHED
}
template <class Epi, class Sched>
__device__ __forceinline__ void gemm_phase_gather(PG8_LAS unsigned char* lds, const Gemm g, const int* idx, const Sched& S, const Epi& E, const int tz = 0  ) {
    const int tid = threadIdx.x + tz, wid = __builtin_amdgcn_readfirstlane(tid >> 6), lane = tid & 63, wr = wid >> 2, wc = wid & 3, fr = lane & 15, fq = lane >> 4;
    const int K = g.K, nt = K / BK;
    unsigned voffA[2], voffB[2];
    int rowA[2];
#pragma unroll
    for (int i = 0; i < 2; ++i) { int R, C; stage_rc(tid * 16 + i * 8192, R, C); const int Rb = Epi::PERM ? ((R & ~31) + perm32(R & 31)) : R;
        voffA[i] = (unsigned)C * 2u; rowA[i] = R; voffB[i] = (unsigned)(Rb * K + C) * 2u; }
    unsigned vA0[2], vA1[2], vN0[2], vN1[2];
#define PG8_GOFF(dst0, dst1, pm_) do { _Pragma("unroll") for (int _i = 0; _i < 2; ++_i) { dst0[_i] = (unsigned)idx[(pm_) * BM + rowA[_i]] * (unsigned)(K * 2) + voffA[_i]; dst1[_i] = (unsigned)idx[(pm_) * BM + HALF + rowA[_i]] * (unsigned)(K * 2) + voffA[_i]; } } while (0)
    const size_t kstep = (size_t)(BK * 2);
    const size_t hstep = (size_t)HALF * K * 2;
    const size_t tstep = 2 * hstep;
    const unsigned ldsw = (unsigned)wid * 1024u;
    const int aoff = lds_byte(wr * 64 + fr, fq * 8), boff = lds_byte(wc * 32 + fr, fq * 8);
#define PG8_SA(b, h) (((b) * 2 + (h)) * HTB)
#define PG8_SB(b, h) ((4 + (b) * 2 + (h)) * HTB)
#define PG8_STAGE(bufoff, gbase, voff) do { _Pragma("unroll") for (int _i = 0; _i < 2; ++_i) \
        __builtin_amdgcn_global_load_lds((const unsigned*)((const char*)(gbase) + (voff)[_i]), (PG8_LAS unsigned*)(lds + (bufoff) + ldsw + _i * 8192), 16, 0, 0); } while (0)
#define PG8_LDA(dst, b, h) do { _Pragma("unroll") for (int m = 0; m < 4; ++m) _Pragma("unroll") for (int k = 0; k < 2; ++k) dst[m][k] = *(const PG8_LAS bf16x8*)(lds + PG8_SA(b, h) + aoff + m * 2048 + k * 1024); } while (0)
#define PG8_LDB(dst, b, h) do { _Pragma("unroll") for (int n = 0; n < 2; ++n) _Pragma("unroll") for (int k = 0; k < 2; ++k) dst[n][k] = *(const PG8_LAS bf16x8*)(lds + PG8_SB(b, h) + boff + n * 2048 + k * 1024); } while (0)
#define PG8_MMA(ai, bj, At, Bt) do { __builtin_amdgcn_s_setprio(1); _Pragma("unroll") for (int m = 0; m < 4; ++m) _Pragma("unroll") for (int n = 0; n < 2; ++n) _Pragma("unroll") for (int k = 0; k < 2; ++k) \
        acc[ai][bj][m][n] = __builtin_amdgcn_mfma_f32_16x16x32_bf16(Bt[n][k], At[m][k], acc[ai][bj][m][n], 0, 0, 0); __builtin_amdgcn_s_setprio(0); } while (0)
#define PG8_WAIT_V(n) asm volatile("s_waitcnt vmcnt(" #n ")" ::: "memory")
#define PG8_WAIT_L(n) asm volatile("s_waitcnt lgkmcnt(" #n ")" ::: "memory")
#define PG8_BAR __builtin_amdgcn_s_barrier()
#define PG8_SCHED __builtin_amdgcn_sched_barrier(0)
    Unit cur, nxt; int ui = 0;
    if (!S.next(0, cur)) return;
    f32x4 acc[2][2][4][2];
#pragma unroll
    for (int a = 0; a < 2; ++a)
#pragma unroll
        for (int b = 0; b < 2; ++b)
#pragma unroll
            for (int m = 0; m < 4; ++m)
#pragma unroll
                for (int n = 0; n < 2; ++n) acc[a][b][m][n] = (f32x4){0.f, 0.f, 0.f, 0.f};
    bf16x8 At[4][2], B0[2][2], B1[2][2];
    const char* cA = (const char*)g.A; PG8_GOFF(vA0, vA1, cur.pm); const char* cB = (const char*)g.Bt + (size_t)cur.pn * tstep;
    S.a_ready(cur);
    if constexpr (true) {
        PG8_STAGE(PG8_SB(0, 0), cB, voffB); PG8_STAGE(PG8_SB(0, 1), cB + hstep, voffB); PG8_STAGE(PG8_SA(0, 0), cA, vA0); PG8_STAGE(PG8_SA(0, 1), cA, vA1);
        if (wr == 1) PG8_BAR;
        PG8_WAIT_V(2); PG8_BAR;
        PG8_STAGE(PG8_SB(1, 0), cB + kstep, voffB); PG8_STAGE(PG8_SA(1, 0), cA + kstep, vA0); PG8_STAGE(PG8_SB(1, 1), cB + hstep + kstep, voffB);
        PG8_WAIT_V(6); PG8_BAR;
    } else {
        PG8_STAGE(PG8_SB(0, 0), cB, voffB); PG8_STAGE(PG8_SA(0, 0), cA, voffA); PG8_STAGE(PG8_SB(0, 1), cB + hstep, voffB); PG8_STAGE(PG8_SA(0, 1), cA + hstep, voffA);
        if (wr == 1) PG8_BAR;
        PG8_WAIT_V(4); PG8_BAR;
        PG8_STAGE(PG8_SB(1, 0), cB + kstep, voffB); PG8_STAGE(PG8_SA(1, 0), cA + kstep, vA0); PG8_STAGE(PG8_SB(1, 1), cB + hstep + kstep, voffB);
        PG8_WAIT_V(6); PG8_BAR;
    }
    for (;;) {
        const bool has_next = S.next(ui + 1, nxt);
        const char* nA = cA; if (has_next) PG8_GOFF(vN0, vN1, nxt.pm); else { vN0[0] = vA0[0]; vN0[1] = vA0[1]; vN1[0] = vA1[0]; vN1[1] = vA1[1]; } const char* nB = has_next ? (const char*)g.Bt + (size_t)nxt.pn * tstep : cB;
        for (int t = 0; t < nt; t += 2) {
            if constexpr (Epi::HAS_MID) { if (t == (nt >> 1)) E.mid(acc, cur, wr, wc, fr, fq); }
            const bool last = (t == nt - 2);
            const char* a1 = cA + (size_t)(t + 1) * kstep;
            const char* a2 = last ? nA : cA + (size_t)(t + 2) * kstep; unsigned x0[2], x1[2]; x0[0] = last ? vN0[0] : vA0[0]; x0[1] = last ? vN0[1] : vA0[1]; x1[0] = last ? vN1[0] : vA1[0]; x1[1] = last ? vN1[1] : vA1[1]; const char* b2 = last ? nB : cB + (size_t)(t + 2) * kstep;
            const char* a3 = a2 + kstep; const char* b3 = b2 + kstep;
            if (last && has_next) S.a_ready(nxt);
            if constexpr (true) {
            PG8_LDB(B0, 0, 0); PG8_LDB(B1, 0, 1); PG8_SCHED; PG8_LDA(At, 0, 0); PG8_STAGE(PG8_SA(1, 1), a1, vA1);
            PG8_WAIT_V(8); PG8_WAIT_L(0); PG8_BAR; PG8_MMA(0, 0, At, B0); PG8_MMA(0, 1, At, B1); PG8_BAR; PG8_SCHED;
            PG8_LDA(At, 0, 1); PG8_STAGE(PG8_SB(0, 0), b2, voffB); PG8_STAGE(PG8_SB(0, 1), b2 + hstep, voffB); PG8_STAGE(PG8_SA(0, 0), a2, x0);
            PG8_WAIT_V(8); PG8_WAIT_L(0); PG8_BAR; PG8_MMA(1, 0, At, B0); PG8_MMA(1, 1, At, B1); PG8_BAR; PG8_SCHED;
            PG8_LDB(B0, 1, 0); PG8_LDB(B1, 1, 1); PG8_SCHED; PG8_LDA(At, 1, 0); PG8_STAGE(PG8_SA(0, 1), a2, x1);
            PG8_WAIT_V(8); PG8_WAIT_L(0); PG8_BAR; PG8_MMA(0, 0, At, B0); PG8_MMA(0, 1, At, B1); PG8_BAR; PG8_SCHED;
            PG8_LDA(At, 1, 1); PG8_STAGE(PG8_SB(1, 0), b3, voffB); PG8_STAGE(PG8_SB(1, 1), b3 + hstep, voffB); PG8_STAGE(PG8_SA(1, 0), a3, x0);
            PG8_WAIT_V(8); PG8_WAIT_L(0); PG8_BAR; PG8_MMA(1, 0, At, B0); PG8_MMA(1, 1, At, B1); PG8_BAR; PG8_SCHED;
            } else {
            PG8_LDB(B0, 0, 0); PG8_SCHED; PG8_LDA(At, 0, 0); PG8_STAGE(PG8_SA(1, 1), a1, vA1);
            PG8_WAIT_L(8); PG8_BAR; PG8_WAIT_L(0); PG8_MMA(0, 0, At, B0); PG8_BAR; PG8_SCHED;
            PG8_LDB(B1, 0, 1); PG8_STAGE(PG8_SB(0, 0), b2, voffB);
            PG8_BAR; PG8_WAIT_L(0); PG8_MMA(0, 1, At, B1); PG8_BAR;
            PG8_LDA(At, 0, 1); PG8_STAGE(PG8_SA(0, 0), a2, x0);
            PG8_BAR; PG8_WAIT_L(0); PG8_MMA(1, 0, At, B0); PG8_BAR; PG8_SCHED;
            PG8_STAGE(PG8_SB(0, 1), b2 + hstep, voffB);
            PG8_WAIT_V(6); PG8_BAR; PG8_MMA(1, 1, At, B1); PG8_BAR;
            PG8_LDB(B0, 1, 0); PG8_SCHED; PG8_LDA(At, 1, 0); PG8_STAGE(PG8_SA(0, 1), a2, x1);
            PG8_WAIT_L(8); PG8_BAR; PG8_WAIT_L(0); PG8_MMA(0, 0, At, B0); PG8_BAR; PG8_SCHED;
            PG8_LDB(B1, 1, 1); PG8_STAGE(PG8_SB(1, 0), b3, voffB);
            PG8_BAR; PG8_WAIT_L(0); PG8_MMA(0, 1, At, B1); PG8_BAR;
            PG8_LDA(At, 1, 1); PG8_STAGE(PG8_SA(1, 0), a3, x0);
            PG8_BAR; PG8_WAIT_L(0); PG8_MMA(1, 0, At, B0); PG8_BAR; PG8_SCHED;
            PG8_STAGE(PG8_SB(1, 1), b3 + hstep, voffB);
            PG8_WAIT_V(6); PG8_BAR; PG8_MMA(1, 1, At, B1); PG8_BAR;
            }
        }
        if constexpr (true) { if (wr == 0) PG8_BAR; }
        if constexpr (!Epi::AFTER_DRAIN) { E(acc, cur, wr, wc, fr, fq); S.done(cur); }
        if (!has_next) break;
#pragma unroll
        for (int a = 0; a < 2; ++a)
#pragma unroll
            for (int b = 0; b < 2; ++b)
#pragma unroll
                for (int m = 0; m < 4; ++m)
#pragma unroll
                    for (int n = 0; n < 2; ++n) acc[a][b][m][n] = (f32x4){0.f, 0.f, 0.f, 0.f};
        cur = nxt; cA = nA; cB = nB; ++ui; vA0[0] = vN0[0]; vA0[1] = vN0[1]; vA1[0] = vN1[0]; vA1[1] = vN1[1];
        if constexpr (true) { if (wr == 1) PG8_BAR; }
    }
    PG8_WAIT_V(0);
    if constexpr (false) { if (wr == 0) PG8_BAR; }
    PG8_BAR;
    if constexpr (Epi::AFTER_DRAIN) { E.fused(acc, cur, wr, wc, fr, fq, lds, wid, lane); S.done(cur); }
#undef PG8_SA
#undef PG8_SB
#undef PG8_GOFF
#undef PG8_STAGE
#undef PG8_LDA
#undef PG8_LDB
#undef PG8_MMA
#undef PG8_WAIT_V
#undef PG8_WAIT_L
#undef PG8_BAR
#undef PG8_SCHED
}
}

constexpr int NB = 8, SEQ = 4096, DM = 1024, T = NB * SEQ;
constexpr int RW = 512, NHR = 8;
constexpr int NPROJ = 5376;
constexpr int FF = 512, NEXP = 32;
constexpr float C2 = 0.125f * 1.4426950408889634f;
constexpr float LAM_INIT = 0.2f;
constexpr int MAXROWS = 2 * T + NEXP * 256;

constexpr size_t MiB = 1u << 20;
constexpr size_t WS_CTL = 0, CTL_ZERO_BYTES = 1 * MiB;
constexpr size_t WS_WLORA = 1 * MiB;
constexpr size_t WS_WBRD = 2 * MiB;
constexpr size_t WS_WO = 4 * MiB;
constexpr size_t WS_WR = 6 * MiB;
constexpr size_t WS_WPG = 7 * MiB;
constexpr size_t WS_WPP = 9 * MiB;
constexpr size_t WS_TOKE = 10 * MiB;
constexpr size_t WS_TOKW = 10 * MiB + 256 * 1024;
constexpr size_t WS_POS = 10 * MiB + 512 * 1024;
constexpr size_t WS_ROWW = 10 * MiB + 768 * 1024;
constexpr size_t WS_TILECNT = 11 * MiB + 256 * 1024;
constexpr size_t WS_DISP = 11 * MiB + 512 * 1024;
constexpr size_t WS_BON = 12 * MiB;
constexpr size_t WS_ROWTOK = 13 * MiB;
constexpr size_t WS_WIN = 16 * MiB;
constexpr size_t WS_LOGITS = 16 * MiB;
constexpr size_t WS_XN = 32 * MiB;
constexpr size_t WS_WGU = 32 * MiB;
constexpr size_t WS_RKV = 96 * MiB;
constexpr size_t WS_MIXED = 96 * MiB;
constexpr size_t WS_WD = 96 * MiB;
constexpr size_t WS_HS = 128 * MiB;
constexpr size_t WS_H3 = 128 * MiB;
constexpr size_t WS_PROJB = 192 * MiB;
constexpr size_t WS_E = 192 * MiB;
constexpr size_t WS_A = 224 * MiB;
constexpr size_t WS_G = 256 * MiB;
constexpr size_t WS_P16 = 192 * MiB;
constexpr size_t WS_PP = 208 * MiB;
constexpr size_t WS_Y2 = 272 * MiB;
constexpr size_t WS_GATES = 304 * MiB;
constexpr size_t WS_H2X = 304 * MiB;
constexpr size_t WS_VT = 432 * MiB;
constexpr size_t WS_ACT = 432 * MiB;
constexpr size_t WS_X2 = 432 * MiB;
constexpr size_t WS_PART = 176 * MiB;
constexpr size_t WS_END = 512 * MiB;
constexpr size_t OUT_STASH = 0, OUT_ORWDF = 32 * MiB, OUT_Y = 96 * MiB  , OUT_LA = 0  ;
static_assert(WS_ACT + (size_t)MAXROWS * 512 * 2 <= WS_END && WS_Y2 + (size_t)MAXROWS * 1024 * 2 <= WS_ACT && WS_HS + (size_t)MAXROWS * 1024 * 2 <= WS_Y2, "ws map");
static_assert(WS_PART + (size_t)T * 1024 * 4 <= WS_GATES && WS_MIXED + (size_t)T * 1024 * 2 <= WS_PART, "ws map");
constexpr int CW_QUEUE = 64;
constexpr int CW_BAR = 4096;

constexpr int RING_BYTES = 131072;
constexpr int MISC_OFF = 158720;
constexpr int LDS_BYTES = 160768;
constexpr int NWAVES = 8, NTHR = 512;

#define GAS __attribute__((address_space(1)))
#define LAS __attribute__((address_space(3)))
typedef unsigned short bf16;
typedef unsigned v4u __attribute__((ext_vector_type(4)));
typedef unsigned v2u __attribute__((ext_vector_type(2)));
typedef float f32x4 __attribute__((ext_vector_type(4)));
typedef float f32x16 __attribute__((ext_vector_type(16)));
typedef short s16x8 __attribute__((ext_vector_type(8)));
typedef short s16x4 __attribute__((ext_vector_type(4)));
#define LDS_WAIT() asm volatile("s_waitcnt lgkmcnt(0)" ::: "memory")
#define VM_WAIT() asm volatile("s_waitcnt vmcnt(0)" ::: "memory")

__device__ __forceinline__ bf16* y_ptr(float* out, int b) { return (bf16*)((unsigned char*)out + OUT_Y) + (size_t)b * SEQ * 512; }
__device__ __forceinline__ bf16* qn_ptr(unsigned char* ws, int b) { return (bf16*)(ws + (b < 4 ? (288 + 4 * (size_t)b) * MiB : (464 + 4 * (size_t)(b - 4)) * MiB)); }
__device__ __forceinline__ bf16* kn_ptr(unsigned char* ws, int b) { return (bf16*)(ws + (480 + 4 * (size_t)b) * MiB); }
__device__ __forceinline__ unsigned f2bf(float f) { unsigned u = __builtin_bit_cast(unsigned, f); return (u + 0x7fffu + ((u >> 16) & 1u)) >> 16; }
typedef float f32x2_t __attribute__((ext_vector_type(2))); typedef __bf16 bf16x2_t __attribute__((ext_vector_type(2)));
__device__ __forceinline__ unsigned pk2(float lo, float hi) { f32x2_t v = {lo, hi}; bf16x2_t b = __builtin_convertvector(v, bf16x2_t); return __builtin_bit_cast(unsigned, b); }
__device__ __forceinline__ float bflo(unsigned w) { return __builtin_bit_cast(float, w << 16); }
__device__ __forceinline__ float bfhi(unsigned w) { return __builtin_bit_cast(float, w & 0xffff0000u); }
__device__ __forceinline__ float sigm(float x) { return __builtin_amdgcn_rcpf(1.0f + __builtin_amdgcn_exp2f(-1.4426950408889634f * x)); }
template <int CTRL> __device__ __forceinline__ float dpp_mov(float v) { return __builtin_bit_cast(float, __builtin_amdgcn_update_dpp(0, __builtin_bit_cast(int, v), CTRL, 0xF, 0xF, false)); }
__device__ __forceinline__ float red8(float v) { v += dpp_mov<0xB1>(v); v += dpp_mov<0x4E>(v); v += dpp_mov<0x141>(v); return v; }
__device__ __forceinline__ float red16(float v) { v = red8(v); v += dpp_mov<0x140>(v); return v; }
__device__ __forceinline__ void swap32(unsigned& a, unsigned& b) { asm volatile("s_nop 1\n\tv_permlane32_swap_b32 %0, %1\n\ts_nop 1" : "+v"(a), "+v"(b)); }
__device__ __forceinline__ float xhalf_max(float m) { unsigned a = __builtin_bit_cast(unsigned, m), b = a; swap32(a, b); return fmaxf(__builtin_bit_cast(float, a), __builtin_bit_cast(float, b)); }
__device__ __forceinline__ float xhalf_sum(float m) { unsigned a = __builtin_bit_cast(unsigned, m), b = a; swap32(a, b); return __builtin_bit_cast(float, a) + __builtin_bit_cast(float, b); }
__device__ __forceinline__ float wave_sum(float v) { v = red16(v); v += __shfl_xor(v, 16); return xhalf_sum(v); }

namespace pg8 {
struct EpiStore {
    static constexpr bool PERM = true, AFTER_DRAIN = false, HAS_MID = false;
    bf16_t* O; int ldc;
    __device__ __forceinline__ void operator()(const f32x4 (&acc)[2][2][4][2], const Unit& u, int wr, int wc, int fr, int fq) const {
        const int row0 = u.pm * BM + wr * 64 + fr, col0 = u.pn * BM + wc * 32 + 8 * fq;
#pragma unroll
        for (int ai = 0; ai < 2; ++ai)
#pragma unroll
            for (int m = 0; m < 4; ++m) { bf16_t* rowp = O + (size_t)(row0 + ai * HALF + m * 16) * ldc + col0;
#pragma unroll
                for (int bj = 0; bj < 2; ++bj) { const f32x4 v0 = acc[ai][bj][m][0], v1 = acc[ai][bj][m][1]; u32x4 w;
                    w.x = cvt_pk_bf16(v0[0], v0[1]); w.y = cvt_pk_bf16(v0[2], v0[3]); w.z = cvt_pk_bf16(v1[0], v1[1]); w.w = cvt_pk_bf16(v1[2], v1[3]);
                    *(u32x4*)(rowp + bj * HALF) = w; } }
    }
};
struct EpiProj {
    static constexpr bool PERM = true, AFTER_DRAIN = false, HAS_MID = false;
    bf16_t *rkv, *projb, *gates;
    __device__ __forceinline__ void operator()(const f32x4 (&acc)[2][2][4][2], const Unit& u, int wr, int wc, int fr, int fq) const {
        bf16_t* base; int ldc, ct;
        if (u.pn < 6) { base = rkv; ldc = 1536; ct = u.pn; } else if (u.pn < 11) { base = projb; ldc = 1280; ct = u.pn - 6; } else { base = gates; ldc = 2048; ct = u.pn - 13; }
        const int row0 = u.pm * BM + wr * 64 + fr, col0 = ct * BM + wc * 32 + 8 * fq;
#pragma unroll
        for (int ai = 0; ai < 2; ++ai)
#pragma unroll
            for (int m = 0; m < 4; ++m) { bf16_t* rowp = base + (size_t)(row0 + ai * HALF + m * 16) * ldc + col0;
#pragma unroll
                for (int bj = 0; bj < 2; ++bj) { f32x4 v0 = acc[ai][bj][m][0], v1 = acc[ai][bj][m][1]; u32x4 w;
                    if (u.pn >= 13) {
#pragma unroll
                        for (int e = 0; e < 4; ++e) { v0[e] = fmaxf(sigm(v0[e]), 1e-6f); v1[e] = fmaxf(sigm(v1[e]), 1e-6f); } }
                    w.x = cvt_pk_bf16(v0[0], v0[1]); w.y = cvt_pk_bf16(v0[2], v0[3]); w.z = cvt_pk_bf16(v1[0], v1[1]); w.w = cvt_pk_bf16(v1[2], v1[3]);
                    *(u32x4*)(rowp + bj * HALF) = w; } }
    }
};
struct EpiLora {
    static constexpr bool PERM = true, AFTER_DRAIN = false, HAS_MID = false;
    bf16_t *E, *A, *G; const float *w0, *a0;
    template <int KIND> __device__ __forceinline__ void body(const f32x4 (&acc)[2][2][4][2], bf16_t* base, const float* bias, int row0, int col0) const {
#pragma unroll
        for (int bj = 0; bj < 2; ++bj)
#pragma unroll
            for (int ai = 0; ai < 2; ++ai)
#pragma unroll
                for (int m = 0; m < 4; ++m) { bf16_t* rowp = base + (size_t)(row0 + ai * HALF + m * 16) * 512 + col0 + bj * HALF;
                    f32x4 v0 = acc[ai][bj][m][0], v1 = acc[ai][bj][m][1];
                    if (KIND < 2) { const f32x4 b0 = *(const f32x4*)(bias + col0 + bj * HALF), b1 = *(const f32x4*)(bias + col0 + bj * HALF + 4); const float sc = KIND == 0 ? 0.60653065971263342f : 1.0f;
                        v0 += b0; v1 += b1;
#pragma unroll
                        for (int e = 0; e < 4; ++e) { v0[e] = sc * sigm(v0[e]); v1[e] = sc * sigm(v1[e]); } }
                    u32x4 w; w.x = cvt_pk_bf16(v0[0], v0[1]); w.y = cvt_pk_bf16(v0[2], v0[3]); w.z = cvt_pk_bf16(v1[0], v1[1]); w.w = cvt_pk_bf16(v1[2], v1[3]);
                    *(u32x4*)rowp = w; asm volatile("" ::: "memory"); }
    }
    __device__ __forceinline__ void operator()(const f32x4 (&acc)[2][2][4][2], const Unit& u, int wr, int wc, int fr, int fq) const {
        const int kind = u.pn >> 1; const int row0 = u.pm * BM + wr * 64 + fr, col0 = (u.pn & 1) * BM + wc * 32 + 8 * fq;
        if (kind == 0) body<0>(acc, E, w0, row0, col0); else if (kind == 1) body<1>(acc, A, a0, row0, col0); else body<2>(acc, G, w0, row0, col0);
    }
};
struct EpiMix {
    static constexpr bool PERM = true, AFTER_DRAIN = false, HAS_MID = true;
    const bf16_t* gates; bf16_t* mixed;
    __device__ __forceinline__ void mid(f32x4 (&acc)[2][2][4][2], const Unit& u, int wr, int wc, int fr, int fq) const {
        const int row0 = u.pm * BM + wr * 64 + fr, col0 = u.pn * BM + wc * 32 + 8 * fq;
#pragma unroll
        for (int ai = 0; ai < 2; ++ai)
#pragma unroll
            for (int m = 0; m < 4; ++m) { const size_t r = (size_t)(row0 + ai * HALF + m * 16);
#pragma unroll
                for (int bj = 0; bj < 2; ++bj) { const int c = col0 + bj * HALF;
                    const u32x4 gr = *(const u32x4*)(gates + r * 2048 + c), gd = *(const u32x4*)(gates + r * 2048 + 1024 + c);
                    f32x4& v0 = acc[ai][bj][m][0]; f32x4& v1 = acc[ai][bj][m][1];
                    v0[0] *= bflo(gr.x) * __builtin_amdgcn_rcpf(bflo(gd.x)); v0[1] *= bfhi(gr.x) * __builtin_amdgcn_rcpf(bfhi(gd.x)); v0[2] *= bflo(gr.y) * __builtin_amdgcn_rcpf(bflo(gd.y)); v0[3] *= bfhi(gr.y) * __builtin_amdgcn_rcpf(bfhi(gd.y));
                    v1[0] *= bflo(gr.z) * __builtin_amdgcn_rcpf(bflo(gd.z)); v1[1] *= bfhi(gr.z) * __builtin_amdgcn_rcpf(bfhi(gd.z)); v1[2] *= bflo(gr.w) * __builtin_amdgcn_rcpf(bflo(gd.w)); v1[3] *= bfhi(gr.w) * __builtin_amdgcn_rcpf(bfhi(gd.w)); }
                asm volatile("" ::: "memory"); }
    }
    __device__ __forceinline__ void operator()(const f32x4 (&acc)[2][2][4][2], const Unit& u, int wr, int wc, int fr, int fq) const {
        const int row0 = u.pm * BM + wr * 64 + fr, col0 = u.pn * BM + wc * 32 + 8 * fq;
#pragma unroll
        for (int ai = 0; ai < 2; ++ai)
#pragma unroll
            for (int m = 0; m < 4; ++m) { const size_t r = (size_t)(row0 + ai * HALF + m * 16);
#pragma unroll
                for (int bj = 0; bj < 2; ++bj) { const int c = col0 + bj * HALF;
                    const u32x4 gd = *(const u32x4*)(gates + r * 2048 + 1024 + c);
                    f32x4 v0 = acc[ai][bj][m][0], v1 = acc[ai][bj][m][1];
                    v0[0] *= bflo(gd.x); v0[1] *= bfhi(gd.x); v0[2] *= bflo(gd.y); v0[3] *= bfhi(gd.y); v1[0] *= bflo(gd.z); v1[1] *= bfhi(gd.z); v1[2] *= bflo(gd.w); v1[3] *= bfhi(gd.w);
                    u32x4 w; w.x = cvt_pk_bf16(v0[0], v0[1]); w.y = cvt_pk_bf16(v0[2], v0[3]); w.z = cvt_pk_bf16(v1[0], v1[1]); w.w = cvt_pk_bf16(v1[2], v1[3]);
                    *(u32x4*)(mixed + r * 1024 + c) = w; } }
    }
};
struct EpiRes {
    static constexpr bool PERM = true, AFTER_DRAIN = false, HAS_MID = false;
    const float* x; bf16_t* x1;
    __device__ __forceinline__ void operator()(const f32x4 (&acc)[2][2][4][2], const Unit& u, int wr, int wc, int fr, int fq) const {
        const int row0 = u.pm * BM + wr * 64 + fr, col0 = u.pn * BM + wc * 32 + 8 * fq;
#pragma unroll
        for (int ai = 0; ai < 2; ++ai)
#pragma unroll
            for (int m = 0; m < 4; ++m) { const size_t off = (size_t)(row0 + ai * HALF + m * 16) * 1024 + col0;
#pragma unroll
                for (int bj = 0; bj < 2; ++bj) { const f32x4 v0 = *(const f32x4*)(x + off + bj * HALF) + acc[ai][bj][m][0], v1 = *(const f32x4*)(x + off + bj * HALF + 4) + acc[ai][bj][m][1]; u32x4 w;
                    w.x = cvt_pk_bf16(v0[0], v0[1]); w.y = cvt_pk_bf16(v0[2], v0[3]); w.z = cvt_pk_bf16(v1[0], v1[1]); w.w = cvt_pk_bf16(v1[2], v1[3]);
                    *(u32x4*)(x1 + off + bj * HALF) = w; } }
    }
};
struct EpiLogits {
    static constexpr bool PERM = false, AFTER_DRAIN = false, HAS_MID = false;
    float* L;
    __device__ __forceinline__ void operator()(const f32x4 (&acc)[2][2][4][2], const Unit& u, int wr, int wc, int fr, int fq) const {
        const int row0 = u.pm * BM + wr * 64 + fr, col0 = wc * 32 + 4 * fq;
#pragma unroll
        for (int ai = 0; ai < 2; ++ai)
#pragma unroll
            for (int m = 0; m < 4; ++m) { float* rowp = L + (size_t)(row0 + ai * HALF + m * 16) * 128 + col0;
#pragma unroll
                for (int n = 0; n < 2; ++n) *(f32x4*)(rowp + n * 16) = acc[ai][0][m][n]; }
    }
};
struct EpiAct {
    static constexpr bool PERM = true, AFTER_DRAIN = false, HAS_MID = false;
    bf16_t* act;
    __device__ __forceinline__ void operator()(const f32x4 (&acc)[2][2][4][2], const Unit& u, int wr, int wc, int fr, int fq) const {
        const int row0 = u.pm * BM + wr * 64 + fr, col0 = (u.pn & 3) * HALF + wc * 32 + 8 * fq;
#pragma unroll
        for (int ai = 0; ai < 2; ++ai)
#pragma unroll
            for (int m = 0; m < 4; ++m) { bf16_t* rowp = act + (size_t)(row0 + ai * HALF + m * 16) * 512 + col0; float o[8];
#pragma unroll
                for (int n = 0; n < 2; ++n)
#pragma unroll
                    for (int e = 0; e < 4; ++e) { const float g = acc[ai][0][m][n][e], up = acc[ai][1][m][n][e]; o[n * 4 + e] = g * sigm(g) * up; }
                u32x4 w; w.x = cvt_pk_bf16(o[0], o[1]); w.y = cvt_pk_bf16(o[2], o[3]); w.z = cvt_pk_bf16(o[4], o[5]); w.w = cvt_pk_bf16(o[6], o[7]);
                *(u32x4*)rowp = w; }
    }
};
struct EpiDown {
    static constexpr bool PERM = true, AFTER_DRAIN = false, HAS_MID = false;
    bf16_t* y2; const float* roww;
    __device__ __forceinline__ void operator()(const f32x4 (&acc)[2][2][4][2], const Unit& u, int wr, int wc, int fr, int fq) const {
        const int row0 = u.pm * BM + wr * 64 + fr, col0 = (u.pn & 3) * BM + wc * 32 + 8 * fq;
#pragma unroll
        for (int ai = 0; ai < 2; ++ai)
#pragma unroll
            for (int m = 0; m < 4; ++m) { const int r = row0 + ai * HALF + m * 16; const float w8 = roww[r]; bf16_t* rowp = y2 + (size_t)r * 1024 + col0;
#pragma unroll
                for (int bj = 0; bj < 2; ++bj) { const f32x4 v0 = acc[ai][bj][m][0] * w8, v1 = acc[ai][bj][m][1] * w8; u32x4 w;
                    w.x = cvt_pk_bf16(v0[0], v0[1]); w.y = cvt_pk_bf16(v0[2], v0[3]); w.z = cvt_pk_bf16(v1[0], v1[1]); w.w = cvt_pk_bf16(v1[2], v1[3]);
                    *(u32x4*)(rowp + bj * HALF) = w; } }
    }
};
struct EpiFinal {
    static constexpr bool PERM = true, AFTER_DRAIN = false, HAS_MID = false;
    const bf16_t* pp; const bf16_t* x2; float* out;
    __device__ __forceinline__ void operator()(const f32x4 (&acc)[2][2][4][2], const Unit& u, int wr, int wc, int fr, int fq) const {
        const int row0 = u.pm * BM + wr * 64 + fr, col0 = u.pn * BM + wc * 32 + 8 * fq;
#pragma unroll
        for (int ai = 0; ai < 2; ++ai)
#pragma unroll
            for (int m = 0; m < 4; ++m) { const size_t r = (size_t)(row0 + ai * HALF + m * 16);
#pragma unroll
                for (int bj = 0; bj < 2; ++bj) { const int c = col0 + bj * HALF;
                    const u32x4 pw = *(const u32x4*)(pp + r * 1024 + c), xw = *(const u32x4*)(x2 + r * 1024 + c); float* op = out + r * 1024 + c;
                    const f32x4 a0 = acc[ai][bj][m][0], a1 = acc[ai][bj][m][1]; f32x4 x0, x1;
                    x0[0] = bflo(xw.x) + sigm(a0[0]) * bflo(pw.x); x0[1] = bfhi(xw.x) + sigm(a0[1]) * bfhi(pw.x); x0[2] = bflo(xw.y) + sigm(a0[2]) * bflo(pw.y); x0[3] = bfhi(xw.y) + sigm(a0[3]) * bfhi(pw.y);
                    x1[0] = bflo(xw.z) + sigm(a1[0]) * bflo(pw.z); x1[1] = bfhi(xw.z) + sigm(a1[1]) * bfhi(pw.z); x1[2] = bflo(xw.w) + sigm(a1[2]) * bflo(pw.w); x1[3] = bfhi(xw.w) + sigm(a1[3]) * bfhi(pw.w);
                    *(f32x4*)op = x0; *(f32x4*)(op + 4) = x1; asm volatile("" ::: "memory"); } }
    }
};
struct EpiGates {
    static constexpr bool PERM = true, AFTER_DRAIN = false, HAS_MID = false;
    bf16_t* gates;
    __device__ __forceinline__ void operator()(const f32x4 (&acc)[2][2][4][2], const Unit& u, int wr, int wc, int fr, int fq) const {
        const int row0 = u.pm * BM + wr * 64 + fr, col0 = u.pn * BM + wc * 32 + 8 * fq;
#pragma unroll
        for (int ai = 0; ai < 2; ++ai)
#pragma unroll
            for (int m = 0; m < 4; ++m) { bf16_t* rowp = gates + (size_t)(row0 + ai * HALF + m * 16) * 2048 + col0;
#pragma unroll
                for (int bj = 0; bj < 2; ++bj) { f32x4 v0 = acc[ai][bj][m][0], v1 = acc[ai][bj][m][1]; u32x4 w;
#pragma unroll
                    for (int e = 0; e < 4; ++e) { v0[e] = fmaxf(sigm(v0[e]), 1e-6f); v1[e] = fmaxf(sigm(v1[e]), 1e-6f); }
                    w.x = cvt_pk_bf16(v0[0], v0[1]); w.y = cvt_pk_bf16(v0[2], v0[3]); w.z = cvt_pk_bf16(v1[0], v1[1]); w.w = cvt_pk_bf16(v1[2], v1[3]);
                    *(u32x4*)(rowp + bj * HALF) = w; } }
    }
};
struct OrderItem {
    int pm, pn0, n;
    __device__ __forceinline__ bool next(int i, Unit& u) const { if (i >= n) return false; u.pm = pm; u.pn = pn0 + i; return true; }
    __device__ __forceinline__ void a_ready(const Unit&) const {}
    __device__ __forceinline__ void done(const Unit&) const {}
};
struct OrderSkipV : StaticOrder {
    __device__ __forceinline__ bool next(int i, Unit& u) const { if (!StaticOrder::next(i, u)) return false; if (u.pn >= 11) u.pn += 2; return true; }
};
struct OrderPair : StaticOrder {
    __device__ __forceinline__ bool next(int i, Unit& u) const { if (!StaticOrder::next(i >> 1, u)) return false; if (i & 1) { u.pm += 128; u.pn += 4; } return true; }
};
struct OrderMoe {
    int nwg, G, c; const PG8_LAS int* tile_e;
    __device__ __forceinline__ bool next(int i, Unit& u) const { const long L = (long)i * G + c; if (L >= nwg) return false; const int rt = (int)(L >> 2); u.pm = rt; u.pn = tile_e[rt] * 4 + (int)(L & 3); return true; }
    __device__ __forceinline__ void a_ready(const Unit&) const {}
    __device__ __forceinline__ void done(const Unit&) const {}
};
}

struct Args { const float* in[36]; float* out; unsigned char* ws; int ph_lo, ph_hi; };

__device__ __forceinline__ void tr_item(const float* W, int N, bf16* WT, int ld, int k0, int n0, size_t dst_row0, int k_off, LAS float* scr, int lane) {
#pragma unroll 8
    for (int i = 0; i < 32; ++i) { const int kk = 2 * i + (lane >> 5); scr[kk * 33 + (lane & 31)] = W[(size_t)(k0 + kk) * N + n0 + (lane & 31)]; }
    LDS_WAIT(); asm volatile("" ::: "memory");
    const int c = lane & 7;
#pragma unroll
    for (int j = 0; j < 4; ++j) { const int n = (lane >> 3) + 8 * j; const LAS float* s = scr + (8 * c) * 33 + n;
        v4u o; o.x = pk2(s[0 * 33], s[1 * 33]); o.y = pk2(s[2 * 33], s[3 * 33]); o.z = pk2(s[4 * 33], s[5 * 33]); o.w = pk2(s[6 * 33], s[7 * 33]);
        *(v4u*)(WT + (dst_row0 + n) * ld + k_off + k0 + 8 * c) = o; }
    LDS_WAIT(); asm volatile("" ::: "memory");
}
__device__ __forceinline__ void tr_matrix(const float* W, int K, int N, bf16* WT, int ld, size_t dst_row0, int k_off, LAS float* scr, int lane, int gw, int NGW) {
    const int nblk = N / 32, nitems = (K / 64) * nblk;
    for (int it = gw; it < nitems; it += NGW) { const int kb = it / nblk, nb = it % nblk; tr_item(W, N, WT, ld, 64 * kb, 32 * nb, dst_row0 + 32 * nb, k_off, scr, lane); }
}
__device__ __forceinline__ void rms_row_to_bf16(const float* xrow, const float* gain, bf16* orow, int lane) {
    const f32x4* xr = (const f32x4*)xrow + lane; f32x4 v[4]; float s = 0.f;
#pragma unroll
    for (int j = 0; j < 4; ++j) { v[j] = xr[64 * j]; s += (v[j].x * v[j].x + v[j].y * v[j].y) + (v[j].z * v[j].z + v[j].w * v[j].w); }
    const float rstd = 1.0f / sqrtf(wave_sum(s) * (1.f / 1024.f) + 1e-6f);
    v2u* o8 = (v2u*)orow + lane;
#pragma unroll
    for (int j = 0; j < 4; ++j) { const f32x4 g = ((const f32x4*)gain)[lane + 64 * j]; v2u o; o.x = pk2(v[j].x * rstd * g.x, v[j].y * rstd * g.y); o.y = pk2(v[j].z * rstd * g.z, v[j].w * rstd * g.w); o8[64 * j] = o; }
}

__device__ __forceinline__ void phase0(const Args& a, LAS unsigned char* lds, int tid, int lane, int wave, int vcu, int G) {
    unsigned char* ws = a.ws;
    LAS float* scr = (LAS float*)(lds + wave * 16384);
    const int gw = vcu * NWAVES + wave, NGW = G * NWAVES; const int gt = vcu * NTHR + tid, NGT = G * NTHR;
    tr_matrix(a.in[3], 1024, NPROJ, (bf16*)(ws + WS_WIN), 1024, 0, 0, scr, lane, gw, NGW);
    tr_matrix(a.in[6], 64, 512, (bf16*)(ws + WS_WLORA), 256, 0, 0, scr, lane, gw, NGW);
    tr_matrix(a.in[8], 64, 512, (bf16*)(ws + WS_WLORA), 256, 512, 64, scr, lane, gw, NGW);
    tr_matrix(a.in[9], 128, 512, (bf16*)(ws + WS_WLORA), 256, 1024, 128, scr, lane, gw, NGW);
    tr_matrix(a.in[22], 512, 1024, (bf16*)(ws + WS_WBRD), 1024, 0, 0, scr, lane, gw, NGW);
    tr_matrix(a.in[23], 512, 1024, (bf16*)(ws + WS_WBRD), 1024, 0, 512, scr, lane, gw, NGW);
    tr_matrix(a.in[24], 1024, 1024, (bf16*)(ws + WS_WO), 1024, 0, 0, scr, lane, gw, NGW);
    tr_matrix(a.in[34], 1024, 1024, (bf16*)(ws + WS_WPG), 1024, 0, 0, scr, lane, gw, NGW);
    tr_matrix(a.in[35], 256, 1024, (bf16*)(ws + WS_WPP), 256, 0, 0, scr, lane, gw, NGW);
    { v4u* wl = (v4u*)(ws + WS_WLORA); const v4u z = (v4u){0u, 0u, 0u, 0u};
      for (int i = gt; i < 1536 * 32; i += NGT) { const int row = i >> 5, kc = (i & 31) * 8; const int blk = row >> 9;
          const bool diag = blk == 0 ? (kc < 64) : (blk == 1 ? (kc >= 64 && kc < 128) : (kc >= 128)); if (!diag) wl[i] = z; } }
    { bf16* wr = (bf16*)(ws + WS_WR); const float* wg = a.in[26]; const float* we = a.in[28];
      for (int i = gt; i < 256 * 1024; i += NGT) { const int row = i >> 10, kk = i & 1023; unsigned short v = 0;
          if (row < 36) v = (unsigned short)f2bf(row < 32 ? we[kk * 32 + row] : wg[kk * 4 + (row - 32)]);
          wr[(size_t)row * 1024 + kk] = v; } }
    for (int m = gw; m < T; m += NGW) rms_row_to_bf16(a.in[0] + (size_t)m * DM, a.in[2], (bf16*)(ws + WS_XN) + (size_t)m * DM, lane);
}

__device__ __forceinline__ void phase2(const Args& a, LAS unsigned char* lds, int tid, int vcu, int G) {
    unsigned char* ws = a.ws;
    const bf16* projb = (const bf16*)(ws + WS_PROJB); const float* mu = a.in[4];
    bf16* la = (bf16*)((unsigned char*)a.out + OUT_LA);
    LAS float* cs = (LAS float*)lds;
    for (int tile = vcu; tile < T / 64; tile += G) {
        const int t0 = tile * 64;
        __syncthreads();
#pragma unroll
        for (int i = 0; i < 4; ++i) { const int idx = tid + 512 * i, tok = idx >> 5, i32 = idx & 31; const int s = (t0 + tok) & (SEQ - 1);
            const float inv = exp2f(-(float)i32 * (13.287712379549449f / 32.0f)); const float ang = (float)s * inv;
            const float rev = ang * 0.15915494309189535f, fr = rev - floorf(rev);
            cs[(tok * 32 + i32) * 2] = __builtin_amdgcn_cosf(fr); cs[(tok * 32 + i32) * 2 + 1] = __builtin_amdgcn_sinf(fr); }
#pragma unroll
        for (int i = 0; i < 4; ++i) { const int idx = tid + 512 * i, tok = idx >> 5, ch = idx & 31, t = t0 + tok, j0 = ch * 8; const bool first = (t & (SEQ - 1)) == 0;
            const v4u cur = *(const v4u*)(projb + (size_t)t * 1280 + j0); v4u prv = (v4u){0u, 0u, 0u, 0u}; if (!first) prv = *(const v4u*)(projb + (size_t)(t - 1) * 1280 + j0);
            const f32x4 m0 = *(const f32x4*)(mu + 1536 + j0), m1 = *(const f32x4*)(mu + 1536 + j0 + 4);
            float x[8]; const unsigned cw[4] = {cur.x, cur.y, cur.z, cur.w}, pw[4] = {prv.x, prv.y, prv.z, prv.w}; const float mm[8] = {m0.x, m0.y, m0.z, m0.w, m1.x, m1.y, m1.z, m1.w};
#pragma unroll
            for (int e = 0; e < 4; ++e) { const float c0 = bflo(cw[e]), c1 = bfhi(cw[e]), p0 = bflo(pw[e]), p1 = bfhi(pw[e]); x[2 * e] = c0 + (p0 - c0) * mm[2 * e]; x[2 * e + 1] = c1 + (p1 - c1) * mm[2 * e + 1]; }
            if (ch < 8) {
#pragma unroll
                for (int e = 0; e < 8; ++e) x[e] = tanhf(x[e]);
            } else if (ch >= 16) {
#pragma unroll
                for (int e = 0; e < 8; ++e) x[e] = sigm(x[e]);
            }
            v4u o; o.x = pk2(x[0], x[1]); o.y = pk2(x[2], x[3]); o.z = pk2(x[4], x[5]); o.w = pk2(x[6], x[7]);
            *(v4u*)(la + (size_t)t * 256 + j0) = o; }
        __syncthreads();
        for (int i = 0; i < 16; ++i) { const int idx = tid + 512 * i, tok = idx >> 7, grp = (idx >> 3) & 15, l8 = idx & 7, t = t0 + tok;
            const bf16* src = projb + (size_t)t * 1280 + 256 + grp * 64 + l8 * 4;
            const v2u wl = *(const v2u*)src, wh = *(const v2u*)(src + 32);
            float xl[4] = {bflo(wl.x), bfhi(wl.x), bflo(wl.y), bfhi(wl.y)}, xh[4] = {bflo(wh.x), bfhi(wh.x), bflo(wh.y), bfhi(wh.y)};
            float ss = 0.f;
#pragma unroll
            for (int e = 0; e < 4; ++e) ss += xl[e] * xl[e] + xh[e] * xh[e];
            ss = red8(ss);
            const float rs = (1.0f / sqrtf(ss * (1.f / 64.f) + 1e-6f)) * (grp < 8 ? C2 : 1.f);
            const float* gn = (grp < 8 ? a.in[15] : a.in[16]) + l8 * 4;
            const f32x4 gl = *(const f32x4*)gn, gh = *(const f32x4*)(gn + 32);
            float ol[4], oh[4];
#pragma unroll
            for (int e = 0; e < 4; ++e) { const float yl = xl[e] * rs * gl[e], yh = xh[e] * rs * gh[e]; const int ci = (tok * 32 + l8 * 4 + e) * 2; const float c = cs[ci], sn = cs[ci + 1];
                ol[e] = yl * c - yh * sn; oh[e] = yh * c + yl * sn; }
            const int b = t >> 12, s = t & (SEQ - 1); bf16* dst = (grp < 8 ? qn_ptr(ws, b) : kn_ptr(ws, b)) + ((size_t)(grp & 7) * SEQ + s) * 64 + l8 * 4;
            *(v2u*)dst = (v2u){pk2(ol[0], ol[1]), pk2(ol[2], ol[3])}; *(v2u*)(dst + 32) = (v2u){pk2(oh[0], oh[1]), pk2(oh[2], oh[3])}; }
    }
}

constexpr int SC_NB = 32, SC_REC = 392;
constexpr int SC_BUF = SC_NB * SC_REC * 4;
constexpr int SC_YOFF = 2 * SC_BUF;
struct ScanIn { v2u r0, k0, v0, r1, k1, v1, e, av; };
__device__ __forceinline__ void scan_unit(const Args& a, LAS unsigned char* lds, int tid, int unit) {
    unsigned char* ws = a.ws;
    const int bh = unit >> 1, half = unit & 1, b = bh >> 3, hd = bh & 7;
    const bf16* rkv = (const bf16*)(ws + WS_RKV); const bf16* E = (const bf16*)(ws + WS_E); const bf16* Aa = (const bf16*)(ws + WS_A);
    float* bon = (float*)(ws + WS_BON); bf16* Y = y_ptr(a.out, b);
    const int st = tid >> 4, c4 = tid & 15, ch = hd * 64 + c4 * 4;
    const f32x4 mur = *(const f32x4*)(a.in[4] + ch), muk = *(const f32x4*)(a.in[4] + 512 + ch), muv = *(const f32x4*)(a.in[4] + 1024 + ch);
    const f32x4 kkw = *(const f32x4*)(a.in[10] + ch), kaw = *(const f32x4*)(a.in[11] + ch), rkw = *(const f32x4*)(a.in[12] + ch);
    f32x4 sA = (f32x4){0.f, 0.f, 0.f, 0.f};
    const size_t tb = (size_t)b * SEQ;
    auto load_batch = [&](int s0, ScanIn& L) {
        const size_t t = tb + s0 + st; const bool first = (s0 + st) == 0;
        L.r0 = *(const v2u*)(rkv + t * 1536 + ch); L.k0 = *(const v2u*)(rkv + t * 1536 + 512 + ch); L.v0 = *(const v2u*)(rkv + t * 1536 + 1024 + ch);
        const size_t tp = first ? t : t - 1;
        L.r1 = *(const v2u*)(rkv + tp * 1536 + ch); L.k1 = *(const v2u*)(rkv + tp * 1536 + 512 + ch); L.v1 = *(const v2u*)(rkv + tp * 1536 + 1024 + ch);
        if (first) { L.r1 = (v2u){0u, 0u}; L.k1 = L.r1; L.v1 = L.r1; }
        L.e = *(const v2u*)(E + t * 512 + ch); L.av = *(const v2u*)(Aa + t * 512 + ch);
    };
    auto convert = [&](const ScanIn& L, int buf, int s0) {
        const unsigned r0w[2] = {L.r0.x, L.r0.y}, r1w[2] = {L.r1.x, L.r1.y}, k0w[2] = {L.k0.x, L.k0.y}, k1w[2] = {L.k1.x, L.k1.y}, v0w[2] = {L.v0.x, L.v0.y}, v1w[2] = {L.v1.x, L.v1.y};
        const unsigned ew[2] = {L.e.x, L.e.y}, aw[2] = {L.av.x, L.av.y};
        float r[4], k[4], v[4], e[4], av[4], kk[4];
#pragma unroll
        for (int i = 0; i < 4; ++i) { const int w = i >> 1; const bool hi = i & 1;
            const float rc = hi ? bfhi(r0w[w]) : bflo(r0w[w]), rp = hi ? bfhi(r1w[w]) : bflo(r1w[w]);
            const float kc = hi ? bfhi(k0w[w]) : bflo(k0w[w]), kp = hi ? bfhi(k1w[w]) : bflo(k1w[w]);
            const float vc = hi ? bfhi(v0w[w]) : bflo(v0w[w]), vp = hi ? bfhi(v1w[w]) : bflo(v1w[w]);
            r[i] = rc + (rp - rc) * mur[i]; k[i] = kc + (kp - kc) * muk[i]; v[i] = vc + (vp - vc) * muv[i];
            e[i] = hi ? bfhi(ew[w]) : bflo(ew[w]); av[i] = hi ? bfhi(aw[w]) : bflo(aw[w]);
            kk[i] = k[i] * kkw[i]; }
        const float ss = red16(kk[0] * kk[0] + kk[1] * kk[1] + kk[2] * kk[2] + kk[3] * kk[3]);
        const float inv = 1.0f / fmaxf(sqrtf(ss), 1e-12f);
        f32x4 w4, aa4, bb4, km4, wr4, vv4; float br = 0.f, kr = 0.f, bo = 0.f;
#pragma unroll
        for (int i = 0; i < 4; ++i) { const float kki = kk[i] * inv; const float km = k[i] * (1.0f + (av[i] - 1.0f) * kaw[i]); const float w = __expf(-e[i]);
            w4[i] = w; aa4[i] = -kki; bb4[i] = kki * av[i]; km4[i] = km; wr4[i] = w * r[i]; vv4[i] = v[i];
            br += bb4[i] * r[i]; kr += km * r[i]; bo += r[i] * km * rkw[i]; }
        br = red16(br); kr = red16(kr); bo = red16(bo);
        LAS float* rec = (LAS float*)(lds + buf * SC_BUF) + st * SC_REC + c4 * 4;
        *(LAS f32x4*)(rec) = w4; *(LAS f32x4*)(rec + 64) = aa4; *(LAS f32x4*)(rec + 128) = bb4; *(LAS f32x4*)(rec + 192) = km4; *(LAS f32x4*)(rec + 256) = wr4; *(LAS f32x4*)(rec + 320) = vv4;
        if (c4 == 0) { rec[384] = br; rec[385] = kr; if (half == 0) bon[(tb + s0 + st) * 8 + hd] = bo; }
    };
    auto write_out = [&](int bi) {
        typedef float f32x2 __attribute__((ext_vector_type(2)));
        const LAS float* yp = (const LAS float*)(lds + SC_YOFF) + (bi & 1) * (SC_NB * 32) + st * 32 + c4 * 2;
        const f32x2 yv = *(const LAS f32x2*)yp; *(unsigned*)(Y + (size_t)(bi * SC_NB + st) * 512 + hd * 64 + 32 * half + 2 * c4) = pk2(yv[0], yv[1]); };
    constexpr int NBATCH = SEQ / SC_NB;
    ScanIn L; load_batch(0, L);
    __syncthreads();
    convert(L, 0, 0);
    load_batch(SC_NB, L);
    __syncthreads();
    for (int bi = 0; bi < NBATCH; ++bi) {
        const int cur = bi & 1;
        if (bi + 1 < NBATCH) convert(L, cur ^ 1, (bi + 1) * SC_NB);
        if (bi + 2 < NBATCH) load_batch((bi + 2) * SC_NB, L);
        if (bi > 0) write_out(bi - 1);
        LAS float* ybuf = (LAS float*)(lds + SC_YOFF) + cur * (SC_NB * 32);
        const LAS float* base = (const LAS float*)(lds + cur * SC_BUF) + c4 * 4;
        const LAS float* vbase = (const LAS float*)(lds + cur * SC_BUF) + 320 + 32 * half + st;
        const LAS float* sbase = (const LAS float*)(lds + cur * SC_BUF) + 384;
        f32x4 nw = *(const LAS f32x4*)(base), na = *(const LAS f32x4*)(base + 64), nb = *(const LAS f32x4*)(base + 128), nk = *(const LAS f32x4*)(base + 192), nq = *(const LAS f32x4*)(base + 256);
        float nvA = vbase[0]; typedef float f32x2 __attribute__((ext_vector_type(2))); f32x2 ns = *(const LAS f32x2*)(sbase);
        float ykA = 0.f;
#pragma unroll
        for (int i = 0; i < SC_NB; ++i) {
            const f32x4 w4 = nw, a4 = na, b4 = nb, k4 = nk, q4 = nq; const float vA = nvA, br = ns[0], kr = ns[1];
            if (i + 1 < SC_NB) { const LAS float* rec = base + (i + 1) * SC_REC;
                nw = *(const LAS f32x4*)(rec); na = *(const LAS f32x4*)(rec + 64); nb = *(const LAS f32x4*)(rec + 128); nk = *(const LAS f32x4*)(rec + 192); nq = *(const LAS f32x4*)(rec + 256);
                nvA = vbase[(i + 1) * SC_REC]; ns = *(const LAS f32x2*)(sbase + (i + 1) * SC_REC); }
            float saA = fmaf(sA[0], a4[0], fmaf(sA[1], a4[1], fmaf(sA[2], a4[2], sA[3] * a4[3])));
            float zA = fmaf(sA[0], q4[0], fmaf(sA[1], q4[1], fmaf(sA[2], q4[2], sA[3] * q4[3])));
            saA = red16(saA); zA = red16(zA);
            const float yA = zA + saA * br + vA * kr;
            ykA = (c4 == (i & 15)) ? yA : ykA;
            sA = sA * w4 + saA * b4 + vA * k4;
            if ((i & 15) == 15) ybuf[(i - 15 + c4) * 32 + st] = ykA;
        }
        __syncthreads();
    }
    write_out(NBATCH - 1);
}
namespace wkv {
constexpr int P = 144, PF = 272, U = 64 * P  , F = 64 * PF  ;
constexpr int O_S = 0, O_B = F;
constexpr int O_AT = O_B + 0 * U, O_BTL = O_B + 1 * U, O_KTL = O_B + 2 * U, O_RT = O_B + 3 * U, O_BHT = O_B + 4 * U, O_KHT = O_B + 5 * U, O_VRT = O_B + 6 * U, O_RHST = O_B + 7 * U  , O_MABH = O_B + 9 * U, O_MRB = O_B + 10 * U, O_MRK = O_B + 11 * U, O_Z2 = O_B + 12 * U;
constexpr int O_XT = O_AT  , O_G1 = O_MABH, O_Z1 = O_KTL, O_G2 = O_RHST  , O_EP = O_Z2  ;
constexpr int O_END = O_B + 13 * U;
constexpr int PO = 80, O_OUTB = O_END  , O_TII = O_OUTB + 8 * 16 * PO  , O_DIAG = O_TII + 4 * 16 * PO  , O_GC = O_DIAG + 4096  , O_CONST = O_GC + 256  , O_TOP = O_CONST + 1536;
static_assert(O_TOP <= 158720, "wkv LDS map");
typedef short bf16x8 __attribute__((ext_vector_type(8)));
__device__ __forceinline__ f32x4 mfma16(bf16x8 a, bf16x8 b, f32x4 c) { return __builtin_amdgcn_mfma_f32_16x16x32_bf16(a, b, c, 0, 0, 0); }
template <int K> __device__ __forceinline__ f32x4 mm_blk(LAS unsigned char* lds, int aoff, int pa, int boff, int pb, int m0, int n0, int lane, f32x4 acc) {
    const int r = lane & 15, kg = lane >> 4;
#pragma unroll
    for (int ks = 0; ks < K / 32; ++ks) { const bf16x8 a = *(const LAS bf16x8*)(lds + aoff + (m0 + r) * pa + (32 * ks + 8 * kg) * 2); const bf16x8 b = *(const LAS bf16x8*)(lds + boff + (n0 + r) * pb + (32 * ks + 8 * kg) * 2); acc = mfma16(a, b, acc); }
    return acc;
}
__device__ __forceinline__ void split8(const LAS float* p, bf16x8& hi, bf16x8& lo) {
    const f32x4 x0 = *(const LAS f32x4*)p, x1 = *(const LAS f32x4*)(p + 4); const float x[8] = {x0[0], x0[1], x0[2], x0[3], x1[0], x1[1], x1[2], x1[3]}; unsigned h[8], l[8];
#pragma unroll
    for (int i = 0; i < 8; ++i) { h[i] = f2bf(x[i]); l[i] = f2bf(x[i] - __builtin_bit_cast(float, h[i] << 16)); }
    hi = (bf16x8){(short)h[0], (short)h[1], (short)h[2], (short)h[3], (short)h[4], (short)h[5], (short)h[6], (short)h[7]}; lo = (bf16x8){(short)l[0], (short)l[1], (short)l[2], (short)l[3], (short)l[4], (short)l[5], (short)l[6], (short)l[7]};
}
__device__ __forceinline__ void st_bf(LAS unsigned char* lds, int off, float v) { *(LAS unsigned short*)(lds + off) = (unsigned short)f2bf(v); }
__device__ __forceinline__ float ld_bf(const LAS unsigned char* lds, int off) { return __builtin_bit_cast(float, (unsigned)*(const LAS unsigned short*)(lds + off) << 16); }
struct Raw { v4u r0, k0, v0, r1, k1, v1, e, av; };
}
__device__ __forceinline__ void st4_bf(LAS unsigned char* lds, int off, f32x4 v) { *(LAS v2u*)(lds + off) = (v2u){pk2(v[0], v[1]), pk2(v[2], v[3])}; }
__device__ __forceinline__ f32x4 ld4_bf(const LAS unsigned char* lds, int off) { const v2u w = *(const LAS v2u*)(lds + off); return (f32x4){bflo(w.x), bfhi(w.x), bflo(w.y), bfhi(w.y)}; }
__device__ __forceinline__ wkv::bf16x8 ident_frag(int n, int ks, int kg) { wkv::bf16x8 f; const int k0 = 32 * ks + 8 * kg;
#pragma unroll
    for (int j = 0; j < 8; ++j) f[j] = (k0 + j == n) ? (short)0x3F80 : (short)0; return f; }
__device__ __forceinline__ void scan_unit_chunked(const Args& a, LAS unsigned char* lds, int tid, int bh) {
    using namespace wkv;
    unsigned char* ws = a.ws;
    const int b = bh >> 3, hd = bh & 7, wave = __builtin_amdgcn_readfirstlane(tid >> 6);
    const bf16* rkv = (const bf16*)(ws + WS_RKV); const bf16* E = (const bf16*)(ws + WS_E); const bf16* Aa = (const bf16*)(ws + WS_A);
    float* bon = (float*)(ws + WS_BON); bf16* Y = y_ptr(a.out, b);
    const size_t tb = (size_t)b * SEQ;
    int oz = 0;
#define WKV_TAINT() asm volatile("" : "+v"(oz))
    const int gch = hd * 64 + (tid & 7) * 8;
    if (tid < 384) { const int vsel = tid >> 6, cc = tid & 63; const float* src = vsel == 0 ? a.in[4] : vsel == 1 ? a.in[4] + 512 : vsel == 2 ? a.in[4] + 1024 : vsel == 3 ? a.in[10] : vsel == 4 ? a.in[11] : a.in[12];
        ((LAS float*)(lds + O_CONST))[vsel * 64 + cc] = src[hd * 64 + cc]; }
    auto load_raw = [&](int c, Raw& L) { const int tt = tid >> 3; const size_t t = tb + c * 64 + tt; const bool first = (c * 64 + tt) == 0; const size_t tp = first ? t : t - 1;
        L.r0 = *(const v4u*)(rkv + t * 1536 + gch); L.k0 = *(const v4u*)(rkv + t * 1536 + 512 + gch); L.v0 = *(const v4u*)(rkv + t * 1536 + 1024 + gch);
        L.r1 = *(const v4u*)(rkv + tp * 1536 + gch); L.k1 = *(const v4u*)(rkv + tp * 1536 + 512 + gch); L.v1 = *(const v4u*)(rkv + tp * 1536 + 1024 + gch);
        if (first) { L.r1 = (v4u){0u, 0u, 0u, 0u}; L.k1 = L.r1; L.v1 = L.r1; }
        L.e = *(const v4u*)(E + t * 512 + gch); L.av = *(const v4u*)(Aa + t * 512 + gch); };
    const int mb = wave >> 1, nb0 = (wave & 1) * 2;
    WKV_TAINT();
#pragma unroll 1
    for (int i = tid + oz; i < 64 * 64; i += NTHR) *(LAS float*)(lds + O_S + (i >> 6) * PF + (i & 63) * 4) = 0.f;
#if defined(PROBE_PHASE) && PROBE_PHASE >= 300 && PROBE_PHASE < 310
    unsigned long long tlast = __builtin_amdgcn_s_memrealtime(); unsigned tacc[6] = {0u, 0u, 0u, 0u, 0u, 0u};
#define WKV_STAMP(k) do { const unsigned long long tn = __builtin_amdgcn_s_memrealtime(); tacc[k] += (unsigned)(tn - tlast); tlast = tn; } while (0)
#else
#define WKV_STAMP(k) do { } while (0)
#endif
    Raw L; load_raw(0, L);
    for (int c = 0; c < SEQ / 64; ++c) {
        __syncthreads();
        WKV_TAINT(); const int td0 = tid + oz, tt = td0 >> 3, kq = td0 & 7, ch0 = kq * 8;
        float e8[8], lr8[8], r8[8], k8[8], v8[8];
        { const unsigned ew[4] = {L.e.x, L.e.y, L.e.z, L.e.w}, aw[4] = {L.av.x, L.av.y, L.av.z, L.av.w};
          const unsigned r0[4] = {L.r0.x, L.r0.y, L.r0.z, L.r0.w}, r1[4] = {L.r1.x, L.r1.y, L.r1.z, L.r1.w}, k0[4] = {L.k0.x, L.k0.y, L.k0.z, L.k0.w}, k1[4] = {L.k1.x, L.k1.y, L.k1.z, L.k1.w}, v0[4] = {L.v0.x, L.v0.y, L.v0.z, L.v0.w}, v1[4] = {L.v1.x, L.v1.y, L.v1.z, L.v1.w};
#pragma unroll
          for (int i = 0; i < 8; ++i) { const int w = i >> 1; const bool hi = i & 1;
              e8[i] = hi ? bfhi(ew[w]) : bflo(ew[w]); lr8[i] = hi ? bfhi(aw[w]) : bflo(aw[w]);
              const float rc = hi ? bfhi(r0[w]) : bflo(r0[w]), rp = hi ? bfhi(r1[w]) : bflo(r1[w]), kc = hi ? bfhi(k0[w]) : bflo(k0[w]), kp = hi ? bfhi(k1[w]) : bflo(k1[w]), vc = hi ? bfhi(v0[w]) : bflo(v0[w]), vp = hi ? bfhi(v1[w]) : bflo(v1[w]);
              const LAS float* cst = (const LAS float*)(lds + O_CONST) + ch0 + i;
              r8[i] = rc + (rp - rc) * cst[0]; k8[i] = kc + (kp - kc) * cst[64]; v8[i] = vc + (vp - vc) * cst[128]; } }
        if (c + 1 < SEQ / 64) load_raw(c + 1, L);
        { LAS float* ep = (LAS float*)(lds + O_EP) + tt * 68 + ch0; *(LAS f32x4*)ep = (f32x4){e8[0], e8[1], e8[2], e8[3]}; *(LAS f32x4*)(ep + 4) = (f32x4){e8[4], e8[5], e8[6], e8[7]}; }
        __syncthreads();
        { const int k = td0 & 63, seg = td0 >> 6; LAS float* col = (LAS float*)(lds + O_EP) + (seg * 8) * 68 + k; float pre[8], run = 0.f;
#pragma unroll
          for (int i = 0; i < 8; ++i) { run += col[i * 68]; pre[i] = run; }
          LAS float* tots = (LAS float*)(lds + O_EP) + 64 * 68;
          tots[seg * 64 + k] = run;
          __syncthreads();
          float base = 0.f;
#pragma unroll
          for (int s2 = 0; s2 < 7; ++s2) base += (s2 < seg) ? tots[s2 * 64 + k] : 0.f;
#pragma unroll
          for (int i = 0; i < 8; ++i) col[i * 68] = pre[i] + base; }
        __syncthreads();
        float ce[8], cep[8], cec[8];
        { const LAS float* epb = (const LAS float*)(lds + O_EP);
          const f32x4 c0 = *(const LAS f32x4*)(epb + tt * 68 + ch0), c1 = *(const LAS f32x4*)(epb + tt * 68 + ch0 + 4);
          const int tq = tt > 0 ? tt - 1 : 0; f32x4 p0 = *(const LAS f32x4*)(epb + tq * 68 + ch0), p1 = *(const LAS f32x4*)(epb + tq * 68 + ch0 + 4); if (tt == 0) { p0 = (f32x4){0.f, 0.f, 0.f, 0.f}; p1 = p0; }
          const f32x4 q0 = *(const LAS f32x4*)(epb + 63 * 68 + ch0), q1 = *(const LAS f32x4*)(epb + 63 * 68 + ch0 + 4);
#pragma unroll
          for (int i = 0; i < 4; ++i) { ce[i] = c0[i]; ce[4 + i] = c1[i]; cep[i] = p0[i]; cep[4 + i] = p1[i]; cec[i] = q0[i]; cec[4 + i] = q1[i]; } }
        { float kk[8], ss = 0.f;
#pragma unroll
          for (int i = 0; i < 8; ++i) { kk[i] = k8[i] * ((const LAS float*)(lds + O_CONST))[192 + ch0 + i]; ss += kk[i] * kk[i]; }
          ss = red8(ss); const float inv = 1.0f / fmaxf(sqrtf(ss), 1e-12f);
          float at[8], bt[8], kt[8], rt[8], bh8[8], kh8[8], bo = 0.f;
#pragma unroll
          for (int i = 0; i < 8; ++i) { const float kaw_i = ((const LAS float*)(lds + O_CONST))[256 + ch0 + i], rkw_i = ((const LAS float*)(lds + O_CONST))[320 + ch0 + i];
              const float kki = kk[i] * inv, km = k8[i] * (1.0f + (lr8[i] - 1.0f) * kaw_i), bbv = kki * lr8[i];
              const float gp = __expf(-cep[i]), gi = __expf(ce[i]), gt = __expf(-ce[i]), gcj = __expf(ce[i] - cec[i]);
              at[i] = -kki * gp; bt[i] = bbv * gi; kt[i] = km * gi; rt[i] = r8[i] * gt; bh8[i] = bbv * gcj; kh8[i] = km * gcj; bo += r8[i] * km * rkw_i; }
          bo = red8(bo);
          if (kq == 0) bon[(tb + c * 64 + tt) * 8 + hd] = bo;
          if (tt == 63) { LAS float* gc = (LAS float*)(lds + O_GC) + ch0;
#pragma unroll
              for (int i = 0; i < 8; ++i) gc[i] = __expf(-cec[i]); }
          const int ro = tt * P + ch0 * 2;
          *(LAS v4u*)(lds + O_AT + ro) = (v4u){pk2(at[0], at[1]), pk2(at[2], at[3]), pk2(at[4], at[5]), pk2(at[6], at[7])};
          *(LAS v4u*)(lds + O_BTL + ro) = (v4u){pk2(bt[0], bt[1]), pk2(bt[2], bt[3]), pk2(bt[4], bt[5]), pk2(bt[6], bt[7])};
          *(LAS v4u*)(lds + O_KTL + ro) = (v4u){pk2(kt[0], kt[1]), pk2(kt[2], kt[3]), pk2(kt[4], kt[5]), pk2(kt[6], kt[7])};
          *(LAS v4u*)(lds + O_RT + ro) = (v4u){pk2(rt[0], rt[1]), pk2(rt[2], rt[3]), pk2(rt[4], rt[5]), pk2(rt[6], rt[7])};
          *(LAS v4u*)(lds + O_MABH + ro) = (v4u){pk2(bh8[0], bh8[1]), pk2(bh8[2], bh8[3]), pk2(bh8[4], bh8[5]), pk2(bh8[6], bh8[7])};
          *(LAS v4u*)(lds + O_MRB + ro) = (v4u){pk2(kh8[0], kh8[1]), pk2(kh8[2], kh8[3]), pk2(kh8[4], kh8[5]), pk2(kh8[6], kh8[7])};
          *(LAS v4u*)(lds + O_MRK + ro) = (v4u){pk2(v8[0], v8[1]), pk2(v8[2], v8[3]), pk2(v8[4], v8[5]), pk2(v8[6], v8[7])}; }
        __syncthreads();
        { WKV_TAINT(); const int lane = (tid & 63) + oz, c16 = lane & 15, rg = lane >> 4;
#pragma unroll
          for (int j = 0; j < 2; ++j) { const int nb = nb0 + j; f32x4 d0 = (f32x4){0.f, 0.f, 0.f, 0.f}, d1 = d0, d2 = d0, d3 = d0;
#pragma unroll
              for (int ks = 0; ks < 2; ++ks) { const bf16x8 idf = ident_frag(16 * nb + c16, ks, rg); const int ao = (16 * mb + c16) * P + (32 * ks + 8 * rg) * 2;
                  d0 = mfma16(*(const LAS bf16x8*)(lds + O_AT + ao), idf, d0); d1 = mfma16(*(const LAS bf16x8*)(lds + O_MABH + ao), idf, d1);
                  d2 = mfma16(*(const LAS bf16x8*)(lds + O_MRB + ao), idf, d2); d3 = mfma16(*(const LAS bf16x8*)(lds + O_MRK + ao), idf, d3); }
              const int to = (16 * nb + c16) * P + (16 * mb + 4 * rg) * 2;
              st4_bf(lds, O_RHST + to, d0); st4_bf(lds, O_BHT + to, d1); st4_bf(lds, O_KHT + to, d2); st4_bf(lds, O_VRT + to, d3); } }
        __syncthreads(); WKV_STAMP(0);
        { WKV_TAINT(); const int lane = (tid & 63) + oz, c16 = lane & 15, rg = lane >> 4; f32x4 acc[4][2];
#pragma unroll
          for (int j = 0; j < 2; ++j) { const int nb = nb0 + j; const f32x4 z = (f32x4){0.f, 0.f, 0.f, 0.f};
              acc[0][j] = mm_blk<64>(lds, O_BTL, P, O_AT, P, 16 * mb, 16 * nb, lane, z);
              acc[1][j] = mm_blk<64>(lds, O_AT, P, O_KTL, P, 16 * mb, 16 * nb, lane, z);
              acc[2][j] = mm_blk<64>(lds, O_BTL, P, O_RT, P, 16 * mb, 16 * nb, lane, z);
              acc[3][j] = mm_blk<64>(lds, O_KTL, P, O_RT, P, 16 * mb, 16 * nb, lane, z); }
#pragma unroll
          for (int j = 0; j < 2; ++j) { const int nb = nb0 + j, n = 16 * nb + c16, m0 = 16 * mb + 4 * rg; f32x4 mab, mak, mrb, mrk;
#pragma unroll
              for (int e = 0; e < 4; ++e) { const int m = m0 + e; mab[e] = m < n ? acc[0][j][e] : 0.f; mak[e] = n < m ? acc[1][j][e] : 0.f; mrb[e] = m <= n ? acc[2][j][e] : 0.f; mrk[e] = m <= n ? acc[3][j][e] : 0.f; }
              st4_bf(lds, O_MABH + n * P + m0 * 2, mab);
              if (mb == nb) *(LAS f32x4*)(lds + O_DIAG + ((mb * 16 + c16) * 16 + 4 * rg) * 4) = mab;
              st4_bf(lds, O_RHST + U + n * P + m0 * 2, mak);
              st4_bf(lds, O_MRB + n * P + m0 * 2, mrb); st4_bf(lds, O_MRK + n * P + m0 * 2, mrk); } }
        __syncthreads(); WKV_STAMP(1);
        WKV_TAINT();
        if (tid < 64) { const int td2 = tid + oz, blk = td2 >> 4, cc = td2 & 15; const LAS float* D = (const LAS float*)(lds + O_DIAG) + blk * 256; float Tc[16];
#pragma unroll
            for (int r4 = 0; r4 < 4; ++r4) { f32x4 dr[4][4];
#pragma unroll
                for (int rr = 0; rr < 4; ++rr)
#pragma unroll
                    for (int q = 0; q <= r4; ++q) dr[rr][q] = *(const LAS f32x4*)(D + (4 * r4 + rr) * 16 + 4 * q);
#pragma unroll
                for (int rr = 0; rr < 4; ++rr) { const int r = 4 * r4 + rr; float sacc = (r == cc) ? 1.f : 0.f;
#pragma unroll
                    for (int j = 0; j < r; ++j) sacc += dr[rr][j >> 2][j & 3] * Tc[j];
                    Tc[r] = sacc; } }
#pragma unroll
            for (int r4 = 0; r4 < 4; ++r4) { const f32x4 tv = (f32x4){Tc[4 * r4], Tc[4 * r4 + 1], Tc[4 * r4 + 2], Tc[4 * r4 + 3]};
                (void)tv; }
#pragma unroll
            for (int r = 0; r < 16; ++r) { st_bf(lds, O_TII + (blk * 16 + r) * PO + cc * 2, Tc[r]); st_bf(lds, O_TII + (blk * 16 + r) * PO + (16 + cc) * 2, 0.f); } }
        { const int lane = (tid & 63) + oz; const v4u z = (v4u){0u, 0u, 0u, 0u};
#pragma unroll
          for (int i = 0; i < 3; ++i) { const int idx = lane + 64 * i; if (idx < 16 * 9) *(LAS v4u*)(lds + O_XT + (16 * wave + idx / 9) * P + (idx % 9) * 16) = z; }
          if (lane < 32) *(LAS v4u*)(lds + O_OUTB + wave * 16 * PO + (lane >> 1) * PO + 32 + (lane & 1) * 16) = z; }
        __syncthreads(); WKV_STAMP(2);
#pragma unroll 1
        for (int i = 0; i < 4; ++i) { WKV_TAINT(); const int lane = (tid & 63) + oz, c16 = lane & 15, rg = lane >> 4;
            f32x4 acc = (f32x4){0.f, 0.f, 0.f, 0.f};
            if (i > 0) acc = mm_blk<64>(lds, O_MABH, P, O_XT, P, 16 * i, 16 * wave, lane, acc);
            acc += ld4_bf(lds, O_RHST + (16 * wave + c16) * P + (16 * i + 4 * rg) * 2);
            st4_bf(lds, O_OUTB + wave * 16 * PO + c16 * PO + (4 * rg) * 2, acc);
            LDS_WAIT();
            f32x4 x = mm_blk<32>(lds, O_TII + i * 16 * PO, PO, O_OUTB + wave * 16 * PO, PO, 0, 0, lane, (f32x4){0.f, 0.f, 0.f, 0.f});
            st4_bf(lds, O_XT + (16 * wave + c16) * P + (16 * i + 4 * rg) * 2, x);
            LDS_WAIT();
        }
        __syncthreads(); WKV_STAMP(3);
        { WKV_TAINT(); const int lane = (tid & 63) + oz, c16 = lane & 15, rg = lane >> 4; f32x4 acc[4][2];
#pragma unroll
          for (int j = 0; j < 2; ++j) { const int nb = nb0 + j; const f32x4 z = (f32x4){0.f, 0.f, 0.f, 0.f};
              acc[0][j] = mm_blk<64>(lds, O_XT, P, O_MRB, P, 16 * mb, 16 * nb, lane, z);
              acc[1][j] = mm_blk<64>(lds, O_XT + U, P, O_MRB, P, 16 * mb, 16 * nb, lane, z);
              acc[2][j] = mm_blk<64>(lds, O_XT, P, O_BHT, P, 16 * mb, 16 * nb, lane, z);
              acc[3][j] = mm_blk<64>(lds, O_XT + U, P, O_BHT, P, 16 * mb, 16 * nb, lane, z); }
#pragma unroll
          for (int j = 0; j < 2; ++j) { const int n = 16 * (nb0 + j) + c16, m0 = 16 * mb + 4 * rg; const int o = n * P + m0 * 2;
              acc[0][j] += ld4_bf(lds, O_RT + o); acc[1][j] += ld4_bf(lds, O_MRK + o); acc[3][j] += ld4_bf(lds, O_KHT + o);
              if (n >= m0 && n < m0 + 4) acc[2][j][n - m0] += *(const LAS float*)(lds + O_GC + n * 4); }
          __syncthreads();
#pragma unroll
          for (int j = 0; j < 2; ++j) { const int n = 16 * (nb0 + j) + c16, m0 = 16 * mb + 4 * rg; const int o = n * P + m0 * 2;
              st4_bf(lds, O_G1 + o, acc[0][j]); st4_bf(lds, O_Z1 + o, acc[1][j]); st4_bf(lds, O_Z2 + o, acc[3][j]);
              f32x4 hi4, lo4;
#pragma unroll
              for (int e = 0; e < 4; ++e) { hi4[e] = __builtin_bit_cast(float, f2bf(acc[2][j][e]) << 16); lo4[e] = acc[2][j][e] - hi4[e]; }
              st4_bf(lds, O_RT + o, hi4); st4_bf(lds, O_KHT + o, lo4); } }
        { WKV_TAINT(); const int td5 = tid + oz, v = td5 >> 3, kq5 = (td5 & 7) * 8; const LAS float* sp = (const LAS float*)(lds + O_S + v * PF) + kq5;
          const f32x4 x0 = *(const LAS f32x4*)sp, x1 = *(const LAS f32x4*)(sp + 4); f32x4 h0, h1, l0, l1;
#pragma unroll
          for (int e = 0; e < 4; ++e) { h0[e] = __builtin_bit_cast(float, f2bf(x0[e]) << 16); l0[e] = x0[e] - h0[e]; h1[e] = __builtin_bit_cast(float, f2bf(x1[e]) << 16); l1[e] = x1[e] - h1[e]; }
          st4_bf(lds, O_MRB + v * P + kq5 * 2, h0); st4_bf(lds, O_MRB + v * P + kq5 * 2 + 8, h1); st4_bf(lds, O_MRK + v * P + kq5 * 2, l0); st4_bf(lds, O_MRK + v * P + kq5 * 2 + 8, l1); }
        __syncthreads(); WKV_STAMP(4);
        { WKV_TAINT(); const int lane = (tid & 63) + oz, c16 = lane & 15, rg = lane >> 4; f32x4 ay[2], as[2];
#pragma unroll
          for (int j = 0; j < 2; ++j) { const int nb = nb0 + j; const f32x4 z = (f32x4){0.f, 0.f, 0.f, 0.f};
              ay[j] = mm_blk<64>(lds, O_VRT, P, O_Z1, P, 16 * mb, 16 * nb, lane, z);
              ay[j] = mm_blk<64>(lds, O_MRB, P, O_G1, P, 16 * mb, 16 * nb, lane, ay[j]);
              ay[j] = mm_blk<64>(lds, O_MRK, P, O_G1, P, 16 * mb, 16 * nb, lane, ay[j]);
              as[j] = mm_blk<64>(lds, O_Z2, P, O_VRT, P, 16 * mb, 16 * nb, lane, z);
              as[j] = mm_blk<64>(lds, O_RT, P, O_MRB, P, 16 * mb, 16 * nb, lane, as[j]);
              as[j] = mm_blk<64>(lds, O_KHT, P, O_MRB, P, 16 * mb, 16 * nb, lane, as[j]);
              as[j] = mm_blk<64>(lds, O_RT, P, O_MRK, P, 16 * mb, 16 * nb, lane, as[j]); }
#pragma unroll
          for (int j = 0; j < 2; ++j) { const int t = 16 * (nb0 + j) + c16, v0 = 16 * mb + 4 * rg;
              *(v2u*)(Y + (size_t)(c * 64 + t) * 512 + hd * 64 + v0) = (v2u){pk2(ay[j][0], ay[j][1]), pk2(ay[j][2], ay[j][3])};
              *(LAS f32x4*)(lds + O_S + t * PF + v0 * 4) = as[j]; } }
        WKV_STAMP(5);
    }
#if defined(PROBE_PHASE) && PROBE_PHASE >= 300 && PROBE_PHASE < 310
    if (tid == 0) atomicAdd((unsigned*)(ws + WS_CTL) + 96, tacc[PROBE_PHASE - 300]);
#endif
}
__device__ __forceinline__ void phase_orw(const Args& a, int lane, int wave, int vcu, int G) {
    unsigned char* ws = a.ws;
    const int gw = vcu * NWAVES + wave, NGW = G * NWAVES;
    const bf16* rkv = (const bf16*)(ws + WS_RKV); const bf16* Gg = (const bf16*)(ws + WS_G); const float* bon = (const float*)(ws + WS_BON);
    bf16* orw = (bf16*)((unsigned char*)a.out + OUT_ORWDF);
    const int ch = lane * 8;
    const f32x4 mv0 = *(const f32x4*)(a.in[4] + 1024 + ch), mv1 = *(const f32x4*)(a.in[4] + 1024 + ch + 4);
    const f32x4 lw0 = *(const f32x4*)(a.in[13] + ch), lw1 = *(const f32x4*)(a.in[13] + ch + 4), lb0 = *(const f32x4*)(a.in[14] + ch), lb1 = *(const f32x4*)(a.in[14] + ch + 4);
    const float muv[8] = {mv0[0], mv0[1], mv0[2], mv0[3], mv1[0], mv1[1], mv1[2], mv1[3]}, lnw[8] = {lw0[0], lw0[1], lw0[2], lw0[3], lw1[0], lw1[1], lw1[2], lw1[3]}, lnb[8] = {lb0[0], lb0[1], lb0[2], lb0[3], lb1[0], lb1[1], lb1[2], lb1[3]};
    for (int t = gw; t < T; t += NGW) {
        const int b = t >> 12, s = t & (SEQ - 1); const v4u yw = *(const v4u*)(y_ptr(a.out, b) + (size_t)s * 512 + ch);
        const f32x4 y0 = (f32x4){bflo(yw.x), bfhi(yw.x), bflo(yw.y), bfhi(yw.y)}, y1 = (f32x4){bflo(yw.z), bfhi(yw.z), bflo(yw.w), bfhi(yw.w)};
        const v4u vc = *(const v4u*)(rkv + (size_t)t * 1536 + 1024 + ch); v4u vp = (v4u){0u, 0u, 0u, 0u}; if (s != 0) vp = *(const v4u*)(rkv + (size_t)(t - 1) * 1536 + 1024 + ch);
        const v4u gw4 = *(const v4u*)(Gg + (size_t)t * 512 + ch); const float bo = bon[(size_t)t * 8 + (lane >> 3)];
        float y[8] = {y0[0], y0[1], y0[2], y0[3], y1[0], y1[1], y1[2], y1[3]};
        float sm = 0.f;
#pragma unroll
        for (int e = 0; e < 8; ++e) sm += y[e];
        const float mean = red8(sm) * (1.f / 64.f); float vs = 0.f;
#pragma unroll
        for (int e = 0; e < 8; ++e) { y[e] -= mean; vs += y[e] * y[e]; }
        const float rstd = 1.0f / sqrtf(red8(vs) * (1.f / 64.f) + 64e-5f);
        const unsigned vcw[4] = {vc.x, vc.y, vc.z, vc.w}, vpw[4] = {vp.x, vp.y, vp.z, vp.w}, gww[4] = {gw4.x, gw4.y, gw4.z, gw4.w}; float o[8];
#pragma unroll
        for (int e = 0; e < 8; ++e) { const int w = e >> 1; const bool hi = e & 1; const float c = hi ? bfhi(vcw[w]) : bflo(vcw[w]), p = hi ? bfhi(vpw[w]) : bflo(vpw[w]), g = hi ? bfhi(gww[w]) : bflo(gww[w]);
            const float v = c + (p - c) * muv[e]; o[e] = ((y[e] * rstd * lnw[e] + lnb[e]) + bo * v) * g; }
        v4u ov; ov.x = pk2(o[0], o[1]); ov.y = pk2(o[2], o[3]); ov.z = pk2(o[4], o[5]); ov.w = pk2(o[6], o[7]);
        *(v4u*)(orw + (size_t)t * 1024 + ch) = ov;
    }
}

__device__ __forceinline__ int crow(int r, int hi) { return (r & 3) + 8 * (r >> 2) + 4 * hi; }
constexpr int AT_BUF = 24576;
__device__ __forceinline__ int at_addr(int row, int ch) { return row * 128 + ((ch ^ ((row >> 1) & 7)) << 4); }
__device__ __forceinline__ void attn_pass(const bf16* qn, const bf16* kn, const bf16* vt, int b, int head, int c, int qb, LAS unsigned char* lds, int tid, f32x16 (&o)[4]) {
    const int lane = tid & 63, wave = __builtin_amdgcn_readfirstlane(tid >> 6), r32 = lane & 31, hi = lane >> 5;
    const int vh = b * 8 + head * 2 + c; const int q0 = qb * 256, qw0 = q0 + wave * 32, qrow = qw0 + r32;
    const bf16* Qp = qn + ((size_t)(vh & 7) * SEQ + qrow) * 64;
    s16x8 qf[4];
#pragma unroll
    for (int ks = 0; ks < 4; ++ks) qf[ks] = *(const s16x8*)(Qp + 16 * ks + 8 * hi);
    const int k_row = tid >> 3, k_ch = tid & 7;
    const bf16* ksrc = kn + (size_t)(vh & 7) * SEQ * 64 + k_row * 64 + k_ch * 8; const int kdst = at_addr(k_row, k_ch);
    const int dv0 = tid >> 3, dv1 = 64 + (tid >> 3);
    const bf16* vsrc0 = vt + (size_t)(head * 128 + dv0) * T + (size_t)b * SEQ + k_ch * 8; const bf16* vsrc1 = vsrc0 + (size_t)64 * T;
    const int vdst0 = 8192 + at_addr(dv0, k_ch), vdst1 = 8192 + at_addr(dv1, k_ch); const bool vsw0 = (dv0 & 16) != 0, vsw1 = (dv1 & 16) != 0;
    const int NT = 4 * qb + 4;
    v4u kreg = *(const v4u*)ksrc, vreg0 = *(const v4u*)vsrc0, vreg1 = *(const v4u*)vsrc1;
    __syncthreads();
    *(LAS v4u*)(lds + kdst) = kreg; *(LAS v4u*)(lds + vdst0) = vsw0 ? (v4u){vreg0.z, vreg0.w, vreg0.x, vreg0.y} : vreg0; *(LAS v4u*)(lds + vdst1) = vsw1 ? (v4u){vreg1.z, vreg1.w, vreg1.x, vreg1.y} : vreg1;
    __syncthreads();
    float m = -1e30f, l = 0.f;
#pragma unroll
    for (int db = 0; db < 4; ++db)
#pragma unroll
        for (int i = 0; i < 16; ++i) o[db][i] = 0.f;
    for (int j = 0; j < NT; ++j) {
        const int cur = (j & 1) * AT_BUF, nxt = AT_BUF - cur; const bool more = j + 1 < NT;
        if (more) { kreg = *(const v4u*)(ksrc + (size_t)(j + 1) * 64 * 64); vreg0 = *(const v4u*)(vsrc0 + (j + 1) * 64); vreg1 = *(const v4u*)(vsrc1 + (j + 1) * 64); }
        const int kv0 = j * 64;
        if (kv0 <= qw0 + 31) {
            f32x16 s0, s1;
#pragma unroll
            for (int i = 0; i < 16; ++i) { s0[i] = 0.f; s1[i] = 0.f; }
            __builtin_amdgcn_s_setprio(1);
#pragma unroll
            for (int ks = 0; ks < 4; ++ks) {
                const s16x8 a0 = *(const LAS s16x8*)(lds + cur + at_addr(r32, 2 * ks + hi));
                const s16x8 a1 = *(const LAS s16x8*)(lds + cur + at_addr(32 + r32, 2 * ks + hi));
                s0 = __builtin_amdgcn_mfma_f32_32x32x16_bf16(a0, qf[ks], s0, 0, 0, 0);
                s1 = __builtin_amdgcn_mfma_f32_32x32x16_bf16(a1, qf[ks], s1, 0, 0, 0);
            }
            __builtin_amdgcn_s_setprio(0);
            if (kv0 + 63 > qw0) {
#pragma unroll
                for (int i = 0; i < 16; ++i) { const int kv = kv0 + crow(i, hi); if (kv > qrow) s0[i] = -1e30f; if (kv + 32 > qrow) s1[i] = -1e30f; }
            }
            float rm = fmaxf(s0[0], s1[0]);
#pragma unroll
            for (int i = 1; i < 16; ++i) rm = fmaxf(rm, fmaxf(s0[i], s1[i]));
            rm = xhalf_max(rm);
            const float mn = fmaxf(m, rm); const float f = __builtin_amdgcn_exp2f(m - mn); m = mn;
            float ps = 0.f;
#pragma unroll
            for (int i = 0; i < 16; ++i) { s0[i] = __builtin_amdgcn_exp2f(s0[i] - mn); s1[i] = __builtin_amdgcn_exp2f(s1[i] - mn); ps += s0[i] + s1[i]; }
            l = l * f + ps;
            if (__any(f != 1.0f)) {
#pragma unroll
                for (int db = 0; db < 4; ++db)
#pragma unroll
                    for (int i = 0; i < 16; ++i) o[db][i] *= f;
            }
            v4u pw[4];
            pw[0] = (v4u){pk2(s0[0], s0[1]), pk2(s0[2], s0[3]), pk2(s0[4], s0[5]), pk2(s0[6], s0[7])};
            pw[1] = (v4u){pk2(s0[8], s0[9]), pk2(s0[10], s0[11]), pk2(s0[12], s0[13]), pk2(s0[14], s0[15])};
            pw[2] = (v4u){pk2(s1[0], s1[1]), pk2(s1[2], s1[3]), pk2(s1[4], s1[5]), pk2(s1[6], s1[7])};
            pw[3] = (v4u){pk2(s1[8], s1[9]), pk2(s1[10], s1[11]), pk2(s1[12], s1[13]), pk2(s1[14], s1[15])};
#pragma unroll
            for (int db = 0; db < 4; ++db) { const int dv = 32 * db + r32; const int vb = cur + 8192 + dv * 128 + 8 * (hi ^ ((dv >> 4) & 1)), sw = (dv >> 1) & 7;
#pragma unroll
                for (int s4 = 0; s4 < 4; ++s4) {
                    const s16x4 lo = *(const LAS s16x4*)(lds + vb + (((2 * s4) ^ sw) << 4));
                    const s16x4 hh = *(const LAS s16x4*)(lds + vb + (((2 * s4 + 1) ^ sw) << 4));
                    const s16x8 av = (s16x8){lo[0], lo[1], lo[2], lo[3], hh[0], hh[1], hh[2], hh[3]};
                    o[db] = __builtin_amdgcn_mfma_f32_32x32x16_bf16(av, __builtin_bit_cast(s16x8, pw[s4]), o[db], 0, 0, 0);
                }
                __builtin_amdgcn_sched_barrier(0); }
        }
        if (more) { *(LAS v4u*)(lds + nxt + kdst) = kreg; *(LAS v4u*)(lds + nxt + vdst0) = vsw0 ? (v4u){vreg0.z, vreg0.w, vreg0.x, vreg0.y} : vreg0; *(LAS v4u*)(lds + nxt + vdst1) = vsw1 ? (v4u){vreg1.z, vreg1.w, vreg1.x, vreg1.y} : vreg1; }
        __syncthreads();
    }
    l = xhalf_sum(l);
    const float il = 1.0f / l;
#pragma unroll
    for (int db = 0; db < 4; ++db)
#pragma unroll
        for (int i = 0; i < 16; ++i) o[db][i] *= il;
}
__device__ __forceinline__ void attn_unit(const Args& a, LAS unsigned char* lds, int tid, int b, int head, int qb, float* stash  ) {
    unsigned char* ws = a.ws;
    const bf16* qn = qn_ptr(ws, b); const bf16* kn = kn_ptr(ws, b); const bf16* vt = (const bf16*)(ws + WS_VT);
    bf16* odf = (bf16*)((unsigned char*)a.out + OUT_ORWDF) + 512;
    const int lane = tid & 63, wave = tid >> 6, r32 = lane & 31, hi = lane >> 5;
    int oz = 0; asm volatile("" : "+v"(oz)); const int ll = lane + oz;
    const float d1 = wave_sum(a.in[17][ll] * a.in[18][ll]), d2 = wave_sum(a.in[19][ll] * a.in[20][ll]);
    const float lam = __expf(d1) - __expf(d2) + LAM_INIT;
    f32x16 o[4];
    attn_pass(qn, kn, vt, b, head, 0, qb, lds, tid, o);
    float* st = stash + tid * 64;
#pragma unroll
    for (int db = 0; db < 4; ++db)
#pragma unroll
        for (int g = 0; g < 4; ++g) *(f32x4*)(st + db * 16 + g * 4) = (f32x4){o[db][4 * g], o[db][4 * g + 1], o[db][4 * g + 2], o[db][4 * g + 3]};
#if defined(PROBE_PHASE) && PROBE_PHASE == 215
    if (head == 0) { bf16* dbg = (bf16*)(ws + 496 * MiB); const size_t tq = (size_t)b * SEQ + qb * 256 + wave * 32 + r32;
#pragma unroll
        for (int db = 0; db < 4; ++db)
#pragma unroll
            for (int g = 0; g < 4; ++g) { const int dv = 32 * db + 8 * g + 4 * hi; v2u ov; ov.x = pk2(o[db][4 * g], o[db][4 * g + 1]); ov.y = pk2(o[db][4 * g + 2], o[db][4 * g + 3]); *(v2u*)(dbg + tq * 128 + dv) = ov; } }
#endif
    attn_pass(qn, kn, vt, b, head, 1, qb, lds, tid, o);
    float ss = 0.f;
#pragma unroll
    for (int db = 0; db < 4; ++db)
#pragma unroll
        for (int g = 0; g < 4; ++g) { const f32x4 s4 = *(const f32x4*)(st + db * 16 + g * 4);
#pragma unroll
            for (int e = 0; e < 4; ++e) { const float d = s4[e] - lam * o[db][4 * g + e]; o[db][4 * g + e] = d; ss += d * d; } }
    ss = xhalf_sum(ss);
    const float rs = (1.0f / sqrtf(ss * (1.f / 128.f) + 1e-6f)) * (1.0f - LAM_INIT);
    const size_t t = (size_t)b * SEQ + qb * 256 + wave * 32 + r32; const float* sw = a.in[21];
#pragma unroll
    for (int db = 0; db < 4; ++db)
#pragma unroll
        for (int g = 0; g < 4; ++g) { const int dv = 32 * db + 8 * g + 4 * hi; const f32x4 w4 = *(const f32x4*)(sw + dv);
            v2u ov; ov.x = pk2(o[db][4 * g] * rs * w4[0], o[db][4 * g + 1] * rs * w4[1]); ov.y = pk2(o[db][4 * g + 2] * rs * w4[2], o[db][4 * g + 3] * rs * w4[3]);
            *(v2u*)(odf + t * 1024 + head * 128 + dv) = ov; }
}
#define XB_TMO      128
#define XB_XCNT(j)  (256  + 64 * (j))
#define XB_XSUB(j)  (1280 + 64 * (j))
#define XB_XGEN(j)  (2304 + 64 * (j))
#define XB_TOP      3328
#define XB_TOPGEN   3392
#define XCD_BAR_WORDS 3456
#define XB_SPIN_CAP (1u << 18)

__device__ __forceinline__ unsigned xb_ld(unsigned* p)              { return __hip_atomic_load(p, __ATOMIC_RELAXED, __HIP_MEMORY_SCOPE_AGENT); }
__device__ __forceinline__ unsigned xb_add(unsigned* p, unsigned v) { return __hip_atomic_fetch_add(p, v, __ATOMIC_RELAXED, __HIP_MEMORY_SCOPE_AGENT); }
__device__ __forceinline__ unsigned xb_xcc_id() { return (unsigned)__builtin_amdgcn_s_getreg((3 << 11) | 20) & 0xFu; }
#define XB_SPIN(cond, bar) do { unsigned _sp = 0; while (cond) { __builtin_amdgcn_s_sleep(1); \
    if ((++_sp & 255u) == 0u) { if (xb_ld(&(bar)[XB_TMO])) break; if (_sp > XB_SPIN_CAP) { atomicAdd(&(bar)[XB_TMO], 1u); break; } } } } while (0)

struct XcdBarrier {
    unsigned* bar; unsigned x;
    volatile LAS unsigned* st;
};

__device__ __forceinline__ XcdBarrier xcd_barrier_post(unsigned* bar, volatile LAS unsigned* st) {
    XcdBarrier b; b.bar = bar; b.x = xb_xcc_id(); b.st = st;
    if (threadIdx.x == 0) (void)xb_add(&bar[XB_XCNT(b.x)], 1u);
    return b;
}
__device__ __forceinline__ void xcd_barrier_complete(unsigned* bar, unsigned x, unsigned& nloc, unsigned& nx) {
    const unsigned G = gridDim.x * gridDim.y * gridDim.z;
    unsigned sum, cnt, mine, sp = 0u;
    for (;;) {
        sum = 0u; cnt = 0u; mine = 0u;
#pragma unroll
        for (unsigned j = 0; j < 16; ++j) { const unsigned c = xb_ld(&bar[XB_XCNT(j)]); sum += c; cnt += (c > 0u) ? 1u : 0u; mine = (j == x) ? c : mine; }
        if (sum == G) break;
        __builtin_amdgcn_s_sleep(1);
        if ((++sp & 255u) == 0u) { if (xb_ld(&bar[XB_TMO])) break; if (sp > XB_SPIN_CAP) { atomicAdd(&bar[XB_TMO], 1u); break; } }
    }
    nloc = mine > 0u ? mine : 1u; nx = cnt > 0u ? cnt : 1u;
}

__device__ __forceinline__ void xcd_barrier(const XcdBarrier& b) {
    asm volatile("s_waitcnt vmcnt(0)" ::: "memory");
    __syncthreads();
    if (threadIdx.x == 0) {
        unsigned* bar = b.bar;
        __builtin_amdgcn_s_waitcnt(0);
        unsigned nloc = b.st[0], nx = b.st[1];
        if (nloc == 0u) { xcd_barrier_complete(bar, b.x, nloc, nx); b.st[0] = nloc; b.st[1] = nx; }
        const unsigned old = xb_add(&bar[XB_XSUB(b.x)], 1u);
        const unsigned gen = old / nloc;
        if (old + 1u == (gen + 1u) * nloc) {
            __builtin_amdgcn_fence(__ATOMIC_RELEASE, "agent");
            asm volatile("s_waitcnt vmcnt(0)" ::: "memory");
            const unsigned og = xb_add(&bar[XB_TOP], 1u);
            const unsigned tg = og / nx;
            if (og + 1u == (tg + 1u) * nx) xb_add(&bar[XB_TOPGEN], 1u);
            else XB_SPIN(xb_ld(&bar[XB_TOPGEN]) == tg, bar);
            __builtin_amdgcn_fence(__ATOMIC_ACQUIRE, "agent");
            xb_add(&bar[XB_XGEN(b.x)], 1u);
            asm volatile("s_waitcnt vmcnt(0)" ::: "memory");
        } else {
            XB_SPIN(xb_ld(&bar[XB_XGEN(b.x)]) == gen, bar);
            __builtin_amdgcn_fence(__ATOMIC_ACQUIRE, "agent");
            asm volatile("s_waitcnt vmcnt(0)" ::: "memory");
        }
    }
    __syncthreads();
}

__device__ __forceinline__ void phase7(const Args& a, LAS unsigned char* lds, int tid, int lane, int wave, int vcu, int G) {
    unsigned char* ws = a.ws;
    const int gw = vcu * NWAVES + wave, NGW = G * NWAVES;
    const bf16* x1 = (const bf16*)a.out; const float* gain = a.in[25]; bf16* h2x = (bf16*)(ws + WS_H2X);
    for (int m = gw; m < T; m += NGW) {
        const v2u* xr = (const v2u*)(x1 + (size_t)m * DM) + lane; f32x4 v[4]; float s = 0.f;
#pragma unroll
        for (int j = 0; j < 4; ++j) { const v2u w = xr[64 * j]; v[j] = (f32x4){bflo(w.x), bfhi(w.x), bflo(w.y), bfhi(w.y)}; s += (v[j].x * v[j].x + v[j].y * v[j].y) + (v[j].z * v[j].z + v[j].w * v[j].w); }
        const float rstd = 1.0f / sqrtf(wave_sum(s) * (1.f / 1024.f) + 1e-6f);
        v2u* oh = (v2u*)(h2x + (size_t)m * 1024) + lane;
#pragma unroll
        for (int j = 0; j < 4; ++j) { const f32x4 g = ((const f32x4*)gain)[lane + 64 * j]; v2u o; o.x = pk2(v[j][0] * rstd * g[0], v[j][1] * rstd * g[1]); o.y = pk2(v[j][2] * rstd * g[2], v[j][3] * rstd * g[3]); oh[64 * j] = o; }
    }
    LAS float* scr = (LAS float*)(lds + wave * 16384);
    bf16* wgu = (bf16*)(ws + WS_WGU); bf16* wd = (bf16*)(ws + WS_WD);
    constexpr int IGU = (1024 / 64) * (512 / 32);
    constexpr int IDN = (512 / 64) * (1024 / 32);
    for (int it = gw; it < NEXP * (2 * IGU + IDN); it += NGW) {
        const int e = it / (2 * IGU + IDN); int r = it % (2 * IGU + IDN);
        if (r < 2 * IGU) { const int up = r >= IGU; if (up) r -= IGU; const int kb = r / 16, nb = r % 16, n0 = 32 * nb;
            const float* W = (up ? a.in[31] : a.in[30]) + (size_t)e * 1024 * 512;
            tr_item(W, 512, wgu, 1024, 64 * kb, n0, (size_t)e * 1024 + (n0 >> 7) * 256 + (up ? 128 : 0) + (n0 & 127), 0, scr, lane);
        } else { r -= 2 * IGU; const int kb = r / 32, nb = r % 32;
            tr_item(a.in[32] + (size_t)e * 512 * 1024, 1024, wd, 512, 64 * kb, 32 * nb, (size_t)e * 1024 + 32 * nb, 0, scr, lane); }
    }
}

__device__ __forceinline__ void route_tile(const Args& a, LAS unsigned char* lds, int tid, int pm) {
    unsigned char* ws = a.ws;
    const float* LG = (const float*)(ws + WS_LOGITS); int* toke = (int*)(ws + WS_TOKE); float* tokw = (float*)(ws + WS_TOKW); int* tilecnt = (int*)(ws + WS_TILECNT);
    LAS int* cnt = (LAS int*)lds;
    if (tid < 32) cnt[tid] = 0;
    __syncthreads();
    if (tid < 256) {
        const int t = pm * 256 + tid; const float* lr = LG + (size_t)t * 128;
        float gl[4];
#pragma unroll
        for (int j = 0; j < 4; ++j) gl[j] = lr[32 + j] + a.in[27][j];
        int gi = 0; float gm = gl[0];
#pragma unroll
        for (int j = 1; j < 4; ++j) if (gl[j] > gm) { gm = gl[j]; gi = j; }
        float gs = 0.f;
#pragma unroll
        for (int j = 0; j < 4; ++j) gs += __expf(gl[j] - gm);
        const float gtop = 1.0f / gs;
        float el[8];
#pragma unroll
        for (int j = 0; j < 8; ++j) el[j] = lr[gi * 8 + j] + a.in[29][gi * 8 + j];
        int i1 = 0; float e1 = el[0];
#pragma unroll
        for (int j = 1; j < 8; ++j) if (el[j] > e1) { e1 = el[j]; i1 = j; }
        int i2 = -1; float e2 = -3.0e38f;
#pragma unroll
        for (int j = 0; j < 8; ++j) if (j != i1 && el[j] > e2) { e2 = el[j]; i2 = j; }
        const float ex = __expf(e2 - e1); const float w1 = gtop / (1.0f + ex), w2 = gtop * ex / (1.0f + ex);
        const int x1 = gi * 8 + i1, x2 = gi * 8 + i2;
        toke[t * 2] = x1; toke[t * 2 + 1] = x2; tokw[t * 2] = w1; tokw[t * 2 + 1] = w2;
        atomicAdd((int*)&cnt[x1], 1); atomicAdd((int*)&cnt[x2], 1);
    }
    __syncthreads();
    if (tid < 32) tilecnt[pm * 32 + tid] = cnt[tid];
    __syncthreads();
}

__device__ __forceinline__ void phase9(const Args& a, LAS unsigned char* lds, int tid, int lane, int wave) {
    unsigned char* ws = a.ws;
    const int tile = blockIdx.x;
    if (tile >= 128) return;
    const int* tilecnt = (const int*)(ws + WS_TILECNT); const int* toke = (const int*)(ws + WS_TOKE); const float* tokw = (const float*)(ws + WS_TOKW);
    int* pos = (int*)(ws + WS_POS); float* roww = (float*)(ws + WS_ROWW); int* disp = (int*)(ws + WS_DISP); int* rowtok = (int*)(ws + WS_ROWTOK);
    LAS int* tc = (LAS int*)lds;
    LAS int* tot = tc + 4096;
    LAS int* bef = tot + 32;
    LAS int* base = bef + 32;
    LAS int* pst = base + 32;
    LAS int* earr = pst + 32;
    LAS int* parr = earr + 512;
    for (int i = tid; i < 4096; i += NTHR) tc[i] = tilecnt[i];
    earr[tid] = toke[tile * 512 + tid];
    __syncthreads();
    if (tid < 32) { int s = 0, b = 0; for (int t = 0; t < 128; ++t) { const int c = tc[t * 32 + tid]; s += c; if (t < tile) b += c; } tot[tid] = s; bef[tid] = b; }
    __syncthreads();
    if (tid == 0) { int p = 0; for (int e = 0; e < 32; ++e) { pst[e] = p; base[e] = p + bef[e]; const int nt = (tot[e] + 255) >> 8;
                        if (tile == 0) { for (int k = 0; k < nt; ++k) disp[16 + (p >> 8) + k] = e; disp[512 + e] = p; disp[576 + e] = tot[e]; }
                        p += nt << 8; }
                    if (tile == 0) disp[0] = p >> 8; }
    __syncthreads();
    for (int q = 0; q < 4; ++q) { const int e = wave * 4 + q; int running = 0;
        for (int c8 = 0; c8 < 8; ++c8) { const int ai = c8 * 64 + lane; const bool mt = earr[ai] == e; const unsigned long long mk = __ballot(mt);
            if (mt) parr[ai] = base[e] + running + __popcll(mk & ((1ull << lane) - 1ull));
            running += __popcll(mk); } }
    __syncthreads();
    { const int ai = tid, p = parr[ai], t = tile * 256 + (ai >> 1); pos[t * 2 + (ai & 1)] = p; roww[p] = tokw[t * 2 + (ai & 1)]; rowtok[p] = t; }
    if (tile < 32) { const int p0 = pst[tile] + tot[tile], p1 = pst[tile] + (((tot[tile] + 255) >> 8) << 8);
        for (int r = p0 + tid; r < p1; r += NTHR) { rowtok[r] = 0; roww[r] = 0.f; } }
}

__device__ __forceinline__ void phase12(const Args& a, int tid, int lane, int wave, int vcu, int G) {
    unsigned char* ws = a.ws;
    const int gw = vcu * NWAVES + wave, NGW = G * NWAVES; const int gt = vcu * NTHR + tid, NGT = G * NTHR;
    const bf16* x1 = (const bf16*)a.out; bf16* x2 = (bf16*)(ws + WS_X2); const bf16* y2 = (const bf16*)(ws + WS_Y2); const int* pos = (const int*)(ws + WS_POS); const float* gain = a.in[33]; bf16* h3 = (bf16*)(ws + WS_H3);
    for (int m = gw; m < T; m += NGW) {
        const int pa = pos[m * 2], pb = pos[m * 2 + 1];
        const v2u* xr = (const v2u*)(x1 + (size_t)m * DM) + lane; v2u* xo = (v2u*)(x2 + (size_t)m * DM) + lane; const v2u* ya = (const v2u*)(y2 + (size_t)pa * 1024) + lane; const v2u* yb = (const v2u*)(y2 + (size_t)pb * 1024) + lane;
        f32x4 v[4]; float s = 0.f;
#pragma unroll
        for (int j = 0; j < 4; ++j) { const v2u wx = xr[64 * j], wa = ya[64 * j], wb = yb[64 * j];
            v[j].x = bflo(wx.x) + bflo(wa.x) + bflo(wb.x); v[j].y = bfhi(wx.x) + bfhi(wa.x) + bfhi(wb.x); v[j].z = bflo(wx.y) + bflo(wa.y) + bflo(wb.y); v[j].w = bfhi(wx.y) + bfhi(wa.y) + bfhi(wb.y);
            v2u o; o.x = pk2(v[j].x, v[j].y); o.y = pk2(v[j].z, v[j].w); xo[64 * j] = o;
            s += (v[j].x * v[j].x + v[j].y * v[j].y) + (v[j].z * v[j].z + v[j].w * v[j].w); }
        const float rstd = 1.0f / sqrtf(wave_sum(s) * (1.f / 1024.f) + 1e-6f);
        v2u* o8 = (v2u*)(h3 + (size_t)m * DM) + lane;
#pragma unroll
        for (int j = 0; j < 4; ++j) { const f32x4 g = ((const f32x4*)gain)[lane + 64 * j]; v2u o; o.x = pk2(v[j].x * rstd * g.x, v[j].y * rstd * g.y); o.y = pk2(v[j].z * rstd * g.z, v[j].w * rstd * g.w); o8[64 * j] = o; }
    }
    const f32x4* p = (const f32x4*)a.in[1]; v2u* p16 = (v2u*)(ws + WS_P16);
    for (int i = gt; i < T * 256 / 4; i += NGT) { const f32x4 v = p[i]; v2u o; o.x = pk2(v.x, v.y); o.y = pk2(v.z, v.w); p16[i] = o; }
}

#if defined(PROBE_PHASE) && (PROBE_PHASE == 200 || PROBE_PHASE == 201)
__device__ __forceinline__ float blk_sum(float v, LAS float* red, int tid) { v = wave_sum(v); __syncthreads(); if ((tid & 63) == 0) red[tid >> 6] = v; __syncthreads(); float s = 0.f; for (int i = 0; i < 8; ++i) s += red[i]; __syncthreads(); return s; }
__device__ __forceinline__ void check_moe(const Args& a, LAS unsigned char* lds, int tid, float* res) {
    unsigned char* ws = a.ws;
    LAS float* hb = (LAS float*)lds; LAS float* hf = hb + 1024; LAS float* act = hf + 1024; LAS float* lg = act + 512; LAS float* red = lg + 64; LAS int* sel = (LAS int*)(red + 16);
    const int* toke = (const int*)(ws + WS_TOKE); const float* tokw = (const float*)(ws + WS_TOKW); const int* pos = (const int*)(ws + WS_POS); const bf16* y2 = (const bf16*)(ws + WS_Y2);
    float errsum = 0.f, refsum = 0.f; int mism = 0;
    for (int si = 0; si < 24; ++si) { const int t = si * 1361 + 17;
        const bf16* xr = (const bf16*)a.out + (size_t)t * DM; const float x0 = __builtin_bit_cast(float, (unsigned)xr[tid] << 16), x1 = __builtin_bit_cast(float, (unsigned)xr[tid + 512] << 16);
        const float rstd = 1.0f / sqrtf(blk_sum(x0 * x0 + x1 * x1, red, tid) * (1.f / 1024.f) + 1e-6f);
        const float h0 = x0 * rstd * a.in[25][tid], h1 = x1 * rstd * a.in[25][tid + 512];
        hf[tid] = h0; hf[tid + 512] = h1; hb[tid] = __builtin_bit_cast(float, f2bf(h0) << 16); hb[tid + 512] = __builtin_bit_cast(float, f2bf(h1) << 16);
        __syncthreads();
        if (tid < 36) { float s = 0.f; for (int k = 0; k < 1024; ++k) s += hf[k] * (tid < 32 ? a.in[28][k * 32 + tid] : a.in[26][k * 4 + (tid - 32)]); lg[tid] = s + (tid < 32 ? a.in[29][tid] : a.in[27][tid - 32]); }
        __syncthreads();
        if (tid == 0) { int gi = 0; for (int j = 1; j < 4; ++j) if (lg[32 + j] > lg[32 + gi]) gi = j;
            int i1 = 0; for (int j = 1; j < 8; ++j) if (lg[gi * 8 + j] > lg[gi * 8 + i1]) i1 = j;
            int i2 = -1; for (int j = 0; j < 8; ++j) if (j != i1 && (i2 < 0 || lg[gi * 8 + j] > lg[gi * 8 + i2])) i2 = j;
            sel[0] = gi * 8 + i1; sel[1] = gi * 8 + i2; }
        __syncthreads();
        if (sel[0] != toke[t * 2] || sel[1] != toke[t * 2 + 1]) mism++;
        float o0 = 0.f, o1 = 0.f;
        for (int kx = 0; kx < 2; ++kx) { const int e = toke[t * 2 + kx]; const float w = tokw[t * 2 + kx];
            const float* Wg = a.in[30] + (size_t)e * 1024 * 512; const float* Wu = a.in[31] + (size_t)e * 1024 * 512; const float* Wd = a.in[32] + (size_t)e * 512 * 1024;
            float gg = 0.f, uu = 0.f; for (int k = 0; k < 1024; ++k) { const float hk = hb[k]; gg += hk * Wg[(size_t)k * 512 + tid]; uu += hk * Wu[(size_t)k * 512 + tid]; }
            __syncthreads(); act[tid] = gg / (1.0f + __expf(-gg)) * uu; __syncthreads();
            float s0 = 0.f, s1 = 0.f; for (int f = 0; f < 512; ++f) { const float af = act[f]; s0 += af * Wd[(size_t)f * 1024 + tid]; s1 += af * Wd[(size_t)f * 1024 + tid + 512]; }
            o0 += s0 * w; o1 += s1 * w; }
        const int pa = pos[t * 2], pb = pos[t * 2 + 1];
        const float m0 = __builtin_bit_cast(float, (unsigned)y2[(size_t)pa * 1024 + tid] << 16) + __builtin_bit_cast(float, (unsigned)y2[(size_t)pb * 1024 + tid] << 16);
        const float m1 = __builtin_bit_cast(float, (unsigned)y2[(size_t)pa * 1024 + tid + 512] << 16) + __builtin_bit_cast(float, (unsigned)y2[(size_t)pb * 1024 + tid + 512] << 16);
        errsum += (m0 - o0) * (m0 - o0) + (m1 - o1) * (m1 - o1); refsum += o0 * o0 + o1 * o1;
    }
    const float es = blk_sum(errsum, red, tid), rs = blk_sum(refsum, red, tid);
    if (tid == 0) *res = (PROBE_PHASE == 200) ? sqrtf(es / rs) : (float)mism / 24.f;
}
#endif

#ifndef PROBE_KAPPA
#define PROBE_KAPPA 0
#endif
#ifndef CHK_S0
#define CHK_S0 0
#define CHK_SN 4096
#endif
#if defined(PROBE_PHASE) && (PROBE_PHASE == 210 || PROBE_PHASE == 211 || PROBE_PHASE == 215)
__device__ __forceinline__ void check_attn(const Args& a, LAS unsigned char* lds, int tid, float* res) {
    unsigned char* ws = a.ws;
    const bf16* vt = (const bf16*)(ws + WS_VT);
    const bf16* odf = (const bf16*)((unsigned char*)a.out + OUT_ORWDF) + 512;
    LAS float* sc = (LAS float*)lds; LAS float* part = sc + 4096; LAS float* oc = part + 512; LAS float* red = oc + 256;
    const float d1 = wave_sum(a.in[17][tid & 63] * a.in[18][tid & 63]), d2 = wave_sum(a.in[19][tid & 63] * a.in[20][tid & 63]);
    const float lam = __expf(d1) - __expf(d2) + LAM_INIT;
    float errsum = 0.f, refsum = 0.f;
    for (int si = 0; si < 24; ++si) { const int b = si & 7, head = (PROBE_PHASE == 215) ? 0 : ((si >> 1) & 3), s = CHK_S0 + ((si * 977 + 31 * (si & 3)) % CHK_SN);
        for (int c = 0; c < 2; ++c) { const int vh = b * 8 + head * 2 + c;
            const bf16* qn = qn_ptr(ws, b); const bf16* kn = kn_ptr(ws, b); const bf16* qp = qn + ((size_t)(vh & 7) * SEQ + s) * 64; float mx = -3e38f;
            for (int j = tid; j <= s; j += NTHR) { const bf16* kp = kn + ((size_t)(vh & 7) * SEQ + j) * 64; float d = 0.f;
                for (int e = 0; e < 64; ++e) d += __builtin_bit_cast(float, (unsigned)qp[e] << 16) * __builtin_bit_cast(float, (unsigned)kp[e] << 16);
                sc[j] = d; mx = fmaxf(mx, d); }
            __syncthreads();
            for (int o = 1; o < 64; o <<= 1) mx = fmaxf(mx, __shfl_xor(mx, o));
            if ((tid & 63) == 0) red[tid >> 6] = mx;
            __syncthreads();
            mx = red[0]; for (int i = 1; i < 8; ++i) mx = fmaxf(mx, red[i]);
            __syncthreads();
            float ls = 0.f;
            for (int j = tid; j <= s; j += NTHR) { const float p = exp2f(sc[j] - mx); sc[j] = p; ls += p; }
            ls = wave_sum(ls); if ((tid & 63) == 0) red[tid >> 6] = ls;
            __syncthreads();
            float l = 0.f; for (int i = 0; i < 8; ++i) l += red[i];
            { const int dv = tid & 127, pr = tid >> 7; const bf16* vp = vt + (size_t)(head * 128 + dv) * T + (size_t)b * SEQ; float acc = 0.f;
              for (int j = pr; j <= s; j += 4) acc += sc[j] * __builtin_bit_cast(float, (unsigned)vp[j] << 16);
              part[tid] = acc; }
            __syncthreads();
            if (tid < 128) oc[c * 128 + tid] = (part[tid] + part[tid + 128] + part[tid + 256] + part[tid + 384]) / l;
            __syncthreads(); }
#if PROBE_PHASE == 215
        if (tid < 128) { const float ref = oc[tid]; const float got = __builtin_bit_cast(float, (unsigned)((const bf16*)(ws + 496 * MiB))[((size_t)b * SEQ + s) * 128 + tid] << 16); errsum += (PROBE_KAPPA ? got * ref : (got - ref) * (got - ref)); refsum += ref * ref; }
        __syncthreads(); continue;
#endif
        float dd = 0.f, sq = 0.f; if (tid < 128) { dd = oc[tid] - lam * oc[128 + tid]; sq = dd * dd; }
        sq = wave_sum(sq); __syncthreads(); if ((tid & 63) == 0) red[tid >> 6] = sq; __syncthreads();
        const float rs = (1.0f / sqrtf((red[0] + red[1]) * (1.f / 128.f) + 1e-6f)) * (1.0f - LAM_INIT);
        if (tid < 128) { const float ref = dd * rs * a.in[21][tid]; const float got = __builtin_bit_cast(float, (unsigned)odf[((size_t)b * SEQ + s) * 1024 + head * 128 + tid] << 16);
            errsum += (got - ref) * (got - ref); refsum += ref * ref; }
        __syncthreads(); }
    errsum = wave_sum(errsum); refsum = wave_sum(refsum);
    __syncthreads(); if ((tid & 63) == 0) { red[tid >> 6] = errsum; red[8 + (tid >> 6)] = refsum; } __syncthreads();
    if (tid == 0) *res = PROBE_KAPPA ? fabsf((red[0] + red[1]) / (red[8] + red[9])) : sqrtf((red[0] + red[1]) / (red[8] + red[9]));
}
__device__ __forceinline__ void check_scan(const Args& a, LAS unsigned char* lds, int tid, float* res) {
    unsigned char* ws = a.ws; const int b = 1, hd = 3, NS = 384;
    const bf16* rkv = (const bf16*)(ws + WS_RKV); const bf16* E = (const bf16*)(ws + WS_E); const bf16* Aa = (const bf16*)(ws + WS_A); const bf16* Y = y_ptr(a.out, b);
    LAS float* vw = (LAS float*)lds; LAS float* vaa = vw + 64; LAS float* vbb = vaa + 64; LAS float* vkm = vbb + 64; LAS float* vr = vkm + 64; LAS float* vv = vr + 64; LAS float* red = vv + 64;
    const int row = tid >> 3, cg = tid & 7; float st[8]; for (int j = 0; j < 8; ++j) st[j] = 0.f;
    float errsum = 0.f, refsum = 0.f;
    for (int s = 0; s < NS; ++s) { const size_t t = (size_t)b * SEQ + s;
        if (tid < 64) { const int ch = hd * 64 + tid;
            auto ld = [&](size_t tt, int off) { return __builtin_bit_cast(float, (unsigned)rkv[tt * 1536 + off + ch] << 16); };
            const float rc = ld(t, 0), kc = ld(t, 512), vc = ld(t, 1024); const float rp = s ? ld(t - 1, 0) : 0.f, kp = s ? ld(t - 1, 512) : 0.f, vp = s ? ld(t - 1, 1024) : 0.f;
            const float r = rc + (rp - rc) * a.in[4][ch], k = kc + (kp - kc) * a.in[4][512 + ch], v = vc + (vp - vc) * a.in[4][1024 + ch];
            const float e = __builtin_bit_cast(float, (unsigned)E[t * 512 + ch] << 16), av = __builtin_bit_cast(float, (unsigned)Aa[t * 512 + ch] << 16);
            float kk = k * a.in[10][ch]; const float nn = sqrtf(wave_sum(kk * kk)); kk = kk / fmaxf(nn, 1e-12f);
            vw[tid] = expf(-e); vaa[tid] = -kk; vbb[tid] = kk * av; vkm[tid] = k * (1.0f + (av - 1.0f) * a.in[11][ch]); vr[tid] = r; vv[tid] = v; }
        __syncthreads();
        float sa = 0.f; for (int j = 0; j < 8; ++j) sa += st[j] * vaa[cg * 8 + j];
        sa += __shfl_xor(sa, 1); sa += __shfl_xor(sa, 2); sa += __shfl_xor(sa, 4);
        float y = 0.f; for (int j = 0; j < 8; ++j) { const int c = cg * 8 + j; st[j] = st[j] * vw[c] + sa * vbb[c] + vv[row] * vkm[c]; y += st[j] * vr[c]; }
        y += __shfl_xor(y, 1); y += __shfl_xor(y, 2); y += __shfl_xor(y, 4);
        if (cg == 0) { const float got = __builtin_bit_cast(float, (unsigned)Y[(size_t)s * 512 + hd * 64 + row] << 16); errsum += (got - y) * (got - y); refsum += y * y; }
        __syncthreads(); }
    errsum = wave_sum(errsum); refsum = wave_sum(refsum);
    if ((tid & 63) == 0) { red[tid >> 6] = errsum; red[8 + (tid >> 6)] = refsum; } __syncthreads();
    if (tid == 0) { float es = 0.f, rs = 0.f; for (int i = 0; i < 8; ++i) { es += red[i]; rs += red[8 + i]; } *res = sqrtf(es / rs); }
}
#endif
#ifndef MK_N_LAUNCHES
#define MK_N_LAUNCHES 1
#endif
#ifndef SCAN_CHUNKED
#define SCAN_CHUNKED 1
#endif
constexpr int NSCAN = SCAN_CHUNKED ? 64 : 128;
constexpr int NGATE = 256;
constexpr int NPHASE = 15;
__global__ void __launch_bounds__(NTHR, 2) mk_fwd(Args args) {
    extern __shared__ __attribute__((aligned(16))) unsigned char lds_raw[];
    LAS unsigned char* lds = (LAS unsigned char*)lds_raw;
    const int tid = threadIdx.x, lane = tid & 63, wave = __builtin_amdgcn_readfirstlane(tid >> 6);
    const int G = gridDim.x; const int bx = blockIdx.x; const int vcu = (G % 8 == 0) ? (bx % 8) * (G / 8) + bx / 8 : bx;
    unsigned char* ws = args.ws;
    const int lo = args.ph_lo, hi = args.ph_hi;
#ifdef ONLY_PHASE
#define IN(k) ((k) == ONLY_PHASE && lo <= (k) && (k) < hi)
#else
#define IN(k) (lo <= (k) && (k) < hi)
#endif
#if MK_N_LAUNCHES == 1
    volatile LAS unsigned* MISC = (volatile LAS unsigned*)(lds + MISC_OFF);
    for (int u = tid; u < 64; u += NTHR) MISC[u] = 0u;
    __syncthreads();
    XcdBarrier xbar = xcd_barrier_post((unsigned*)(ws + WS_CTL) + CW_BAR, MISC + 8);
    if (lo < 0) { __threadfence(); cg::this_grid().sync(); }
#define SEAM(k) do { if (IN(k) && IN((k) + 1)) xcd_barrier(xbar); } while (0)
#else
#define SEAM(k) do { } while (0)
#endif
#ifdef PROBE_PHASE
    volatile LAS unsigned long long* ptw = (volatile LAS unsigned long long*)(lds + MISC_OFF + 1536);
#define pt0 ptw[0]
#define pt1 ptw[1]
    if (tid == 0) { pt0 = 0ull; pt1 = 0ull; }
#define PB(k) do { if ((k) == PROBE_PHASE && bx == 0 && tid == 0) pt0 = __builtin_amdgcn_s_memrealtime(); } while (0)
#define PE(k) do { if ((k) == PROBE_PHASE && bx == 0 && tid == 0) pt1 = __builtin_amdgcn_s_memrealtime(); } while (0)
#else
#define PB(k) do { } while (0)
#define PE(k) do { } while (0)
#endif
    typedef pg8::bf16_t pbf;
    int K256 = 256, K512 = 512, K1024 = 1024, K2048 = 2048;
    asm volatile("" : "+s"(K256), "+s"(K512), "+s"(K1024), "+s"(K2048));
    PB(0);
    if (IN(0)) { phase0(args, lds, tid, lane, wave, vcu, G); }
    SEAM(0); PE(0);
    PB(1);
    if (IN(1)) {
        { pg8::Gemm g{(const pbf*)(ws + WS_XN), (const pbf*)(ws + WS_WIN), T, 11 * 256, K1024}; pg8::StaticOrder S; S.init(T, 11 * 256, G, bx);
          pg8::EpiProj E{(pbf*)(ws + WS_RKV), (pbf*)(ws + WS_PROJB), (pbf*)(ws + WS_GATES)};
          pg8::gemm_phase<pg8::EpiProj, pg8::StaticOrder, true, true>(lds, g, S, E); }
        { pg8::Gemm g{(const pbf*)(ws + WS_WIN) + (size_t)2816 * 1024, (const pbf*)(ws + WS_XN), 512, T, K1024}; pg8::StaticOrder S; S.init(512, T, G, bx);
          pg8::EpiStore E{(pbf*)(ws + WS_VT), T};
          pg8::gemm_phase<pg8::EpiStore, pg8::StaticOrder, true, true>(lds, g, S, E); }
    }
    SEAM(1); PE(1);
    PB(2);
    if (IN(2)) { phase2(args, lds, tid, vcu, G); }
    SEAM(2); PE(2);
    PB(3);
    if (IN(3)) {
        pg8::Gemm g{(const pbf*)((unsigned char*)args.out + OUT_LA), (const pbf*)(ws + WS_WLORA), T, 1536, K256}; pg8::StaticOrder S; S.init(T, 1536, G, bx);
        pg8::EpiLora E{(pbf*)(ws + WS_E), (pbf*)(ws + WS_A), (pbf*)(ws + WS_G), args.in[5], args.in[7]};
        pg8::gemm_phase<pg8::EpiLora, pg8::StaticOrder, true, true>(lds, g, S, E);
    }
    SEAM(3); PE(3);
    PB(4);
    if (IN(4)) {
        unsigned* qhead = (unsigned*)(ws + WS_CTL) + CW_QUEUE; LAS unsigned* ubox = (LAS unsigned*)(lds + MISC_OFF);
        float* stash = (float*)((unsigned char*)args.out + OUT_STASH) + (size_t)bx * 64 * 512;
        for (;;) {
            __syncthreads();
            if (tid == 0) ubox[0] = atomicAdd(qhead, 1u);
            __syncthreads();
            const int u = (int)ubox[0];
            int oq = 0; asm volatile("" : "+v"(oq)); const int tq = tid + oq;
            if (u >= NSCAN + NGATE + 512) break;
#if defined(PROBE_PHASE) && PROBE_PHASE == 100
            if (u < NSCAN) { if (tid == 0) ptw[2] = __builtin_amdgcn_s_memrealtime(); if (SCAN_CHUNKED) scan_unit_chunked(args, lds, tq, u); else scan_unit(args, lds, tq, u);
                if (tid == 0) atomicMax((unsigned*)(ws + WS_CTL) + 96, (unsigned)(__builtin_amdgcn_s_memrealtime() - ptw[2])); }
#else
            if (u < NSCAN) { if (SCAN_CHUNKED) scan_unit_chunked(args, lds, tq, u); else scan_unit(args, lds, tq, u); }
#endif
#if defined(PROBE_PHASE) && PROBE_PHASE == 101
            else if (u < NSCAN + NGATE) { } else { const int au = u - NSCAN - NGATE; const unsigned long long q0 = __builtin_amdgcn_s_memrealtime(); attn_unit(args, lds, tid, (au & 31) >> 2, au & 3, 15 - (au >> 5), stash); const unsigned long long q1 = __builtin_amdgcn_s_memrealtime();
                if (tid == 0) atomicAdd((unsigned*)(ws + WS_CTL) + 96, (unsigned)(q1 - q0)); }
#else
            else if (u < NSCAN + NGATE) { const int it = u - NSCAN;
                pg8::Gemm g{(const pbf*)(ws + WS_XN), (const pbf*)(ws + WS_WIN) + (size_t)3328 * 1024, T, 2048, K1024}; pg8::OrderItem S{it >> 1, (it & 1) * 4, 4};
                pg8::EpiGates E{(pbf*)(ws + WS_GATES)};
                pg8::gemm_phase<pg8::EpiGates, pg8::OrderItem, true, true>(lds, g, S, E, oq); }
            else { const int au = u - NSCAN - NGATE; attn_unit(args, lds, tq, (au & 31) >> 2, au & 3, 15 - (au >> 5), stash); }
#endif
        }
    }
    SEAM(4); PE(4);
#if defined(PROBE_PHASE) && (PROBE_PHASE == 210 || PROBE_PHASE == 211 || PROBE_PHASE == 215)
    if (bx == 0) { float* res = (float*)(ws + WS_CTL) + 100; if (PROBE_PHASE != 211) check_attn(args, lds, tid, res); else check_scan(args, lds, tid, res); __syncthreads(); if (tid == 0) { pt0 = 0ull; pt1 = (unsigned long long)(*(volatile float*)res * 1.0e6f); } }
    xcd_barrier(xbar);
#endif
#if defined(PROBE_PHASE) && PROBE_PHASE == 100
    if (bx == 0 && tid == 0) { pt0 = 0ull; pt1 = (unsigned long long)__hip_atomic_load((unsigned*)(ws + WS_CTL) + 96, __ATOMIC_RELAXED, __HIP_MEMORY_SCOPE_AGENT); }
#endif
#if defined(PROBE_PHASE) && PROBE_PHASE >= 300 && PROBE_PHASE < 310
    if (bx == 0 && tid == 0) { pt0 = 0ull; pt1 = (unsigned long long)__hip_atomic_load((unsigned*)(ws + WS_CTL) + 96, __ATOMIC_RELAXED, __HIP_MEMORY_SCOPE_AGENT) / 64ull; }
#endif
#if defined(PROBE_PHASE) && PROBE_PHASE == 101
    if (bx == 0 && tid == 0) { pt0 = 0ull; pt1 = (unsigned long long)__hip_atomic_load((unsigned*)(ws + WS_CTL) + 96, __ATOMIC_RELAXED, __HIP_MEMORY_SCOPE_AGENT) / 256ull; }
#endif
    PB(5);
    if (IN(5)) { phase_orw(args, lane, wave, vcu, G); }
    SEAM(5); PE(5);
    PB(6);
    if (IN(6)) {
        pg8::Gemm g{(const pbf*)((unsigned char*)args.out + OUT_ORWDF), (const pbf*)(ws + WS_WBRD), T, 1024, K1024}; pg8::StaticOrder S; S.init(T, 1024, G, bx);
        pg8::EpiMix E{(const pbf*)(ws + WS_GATES), (pbf*)(ws + WS_MIXED)};
        pg8::gemm_phase<pg8::EpiMix, pg8::StaticOrder, true, true>(lds, g, S, E);
    }
    SEAM(6); PE(6);
    PB(7);
    if (IN(7)) {
        pg8::Gemm g{(const pbf*)(ws + WS_MIXED), (const pbf*)(ws + WS_WO), T, 1024, K1024}; pg8::StaticOrder S; S.init(T, 1024, G, bx);
        pg8::EpiRes E{args.in[0], (pbf*)args.out};
        pg8::gemm_phase<pg8::EpiRes, pg8::StaticOrder, true, true>(lds, g, S, E);
    }
    SEAM(7); PE(7);
    PB(8);
    if (IN(8)) { phase7(args, lds, tid, lane, wave, vcu, G); }
    SEAM(8); PE(8);
    PB(9);
    if (IN(9)) {
        pg8::Gemm g{(const pbf*)(ws + WS_H2X), (const pbf*)(ws + WS_WR), T, 256, K1024}; pg8::StaticOrder S; S.init(T, 256, G, bx);
        pg8::EpiLogits E{(float*)(ws + WS_LOGITS)};
        pg8::gemm_phase<pg8::EpiLogits, pg8::StaticOrder, true, true>(lds, g, S, E);
        VM_WAIT(); __syncthreads();
        pg8::Unit u;
        for (int i = 0; S.next(i, u); ++i) route_tile(args, lds, tid, u.pm);
    }
    SEAM(9); PE(9);
    PB(10);
    if (IN(10)) { phase9(args, lds, tid, lane, wave); }
    SEAM(10); PE(10);
    PB(11);
    if (IN(11) || IN(12)) {
        const int* disp = (const int*)(ws + WS_DISP); LAS int* tile_e = (LAS int*)(lds + MISC_OFF + 64);
        __syncthreads();
        const int NT = disp[0];
        for (int i = tid; i < NT && i < 320; i += NTHR) tile_e[i] = disp[16 + i];
        __syncthreads();
        if (IN(11)) {
            pg8::Gemm g{(const pbf*)(ws + WS_H2X), (const pbf*)(ws + WS_WGU), T, NEXP * 1024, K1024}; pg8::OrderMoe S{NT * 4, G, bx, tile_e};
            pg8::EpiAct E{(pbf*)(ws + WS_ACT)};
            pg8::gemm_phase_gather<pg8::EpiAct, pg8::OrderMoe>(lds, g, (const int*)(ws + WS_ROWTOK), S, E);
        }
        SEAM(11); PE(11); PB(12);
        if (IN(12)) {
            pg8::Gemm g{(const pbf*)(ws + WS_ACT), (const pbf*)(ws + WS_WD), MAXROWS, NEXP * 1024, K512}; pg8::OrderMoe S{NT * 4, G, bx, tile_e};
            pg8::EpiDown E{(pbf*)(ws + WS_Y2), (const float*)(ws + WS_ROWW)};
            pg8::gemm_phase<pg8::EpiDown, pg8::OrderMoe, true, true>(lds, g, S, E);
        }
    }
    SEAM(12); PE(12);
#if defined(PROBE_PHASE) && (PROBE_PHASE == 200 || PROBE_PHASE == 201)
    if (bx == 0) { float* res = (float*)(ws + WS_CTL) + 100; check_moe(args, lds, tid, res); __syncthreads(); if (tid == 0) { pt0 = 0ull; pt1 = (unsigned long long)(*(volatile float*)res * 1.0e6f); } }
    xcd_barrier(xbar);
#endif
    PB(13);
    if (IN(13)) { phase12(args, tid, lane, wave, vcu, G); }
    SEAM(13); PE(13);
    PB(14);
    if (IN(14)) {
        { pg8::Gemm g{(const pbf*)(ws + WS_P16), (const pbf*)(ws + WS_WPP), T, 1024, K256}; pg8::StaticOrder S; S.init(T, 1024, G, bx);
          pg8::EpiStore E{(pbf*)(ws + WS_PP), 1024};
          pg8::gemm_phase<pg8::EpiStore, pg8::StaticOrder, true, true>(lds, g, S, E); }
        { pg8::Gemm g{(const pbf*)(ws + WS_H3), (const pbf*)(ws + WS_WPG), T, 1024, K1024}; pg8::StaticOrder S; S.init(T, 1024, G, bx);
          pg8::EpiFinal E{(const pbf*)(ws + WS_PP), (const pbf*)(ws + WS_X2), args.out};
          pg8::gemm_phase<pg8::EpiFinal, pg8::StaticOrder, true, true>(lds, g, S, E); }
    }
#ifdef PROBE_PHASE
    if (PROBE_PHASE == 14 && bx == 0 && tid == 0) { pt1 = __builtin_amdgcn_s_memrealtime(); }
    if (bx == 0 && tid == 0) { const unsigned long long te = __builtin_amdgcn_s_memrealtime(), w = (unsigned long long)PROBE_MULT * (pt1 - pt0);
        while (__builtin_amdgcn_s_memrealtime() - te < w) __builtin_amdgcn_s_sleep(32); }
#endif
#undef IN
#undef SEAM
}

extern "C" void kernel_launch(void* const* d_in, const int* in_sizes, int n_in, void* d_out, int out_size, void* d_ws, size_t ws_size, hipStream_t stream) {
    static int grid = 0;
    if (grid == 0) {
        if (n_in != 36 || in_sizes[0] != T * DM || out_size != T * DM || ws_size < WS_END) {
            fprintf(stderr, "kernel_launch: unexpected problem: n_in %d in0 %d out %d ws %zu (need %zu)\n", n_in, n_in > 0 ? in_sizes[0] : -1, out_size, ws_size, (size_t)WS_END); grid = -1; return; }
        int dev = 0, cus = 0, per_cu = 0;
        if (hipGetDevice(&dev) != hipSuccess || hipDeviceGetAttribute(&cus, hipDeviceAttributeMultiprocessorCount, dev) != hipSuccess) { grid = -1; return; }
        if (hipFuncSetAttribute((const void*)mk_fwd, hipFuncAttributeMaxDynamicSharedMemorySize, LDS_BYTES) != hipSuccess) { fprintf(stderr, "kernel_launch: hipFuncSetAttribute failed\n"); grid = -1; return; }
        if (hipOccupancyMaxActiveBlocksPerMultiprocessor(&per_cu, (const void*)mk_fwd, NTHR, LDS_BYTES) != hipSuccess || per_cu < 1) { fprintf(stderr, "kernel_launch: occupancy query says %d blocks per CU\n", per_cu); (void)hipGetLastError(); grid = -1; return; }
        grid = cus;
        if (grid > 256) grid = 256;
    }
    if (grid < 0) return;
    (void)hipMemsetAsync((char*)d_ws + WS_CTL, 0, CTL_ZERO_BYTES, stream);
    Args a{};
    for (int i = 0; i < 36; ++i) a.in[i] = (const float*)d_in[i];
    a.out = (float*)d_out; a.ws = (unsigned char*)d_ws;
#if MK_N_LAUNCHES == 1
    a.ph_lo = 0; a.ph_hi = NPHASE;
    void* kargs[] = {&a};
    const hipError_t e = hipLaunchCooperativeKernel((const void*)mk_fwd, dim3(grid), dim3(NTHR), kargs, LDS_BYTES, stream);
    if (e != hipSuccess) fprintf(stderr, "kernel_launch: cooperative launch failed: %s (grid %d)\n", hipGetErrorString(e), grid);
#else
    for (int ph = 0; ph < NPHASE; ++ph) { a.ph_lo = ph; a.ph_hi = ph + 1; hipLaunchKernelGGL(mk_fwd, dim3(grid), dim3(NTHR), LDS_BYTES, stream, a); }
#endif
}
```

```cpp
#include <hip/hip_runtime.h>
#include <hip/hip_cooperative_groups.h>
#include <cstdio>
#include <cstdint>
namespace cg = cooperative_groups;
namespace pg8 {
#define PG8_LAS __attribute__((address_space(3)))
typedef unsigned short bf16_t;
typedef short bf16x8 __attribute__((ext_vector_type(8)));
typedef float f32x4 __attribute__((ext_vector_type(4)));
typedef unsigned u32x4 __attribute__((ext_vector_type(4)));
constexpr int BM = 256, BK = 64, HALF = 128, HTB = HALF * BK * 2  , STAGE_BYTES = 8 * HTB, NXCD = 8, WGM = 8;

__host__ __device__ __forceinline__ int lds_byte(int r, int c) { const int st = (r >> 4) * 2 + (c >> 5), rr = r & 15, cc = c & 31, ob = rr * 64 + cc * 2; return st * 1024 + (ob ^ (((ob >> 9) & 1) << 5)); }
__host__ __device__ __forceinline__ void stage_rc(int b, int& R, int& C) { const int st = b / 1024, sb = b % 1024, swz = sb ^ (((sb >> 9) & 1) << 5); R = (st >> 1) * 16 + swz / 64; C = (st & 1) * 32 + (swz % 64) / 2; }
__host__ __device__ __forceinline__ int perm32(int rho) { const int n = rho >> 4, i = rho & 15; return 8 * (i >> 2) + 4 * n + (i & 3); }

struct Unit { int pm, pn; };
struct Gemm { const bf16_t* A; const bf16_t* Bt; int M, N, K; };

struct StaticOrder {
    int nM, nN, nwg, G, c;
    __host__ __device__ __forceinline__ void init(int M, int N, int G_, int c_) { nM = M / BM; nN = N / BM; nwg = nM * nN; G = G_; c = c_; }
    __host__ __device__ __forceinline__ bool next(int i, Unit& u) const {
        const long L = (long)i * G + c; if (L >= nwg) return false;
        int wgid = (int)L; { const int q = nwg / NXCD, r = nwg % NXCD, xcd = wgid % NXCD, off = wgid / NXCD; wgid = (xcd < r ? xcd * (q + 1) : r * (q + 1) + (xcd - r) * q) + off; }
        const int nig = WGM * nN, gid = wgid / nig, fm = gid * WGM, gsz = (nM - fm) < WGM ? (nM - fm) : WGM;
        u.pm = fm + ((wgid % nig) % gsz); u.pn = (wgid % nig) / gsz; return true;
    }
    __device__ __forceinline__ void a_ready(const Unit&) const {}
    __device__ __forceinline__ void done(const Unit&) const {}
};

__device__ __forceinline__ unsigned cvt_pk_bf16(float lo, float hi) { unsigned r; asm volatile("v_cvt_pk_bf16_f32 %0, %1, %2" : "=v"(r) : "v"(lo), "v"(hi)); return r; }
template <class Epi, class Sched, bool ALIGN_EPI = false, bool SP2 = false>
__device__ __forceinline__ void gemm_phase(PG8_LAS unsigned char* lds, const Gemm g, const Sched& S, const Epi& E, const int tz = 0  ) {
    const int tid = threadIdx.x + tz, wid = __builtin_amdgcn_readfirstlane(tid >> 6), lane = tid & 63, wr = wid >> 2, wc = wid & 3, fr = lane & 15, fq = lane >> 4;
    const int K = g.K, nt = K / BK;
    unsigned voffA[2], voffB[2];
#pragma unroll
    for (int i = 0; i < 2; ++i) { int R, C; stage_rc(tid * 16 + i * 8192, R, C); const int Rb = Epi::PERM ? ((R & ~31) + perm32(R & 31)) : R;
        voffA[i] = (unsigned)(R * K + C) * 2u; voffB[i] = (unsigned)(Rb * K + C) * 2u; }
    const size_t kstep = (size_t)(BK * 2);
    const size_t hstep = (size_t)HALF * K * 2;
    const size_t tstep = 2 * hstep;
    const unsigned ldsw = (unsigned)wid * 1024u;
    const int aoff = lds_byte(wr * 64 + fr, fq * 8), boff = lds_byte(wc * 32 + fr, fq * 8);
#define PG8_SA(b, h) (((b) * 2 + (h)) * HTB)
#define PG8_SB(b, h) ((4 + (b) * 2 + (h)) * HTB)
#define PG8_STAGE(bufoff, gbase, voff) do { _Pragma("unroll") for (int _i = 0; _i < 2; ++_i) \
        __builtin_amdgcn_global_load_lds((const unsigned*)((const char*)(gbase) + (voff)[_i]), (PG8_LAS unsigned*)(lds + (bufoff) + ldsw + _i * 8192), 16, 0, 0); } while (0)
#define PG8_LDA(dst, b, h) do { _Pragma("unroll") for (int m = 0; m < 4; ++m) _Pragma("unroll") for (int k = 0; k < 2; ++k) dst[m][k] = *(const PG8_LAS bf16x8*)(lds + PG8_SA(b, h) + aoff + m * 2048 + k * 1024); } while (0)
#define PG8_LDB(dst, b, h) do { _Pragma("unroll") for (int n = 0; n < 2; ++n) _Pragma("unroll") for (int k = 0; k < 2; ++k) dst[n][k] = *(const PG8_LAS bf16x8*)(lds + PG8_SB(b, h) + boff + n * 2048 + k * 1024); } while (0)
#define PG8_MMA(ai, bj, At, Bt) do { __builtin_amdgcn_s_setprio(1); _Pragma("unroll") for (int m = 0; m < 4; ++m) _Pragma("unroll") for (int n = 0; n < 2; ++n) _Pragma("unroll") for (int k = 0; k < 2; ++k) \
        acc[ai][bj][m][n] = __builtin_amdgcn_mfma_f32_16x16x32_bf16(Bt[n][k], At[m][k], acc[ai][bj][m][n], 0, 0, 0); __builtin_amdgcn_s_setprio(0); } while (0)
#define PG8_WAIT_V(n) asm volatile("s_waitcnt vmcnt(" #n ")" ::: "memory")
#define PG8_WAIT_L(n) asm volatile("s_waitcnt lgkmcnt(" #n ")" ::: "memory")
#define PG8_BAR __builtin_amdgcn_s_barrier()
#define PG8_SCHED __builtin_amdgcn_sched_barrier(0)
    Unit cur, nxt; int ui = 0;
    if (!S.next(0, cur)) return;
    f32x4 acc[2][2][4][2];
#pragma unroll
    for (int a = 0; a < 2; ++a)
#pragma unroll
        for (int b = 0; b < 2; ++b)
#pragma unroll
            for (int m = 0; m < 4; ++m)
#pragma unroll
                for (int n = 0; n < 2; ++n) acc[a][b][m][n] = (f32x4){0.f, 0.f, 0.f, 0.f};
    bf16x8 At[4][2], B0[2][2], B1[2][2];
    const char* cA = (const char*)g.A + (size_t)cur.pm * tstep; const char* cB = (const char*)g.Bt + (size_t)cur.pn * tstep;
    S.a_ready(cur);
    if constexpr (SP2) {
        PG8_STAGE(PG8_SB(0, 0), cB, voffB); PG8_STAGE(PG8_SB(0, 1), cB + hstep, voffB); PG8_STAGE(PG8_SA(0, 0), cA, voffA); PG8_STAGE(PG8_SA(0, 1), cA + hstep, voffA);
        if (wr == 1) PG8_BAR;
        PG8_WAIT_V(2); PG8_BAR;
        PG8_STAGE(PG8_SB(1, 0), cB + kstep, voffB); PG8_STAGE(PG8_SA(1, 0), cA + kstep, voffA); PG8_STAGE(PG8_SB(1, 1), cB + hstep + kstep, voffB);
        PG8_WAIT_V(6); PG8_BAR;
    } else {
        PG8_STAGE(PG8_SB(0, 0), cB, voffB); PG8_STAGE(PG8_SA(0, 0), cA, voffA); PG8_STAGE(PG8_SB(0, 1), cB + hstep, voffB); PG8_STAGE(PG8_SA(0, 1), cA + hstep, voffA);
        if (wr == 1) PG8_BAR;
        PG8_WAIT_V(4); PG8_BAR;
        PG8_STAGE(PG8_SB(1, 0), cB + kstep, voffB); PG8_STAGE(PG8_SA(1, 0), cA + kstep, voffA); PG8_STAGE(PG8_SB(1, 1), cB + hstep + kstep, voffB);
        PG8_WAIT_V(6); PG8_BAR;
    }
    for (;;) {
        const bool has_next = S.next(ui + 1, nxt);
        const char* nA = has_next ? (const char*)g.A + (size_t)nxt.pm * tstep : cA; const char* nB = has_next ? (const char*)g.Bt + (size_t)nxt.pn * tstep : cB;
        for (int t = 0; t < nt; t += 2) {
            if constexpr (Epi::HAS_MID) { if (t == (nt >> 1)) E.mid(acc, cur, wr, wc, fr, fq); }
            const bool last = (t == nt - 2);
            const char* a1 = cA + (size_t)(t + 1) * kstep;
            const char* a2 = last ? nA : cA + (size_t)(t + 2) * kstep; const char* b2 = last ? nB : cB + (size_t)(t + 2) * kstep;
            const char* a3 = a2 + kstep; const char* b3 = b2 + kstep;
            if (last && has_next) S.a_ready(nxt);
            if constexpr (SP2) {
            PG8_LDB(B0, 0, 0); PG8_LDB(B1, 0, 1); PG8_SCHED; PG8_LDA(At, 0, 0); PG8_STAGE(PG8_SA(1, 1), a1 + hstep, voffA);
            PG8_WAIT_V(8); PG8_WAIT_L(0); PG8_BAR; PG8_MMA(0, 0, At, B0); PG8_MMA(0, 1, At, B1); PG8_BAR; PG8_SCHED;
            PG8_LDA(At, 0, 1); PG8_STAGE(PG8_SB(0, 0), b2, voffB); PG8_STAGE(PG8_SB(0, 1), b2 + hstep, voffB); PG8_STAGE(PG8_SA(0, 0), a2, voffA);
            PG8_WAIT_V(8); PG8_WAIT_L(0); PG8_BAR; PG8_MMA(1, 0, At, B0); PG8_MMA(1, 1, At, B1); PG8_BAR; PG8_SCHED;
            PG8_LDB(B0, 1, 0); PG8_LDB(B1, 1, 1); PG8_SCHED; PG8_LDA(At, 1, 0); PG8_STAGE(PG8_SA(0, 1), a2 + hstep, voffA);
            PG8_WAIT_V(8); PG8_WAIT_L(0); PG8_BAR; PG8_MMA(0, 0, At, B0); PG8_MMA(0, 1, At, B1); PG8_BAR; PG8_SCHED;
            PG8_LDA(At, 1, 1); PG8_STAGE(PG8_SB(1, 0), b3, voffB); PG8_STAGE(PG8_SB(1, 1), b3 + hstep, voffB); PG8_STAGE(PG8_SA(1, 0), a3, voffA);
            PG8_WAIT_V(8); PG8_WAIT_L(0); PG8_BAR; PG8_MMA(1, 0, At, B0); PG8_MMA(1, 1, At, B1); PG8_BAR; PG8_SCHED;
            } else {
            PG8_LDB(B0, 0, 0); PG8_SCHED; PG8_LDA(At, 0, 0); PG8_STAGE(PG8_SA(1, 1), a1 + hstep, voffA);
            PG8_WAIT_L(8); PG8_BAR; PG8_WAIT_L(0); PG8_MMA(0, 0, At, B0); PG8_BAR; PG8_SCHED;
            PG8_LDB(B1, 0, 1); PG8_STAGE(PG8_SB(0, 0), b2, voffB);
            PG8_BAR; PG8_WAIT_L(0); PG8_MMA(0, 1, At, B1); PG8_BAR;
            PG8_LDA(At, 0, 1); PG8_STAGE(PG8_SA(0, 0), a2, voffA);
            PG8_BAR; PG8_WAIT_L(0); PG8_MMA(1, 0, At, B0); PG8_BAR; PG8_SCHED;
            PG8_STAGE(PG8_SB(0, 1), b2 + hstep, voffB);
            PG8_WAIT_V(6); PG8_BAR; PG8_MMA(1, 1, At, B1); PG8_BAR;
            PG8_LDB(B0, 1, 0); PG8_SCHED; PG8_LDA(At, 1, 0); PG8_STAGE(PG8_SA(0, 1), a2 + hstep, voffA);
            PG8_WAIT_L(8); PG8_BAR; PG8_WAIT_L(0); PG8_MMA(0, 0, At, B0); PG8_BAR; PG8_SCHED;
            PG8_LDB(B1, 1, 1); PG8_STAGE(PG8_SB(1, 0), b3, voffB);
            PG8_BAR; PG8_WAIT_L(0); PG8_MMA(0, 1, At, B1); PG8_BAR;
            PG8_LDA(At, 1, 1); PG8_STAGE(PG8_SA(1, 0), a3, voffA);
            PG8_BAR; PG8_WAIT_L(0); PG8_MMA(1, 0, At, B0); PG8_BAR; PG8_SCHED;
            PG8_STAGE(PG8_SB(1, 1), b3 + hstep, voffB);
            PG8_WAIT_V(6); PG8_BAR; PG8_MMA(1, 1, At, B1); PG8_BAR;
            }
        }
        if constexpr (ALIGN_EPI) { if (wr == 0) PG8_BAR; }
        if constexpr (!Epi::AFTER_DRAIN) { E(acc, cur, wr, wc, fr, fq); S.done(cur); }
        if (!has_next) break;
#pragma unroll
        for (int a = 0; a < 2; ++a)
#pragma unroll
            for (int b = 0; b < 2; ++b)
#pragma unroll
                for (int m = 0; m < 4; ++m)
#pragma unroll
                    for (int n = 0; n < 2; ++n) acc[a][b][m][n] = (f32x4){0.f, 0.f, 0.f, 0.f};
        cur = nxt; cA = nA; cB = nB; ++ui;
        if constexpr (ALIGN_EPI) { if (wr == 1) PG8_BAR; }
    }
    PG8_WAIT_V(0);
    if constexpr (!ALIGN_EPI) { if (wr == 0) PG8_BAR; }
    PG8_BAR;
    if constexpr (Epi::AFTER_DRAIN) { E.fused(acc, cur, wr, wc, fr, fq, lds, wid, lane); S.done(cur); }
#undef PG8_SA
#undef PG8_SB
#undef PG8_STAGE
#undef PG8_LDA
#undef PG8_LDB
#undef PG8_MMA
#undef PG8_WAIT_V
#undef PG8_WAIT_L
#undef PG8_BAR
#undef PG8_SCHED
}
template <class Epi, class Sched>
__device__ __forceinline__ void gemm_phase_gather(PG8_LAS unsigned char* lds, const Gemm g, const int* idx, const Sched& S, const Epi& E, const int tz = 0  ) {
    const int tid = threadIdx.x + tz, wid = __builtin_amdgcn_readfirstlane(tid >> 6), lane = tid & 63, wr = wid >> 2, wc = wid & 3, fr = lane & 15, fq = lane >> 4;
    const int K = g.K, nt = K / BK;
    unsigned voffA[2], voffB[2];
    int rowA[2];
#pragma unroll
    for (int i = 0; i < 2; ++i) { int R, C; stage_rc(tid * 16 + i * 8192, R, C); const int Rb = Epi::PERM ? ((R & ~31) + perm32(R & 31)) : R;
        voffA[i] = (unsigned)C * 2u; rowA[i] = R; voffB[i] = (unsigned)(Rb * K + C) * 2u; }
    unsigned vA0[2], vA1[2], vN0[2], vN1[2];
#define PG8_GOFF(dst0, dst1, pm_) do { _Pragma("unroll") for (int _i = 0; _i < 2; ++_i) { dst0[_i] = (unsigned)idx[(pm_) * BM + rowA[_i]] * (unsigned)(K * 2) + voffA[_i]; dst1[_i] = (unsigned)idx[(pm_) * BM + HALF + rowA[_i]] * (unsigned)(K * 2) + voffA[_i]; } } while (0)
    const size_t kstep = (size_t)(BK * 2);
    const size_t hstep = (size_t)HALF * K * 2;
    const size_t tstep = 2 * hstep;
    const unsigned ldsw = (unsigned)wid * 1024u;
    const int aoff = lds_byte(wr * 64 + fr, fq * 8), boff = lds_byte(wc * 32 + fr, fq * 8);
#define PG8_SA(b, h) (((b) * 2 + (h)) * HTB)
#define PG8_SB(b, h) ((4 + (b) * 2 + (h)) * HTB)
#define PG8_STAGE(bufoff, gbase, voff) do { _Pragma("unroll") for (int _i = 0; _i < 2; ++_i) \
        __builtin_amdgcn_global_load_lds((const unsigned*)((const char*)(gbase) + (voff)[_i]), (PG8_LAS unsigned*)(lds + (bufoff) + ldsw + _i * 8192), 16, 0, 0); } while (0)
#define PG8_LDA(dst, b, h) do { _Pragma("unroll") for (int m = 0; m < 4; ++m) _Pragma("unroll") for (int k = 0; k < 2; ++k) dst[m][k] = *(const PG8_LAS bf16x8*)(lds + PG8_SA(b, h) + aoff + m * 2048 + k * 1024); } while (0)
#define PG8_LDB(dst, b, h) do { _Pragma("unroll") for (int n = 0; n < 2; ++n) _Pragma("unroll") for (int k = 0; k < 2; ++k) dst[n][k] = *(const PG8_LAS bf16x8*)(lds + PG8_SB(b, h) + boff + n * 2048 + k * 1024); } while (0)
#define PG8_MMA(ai, bj, At, Bt) do { __builtin_amdgcn_s_setprio(1); _Pragma("unroll") for (int m = 0; m < 4; ++m) _Pragma("unroll") for (int n = 0; n < 2; ++n) _Pragma("unroll") for (int k = 0; k < 2; ++k) \
        acc[ai][bj][m][n] = __builtin_amdgcn_mfma_f32_16x16x32_bf16(Bt[n][k], At[m][k], acc[ai][bj][m][n], 0, 0, 0); __builtin_amdgcn_s_setprio(0); } while (0)
#define PG8_WAIT_V(n) asm volatile("s_waitcnt vmcnt(" #n ")" ::: "memory")
#define PG8_WAIT_L(n) asm volatile("s_waitcnt lgkmcnt(" #n ")" ::: "memory")
#define PG8_BAR __builtin_amdgcn_s_barrier()
#define PG8_SCHED __builtin_amdgcn_sched_barrier(0)
    Unit cur, nxt; int ui = 0;
    if (!S.next(0, cur)) return;
    f32x4 acc[2][2][4][2];
#pragma unroll
    for (int a = 0; a < 2; ++a)
#pragma unroll
        for (int b = 0; b < 2; ++b)
#pragma unroll
            for (int m = 0; m < 4; ++m)
#pragma unroll
                for (int n = 0; n < 2; ++n) acc[a][b][m][n] = (f32x4){0.f, 0.f, 0.f, 0.f};
    bf16x8 At[4][2], B0[2][2], B1[2][2];
    const char* cA = (const char*)g.A; PG8_GOFF(vA0, vA1, cur.pm); const char* cB = (const char*)g.Bt + (size_t)cur.pn * tstep;
    S.a_ready(cur);
    if constexpr (true) {
        PG8_STAGE(PG8_SB(0, 0), cB, voffB); PG8_STAGE(PG8_SB(0, 1), cB + hstep, voffB); PG8_STAGE(PG8_SA(0, 0), cA, vA0); PG8_STAGE(PG8_SA(0, 1), cA, vA1);
        if (wr == 1) PG8_BAR;
        PG8_WAIT_V(2); PG8_BAR;
        PG8_STAGE(PG8_SB(1, 0), cB + kstep, voffB); PG8_STAGE(PG8_SA(1, 0), cA + kstep, vA0); PG8_STAGE(PG8_SB(1, 1), cB + hstep + kstep, voffB);
        PG8_WAIT_V(6); PG8_BAR;
    } else {
        PG8_STAGE(PG8_SB(0, 0), cB, voffB); PG8_STAGE(PG8_SA(0, 0), cA, voffA); PG8_STAGE(PG8_SB(0, 1), cB + hstep, voffB); PG8_STAGE(PG8_SA(0, 1), cA + hstep, voffA);
        if (wr == 1) PG8_BAR;
        PG8_WAIT_V(4); PG8_BAR;
        PG8_STAGE(PG8_SB(1, 0), cB + kstep, voffB); PG8_STAGE(PG8_SA(1, 0), cA + kstep, vA0); PG8_STAGE(PG8_SB(1, 1), cB + hstep + kstep, voffB);
        PG8_WAIT_V(6); PG8_BAR;
    }
    for (;;) {
        const bool has_next = S.next(ui + 1, nxt);
        const char* nA = cA; if (has_next) PG8_GOFF(vN0, vN1, nxt.pm); else { vN0[0] = vA0[0]; vN0[1] = vA0[1]; vN1[0] = vA1[0]; vN1[1] = vA1[1]; } const char* nB = has_next ? (const char*)g.Bt + (size_t)nxt.pn * tstep : cB;
        for (int t = 0; t < nt; t += 2) {
            if constexpr (Epi::HAS_MID) { if (t == (nt >> 1)) E.mid(acc, cur, wr, wc, fr, fq); }
            const bool last = (t == nt - 2);
            const char* a1 = cA + (size_t)(t + 1) * kstep;
            const char* a2 = last ? nA : cA + (size_t)(t + 2) * kstep; unsigned x0[2], x1[2]; x0[0] = last ? vN0[0] : vA0[0]; x0[1] = last ? vN0[1] : vA0[1]; x1[0] = last ? vN1[0] : vA1[0]; x1[1] = last ? vN1[1] : vA1[1]; const char* b2 = last ? nB : cB + (size_t)(t + 2) * kstep;
            const char* a3 = a2 + kstep; const char* b3 = b2 + kstep;
            if (last && has_next) S.a_ready(nxt);
            if constexpr (true) {
            PG8_LDB(B0, 0, 0); PG8_LDB(B1, 0, 1); PG8_SCHED; PG8_LDA(At, 0, 0); PG8_STAGE(PG8_SA(1, 1), a1, vA1);
            PG8_WAIT_V(8); PG8_WAIT_L(0); PG8_BAR; PG8_MMA(0, 0, At, B0); PG8_MMA(0, 1, At, B1); PG8_BAR; PG8_SCHED;
            PG8_LDA(At, 0, 1); PG8_STAGE(PG8_SB(0, 0), b2, voffB); PG8_STAGE(PG8_SB(0, 1), b2 + hstep, voffB); PG8_STAGE(PG8_SA(0, 0), a2, x0);
            PG8_WAIT_V(8); PG8_WAIT_L(0); PG8_BAR; PG8_MMA(1, 0, At, B0); PG8_MMA(1, 1, At, B1); PG8_BAR; PG8_SCHED;
            PG8_LDB(B0, 1, 0); PG8_LDB(B1, 1, 1); PG8_SCHED; PG8_LDA(At, 1, 0); PG8_STAGE(PG8_SA(0, 1), a2, x1);
            PG8_WAIT_V(8); PG8_WAIT_L(0); PG8_BAR; PG8_MMA(0, 0, At, B0); PG8_MMA(0, 1, At, B1); PG8_BAR; PG8_SCHED;
            PG8_LDA(At, 1, 1); PG8_STAGE(PG8_SB(1, 0), b3, voffB); PG8_STAGE(PG8_SB(1, 1), b3 + hstep, voffB); PG8_STAGE(PG8_SA(1, 0), a3, x0);
            PG8_WAIT_V(8); PG8_WAIT_L(0); PG8_BAR; PG8_MMA(1, 0, At, B0); PG8_MMA(1, 1, At, B1); PG8_BAR; PG8_SCHED;
            } else {
            PG8_LDB(B0, 0, 0); PG8_SCHED; PG8_LDA(At, 0, 0); PG8_STAGE(PG8_SA(1, 1), a1, vA1);
            PG8_WAIT_L(8); PG8_BAR; PG8_WAIT_L(0); PG8_MMA(0, 0, At, B0); PG8_BAR; PG8_SCHED;
            PG8_LDB(B1, 0, 1); PG8_STAGE(PG8_SB(0, 0), b2, voffB);
            PG8_BAR; PG8_WAIT_L(0); PG8_MMA(0, 1, At, B1); PG8_BAR;
            PG8_LDA(At, 0, 1); PG8_STAGE(PG8_SA(0, 0), a2, x0);
            PG8_BAR; PG8_WAIT_L(0); PG8_MMA(1, 0, At, B0); PG8_BAR; PG8_SCHED;
            PG8_STAGE(PG8_SB(0, 1), b2 + hstep, voffB);
            PG8_WAIT_V(6); PG8_BAR; PG8_MMA(1, 1, At, B1); PG8_BAR;
            PG8_LDB(B0, 1, 0); PG8_SCHED; PG8_LDA(At, 1, 0); PG8_STAGE(PG8_SA(0, 1), a2, x1);
            PG8_WAIT_L(8); PG8_BAR; PG8_WAIT_L(0); PG8_MMA(0, 0, At, B0); PG8_BAR; PG8_SCHED;
            PG8_LDB(B1, 1, 1); PG8_STAGE(PG8_SB(1, 0), b3, voffB);
            PG8_BAR; PG8_WAIT_L(0); PG8_MMA(0, 1, At, B1); PG8_BAR;
            PG8_LDA(At, 1, 1); PG8_STAGE(PG8_SA(1, 0), a3, x0);
            PG8_BAR; PG8_WAIT_L(0); PG8_MMA(1, 0, At, B0); PG8_BAR; PG8_SCHED;
            PG8_STAGE(PG8_SB(1, 1), b3 + hstep, voffB);
            PG8_WAIT_V(6); PG8_BAR; PG8_MMA(1, 1, At, B1); PG8_BAR;
            }
        }
        if constexpr (true) { if (wr == 0) PG8_BAR; }
        if constexpr (!Epi::AFTER_DRAIN) { E(acc, cur, wr, wc, fr, fq); S.done(cur); }
        if (!has_next) break;
#pragma unroll
        for (int a = 0; a < 2; ++a)
#pragma unroll
            for (int b = 0; b < 2; ++b)
#pragma unroll
                for (int m = 0; m < 4; ++m)
#pragma unroll
                    for (int n = 0; n < 2; ++n) acc[a][b][m][n] = (f32x4){0.f, 0.f, 0.f, 0.f};
        cur = nxt; cA = nA; cB = nB; ++ui; vA0[0] = vN0[0]; vA0[1] = vN0[1]; vA1[0] = vN1[0]; vA1[1] = vN1[1];
        if constexpr (true) { if (wr == 1) PG8_BAR; }
    }
    PG8_WAIT_V(0);
    if constexpr (false) { if (wr == 0) PG8_BAR; }
    PG8_BAR;
    if constexpr (Epi::AFTER_DRAIN) { E.fused(acc, cur, wr, wc, fr, fq, lds, wid, lane); S.done(cur); }
#undef PG8_SA
#undef PG8_SB
#undef PG8_GOFF
#undef PG8_STAGE
#undef PG8_LDA
#undef PG8_LDB
#undef PG8_MMA
#undef PG8_WAIT_V
#undef PG8_WAIT_L
#undef PG8_BAR
#undef PG8_SCHED
}
}

constexpr int NB = 8, SEQ = 4096, DM = 1024, T = NB * SEQ;
constexpr int RW = 512, NHR = 8;
constexpr int NPROJ = 5376;
constexpr int FF = 512, NEXP = 32;
constexpr float C2 = 0.125f * 1.4426950408889634f;
constexpr float LAM_INIT = 0.2f;
constexpr int MAXROWS = 2 * T + NEXP * 256;

constexpr size_t MiB = 1u << 20;
constexpr size_t WS_CTL = 0, CTL_ZERO_BYTES = 1 * MiB;
constexpr size_t WS_WLORA = 1 * MiB;
constexpr size_t WS_WBRD = 2 * MiB;
constexpr size_t WS_WO = 4 * MiB;
constexpr size_t WS_WR = 6 * MiB;
constexpr size_t WS_WPG = 7 * MiB;
constexpr size_t WS_WPP = 9 * MiB;
constexpr size_t WS_TOKE = 10 * MiB;
constexpr size_t WS_TOKW = 10 * MiB + 256 * 1024;
constexpr size_t WS_POS = 10 * MiB + 512 * 1024;
constexpr size_t WS_ROWW = 10 * MiB + 768 * 1024;
constexpr size_t WS_TILECNT = 11 * MiB + 256 * 1024;
constexpr size_t WS_DISP = 11 * MiB + 512 * 1024;
constexpr size_t WS_BON = 12 * MiB;
constexpr size_t WS_ROWTOK = 13 * MiB;
constexpr size_t WS_RS = 13 * MiB + 512 * 1024;
constexpr size_t WS_ROWRS = 13 * MiB + 640 * 1024;
constexpr size_t WS_SSQ = 14 * MiB;
constexpr size_t WS_WIN = 16 * MiB;
constexpr size_t WS_LOGITS = 16 * MiB;
constexpr size_t WS_XN = 32 * MiB;
constexpr size_t WS_WGU = 32 * MiB;
constexpr size_t WS_RKV = 96 * MiB;
constexpr size_t WS_MIXED = 96 * MiB;
constexpr size_t WS_WD = 96 * MiB;
constexpr size_t WS_HS = 128 * MiB;
constexpr size_t WS_H3 = 128 * MiB;
constexpr size_t WS_PROJB = 192 * MiB;
constexpr size_t WS_E = 192 * MiB;
constexpr size_t WS_A = 224 * MiB;
constexpr size_t WS_G = 256 * MiB;
constexpr size_t WS_P16 = 192 * MiB;
constexpr size_t WS_PP = 208 * MiB;
constexpr size_t WS_Y2 = 272 * MiB;
constexpr size_t WS_GATES = 304 * MiB;
constexpr size_t WS_H2X = 304 * MiB;
constexpr size_t WS_VT = 432 * MiB;
constexpr size_t WS_ACT = 432 * MiB;
constexpr size_t WS_X2 = 432 * MiB;
constexpr size_t WS_PART = 176 * MiB;
constexpr size_t WS_END = 512 * MiB;
constexpr size_t OUT_STASH = 0, OUT_ORWDF = 32 * MiB, OUT_Y = 96 * MiB  , OUT_LA = 0  ;
static_assert(WS_ACT + (size_t)MAXROWS * 512 * 2 <= WS_END && WS_Y2 + (size_t)MAXROWS * 1024 * 2 <= WS_ACT && WS_HS + (size_t)MAXROWS * 1024 * 2 <= WS_Y2, "ws map");
static_assert(WS_PART + (size_t)T * 1024 * 4 <= WS_GATES && WS_MIXED + (size_t)T * 1024 * 2 <= WS_PART, "ws map");
constexpr int CW_QUEUE = 64;
constexpr int CW_BAR = 4096;

constexpr int RING_BYTES = 131072;
constexpr int MISC_OFF = 158720;
constexpr int LDS_BYTES = 160768;
constexpr int NWAVES = 8, NTHR = 512;

#define GAS __attribute__((address_space(1)))
#define LAS __attribute__((address_space(3)))
typedef unsigned short bf16;
typedef unsigned v4u __attribute__((ext_vector_type(4)));
typedef unsigned v2u __attribute__((ext_vector_type(2)));
typedef float f32x4 __attribute__((ext_vector_type(4)));
typedef float f32x16 __attribute__((ext_vector_type(16)));
typedef short s16x8 __attribute__((ext_vector_type(8)));
typedef short s16x4 __attribute__((ext_vector_type(4)));
#define LDS_WAIT() asm volatile("s_waitcnt lgkmcnt(0)" ::: "memory")
#define VM_WAIT() asm volatile("s_waitcnt vmcnt(0)" ::: "memory")

__device__ __forceinline__ bf16* y_ptr(float* out, int b) { return (bf16*)((unsigned char*)out + OUT_Y) + (size_t)b * SEQ * 512; }
__device__ __forceinline__ bf16* qn_ptr(unsigned char* ws, int b) { return (bf16*)(ws + (b < 4 ? (288 + 4 * (size_t)b) * MiB : (464 + 4 * (size_t)(b - 4)) * MiB)); }
__device__ __forceinline__ bf16* kn_ptr(unsigned char* ws, int b) { return (bf16*)(ws + (480 + 4 * (size_t)b) * MiB); }
__device__ __forceinline__ unsigned f2bf(float f) { unsigned u = __builtin_bit_cast(unsigned, f); return (u + 0x7fffu + ((u >> 16) & 1u)) >> 16; }
typedef float f32x2_t __attribute__((ext_vector_type(2))); typedef __bf16 bf16x2_t __attribute__((ext_vector_type(2)));
__device__ __forceinline__ unsigned pk2(float lo, float hi) { f32x2_t v = {lo, hi}; bf16x2_t b = __builtin_convertvector(v, bf16x2_t); return __builtin_bit_cast(unsigned, b); }
__device__ __forceinline__ float bflo(unsigned w) { return __builtin_bit_cast(float, w << 16); }
__device__ __forceinline__ float bfhi(unsigned w) { return __builtin_bit_cast(float, w & 0xffff0000u); }
__device__ __forceinline__ float sigm(float x) { return __builtin_amdgcn_rcpf(1.0f + __builtin_amdgcn_exp2f(-1.4426950408889634f * x)); }
template <int CTRL> __device__ __forceinline__ float dpp_mov(float v) { return __builtin_bit_cast(float, __builtin_amdgcn_update_dpp(0, __builtin_bit_cast(int, v), CTRL, 0xF, 0xF, false)); }
__device__ __forceinline__ float red8(float v) { v += dpp_mov<0xB1>(v); v += dpp_mov<0x4E>(v); v += dpp_mov<0x141>(v); return v; }
__device__ __forceinline__ float red16(float v) { v = red8(v); v += dpp_mov<0x140>(v); return v; }
__device__ __forceinline__ void swap32(unsigned& a, unsigned& b) { asm volatile("s_nop 1\n\tv_permlane32_swap_b32 %0, %1\n\ts_nop 1" : "+v"(a), "+v"(b)); }
__device__ __forceinline__ float xhalf_max(float m) { unsigned a = __builtin_bit_cast(unsigned, m), b = a; swap32(a, b); return fmaxf(__builtin_bit_cast(float, a), __builtin_bit_cast(float, b)); }
__device__ __forceinline__ float xhalf_sum(float m) { unsigned a = __builtin_bit_cast(unsigned, m), b = a; swap32(a, b); return __builtin_bit_cast(float, a) + __builtin_bit_cast(float, b); }
__device__ __forceinline__ float wave_sum(float v) { v = red16(v); v += __shfl_xor(v, 16); return xhalf_sum(v); }

namespace pg8 {
struct EpiStore {
    static constexpr bool PERM = true, AFTER_DRAIN = false, HAS_MID = false;
    bf16_t* O; int ldc;
    __device__ __forceinline__ void operator()(const f32x4 (&acc)[2][2][4][2], const Unit& u, int wr, int wc, int fr, int fq) const {
        const int row0 = u.pm * BM + wr * 64 + fr, col0 = u.pn * BM + wc * 32 + 8 * fq;
#pragma unroll
        for (int ai = 0; ai < 2; ++ai)
#pragma unroll
            for (int m = 0; m < 4; ++m) { bf16_t* rowp = O + (size_t)(row0 + ai * HALF + m * 16) * ldc + col0;
#pragma unroll
                for (int bj = 0; bj < 2; ++bj) { const f32x4 v0 = acc[ai][bj][m][0], v1 = acc[ai][bj][m][1]; u32x4 w;
                    w.x = cvt_pk_bf16(v0[0], v0[1]); w.y = cvt_pk_bf16(v0[2], v0[3]); w.z = cvt_pk_bf16(v1[0], v1[1]); w.w = cvt_pk_bf16(v1[2], v1[3]);
                    *(u32x4*)(rowp + bj * HALF) = w; } }
    }
};
struct EpiProj {
    static constexpr bool PERM = true, AFTER_DRAIN = false, HAS_MID = false;
    bf16_t *rkv, *projb, *gates;
    __device__ __forceinline__ void operator()(const f32x4 (&acc)[2][2][4][2], const Unit& u, int wr, int wc, int fr, int fq) const {
        bf16_t* base; int ldc, ct;
        if (u.pn < 6) { base = rkv; ldc = 1536; ct = u.pn; } else if (u.pn < 11) { base = projb; ldc = 1280; ct = u.pn - 6; } else { base = gates; ldc = 2048; ct = u.pn - 13; }
        const int row0 = u.pm * BM + wr * 64 + fr, col0 = ct * BM + wc * 32 + 8 * fq;
#pragma unroll
        for (int ai = 0; ai < 2; ++ai)
#pragma unroll
            for (int m = 0; m < 4; ++m) { bf16_t* rowp = base + (size_t)(row0 + ai * HALF + m * 16) * ldc + col0;
#pragma unroll
                for (int bj = 0; bj < 2; ++bj) { f32x4 v0 = acc[ai][bj][m][0], v1 = acc[ai][bj][m][1]; u32x4 w;
                    if (u.pn >= 13) {
#pragma unroll
                        for (int e = 0; e < 4; ++e) { v0[e] = fmaxf(sigm(v0[e]), 1e-6f); v1[e] = fmaxf(sigm(v1[e]), 1e-6f); } }
                    w.x = cvt_pk_bf16(v0[0], v0[1]); w.y = cvt_pk_bf16(v0[2], v0[3]); w.z = cvt_pk_bf16(v1[0], v1[1]); w.w = cvt_pk_bf16(v1[2], v1[3]);
                    *(u32x4*)(rowp + bj * HALF) = w; } }
    }
};
struct EpiLora {
    static constexpr bool PERM = true, AFTER_DRAIN = false, HAS_MID = false;
    bf16_t *E, *A, *G; const float *w0, *a0;
    template <int KIND> __device__ __forceinline__ void body(const f32x4 (&acc)[2][2][4][2], bf16_t* base, const float* bias, int row0, int col0) const {
#pragma unroll
        for (int bj = 0; bj < 2; ++bj)
#pragma unroll
            for (int ai = 0; ai < 2; ++ai)
#pragma unroll
                for (int m = 0; m < 4; ++m) { bf16_t* rowp = base + (size_t)(row0 + ai * HALF + m * 16) * 512 + col0 + bj * HALF;
                    f32x4 v0 = acc[ai][bj][m][0], v1 = acc[ai][bj][m][1];
                    if (KIND < 2) { const f32x4 b0 = *(const f32x4*)(bias + col0 + bj * HALF), b1 = *(const f32x4*)(bias + col0 + bj * HALF + 4); const float sc = KIND == 0 ? 0.60653065971263342f : 1.0f;
                        v0 += b0; v1 += b1;
#pragma unroll
                        for (int e = 0; e < 4; ++e) { v0[e] = sc * sigm(v0[e]); v1[e] = sc * sigm(v1[e]); } }
                    u32x4 w; w.x = cvt_pk_bf16(v0[0], v0[1]); w.y = cvt_pk_bf16(v0[2], v0[3]); w.z = cvt_pk_bf16(v1[0], v1[1]); w.w = cvt_pk_bf16(v1[2], v1[3]);
                    *(u32x4*)rowp = w; asm volatile("" ::: "memory"); }
    }
    __device__ __forceinline__ void operator()(const f32x4 (&acc)[2][2][4][2], const Unit& u, int wr, int wc, int fr, int fq) const {
        const int kind = u.pn >> 1; const int row0 = u.pm * BM + wr * 64 + fr, col0 = (u.pn & 1) * BM + wc * 32 + 8 * fq;
        if (kind == 0) body<0>(acc, E, w0, row0, col0); else if (kind == 1) body<1>(acc, A, a0, row0, col0); else body<2>(acc, G, w0, row0, col0);
    }
};
struct EpiMix {
    static constexpr bool PERM = true, AFTER_DRAIN = false, HAS_MID = true;
    const bf16_t* gates; bf16_t* mixed;
    __device__ __forceinline__ void mid(f32x4 (&acc)[2][2][4][2], const Unit& u, int wr, int wc, int fr, int fq) const {
        const int row0 = u.pm * BM + wr * 64 + fr, col0 = u.pn * BM + wc * 32 + 8 * fq;
#pragma unroll
        for (int ai = 0; ai < 2; ++ai)
#pragma unroll
            for (int m = 0; m < 4; ++m) { const size_t r = (size_t)(row0 + ai * HALF + m * 16);
#pragma unroll
                for (int bj = 0; bj < 2; ++bj) { const int c = col0 + bj * HALF;
                    const u32x4 gr = *(const u32x4*)(gates + r * 2048 + c), gd = *(const u32x4*)(gates + r * 2048 + 1024 + c);
                    f32x4& v0 = acc[ai][bj][m][0]; f32x4& v1 = acc[ai][bj][m][1];
                    v0[0] *= bflo(gr.x) * __builtin_amdgcn_rcpf(bflo(gd.x)); v0[1] *= bfhi(gr.x) * __builtin_amdgcn_rcpf(bfhi(gd.x)); v0[2] *= bflo(gr.y) * __builtin_amdgcn_rcpf(bflo(gd.y)); v0[3] *= bfhi(gr.y) * __builtin_amdgcn_rcpf(bfhi(gd.y));
                    v1[0] *= bflo(gr.z) * __builtin_amdgcn_rcpf(bflo(gd.z)); v1[1] *= bfhi(gr.z) * __builtin_amdgcn_rcpf(bfhi(gd.z)); v1[2] *= bflo(gr.w) * __builtin_amdgcn_rcpf(bflo(gd.w)); v1[3] *= bfhi(gr.w) * __builtin_amdgcn_rcpf(bfhi(gd.w)); }
                asm volatile("" ::: "memory"); }
    }
    __device__ __forceinline__ void operator()(const f32x4 (&acc)[2][2][4][2], const Unit& u, int wr, int wc, int fr, int fq) const {
        const int row0 = u.pm * BM + wr * 64 + fr, col0 = u.pn * BM + wc * 32 + 8 * fq;
#pragma unroll
        for (int ai = 0; ai < 2; ++ai)
#pragma unroll
            for (int m = 0; m < 4; ++m) { const size_t r = (size_t)(row0 + ai * HALF + m * 16);
#pragma unroll
                for (int bj = 0; bj < 2; ++bj) { const int c = col0 + bj * HALF;
                    const u32x4 gd = *(const u32x4*)(gates + r * 2048 + 1024 + c);
                    f32x4 v0 = acc[ai][bj][m][0], v1 = acc[ai][bj][m][1];
                    v0[0] *= bflo(gd.x); v0[1] *= bfhi(gd.x); v0[2] *= bflo(gd.y); v0[3] *= bfhi(gd.y); v1[0] *= bflo(gd.z); v1[1] *= bfhi(gd.z); v1[2] *= bflo(gd.w); v1[3] *= bfhi(gd.w);
                    u32x4 w; w.x = cvt_pk_bf16(v0[0], v0[1]); w.y = cvt_pk_bf16(v0[2], v0[3]); w.z = cvt_pk_bf16(v1[0], v1[1]); w.w = cvt_pk_bf16(v1[2], v1[3]);
                    *(u32x4*)(mixed + r * 1024 + c) = w; } }
    }
};
struct EpiRes {
    static constexpr bool PERM = true, AFTER_DRAIN = false, HAS_MID = false;
    const float* x; bf16_t* x1; float* ssq;
    __device__ __forceinline__ void operator()(const f32x4 (&acc)[2][2][4][2], const Unit& u, int wr, int wc, int fr, int fq) const {
        const int row0 = u.pm * BM + wr * 64 + fr, col0 = u.pn * BM + wc * 32 + 8 * fq;
#pragma unroll
        for (int ai = 0; ai < 2; ++ai)
#pragma unroll
            for (int m = 0; m < 4; ++m) { const size_t off = (size_t)(row0 + ai * HALF + m * 16) * 1024 + col0; float s = 0.f;
#pragma unroll
                for (int bj = 0; bj < 2; ++bj) { const f32x4 v0 = *(const f32x4*)(x + off + bj * HALF) + acc[ai][bj][m][0], v1 = *(const f32x4*)(x + off + bj * HALF + 4) + acc[ai][bj][m][1]; u32x4 w;
                    s += ((v0[0] * v0[0] + v0[1] * v0[1]) + (v0[2] * v0[2] + v0[3] * v0[3])) + ((v1[0] * v1[0] + v1[1] * v1[1]) + (v1[2] * v1[2] + v1[3] * v1[3]));
                    w.x = cvt_pk_bf16(v0[0], v0[1]); w.y = cvt_pk_bf16(v0[2], v0[3]); w.z = cvt_pk_bf16(v1[0], v1[1]); w.w = cvt_pk_bf16(v1[2], v1[3]);
                    *(u32x4*)(x1 + off + bj * HALF) = w; }
                s += __shfl_xor(s, 16); s = xhalf_sum(s);
                if (fq == 0) ssq[(size_t)(row0 + ai * HALF + m * 16) * 16 + u.pn * 4 + wc] = s; }
    }
};
struct EpiLogits {
    static constexpr bool PERM = false, AFTER_DRAIN = false, HAS_MID = false;
    float* L;
    __device__ __forceinline__ void operator()(const f32x4 (&acc)[2][2][4][2], const Unit& u, int wr, int wc, int fr, int fq) const {
        const int row0 = u.pm * BM + wr * 64 + fr, col0 = wc * 32 + 4 * fq;
#pragma unroll
        for (int ai = 0; ai < 2; ++ai)
#pragma unroll
            for (int m = 0; m < 4; ++m) { float* rowp = L + (size_t)(row0 + ai * HALF + m * 16) * 128 + col0;
#pragma unroll
                for (int n = 0; n < 2; ++n) *(f32x4*)(rowp + n * 16) = acc[ai][0][m][n]; }
    }
};
struct EpiAct {
    static constexpr bool PERM = true, AFTER_DRAIN = false, HAS_MID = false;
    bf16_t* act; const float* rowrs;
    __device__ __forceinline__ void operator()(const f32x4 (&acc)[2][2][4][2], const Unit& u, int wr, int wc, int fr, int fq) const {
        const int row0 = u.pm * BM + wr * 64 + fr, col0 = (u.pn & 3) * HALF + wc * 32 + 8 * fq;
#pragma unroll
        for (int ai = 0; ai < 2; ++ai)
#pragma unroll
            for (int m = 0; m < 4; ++m) { const int r = row0 + ai * HALF + m * 16; bf16_t* rowp = act + (size_t)r * 512 + col0; float o[8]; const float rs = rowrs[r];
#pragma unroll
                for (int n = 0; n < 2; ++n)
#pragma unroll
                    for (int e = 0; e < 4; ++e) { const float g = acc[ai][0][m][n][e] * rs, up = acc[ai][1][m][n][e] * rs; o[n * 4 + e] = g * sigm(g) * up; }
                u32x4 w; w.x = cvt_pk_bf16(o[0], o[1]); w.y = cvt_pk_bf16(o[2], o[3]); w.z = cvt_pk_bf16(o[4], o[5]); w.w = cvt_pk_bf16(o[6], o[7]);
                *(u32x4*)rowp = w; }
    }
};
struct EpiDown {
    static constexpr bool PERM = true, AFTER_DRAIN = false, HAS_MID = false;
    bf16_t* y2; const float* roww;
    __device__ __forceinline__ void operator()(const f32x4 (&acc)[2][2][4][2], const Unit& u, int wr, int wc, int fr, int fq) const {
        const int row0 = u.pm * BM + wr * 64 + fr, col0 = (u.pn & 3) * BM + wc * 32 + 8 * fq;
#pragma unroll
        for (int ai = 0; ai < 2; ++ai)
#pragma unroll
            for (int m = 0; m < 4; ++m) { const int r = row0 + ai * HALF + m * 16; const float w8 = roww[r]; bf16_t* rowp = y2 + (size_t)r * 1024 + col0;
#pragma unroll
                for (int bj = 0; bj < 2; ++bj) { const f32x4 v0 = acc[ai][bj][m][0] * w8, v1 = acc[ai][bj][m][1] * w8; u32x4 w;
                    w.x = cvt_pk_bf16(v0[0], v0[1]); w.y = cvt_pk_bf16(v0[2], v0[3]); w.z = cvt_pk_bf16(v1[0], v1[1]); w.w = cvt_pk_bf16(v1[2], v1[3]);
                    *(u32x4*)(rowp + bj * HALF) = w; } }
    }
};
struct EpiFinal {
    static constexpr bool PERM = true, AFTER_DRAIN = false, HAS_MID = false;
    const bf16_t* pp; const bf16_t* x2; float* out;
    __device__ __forceinline__ void operator()(const f32x4 (&acc)[2][2][4][2], const Unit& u, int wr, int wc, int fr, int fq) const {
        const int row0 = u.pm * BM + wr * 64 + fr, col0 = u.pn * BM + wc * 32 + 8 * fq;
#pragma unroll
        for (int ai = 0; ai < 2; ++ai)
#pragma unroll
            for (int m = 0; m < 4; ++m) { const size_t r = (size_t)(row0 + ai * HALF + m * 16);
#pragma unroll
                for (int bj = 0; bj < 2; ++bj) { const int c = col0 + bj * HALF;
                    const u32x4 pw = *(const u32x4*)(pp + r * 1024 + c), xw = *(const u32x4*)(x2 + r * 1024 + c); float* op = out + r * 1024 + c;
                    const f32x4 a0 = acc[ai][bj][m][0], a1 = acc[ai][bj][m][1]; f32x4 x0, x1;
                    x0[0] = bflo(xw.x) + sigm(a0[0]) * bflo(pw.x); x0[1] = bfhi(xw.x) + sigm(a0[1]) * bfhi(pw.x); x0[2] = bflo(xw.y) + sigm(a0[2]) * bflo(pw.y); x0[3] = bfhi(xw.y) + sigm(a0[3]) * bfhi(pw.y);
                    x1[0] = bflo(xw.z) + sigm(a1[0]) * bflo(pw.z); x1[1] = bfhi(xw.z) + sigm(a1[1]) * bfhi(pw.z); x1[2] = bflo(xw.w) + sigm(a1[2]) * bflo(pw.w); x1[3] = bfhi(xw.w) + sigm(a1[3]) * bfhi(pw.w);
                    *(f32x4*)op = x0; *(f32x4*)(op + 4) = x1; asm volatile("" ::: "memory"); } }
    }
};
struct EpiGates {
    static constexpr bool PERM = true, AFTER_DRAIN = false, HAS_MID = false;
    bf16_t* gates;
    __device__ __forceinline__ void operator()(const f32x4 (&acc)[2][2][4][2], const Unit& u, int wr, int wc, int fr, int fq) const {
        const int row0 = u.pm * BM + wr * 64 + fr, col0 = u.pn * BM + wc * 32 + 8 * fq;
#pragma unroll
        for (int ai = 0; ai < 2; ++ai)
#pragma unroll
            for (int m = 0; m < 4; ++m) { bf16_t* rowp = gates + (size_t)(row0 + ai * HALF + m * 16) * 2048 + col0;
#pragma unroll
                for (int bj = 0; bj < 2; ++bj) { f32x4 v0 = acc[ai][bj][m][0], v1 = acc[ai][bj][m][1]; u32x4 w;
#pragma unroll
                    for (int e = 0; e < 4; ++e) { v0[e] = fmaxf(sigm(v0[e]), 1e-6f); v1[e] = fmaxf(sigm(v1[e]), 1e-6f); }
                    w.x = cvt_pk_bf16(v0[0], v0[1]); w.y = cvt_pk_bf16(v0[2], v0[3]); w.z = cvt_pk_bf16(v1[0], v1[1]); w.w = cvt_pk_bf16(v1[2], v1[3]);
                    *(u32x4*)(rowp + bj * HALF) = w; } }
    }
};
struct OrderItem {
    int pm, pn0, n;
    __device__ __forceinline__ bool next(int i, Unit& u) const { if (i >= n) return false; u.pm = pm; u.pn = pn0 + i; return true; }
    __device__ __forceinline__ void a_ready(const Unit&) const {}
    __device__ __forceinline__ void done(const Unit&) const {}
};
struct OrderSkipV : StaticOrder {
    __device__ __forceinline__ bool next(int i, Unit& u) const { if (!StaticOrder::next(i, u)) return false; if (u.pn >= 11) u.pn += 2; return true; }
};
struct OrderPair : StaticOrder {
    __device__ __forceinline__ bool next(int i, Unit& u) const { if (!StaticOrder::next(i >> 1, u)) return false; if (i & 1) { u.pm += 128; u.pn += 4; } return true; }
};
struct OrderMoe {
    int nwg, G, c; const PG8_LAS int* tile_e;
    __device__ __forceinline__ bool next(int i, Unit& u) const { const long L = (long)i * G + c; if (L >= nwg) return false; const int rt = (int)(L >> 2); u.pm = rt; u.pn = tile_e[rt] * 4 + (int)(L & 3); return true; }
    __device__ __forceinline__ void a_ready(const Unit&) const {}
    __device__ __forceinline__ void done(const Unit&) const {}
};
}

struct Args { const float* in[36]; float* out; unsigned char* ws; int ph_lo, ph_hi; };

template <bool KG = false> __device__ __forceinline__ void tr_item(const float* W, int N, bf16* WT, int ld, int k0, int n0, size_t dst_row0, int k_off, LAS float* scr, int lane, const float* kg = nullptr) {
#pragma unroll 8
    for (int i = 0; i < 32; ++i) { const int kk = 2 * i + (lane >> 5); float w = W[(size_t)(k0 + kk) * N + n0 + (lane & 31)]; if (KG) w *= kg[k0 + kk]; scr[kk * 33 + (lane & 31)] = w; }
    LDS_WAIT(); asm volatile("" ::: "memory");
    const int c = lane & 7;
#pragma unroll
    for (int j = 0; j < 4; ++j) { const int n = (lane >> 3) + 8 * j; const LAS float* s = scr + (8 * c) * 33 + n;
        v4u o; o.x = pk2(s[0 * 33], s[1 * 33]); o.y = pk2(s[2 * 33], s[3 * 33]); o.z = pk2(s[4 * 33], s[5 * 33]); o.w = pk2(s[6 * 33], s[7 * 33]);
        *(v4u*)(WT + (dst_row0 + n) * ld + k_off + k0 + 8 * c) = o; }
    LDS_WAIT(); asm volatile("" ::: "memory");
}
__device__ __forceinline__ void tr_matrix(const float* W, int K, int N, bf16* WT, int ld, size_t dst_row0, int k_off, LAS float* scr, int lane, int gw, int NGW) {
    const int nblk = N / 32, nitems = (K / 64) * nblk;
    for (int it = gw; it < nitems; it += NGW) { const int kb = it / nblk, nb = it % nblk; tr_item(W, N, WT, ld, 64 * kb, 32 * nb, dst_row0 + 32 * nb, k_off, scr, lane); }
}
__device__ __forceinline__ void rms_row_to_bf16(const float* xrow, const float* gain, bf16* orow, int lane) {
    const f32x4* xr = (const f32x4*)xrow + lane; f32x4 v[4]; float s = 0.f;
#pragma unroll
    for (int j = 0; j < 4; ++j) { v[j] = xr[64 * j]; s += (v[j].x * v[j].x + v[j].y * v[j].y) + (v[j].z * v[j].z + v[j].w * v[j].w); }
    const float rstd = 1.0f / sqrtf(wave_sum(s) * (1.f / 1024.f) + 1e-6f);
    v2u* o8 = (v2u*)orow + lane;
#pragma unroll
    for (int j = 0; j < 4; ++j) { const f32x4 g = ((const f32x4*)gain)[lane + 64 * j]; v2u o; o.x = pk2(v[j].x * rstd * g.x, v[j].y * rstd * g.y); o.y = pk2(v[j].z * rstd * g.z, v[j].w * rstd * g.w); o8[64 * j] = o; }
}

__device__ __forceinline__ void phase0(const Args& a, LAS unsigned char* lds, int tid, int lane, int wave, int vcu, int G) {
    unsigned char* ws = a.ws;
    LAS float* scr = (LAS float*)(lds + wave * 16384);
    const int gw = vcu * NWAVES + wave, NGW = G * NWAVES; const int gt = vcu * NTHR + tid, NGT = G * NTHR;
    tr_matrix(a.in[3], 1024, NPROJ, (bf16*)(ws + WS_WIN), 1024, 0, 0, scr, lane, gw, NGW);
    tr_matrix(a.in[6], 64, 512, (bf16*)(ws + WS_WLORA), 256, 0, 0, scr, lane, gw, NGW);
    tr_matrix(a.in[8], 64, 512, (bf16*)(ws + WS_WLORA), 256, 512, 64, scr, lane, gw, NGW);
    tr_matrix(a.in[9], 128, 512, (bf16*)(ws + WS_WLORA), 256, 1024, 128, scr, lane, gw, NGW);
    tr_matrix(a.in[22], 512, 1024, (bf16*)(ws + WS_WBRD), 1024, 0, 0, scr, lane, gw, NGW);
    tr_matrix(a.in[23], 512, 1024, (bf16*)(ws + WS_WBRD), 1024, 0, 512, scr, lane, gw, NGW);
    tr_matrix(a.in[24], 1024, 1024, (bf16*)(ws + WS_WO), 1024, 0, 0, scr, lane, gw, NGW);
    tr_matrix(a.in[34], 1024, 1024, (bf16*)(ws + WS_WPG), 1024, 0, 0, scr, lane, gw, NGW);
    tr_matrix(a.in[35], 256, 1024, (bf16*)(ws + WS_WPP), 256, 0, 0, scr, lane, gw, NGW);
    { v4u* wl = (v4u*)(ws + WS_WLORA); const v4u z = (v4u){0u, 0u, 0u, 0u};
      for (int i = gt; i < 1536 * 32; i += NGT) { const int row = i >> 5, kc = (i & 31) * 8; const int blk = row >> 9;
          const bool diag = blk == 0 ? (kc < 64) : (blk == 1 ? (kc >= 64 && kc < 128) : (kc >= 128)); if (!diag) wl[i] = z; } }
    { bf16* wr = (bf16*)(ws + WS_WR); const float* wg = a.in[26]; const float* we = a.in[28];
      for (int i = gt; i < 256 * 1024; i += NGT) { const int row = i >> 10, kk = i & 1023; unsigned short v = 0;
          if (row < 36) v = (unsigned short)f2bf((row < 32 ? we[kk * 32 + row] : wg[kk * 4 + (row - 32)]) * a.in[25][kk]);
          wr[(size_t)row * 1024 + kk] = v; } }
    for (int m = gw; m < T; m += NGW) rms_row_to_bf16(a.in[0] + (size_t)m * DM, a.in[2], (bf16*)(ws + WS_XN) + (size_t)m * DM, lane);
}

__device__ __forceinline__ void phase2(const Args& a, LAS unsigned char* lds, int tid, int vcu, int G) {
    unsigned char* ws = a.ws;
    const bf16* projb = (const bf16*)(ws + WS_PROJB); const float* mu = a.in[4];
    bf16* la = (bf16*)((unsigned char*)a.out + OUT_LA);
    LAS float* cs = (LAS float*)lds;
    for (int tile = vcu; tile < T / 64; tile += G) {
        const int t0 = tile * 64;
        __syncthreads();
#pragma unroll
        for (int i = 0; i < 4; ++i) { const int idx = tid + 512 * i, tok = idx >> 5, i32 = idx & 31; const int s = (t0 + tok) & (SEQ - 1);
            const float inv = exp2f(-(float)i32 * (13.287712379549449f / 32.0f)); const float ang = (float)s * inv;
            const float rev = ang * 0.15915494309189535f, fr = rev - floorf(rev);
            cs[(tok * 32 + i32) * 2] = __builtin_amdgcn_cosf(fr); cs[(tok * 32 + i32) * 2 + 1] = __builtin_amdgcn_sinf(fr); }
#pragma unroll
        for (int i = 0; i < 4; ++i) { const int idx = tid + 512 * i, tok = idx >> 5, ch = idx & 31, t = t0 + tok, j0 = ch * 8; const bool first = (t & (SEQ - 1)) == 0;
            const v4u cur = *(const v4u*)(projb + (size_t)t * 1280 + j0); v4u prv = (v4u){0u, 0u, 0u, 0u}; if (!first) prv = *(const v4u*)(projb + (size_t)(t - 1) * 1280 + j0);
            const f32x4 m0 = *(const f32x4*)(mu + 1536 + j0), m1 = *(const f32x4*)(mu + 1536 + j0 + 4);
            float x[8]; const unsigned cw[4] = {cur.x, cur.y, cur.z, cur.w}, pw[4] = {prv.x, prv.y, prv.z, prv.w}; const float mm[8] = {m0.x, m0.y, m0.z, m0.w, m1.x, m1.y, m1.z, m1.w};
#pragma unroll
            for (int e = 0; e < 4; ++e) { const float c0 = bflo(cw[e]), c1 = bfhi(cw[e]), p0 = bflo(pw[e]), p1 = bfhi(pw[e]); x[2 * e] = c0 + (p0 - c0) * mm[2 * e]; x[2 * e + 1] = c1 + (p1 - c1) * mm[2 * e + 1]; }
            if (ch < 8) {
#pragma unroll
                for (int e = 0; e < 8; ++e) x[e] = tanhf(x[e]);
            } else if (ch >= 16) {
#pragma unroll
                for (int e = 0; e < 8; ++e) x[e] = sigm(x[e]);
            }
            v4u o; o.x = pk2(x[0], x[1]); o.y = pk2(x[2], x[3]); o.z = pk2(x[4], x[5]); o.w = pk2(x[6], x[7]);
            *(v4u*)(la + (size_t)t * 256 + j0) = o; }
        __syncthreads();
        for (int i = 0; i < 16; ++i) { const int idx = tid + 512 * i, tok = idx >> 7, grp = (idx >> 3) & 15, l8 = idx & 7, t = t0 + tok;
            const bf16* src = projb + (size_t)t * 1280 + 256 + grp * 64 + l8 * 4;
            const v2u wl = *(const v2u*)src, wh = *(const v2u*)(src + 32);
            float xl[4] = {bflo(wl.x), bfhi(wl.x), bflo(wl.y), bfhi(wl.y)}, xh[4] = {bflo(wh.x), bfhi(wh.x), bflo(wh.y), bfhi(wh.y)};
            float ss = 0.f;
#pragma unroll
            for (int e = 0; e < 4; ++e) ss += xl[e] * xl[e] + xh[e] * xh[e];
            ss = red8(ss);
            const float rs = (1.0f / sqrtf(ss * (1.f / 64.f) + 1e-6f)) * (grp < 8 ? C2 : 1.f);
            const float* gn = (grp < 8 ? a.in[15] : a.in[16]) + l8 * 4;
            const f32x4 gl = *(const f32x4*)gn, gh = *(const f32x4*)(gn + 32);
            float ol[4], oh[4];
#pragma unroll
            for (int e = 0; e < 4; ++e) { const float yl = xl[e] * rs * gl[e], yh = xh[e] * rs * gh[e]; const int ci = (tok * 32 + l8 * 4 + e) * 2; const float c = cs[ci], sn = cs[ci + 1];
                ol[e] = yl * c - yh * sn; oh[e] = yh * c + yl * sn; }
            const int b = t >> 12, s = t & (SEQ - 1); bf16* dst = (grp < 8 ? qn_ptr(ws, b) : kn_ptr(ws, b)) + ((size_t)(grp & 7) * SEQ + s) * 64 + l8 * 4;
            *(v2u*)dst = (v2u){pk2(ol[0], ol[1]), pk2(ol[2], ol[3])}; *(v2u*)(dst + 32) = (v2u){pk2(oh[0], oh[1]), pk2(oh[2], oh[3])}; }
    }
}

constexpr int SC_NB = 32, SC_REC = 392;
constexpr int SC_BUF = SC_NB * SC_REC * 4;
constexpr int SC_YOFF = 2 * SC_BUF;
struct ScanIn { v2u r0, k0, v0, r1, k1, v1, e, av; };
__device__ __forceinline__ void scan_unit(const Args& a, LAS unsigned char* lds, int tid, int unit) {
    unsigned char* ws = a.ws;
    const int bh = unit >> 1, half = unit & 1, b = bh >> 3, hd = bh & 7;
    const bf16* rkv = (const bf16*)(ws + WS_RKV); const bf16* E = (const bf16*)(ws + WS_E); const bf16* Aa = (const bf16*)(ws + WS_A);
    float* bon = (float*)(ws + WS_BON); bf16* Y = y_ptr(a.out, b);
    const int st = tid >> 4, c4 = tid & 15, ch = hd * 64 + c4 * 4;
    const f32x4 mur = *(const f32x4*)(a.in[4] + ch), muk = *(const f32x4*)(a.in[4] + 512 + ch), muv = *(const f32x4*)(a.in[4] + 1024 + ch);
    const f32x4 kkw = *(const f32x4*)(a.in[10] + ch), kaw = *(const f32x4*)(a.in[11] + ch), rkw = *(const f32x4*)(a.in[12] + ch);
    f32x4 sA = (f32x4){0.f, 0.f, 0.f, 0.f};
    const size_t tb = (size_t)b * SEQ;
    auto load_batch = [&](int s0, ScanIn& L) {
        const size_t t = tb + s0 + st; const bool first = (s0 + st) == 0;
        L.r0 = *(const v2u*)(rkv + t * 1536 + ch); L.k0 = *(const v2u*)(rkv + t * 1536 + 512 + ch); L.v0 = *(const v2u*)(rkv + t * 1536 + 1024 + ch);
        const size_t tp = first ? t : t - 1;
        L.r1 = *(const v2u*)(rkv + tp * 1536 + ch); L.k1 = *(const v2u*)(rkv + tp * 1536 + 512 + ch); L.v1 = *(const v2u*)(rkv + tp * 1536 + 1024 + ch);
        if (first) { L.r1 = (v2u){0u, 0u}; L.k1 = L.r1; L.v1 = L.r1; }
        L.e = *(const v2u*)(E + t * 512 + ch); L.av = *(const v2u*)(Aa + t * 512 + ch);
    };
    auto convert = [&](const ScanIn& L, int buf, int s0) {
        const unsigned r0w[2] = {L.r0.x, L.r0.y}, r1w[2] = {L.r1.x, L.r1.y}, k0w[2] = {L.k0.x, L.k0.y}, k1w[2] = {L.k1.x, L.k1.y}, v0w[2] = {L.v0.x, L.v0.y}, v1w[2] = {L.v1.x, L.v1.y};
        const unsigned ew[2] = {L.e.x, L.e.y}, aw[2] = {L.av.x, L.av.y};
        float r[4], k[4], v[4], e[4], av[4], kk[4];
#pragma unroll
        for (int i = 0; i < 4; ++i) { const int w = i >> 1; const bool hi = i & 1;
            const float rc = hi ? bfhi(r0w[w]) : bflo(r0w[w]), rp = hi ? bfhi(r1w[w]) : bflo(r1w[w]);
            const float kc = hi ? bfhi(k0w[w]) : bflo(k0w[w]), kp = hi ? bfhi(k1w[w]) : bflo(k1w[w]);
            const float vc = hi ? bfhi(v0w[w]) : bflo(v0w[w]), vp = hi ? bfhi(v1w[w]) : bflo(v1w[w]);
            r[i] = rc + (rp - rc) * mur[i]; k[i] = kc + (kp - kc) * muk[i]; v[i] = vc + (vp - vc) * muv[i];
            e[i] = hi ? bfhi(ew[w]) : bflo(ew[w]); av[i] = hi ? bfhi(aw[w]) : bflo(aw[w]);
            kk[i] = k[i] * kkw[i]; }
        const float ss = red16(kk[0] * kk[0] + kk[1] * kk[1] + kk[2] * kk[2] + kk[3] * kk[3]);
        const float inv = 1.0f / fmaxf(sqrtf(ss), 1e-12f);
        f32x4 w4, aa4, bb4, km4, wr4, vv4; float br = 0.f, kr = 0.f, bo = 0.f;
#pragma unroll
        for (int i = 0; i < 4; ++i) { const float kki = kk[i] * inv; const float km = k[i] * (1.0f + (av[i] - 1.0f) * kaw[i]); const float w = __expf(-e[i]);
            w4[i] = w; aa4[i] = -kki; bb4[i] = kki * av[i]; km4[i] = km; wr4[i] = w * r[i]; vv4[i] = v[i];
            br += bb4[i] * r[i]; kr += km * r[i]; bo += r[i] * km * rkw[i]; }
        br = red16(br); kr = red16(kr); bo = red16(bo);
        LAS float* rec = (LAS float*)(lds + buf * SC_BUF) + st * SC_REC + c4 * 4;
        *(LAS f32x4*)(rec) = w4; *(LAS f32x4*)(rec + 64) = aa4; *(LAS f32x4*)(rec + 128) = bb4; *(LAS f32x4*)(rec + 192) = km4; *(LAS f32x4*)(rec + 256) = wr4; *(LAS f32x4*)(rec + 320) = vv4;
        if (c4 == 0) { rec[384] = br; rec[385] = kr; if (half == 0) bon[(tb + s0 + st) * 8 + hd] = bo; }
    };
    auto write_out = [&](int bi) {
        typedef float f32x2 __attribute__((ext_vector_type(2)));
        const LAS float* yp = (const LAS float*)(lds + SC_YOFF) + (bi & 1) * (SC_NB * 32) + st * 32 + c4 * 2;
        const f32x2 yv = *(const LAS f32x2*)yp; *(unsigned*)(Y + (size_t)(bi * SC_NB + st) * 512 + hd * 64 + 32 * half + 2 * c4) = pk2(yv[0], yv[1]); };
    constexpr int NBATCH = SEQ / SC_NB;
    ScanIn L; load_batch(0, L);
    __syncthreads();
    convert(L, 0, 0);
    load_batch(SC_NB, L);
    __syncthreads();
    for (int bi = 0; bi < NBATCH; ++bi) {
        const int cur = bi & 1;
        if (bi + 1 < NBATCH) convert(L, cur ^ 1, (bi + 1) * SC_NB);
        if (bi + 2 < NBATCH) load_batch((bi + 2) * SC_NB, L);
        if (bi > 0) write_out(bi - 1);
        LAS float* ybuf = (LAS float*)(lds + SC_YOFF) + cur * (SC_NB * 32);
        const LAS float* base = (const LAS float*)(lds + cur * SC_BUF) + c4 * 4;
        const LAS float* vbase = (const LAS float*)(lds + cur * SC_BUF) + 320 + 32 * half + st;
        const LAS float* sbase = (const LAS float*)(lds + cur * SC_BUF) + 384;
        f32x4 nw = *(const LAS f32x4*)(base), na = *(const LAS f32x4*)(base + 64), nb = *(const LAS f32x4*)(base + 128), nk = *(const LAS f32x4*)(base + 192), nq = *(const LAS f32x4*)(base + 256);
        float nvA = vbase[0]; typedef float f32x2 __attribute__((ext_vector_type(2))); f32x2 ns = *(const LAS f32x2*)(sbase);
        float ykA = 0.f;
#pragma unroll
        for (int i = 0; i < SC_NB; ++i) {
            const f32x4 w4 = nw, a4 = na, b4 = nb, k4 = nk, q4 = nq; const float vA = nvA, br = ns[0], kr = ns[1];
            if (i + 1 < SC_NB) { const LAS float* rec = base + (i + 1) * SC_REC;
                nw = *(const LAS f32x4*)(rec); na = *(const LAS f32x4*)(rec + 64); nb = *(const LAS f32x4*)(rec + 128); nk = *(const LAS f32x4*)(rec + 192); nq = *(const LAS f32x4*)(rec + 256);
                nvA = vbase[(i + 1) * SC_REC]; ns = *(const LAS f32x2*)(sbase + (i + 1) * SC_REC); }
            float saA = fmaf(sA[0], a4[0], fmaf(sA[1], a4[1], fmaf(sA[2], a4[2], sA[3] * a4[3])));
            float zA = fmaf(sA[0], q4[0], fmaf(sA[1], q4[1], fmaf(sA[2], q4[2], sA[3] * q4[3])));
            saA = red16(saA); zA = red16(zA);
            const float yA = zA + saA * br + vA * kr;
            ykA = (c4 == (i & 15)) ? yA : ykA;
            sA = sA * w4 + saA * b4 + vA * k4;
            if ((i & 15) == 15) ybuf[(i - 15 + c4) * 32 + st] = ykA;
        }
        __syncthreads();
    }
    write_out(NBATCH - 1);
}
namespace wkv {
constexpr int P = 144, PF = 272, U = 64 * P  , F = 64 * PF  ;
constexpr int O_S = 0, O_B = F;
constexpr int O_AT = O_B + 0 * U, O_BTL = O_B + 1 * U, O_KTL = O_B + 2 * U, O_RT = O_B + 3 * U, O_BHT = O_B + 4 * U, O_KHT = O_B + 5 * U, O_VRT = O_B + 6 * U, O_RHST = O_B + 7 * U  , O_MABH = O_B + 9 * U, O_MRB = O_B + 10 * U, O_MRK = O_B + 11 * U, O_Z2 = O_B + 12 * U;
constexpr int O_XT = O_AT  , O_G1 = O_MABH, O_Z1 = O_KTL, O_G2 = O_RHST  , O_EP = O_Z2  ;
constexpr int O_END = O_B + 13 * U;
constexpr int PO = 80, O_OUTB = O_END  , O_TII = O_OUTB + 8 * 16 * PO  , O_DIAG = O_TII + 4 * 16 * PO  , O_GC = O_DIAG + 4096  , O_CONST = O_GC + 256  , O_TOP = O_CONST + 1536;
static_assert(O_TOP <= 158720, "wkv LDS map");
typedef short bf16x8 __attribute__((ext_vector_type(8)));
__device__ __forceinline__ f32x4 mfma16(bf16x8 a, bf16x8 b, f32x4 c) { return __builtin_amdgcn_mfma_f32_16x16x32_bf16(a, b, c, 0, 0, 0); }
template <int K> __device__ __forceinline__ f32x4 mm_blk(LAS unsigned char* lds, int aoff, int pa, int boff, int pb, int m0, int n0, int lane, f32x4 acc) {
    const int r = lane & 15, kg = lane >> 4;
#pragma unroll
    for (int ks = 0; ks < K / 32; ++ks) { const bf16x8 a = *(const LAS bf16x8*)(lds + aoff + (m0 + r) * pa + (32 * ks + 8 * kg) * 2); const bf16x8 b = *(const LAS bf16x8*)(lds + boff + (n0 + r) * pb + (32 * ks + 8 * kg) * 2); acc = mfma16(a, b, acc); }
    return acc;
}
__device__ __forceinline__ void split8(const LAS float* p, bf16x8& hi, bf16x8& lo) {
    const f32x4 x0 = *(const LAS f32x4*)p, x1 = *(const LAS f32x4*)(p + 4); const float x[8] = {x0[0], x0[1], x0[2], x0[3], x1[0], x1[1], x1[2], x1[3]}; unsigned h[8], l[8];
#pragma unroll
    for (int i = 0; i < 8; ++i) { h[i] = f2bf(x[i]); l[i] = f2bf(x[i] - __builtin_bit_cast(float, h[i] << 16)); }
    hi = (bf16x8){(short)h[0], (short)h[1], (short)h[2], (short)h[3], (short)h[4], (short)h[5], (short)h[6], (short)h[7]}; lo = (bf16x8){(short)l[0], (short)l[1], (short)l[2], (short)l[3], (short)l[4], (short)l[5], (short)l[6], (short)l[7]};
}
__device__ __forceinline__ void st_bf(LAS unsigned char* lds, int off, float v) { *(LAS unsigned short*)(lds + off) = (unsigned short)f2bf(v); }
__device__ __forceinline__ float ld_bf(const LAS unsigned char* lds, int off) { return __builtin_bit_cast(float, (unsigned)*(const LAS unsigned short*)(lds + off) << 16); }
struct Raw { v4u r0, k0, v0, r1, k1, v1, e, av; };
}
__device__ __forceinline__ void st4_bf(LAS unsigned char* lds, int off, f32x4 v) { *(LAS v2u*)(lds + off) = (v2u){pk2(v[0], v[1]), pk2(v[2], v[3])}; }
__device__ __forceinline__ f32x4 ld4_bf(const LAS unsigned char* lds, int off) { const v2u w = *(const LAS v2u*)(lds + off); return (f32x4){bflo(w.x), bfhi(w.x), bflo(w.y), bfhi(w.y)}; }
__device__ __forceinline__ wkv::bf16x8 ident_frag(int n, int ks, int kg) { wkv::bf16x8 f; const int k0 = 32 * ks + 8 * kg;
#pragma unroll
    for (int j = 0; j < 8; ++j) f[j] = (k0 + j == n) ? (short)0x3F80 : (short)0; return f; }
__device__ __forceinline__ void scan_unit_chunked(const Args& a, LAS unsigned char* lds, int tid, int bh) {
    using namespace wkv;
    unsigned char* ws = a.ws;
    const int b = bh >> 3, hd = bh & 7, wave = __builtin_amdgcn_readfirstlane(tid >> 6);
    const bf16* rkv = (const bf16*)(ws + WS_RKV); const bf16* E = (const bf16*)(ws + WS_E); const bf16* Aa = (const bf16*)(ws + WS_A);
    float* bon = (float*)(ws + WS_BON); bf16* Y = y_ptr(a.out, b);
    const size_t tb = (size_t)b * SEQ;
    int oz = 0;
#define WKV_TAINT() asm volatile("" : "+v"(oz))
    const int gch = hd * 64 + (tid & 7) * 8;
    if (tid < 384) { const int vsel = tid >> 6, cc = tid & 63; const float* src = vsel == 0 ? a.in[4] : vsel == 1 ? a.in[4] + 512 : vsel == 2 ? a.in[4] + 1024 : vsel == 3 ? a.in[10] : vsel == 4 ? a.in[11] : a.in[12];
        ((LAS float*)(lds + O_CONST))[vsel * 64 + cc] = src[hd * 64 + cc]; }
    auto load_raw = [&](int c, Raw& L) { const int tt = tid >> 3; const size_t t = tb + c * 64 + tt; const bool first = (c * 64 + tt) == 0; const size_t tp = first ? t : t - 1;
        L.r0 = *(const v4u*)(rkv + t * 1536 + gch); L.k0 = *(const v4u*)(rkv + t * 1536 + 512 + gch); L.v0 = *(const v4u*)(rkv + t * 1536 + 1024 + gch);
        L.r1 = *(const v4u*)(rkv + tp * 1536 + gch); L.k1 = *(const v4u*)(rkv + tp * 1536 + 512 + gch); L.v1 = *(const v4u*)(rkv + tp * 1536 + 1024 + gch);
        if (first) { L.r1 = (v4u){0u, 0u, 0u, 0u}; L.k1 = L.r1; L.v1 = L.r1; }
        L.e = *(const v4u*)(E + t * 512 + gch); L.av = *(const v4u*)(Aa + t * 512 + gch); };
    const int mb = wave >> 1, nb0 = (wave & 1) * 2;
    WKV_TAINT();
#pragma unroll 1
    for (int i = tid + oz; i < 64 * 64; i += NTHR) *(LAS float*)(lds + O_S + (i >> 6) * PF + (i & 63) * 4) = 0.f;
#if defined(PROBE_PHASE) && PROBE_PHASE >= 300 && PROBE_PHASE < 310
    unsigned long long tlast = __builtin_amdgcn_s_memrealtime(); unsigned tacc[6] = {0u, 0u, 0u, 0u, 0u, 0u};
#define WKV_STAMP(k) do { const unsigned long long tn = __builtin_amdgcn_s_memrealtime(); tacc[k] += (unsigned)(tn - tlast); tlast = tn; } while (0)
#else
#define WKV_STAMP(k) do { } while (0)
#endif
    Raw L; load_raw(0, L);
    for (int c = 0; c < SEQ / 64; ++c) {
        __syncthreads();
        WKV_TAINT(); const int td0 = tid + oz, tt = td0 >> 3, kq = td0 & 7, ch0 = kq * 8;
        float e8[8], lr8[8], r8[8], k8[8], v8[8];
        { const unsigned ew[4] = {L.e.x, L.e.y, L.e.z, L.e.w}, aw[4] = {L.av.x, L.av.y, L.av.z, L.av.w};
          const unsigned r0[4] = {L.r0.x, L.r0.y, L.r0.z, L.r0.w}, r1[4] = {L.r1.x, L.r1.y, L.r1.z, L.r1.w}, k0[4] = {L.k0.x, L.k0.y, L.k0.z, L.k0.w}, k1[4] = {L.k1.x, L.k1.y, L.k1.z, L.k1.w}, v0[4] = {L.v0.x, L.v0.y, L.v0.z, L.v0.w}, v1[4] = {L.v1.x, L.v1.y, L.v1.z, L.v1.w};
#pragma unroll
          for (int i = 0; i < 8; ++i) { const int w = i >> 1; const bool hi = i & 1;
              e8[i] = hi ? bfhi(ew[w]) : bflo(ew[w]); lr8[i] = hi ? bfhi(aw[w]) : bflo(aw[w]);
              const float rc = hi ? bfhi(r0[w]) : bflo(r0[w]), rp = hi ? bfhi(r1[w]) : bflo(r1[w]), kc = hi ? bfhi(k0[w]) : bflo(k0[w]), kp = hi ? bfhi(k1[w]) : bflo(k1[w]), vc = hi ? bfhi(v0[w]) : bflo(v0[w]), vp = hi ? bfhi(v1[w]) : bflo(v1[w]);
              const LAS float* cst = (const LAS float*)(lds + O_CONST) + ch0 + i;
              r8[i] = rc + (rp - rc) * cst[0]; k8[i] = kc + (kp - kc) * cst[64]; v8[i] = vc + (vp - vc) * cst[128]; } }
        if (c + 1 < SEQ / 64) load_raw(c + 1, L);
        { LAS float* ep = (LAS float*)(lds + O_EP) + tt * 68 + ch0; *(LAS f32x4*)ep = (f32x4){e8[0], e8[1], e8[2], e8[3]}; *(LAS f32x4*)(ep + 4) = (f32x4){e8[4], e8[5], e8[6], e8[7]}; }
        __syncthreads();
        { const int k = td0 & 63, seg = td0 >> 6; LAS float* col = (LAS float*)(lds + O_EP) + (seg * 8) * 68 + k; float pre[8], run = 0.f;
#pragma unroll
          for (int i = 0; i < 8; ++i) { run += col[i * 68]; pre[i] = run; }
          LAS float* tots = (LAS float*)(lds + O_EP) + 64 * 68;
          tots[seg * 64 + k] = run;
          __syncthreads();
          float base = 0.f;
#pragma unroll
          for (int s2 = 0; s2 < 7; ++s2) base += (s2 < seg) ? tots[s2 * 64 + k] : 0.f;
#pragma unroll
          for (int i = 0; i < 8; ++i) col[i * 68] = pre[i] + base; }
        __syncthreads();
        float ce[8], cep[8], cec[8];
        { const LAS float* epb = (const LAS float*)(lds + O_EP);
          const f32x4 c0 = *(const LAS f32x4*)(epb + tt * 68 + ch0), c1 = *(const LAS f32x4*)(epb + tt * 68 + ch0 + 4);
          const int tq = tt > 0 ? tt - 1 : 0; f32x4 p0 = *(const LAS f32x4*)(epb + tq * 68 + ch0), p1 = *(const LAS f32x4*)(epb + tq * 68 + ch0 + 4); if (tt == 0) { p0 = (f32x4){0.f, 0.f, 0.f, 0.f}; p1 = p0; }
          const f32x4 q0 = *(const LAS f32x4*)(epb + 63 * 68 + ch0), q1 = *(const LAS f32x4*)(epb + 63 * 68 + ch0 + 4);
#pragma unroll
          for (int i = 0; i < 4; ++i) { ce[i] = c0[i]; ce[4 + i] = c1[i]; cep[i] = p0[i]; cep[4 + i] = p1[i]; cec[i] = q0[i]; cec[4 + i] = q1[i]; } }
        { float kk[8], ss = 0.f;
#pragma unroll
          for (int i = 0; i < 8; ++i) { kk[i] = k8[i] * ((const LAS float*)(lds + O_CONST))[192 + ch0 + i]; ss += kk[i] * kk[i]; }
          ss = red8(ss); const float inv = 1.0f / fmaxf(sqrtf(ss), 1e-12f);
          float at[8], bt[8], kt[8], rt[8], bh8[8], kh8[8], bo = 0.f;
#pragma unroll
          for (int i = 0; i < 8; ++i) { const float kaw_i = ((const LAS float*)(lds + O_CONST))[256 + ch0 + i], rkw_i = ((const LAS float*)(lds + O_CONST))[320 + ch0 + i];
              const float kki = kk[i] * inv, km = k8[i] * (1.0f + (lr8[i] - 1.0f) * kaw_i), bbv = kki * lr8[i];
              const float gp = __expf(-cep[i]), gi = __expf(ce[i]), gt = __expf(-ce[i]), gcj = __expf(ce[i] - cec[i]);
              at[i] = -kki * gp; bt[i] = bbv * gi; kt[i] = km * gi; rt[i] = r8[i] * gt; bh8[i] = bbv * gcj; kh8[i] = km * gcj; bo += r8[i] * km * rkw_i; }
          bo = red8(bo);
          if (kq == 0) bon[(tb + c * 64 + tt) * 8 + hd] = bo;
          if (tt == 63) { LAS float* gc = (LAS float*)(lds + O_GC) + ch0;
#pragma unroll
              for (int i = 0; i < 8; ++i) gc[i] = __expf(-cec[i]); }
          const int ro = tt * P + ch0 * 2;
          *(LAS v4u*)(lds + O_AT + ro) = (v4u){pk2(at[0], at[1]), pk2(at[2], at[3]), pk2(at[4], at[5]), pk2(at[6], at[7])};
          *(LAS v4u*)(lds + O_BTL + ro) = (v4u){pk2(bt[0], bt[1]), pk2(bt[2], bt[3]), pk2(bt[4], bt[5]), pk2(bt[6], bt[7])};
          *(LAS v4u*)(lds + O_KTL + ro) = (v4u){pk2(kt[0], kt[1]), pk2(kt[2], kt[3]), pk2(kt[4], kt[5]), pk2(kt[6], kt[7])};
          *(LAS v4u*)(lds + O_RT + ro) = (v4u){pk2(rt[0], rt[1]), pk2(rt[2], rt[3]), pk2(rt[4], rt[5]), pk2(rt[6], rt[7])};
          *(LAS v4u*)(lds + O_MABH + ro) = (v4u){pk2(bh8[0], bh8[1]), pk2(bh8[2], bh8[3]), pk2(bh8[4], bh8[5]), pk2(bh8[6], bh8[7])};
          *(LAS v4u*)(lds + O_MRB + ro) = (v4u){pk2(kh8[0], kh8[1]), pk2(kh8[2], kh8[3]), pk2(kh8[4], kh8[5]), pk2(kh8[6], kh8[7])};
          *(LAS v4u*)(lds + O_MRK + ro) = (v4u){pk2(v8[0], v8[1]), pk2(v8[2], v8[3]), pk2(v8[4], v8[5]), pk2(v8[6], v8[7])}; }
        __syncthreads();
        { WKV_TAINT(); const int lane = (tid & 63) + oz, c16 = lane & 15, rg = lane >> 4;
#pragma unroll
          for (int j = 0; j < 2; ++j) { const int nb = nb0 + j; f32x4 d0 = (f32x4){0.f, 0.f, 0.f, 0.f}, d1 = d0, d2 = d0, d3 = d0;
#pragma unroll
              for (int ks = 0; ks < 2; ++ks) { const bf16x8 idf = ident_frag(16 * nb + c16, ks, rg); const int ao = (16 * mb + c16) * P + (32 * ks + 8 * rg) * 2;
                  d0 = mfma16(*(const LAS bf16x8*)(lds + O_AT + ao), idf, d0); d1 = mfma16(*(const LAS bf16x8*)(lds + O_MABH + ao), idf, d1);
                  d2 = mfma16(*(const LAS bf16x8*)(lds + O_MRB + ao), idf, d2); d3 = mfma16(*(const LAS bf16x8*)(lds + O_MRK + ao), idf, d3); }
              const int to = (16 * nb + c16) * P + (16 * mb + 4 * rg) * 2;
              st4_bf(lds, O_RHST + to, d0); st4_bf(lds, O_BHT + to, d1); st4_bf(lds, O_KHT + to, d2); st4_bf(lds, O_VRT + to, d3); } }
        __syncthreads(); WKV_STAMP(0);
        { WKV_TAINT(); const int lane = (tid & 63) + oz, c16 = lane & 15, rg = lane >> 4; f32x4 acc[4][2];
#pragma unroll
          for (int j = 0; j < 2; ++j) { const int nb = nb0 + j; const f32x4 z = (f32x4){0.f, 0.f, 0.f, 0.f};
              acc[0][j] = mm_blk<64>(lds, O_BTL, P, O_AT, P, 16 * mb, 16 * nb, lane, z);
              acc[1][j] = mm_blk<64>(lds, O_AT, P, O_KTL, P, 16 * mb, 16 * nb, lane, z);
              acc[2][j] = mm_blk<64>(lds, O_BTL, P, O_RT, P, 16 * mb, 16 * nb, lane, z);
              acc[3][j] = mm_blk<64>(lds, O_KTL, P, O_RT, P, 16 * mb, 16 * nb, lane, z); }
#pragma unroll
          for (int j = 0; j < 2; ++j) { const int nb = nb0 + j, n = 16 * nb + c16, m0 = 16 * mb + 4 * rg; f32x4 mab, mak, mrb, mrk;
#pragma unroll
              for (int e = 0; e < 4; ++e) { const int m = m0 + e; mab[e] = m < n ? acc[0][j][e] : 0.f; mak[e] = n < m ? acc[1][j][e] : 0.f; mrb[e] = m <= n ? acc[2][j][e] : 0.f; mrk[e] = m <= n ? acc[3][j][e] : 0.f; }
              st4_bf(lds, O_MABH + n * P + m0 * 2, mab);
              if (mb == nb) *(LAS f32x4*)(lds + O_DIAG + ((mb * 16 + c16) * 16 + 4 * rg) * 4) = mab;
              st4_bf(lds, O_RHST + U + n * P + m0 * 2, mak);
              st4_bf(lds, O_MRB + n * P + m0 * 2, mrb); st4_bf(lds, O_MRK + n * P + m0 * 2, mrk); } }
        __syncthreads(); WKV_STAMP(1);
        WKV_TAINT();
        if (tid < 64) { const int td2 = tid + oz, blk = td2 >> 4, cc = td2 & 15; const LAS float* D = (const LAS float*)(lds + O_DIAG) + blk * 256; float Tc[16];
#pragma unroll
            for (int r4 = 0; r4 < 4; ++r4) { f32x4 dr[4][4];
#pragma unroll
                for (int rr = 0; rr < 4; ++rr)
#pragma unroll
                    for (int q = 0; q <= r4; ++q) dr[rr][q] = *(const LAS f32x4*)(D + (4 * r4 + rr) * 16 + 4 * q);
#pragma unroll
                for (int rr = 0; rr < 4; ++rr) { const int r = 4 * r4 + rr; float sacc = (r == cc) ? 1.f : 0.f;
#pragma unroll
                    for (int j = 0; j < r; ++j) sacc += dr[rr][j >> 2][j & 3] * Tc[j];
                    Tc[r] = sacc; } }
#pragma unroll
            for (int r4 = 0; r4 < 4; ++r4) { const f32x4 tv = (f32x4){Tc[4 * r4], Tc[4 * r4 + 1], Tc[4 * r4 + 2], Tc[4 * r4 + 3]};
                (void)tv; }
#pragma unroll
            for (int r = 0; r < 16; ++r) { st_bf(lds, O_TII + (blk * 16 + r) * PO + cc * 2, Tc[r]); st_bf(lds, O_TII + (blk * 16 + r) * PO + (16 + cc) * 2, 0.f); } }
        { const int lane = (tid & 63) + oz; const v4u z = (v4u){0u, 0u, 0u, 0u};
#pragma unroll
          for (int i = 0; i < 3; ++i) { const int idx = lane + 64 * i; if (idx < 16 * 9) *(LAS v4u*)(lds + O_XT + (16 * wave + idx / 9) * P + (idx % 9) * 16) = z; }
          if (lane < 32) *(LAS v4u*)(lds + O_OUTB + wave * 16 * PO + (lane >> 1) * PO + 32 + (lane & 1) * 16) = z; }
        __syncthreads(); WKV_STAMP(2);
#pragma unroll 1
        for (int i = 0; i < 4; ++i) { WKV_TAINT(); const int lane = (tid & 63) + oz, c16 = lane & 15, rg = lane >> 4;
            f32x4 acc = (f32x4){0.f, 0.f, 0.f, 0.f};
            if (i > 0) acc = mm_blk<64>(lds, O_MABH, P, O_XT, P, 16 * i, 16 * wave, lane, acc);
            acc += ld4_bf(lds, O_RHST + (16 * wave + c16) * P + (16 * i + 4 * rg) * 2);
            st4_bf(lds, O_OUTB + wave * 16 * PO + c16 * PO + (4 * rg) * 2, acc);
            LDS_WAIT();
            f32x4 x = mm_blk<32>(lds, O_TII + i * 16 * PO, PO, O_OUTB + wave * 16 * PO, PO, 0, 0, lane, (f32x4){0.f, 0.f, 0.f, 0.f});
            st4_bf(lds, O_XT + (16 * wave + c16) * P + (16 * i + 4 * rg) * 2, x);
            LDS_WAIT();
        }
        __syncthreads(); WKV_STAMP(3);
        { WKV_TAINT(); const int lane = (tid & 63) + oz, c16 = lane & 15, rg = lane >> 4; f32x4 acc[4][2];
#pragma unroll
          for (int j = 0; j < 2; ++j) { const int nb = nb0 + j; const f32x4 z = (f32x4){0.f, 0.f, 0.f, 0.f};
              acc[0][j] = mm_blk<64>(lds, O_XT, P, O_MRB, P, 16 * mb, 16 * nb, lane, z);
              acc[1][j] = mm_blk<64>(lds, O_XT + U, P, O_MRB, P, 16 * mb, 16 * nb, lane, z);
              acc[2][j] = mm_blk<64>(lds, O_XT, P, O_BHT, P, 16 * mb, 16 * nb, lane, z);
              acc[3][j] = mm_blk<64>(lds, O_XT + U, P, O_BHT, P, 16 * mb, 16 * nb, lane, z); }
#pragma unroll
          for (int j = 0; j < 2; ++j) { const int n = 16 * (nb0 + j) + c16, m0 = 16 * mb + 4 * rg; const int o = n * P + m0 * 2;
              acc[0][j] += ld4_bf(lds, O_RT + o); acc[1][j] += ld4_bf(lds, O_MRK + o); acc[3][j] += ld4_bf(lds, O_KHT + o);
              if (n >= m0 && n < m0 + 4) acc[2][j][n - m0] += *(const LAS float*)(lds + O_GC + n * 4); }
          __syncthreads();
#pragma unroll
          for (int j = 0; j < 2; ++j) { const int n = 16 * (nb0 + j) + c16, m0 = 16 * mb + 4 * rg; const int o = n * P + m0 * 2;
              st4_bf(lds, O_G1 + o, acc[0][j]); st4_bf(lds, O_Z1 + o, acc[1][j]); st4_bf(lds, O_Z2 + o, acc[3][j]);
              f32x4 hi4, lo4;
#pragma unroll
              for (int e = 0; e < 4; ++e) { hi4[e] = __builtin_bit_cast(float, f2bf(acc[2][j][e]) << 16); lo4[e] = acc[2][j][e] - hi4[e]; }
              st4_bf(lds, O_RT + o, hi4); st4_bf(lds, O_KHT + o, lo4); } }
        { WKV_TAINT(); const int td5 = tid + oz, v = td5 >> 3, kq5 = (td5 & 7) * 8; const LAS float* sp = (const LAS float*)(lds + O_S + v * PF) + kq5;
          const f32x4 x0 = *(const LAS f32x4*)sp, x1 = *(const LAS f32x4*)(sp + 4); f32x4 h0, h1, l0, l1;
#pragma unroll
          for (int e = 0; e < 4; ++e) { h0[e] = __builtin_bit_cast(float, f2bf(x0[e]) << 16); l0[e] = x0[e] - h0[e]; h1[e] = __builtin_bit_cast(float, f2bf(x1[e]) << 16); l1[e] = x1[e] - h1[e]; }
          st4_bf(lds, O_MRB + v * P + kq5 * 2, h0); st4_bf(lds, O_MRB + v * P + kq5 * 2 + 8, h1); st4_bf(lds, O_MRK + v * P + kq5 * 2, l0); st4_bf(lds, O_MRK + v * P + kq5 * 2 + 8, l1); }
        __syncthreads(); WKV_STAMP(4);
        { WKV_TAINT(); const int lane = (tid & 63) + oz, c16 = lane & 15, rg = lane >> 4; f32x4 ay[2], as[2];
#pragma unroll
          for (int j = 0; j < 2; ++j) { const int nb = nb0 + j; const f32x4 z = (f32x4){0.f, 0.f, 0.f, 0.f};
              ay[j] = mm_blk<64>(lds, O_VRT, P, O_Z1, P, 16 * mb, 16 * nb, lane, z);
              ay[j] = mm_blk<64>(lds, O_MRB, P, O_G1, P, 16 * mb, 16 * nb, lane, ay[j]);
              ay[j] = mm_blk<64>(lds, O_MRK, P, O_G1, P, 16 * mb, 16 * nb, lane, ay[j]);
              as[j] = mm_blk<64>(lds, O_Z2, P, O_VRT, P, 16 * mb, 16 * nb, lane, z);
              as[j] = mm_blk<64>(lds, O_RT, P, O_MRB, P, 16 * mb, 16 * nb, lane, as[j]);
              as[j] = mm_blk<64>(lds, O_KHT, P, O_MRB, P, 16 * mb, 16 * nb, lane, as[j]);
              as[j] = mm_blk<64>(lds, O_RT, P, O_MRK, P, 16 * mb, 16 * nb, lane, as[j]); }
#pragma unroll
          for (int j = 0; j < 2; ++j) { const int t = 16 * (nb0 + j) + c16, v0 = 16 * mb + 4 * rg;
              *(v2u*)(Y + (size_t)(c * 64 + t) * 512 + hd * 64 + v0) = (v2u){pk2(ay[j][0], ay[j][1]), pk2(ay[j][2], ay[j][3])};
              *(LAS f32x4*)(lds + O_S + t * PF + v0 * 4) = as[j]; } }
        WKV_STAMP(5);
    }
#if defined(PROBE_PHASE) && PROBE_PHASE >= 300 && PROBE_PHASE < 310
    if (tid == 0) atomicAdd((unsigned*)(ws + WS_CTL) + 96, tacc[PROBE_PHASE - 300]);
#endif
}
__device__ __forceinline__ void phase_orw(const Args& a, int lane, int wave, int vcu, int G) {
    unsigned char* ws = a.ws;
    const int gw = vcu * NWAVES + wave, NGW = G * NWAVES;
    const bf16* rkv = (const bf16*)(ws + WS_RKV); const bf16* Gg = (const bf16*)(ws + WS_G); const float* bon = (const float*)(ws + WS_BON);
    bf16* orw = (bf16*)((unsigned char*)a.out + OUT_ORWDF);
    const int ch = lane * 8;
    const f32x4 mv0 = *(const f32x4*)(a.in[4] + 1024 + ch), mv1 = *(const f32x4*)(a.in[4] + 1024 + ch + 4);
    const f32x4 lw0 = *(const f32x4*)(a.in[13] + ch), lw1 = *(const f32x4*)(a.in[13] + ch + 4), lb0 = *(const f32x4*)(a.in[14] + ch), lb1 = *(const f32x4*)(a.in[14] + ch + 4);
    const float muv[8] = {mv0[0], mv0[1], mv0[2], mv0[3], mv1[0], mv1[1], mv1[2], mv1[3]}, lnw[8] = {lw0[0], lw0[1], lw0[2], lw0[3], lw1[0], lw1[1], lw1[2], lw1[3]}, lnb[8] = {lb0[0], lb0[1], lb0[2], lb0[3], lb1[0], lb1[1], lb1[2], lb1[3]};
    for (int t = gw; t < T; t += NGW) {
        const int b = t >> 12, s = t & (SEQ - 1); const v4u yw = *(const v4u*)(y_ptr(a.out, b) + (size_t)s * 512 + ch);
        const f32x4 y0 = (f32x4){bflo(yw.x), bfhi(yw.x), bflo(yw.y), bfhi(yw.y)}, y1 = (f32x4){bflo(yw.z), bfhi(yw.z), bflo(yw.w), bfhi(yw.w)};
        const v4u vc = *(const v4u*)(rkv + (size_t)t * 1536 + 1024 + ch); v4u vp = (v4u){0u, 0u, 0u, 0u}; if (s != 0) vp = *(const v4u*)(rkv + (size_t)(t - 1) * 1536 + 1024 + ch);
        const v4u gw4 = *(const v4u*)(Gg + (size_t)t * 512 + ch); const float bo = bon[(size_t)t * 8 + (lane >> 3)];
        float y[8] = {y0[0], y0[1], y0[2], y0[3], y1[0], y1[1], y1[2], y1[3]};
        float sm = 0.f;
#pragma unroll
        for (int e = 0; e < 8; ++e) sm += y[e];
        const float mean = red8(sm) * (1.f / 64.f); float vs = 0.f;
#pragma unroll
        for (int e = 0; e < 8; ++e) { y[e] -= mean; vs += y[e] * y[e]; }
        const float rstd = 1.0f / sqrtf(red8(vs) * (1.f / 64.f) + 64e-5f);
        const unsigned vcw[4] = {vc.x, vc.y, vc.z, vc.w}, vpw[4] = {vp.x, vp.y, vp.z, vp.w}, gww[4] = {gw4.x, gw4.y, gw4.z, gw4.w}; float o[8];
#pragma unroll
        for (int e = 0; e < 8; ++e) { const int w = e >> 1; const bool hi = e & 1; const float c = hi ? bfhi(vcw[w]) : bflo(vcw[w]), p = hi ? bfhi(vpw[w]) : bflo(vpw[w]), g = hi ? bfhi(gww[w]) : bflo(gww[w]);
            const float v = c + (p - c) * muv[e]; o[e] = ((y[e] * rstd * lnw[e] + lnb[e]) + bo * v) * g; }
        v4u ov; ov.x = pk2(o[0], o[1]); ov.y = pk2(o[2], o[3]); ov.z = pk2(o[4], o[5]); ov.w = pk2(o[6], o[7]);
        *(v4u*)(orw + (size_t)t * 1024 + ch) = ov;
    }
}

__device__ __forceinline__ int crow(int r, int hi) { return (r & 3) + 8 * (r >> 2) + 4 * hi; }
constexpr int AT_BUF = 24576;
__device__ __forceinline__ int at_addr(int row, int ch) { return row * 128 + ((ch ^ ((row >> 1) & 7)) << 4); }
__device__ __forceinline__ void attn_pass(const bf16* qn, const bf16* kn, const bf16* vt, int b, int head, int c, int qb, LAS unsigned char* lds, int tid, f32x16 (&o)[4]) {
    const int lane = tid & 63, wave = __builtin_amdgcn_readfirstlane(tid >> 6), r32 = lane & 31, hi = lane >> 5;
    const int vh = b * 8 + head * 2 + c; const int q0 = qb * 256, qw0 = q0 + wave * 32, qrow = qw0 + r32;
    const bf16* Qp = qn + ((size_t)(vh & 7) * SEQ + qrow) * 64;
    s16x8 qf[4];
#pragma unroll
    for (int ks = 0; ks < 4; ++ks) qf[ks] = *(const s16x8*)(Qp + 16 * ks + 8 * hi);
    const int k_row = tid >> 3, k_ch = tid & 7;
    const bf16* ksrc = kn + (size_t)(vh & 7) * SEQ * 64 + k_row * 64 + k_ch * 8; const int kdst = at_addr(k_row, k_ch);
    const int dv0 = tid >> 3, dv1 = 64 + (tid >> 3);
    const bf16* vsrc0 = vt + (size_t)(head * 128 + dv0) * T + (size_t)b * SEQ + k_ch * 8; const bf16* vsrc1 = vsrc0 + (size_t)64 * T;
    const int vdst0 = 8192 + at_addr(dv0, k_ch), vdst1 = 8192 + at_addr(dv1, k_ch); const bool vsw0 = (dv0 & 16) != 0, vsw1 = (dv1 & 16) != 0;
    const int NT = 4 * qb + 4;
    v4u kreg = *(const v4u*)ksrc, vreg0 = *(const v4u*)vsrc0, vreg1 = *(const v4u*)vsrc1;
    __syncthreads();
    *(LAS v4u*)(lds + kdst) = kreg; *(LAS v4u*)(lds + vdst0) = vsw0 ? (v4u){vreg0.z, vreg0.w, vreg0.x, vreg0.y} : vreg0; *(LAS v4u*)(lds + vdst1) = vsw1 ? (v4u){vreg1.z, vreg1.w, vreg1.x, vreg1.y} : vreg1;
    __syncthreads();
    float m = -1e30f, l = 0.f;
#pragma unroll
    for (int db = 0; db < 4; ++db)
#pragma unroll
        for (int i = 0; i < 16; ++i) o[db][i] = 0.f;
    for (int j = 0; j < NT; ++j) {
        const int cur = (j & 1) * AT_BUF, nxt = AT_BUF - cur; const bool more = j + 1 < NT;
        if (more) { kreg = *(const v4u*)(ksrc + (size_t)(j + 1) * 64 * 64); vreg0 = *(const v4u*)(vsrc0 + (j + 1) * 64); vreg1 = *(const v4u*)(vsrc1 + (j + 1) * 64); }
        const int kv0 = j * 64;
        if (kv0 <= qw0 + 31) {
            f32x16 s0, s1;
#pragma unroll
            for (int i = 0; i < 16; ++i) { s0[i] = 0.f; s1[i] = 0.f; }
            __builtin_amdgcn_s_setprio(1);
#pragma unroll
            for (int ks = 0; ks < 4; ++ks) {
                const s16x8 a0 = *(const LAS s16x8*)(lds + cur + at_addr(r32, 2 * ks + hi));
                const s16x8 a1 = *(const LAS s16x8*)(lds + cur + at_addr(32 + r32, 2 * ks + hi));
                s0 = __builtin_amdgcn_mfma_f32_32x32x16_bf16(a0, qf[ks], s0, 0, 0, 0);
                s1 = __builtin_amdgcn_mfma_f32_32x32x16_bf16(a1, qf[ks], s1, 0, 0, 0);
            }
            __builtin_amdgcn_s_setprio(0);
            if (kv0 + 63 > qw0) {
#pragma unroll
                for (int i = 0; i < 16; ++i) { const int kv = kv0 + crow(i, hi); if (kv > qrow) s0[i] = -1e30f; if (kv + 32 > qrow) s1[i] = -1e30f; }
            }
            float rm = fmaxf(s0[0], s1[0]);
#pragma unroll
            for (int i = 1; i < 16; ++i) rm = fmaxf(rm, fmaxf(s0[i], s1[i]));
            rm = xhalf_max(rm);
            const float mn = fmaxf(m, rm); const float f = __builtin_amdgcn_exp2f(m - mn); m = mn;
            float ps = 0.f;
#pragma unroll
            for (int i = 0; i < 16; ++i) { s0[i] = __builtin_amdgcn_exp2f(s0[i] - mn); s1[i] = __builtin_amdgcn_exp2f(s1[i] - mn); ps += s0[i] + s1[i]; }
            l = l * f + ps;
            if (__any(f != 1.0f)) {
#pragma unroll
                for (int db = 0; db < 4; ++db)
#pragma unroll
                    for (int i = 0; i < 16; ++i) o[db][i] *= f;
            }
            v4u pw[4];
            pw[0] = (v4u){pk2(s0[0], s0[1]), pk2(s0[2], s0[3]), pk2(s0[4], s0[5]), pk2(s0[6], s0[7])};
            pw[1] = (v4u){pk2(s0[8], s0[9]), pk2(s0[10], s0[11]), pk2(s0[12], s0[13]), pk2(s0[14], s0[15])};
            pw[2] = (v4u){pk2(s1[0], s1[1]), pk2(s1[2], s1[3]), pk2(s1[4], s1[5]), pk2(s1[6], s1[7])};
            pw[3] = (v4u){pk2(s1[8], s1[9]), pk2(s1[10], s1[11]), pk2(s1[12], s1[13]), pk2(s1[14], s1[15])};
#pragma unroll
            for (int db = 0; db < 4; ++db) { const int dv = 32 * db + r32; const int vb = cur + 8192 + dv * 128 + 8 * (hi ^ ((dv >> 4) & 1)), sw = (dv >> 1) & 7;
#pragma unroll
                for (int s4 = 0; s4 < 4; ++s4) {
                    const s16x4 lo = *(const LAS s16x4*)(lds + vb + (((2 * s4) ^ sw) << 4));
                    const s16x4 hh = *(const LAS s16x4*)(lds + vb + (((2 * s4 + 1) ^ sw) << 4));
                    const s16x8 av = (s16x8){lo[0], lo[1], lo[2], lo[3], hh[0], hh[1], hh[2], hh[3]};
                    o[db] = __builtin_amdgcn_mfma_f32_32x32x16_bf16(av, __builtin_bit_cast(s16x8, pw[s4]), o[db], 0, 0, 0);
                }
                __builtin_amdgcn_sched_barrier(0); }
        }
        if (more) { *(LAS v4u*)(lds + nxt + kdst) = kreg; *(LAS v4u*)(lds + nxt + vdst0) = vsw0 ? (v4u){vreg0.z, vreg0.w, vreg0.x, vreg0.y} : vreg0; *(LAS v4u*)(lds + nxt + vdst1) = vsw1 ? (v4u){vreg1.z, vreg1.w, vreg1.x, vreg1.y} : vreg1; }
        __syncthreads();
    }
    l = xhalf_sum(l);
    const float il = 1.0f / l;
#pragma unroll
    for (int db = 0; db < 4; ++db)
#pragma unroll
        for (int i = 0; i < 16; ++i) o[db][i] *= il;
}
__device__ __forceinline__ void attn_unit(const Args& a, LAS unsigned char* lds, int tid, int b, int head, int qb, float* stash  ) {
    unsigned char* ws = a.ws;
    const bf16* qn = qn_ptr(ws, b); const bf16* kn = kn_ptr(ws, b); const bf16* vt = (const bf16*)(ws + WS_VT);
    bf16* odf = (bf16*)((unsigned char*)a.out + OUT_ORWDF) + 512;
    const int lane = tid & 63, wave = tid >> 6, r32 = lane & 31, hi = lane >> 5;
    int oz = 0; asm volatile("" : "+v"(oz)); const int ll = lane + oz;
    const float d1 = wave_sum(a.in[17][ll] * a.in[18][ll]), d2 = wave_sum(a.in[19][ll] * a.in[20][ll]);
    const float lam = __expf(d1) - __expf(d2) + LAM_INIT;
    f32x16 o[4];
    attn_pass(qn, kn, vt, b, head, 0, qb, lds, tid, o);
    float* st = stash + tid * 64;
#pragma unroll
    for (int db = 0; db < 4; ++db)
#pragma unroll
        for (int g = 0; g < 4; ++g) *(f32x4*)(st + db * 16 + g * 4) = (f32x4){o[db][4 * g], o[db][4 * g + 1], o[db][4 * g + 2], o[db][4 * g + 3]};
#if defined(PROBE_PHASE) && PROBE_PHASE == 215
    if (head == 0) { bf16* dbg = (bf16*)(ws + 496 * MiB); const size_t tq = (size_t)b * SEQ + qb * 256 + wave * 32 + r32;
#pragma unroll
        for (int db = 0; db < 4; ++db)
#pragma unroll
            for (int g = 0; g < 4; ++g) { const int dv = 32 * db + 8 * g + 4 * hi; v2u ov; ov.x = pk2(o[db][4 * g], o[db][4 * g + 1]); ov.y = pk2(o[db][4 * g + 2], o[db][4 * g + 3]); *(v2u*)(dbg + tq * 128 + dv) = ov; } }
#endif
    attn_pass(qn, kn, vt, b, head, 1, qb, lds, tid, o);
    float ss = 0.f;
#pragma unroll
    for (int db = 0; db < 4; ++db)
#pragma unroll
        for (int g = 0; g < 4; ++g) { const f32x4 s4 = *(const f32x4*)(st + db * 16 + g * 4);
#pragma unroll
            for (int e = 0; e < 4; ++e) { const float d = s4[e] - lam * o[db][4 * g + e]; o[db][4 * g + e] = d; ss += d * d; } }
    ss = xhalf_sum(ss);
    const float rs = (1.0f / sqrtf(ss * (1.f / 128.f) + 1e-6f)) * (1.0f - LAM_INIT);
    const size_t t = (size_t)b * SEQ + qb * 256 + wave * 32 + r32; const float* sw = a.in[21];
#pragma unroll
    for (int db = 0; db < 4; ++db)
#pragma unroll
        for (int g = 0; g < 4; ++g) { const int dv = 32 * db + 8 * g + 4 * hi; const f32x4 w4 = *(const f32x4*)(sw + dv);
            v2u ov; ov.x = pk2(o[db][4 * g] * rs * w4[0], o[db][4 * g + 1] * rs * w4[1]); ov.y = pk2(o[db][4 * g + 2] * rs * w4[2], o[db][4 * g + 3] * rs * w4[3]);
            *(v2u*)(odf + t * 1024 + head * 128 + dv) = ov; }
}
#define XB_TMO      128
#define XB_XCNT(j)  (256  + 64 * (j))
#define XB_XSUB(j)  (1280 + 64 * (j))
#define XB_XGEN(j)  (2304 + 64 * (j))
#define XB_TOP      3328
#define XB_TOPGEN   3392
#define XCD_BAR_WORDS 3456
#define XB_SPIN_CAP (1u << 18)

__device__ __forceinline__ unsigned xb_ld(unsigned* p)              { return __hip_atomic_load(p, __ATOMIC_RELAXED, __HIP_MEMORY_SCOPE_AGENT); }
__device__ __forceinline__ unsigned xb_add(unsigned* p, unsigned v) { return __hip_atomic_fetch_add(p, v, __ATOMIC_RELAXED, __HIP_MEMORY_SCOPE_AGENT); }
__device__ __forceinline__ unsigned xb_xcc_id() { return (unsigned)__builtin_amdgcn_s_getreg((3 << 11) | 20) & 0xFu; }
#define XB_SPIN(cond, bar) do { unsigned _sp = 0; while (cond) { __builtin_amdgcn_s_sleep(1); \
    if ((++_sp & 255u) == 0u) { if (xb_ld(&(bar)[XB_TMO])) break; if (_sp > XB_SPIN_CAP) { atomicAdd(&(bar)[XB_TMO], 1u); break; } } } } while (0)

struct XcdBarrier {
    unsigned* bar; unsigned x;
    volatile LAS unsigned* st;
};

__device__ __forceinline__ XcdBarrier xcd_barrier_post(unsigned* bar, volatile LAS unsigned* st) {
    XcdBarrier b; b.bar = bar; b.x = xb_xcc_id(); b.st = st;
    if (threadIdx.x == 0) (void)xb_add(&bar[XB_XCNT(b.x)], 1u);
    return b;
}
__device__ __forceinline__ void xcd_barrier_complete(unsigned* bar, unsigned x, unsigned& nloc, unsigned& nx) {
    const unsigned G = gridDim.x * gridDim.y * gridDim.z;
    unsigned sum, cnt, mine, sp = 0u;
    for (;;) {
        sum = 0u; cnt = 0u; mine = 0u;
#pragma unroll
        for (unsigned j = 0; j < 16; ++j) { const unsigned c = xb_ld(&bar[XB_XCNT(j)]); sum += c; cnt += (c > 0u) ? 1u : 0u; mine = (j == x) ? c : mine; }
        if (sum == G) break;
        __builtin_amdgcn_s_sleep(1);
        if ((++sp & 255u) == 0u) { if (xb_ld(&bar[XB_TMO])) break; if (sp > XB_SPIN_CAP) { atomicAdd(&bar[XB_TMO], 1u); break; } }
    }
    nloc = mine > 0u ? mine : 1u; nx = cnt > 0u ? cnt : 1u;
}

__device__ __forceinline__ void xcd_barrier(const XcdBarrier& b) {
    asm volatile("s_waitcnt vmcnt(0)" ::: "memory");
    __syncthreads();
    if (threadIdx.x == 0) {
        unsigned* bar = b.bar;
        __builtin_amdgcn_s_waitcnt(0);
        unsigned nloc = b.st[0], nx = b.st[1];
        if (nloc == 0u) { xcd_barrier_complete(bar, b.x, nloc, nx); b.st[0] = nloc; b.st[1] = nx; }
        const unsigned old = xb_add(&bar[XB_XSUB(b.x)], 1u);
        const unsigned gen = old / nloc;
        if (old + 1u == (gen + 1u) * nloc) {
            __builtin_amdgcn_fence(__ATOMIC_RELEASE, "agent");
            asm volatile("s_waitcnt vmcnt(0)" ::: "memory");
            const unsigned og = xb_add(&bar[XB_TOP], 1u);
            const unsigned tg = og / nx;
            if (og + 1u == (tg + 1u) * nx) xb_add(&bar[XB_TOPGEN], 1u);
            else XB_SPIN(xb_ld(&bar[XB_TOPGEN]) == tg, bar);
            __builtin_amdgcn_fence(__ATOMIC_ACQUIRE, "agent");
            xb_add(&bar[XB_XGEN(b.x)], 1u);
            asm volatile("s_waitcnt vmcnt(0)" ::: "memory");
        } else {
            XB_SPIN(xb_ld(&bar[XB_XGEN(b.x)]) == gen, bar);
            __builtin_amdgcn_fence(__ATOMIC_ACQUIRE, "agent");
            asm volatile("s_waitcnt vmcnt(0)" ::: "memory");
        }
    }
    __syncthreads();
}

__device__ __forceinline__ void phase7(const Args& a, LAS unsigned char* lds, int tid, int lane, int wave, int vcu, int G) {
    unsigned char* ws = a.ws;
    const int gw = vcu * NWAVES + wave, NGW = G * NWAVES;
    const float* gain = a.in[25];
    LAS float* scr = (LAS float*)(lds + wave * 16384);
    bf16* wgu = (bf16*)(ws + WS_WGU); bf16* wd = (bf16*)(ws + WS_WD);
    constexpr int IGU = (1024 / 64) * (512 / 32);
    constexpr int IDN = (512 / 64) * (1024 / 32);
    for (int it = gw; it < NEXP * (2 * IGU + IDN); it += NGW) {
        const int e = it / (2 * IGU + IDN); int r = it % (2 * IGU + IDN);
        if (r < 2 * IGU) { const int up = r >= IGU; if (up) r -= IGU; const int kb = r / 16, nb = r % 16, n0 = 32 * nb;
            const float* W = (up ? a.in[31] : a.in[30]) + (size_t)e * 1024 * 512;
            tr_item<true>(W, 512, wgu, 1024, 64 * kb, n0, (size_t)e * 1024 + (n0 >> 7) * 256 + (up ? 128 : 0) + (n0 & 127), 0, scr, lane, gain);
        } else { r -= 2 * IGU; const int kb = r / 32, nb = r % 32;
            tr_item(a.in[32] + (size_t)e * 512 * 1024, 1024, wd, 512, 64 * kb, 32 * nb, (size_t)e * 1024 + 32 * nb, 0, scr, lane); }
    }
}

__device__ __forceinline__ void route_tile(const Args& a, LAS unsigned char* lds, int tid, int pm) {
    unsigned char* ws = a.ws;
    const float* LG = (const float*)(ws + WS_LOGITS); int* toke = (int*)(ws + WS_TOKE); float* tokw = (float*)(ws + WS_TOKW); int* tilecnt = (int*)(ws + WS_TILECNT);
    LAS int* cnt = (LAS int*)lds;
    if (tid < 32) cnt[tid] = 0;
    __syncthreads();
    if (tid < 256) {
        const int t = pm * 256 + tid; const float* lr = LG + (size_t)t * 128;
        float rs;
        { const f32x4* sp = (const f32x4*)((const float*)(ws + WS_SSQ) + (size_t)t * 16); const f32x4 s0 = sp[0], s1 = sp[1], s2 = sp[2], s3 = sp[3];
          const float ss = (((s0[0] + s0[1]) + (s0[2] + s0[3])) + ((s1[0] + s1[1]) + (s1[2] + s1[3]))) + (((s2[0] + s2[1]) + (s2[2] + s2[3])) + ((s3[0] + s3[1]) + (s3[2] + s3[3])));
          rs = 1.0f / sqrtf(ss * (1.f / 1024.f) + 1e-6f); ((float*)(ws + WS_RS))[t] = rs; }
        float gl[4];
#pragma unroll
        for (int j = 0; j < 4; ++j) gl[j] = lr[32 + j] * rs + a.in[27][j];
        int gi = 0; float gm = gl[0];
#pragma unroll
        for (int j = 1; j < 4; ++j) if (gl[j] > gm) { gm = gl[j]; gi = j; }
        float gs = 0.f;
#pragma unroll
        for (int j = 0; j < 4; ++j) gs += __expf(gl[j] - gm);
        const float gtop = 1.0f / gs;
        float el[8];
#pragma unroll
        for (int j = 0; j < 8; ++j) el[j] = lr[gi * 8 + j] * rs + a.in[29][gi * 8 + j];
        int i1 = 0; float e1 = el[0];
#pragma unroll
        for (int j = 1; j < 8; ++j) if (el[j] > e1) { e1 = el[j]; i1 = j; }
        int i2 = -1; float e2 = -3.0e38f;
#pragma unroll
        for (int j = 0; j < 8; ++j) if (j != i1 && el[j] > e2) { e2 = el[j]; i2 = j; }
        const float ex = __expf(e2 - e1); const float w1 = gtop / (1.0f + ex), w2 = gtop * ex / (1.0f + ex);
        const int x1 = gi * 8 + i1, x2 = gi * 8 + i2;
        toke[t * 2] = x1; toke[t * 2 + 1] = x2; tokw[t * 2] = w1; tokw[t * 2 + 1] = w2;
        atomicAdd((int*)&cnt[x1], 1); atomicAdd((int*)&cnt[x2], 1);
    }
    __syncthreads();
    if (tid < 32) tilecnt[pm * 32 + tid] = cnt[tid];
    __syncthreads();
}

__device__ __forceinline__ void phase9(const Args& a, LAS unsigned char* lds, int tid, int lane, int wave) {
    unsigned char* ws = a.ws;
    const int tile = blockIdx.x;
    if (tile >= 128) return;
    const int* tilecnt = (const int*)(ws + WS_TILECNT); const int* toke = (const int*)(ws + WS_TOKE); const float* tokw = (const float*)(ws + WS_TOKW);
    int* pos = (int*)(ws + WS_POS); float* roww = (float*)(ws + WS_ROWW); int* disp = (int*)(ws + WS_DISP); int* rowtok = (int*)(ws + WS_ROWTOK);
    LAS int* tc = (LAS int*)lds;
    LAS int* tot = tc + 4096;
    LAS int* bef = tot + 32;
    LAS int* base = bef + 32;
    LAS int* pst = base + 32;
    LAS int* earr = pst + 32;
    LAS int* parr = earr + 512;
    for (int i = tid; i < 4096; i += NTHR) tc[i] = tilecnt[i];
    earr[tid] = toke[tile * 512 + tid];
    __syncthreads();
    if (tid < 32) { int s = 0, b = 0; for (int t = 0; t < 128; ++t) { const int c = tc[t * 32 + tid]; s += c; if (t < tile) b += c; } tot[tid] = s; bef[tid] = b; }
    __syncthreads();
    if (tid == 0) { int p = 0; for (int e = 0; e < 32; ++e) { pst[e] = p; base[e] = p + bef[e]; const int nt = (tot[e] + 255) >> 8;
                        if (tile == 0) { for (int k = 0; k < nt; ++k) disp[16 + (p >> 8) + k] = e; disp[512 + e] = p; disp[576 + e] = tot[e]; }
                        p += nt << 8; }
                    if (tile == 0) disp[0] = p >> 8; }
    __syncthreads();
    for (int q = 0; q < 4; ++q) { const int e = wave * 4 + q; int running = 0;
        for (int c8 = 0; c8 < 8; ++c8) { const int ai = c8 * 64 + lane; const bool mt = earr[ai] == e; const unsigned long long mk = __ballot(mt);
            if (mt) parr[ai] = base[e] + running + __popcll(mk & ((1ull << lane) - 1ull));
            running += __popcll(mk); } }
    __syncthreads();
    { const int ai = tid, p = parr[ai], t = tile * 256 + (ai >> 1); pos[t * 2 + (ai & 1)] = p; roww[p] = tokw[t * 2 + (ai & 1)]; rowtok[p] = t; ((float*)(ws + WS_ROWRS))[p] = ((const float*)(ws + WS_RS))[t]; }
    if (tile < 32) { const int p0 = pst[tile] + tot[tile], p1 = pst[tile] + (((tot[tile] + 255) >> 8) << 8);
        for (int r = p0 + tid; r < p1; r += NTHR) { rowtok[r] = 0; roww[r] = 0.f; ((float*)(ws + WS_ROWRS))[r] = 0.f; } }
}

__device__ __forceinline__ void phase12(const Args& a, int tid, int lane, int wave, int vcu, int G) {
    unsigned char* ws = a.ws;
    const int gw = vcu * NWAVES + wave, NGW = G * NWAVES; const int gt = vcu * NTHR + tid, NGT = G * NTHR;
    const bf16* x1 = (const bf16*)a.out; bf16* x2 = (bf16*)(ws + WS_X2); const bf16* y2 = (const bf16*)(ws + WS_Y2); const int* pos = (const int*)(ws + WS_POS); const float* gain = a.in[33]; bf16* h3 = (bf16*)(ws + WS_H3);
    for (int m = gw; m < T; m += NGW) {
        const int pa = pos[m * 2], pb = pos[m * 2 + 1];
        const v2u* xr = (const v2u*)(x1 + (size_t)m * DM) + lane; v2u* xo = (v2u*)(x2 + (size_t)m * DM) + lane; const v2u* ya = (const v2u*)(y2 + (size_t)pa * 1024) + lane; const v2u* yb = (const v2u*)(y2 + (size_t)pb * 1024) + lane;
        f32x4 v[4]; float s = 0.f;
#pragma unroll
        for (int j = 0; j < 4; ++j) { const v2u wx = xr[64 * j], wa = ya[64 * j], wb = yb[64 * j];
            v[j].x = bflo(wx.x) + bflo(wa.x) + bflo(wb.x); v[j].y = bfhi(wx.x) + bfhi(wa.x) + bfhi(wb.x); v[j].z = bflo(wx.y) + bflo(wa.y) + bflo(wb.y); v[j].w = bfhi(wx.y) + bfhi(wa.y) + bfhi(wb.y);
            v2u o; o.x = pk2(v[j].x, v[j].y); o.y = pk2(v[j].z, v[j].w); xo[64 * j] = o;
            s += (v[j].x * v[j].x + v[j].y * v[j].y) + (v[j].z * v[j].z + v[j].w * v[j].w); }
        const float rstd = 1.0f / sqrtf(wave_sum(s) * (1.f / 1024.f) + 1e-6f);
        v2u* o8 = (v2u*)(h3 + (size_t)m * DM) + lane;
#pragma unroll
        for (int j = 0; j < 4; ++j) { const f32x4 g = ((const f32x4*)gain)[lane + 64 * j]; v2u o; o.x = pk2(v[j].x * rstd * g.x, v[j].y * rstd * g.y); o.y = pk2(v[j].z * rstd * g.z, v[j].w * rstd * g.w); o8[64 * j] = o; }
    }
    const f32x4* p = (const f32x4*)a.in[1]; v2u* p16 = (v2u*)(ws + WS_P16);
    for (int i = gt; i < T * 256 / 4; i += NGT) { const f32x4 v = p[i]; v2u o; o.x = pk2(v.x, v.y); o.y = pk2(v.z, v.w); p16[i] = o; }
}

#if defined(PROBE_PHASE) && (PROBE_PHASE == 200 || PROBE_PHASE == 201)
__device__ __forceinline__ float blk_sum(float v, LAS float* red, int tid) { v = wave_sum(v); __syncthreads(); if ((tid & 63) == 0) red[tid >> 6] = v; __syncthreads(); float s = 0.f; for (int i = 0; i < 8; ++i) s += red[i]; __syncthreads(); return s; }
__device__ __forceinline__ void check_moe(const Args& a, LAS unsigned char* lds, int tid, float* res) {
    unsigned char* ws = a.ws;
    LAS float* hb = (LAS float*)lds; LAS float* hf = hb + 1024; LAS float* act = hf + 1024; LAS float* lg = act + 512; LAS float* red = lg + 64; LAS int* sel = (LAS int*)(red + 16);
    const int* toke = (const int*)(ws + WS_TOKE); const float* tokw = (const float*)(ws + WS_TOKW); const int* pos = (const int*)(ws + WS_POS); const bf16* y2 = (const bf16*)(ws + WS_Y2);
    float errsum = 0.f, refsum = 0.f; int mism = 0;
    for (int si = 0; si < 24; ++si) { const int t = si * 1361 + 17;
        const bf16* xr = (const bf16*)a.out + (size_t)t * DM; const float x0 = __builtin_bit_cast(float, (unsigned)xr[tid] << 16), x1 = __builtin_bit_cast(float, (unsigned)xr[tid + 512] << 16);
        const float rstd = 1.0f / sqrtf(blk_sum(x0 * x0 + x1 * x1, red, tid) * (1.f / 1024.f) + 1e-6f);
        const float h0 = x0 * rstd * a.in[25][tid], h1 = x1 * rstd * a.in[25][tid + 512];
        hf[tid] = h0; hf[tid + 512] = h1; hb[tid] = __builtin_bit_cast(float, f2bf(h0) << 16); hb[tid + 512] = __builtin_bit_cast(float, f2bf(h1) << 16);
        __syncthreads();
        if (tid < 36) { float s = 0.f; for (int k = 0; k < 1024; ++k) s += hf[k] * (tid < 32 ? a.in[28][k * 32 + tid] : a.in[26][k * 4 + (tid - 32)]); lg[tid] = s + (tid < 32 ? a.in[29][tid] : a.in[27][tid - 32]); }
        __syncthreads();
        if (tid == 0) { int gi = 0; for (int j = 1; j < 4; ++j) if (lg[32 + j] > lg[32 + gi]) gi = j;
            int i1 = 0; for (int j = 1; j < 8; ++j) if (lg[gi * 8 + j] > lg[gi * 8 + i1]) i1 = j;
            int i2 = -1; for (int j = 0; j < 8; ++j) if (j != i1 && (i2 < 0 || lg[gi * 8 + j] > lg[gi * 8 + i2])) i2 = j;
            sel[0] = gi * 8 + i1; sel[1] = gi * 8 + i2; }
        __syncthreads();
        if (sel[0] != toke[t * 2] || sel[1] != toke[t * 2 + 1]) mism++;
        float o0 = 0.f, o1 = 0.f;
        for (int kx = 0; kx < 2; ++kx) { const int e = toke[t * 2 + kx]; const float w = tokw[t * 2 + kx];
            const float* Wg = a.in[30] + (size_t)e * 1024 * 512; const float* Wu = a.in[31] + (size_t)e * 1024 * 512; const float* Wd = a.in[32] + (size_t)e * 512 * 1024;
            float gg = 0.f, uu = 0.f; for (int k = 0; k < 1024; ++k) { const float hk = hb[k]; gg += hk * Wg[(size_t)k * 512 + tid]; uu += hk * Wu[(size_t)k * 512 + tid]; }
            __syncthreads(); act[tid] = gg / (1.0f + __expf(-gg)) * uu; __syncthreads();
            float s0 = 0.f, s1 = 0.f; for (int f = 0; f < 512; ++f) { const float af = act[f]; s0 += af * Wd[(size_t)f * 1024 + tid]; s1 += af * Wd[(size_t)f * 1024 + tid + 512]; }
            o0 += s0 * w; o1 += s1 * w; }
        const int pa = pos[t * 2], pb = pos[t * 2 + 1];
        const float m0 = __builtin_bit_cast(float, (unsigned)y2[(size_t)pa * 1024 + tid] << 16) + __builtin_bit_cast(float, (unsigned)y2[(size_t)pb * 1024 + tid] << 16);
        const float m1 = __builtin_bit_cast(float, (unsigned)y2[(size_t)pa * 1024 + tid + 512] << 16) + __builtin_bit_cast(float, (unsigned)y2[(size_t)pb * 1024 + tid + 512] << 16);
        errsum += (m0 - o0) * (m0 - o0) + (m1 - o1) * (m1 - o1); refsum += o0 * o0 + o1 * o1;
    }
    const float es = blk_sum(errsum, red, tid), rs = blk_sum(refsum, red, tid);
    if (tid == 0) *res = (PROBE_PHASE == 200) ? sqrtf(es / rs) : (float)mism / 24.f;
}
#endif

#ifndef PROBE_KAPPA
#define PROBE_KAPPA 0
#endif
#ifndef CHK_S0
#define CHK_S0 0
#define CHK_SN 4096
#endif
#if defined(PROBE_PHASE) && (PROBE_PHASE == 210 || PROBE_PHASE == 211 || PROBE_PHASE == 215)
__device__ __forceinline__ void check_attn(const Args& a, LAS unsigned char* lds, int tid, float* res) {
    unsigned char* ws = a.ws;
    const bf16* vt = (const bf16*)(ws + WS_VT);
    const bf16* odf = (const bf16*)((unsigned char*)a.out + OUT_ORWDF) + 512;
    LAS float* sc = (LAS float*)lds; LAS float* part = sc + 4096; LAS float* oc = part + 512; LAS float* red = oc + 256;
    const float d1 = wave_sum(a.in[17][tid & 63] * a.in[18][tid & 63]), d2 = wave_sum(a.in[19][tid & 63] * a.in[20][tid & 63]);
    const float lam = __expf(d1) - __expf(d2) + LAM_INIT;
    float errsum = 0.f, refsum = 0.f;
    for (int si = 0; si < 24; ++si) { const int b = si & 7, head = (PROBE_PHASE == 215) ? 0 : ((si >> 1) & 3), s = CHK_S0 + ((si * 977 + 31 * (si & 3)) % CHK_SN);
        for (int c = 0; c < 2; ++c) { const int vh = b * 8 + head * 2 + c;
            const bf16* qn = qn_ptr(ws, b); const bf16* kn = kn_ptr(ws, b); const bf16* qp = qn + ((size_t)(vh & 7) * SEQ + s) * 64; float mx = -3e38f;
            for (int j = tid; j <= s; j += NTHR) { const bf16* kp = kn + ((size_t)(vh & 7) * SEQ + j) * 64; float d = 0.f;
                for (int e = 0; e < 64; ++e) d += __builtin_bit_cast(float, (unsigned)qp[e] << 16) * __builtin_bit_cast(float, (unsigned)kp[e] << 16);
                sc[j] = d; mx = fmaxf(mx, d); }
            __syncthreads();
            for (int o = 1; o < 64; o <<= 1) mx = fmaxf(mx, __shfl_xor(mx, o));
            if ((tid & 63) == 0) red[tid >> 6] = mx;
            __syncthreads();
            mx = red[0]; for (int i = 1; i < 8; ++i) mx = fmaxf(mx, red[i]);
            __syncthreads();
            float ls = 0.f;
            for (int j = tid; j <= s; j += NTHR) { const float p = exp2f(sc[j] - mx); sc[j] = p; ls += p; }
            ls = wave_sum(ls); if ((tid & 63) == 0) red[tid >> 6] = ls;
            __syncthreads();
            float l = 0.f; for (int i = 0; i < 8; ++i) l += red[i];
            { const int dv = tid & 127, pr = tid >> 7; const bf16* vp = vt + (size_t)(head * 128 + dv) * T + (size_t)b * SEQ; float acc = 0.f;
              for (int j = pr; j <= s; j += 4) acc += sc[j] * __builtin_bit_cast(float, (unsigned)vp[j] << 16);
              part[tid] = acc; }
            __syncthreads();
            if (tid < 128) oc[c * 128 + tid] = (part[tid] + part[tid + 128] + part[tid + 256] + part[tid + 384]) / l;
            __syncthreads(); }
#if PROBE_PHASE == 215
        if (tid < 128) { const float ref = oc[tid]; const float got = __builtin_bit_cast(float, (unsigned)((const bf16*)(ws + 496 * MiB))[((size_t)b * SEQ + s) * 128 + tid] << 16); errsum += (PROBE_KAPPA ? got * ref : (got - ref) * (got - ref)); refsum += ref * ref; }
        __syncthreads(); continue;
#endif
        float dd = 0.f, sq = 0.f; if (tid < 128) { dd = oc[tid] - lam * oc[128 + tid]; sq = dd * dd; }
        sq = wave_sum(sq); __syncthreads(); if ((tid & 63) == 0) red[tid >> 6] = sq; __syncthreads();
        const float rs = (1.0f / sqrtf((red[0] + red[1]) * (1.f / 128.f) + 1e-6f)) * (1.0f - LAM_INIT);
        if (tid < 128) { const float ref = dd * rs * a.in[21][tid]; const float got = __builtin_bit_cast(float, (unsigned)odf[((size_t)b * SEQ + s) * 1024 + head * 128 + tid] << 16);
            errsum += (got - ref) * (got - ref); refsum += ref * ref; }
        __syncthreads(); }
    errsum = wave_sum(errsum); refsum = wave_sum(refsum);
    __syncthreads(); if ((tid & 63) == 0) { red[tid >> 6] = errsum; red[8 + (tid >> 6)] = refsum; } __syncthreads();
    if (tid == 0) *res = PROBE_KAPPA ? fabsf((red[0] + red[1]) / (red[8] + red[9])) : sqrtf((red[0] + red[1]) / (red[8] + red[9]));
}
__device__ __forceinline__ void check_scan(const Args& a, LAS unsigned char* lds, int tid, float* res) {
    unsigned char* ws = a.ws; const int b = 1, hd = 3, NS = 384;
    const bf16* rkv = (const bf16*)(ws + WS_RKV); const bf16* E = (const bf16*)(ws + WS_E); const bf16* Aa = (const bf16*)(ws + WS_A); const bf16* Y = y_ptr(a.out, b);
    LAS float* vw = (LAS float*)lds; LAS float* vaa = vw + 64; LAS float* vbb = vaa + 64; LAS float* vkm = vbb + 64; LAS float* vr = vkm + 64; LAS float* vv = vr + 64; LAS float* red = vv + 64;
    const int row = tid >> 3, cg = tid & 7; float st[8]; for (int j = 0; j < 8; ++j) st[j] = 0.f;
    float errsum = 0.f, refsum = 0.f;
    for (int s = 0; s < NS; ++s) { const size_t t = (size_t)b * SEQ + s;
        if (tid < 64) { const int ch = hd * 64 + tid;
            auto ld = [&](size_t tt, int off) { return __builtin_bit_cast(float, (unsigned)rkv[tt * 1536 + off + ch] << 16); };
            const float rc = ld(t, 0), kc = ld(t, 512), vc = ld(t, 1024); const float rp = s ? ld(t - 1, 0) : 0.f, kp = s ? ld(t - 1, 512) : 0.f, vp = s ? ld(t - 1, 1024) : 0.f;
            const float r = rc + (rp - rc) * a.in[4][ch], k = kc + (kp - kc) * a.in[4][512 + ch], v = vc + (vp - vc) * a.in[4][1024 + ch];
            const float e = __builtin_bit_cast(float, (unsigned)E[t * 512 + ch] << 16), av = __builtin_bit_cast(float, (unsigned)Aa[t * 512 + ch] << 16);
            float kk = k * a.in[10][ch]; const float nn = sqrtf(wave_sum(kk * kk)); kk = kk / fmaxf(nn, 1e-12f);
            vw[tid] = expf(-e); vaa[tid] = -kk; vbb[tid] = kk * av; vkm[tid] = k * (1.0f + (av - 1.0f) * a.in[11][ch]); vr[tid] = r; vv[tid] = v; }
        __syncthreads();
        float sa = 0.f; for (int j = 0; j < 8; ++j) sa += st[j] * vaa[cg * 8 + j];
        sa += __shfl_xor(sa, 1); sa += __shfl_xor(sa, 2); sa += __shfl_xor(sa, 4);
        float y = 0.f; for (int j = 0; j < 8; ++j) { const int c = cg * 8 + j; st[j] = st[j] * vw[c] + sa * vbb[c] + vv[row] * vkm[c]; y += st[j] * vr[c]; }
        y += __shfl_xor(y, 1); y += __shfl_xor(y, 2); y += __shfl_xor(y, 4);
        if (cg == 0) { const float got = __builtin_bit_cast(float, (unsigned)Y[(size_t)s * 512 + hd * 64 + row] << 16); errsum += (got - y) * (got - y); refsum += y * y; }
        __syncthreads(); }
    errsum = wave_sum(errsum); refsum = wave_sum(refsum);
    if ((tid & 63) == 0) { red[tid >> 6] = errsum; red[8 + (tid >> 6)] = refsum; } __syncthreads();
    if (tid == 0) { float es = 0.f, rs = 0.f; for (int i = 0; i < 8; ++i) { es += red[i]; rs += red[8 + i]; } *res = sqrtf(es / rs); }
}
#endif
#ifndef MK_N_LAUNCHES
#define MK_N_LAUNCHES 1
#endif
#ifndef SCAN_CHUNKED
#define SCAN_CHUNKED 1
#endif
constexpr int NSCAN = SCAN_CHUNKED ? 64 : 128;
constexpr int NGATE = 256;
constexpr int NPHASE = 15;
__global__ void __launch_bounds__(NTHR, 2) mk_fwd(Args args) {
    extern __shared__ __attribute__((aligned(16))) unsigned char lds_raw[];
    LAS unsigned char* lds = (LAS unsigned char*)lds_raw;
    const int tid = threadIdx.x, lane = tid & 63, wave = __builtin_amdgcn_readfirstlane(tid >> 6);
    const int G = gridDim.x; const int bx = blockIdx.x; const int vcu = (G % 8 == 0) ? (bx % 8) * (G / 8) + bx / 8 : bx;
    unsigned char* ws = args.ws;
    const int lo = args.ph_lo, hi = args.ph_hi;
#ifdef ONLY_PHASE
#define IN(k) ((k) == ONLY_PHASE && lo <= (k) && (k) < hi)
#else
#define IN(k) (lo <= (k) && (k) < hi)
#endif
#if MK_N_LAUNCHES == 1
    volatile LAS unsigned* MISC = (volatile LAS unsigned*)(lds + MISC_OFF);
    for (int u = tid; u < 64; u += NTHR) MISC[u] = 0u;
    __syncthreads();
    XcdBarrier xbar = xcd_barrier_post((unsigned*)(ws + WS_CTL) + CW_BAR, MISC + 8);
    if (lo < 0) { __threadfence(); cg::this_grid().sync(); }
#define SEAM(k) do { if (IN(k) && IN((k) + 1)) xcd_barrier(xbar); } while (0)
#else
#define SEAM(k) do { } while (0)
#endif
#ifdef PROBE_PHASE
    volatile LAS unsigned long long* ptw = (volatile LAS unsigned long long*)(lds + MISC_OFF + 1536);
#define pt0 ptw[0]
#define pt1 ptw[1]
    if (tid == 0) { pt0 = 0ull; pt1 = 0ull; }
#define PB(k) do { if ((k) == PROBE_PHASE && bx == 0 && tid == 0) pt0 = __builtin_amdgcn_s_memrealtime(); } while (0)
#define PE(k) do { if ((k) == PROBE_PHASE && bx == 0 && tid == 0) pt1 = __builtin_amdgcn_s_memrealtime(); } while (0)
#else
#define PB(k) do { } while (0)
#define PE(k) do { } while (0)
#endif
    typedef pg8::bf16_t pbf;
    int K256 = 256, K512 = 512, K1024 = 1024, K2048 = 2048;
    asm volatile("" : "+s"(K256), "+s"(K512), "+s"(K1024), "+s"(K2048));
    PB(0);
    if (IN(0)) { phase0(args, lds, tid, lane, wave, vcu, G); }
    SEAM(0); PE(0);
    PB(1);
    if (IN(1)) {
        { pg8::Gemm g{(const pbf*)(ws + WS_XN), (const pbf*)(ws + WS_WIN), T, 11 * 256, K1024}; pg8::StaticOrder S; S.init(T, 11 * 256, G, bx);
          pg8::EpiProj E{(pbf*)(ws + WS_RKV), (pbf*)(ws + WS_PROJB), (pbf*)(ws + WS_GATES)};
          pg8::gemm_phase<pg8::EpiProj, pg8::StaticOrder, true, true>(lds, g, S, E); }
        { pg8::Gemm g{(const pbf*)(ws + WS_WIN) + (size_t)2816 * 1024, (const pbf*)(ws + WS_XN), 512, T, K1024}; pg8::StaticOrder S; S.init(512, T, G, bx);
          pg8::EpiStore E{(pbf*)(ws + WS_VT), T};
          pg8::gemm_phase<pg8::EpiStore, pg8::StaticOrder, true, true>(lds, g, S, E); }
    }
    SEAM(1); PE(1);
    PB(2);
    if (IN(2)) { phase2(args, lds, tid, vcu, G); }
    SEAM(2); PE(2);
    PB(3);
    if (IN(3)) {
        pg8::Gemm g{(const pbf*)((unsigned char*)args.out + OUT_LA), (const pbf*)(ws + WS_WLORA), T, 1536, K256}; pg8::StaticOrder S; S.init(T, 1536, G, bx);
        pg8::EpiLora E{(pbf*)(ws + WS_E), (pbf*)(ws + WS_A), (pbf*)(ws + WS_G), args.in[5], args.in[7]};
        pg8::gemm_phase<pg8::EpiLora, pg8::StaticOrder, true, true>(lds, g, S, E);
    }
    SEAM(3); PE(3);
    PB(4);
    if (IN(4)) {
        unsigned* qhead = (unsigned*)(ws + WS_CTL) + CW_QUEUE; LAS unsigned* ubox = (LAS unsigned*)(lds + MISC_OFF);
        float* stash = (float*)((unsigned char*)args.out + OUT_STASH) + (size_t)bx * 64 * 512;
        for (;;) {
            __syncthreads();
            if (tid == 0) ubox[0] = atomicAdd(qhead, 1u);
            __syncthreads();
            const int u = (int)ubox[0];
            int oq = 0; asm volatile("" : "+v"(oq)); const int tq = tid + oq;
            if (u >= NSCAN + NGATE + 512) break;
#if defined(PROBE_PHASE) && PROBE_PHASE == 100
            if (u < NSCAN) { if (tid == 0) ptw[2] = __builtin_amdgcn_s_memrealtime(); if (SCAN_CHUNKED) scan_unit_chunked(args, lds, tq, u); else scan_unit(args, lds, tq, u);
                if (tid == 0) atomicMax((unsigned*)(ws + WS_CTL) + 96, (unsigned)(__builtin_amdgcn_s_memrealtime() - ptw[2])); }
#else
            if (u < NSCAN) { if (SCAN_CHUNKED) scan_unit_chunked(args, lds, tq, u); else scan_unit(args, lds, tq, u); }
#endif
#if defined(PROBE_PHASE) && PROBE_PHASE == 101
            else if (u < NSCAN + NGATE) { } else { const int au = u - NSCAN - NGATE; const unsigned long long q0 = __builtin_amdgcn_s_memrealtime(); attn_unit(args, lds, tid, (au & 31) >> 2, au & 3, 15 - (au >> 5), stash); const unsigned long long q1 = __builtin_amdgcn_s_memrealtime();
                if (tid == 0) atomicAdd((unsigned*)(ws + WS_CTL) + 96, (unsigned)(q1 - q0)); }
#else
            else if (u < NSCAN + NGATE) { const int it = u - NSCAN;
                pg8::Gemm g{(const pbf*)(ws + WS_XN), (const pbf*)(ws + WS_WIN) + (size_t)3328 * 1024, T, 2048, K1024}; pg8::OrderItem S{it >> 1, (it & 1) * 4, 4};
                pg8::EpiGates E{(pbf*)(ws + WS_GATES)};
                pg8::gemm_phase<pg8::EpiGates, pg8::OrderItem, true, true>(lds, g, S, E, oq); }
            else { const int au = u - NSCAN - NGATE; attn_unit(args, lds, tq, (au & 31) >> 2, au & 3, 15 - (au >> 5), stash); }
#endif
        }
    }
    SEAM(4); PE(4);
#if defined(PROBE_PHASE) && (PROBE_PHASE == 210 || PROBE_PHASE == 211 || PROBE_PHASE == 215)
    if (bx == 0) { float* res = (float*)(ws + WS_CTL) + 100; if (PROBE_PHASE != 211) check_attn(args, lds, tid, res); else check_scan(args, lds, tid, res); __syncthreads(); if (tid == 0) { pt0 = 0ull; pt1 = (unsigned long long)(*(volatile float*)res * 1.0e6f); } }
    xcd_barrier(xbar);
#endif
#if defined(PROBE_PHASE) && PROBE_PHASE == 100
    if (bx == 0 && tid == 0) { pt0 = 0ull; pt1 = (unsigned long long)__hip_atomic_load((unsigned*)(ws + WS_CTL) + 96, __ATOMIC_RELAXED, __HIP_MEMORY_SCOPE_AGENT); }
#endif
#if defined(PROBE_PHASE) && PROBE_PHASE >= 300 && PROBE_PHASE < 310
    if (bx == 0 && tid == 0) { pt0 = 0ull; pt1 = (unsigned long long)__hip_atomic_load((unsigned*)(ws + WS_CTL) + 96, __ATOMIC_RELAXED, __HIP_MEMORY_SCOPE_AGENT) / 64ull; }
#endif
#if defined(PROBE_PHASE) && PROBE_PHASE == 101
    if (bx == 0 && tid == 0) { pt0 = 0ull; pt1 = (unsigned long long)__hip_atomic_load((unsigned*)(ws + WS_CTL) + 96, __ATOMIC_RELAXED, __HIP_MEMORY_SCOPE_AGENT) / 256ull; }
#endif
    PB(5);
    if (IN(5)) { phase_orw(args, lane, wave, vcu, G); }
    SEAM(5); PE(5);
    PB(6);
    if (IN(6)) {
        pg8::Gemm g{(const pbf*)((unsigned char*)args.out + OUT_ORWDF), (const pbf*)(ws + WS_WBRD), T, 1024, K1024}; pg8::StaticOrder S; S.init(T, 1024, G, bx);
        pg8::EpiMix E{(const pbf*)(ws + WS_GATES), (pbf*)(ws + WS_MIXED)};
        pg8::gemm_phase<pg8::EpiMix, pg8::StaticOrder, true, true>(lds, g, S, E);
    }
    SEAM(6); PE(6);
    PB(7);
    if (IN(7)) {
        pg8::Gemm g{(const pbf*)(ws + WS_MIXED), (const pbf*)(ws + WS_WO), T, 1024, K1024}; pg8::StaticOrder S; S.init(T, 1024, G, bx);
        pg8::EpiRes E{args.in[0], (pbf*)args.out, (float*)(ws + WS_SSQ)};
        pg8::gemm_phase<pg8::EpiRes, pg8::StaticOrder, true, true>(lds, g, S, E);
    }
    SEAM(7); PE(7);
    PB(8);
    if (IN(8)) { phase7(args, lds, tid, lane, wave, vcu, G); }
    SEAM(8); PE(8);
    PB(9);
    if (IN(9)) {
        pg8::Gemm g{(const pbf*)args.out, (const pbf*)(ws + WS_WR), T, 256, K1024}; pg8::StaticOrder S; S.init(T, 256, G, bx);
        pg8::EpiLogits E{(float*)(ws + WS_LOGITS)};
        pg8::gemm_phase<pg8::EpiLogits, pg8::StaticOrder, true, true>(lds, g, S, E);
        VM_WAIT(); __syncthreads();
        pg8::Unit u;
        for (int i = 0; S.next(i, u); ++i) route_tile(args, lds, tid, u.pm);
    }
    SEAM(9); PE(9);
    PB(10);
    if (IN(10)) { phase9(args, lds, tid, lane, wave); }
    SEAM(10); PE(10);
    PB(11);
    if (IN(11) || IN(12)) {
        const int* disp = (const int*)(ws + WS_DISP); LAS int* tile_e = (LAS int*)(lds + MISC_OFF + 64);
        __syncthreads();
        const int NT = disp[0];
        for (int i = tid; i < NT && i < 320; i += NTHR) tile_e[i] = disp[16 + i];
        __syncthreads();
        if (IN(11)) {
            pg8::Gemm g{(const pbf*)args.out, (const pbf*)(ws + WS_WGU), T, NEXP * 1024, K1024}; pg8::OrderMoe S{NT * 4, G, bx, tile_e};
            pg8::EpiAct E{(pbf*)(ws + WS_ACT), (const float*)(ws + WS_ROWRS)};
            pg8::gemm_phase_gather<pg8::EpiAct, pg8::OrderMoe>(lds, g, (const int*)(ws + WS_ROWTOK), S, E);
        }
        SEAM(11); PE(11); PB(12);
        if (IN(12)) {
            pg8::Gemm g{(const pbf*)(ws + WS_ACT), (const pbf*)(ws + WS_WD), MAXROWS, NEXP * 1024, K512}; pg8::OrderMoe S{NT * 4, G, bx, tile_e};
            pg8::EpiDown E{(pbf*)(ws + WS_Y2), (const float*)(ws + WS_ROWW)};
            pg8::gemm_phase<pg8::EpiDown, pg8::OrderMoe, true, true>(lds, g, S, E);
        }
    }
    SEAM(12); PE(12);
#if defined(PROBE_PHASE) && (PROBE_PHASE == 200 || PROBE_PHASE == 201)
    if (bx == 0) { float* res = (float*)(ws + WS_CTL) + 100; check_moe(args, lds, tid, res); __syncthreads(); if (tid == 0) { pt0 = 0ull; pt1 = (unsigned long long)(*(volatile float*)res * 1.0e6f); } }
    xcd_barrier(xbar);
#endif
    PB(13);
    if (IN(13)) { phase12(args, tid, lane, wave, vcu, G); }
    SEAM(13); PE(13);
    PB(14);
    if (IN(14)) {
        { pg8::Gemm g{(const pbf*)(ws + WS_P16), (const pbf*)(ws + WS_WPP), T, 1024, K256}; pg8::StaticOrder S; S.init(T, 1024, G, bx);
          pg8::EpiStore E{(pbf*)(ws + WS_PP), 1024};
          pg8::gemm_phase<pg8::EpiStore, pg8::StaticOrder, true, true>(lds, g, S, E); }
        { pg8::Gemm g{(const pbf*)(ws + WS_H3), (const pbf*)(ws + WS_WPG), T, 1024, K1024}; pg8::StaticOrder S; S.init(T, 1024, G, bx);
          pg8::EpiFinal E{(const pbf*)(ws + WS_PP), (const pbf*)(ws + WS_X2), args.out};
          pg8::gemm_phase<pg8::EpiFinal, pg8::StaticOrder, true, true>(lds, g, S, E); }
    }
#ifdef PROBE_PHASE
    if (PROBE_PHASE == 14 && bx == 0 && tid == 0) { pt1 = __builtin_amdgcn_s_memrealtime(); }
    if (bx == 0 && tid == 0) { const unsigned long long te = __builtin_amdgcn_s_memrealtime(), w = (unsigned long long)PROBE_MULT * (pt1 - pt0);
        while (__builtin_amdgcn_s_memrealtime() - te < w) __builtin_amdgcn_s_sleep(32); }
#endif
#undef IN
#undef SEAM
}

extern "C" void kernel_launch(void* const* d_in, const int* in_sizes, int n_in, void* d_out, int out_size, void* d_ws, size_t ws_size, hipStream_t stream) {
    static int grid = 0;
    if (grid == 0) {
        if (n_in != 36 || in_sizes[0] != T * DM || out_size != T * DM || ws_size < WS_END) {
            fprintf(stderr, "kernel_launch: unexpected problem: n_in %d in0 %d out %d ws %zu (need %zu)\n", n_in, n_in > 0 ? in_sizes[0] : -1, out_size, ws_size, (size_t)WS_END); grid = -1; return; }
        int dev = 0, cus = 0, per_cu = 0;
        if (hipGetDevice(&dev) != hipSuccess || hipDeviceGetAttribute(&cus, hipDeviceAttributeMultiprocessorCount, dev) != hipSuccess) { grid = -1; return; }
        if (hipFuncSetAttribute((const void*)mk_fwd, hipFuncAttributeMaxDynamicSharedMemorySize, LDS_BYTES) != hipSuccess) { fprintf(stderr, "kernel_launch: hipFuncSetAttribute failed\n"); grid = -1; return; }
        if (hipOccupancyMaxActiveBlocksPerMultiprocessor(&per_cu, (const void*)mk_fwd, NTHR, LDS_BYTES) != hipSuccess || per_cu < 1) { fprintf(stderr, "kernel_launch: occupancy query says %d blocks per CU\n", per_cu); (void)hipGetLastError(); grid = -1; return; }
        grid = cus;
        if (grid > 256) grid = 256;
    }
    if (grid < 0) return;
    (void)hipMemsetAsync((char*)d_ws + WS_CTL, 0, CTL_ZERO_BYTES, stream);
    Args a{};
    for (int i = 0; i < 36; ++i) a.in[i] = (const float*)d_in[i];
    a.out = (float*)d_out; a.ws = (unsigned char*)d_ws;
#if MK_N_LAUNCHES == 1
    a.ph_lo = 0; a.ph_hi = NPHASE;
    void* kargs[] = {&a};
    const hipError_t e = hipLaunchCooperativeKernel((const void*)mk_fwd, dim3(grid), dim3(NTHR), kargs, LDS_BYTES, stream);
    if (e != hipSuccess) fprintf(stderr, "kernel_launch: cooperative launch failed: %s (grid %d)\n", hipGetErrorString(e), grid);
#else
    for (int ph = 0; ph < NPHASE; ++ph) { a.ph_lo = ph; a.ph_hi = ph + 1; hipLaunchKernelGGL(mk_fwd, dim3(grid), dim3(NTHR), LDS_BYTES, stream, a); }
#endif
}
```

```cpp
#include <hip/hip_runtime.h>
#include <hip/hip_cooperative_groups.h>
#include <cstdio>
#include <cstdint>
namespace cg = cooperative_groups;
namespace pg8 {
#define PG8_LAS __attribute__((address_space(3)))
typedef unsigned short bf16_t;
typedef short bf16x8 __attribute__((ext_vector_type(8)));
typedef float f32x4 __attribute__((ext_vector_type(4)));
typedef unsigned u32x4 __attribute__((ext_vector_type(4)));
constexpr int BM = 256, BK = 64, HALF = 128, HTB = HALF * BK * 2  , STAGE_BYTES = 8 * HTB, NXCD = 8, WGM = 8;

__host__ __device__ __forceinline__ int lds_byte(int r, int c) { const int st = (r >> 4) * 2 + (c >> 5), rr = r & 15, cc = c & 31, ob = rr * 64 + cc * 2; return st * 1024 + (ob ^ (((ob >> 9) & 1) << 5)); }
__host__ __device__ __forceinline__ void stage_rc(int b, int& R, int& C) { const int st = b / 1024, sb = b % 1024, swz = sb ^ (((sb >> 9) & 1) << 5); R = (st >> 1) * 16 + swz / 64; C = (st & 1) * 32 + (swz % 64) / 2; }
__host__ __device__ __forceinline__ int perm32(int rho) { const int n = rho >> 4, i = rho & 15; return 8 * (i >> 2) + 4 * n + (i & 3); }

struct Unit { int pm, pn; };
struct Gemm { const bf16_t* A; const bf16_t* Bt; int M, N, K; };

struct StaticOrder {
    int nM, nN, nwg, G, c;
    __host__ __device__ __forceinline__ void init(int M, int N, int G_, int c_) { nM = M / BM; nN = N / BM; nwg = nM * nN; G = G_; c = c_; }
    __host__ __device__ __forceinline__ bool next(int i, Unit& u) const {
        const long L = (long)i * G + c; if (L >= nwg) return false;
        int wgid = (int)L; { const int q = nwg / NXCD, r = nwg % NXCD, xcd = wgid % NXCD, off = wgid / NXCD; wgid = (xcd < r ? xcd * (q + 1) : r * (q + 1) + (xcd - r) * q) + off; }
        const int nig = WGM * nN, gid = wgid / nig, fm = gid * WGM, gsz = (nM - fm) < WGM ? (nM - fm) : WGM;
        u.pm = fm + ((wgid % nig) % gsz); u.pn = (wgid % nig) / gsz; return true;
    }
    __device__ __forceinline__ void a_ready(const Unit&) const {}
    __device__ __forceinline__ void done(const Unit&) const {}
};

__device__ __forceinline__ unsigned cvt_pk_bf16(float lo, float hi) { unsigned r; asm volatile("v_cvt_pk_bf16_f32 %0, %1, %2" : "=v"(r) : "v"(lo), "v"(hi)); return r; }
template <class Epi, class Sched, bool ALIGN_EPI = false, bool SP2 = false>
__device__ __forceinline__ void gemm_phase(PG8_LAS unsigned char* lds, const Gemm g, const Sched& S, const Epi& E, const int tz = 0  ) {
    const int tid = threadIdx.x + tz, wid = __builtin_amdgcn_readfirstlane(tid >> 6), lane = tid & 63, wr = wid >> 2, wc = wid & 3, fr = lane & 15, fq = lane >> 4;
    const int K = g.K, nt = K / BK;
    unsigned voffA[2], voffB[2];
#pragma unroll
    for (int i = 0; i < 2; ++i) { int R, C; stage_rc(tid * 16 + i * 8192, R, C); const int Rb = Epi::PERM ? ((R & ~31) + perm32(R & 31)) : R;
        voffA[i] = (unsigned)(R * K + C) * 2u; voffB[i] = (unsigned)(Rb * K + C) * 2u; }
    const size_t kstep = (size_t)(BK * 2);
    const size_t hstep = (size_t)HALF * K * 2;
    const size_t tstep = 2 * hstep;
    const unsigned ldsw = (unsigned)wid * 1024u;
    const int aoff = lds_byte(wr * 64 + fr, fq * 8), boff = lds_byte(wc * 32 + fr, fq * 8);
#define PG8_SA(b, h) (((b) * 2 + (h)) * HTB)
#define PG8_SB(b, h) ((4 + (b) * 2 + (h)) * HTB)
#define PG8_STAGE(bufoff, gbase, voff) do { _Pragma("unroll") for (int _i = 0; _i < 2; ++_i) \
        __builtin_amdgcn_global_load_lds((const unsigned*)((const char*)(gbase) + (voff)[_i]), (PG8_LAS unsigned*)(lds + (bufoff) + ldsw + _i * 8192), 16, 0, 0); } while (0)
#define PG8_LDA(dst, b, h) do { _Pragma("unroll") for (int m = 0; m < 4; ++m) _Pragma("unroll") for (int k = 0; k < 2; ++k) dst[m][k] = *(const PG8_LAS bf16x8*)(lds + PG8_SA(b, h) + aoff + m * 2048 + k * 1024); } while (0)
#define PG8_LDB(dst, b, h) do { _Pragma("unroll") for (int n = 0; n < 2; ++n) _Pragma("unroll") for (int k = 0; k < 2; ++k) dst[n][k] = *(const PG8_LAS bf16x8*)(lds + PG8_SB(b, h) + boff + n * 2048 + k * 1024); } while (0)
#define PG8_MMA(ai, bj, At, Bt) do { __builtin_amdgcn_s_setprio(1); _Pragma("unroll") for (int m = 0; m < 4; ++m) _Pragma("unroll") for (int n = 0; n < 2; ++n) _Pragma("unroll") for (int k = 0; k < 2; ++k) \
        acc[ai][bj][m][n] = __builtin_amdgcn_mfma_f32_16x16x32_bf16(Bt[n][k], At[m][k], acc[ai][bj][m][n], 0, 0, 0); __builtin_amdgcn_s_setprio(0); } while (0)
#define PG8_WAIT_V(n) asm volatile("s_waitcnt vmcnt(" #n ")" ::: "memory")
#define PG8_WAIT_L(n) asm volatile("s_waitcnt lgkmcnt(" #n ")" ::: "memory")
#define PG8_BAR __builtin_amdgcn_s_barrier()
#define PG8_SCHED __builtin_amdgcn_sched_barrier(0)
    Unit cur, nxt; int ui = 0;
    if (!S.next(0, cur)) return;
    f32x4 acc[2][2][4][2];
#pragma unroll
    for (int a = 0; a < 2; ++a)
#pragma unroll
        for (int b = 0; b < 2; ++b)
#pragma unroll
            for (int m = 0; m < 4; ++m)
#pragma unroll
                for (int n = 0; n < 2; ++n) acc[a][b][m][n] = (f32x4){0.f, 0.f, 0.f, 0.f};
    bf16x8 At[4][2], B0[2][2], B1[2][2];
    const char* cA = (const char*)g.A + (size_t)cur.pm * tstep; const char* cB = (const char*)g.Bt + (size_t)cur.pn * tstep;
    S.a_ready(cur);
    if constexpr (SP2) {
        PG8_STAGE(PG8_SB(0, 0), cB, voffB); PG8_STAGE(PG8_SB(0, 1), cB + hstep, voffB); PG8_STAGE(PG8_SA(0, 0), cA, voffA); PG8_STAGE(PG8_SA(0, 1), cA + hstep, voffA);
        if (wr == 1) PG8_BAR;
        PG8_WAIT_V(2); PG8_BAR;
        PG8_STAGE(PG8_SB(1, 0), cB + kstep, voffB); PG8_STAGE(PG8_SA(1, 0), cA + kstep, voffA); PG8_STAGE(PG8_SB(1, 1), cB + hstep + kstep, voffB);
        PG8_WAIT_V(6); PG8_BAR;
    } else {
        PG8_STAGE(PG8_SB(0, 0), cB, voffB); PG8_STAGE(PG8_SA(0, 0), cA, voffA); PG8_STAGE(PG8_SB(0, 1), cB + hstep, voffB); PG8_STAGE(PG8_SA(0, 1), cA + hstep, voffA);
        if (wr == 1) PG8_BAR;
        PG8_WAIT_V(4); PG8_BAR;
        PG8_STAGE(PG8_SB(1, 0), cB + kstep, voffB); PG8_STAGE(PG8_SA(1, 0), cA + kstep, voffA); PG8_STAGE(PG8_SB(1, 1), cB + hstep + kstep, voffB);
        PG8_WAIT_V(6); PG8_BAR;
    }
    for (;;) {
        const bool has_next = S.next(ui + 1, nxt);
        const char* nA = has_next ? (const char*)g.A + (size_t)nxt.pm * tstep : cA; const char* nB = has_next ? (const char*)g.Bt + (size_t)nxt.pn * tstep : cB;
        for (int t = 0; t < nt; t += 2) {
            if constexpr (Epi::HAS_MID) { if (t == (nt >> 1)) E.mid(acc, cur, wr, wc, fr, fq); }
            const bool last = (t == nt - 2);
            const char* a1 = cA + (size_t)(t + 1) * kstep;
            const char* a2 = last ? nA : cA + (size_t)(t + 2) * kstep; const char* b2 = last ? nB : cB + (size_t)(t + 2) * kstep;
            const char* a3 = a2 + kstep; const char* b3 = b2 + kstep;
            if (last && has_next) S.a_ready(nxt);
            if constexpr (SP2) {
            PG8_LDB(B0, 0, 0); PG8_LDB(B1, 0, 1); PG8_SCHED; PG8_LDA(At, 0, 0); PG8_STAGE(PG8_SA(1, 1), a1 + hstep, voffA);
            PG8_WAIT_V(8); PG8_WAIT_L(0); PG8_BAR; PG8_MMA(0, 0, At, B0); PG8_MMA(0, 1, At, B1); PG8_BAR; PG8_SCHED;
            PG8_LDA(At, 0, 1); PG8_STAGE(PG8_SB(0, 0), b2, voffB); PG8_STAGE(PG8_SB(0, 1), b2 + hstep, voffB); PG8_STAGE(PG8_SA(0, 0), a2, voffA);
            PG8_WAIT_V(8); PG8_WAIT_L(0); PG8_BAR; PG8_MMA(1, 0, At, B0); PG8_MMA(1, 1, At, B1); PG8_BAR; PG8_SCHED;
            PG8_LDB(B0, 1, 0); PG8_LDB(B1, 1, 1); PG8_SCHED; PG8_LDA(At, 1, 0); PG8_STAGE(PG8_SA(0, 1), a2 + hstep, voffA);
            PG8_WAIT_V(8); PG8_WAIT_L(0); PG8_BAR; PG8_MMA(0, 0, At, B0); PG8_MMA(0, 1, At, B1); PG8_BAR; PG8_SCHED;
            PG8_LDA(At, 1, 1); PG8_STAGE(PG8_SB(1, 0), b3, voffB); PG8_STAGE(PG8_SB(1, 1), b3 + hstep, voffB); PG8_STAGE(PG8_SA(1, 0), a3, voffA);
            PG8_WAIT_V(8); PG8_WAIT_L(0); PG8_BAR; PG8_MMA(1, 0, At, B0); PG8_MMA(1, 1, At, B1); PG8_BAR; PG8_SCHED;
            } else {
            PG8_LDB(B0, 0, 0); PG8_SCHED; PG8_LDA(At, 0, 0); PG8_STAGE(PG8_SA(1, 1), a1 + hstep, voffA);
            PG8_WAIT_L(8); PG8_BAR; PG8_WAIT_L(0); PG8_MMA(0, 0, At, B0); PG8_BAR; PG8_SCHED;
            PG8_LDB(B1, 0, 1); PG8_STAGE(PG8_SB(0, 0), b2, voffB);
            PG8_BAR; PG8_WAIT_L(0); PG8_MMA(0, 1, At, B1); PG8_BAR;
            PG8_LDA(At, 0, 1); PG8_STAGE(PG8_SA(0, 0), a2, voffA);
            PG8_BAR; PG8_WAIT_L(0); PG8_MMA(1, 0, At, B0); PG8_BAR; PG8_SCHED;
            PG8_STAGE(PG8_SB(0, 1), b2 + hstep, voffB);
            PG8_WAIT_V(6); PG8_BAR; PG8_MMA(1, 1, At, B1); PG8_BAR;
            PG8_LDB(B0, 1, 0); PG8_SCHED; PG8_LDA(At, 1, 0); PG8_STAGE(PG8_SA(0, 1), a2 + hstep, voffA);
            PG8_WAIT_L(8); PG8_BAR; PG8_WAIT_L(0); PG8_MMA(0, 0, At, B0); PG8_BAR; PG8_SCHED;
            PG8_LDB(B1, 1, 1); PG8_STAGE(PG8_SB(1, 0), b3, voffB);
            PG8_BAR; PG8_WAIT_L(0); PG8_MMA(0, 1, At, B1); PG8_BAR;
            PG8_LDA(At, 1, 1); PG8_STAGE(PG8_SA(1, 0), a3, voffA);
            PG8_BAR; PG8_WAIT_L(0); PG8_MMA(1, 0, At, B0); PG8_BAR; PG8_SCHED;
            PG8_STAGE(PG8_SB(1, 1), b3 + hstep, voffB);
            PG8_WAIT_V(6); PG8_BAR; PG8_MMA(1, 1, At, B1); PG8_BAR;
            }
        }
        if constexpr (ALIGN_EPI) { if (wr == 0) PG8_BAR; }
        if constexpr (!Epi::AFTER_DRAIN) { E(acc, cur, wr, wc, fr, fq); S.done(cur); }
        if (!has_next) break;
#pragma unroll
        for (int a = 0; a < 2; ++a)
#pragma unroll
            for (int b = 0; b < 2; ++b)
#pragma unroll
                for (int m = 0; m < 4; ++m)
#pragma unroll
                    for (int n = 0; n < 2; ++n) acc[a][b][m][n] = (f32x4){0.f, 0.f, 0.f, 0.f};
        cur = nxt; cA = nA; cB = nB; ++ui;
        if constexpr (ALIGN_EPI) { if (wr == 1) PG8_BAR; }
    }
    PG8_WAIT_V(0);
    if constexpr (!ALIGN_EPI) { if (wr == 0) PG8_BAR; }
    PG8_BAR;
    if constexpr (Epi::AFTER_DRAIN) { E.fused(acc, cur, wr, wc, fr, fq, lds, wid, lane); S.done(cur); }
#undef PG8_SA
#undef PG8_SB
#undef PG8_STAGE
#undef PG8_LDA
#undef PG8_LDB
#undef PG8_MMA
#undef PG8_WAIT_V
#undef PG8_WAIT_L
#undef PG8_BAR
#undef PG8_SCHED
}
template <class Epi, class Sched>
__device__ __forceinline__ void gemm_phase_gather(PG8_LAS unsigned char* lds, const Gemm g, const int* idx, const Sched& S, const Epi& E, const int tz = 0  ) {
    const int tid = threadIdx.x + tz, wid = __builtin_amdgcn_readfirstlane(tid >> 6), lane = tid & 63, wr = wid >> 2, wc = wid & 3, fr = lane & 15, fq = lane >> 4;
    const int K = g.K, nt = K / BK;
    unsigned voffA[2], voffB[2];
    int rowA[2];
#pragma unroll
    for (int i = 0; i < 2; ++i) { int R, C; stage_rc(tid * 16 + i * 8192, R, C); const int Rb = Epi::PERM ? ((R & ~31) + perm32(R & 31)) : R;
        voffA[i] = (unsigned)C * 2u; rowA[i] = R; voffB[i] = (unsigned)(Rb * K + C) * 2u; }
    unsigned vA0[2], vA1[2], vN0[2], vN1[2];
#define PG8_GOFF(dst0, dst1, pm_) do { _Pragma("unroll") for (int _i = 0; _i < 2; ++_i) { dst0[_i] = (unsigned)idx[(pm_) * BM + rowA[_i]] * (unsigned)(K * 2) + voffA[_i]; dst1[_i] = (unsigned)idx[(pm_) * BM + HALF + rowA[_i]] * (unsigned)(K * 2) + voffA[_i]; } } while (0)
    const size_t kstep = (size_t)(BK * 2);
    const size_t hstep = (size_t)HALF * K * 2;
    const size_t tstep = 2 * hstep;
    const unsigned ldsw = (unsigned)wid * 1024u;
    const int aoff = lds_byte(wr * 64 + fr, fq * 8), boff = lds_byte(wc * 32 + fr, fq * 8);
#define PG8_SA(b, h) (((b) * 2 + (h)) * HTB)
#define PG8_SB(b, h) ((4 + (b) * 2 + (h)) * HTB)
#define PG8_STAGE(bufoff, gbase, voff) do { _Pragma("unroll") for (int _i = 0; _i < 2; ++_i) \
        __builtin_amdgcn_global_load_lds((const unsigned*)((const char*)(gbase) + (voff)[_i]), (PG8_LAS unsigned*)(lds + (bufoff) + ldsw + _i * 8192), 16, 0, 0); } while (0)
#define PG8_LDA(dst, b, h) do { _Pragma("unroll") for (int m = 0; m < 4; ++m) _Pragma("unroll") for (int k = 0; k < 2; ++k) dst[m][k] = *(const PG8_LAS bf16x8*)(lds + PG8_SA(b, h) + aoff + m * 2048 + k * 1024); } while (0)
#define PG8_LDB(dst, b, h) do { _Pragma("unroll") for (int n = 0; n < 2; ++n) _Pragma("unroll") for (int k = 0; k < 2; ++k) dst[n][k] = *(const PG8_LAS bf16x8*)(lds + PG8_SB(b, h) + boff + n * 2048 + k * 1024); } while (0)
#define PG8_MMA(ai, bj, At, Bt) do { __builtin_amdgcn_s_setprio(1); _Pragma("unroll") for (int m = 0; m < 4; ++m) _Pragma("unroll") for (int n = 0; n < 2; ++n) _Pragma("unroll") for (int k = 0; k < 2; ++k) \
        acc[ai][bj][m][n] = __builtin_amdgcn_mfma_f32_16x16x32_bf16(Bt[n][k], At[m][k], acc[ai][bj][m][n], 0, 0, 0); __builtin_amdgcn_s_setprio(0); } while (0)
#define PG8_WAIT_V(n) asm volatile("s_waitcnt vmcnt(" #n ")" ::: "memory")
#define PG8_WAIT_L(n) asm volatile("s_waitcnt lgkmcnt(" #n ")" ::: "memory")
#define PG8_BAR __builtin_amdgcn_s_barrier()
#define PG8_SCHED __builtin_amdgcn_sched_barrier(0)
    Unit cur, nxt; int ui = 0;
    if (!S.next(0, cur)) return;
    f32x4 acc[2][2][4][2];
#pragma unroll
    for (int a = 0; a < 2; ++a)
#pragma unroll
        for (int b = 0; b < 2; ++b)
#pragma unroll
            for (int m = 0; m < 4; ++m)
#pragma unroll
                for (int n = 0; n < 2; ++n) acc[a][b][m][n] = (f32x4){0.f, 0.f, 0.f, 0.f};
    bf16x8 At[4][2], B0[2][2], B1[2][2];
    const char* cA = (const char*)g.A; PG8_GOFF(vA0, vA1, cur.pm); const char* cB = (const char*)g.Bt + (size_t)cur.pn * tstep;
    S.a_ready(cur);
    if constexpr (true) {
        PG8_STAGE(PG8_SB(0, 0), cB, voffB); PG8_STAGE(PG8_SB(0, 1), cB + hstep, voffB); PG8_STAGE(PG8_SA(0, 0), cA, vA0); PG8_STAGE(PG8_SA(0, 1), cA, vA1);
        if (wr == 1) PG8_BAR;
        PG8_WAIT_V(2); PG8_BAR;
        PG8_STAGE(PG8_SB(1, 0), cB + kstep, voffB); PG8_STAGE(PG8_SA(1, 0), cA + kstep, vA0); PG8_STAGE(PG8_SB(1, 1), cB + hstep + kstep, voffB);
        PG8_WAIT_V(6); PG8_BAR;
    } else {
        PG8_STAGE(PG8_SB(0, 0), cB, voffB); PG8_STAGE(PG8_SA(0, 0), cA, voffA); PG8_STAGE(PG8_SB(0, 1), cB + hstep, voffB); PG8_STAGE(PG8_SA(0, 1), cA + hstep, voffA);
        if (wr == 1) PG8_BAR;
        PG8_WAIT_V(4); PG8_BAR;
        PG8_STAGE(PG8_SB(1, 0), cB + kstep, voffB); PG8_STAGE(PG8_SA(1, 0), cA + kstep, vA0); PG8_STAGE(PG8_SB(1, 1), cB + hstep + kstep, voffB);
        PG8_WAIT_V(6); PG8_BAR;
    }
    for (;;) {
        const bool has_next = S.next(ui + 1, nxt);
        const char* nA = cA; if (has_next) PG8_GOFF(vN0, vN1, nxt.pm); else { vN0[0] = vA0[0]; vN0[1] = vA0[1]; vN1[0] = vA1[0]; vN1[1] = vA1[1]; } const char* nB = has_next ? (const char*)g.Bt + (size_t)nxt.pn * tstep : cB;
        for (int t = 0; t < nt; t += 2) {
            if constexpr (Epi::HAS_MID) { if (t == (nt >> 1)) E.mid(acc, cur, wr, wc, fr, fq); }
            const bool last = (t == nt - 2);
            const char* a1 = cA + (size_t)(t + 1) * kstep;
            const char* a2 = last ? nA : cA + (size_t)(t + 2) * kstep; unsigned x0[2], x1[2]; x0[0] = last ? vN0[0] : vA0[0]; x0[1] = last ? vN0[1] : vA0[1]; x1[0] = last ? vN1[0] : vA1[0]; x1[1] = last ? vN1[1] : vA1[1]; const char* b2 = last ? nB : cB + (size_t)(t + 2) * kstep;
            const char* a3 = a2 + kstep; const char* b3 = b2 + kstep;
            if (last && has_next) S.a_ready(nxt);
            if constexpr (true) {
            PG8_LDB(B0, 0, 0); PG8_LDB(B1, 0, 1); PG8_SCHED; PG8_LDA(At, 0, 0); PG8_STAGE(PG8_SA(1, 1), a1, vA1);
            PG8_WAIT_V(8); PG8_WAIT_L(0); PG8_BAR; PG8_MMA(0, 0, At, B0); PG8_MMA(0, 1, At, B1); PG8_BAR; PG8_SCHED;
            PG8_LDA(At, 0, 1); PG8_STAGE(PG8_SB(0, 0), b2, voffB); PG8_STAGE(PG8_SB(0, 1), b2 + hstep, voffB); PG8_STAGE(PG8_SA(0, 0), a2, x0);
            PG8_WAIT_V(8); PG8_WAIT_L(0); PG8_BAR; PG8_MMA(1, 0, At, B0); PG8_MMA(1, 1, At, B1); PG8_BAR; PG8_SCHED;
            PG8_LDB(B0, 1, 0); PG8_LDB(B1, 1, 1); PG8_SCHED; PG8_LDA(At, 1, 0); PG8_STAGE(PG8_SA(0, 1), a2, x1);
            PG8_WAIT_V(8); PG8_WAIT_L(0); PG8_BAR; PG8_MMA(0, 0, At, B0); PG8_MMA(0, 1, At, B1); PG8_BAR; PG8_SCHED;
            PG8_LDA(At, 1, 1); PG8_STAGE(PG8_SB(1, 0), b3, voffB); PG8_STAGE(PG8_SB(1, 1), b3 + hstep, voffB); PG8_STAGE(PG8_SA(1, 0), a3, x0);
            PG8_WAIT_V(8); PG8_WAIT_L(0); PG8_BAR; PG8_MMA(1, 0, At, B0); PG8_MMA(1, 1, At, B1); PG8_BAR; PG8_SCHED;
            } else {
            PG8_LDB(B0, 0, 0); PG8_SCHED; PG8_LDA(At, 0, 0); PG8_STAGE(PG8_SA(1, 1), a1, vA1);
            PG8_WAIT_L(8); PG8_BAR; PG8_WAIT_L(0); PG8_MMA(0, 0, At, B0); PG8_BAR; PG8_SCHED;
            PG8_LDB(B1, 0, 1); PG8_STAGE(PG8_SB(0, 0), b2, voffB);
            PG8_BAR; PG8_WAIT_L(0); PG8_MMA(0, 1, At, B1); PG8_BAR;
            PG8_LDA(At, 0, 1); PG8_STAGE(PG8_SA(0, 0), a2, x0);
            PG8_BAR; PG8_WAIT_L(0); PG8_MMA(1, 0, At, B0); PG8_BAR; PG8_SCHED;
            PG8_STAGE(PG8_SB(0, 1), b2 + hstep, voffB);
            PG8_WAIT_V(6); PG8_BAR; PG8_MMA(1, 1, At, B1); PG8_BAR;
            PG8_LDB(B0, 1, 0); PG8_SCHED; PG8_LDA(At, 1, 0); PG8_STAGE(PG8_SA(0, 1), a2, x1);
            PG8_WAIT_L(8); PG8_BAR; PG8_WAIT_L(0); PG8_MMA(0, 0, At, B0); PG8_BAR; PG8_SCHED;
            PG8_LDB(B1, 1, 1); PG8_STAGE(PG8_SB(1, 0), b3, voffB);
            PG8_BAR; PG8_WAIT_L(0); PG8_MMA(0, 1, At, B1); PG8_BAR;
            PG8_LDA(At, 1, 1); PG8_STAGE(PG8_SA(1, 0), a3, x0);
            PG8_BAR; PG8_WAIT_L(0); PG8_MMA(1, 0, At, B0); PG8_BAR; PG8_SCHED;
            PG8_STAGE(PG8_SB(1, 1), b3 + hstep, voffB);
            PG8_WAIT_V(6); PG8_BAR; PG8_MMA(1, 1, At, B1); PG8_BAR;
            }
        }
        if constexpr (true) { if (wr == 0) PG8_BAR; }
        if constexpr (!Epi::AFTER_DRAIN) { E(acc, cur, wr, wc, fr, fq); S.done(cur); }
        if (!has_next) break;
#pragma unroll
        for (int a = 0; a < 2; ++a)
#pragma unroll
            for (int b = 0; b < 2; ++b)
#pragma unroll
                for (int m = 0; m < 4; ++m)
#pragma unroll
                    for (int n = 0; n < 2; ++n) acc[a][b][m][n] = (f32x4){0.f, 0.f, 0.f, 0.f};
        cur = nxt; cA = nA; cB = nB; ++ui; vA0[0] = vN0[0]; vA0[1] = vN0[1]; vA1[0] = vN1[0]; vA1[1] = vN1[1];
        if constexpr (true) { if (wr == 1) PG8_BAR; }
    }
    PG8_WAIT_V(0);
    if constexpr (false) { if (wr == 0) PG8_BAR; }
    PG8_BAR;
    if constexpr (Epi::AFTER_DRAIN) { E.fused(acc, cur, wr, wc, fr, fq, lds, wid, lane); S.done(cur); }
#undef PG8_SA
#undef PG8_SB
#undef PG8_GOFF
#undef PG8_STAGE
#undef PG8_LDA
#undef PG8_LDB
#undef PG8_MMA
#undef PG8_WAIT_V
#undef PG8_WAIT_L
#undef PG8_BAR
#undef PG8_SCHED
}
}

constexpr int NB = 8, SEQ = 4096, DM = 1024, T = NB * SEQ;
constexpr int RW = 512, NHR = 8;
constexpr int NPROJ = 5376;
constexpr int FF = 512, NEXP = 32;
constexpr float C2 = 0.125f * 1.4426950408889634f;
constexpr float LAM_INIT = 0.2f;
constexpr int MAXROWS = 2 * T + NEXP * 256;

constexpr size_t MiB = 1u << 20;
constexpr size_t WS_CTL = 0, CTL_ZERO_BYTES = 1 * MiB;
constexpr size_t WS_WLORA = 1 * MiB;
constexpr size_t WS_WBRD = 2 * MiB;
constexpr size_t WS_WO = 4 * MiB;
constexpr size_t WS_WR = 6 * MiB;
constexpr size_t WS_WPG = 7 * MiB;
constexpr size_t WS_WPP = 9 * MiB;
constexpr size_t WS_TOKE = 10 * MiB;
constexpr size_t WS_TOKW = 10 * MiB + 256 * 1024;
constexpr size_t WS_POS = 10 * MiB + 512 * 1024;
constexpr size_t WS_ROWW = 10 * MiB + 768 * 1024;
constexpr size_t WS_TILECNT = 11 * MiB + 256 * 1024;
constexpr size_t WS_DISP = 11 * MiB + 512 * 1024;
constexpr size_t WS_BON = 12 * MiB;
constexpr size_t WS_ROWTOK = 13 * MiB;
constexpr size_t WS_RS = 13 * MiB + 512 * 1024;
constexpr size_t WS_ROWRS = 13 * MiB + 640 * 1024;
constexpr size_t WS_SSQ = 14 * MiB;
constexpr size_t WS_WIN = 16 * MiB;
constexpr size_t WS_LOGITS = 16 * MiB;
constexpr size_t WS_XN = 32 * MiB;
constexpr size_t WS_WGU = 32 * MiB;
constexpr size_t WS_RKV = 96 * MiB;
constexpr size_t WS_MIXED = 96 * MiB;
constexpr size_t WS_WD = 96 * MiB;
constexpr size_t WS_HS = 128 * MiB;
constexpr size_t WS_H3 = 128 * MiB;
constexpr size_t WS_PROJB = 192 * MiB;
constexpr size_t WS_E = 192 * MiB;
constexpr size_t WS_A = 224 * MiB;
constexpr size_t WS_G = 256 * MiB;
constexpr size_t WS_P16 = 192 * MiB;
constexpr size_t WS_PP = 208 * MiB;
constexpr size_t WS_Y2 = 272 * MiB;
constexpr size_t WS_GATES = 304 * MiB;
constexpr size_t WS_H2X = 304 * MiB;
constexpr size_t WS_VT = 432 * MiB;
constexpr size_t WS_ACT = 432 * MiB;
constexpr size_t WS_X2 = 432 * MiB;
constexpr size_t WS_PART = 176 * MiB;
constexpr size_t WS_END = 512 * MiB;
constexpr size_t OUT_STASH = 0, OUT_ORWDF = 32 * MiB, OUT_Y = 96 * MiB  , OUT_LA = 0  ;
static_assert(WS_ACT + (size_t)MAXROWS * 512 * 2 <= WS_END && WS_Y2 + (size_t)MAXROWS * 1024 * 2 <= WS_ACT && WS_HS + (size_t)MAXROWS * 1024 * 2 <= WS_Y2, "ws map");
static_assert(WS_PART + (size_t)T * 1024 * 4 <= WS_GATES && WS_MIXED + (size_t)T * 1024 * 2 <= WS_PART, "ws map");
constexpr int CW_QUEUE = 64;
constexpr int CW_BAR = 4096;

constexpr int RING_BYTES = 131072;
constexpr int MISC_OFF = 158720;
constexpr int LDS_BYTES = 160768;
constexpr int NWAVES = 8, NTHR = 512;

#define GAS __attribute__((address_space(1)))
#define LAS __attribute__((address_space(3)))
typedef unsigned short bf16;
typedef unsigned v4u __attribute__((ext_vector_type(4)));
typedef unsigned v2u __attribute__((ext_vector_type(2)));
typedef float f32x4 __attribute__((ext_vector_type(4)));
typedef float f32x16 __attribute__((ext_vector_type(16)));
typedef short s16x8 __attribute__((ext_vector_type(8)));
typedef short s16x4 __attribute__((ext_vector_type(4)));
#define LDS_WAIT() asm volatile("s_waitcnt lgkmcnt(0)" ::: "memory")
#define VM_WAIT() asm volatile("s_waitcnt vmcnt(0)" ::: "memory")

__device__ __forceinline__ bf16* y_ptr(float* out, int b) { return (bf16*)((unsigned char*)out + OUT_Y) + (size_t)b * SEQ * 512; }
__device__ __forceinline__ bf16* qn_ptr(unsigned char* ws, int b) { return (bf16*)(ws + (b < 4 ? (288 + 4 * (size_t)b) * MiB : (464 + 4 * (size_t)(b - 4)) * MiB)); }
__device__ __forceinline__ bf16* kn_ptr(unsigned char* ws, int b) { return (bf16*)(ws + (480 + 4 * (size_t)b) * MiB); }
__device__ __forceinline__ unsigned f2bf(float f) { unsigned u = __builtin_bit_cast(unsigned, f); return (u + 0x7fffu + ((u >> 16) & 1u)) >> 16; }
typedef float f32x2_t __attribute__((ext_vector_type(2))); typedef __bf16 bf16x2_t __attribute__((ext_vector_type(2)));
__device__ __forceinline__ unsigned pk2(float lo, float hi) { f32x2_t v = {lo, hi}; bf16x2_t b = __builtin_convertvector(v, bf16x2_t); return __builtin_bit_cast(unsigned, b); }
__device__ __forceinline__ float bflo(unsigned w) { return __builtin_bit_cast(float, w << 16); }
__device__ __forceinline__ float bfhi(unsigned w) { return __builtin_bit_cast(float, w & 0xffff0000u); }
__device__ __forceinline__ float sigm(float x) { return __builtin_amdgcn_rcpf(1.0f + __builtin_amdgcn_exp2f(-1.4426950408889634f * x)); }
template <int CTRL> __device__ __forceinline__ float dpp_mov(float v) { return __builtin_bit_cast(float, __builtin_amdgcn_update_dpp(0, __builtin_bit_cast(int, v), CTRL, 0xF, 0xF, false)); }
__device__ __forceinline__ float red8(float v) { v += dpp_mov<0xB1>(v); v += dpp_mov<0x4E>(v); v += dpp_mov<0x141>(v); return v; }
__device__ __forceinline__ float red16(float v) { v = red8(v); v += dpp_mov<0x140>(v); return v; }
__device__ __forceinline__ void swap32(unsigned& a, unsigned& b) { asm volatile("s_nop 1\n\tv_permlane32_swap_b32 %0, %1\n\ts_nop 1" : "+v"(a), "+v"(b)); }
__device__ __forceinline__ float xhalf_max(float m) { unsigned a = __builtin_bit_cast(unsigned, m), b = a; swap32(a, b); return fmaxf(__builtin_bit_cast(float, a), __builtin_bit_cast(float, b)); }
__device__ __forceinline__ float xhalf_sum(float m) { unsigned a = __builtin_bit_cast(unsigned, m), b = a; swap32(a, b); return __builtin_bit_cast(float, a) + __builtin_bit_cast(float, b); }
__device__ __forceinline__ float wave_sum(float v) { v = red16(v); v += __shfl_xor(v, 16); return xhalf_sum(v); }

namespace pg8 {
struct EpiStore {
    static constexpr bool PERM = true, AFTER_DRAIN = false, HAS_MID = false;
    bf16_t* O; int ldc;
    __device__ __forceinline__ void operator()(const f32x4 (&acc)[2][2][4][2], const Unit& u, int wr, int wc, int fr, int fq) const {
        const int row0 = u.pm * BM + wr * 64 + fr, col0 = u.pn * BM + wc * 32 + 8 * fq;
#pragma unroll
        for (int ai = 0; ai < 2; ++ai)
#pragma unroll
            for (int m = 0; m < 4; ++m) { bf16_t* rowp = O + (size_t)(row0 + ai * HALF + m * 16) * ldc + col0;
#pragma unroll
                for (int bj = 0; bj < 2; ++bj) { const f32x4 v0 = acc[ai][bj][m][0], v1 = acc[ai][bj][m][1]; u32x4 w;
                    w.x = cvt_pk_bf16(v0[0], v0[1]); w.y = cvt_pk_bf16(v0[2], v0[3]); w.z = cvt_pk_bf16(v1[0], v1[1]); w.w = cvt_pk_bf16(v1[2], v1[3]);
                    *(u32x4*)(rowp + bj * HALF) = w; } }
    }
};
struct EpiProj {
    static constexpr bool PERM = true, AFTER_DRAIN = false, HAS_MID = false;
    bf16_t *rkv, *projb, *gates;
    __device__ __forceinline__ void operator()(const f32x4 (&acc)[2][2][4][2], const Unit& u, int wr, int wc, int fr, int fq) const {
        bf16_t* base; int ldc, ct;
        if (u.pn < 6) { base = rkv; ldc = 1536; ct = u.pn; } else if (u.pn < 11) { base = projb; ldc = 1280; ct = u.pn - 6; } else { base = gates; ldc = 2048; ct = u.pn - 13; }
        const int row0 = u.pm * BM + wr * 64 + fr, col0 = ct * BM + wc * 32 + 8 * fq;
#pragma unroll
        for (int ai = 0; ai < 2; ++ai)
#pragma unroll
            for (int m = 0; m < 4; ++m) { bf16_t* rowp = base + (size_t)(row0 + ai * HALF + m * 16) * ldc + col0;
#pragma unroll
                for (int bj = 0; bj < 2; ++bj) { f32x4 v0 = acc[ai][bj][m][0], v1 = acc[ai][bj][m][1]; u32x4 w;
                    if (u.pn >= 13) {
#pragma unroll
                        for (int e = 0; e < 4; ++e) { v0[e] = fmaxf(sigm(v0[e]), 1e-6f); v1[e] = fmaxf(sigm(v1[e]), 1e-6f); } }
                    w.x = cvt_pk_bf16(v0[0], v0[1]); w.y = cvt_pk_bf16(v0[2], v0[3]); w.z = cvt_pk_bf16(v1[0], v1[1]); w.w = cvt_pk_bf16(v1[2], v1[3]);
                    *(u32x4*)(rowp + bj * HALF) = w; } }
    }
};
struct EpiLora {
    static constexpr bool PERM = true, AFTER_DRAIN = false, HAS_MID = false;
    bf16_t *E, *A, *G; const float *w0, *a0;
    template <int KIND> __device__ __forceinline__ void body(const f32x4 (&acc)[2][2][4][2], bf16_t* base, const float* bias, int row0, int col0) const {
#pragma unroll
        for (int bj = 0; bj < 2; ++bj)
#pragma unroll
            for (int ai = 0; ai < 2; ++ai)
#pragma unroll
                for (int m = 0; m < 4; ++m) { bf16_t* rowp = base + (size_t)(row0 + ai * HALF + m * 16) * 512 + col0 + bj * HALF;
                    f32x4 v0 = acc[ai][bj][m][0], v1 = acc[ai][bj][m][1];
                    if (KIND < 2) { const f32x4 b0 = *(const f32x4*)(bias + col0 + bj * HALF), b1 = *(const f32x4*)(bias + col0 + bj * HALF + 4); const float sc = KIND == 0 ? 0.60653065971263342f : 1.0f;
                        v0 += b0; v1 += b1;
#pragma unroll
                        for (int e = 0; e < 4; ++e) { v0[e] = sc * sigm(v0[e]); v1[e] = sc * sigm(v1[e]); } }
                    u32x4 w; w.x = cvt_pk_bf16(v0[0], v0[1]); w.y = cvt_pk_bf16(v0[2], v0[3]); w.z = cvt_pk_bf16(v1[0], v1[1]); w.w = cvt_pk_bf16(v1[2], v1[3]);
                    *(u32x4*)rowp = w; asm volatile("" ::: "memory"); }
    }
    __device__ __forceinline__ void operator()(const f32x4 (&acc)[2][2][4][2], const Unit& u, int wr, int wc, int fr, int fq) const {
        const int kind = u.pn >> 1; const int row0 = u.pm * BM + wr * 64 + fr, col0 = (u.pn & 1) * BM + wc * 32 + 8 * fq;
        if (kind == 0) body<0>(acc, E, w0, row0, col0); else if (kind == 1) body<1>(acc, A, a0, row0, col0); else body<2>(acc, G, w0, row0, col0);
    }
};
struct EpiMix {
    static constexpr bool PERM = true, AFTER_DRAIN = false, HAS_MID = true;
    const bf16_t* gates; bf16_t* mixed;
    __device__ __forceinline__ void mid(f32x4 (&acc)[2][2][4][2], const Unit& u, int wr, int wc, int fr, int fq) const {
        const int row0 = u.pm * BM + wr * 64 + fr, col0 = u.pn * BM + wc * 32 + 8 * fq;
#pragma unroll
        for (int ai = 0; ai < 2; ++ai)
#pragma unroll
            for (int m = 0; m < 4; ++m) { const size_t r = (size_t)(row0 + ai * HALF + m * 16);
#pragma unroll
                for (int bj = 0; bj < 2; ++bj) { const int c = col0 + bj * HALF;
                    const u32x4 gr = *(const u32x4*)(gates + r * 2048 + c), gd = *(const u32x4*)(gates + r * 2048 + 1024 + c);
                    f32x4& v0 = acc[ai][bj][m][0]; f32x4& v1 = acc[ai][bj][m][1];
                    v0[0] *= bflo(gr.x) * __builtin_amdgcn_rcpf(bflo(gd.x)); v0[1] *= bfhi(gr.x) * __builtin_amdgcn_rcpf(bfhi(gd.x)); v0[2] *= bflo(gr.y) * __builtin_amdgcn_rcpf(bflo(gd.y)); v0[3] *= bfhi(gr.y) * __builtin_amdgcn_rcpf(bfhi(gd.y));
                    v1[0] *= bflo(gr.z) * __builtin_amdgcn_rcpf(bflo(gd.z)); v1[1] *= bfhi(gr.z) * __builtin_amdgcn_rcpf(bfhi(gd.z)); v1[2] *= bflo(gr.w) * __builtin_amdgcn_rcpf(bflo(gd.w)); v1[3] *= bfhi(gr.w) * __builtin_amdgcn_rcpf(bfhi(gd.w)); }
                asm volatile("" ::: "memory"); }
    }
    __device__ __forceinline__ void operator()(const f32x4 (&acc)[2][2][4][2], const Unit& u, int wr, int wc, int fr, int fq) const {
        const int row0 = u.pm * BM + wr * 64 + fr, col0 = u.pn * BM + wc * 32 + 8 * fq;
#pragma unroll
        for (int ai = 0; ai < 2; ++ai)
#pragma unroll
            for (int m = 0; m < 4; ++m) { const size_t r = (size_t)(row0 + ai * HALF + m * 16);
#pragma unroll
                for (int bj = 0; bj < 2; ++bj) { const int c = col0 + bj * HALF;
                    const u32x4 gd = *(const u32x4*)(gates + r * 2048 + 1024 + c);
                    f32x4 v0 = acc[ai][bj][m][0], v1 = acc[ai][bj][m][1];
                    v0[0] *= bflo(gd.x); v0[1] *= bfhi(gd.x); v0[2] *= bflo(gd.y); v0[3] *= bfhi(gd.y); v1[0] *= bflo(gd.z); v1[1] *= bfhi(gd.z); v1[2] *= bflo(gd.w); v1[3] *= bfhi(gd.w);
                    u32x4 w; w.x = cvt_pk_bf16(v0[0], v0[1]); w.y = cvt_pk_bf16(v0[2], v0[3]); w.z = cvt_pk_bf16(v1[0], v1[1]); w.w = cvt_pk_bf16(v1[2], v1[3]);
                    *(u32x4*)(mixed + r * 1024 + c) = w; } }
    }
};
struct EpiRes {
    static constexpr bool PERM = true, AFTER_DRAIN = false, HAS_MID = false;
    const float* x; bf16_t* x1; float* ssq;
    __device__ __forceinline__ void operator()(const f32x4 (&acc)[2][2][4][2], const Unit& u, int wr, int wc, int fr, int fq) const {
        const int row0 = u.pm * BM + wr * 64 + fr, col0 = u.pn * BM + wc * 32 + 8 * fq;
#pragma unroll
        for (int ai = 0; ai < 2; ++ai)
#pragma unroll
            for (int m = 0; m < 4; ++m) { const size_t off = (size_t)(row0 + ai * HALF + m * 16) * 1024 + col0; float s = 0.f;
#pragma unroll
                for (int bj = 0; bj < 2; ++bj) { const f32x4 v0 = *(const f32x4*)(x + off + bj * HALF) + acc[ai][bj][m][0], v1 = *(const f32x4*)(x + off + bj * HALF + 4) + acc[ai][bj][m][1]; u32x4 w;
                    s += ((v0[0] * v0[0] + v0[1] * v0[1]) + (v0[2] * v0[2] + v0[3] * v0[3])) + ((v1[0] * v1[0] + v1[1] * v1[1]) + (v1[2] * v1[2] + v1[3] * v1[3]));
                    w.x = cvt_pk_bf16(v0[0], v0[1]); w.y = cvt_pk_bf16(v0[2], v0[3]); w.z = cvt_pk_bf16(v1[0], v1[1]); w.w = cvt_pk_bf16(v1[2], v1[3]);
                    *(u32x4*)(x1 + off + bj * HALF) = w; }
                s += __shfl_xor(s, 16); s = xhalf_sum(s);
                if (fq == 0) ssq[(size_t)(row0 + ai * HALF + m * 16) * 16 + u.pn * 4 + wc] = s; }
    }
};
struct EpiLogits {
    static constexpr bool PERM = false, AFTER_DRAIN = false, HAS_MID = false;
    float* L;
    __device__ __forceinline__ void operator()(const f32x4 (&acc)[2][2][4][2], const Unit& u, int wr, int wc, int fr, int fq) const {
        const int row0 = u.pm * BM + wr * 64 + fr, col0 = wc * 32 + 4 * fq;
#pragma unroll
        for (int ai = 0; ai < 2; ++ai)
#pragma unroll
            for (int m = 0; m < 4; ++m) { float* rowp = L + (size_t)(row0 + ai * HALF + m * 16) * 128 + col0;
#pragma unroll
                for (int n = 0; n < 2; ++n) *(f32x4*)(rowp + n * 16) = acc[ai][0][m][n]; }
    }
};
struct EpiAct {
    static constexpr bool PERM = true, AFTER_DRAIN = false, HAS_MID = false;
    bf16_t* act; const float* rowrs;
    __device__ __forceinline__ void operator()(const f32x4 (&acc)[2][2][4][2], const Unit& u, int wr, int wc, int fr, int fq) const {
        const int row0 = u.pm * BM + wr * 64 + fr, col0 = (u.pn & 3) * HALF + wc * 32 + 8 * fq;
#pragma unroll
        for (int ai = 0; ai < 2; ++ai)
#pragma unroll
            for (int m = 0; m < 4; ++m) { const int r = row0 + ai * HALF + m * 16; bf16_t* rowp = act + (size_t)r * 512 + col0; float o[8]; const float rs = rowrs[r];
#pragma unroll
                for (int n = 0; n < 2; ++n)
#pragma unroll
                    for (int e = 0; e < 4; ++e) { const float g = acc[ai][0][m][n][e] * rs, up = acc[ai][1][m][n][e] * rs; o[n * 4 + e] = g * sigm(g) * up; }
                u32x4 w; w.x = cvt_pk_bf16(o[0], o[1]); w.y = cvt_pk_bf16(o[2], o[3]); w.z = cvt_pk_bf16(o[4], o[5]); w.w = cvt_pk_bf16(o[6], o[7]);
                *(u32x4*)rowp = w; }
    }
};
struct EpiDown {
    static constexpr bool PERM = true, AFTER_DRAIN = false, HAS_MID = false;
    bf16_t* y2; const float* roww;
    __device__ __forceinline__ void operator()(const f32x4 (&acc)[2][2][4][2], const Unit& u, int wr, int wc, int fr, int fq) const {
        const int row0 = u.pm * BM + wr * 64 + fr, col0 = (u.pn & 3) * BM + wc * 32 + 8 * fq;
#pragma unroll
        for (int ai = 0; ai < 2; ++ai)
#pragma unroll
            for (int m = 0; m < 4; ++m) { const int r = row0 + ai * HALF + m * 16; const float w8 = roww[r]; bf16_t* rowp = y2 + (size_t)r * 1024 + col0;
#pragma unroll
                for (int bj = 0; bj < 2; ++bj) { const f32x4 v0 = acc[ai][bj][m][0] * w8, v1 = acc[ai][bj][m][1] * w8; u32x4 w;
                    w.x = cvt_pk_bf16(v0[0], v0[1]); w.y = cvt_pk_bf16(v0[2], v0[3]); w.z = cvt_pk_bf16(v1[0], v1[1]); w.w = cvt_pk_bf16(v1[2], v1[3]);
                    *(u32x4*)(rowp + bj * HALF) = w; } }
    }
};
struct EpiFinal {
    static constexpr bool PERM = true, AFTER_DRAIN = false, HAS_MID = false;
    const bf16_t* pp; const bf16_t* x2; float* out;
    __device__ __forceinline__ void operator()(const f32x4 (&acc)[2][2][4][2], const Unit& u, int wr, int wc, int fr, int fq) const {
        const int row0 = u.pm * BM + wr * 64 + fr, col0 = u.pn * BM + wc * 32 + 8 * fq;
#pragma unroll
        for (int ai = 0; ai < 2; ++ai)
#pragma unroll
            for (int m = 0; m < 4; ++m) { const size_t r = (size_t)(row0 + ai * HALF + m * 16);
#pragma unroll
                for (int bj = 0; bj < 2; ++bj) { const int c = col0 + bj * HALF;
                    const u32x4 pw = *(const u32x4*)(pp + r * 1024 + c), xw = *(const u32x4*)(x2 + r * 1024 + c); float* op = out + r * 1024 + c;
                    const f32x4 a0 = acc[ai][bj][m][0], a1 = acc[ai][bj][m][1]; f32x4 x0, x1;
                    x0[0] = bflo(xw.x) + sigm(a0[0]) * bflo(pw.x); x0[1] = bfhi(xw.x) + sigm(a0[1]) * bfhi(pw.x); x0[2] = bflo(xw.y) + sigm(a0[2]) * bflo(pw.y); x0[3] = bfhi(xw.y) + sigm(a0[3]) * bfhi(pw.y);
                    x1[0] = bflo(xw.z) + sigm(a1[0]) * bflo(pw.z); x1[1] = bfhi(xw.z) + sigm(a1[1]) * bfhi(pw.z); x1[2] = bflo(xw.w) + sigm(a1[2]) * bflo(pw.w); x1[3] = bfhi(xw.w) + sigm(a1[3]) * bfhi(pw.w);
                    *(f32x4*)op = x0; *(f32x4*)(op + 4) = x1; asm volatile("" ::: "memory"); } }
    }
};
struct EpiGates {
    static constexpr bool PERM = true, AFTER_DRAIN = false, HAS_MID = false;
    bf16_t* gates;
    __device__ __forceinline__ void operator()(const f32x4 (&acc)[2][2][4][2], const Unit& u, int wr, int wc, int fr, int fq) const {
        const int row0 = u.pm * BM + wr * 64 + fr, col0 = u.pn * BM + wc * 32 + 8 * fq;
#pragma unroll
        for (int ai = 0; ai < 2; ++ai)
#pragma unroll
            for (int m = 0; m < 4; ++m) { bf16_t* rowp = gates + (size_t)(row0 + ai * HALF + m * 16) * 2048 + col0;
#pragma unroll
                for (int bj = 0; bj < 2; ++bj) { f32x4 v0 = acc[ai][bj][m][0], v1 = acc[ai][bj][m][1]; u32x4 w;
#pragma unroll
                    for (int e = 0; e < 4; ++e) { v0[e] = fmaxf(sigm(v0[e]), 1e-6f); v1[e] = fmaxf(sigm(v1[e]), 1e-6f); }
                    w.x = cvt_pk_bf16(v0[0], v0[1]); w.y = cvt_pk_bf16(v0[2], v0[3]); w.z = cvt_pk_bf16(v1[0], v1[1]); w.w = cvt_pk_bf16(v1[2], v1[3]);
                    *(u32x4*)(rowp + bj * HALF) = w; } }
    }
};
struct OrderItem {
    int pm, pn0, n;
    __device__ __forceinline__ bool next(int i, Unit& u) const { if (i >= n) return false; u.pm = pm; u.pn = pn0 + i; return true; }
    __device__ __forceinline__ void a_ready(const Unit&) const {}
    __device__ __forceinline__ void done(const Unit&) const {}
};
struct OrderSkipV : StaticOrder {
    __device__ __forceinline__ bool next(int i, Unit& u) const { if (!StaticOrder::next(i, u)) return false; if (u.pn >= 11) u.pn += 2; return true; }
};
struct OrderPair : StaticOrder {
    __device__ __forceinline__ bool next(int i, Unit& u) const { if (!StaticOrder::next(i >> 1, u)) return false; if (i & 1) { u.pm += 128; u.pn += 4; } return true; }
};
struct OrderMoe {
    int nwg, G, c; const PG8_LAS int* tile_e;
    __device__ __forceinline__ bool next(int i, Unit& u) const { const long L = (long)i * G + c; if (L >= nwg) return false; const int rt = (int)(L >> 2); u.pm = rt; u.pn = tile_e[rt] * 4 + (int)(L & 3); return true; }
    __device__ __forceinline__ void a_ready(const Unit&) const {}
    __device__ __forceinline__ void done(const Unit&) const {}
};
}

struct Args { const float* in[36]; float* out; unsigned char* ws; int ph_lo, ph_hi; };

template <bool KG = false> __device__ __forceinline__ void tr_item(const float* W, int N, bf16* WT, int ld, int k0, int n0, size_t dst_row0, int k_off, LAS float* scr, int lane, const float* kg = nullptr) {
#pragma unroll 8
    for (int i = 0; i < 32; ++i) { const int kk = 2 * i + (lane >> 5); float w = W[(size_t)(k0 + kk) * N + n0 + (lane & 31)]; if (KG) w *= kg[k0 + kk]; scr[kk * 33 + (lane & 31)] = w; }
    LDS_WAIT(); asm volatile("" ::: "memory");
    const int c = lane & 7;
#pragma unroll
    for (int j = 0; j < 4; ++j) { const int n = (lane >> 3) + 8 * j; const LAS float* s = scr + (8 * c) * 33 + n;
        v4u o; o.x = pk2(s[0 * 33], s[1 * 33]); o.y = pk2(s[2 * 33], s[3 * 33]); o.z = pk2(s[4 * 33], s[5 * 33]); o.w = pk2(s[6 * 33], s[7 * 33]);
        *(v4u*)(WT + (dst_row0 + n) * ld + k_off + k0 + 8 * c) = o; }
    LDS_WAIT(); asm volatile("" ::: "memory");
}
__device__ __forceinline__ void tr_matrix(const float* W, int K, int N, bf16* WT, int ld, size_t dst_row0, int k_off, LAS float* scr, int lane, int gw, int NGW) {
    const int nblk = N / 32, nitems = (K / 64) * nblk;
    for (int it = gw; it < nitems; it += NGW) { const int kb = it / nblk, nb = it % nblk; tr_item(W, N, WT, ld, 64 * kb, 32 * nb, dst_row0 + 32 * nb, k_off, scr, lane); }
}
__device__ __forceinline__ void rms_row_to_bf16(const float* xrow, const float* gain, bf16* orow, int lane) {
    const f32x4* xr = (const f32x4*)xrow + lane; f32x4 v[4]; float s = 0.f;
#pragma unroll
    for (int j = 0; j < 4; ++j) { v[j] = xr[64 * j]; s += (v[j].x * v[j].x + v[j].y * v[j].y) + (v[j].z * v[j].z + v[j].w * v[j].w); }
    const float rstd = 1.0f / sqrtf(wave_sum(s) * (1.f / 1024.f) + 1e-6f);
    v2u* o8 = (v2u*)orow + lane;
#pragma unroll
    for (int j = 0; j < 4; ++j) { const f32x4 g = ((const f32x4*)gain)[lane + 64 * j]; v2u o; o.x = pk2(v[j].x * rstd * g.x, v[j].y * rstd * g.y); o.y = pk2(v[j].z * rstd * g.z, v[j].w * rstd * g.w); o8[64 * j] = o; }
}

__device__ __forceinline__ void phase0(const Args& a, LAS unsigned char* lds, int tid, int lane, int wave, int vcu, int G) {
    unsigned char* ws = a.ws;
    LAS float* scr = (LAS float*)(lds + wave * 16384);
    const int gw = vcu * NWAVES + wave, NGW = G * NWAVES; const int gt = vcu * NTHR + tid, NGT = G * NTHR;
    tr_matrix(a.in[3], 1024, NPROJ, (bf16*)(ws + WS_WIN), 1024, 0, 0, scr, lane, gw, NGW);
    tr_matrix(a.in[6], 64, 512, (bf16*)(ws + WS_WLORA), 256, 0, 0, scr, lane, gw, NGW);
    tr_matrix(a.in[8], 64, 512, (bf16*)(ws + WS_WLORA), 256, 512, 64, scr, lane, gw, NGW);
    tr_matrix(a.in[9], 128, 512, (bf16*)(ws + WS_WLORA), 256, 1024, 128, scr, lane, gw, NGW);
    tr_matrix(a.in[22], 512, 1024, (bf16*)(ws + WS_WBRD), 1024, 0, 0, scr, lane, gw, NGW);
    tr_matrix(a.in[23], 512, 1024, (bf16*)(ws + WS_WBRD), 1024, 0, 512, scr, lane, gw, NGW);
    tr_matrix(a.in[24], 1024, 1024, (bf16*)(ws + WS_WO), 1024, 0, 0, scr, lane, gw, NGW);
    tr_matrix(a.in[34], 1024, 1024, (bf16*)(ws + WS_WPG), 1024, 0, 0, scr, lane, gw, NGW);
    tr_matrix(a.in[35], 256, 1024, (bf16*)(ws + WS_WPP), 256, 0, 0, scr, lane, gw, NGW);
    { v4u* wl = (v4u*)(ws + WS_WLORA); const v4u z = (v4u){0u, 0u, 0u, 0u};
      for (int i = gt; i < 1536 * 32; i += NGT) { const int row = i >> 5, kc = (i & 31) * 8; const int blk = row >> 9;
          const bool diag = blk == 0 ? (kc < 64) : (blk == 1 ? (kc >= 64 && kc < 128) : (kc >= 128)); if (!diag) wl[i] = z; } }
    { bf16* wr = (bf16*)(ws + WS_WR); const float* wg = a.in[26]; const float* we = a.in[28];
      for (int i = gt; i < 256 * 1024; i += NGT) { const int row = i >> 10, kk = i & 1023; unsigned short v = 0;
          if (row < 36) v = (unsigned short)f2bf((row < 32 ? we[kk * 32 + row] : wg[kk * 4 + (row - 32)]) * a.in[25][kk]);
          wr[(size_t)row * 1024 + kk] = v; } }
    for (int m = gw; m < T; m += NGW) rms_row_to_bf16(a.in[0] + (size_t)m * DM, a.in[2], (bf16*)(ws + WS_XN) + (size_t)m * DM, lane);
}

__device__ __forceinline__ void phase2(const Args& a, LAS unsigned char* lds, int tid, int vcu, int G) {
    unsigned char* ws = a.ws;
    const bf16* projb = (const bf16*)(ws + WS_PROJB); const float* mu = a.in[4];
    bf16* la = (bf16*)((unsigned char*)a.out + OUT_LA);
    LAS float* cs = (LAS float*)lds;
    for (int tile = vcu; tile < T / 64; tile += G) {
        const int t0 = tile * 64;
        __syncthreads();
#pragma unroll
        for (int i = 0; i < 4; ++i) { const int idx = tid + 512 * i, tok = idx >> 5, i32 = idx & 31; const int s = (t0 + tok) & (SEQ - 1);
            const float inv = exp2f(-(float)i32 * (13.287712379549449f / 32.0f)); const float ang = (float)s * inv;
            const float rev = ang * 0.15915494309189535f, fr = rev - floorf(rev);
            cs[(tok * 32 + i32) * 2] = __builtin_amdgcn_cosf(fr); cs[(tok * 32 + i32) * 2 + 1] = __builtin_amdgcn_sinf(fr); }
#pragma unroll
        for (int i = 0; i < 4; ++i) { const int idx = tid + 512 * i, tok = idx >> 5, ch = idx & 31, t = t0 + tok, j0 = ch * 8; const bool first = (t & (SEQ - 1)) == 0;
            const v4u cur = *(const v4u*)(projb + (size_t)t * 1280 + j0); v4u prv = (v4u){0u, 0u, 0u, 0u}; if (!first) prv = *(const v4u*)(projb + (size_t)(t - 1) * 1280 + j0);
            const f32x4 m0 = *(const f32x4*)(mu + 1536 + j0), m1 = *(const f32x4*)(mu + 1536 + j0 + 4);
            float x[8]; const unsigned cw[4] = {cur.x, cur.y, cur.z, cur.w}, pw[4] = {prv.x, prv.y, prv.z, prv.w}; const float mm[8] = {m0.x, m0.y, m0.z, m0.w, m1.x, m1.y, m1.z, m1.w};
#pragma unroll
            for (int e = 0; e < 4; ++e) { const float c0 = bflo(cw[e]), c1 = bfhi(cw[e]), p0 = bflo(pw[e]), p1 = bfhi(pw[e]); x[2 * e] = c0 + (p0 - c0) * mm[2 * e]; x[2 * e + 1] = c1 + (p1 - c1) * mm[2 * e + 1]; }
            if (ch < 8) {
#pragma unroll
                for (int e = 0; e < 8; ++e) x[e] = tanhf(x[e]);
            } else if (ch >= 16) {
#pragma unroll
                for (int e = 0; e < 8; ++e) x[e] = sigm(x[e]);
            }
            v4u o; o.x = pk2(x[0], x[1]); o.y = pk2(x[2], x[3]); o.z = pk2(x[4], x[5]); o.w = pk2(x[6], x[7]);
            *(v4u*)(la + (size_t)t * 256 + j0) = o; }
        __syncthreads();
        for (int i = 0; i < 16; ++i) { const int idx = tid + 512 * i, tok = idx >> 7, grp = (idx >> 3) & 15, l8 = idx & 7, t = t0 + tok;
            const bf16* src = projb + (size_t)t * 1280 + 256 + grp * 64 + l8 * 4;
            const v2u wl = *(const v2u*)src, wh = *(const v2u*)(src + 32);
            float xl[4] = {bflo(wl.x), bfhi(wl.x), bflo(wl.y), bfhi(wl.y)}, xh[4] = {bflo(wh.x), bfhi(wh.x), bflo(wh.y), bfhi(wh.y)};
            float ss = 0.f;
#pragma unroll
            for (int e = 0; e < 4; ++e) ss += xl[e] * xl[e] + xh[e] * xh[e];
            ss = red8(ss);
            const float rs = (1.0f / sqrtf(ss * (1.f / 64.f) + 1e-6f)) * (grp < 8 ? C2 : 1.f);
            const float* gn = (grp < 8 ? a.in[15] : a.in[16]) + l8 * 4;
            const f32x4 gl = *(const f32x4*)gn, gh = *(const f32x4*)(gn + 32);
            float ol[4], oh[4];
#pragma unroll
            for (int e = 0; e < 4; ++e) { const float yl = xl[e] * rs * gl[e], yh = xh[e] * rs * gh[e]; const int ci = (tok * 32 + l8 * 4 + e) * 2; const float c = cs[ci], sn = cs[ci + 1];
                ol[e] = yl * c - yh * sn; oh[e] = yh * c + yl * sn; }
            const int b = t >> 12, s = t & (SEQ - 1); bf16* dst = (grp < 8 ? qn_ptr(ws, b) : kn_ptr(ws, b)) + ((size_t)(grp & 7) * SEQ + s) * 64 + l8 * 4;
            *(v2u*)dst = (v2u){pk2(ol[0], ol[1]), pk2(ol[2], ol[3])}; *(v2u*)(dst + 32) = (v2u){pk2(oh[0], oh[1]), pk2(oh[2], oh[3])}; }
    }
}

constexpr int SC_NB = 32, SC_REC = 392;
constexpr int SC_BUF = SC_NB * SC_REC * 4;
constexpr int SC_YOFF = 2 * SC_BUF;
struct ScanIn { v2u r0, k0, v0, r1, k1, v1, e, av; };
__device__ __forceinline__ void scan_unit(const Args& a, LAS unsigned char* lds, int tid, int unit) {
    unsigned char* ws = a.ws;
    const int bh = unit >> 1, half = unit & 1, b = bh >> 3, hd = bh & 7;
    const bf16* rkv = (const bf16*)(ws + WS_RKV); const bf16* E = (const bf16*)(ws + WS_E); const bf16* Aa = (const bf16*)(ws + WS_A);
    float* bon = (float*)(ws + WS_BON); bf16* Y = y_ptr(a.out, b);
    const int st = tid >> 4, c4 = tid & 15, ch = hd * 64 + c4 * 4;
    const f32x4 mur = *(const f32x4*)(a.in[4] + ch), muk = *(const f32x4*)(a.in[4] + 512 + ch), muv = *(const f32x4*)(a.in[4] + 1024 + ch);
    const f32x4 kkw = *(const f32x4*)(a.in[10] + ch), kaw = *(const f32x4*)(a.in[11] + ch), rkw = *(const f32x4*)(a.in[12] + ch);
    f32x4 sA = (f32x4){0.f, 0.f, 0.f, 0.f};
    const size_t tb = (size_t)b * SEQ;
    auto load_batch = [&](int s0, ScanIn& L) {
        const size_t t = tb + s0 + st; const bool first = (s0 + st) == 0;
        L.r0 = *(const v2u*)(rkv + t * 1536 + ch); L.k0 = *(const v2u*)(rkv + t * 1536 + 512 + ch); L.v0 = *(const v2u*)(rkv + t * 1536 + 1024 + ch);
        const size_t tp = first ? t : t - 1;
        L.r1 = *(const v2u*)(rkv + tp * 1536 + ch); L.k1 = *(const v2u*)(rkv + tp * 1536 + 512 + ch); L.v1 = *(const v2u*)(rkv + tp * 1536 + 1024 + ch);
        if (first) { L.r1 = (v2u){0u, 0u}; L.k1 = L.r1; L.v1 = L.r1; }
        L.e = *(const v2u*)(E + t * 512 + ch); L.av = *(const v2u*)(Aa + t * 512 + ch);
    };
    auto convert = [&](const ScanIn& L, int buf, int s0) {
        const unsigned r0w[2] = {L.r0.x, L.r0.y}, r1w[2] = {L.r1.x, L.r1.y}, k0w[2] = {L.k0.x, L.k0.y}, k1w[2] = {L.k1.x, L.k1.y}, v0w[2] = {L.v0.x, L.v0.y}, v1w[2] = {L.v1.x, L.v1.y};
        const unsigned ew[2] = {L.e.x, L.e.y}, aw[2] = {L.av.x, L.av.y};
        float r[4], k[4], v[4], e[4], av[4], kk[4];
#pragma unroll
        for (int i = 0; i < 4; ++i) { const int w = i >> 1; const bool hi = i & 1;
            const float rc = hi ? bfhi(r0w[w]) : bflo(r0w[w]), rp = hi ? bfhi(r1w[w]) : bflo(r1w[w]);
            const float kc = hi ? bfhi(k0w[w]) : bflo(k0w[w]), kp = hi ? bfhi(k1w[w]) : bflo(k1w[w]);
            const float vc = hi ? bfhi(v0w[w]) : bflo(v0w[w]), vp = hi ? bfhi(v1w[w]) : bflo(v1w[w]);
            r[i] = rc + (rp - rc) * mur[i]; k[i] = kc + (kp - kc) * muk[i]; v[i] = vc + (vp - vc) * muv[i];
            e[i] = hi ? bfhi(ew[w]) : bflo(ew[w]); av[i] = hi ? bfhi(aw[w]) : bflo(aw[w]);
            kk[i] = k[i] * kkw[i]; }
        const float ss = red16(kk[0] * kk[0] + kk[1] * kk[1] + kk[2] * kk[2] + kk[3] * kk[3]);
        const float inv = 1.0f / fmaxf(sqrtf(ss), 1e-12f);
        f32x4 w4, aa4, bb4, km4, wr4, vv4; float br = 0.f, kr = 0.f, bo = 0.f;
#pragma unroll
        for (int i = 0; i < 4; ++i) { const float kki = kk[i] * inv; const float km = k[i] * (1.0f + (av[i] - 1.0f) * kaw[i]); const float w = __expf(-e[i]);
            w4[i] = w; aa4[i] = -kki; bb4[i] = kki * av[i]; km4[i] = km; wr4[i] = w * r[i]; vv4[i] = v[i];
            br += bb4[i] * r[i]; kr += km * r[i]; bo += r[i] * km * rkw[i]; }
        br = red16(br); kr = red16(kr); bo = red16(bo);
        LAS float* rec = (LAS float*)(lds + buf * SC_BUF) + st * SC_REC + c4 * 4;
        *(LAS f32x4*)(rec) = w4; *(LAS f32x4*)(rec + 64) = aa4; *(LAS f32x4*)(rec + 128) = bb4; *(LAS f32x4*)(rec + 192) = km4; *(LAS f32x4*)(rec + 256) = wr4; *(LAS f32x4*)(rec + 320) = vv4;
        if (c4 == 0) { rec[384] = br; rec[385] = kr; if (half == 0) bon[(tb + s0 + st) * 8 + hd] = bo; }
    };
    auto write_out = [&](int bi) {
        typedef float f32x2 __attribute__((ext_vector_type(2)));
        const LAS float* yp = (const LAS float*)(lds + SC_YOFF) + (bi & 1) * (SC_NB * 32) + st * 32 + c4 * 2;
        const f32x2 yv = *(const LAS f32x2*)yp; *(unsigned*)(Y + (size_t)(bi * SC_NB + st) * 512 + hd * 64 + 32 * half + 2 * c4) = pk2(yv[0], yv[1]); };
    constexpr int NBATCH = SEQ / SC_NB;
    ScanIn L; load_batch(0, L);
    __syncthreads();
    convert(L, 0, 0);
    load_batch(SC_NB, L);
    __syncthreads();
    for (int bi = 0; bi < NBATCH; ++bi) {
        const int cur = bi & 1;
        if (bi + 1 < NBATCH) convert(L, cur ^ 1, (bi + 1) * SC_NB);
        if (bi + 2 < NBATCH) load_batch((bi + 2) * SC_NB, L);
        if (bi > 0) write_out(bi - 1);
        LAS float* ybuf = (LAS float*)(lds + SC_YOFF) + cur * (SC_NB * 32);
        const LAS float* base = (const LAS float*)(lds + cur * SC_BUF) + c4 * 4;
        const LAS float* vbase = (const LAS float*)(lds + cur * SC_BUF) + 320 + 32 * half + st;
        const LAS float* sbase = (const LAS float*)(lds + cur * SC_BUF) + 384;
        f32x4 nw = *(const LAS f32x4*)(base), na = *(const LAS f32x4*)(base + 64), nb = *(const LAS f32x4*)(base + 128), nk = *(const LAS f32x4*)(base + 192), nq = *(const LAS f32x4*)(base + 256);
        float nvA = vbase[0]; typedef float f32x2 __attribute__((ext_vector_type(2))); f32x2 ns = *(const LAS f32x2*)(sbase);
        float ykA = 0.f;
#pragma unroll
        for (int i = 0; i < SC_NB; ++i) {
            const f32x4 w4 = nw, a4 = na, b4 = nb, k4 = nk, q4 = nq; const float vA = nvA, br = ns[0], kr = ns[1];
            if (i + 1 < SC_NB) { const LAS float* rec = base + (i + 1) * SC_REC;
                nw = *(const LAS f32x4*)(rec); na = *(const LAS f32x4*)(rec + 64); nb = *(const LAS f32x4*)(rec + 128); nk = *(const LAS f32x4*)(rec + 192); nq = *(const LAS f32x4*)(rec + 256);
                nvA = vbase[(i + 1) * SC_REC]; ns = *(const LAS f32x2*)(sbase + (i + 1) * SC_REC); }
            float saA = fmaf(sA[0], a4[0], fmaf(sA[1], a4[1], fmaf(sA[2], a4[2], sA[3] * a4[3])));
            float zA = fmaf(sA[0], q4[0], fmaf(sA[1], q4[1], fmaf(sA[2], q4[2], sA[3] * q4[3])));
            saA = red16(saA); zA = red16(zA);
            const float yA = zA + saA * br + vA * kr;
            ykA = (c4 == (i & 15)) ? yA : ykA;
            sA = sA * w4 + saA * b4 + vA * k4;
            if ((i & 15) == 15) ybuf[(i - 15 + c4) * 32 + st] = ykA;
        }
        __syncthreads();
    }
    write_out(NBATCH - 1);
}
namespace wkv {
constexpr int P = 144, PF = 272, U = 64 * P  , F = 64 * PF  ;
constexpr int O_S = 0, O_B = F;
constexpr int O_AT = O_B + 0 * U, O_BTL = O_B + 1 * U, O_KTL = O_B + 2 * U, O_RT = O_B + 3 * U, O_BHT = O_B + 4 * U, O_KHT = O_B + 5 * U, O_VRT = O_B + 6 * U, O_RHST = O_B + 7 * U  , O_MABH = O_B + 9 * U, O_MRB = O_B + 10 * U, O_MRK = O_B + 11 * U, O_Z2 = O_B + 12 * U;
constexpr int O_XT = O_AT  , O_G1 = O_MABH, O_Z1 = O_KTL, O_G2 = O_RHST  , O_EP = O_Z2  ;
constexpr int O_END = O_B + 13 * U;
constexpr int PO = 80, O_OUTB = O_END  , O_TII = O_OUTB + 8 * 16 * PO  , O_DIAG = O_TII + 4 * 16 * PO  , O_GC = O_DIAG + 4096  , O_CONST = O_GC + 256  , O_TOP = O_CONST + 1536;
static_assert(O_TOP <= 158720, "wkv LDS map");
typedef short bf16x8 __attribute__((ext_vector_type(8)));
__device__ __forceinline__ f32x4 mfma16(bf16x8 a, bf16x8 b, f32x4 c) { return __builtin_amdgcn_mfma_f32_16x16x32_bf16(a, b, c, 0, 0, 0); }
template <int K> __device__ __forceinline__ f32x4 mm_blk(LAS unsigned char* lds, int aoff, int pa, int boff, int pb, int m0, int n0, int lane, f32x4 acc) {
    const int r = lane & 15, kg = lane >> 4;
#pragma unroll
    for (int ks = 0; ks < K / 32; ++ks) { const bf16x8 a = *(const LAS bf16x8*)(lds + aoff + (m0 + r) * pa + (32 * ks + 8 * kg) * 2); const bf16x8 b = *(const LAS bf16x8*)(lds + boff + (n0 + r) * pb + (32 * ks + 8 * kg) * 2); acc = mfma16(a, b, acc); }
    return acc;
}
__device__ __forceinline__ void split8(const LAS float* p, bf16x8& hi, bf16x8& lo) {
    const f32x4 x0 = *(const LAS f32x4*)p, x1 = *(const LAS f32x4*)(p + 4); const float x[8] = {x0[0], x0[1], x0[2], x0[3], x1[0], x1[1], x1[2], x1[3]}; unsigned h[8], l[8];
#pragma unroll
    for (int i = 0; i < 8; ++i) { h[i] = f2bf(x[i]); l[i] = f2bf(x[i] - __builtin_bit_cast(float, h[i] << 16)); }
    hi = (bf16x8){(short)h[0], (short)h[1], (short)h[2], (short)h[3], (short)h[4], (short)h[5], (short)h[6], (short)h[7]}; lo = (bf16x8){(short)l[0], (short)l[1], (short)l[2], (short)l[3], (short)l[4], (short)l[5], (short)l[6], (short)l[7]};
}
__device__ __forceinline__ void st_bf(LAS unsigned char* lds, int off, float v) { *(LAS unsigned short*)(lds + off) = (unsigned short)f2bf(v); }
__device__ __forceinline__ float ld_bf(const LAS unsigned char* lds, int off) { return __builtin_bit_cast(float, (unsigned)*(const LAS unsigned short*)(lds + off) << 16); }
struct Raw { v4u r0, k0, v0, r1, k1, v1, e, av; };
}
__device__ __forceinline__ void st4_bf(LAS unsigned char* lds, int off, f32x4 v) { *(LAS v2u*)(lds + off) = (v2u){pk2(v[0], v[1]), pk2(v[2], v[3])}; }
__device__ __forceinline__ f32x4 ld4_bf(const LAS unsigned char* lds, int off) { const v2u w = *(const LAS v2u*)(lds + off); return (f32x4){bflo(w.x), bfhi(w.x), bflo(w.y), bfhi(w.y)}; }
__device__ __forceinline__ wkv::bf16x8 ident_frag(int n, int ks, int kg) { wkv::bf16x8 f; const int k0 = 32 * ks + 8 * kg;
#pragma unroll
    for (int j = 0; j < 8; ++j) f[j] = (k0 + j == n) ? (short)0x3F80 : (short)0; return f; }
__device__ __forceinline__ void scan_unit_chunked(const Args& a, LAS unsigned char* lds, int tid, int bh) {
    using namespace wkv;
    unsigned char* ws = a.ws;
    const int b = bh >> 3, hd = bh & 7, wave = __builtin_amdgcn_readfirstlane(tid >> 6);
    const bf16* rkv = (const bf16*)(ws + WS_RKV); const bf16* E = (const bf16*)(ws + WS_E); const bf16* Aa = (const bf16*)(ws + WS_A);
    float* bon = (float*)(ws + WS_BON); bf16* Y = y_ptr(a.out, b);
    const size_t tb = (size_t)b * SEQ;
    int oz = 0;
#define WKV_TAINT() asm volatile("" : "+v"(oz))
    const int gch = hd * 64 + (tid & 7) * 8;
    if (tid < 384) { const int vsel = tid >> 6, cc = tid & 63; const float* src = vsel == 0 ? a.in[4] : vsel == 1 ? a.in[4] + 512 : vsel == 2 ? a.in[4] + 1024 : vsel == 3 ? a.in[10] : vsel == 4 ? a.in[11] : a.in[12];
        ((LAS float*)(lds + O_CONST))[vsel * 64 + cc] = src[hd * 64 + cc]; }
    auto load_raw = [&](int c, Raw& L) { const int tt = tid >> 3; const size_t t = tb + c * 64 + tt; const bool first = (c * 64 + tt) == 0; const size_t tp = first ? t : t - 1;
        L.r0 = *(const v4u*)(rkv + t * 1536 + gch); L.k0 = *(const v4u*)(rkv + t * 1536 + 512 + gch); L.v0 = *(const v4u*)(rkv + t * 1536 + 1024 + gch);
        L.r1 = *(const v4u*)(rkv + tp * 1536 + gch); L.k1 = *(const v4u*)(rkv + tp * 1536 + 512 + gch); L.v1 = *(const v4u*)(rkv + tp * 1536 + 1024 + gch);
        if (first) { L.r1 = (v4u){0u, 0u, 0u, 0u}; L.k1 = L.r1; L.v1 = L.r1; }
        L.e = *(const v4u*)(E + t * 512 + gch); L.av = *(const v4u*)(Aa + t * 512 + gch); };
    const int mb = wave >> 1, nb0 = (wave & 1) * 2;
    WKV_TAINT();
#pragma unroll 1
    for (int i = tid + oz; i < 64 * 64; i += NTHR) *(LAS float*)(lds + O_S + (i >> 6) * PF + (i & 63) * 4) = 0.f;
#if defined(PROBE_PHASE) && PROBE_PHASE >= 300 && PROBE_PHASE < 310
    unsigned long long tlast = __builtin_amdgcn_s_memrealtime(); unsigned tacc[6] = {0u, 0u, 0u, 0u, 0u, 0u};
#define WKV_STAMP(k) do { const unsigned long long tn = __builtin_amdgcn_s_memrealtime(); tacc[k] += (unsigned)(tn - tlast); tlast = tn; } while (0)
#else
#define WKV_STAMP(k) do { } while (0)
#endif
    Raw L; load_raw(0, L);
    for (int c = 0; c < SEQ / 64; ++c) {
        __syncthreads();
        WKV_TAINT(); const int td0 = tid + oz, tt = td0 >> 3, kq = td0 & 7, ch0 = kq * 8;
        float e8[8], lr8[8], r8[8], k8[8], v8[8];
        { const unsigned ew[4] = {L.e.x, L.e.y, L.e.z, L.e.w}, aw[4] = {L.av.x, L.av.y, L.av.z, L.av.w};
          const unsigned r0[4] = {L.r0.x, L.r0.y, L.r0.z, L.r0.w}, r1[4] = {L.r1.x, L.r1.y, L.r1.z, L.r1.w}, k0[4] = {L.k0.x, L.k0.y, L.k0.z, L.k0.w}, k1[4] = {L.k1.x, L.k1.y, L.k1.z, L.k1.w}, v0[4] = {L.v0.x, L.v0.y, L.v0.z, L.v0.w}, v1[4] = {L.v1.x, L.v1.y, L.v1.z, L.v1.w};
#pragma unroll
          for (int i = 0; i < 8; ++i) { const int w = i >> 1; const bool hi = i & 1;
              e8[i] = hi ? bfhi(ew[w]) : bflo(ew[w]); lr8[i] = hi ? bfhi(aw[w]) : bflo(aw[w]);
              const float rc = hi ? bfhi(r0[w]) : bflo(r0[w]), rp = hi ? bfhi(r1[w]) : bflo(r1[w]), kc = hi ? bfhi(k0[w]) : bflo(k0[w]), kp = hi ? bfhi(k1[w]) : bflo(k1[w]), vc = hi ? bfhi(v0[w]) : bflo(v0[w]), vp = hi ? bfhi(v1[w]) : bflo(v1[w]);
              const LAS float* cst = (const LAS float*)(lds + O_CONST) + ch0 + i;
              r8[i] = rc + (rp - rc) * cst[0]; k8[i] = kc + (kp - kc) * cst[64]; v8[i] = vc + (vp - vc) * cst[128]; } }
        if (c + 1 < SEQ / 64) load_raw(c + 1, L);
        { LAS float* ep = (LAS float*)(lds + O_EP) + tt * 68 + ch0; *(LAS f32x4*)ep = (f32x4){e8[0], e8[1], e8[2], e8[3]}; *(LAS f32x4*)(ep + 4) = (f32x4){e8[4], e8[5], e8[6], e8[7]}; }
        __syncthreads();
        { const int k = td0 & 63, seg = td0 >> 6; LAS float* col = (LAS float*)(lds + O_EP) + (seg * 8) * 68 + k; float pre[8], run = 0.f;
#pragma unroll
          for (int i = 0; i < 8; ++i) { run += col[i * 68]; pre[i] = run; }
          LAS float* tots = (LAS float*)(lds + O_EP) + 64 * 68;
          tots[seg * 64 + k] = run;
          __syncthreads();
          float base = 0.f;
#pragma unroll
          for (int s2 = 0; s2 < 7; ++s2) base += (s2 < seg) ? tots[s2 * 64 + k] : 0.f;
#pragma unroll
          for (int i = 0; i < 8; ++i) col[i * 68] = pre[i] + base; }
        __syncthreads();
        float ce[8], cep[8], cec[8];
        { const LAS float* epb = (const LAS float*)(lds + O_EP);
          const f32x4 c0 = *(const LAS f32x4*)(epb + tt * 68 + ch0), c1 = *(const LAS f32x4*)(epb + tt * 68 + ch0 + 4);
          const int tq = tt > 0 ? tt - 1 : 0; f32x4 p0 = *(const LAS f32x4*)(epb + tq * 68 + ch0), p1 = *(const LAS f32x4*)(epb + tq * 68 + ch0 + 4); if (tt == 0) { p0 = (f32x4){0.f, 0.f, 0.f, 0.f}; p1 = p0; }
          const f32x4 q0 = *(const LAS f32x4*)(epb + 63 * 68 + ch0), q1 = *(const LAS f32x4*)(epb + 63 * 68 + ch0 + 4);
#pragma unroll
          for (int i = 0; i < 4; ++i) { ce[i] = c0[i]; ce[4 + i] = c1[i]; cep[i] = p0[i]; cep[4 + i] = p1[i]; cec[i] = q0[i]; cec[4 + i] = q1[i]; } }
        { float kk[8], ss = 0.f;
#pragma unroll
          for (int i = 0; i < 8; ++i) { kk[i] = k8[i] * ((const LAS float*)(lds + O_CONST))[192 + ch0 + i]; ss += kk[i] * kk[i]; }
          ss = red8(ss); const float inv = 1.0f / fmaxf(sqrtf(ss), 1e-12f);
          float at[8], bt[8], kt[8], rt[8], bh8[8], kh8[8], bo = 0.f;
#pragma unroll
          for (int i = 0; i < 8; ++i) { const float kaw_i = ((const LAS float*)(lds + O_CONST))[256 + ch0 + i], rkw_i = ((const LAS float*)(lds + O_CONST))[320 + ch0 + i];
              const float kki = kk[i] * inv, km = k8[i] * (1.0f + (lr8[i] - 1.0f) * kaw_i), bbv = kki * lr8[i];
              const float gp = __expf(-cep[i]), gi = __expf(ce[i]), gt = __expf(-ce[i]), gcj = __expf(ce[i] - cec[i]);
              at[i] = -kki * gp; bt[i] = bbv * gi; kt[i] = km * gi; rt[i] = r8[i] * gt; bh8[i] = bbv * gcj; kh8[i] = km * gcj; bo += r8[i] * km * rkw_i; }
          bo = red8(bo);
          if (kq == 0) bon[(tb + c * 64 + tt) * 8 + hd] = bo;
          if (tt == 63) { LAS float* gc = (LAS float*)(lds + O_GC) + ch0;
#pragma unroll
              for (int i = 0; i < 8; ++i) gc[i] = __expf(-cec[i]); }
          const int ro = tt * P + ch0 * 2;
          *(LAS v4u*)(lds + O_AT + ro) = (v4u){pk2(at[0], at[1]), pk2(at[2], at[3]), pk2(at[4], at[5]), pk2(at[6], at[7])};
          *(LAS v4u*)(lds + O_BTL + ro) = (v4u){pk2(bt[0], bt[1]), pk2(bt[2], bt[3]), pk2(bt[4], bt[5]), pk2(bt[6], bt[7])};
          *(LAS v4u*)(lds + O_KTL + ro) = (v4u){pk2(kt[0], kt[1]), pk2(kt[2], kt[3]), pk2(kt[4], kt[5]), pk2(kt[6], kt[7])};
          *(LAS v4u*)(lds + O_RT + ro) = (v4u){pk2(rt[0], rt[1]), pk2(rt[2], rt[3]), pk2(rt[4], rt[5]), pk2(rt[6], rt[7])};
          *(LAS v4u*)(lds + O_MABH + ro) = (v4u){pk2(bh8[0], bh8[1]), pk2(bh8[2], bh8[3]), pk2(bh8[4], bh8[5]), pk2(bh8[6], bh8[7])};
          *(LAS v4u*)(lds + O_MRB + ro) = (v4u){pk2(kh8[0], kh8[1]), pk2(kh8[2], kh8[3]), pk2(kh8[4], kh8[5]), pk2(kh8[6], kh8[7])};
          *(LAS v4u*)(lds + O_MRK + ro) = (v4u){pk2(v8[0], v8[1]), pk2(v8[2], v8[3]), pk2(v8[4], v8[5]), pk2(v8[6], v8[7])}; }
        __syncthreads();
        { WKV_TAINT(); const int lane = (tid & 63) + oz, c16 = lane & 15, rg = lane >> 4;
#pragma unroll
          for (int j = 0; j < 2; ++j) { const int nb = nb0 + j; f32x4 d0 = (f32x4){0.f, 0.f, 0.f, 0.f}, d1 = d0, d2 = d0, d3 = d0;
#pragma unroll
              for (int ks = 0; ks < 2; ++ks) { const bf16x8 idf = ident_frag(16 * nb + c16, ks, rg); const int ao = (16 * mb + c16) * P + (32 * ks + 8 * rg) * 2;
                  d0 = mfma16(*(const LAS bf16x8*)(lds + O_AT + ao), idf, d0); d1 = mfma16(*(const LAS bf16x8*)(lds + O_MABH + ao), idf, d1);
                  d2 = mfma16(*(const LAS bf16x8*)(lds + O_MRB + ao), idf, d2); d3 = mfma16(*(const LAS bf16x8*)(lds + O_MRK + ao), idf, d3); }
              const int to = (16 * nb + c16) * P + (16 * mb + 4 * rg) * 2;
              st4_bf(lds, O_RHST + to, d0); st4_bf(lds, O_BHT + to, d1); st4_bf(lds, O_KHT + to, d2); st4_bf(lds, O_VRT + to, d3); } }
        __syncthreads(); WKV_STAMP(0);
        { WKV_TAINT(); const int lane = (tid & 63) + oz, c16 = lane & 15, rg = lane >> 4; f32x4 acc[4][2];
#pragma unroll
          for (int j = 0; j < 2; ++j) { const int nb = nb0 + j; const f32x4 z = (f32x4){0.f, 0.f, 0.f, 0.f};
              acc[0][j] = mm_blk<64>(lds, O_BTL, P, O_AT, P, 16 * mb, 16 * nb, lane, z);
              acc[1][j] = mm_blk<64>(lds, O_AT, P, O_KTL, P, 16 * mb, 16 * nb, lane, z);
              acc[2][j] = mm_blk<64>(lds, O_BTL, P, O_RT, P, 16 * mb, 16 * nb, lane, z);
              acc[3][j] = mm_blk<64>(lds, O_KTL, P, O_RT, P, 16 * mb, 16 * nb, lane, z); }
#pragma unroll
          for (int j = 0; j < 2; ++j) { const int nb = nb0 + j, n = 16 * nb + c16, m0 = 16 * mb + 4 * rg; f32x4 mab, mak, mrb, mrk;
#pragma unroll
              for (int e = 0; e < 4; ++e) { const int m = m0 + e; mab[e] = m < n ? acc[0][j][e] : 0.f; mak[e] = n < m ? acc[1][j][e] : 0.f; mrb[e] = m <= n ? acc[2][j][e] : 0.f; mrk[e] = m <= n ? acc[3][j][e] : 0.f; }
              st4_bf(lds, O_MABH + n * P + m0 * 2, mab);
              if (mb == nb) *(LAS f32x4*)(lds + O_DIAG + ((mb * 16 + c16) * 16 + 4 * rg) * 4) = mab;
              st4_bf(lds, O_RHST + U + n * P + m0 * 2, mak);
              st4_bf(lds, O_MRB + n * P + m0 * 2, mrb); st4_bf(lds, O_MRK + n * P + m0 * 2, mrk); } }
        __syncthreads(); WKV_STAMP(1);
        WKV_TAINT();
        if (tid < 64) { const int td2 = tid + oz, blk = td2 >> 4, cc = td2 & 15; const LAS float* D = (const LAS float*)(lds + O_DIAG) + blk * 256; float Tc[16];
#pragma unroll
            for (int r4 = 0; r4 < 4; ++r4) { f32x4 dr[4][4];
#pragma unroll
                for (int rr = 0; rr < 4; ++rr)
#pragma unroll
                    for (int q = 0; q <= r4; ++q) dr[rr][q] = *(const LAS f32x4*)(D + (4 * r4 + rr) * 16 + 4 * q);
#pragma unroll
                for (int rr = 0; rr < 4; ++rr) { const int r = 4 * r4 + rr; float sacc = (r == cc) ? 1.f : 0.f;
#pragma unroll
                    for (int j = 0; j < r; ++j) sacc += dr[rr][j >> 2][j & 3] * Tc[j];
                    Tc[r] = sacc; } }
#pragma unroll
            for (int r4 = 0; r4 < 4; ++r4) { const f32x4 tv = (f32x4){Tc[4 * r4], Tc[4 * r4 + 1], Tc[4 * r4 + 2], Tc[4 * r4 + 3]};
                (void)tv; }
#pragma unroll
            for (int r = 0; r < 16; ++r) { st_bf(lds, O_TII + (blk * 16 + r) * PO + cc * 2, Tc[r]); st_bf(lds, O_TII + (blk * 16 + r) * PO + (16 + cc) * 2, 0.f); } }
        { const int lane = (tid & 63) + oz; const v4u z = (v4u){0u, 0u, 0u, 0u};
#pragma unroll
          for (int i = 0; i < 3; ++i) { const int idx = lane + 64 * i; if (idx < 16 * 9) *(LAS v4u*)(lds + O_XT + (16 * wave + idx / 9) * P + (idx % 9) * 16) = z; }
          if (lane < 32) *(LAS v4u*)(lds + O_OUTB + wave * 16 * PO + (lane >> 1) * PO + 32 + (lane & 1) * 16) = z; }
        __syncthreads(); WKV_STAMP(2);
#pragma unroll 1
        for (int i = 0; i < 4; ++i) { WKV_TAINT(); const int lane = (tid & 63) + oz, c16 = lane & 15, rg = lane >> 4;
            f32x4 acc = (f32x4){0.f, 0.f, 0.f, 0.f};
            if (i > 0) acc = mm_blk<64>(lds, O_MABH, P, O_XT, P, 16 * i, 16 * wave, lane, acc);
            acc += ld4_bf(lds, O_RHST + (16 * wave + c16) * P + (16 * i + 4 * rg) * 2);
            st4_bf(lds, O_OUTB + wave * 16 * PO + c16 * PO + (4 * rg) * 2, acc);
            LDS_WAIT();
            f32x4 x = mm_blk<32>(lds, O_TII + i * 16 * PO, PO, O_OUTB + wave * 16 * PO, PO, 0, 0, lane, (f32x4){0.f, 0.f, 0.f, 0.f});
            st4_bf(lds, O_XT + (16 * wave + c16) * P + (16 * i + 4 * rg) * 2, x);
            LDS_WAIT();
        }
        __syncthreads(); WKV_STAMP(3);
        { WKV_TAINT(); const int lane = (tid & 63) + oz, c16 = lane & 15, rg = lane >> 4; f32x4 acc[4][2];
#pragma unroll
          for (int j = 0; j < 2; ++j) { const int nb = nb0 + j; const f32x4 z = (f32x4){0.f, 0.f, 0.f, 0.f};
              acc[0][j] = mm_blk<64>(lds, O_XT, P, O_MRB, P, 16 * mb, 16 * nb, lane, z);
              acc[1][j] = mm_blk<64>(lds, O_XT + U, P, O_MRB, P, 16 * mb, 16 * nb, lane, z);
              acc[2][j] = mm_blk<64>(lds, O_XT, P, O_BHT, P, 16 * mb, 16 * nb, lane, z);
              acc[3][j] = mm_blk<64>(lds, O_XT + U, P, O_BHT, P, 16 * mb, 16 * nb, lane, z); }
#pragma unroll
          for (int j = 0; j < 2; ++j) { const int n = 16 * (nb0 + j) + c16, m0 = 16 * mb + 4 * rg; const int o = n * P + m0 * 2;
              acc[0][j] += ld4_bf(lds, O_RT + o); acc[1][j] += ld4_bf(lds, O_MRK + o); acc[3][j] += ld4_bf(lds, O_KHT + o);
              if (n >= m0 && n < m0 + 4) acc[2][j][n - m0] += *(const LAS float*)(lds + O_GC + n * 4); }
          __syncthreads();
#pragma unroll
          for (int j = 0; j < 2; ++j) { const int n = 16 * (nb0 + j) + c16, m0 = 16 * mb + 4 * rg; const int o = n * P + m0 * 2;
              st4_bf(lds, O_G1 + o, acc[0][j]); st4_bf(lds, O_Z1 + o, acc[1][j]); st4_bf(lds, O_Z2 + o, acc[3][j]);
              f32x4 hi4, lo4;
#pragma unroll
              for (int e = 0; e < 4; ++e) { hi4[e] = __builtin_bit_cast(float, f2bf(acc[2][j][e]) << 16); lo4[e] = acc[2][j][e] - hi4[e]; }
              st4_bf(lds, O_RT + o, hi4); st4_bf(lds, O_KHT + o, lo4); } }
        { WKV_TAINT(); const int td5 = tid + oz, v = td5 >> 3, kq5 = (td5 & 7) * 8; const LAS float* sp = (const LAS float*)(lds + O_S + v * PF) + kq5;
          const f32x4 x0 = *(const LAS f32x4*)sp, x1 = *(const LAS f32x4*)(sp + 4); f32x4 h0, h1, l0, l1;
#pragma unroll
          for (int e = 0; e < 4; ++e) { h0[e] = __builtin_bit_cast(float, f2bf(x0[e]) << 16); l0[e] = x0[e] - h0[e]; h1[e] = __builtin_bit_cast(float, f2bf(x1[e]) << 16); l1[e] = x1[e] - h1[e]; }
          st4_bf(lds, O_MRB + v * P + kq5 * 2, h0); st4_bf(lds, O_MRB + v * P + kq5 * 2 + 8, h1); st4_bf(lds, O_MRK + v * P + kq5 * 2, l0); st4_bf(lds, O_MRK + v * P + kq5 * 2 + 8, l1); }
        __syncthreads(); WKV_STAMP(4);
        { WKV_TAINT(); const int lane = (tid & 63) + oz, c16 = lane & 15, rg = lane >> 4; f32x4 ay[2], as[2];
#pragma unroll
          for (int j = 0; j < 2; ++j) { const int nb = nb0 + j; const f32x4 z = (f32x4){0.f, 0.f, 0.f, 0.f};
              ay[j] = mm_blk<64>(lds, O_VRT, P, O_Z1, P, 16 * mb, 16 * nb, lane, z);
              ay[j] = mm_blk<64>(lds, O_MRB, P, O_G1, P, 16 * mb, 16 * nb, lane, ay[j]);
              ay[j] = mm_blk<64>(lds, O_MRK, P, O_G1, P, 16 * mb, 16 * nb, lane, ay[j]);
              as[j] = mm_blk<64>(lds, O_Z2, P, O_VRT, P, 16 * mb, 16 * nb, lane, z);
              as[j] = mm_blk<64>(lds, O_RT, P, O_MRB, P, 16 * mb, 16 * nb, lane, as[j]);
              as[j] = mm_blk<64>(lds, O_KHT, P, O_MRB, P, 16 * mb, 16 * nb, lane, as[j]);
              as[j] = mm_blk<64>(lds, O_RT, P, O_MRK, P, 16 * mb, 16 * nb, lane, as[j]); }
#pragma unroll
          for (int j = 0; j < 2; ++j) { const int t = 16 * (nb0 + j) + c16, v0 = 16 * mb + 4 * rg;
              *(v2u*)(Y + (size_t)(c * 64 + t) * 512 + hd * 64 + v0) = (v2u){pk2(ay[j][0], ay[j][1]), pk2(ay[j][2], ay[j][3])};
              *(LAS f32x4*)(lds + O_S + t * PF + v0 * 4) = as[j]; } }
        WKV_STAMP(5);
    }
#if defined(PROBE_PHASE) && PROBE_PHASE >= 300 && PROBE_PHASE < 310
    if (tid == 0) atomicAdd((unsigned*)(ws + WS_CTL) + 96, tacc[PROBE_PHASE - 300]);
#endif
}
__device__ __forceinline__ void phase_orw(const Args& a, int lane, int wave, int vcu, int G) {
    unsigned char* ws = a.ws;
    const int gw = vcu * NWAVES + wave, NGW = G * NWAVES;
    const bf16* rkv = (const bf16*)(ws + WS_RKV); const bf16* Gg = (const bf16*)(ws + WS_G); const float* bon = (const float*)(ws + WS_BON);
    bf16* orw = (bf16*)((unsigned char*)a.out + OUT_ORWDF);
    const int ch = lane * 8;
    const f32x4 mv0 = *(const f32x4*)(a.in[4] + 1024 + ch), mv1 = *(const f32x4*)(a.in[4] + 1024 + ch + 4);
    const f32x4 lw0 = *(const f32x4*)(a.in[13] + ch), lw1 = *(const f32x4*)(a.in[13] + ch + 4), lb0 = *(const f32x4*)(a.in[14] + ch), lb1 = *(const f32x4*)(a.in[14] + ch + 4);
    const float muv[8] = {mv0[0], mv0[1], mv0[2], mv0[3], mv1[0], mv1[1], mv1[2], mv1[3]}, lnw[8] = {lw0[0], lw0[1], lw0[2], lw0[3], lw1[0], lw1[1], lw1[2], lw1[3]}, lnb[8] = {lb0[0], lb0[1], lb0[2], lb0[3], lb1[0], lb1[1], lb1[2], lb1[3]};
    for (int t = gw; t < T; t += NGW) {
        const int b = t >> 12, s = t & (SEQ - 1); const v4u yw = *(const v4u*)(y_ptr(a.out, b) + (size_t)s * 512 + ch);
        const f32x4 y0 = (f32x4){bflo(yw.x), bfhi(yw.x), bflo(yw.y), bfhi(yw.y)}, y1 = (f32x4){bflo(yw.z), bfhi(yw.z), bflo(yw.w), bfhi(yw.w)};
        const v4u vc = *(const v4u*)(rkv + (size_t)t * 1536 + 1024 + ch); v4u vp = (v4u){0u, 0u, 0u, 0u}; if (s != 0) vp = *(const v4u*)(rkv + (size_t)(t - 1) * 1536 + 1024 + ch);
        const v4u gw4 = *(const v4u*)(Gg + (size_t)t * 512 + ch); const float bo = bon[(size_t)t * 8 + (lane >> 3)];
        float y[8] = {y0[0], y0[1], y0[2], y0[3], y1[0], y1[1], y1[2], y1[3]};
        float sm = 0.f;
#pragma unroll
        for (int e = 0; e < 8; ++e) sm += y[e];
        const float mean = red8(sm) * (1.f / 64.f); float vs = 0.f;
#pragma unroll
        for (int e = 0; e < 8; ++e) { y[e] -= mean; vs += y[e] * y[e]; }
        const float rstd = 1.0f / sqrtf(red8(vs) * (1.f / 64.f) + 64e-5f);
        const unsigned vcw[4] = {vc.x, vc.y, vc.z, vc.w}, vpw[4] = {vp.x, vp.y, vp.z, vp.w}, gww[4] = {gw4.x, gw4.y, gw4.z, gw4.w}; float o[8];
#pragma unroll
        for (int e = 0; e < 8; ++e) { const int w = e >> 1; const bool hi = e & 1; const float c = hi ? bfhi(vcw[w]) : bflo(vcw[w]), p = hi ? bfhi(vpw[w]) : bflo(vpw[w]), g = hi ? bfhi(gww[w]) : bflo(gww[w]);
            const float v = c + (p - c) * muv[e]; o[e] = ((y[e] * rstd * lnw[e] + lnb[e]) + bo * v) * g; }
        v4u ov; ov.x = pk2(o[0], o[1]); ov.y = pk2(o[2], o[3]); ov.z = pk2(o[4], o[5]); ov.w = pk2(o[6], o[7]);
        *(v4u*)(orw + (size_t)t * 1024 + ch) = ov;
    }
}

__device__ __forceinline__ int crow(int r, int hi) { return (r & 3) + 8 * (r >> 2) + 4 * hi; }
constexpr int AT_BUF = 24576;
__device__ __forceinline__ int at_addr(int row, int ch) { return row * 128 + ((ch ^ ((row >> 1) & 7)) << 4); }
__device__ __forceinline__ void attn_pass(const bf16* qn, const bf16* kn, const bf16* vt, int b, int head, int c, int qb, LAS unsigned char* lds, int tid, f32x16 (&o)[4]) {
    const int lane = tid & 63, wave = __builtin_amdgcn_readfirstlane(tid >> 6), r32 = lane & 31, hi = lane >> 5;
    const int vh = b * 8 + head * 2 + c; const int q0 = qb * 256, qw0 = q0 + wave * 32, qrow = qw0 + r32;
    const bf16* Qp = qn + ((size_t)(vh & 7) * SEQ + qrow) * 64;
    s16x8 qf[4];
#pragma unroll
    for (int ks = 0; ks < 4; ++ks) qf[ks] = *(const s16x8*)(Qp + 16 * ks + 8 * hi);
    const int k_row = tid >> 3, k_ch = tid & 7;
    const bf16* ksrc = kn + (size_t)(vh & 7) * SEQ * 64 + k_row * 64 + k_ch * 8; const int kdst = at_addr(k_row, k_ch);
    const int dv0 = tid >> 3, dv1 = 64 + (tid >> 3);
    const bf16* vsrc0 = vt + (size_t)(head * 128 + dv0) * T + (size_t)b * SEQ + k_ch * 8; const bf16* vsrc1 = vsrc0 + (size_t)64 * T;
    const int vdst0 = 8192 + at_addr(dv0, k_ch), vdst1 = 8192 + at_addr(dv1, k_ch); const bool vsw0 = (dv0 & 16) != 0, vsw1 = (dv1 & 16) != 0;
    const int NT = 4 * qb + 4;
    v4u kreg = *(const v4u*)ksrc, vreg0 = *(const v4u*)vsrc0, vreg1 = *(const v4u*)vsrc1;
    __syncthreads();
    *(LAS v4u*)(lds + kdst) = kreg; *(LAS v4u*)(lds + vdst0) = vsw0 ? (v4u){vreg0.z, vreg0.w, vreg0.x, vreg0.y} : vreg0; *(LAS v4u*)(lds + vdst1) = vsw1 ? (v4u){vreg1.z, vreg1.w, vreg1.x, vreg1.y} : vreg1;
    __syncthreads();
    float m = -1e30f, l = 0.f;
#pragma unroll
    for (int db = 0; db < 4; ++db)
#pragma unroll
        for (int i = 0; i < 16; ++i) o[db][i] = 0.f;
    for (int j = 0; j < NT; ++j) {
        const int cur = (j & 1) * AT_BUF, nxt = AT_BUF - cur; const bool more = j + 1 < NT;
        if (more) { kreg = *(const v4u*)(ksrc + (size_t)(j + 1) * 64 * 64); vreg0 = *(const v4u*)(vsrc0 + (j + 1) * 64); vreg1 = *(const v4u*)(vsrc1 + (j + 1) * 64); }
        const int kv0 = j * 64;
        if (kv0 <= qw0 + 31) {
            f32x16 s0, s1;
#pragma unroll
            for (int i = 0; i < 16; ++i) { s0[i] = 0.f; s1[i] = 0.f; }
            __builtin_amdgcn_s_setprio(1);
#pragma unroll
            for (int ks = 0; ks < 4; ++ks) {
                const s16x8 a0 = *(const LAS s16x8*)(lds + cur + at_addr(r32, 2 * ks + hi));
                const s16x8 a1 = *(const LAS s16x8*)(lds + cur + at_addr(32 + r32, 2 * ks + hi));
                s0 = __builtin_amdgcn_mfma_f32_32x32x16_bf16(a0, qf[ks], s0, 0, 0, 0);
                s1 = __builtin_amdgcn_mfma_f32_32x32x16_bf16(a1, qf[ks], s1, 0, 0, 0);
            }
            __builtin_amdgcn_s_setprio(0);
            if (kv0 + 63 > qw0) {
#pragma unroll
                for (int i = 0; i < 16; ++i) { const int kv = kv0 + crow(i, hi); if (kv > qrow) s0[i] = -1e30f; if (kv + 32 > qrow) s1[i] = -1e30f; }
            }
            float rm = fmaxf(s0[0], s1[0]);
#pragma unroll
            for (int i = 1; i < 16; ++i) rm = fmaxf(rm, fmaxf(s0[i], s1[i]));
            rm = xhalf_max(rm);
            const float mn = fmaxf(m, rm); const float f = __builtin_amdgcn_exp2f(m - mn); m = mn;
            float ps = 0.f;
#pragma unroll
            for (int i = 0; i < 16; ++i) { s0[i] = __builtin_amdgcn_exp2f(s0[i] - mn); s1[i] = __builtin_amdgcn_exp2f(s1[i] - mn); ps += s0[i] + s1[i]; }
            l = l * f + ps;
            if (__any(f != 1.0f)) {
#pragma unroll
                for (int db = 0; db < 4; ++db)
#pragma unroll
                    for (int i = 0; i < 16; ++i) o[db][i] *= f;
            }
            v4u pw[4];
            pw[0] = (v4u){pk2(s0[0], s0[1]), pk2(s0[2], s0[3]), pk2(s0[4], s0[5]), pk2(s0[6], s0[7])};
            pw[1] = (v4u){pk2(s0[8], s0[9]), pk2(s0[10], s0[11]), pk2(s0[12], s0[13]), pk2(s0[14], s0[15])};
            pw[2] = (v4u){pk2(s1[0], s1[1]), pk2(s1[2], s1[3]), pk2(s1[4], s1[5]), pk2(s1[6], s1[7])};
            pw[3] = (v4u){pk2(s1[8], s1[9]), pk2(s1[10], s1[11]), pk2(s1[12], s1[13]), pk2(s1[14], s1[15])};
#pragma unroll
            for (int db = 0; db < 4; ++db) { const int dv = 32 * db + r32; const int vb = cur + 8192 + dv * 128 + 8 * (hi ^ ((dv >> 4) & 1)), sw = (dv >> 1) & 7;
#pragma unroll
                for (int s4 = 0; s4 < 4; ++s4) {
                    const s16x4 lo = *(const LAS s16x4*)(lds + vb + (((2 * s4) ^ sw) << 4));
                    const s16x4 hh = *(const LAS s16x4*)(lds + vb + (((2 * s4 + 1) ^ sw) << 4));
                    const s16x8 av = (s16x8){lo[0], lo[1], lo[2], lo[3], hh[0], hh[1], hh[2], hh[3]};
                    o[db] = __builtin_amdgcn_mfma_f32_32x32x16_bf16(av, __builtin_bit_cast(s16x8, pw[s4]), o[db], 0, 0, 0);
                }
                __builtin_amdgcn_sched_barrier(0); }
        }
        if (more) { *(LAS v4u*)(lds + nxt + kdst) = kreg; *(LAS v4u*)(lds + nxt + vdst0) = vsw0 ? (v4u){vreg0.z, vreg0.w, vreg0.x, vreg0.y} : vreg0; *(LAS v4u*)(lds + nxt + vdst1) = vsw1 ? (v4u){vreg1.z, vreg1.w, vreg1.x, vreg1.y} : vreg1; }
        __syncthreads();
    }
    l = xhalf_sum(l);
    const float il = 1.0f / l;
#pragma unroll
    for (int db = 0; db < 4; ++db)
#pragma unroll
        for (int i = 0; i < 16; ++i) o[db][i] *= il;
}
__device__ __forceinline__ void attn_unit(const Args& a, LAS unsigned char* lds, int tid, int b, int head, int qb, float* stash  ) {
    unsigned char* ws = a.ws;
    const bf16* qn = qn_ptr(ws, b); const bf16* kn = kn_ptr(ws, b); const bf16* vt = (const bf16*)(ws + WS_VT);
    bf16* odf = (bf16*)((unsigned char*)a.out + OUT_ORWDF) + 512;
    const int lane = tid & 63, wave = tid >> 6, r32 = lane & 31, hi = lane >> 5;
    int oz = 0; asm volatile("" : "+v"(oz)); const int ll = lane + oz;
    const float d1 = wave_sum(a.in[17][ll] * a.in[18][ll]), d2 = wave_sum(a.in[19][ll] * a.in[20][ll]);
    const float lam = __expf(d1) - __expf(d2) + LAM_INIT;
    f32x16 o[4];
    attn_pass(qn, kn, vt, b, head, 0, qb, lds, tid, o);
    float* st = stash + tid * 64;
#pragma unroll
    for (int db = 0; db < 4; ++db)
#pragma unroll
        for (int g = 0; g < 4; ++g) *(f32x4*)(st + db * 16 + g * 4) = (f32x4){o[db][4 * g], o[db][4 * g + 1], o[db][4 * g + 2], o[db][4 * g + 3]};
#if defined(PROBE_PHASE) && PROBE_PHASE == 215
    if (head == 0) { bf16* dbg = (bf16*)(ws + 496 * MiB); const size_t tq = (size_t)b * SEQ + qb * 256 + wave * 32 + r32;
#pragma unroll
        for (int db = 0; db < 4; ++db)
#pragma unroll
            for (int g = 0; g < 4; ++g) { const int dv = 32 * db + 8 * g + 4 * hi; v2u ov; ov.x = pk2(o[db][4 * g], o[db][4 * g + 1]); ov.y = pk2(o[db][4 * g + 2], o[db][4 * g + 3]); *(v2u*)(dbg + tq * 128 + dv) = ov; } }
#endif
    attn_pass(qn, kn, vt, b, head, 1, qb, lds, tid, o);
    float ss = 0.f;
#pragma unroll
    for (int db = 0; db < 4; ++db)
#pragma unroll
        for (int g = 0; g < 4; ++g) { const f32x4 s4 = *(const f32x4*)(st + db * 16 + g * 4);
#pragma unroll
            for (int e = 0; e < 4; ++e) { const float d = s4[e] - lam * o[db][4 * g + e]; o[db][4 * g + e] = d; ss += d * d; } }
    ss = xhalf_sum(ss);
    const float rs = (1.0f / sqrtf(ss * (1.f / 128.f) + 1e-6f)) * (1.0f - LAM_INIT);
    const size_t t = (size_t)b * SEQ + qb * 256 + wave * 32 + r32; const float* sw = a.in[21];
#pragma unroll
    for (int db = 0; db < 4; ++db)
#pragma unroll
        for (int g = 0; g < 4; ++g) { const int dv = 32 * db + 8 * g + 4 * hi; const f32x4 w4 = *(const f32x4*)(sw + dv);
            v2u ov; ov.x = pk2(o[db][4 * g] * rs * w4[0], o[db][4 * g + 1] * rs * w4[1]); ov.y = pk2(o[db][4 * g + 2] * rs * w4[2], o[db][4 * g + 3] * rs * w4[3]);
            *(v2u*)(odf + t * 1024 + head * 128 + dv) = ov; }
}
#define XB_TMO      128
#define XB_XCNT(j)  (256  + 64 * (j))
#define XB_XSUB(j)  (1280 + 64 * (j))
#define XB_XGEN(j)  (2304 + 64 * (j))
#define XB_TOP      3328
#define XB_TOPGEN   3392
#define XCD_BAR_WORDS 3456
#define XB_SPIN_CAP (1u << 18)

__device__ __forceinline__ unsigned xb_ld(unsigned* p)              { return __hip_atomic_load(p, __ATOMIC_RELAXED, __HIP_MEMORY_SCOPE_AGENT); }
__device__ __forceinline__ unsigned xb_add(unsigned* p, unsigned v) { return __hip_atomic_fetch_add(p, v, __ATOMIC_RELAXED, __HIP_MEMORY_SCOPE_AGENT); }
__device__ __forceinline__ unsigned xb_xcc_id() { return (unsigned)__builtin_amdgcn_s_getreg((3 << 11) | 20) & 0xFu; }
#define XB_SPIN(cond, bar) do { unsigned _sp = 0; while (cond) { __builtin_amdgcn_s_sleep(1); \
    if ((++_sp & 255u) == 0u) { if (xb_ld(&(bar)[XB_TMO])) break; if (_sp > XB_SPIN_CAP) { atomicAdd(&(bar)[XB_TMO], 1u); break; } } } } while (0)

struct XcdBarrier {
    unsigned* bar; unsigned x;
    volatile LAS unsigned* st;
};

__device__ __forceinline__ XcdBarrier xcd_barrier_post(unsigned* bar, volatile LAS unsigned* st) {
    XcdBarrier b; b.bar = bar; b.x = xb_xcc_id(); b.st = st;
    if (threadIdx.x == 0) (void)xb_add(&bar[XB_XCNT(b.x)], 1u);
    return b;
}
__device__ __forceinline__ void xcd_barrier_complete(unsigned* bar, unsigned x, unsigned& nloc, unsigned& nx) {
    const unsigned G = gridDim.x * gridDim.y * gridDim.z;
    unsigned sum, cnt, mine, sp = 0u;
    for (;;) {
        sum = 0u; cnt = 0u; mine = 0u;
#pragma unroll
        for (unsigned j = 0; j < 16; ++j) { const unsigned c = xb_ld(&bar[XB_XCNT(j)]); sum += c; cnt += (c > 0u) ? 1u : 0u; mine = (j == x) ? c : mine; }
        if (sum == G) break;
        __builtin_amdgcn_s_sleep(1);
        if ((++sp & 255u) == 0u) { if (xb_ld(&bar[XB_TMO])) break; if (sp > XB_SPIN_CAP) { atomicAdd(&bar[XB_TMO], 1u); break; } }
    }
    nloc = mine > 0u ? mine : 1u; nx = cnt > 0u ? cnt : 1u;
}

__device__ __forceinline__ void xcd_barrier(const XcdBarrier& b) {
    asm volatile("s_waitcnt vmcnt(0)" ::: "memory");
    __syncthreads();
    if (threadIdx.x == 0) {
        unsigned* bar = b.bar;
        __builtin_amdgcn_s_waitcnt(0);
        unsigned nloc = b.st[0], nx = b.st[1];
        if (nloc == 0u) { xcd_barrier_complete(bar, b.x, nloc, nx); b.st[0] = nloc; b.st[1] = nx; }
        const unsigned old = xb_add(&bar[XB_XSUB(b.x)], 1u);
        const unsigned gen = old / nloc;
        if (old + 1u == (gen + 1u) * nloc) {
            __builtin_amdgcn_fence(__ATOMIC_RELEASE, "agent");
            asm volatile("s_waitcnt vmcnt(0)" ::: "memory");
            const unsigned og = xb_add(&bar[XB_TOP], 1u);
            const unsigned tg = og / nx;
            if (og + 1u == (tg + 1u) * nx) xb_add(&bar[XB_TOPGEN], 1u);
            else XB_SPIN(xb_ld(&bar[XB_TOPGEN]) == tg, bar);
            __builtin_amdgcn_fence(__ATOMIC_ACQUIRE, "agent");
            xb_add(&bar[XB_XGEN(b.x)], 1u);
            asm volatile("s_waitcnt vmcnt(0)" ::: "memory");
        } else {
            XB_SPIN(xb_ld(&bar[XB_XGEN(b.x)]) == gen, bar);
            __builtin_amdgcn_fence(__ATOMIC_ACQUIRE, "agent");
            asm volatile("s_waitcnt vmcnt(0)" ::: "memory");
        }
    }
    __syncthreads();
}

constexpr int TR_IGU = (1024 / 64) * (512 / 32);
constexpr int TR_IDN = (512 / 64) * (1024 / 32);
constexpr int NTRQ = 256, TRQ_PER_WAVE = NEXP * 2 * TR_IGU / (NTRQ * NWAVES);
__device__ __forceinline__ void tr_wgu_qitem(const Args& a, LAS unsigned char* lds, int lane, int wave, int q) {
    LAS float* scr = (LAS float*)(lds + wave * 16384); bf16* wgu = (bf16*)(a.ws + WS_WGU);
#pragma unroll 1
    for (int j = 0; j < TRQ_PER_WAVE; ++j) { const int it = (q * NWAVES + wave) * TRQ_PER_WAVE + j; const int e = it / (2 * TR_IGU); int r = it % (2 * TR_IGU);
        const int up = r >= TR_IGU; if (up) r -= TR_IGU; const int kb = r / 16, nb = r % 16, n0 = 32 * nb;
        const float* W = (up ? a.in[31] : a.in[30]) + (size_t)e * 1024 * 512;
        tr_item<true>(W, 512, wgu, 1024, 64 * kb, n0, (size_t)e * 1024 + (n0 >> 7) * 256 + (up ? 128 : 0) + (n0 & 127), 0, scr, lane, a.in[25]); }
}
__device__ __forceinline__ void tr_wd_all(const Args& a, LAS unsigned char* lds, int lane, int wave, int w0, int nw) {
    LAS float* scr = (LAS float*)(lds + wave * 16384); bf16* wd = (bf16*)(a.ws + WS_WD);
#pragma unroll 1
    for (int it = w0; it < NEXP * TR_IDN; it += nw) { const int e = it / TR_IDN, r = it % TR_IDN, kb = r / 32, nb = r % 32;
        tr_item(a.in[32] + (size_t)e * 512 * 1024, 1024, wd, 512, 64 * kb, 32 * nb, (size_t)e * 1024 + 32 * nb, 0, scr, lane); }
}

__device__ __forceinline__ void route_tile(const Args& a, LAS unsigned char* lds, int tid, int pm) {
    unsigned char* ws = a.ws;
    const float* LG = (const float*)(ws + WS_LOGITS); int* toke = (int*)(ws + WS_TOKE); float* tokw = (float*)(ws + WS_TOKW); int* tilecnt = (int*)(ws + WS_TILECNT);
    LAS int* cnt = (LAS int*)lds;
    if (tid < 32) cnt[tid] = 0;
    __syncthreads();
    if (tid < 256) {
        const int t = pm * 256 + tid; const float* lr = LG + (size_t)t * 128;
        float rs;
        { const f32x4* sp = (const f32x4*)((const float*)(ws + WS_SSQ) + (size_t)t * 16); const f32x4 s0 = sp[0], s1 = sp[1], s2 = sp[2], s3 = sp[3];
          const float ss = (((s0[0] + s0[1]) + (s0[2] + s0[3])) + ((s1[0] + s1[1]) + (s1[2] + s1[3]))) + (((s2[0] + s2[1]) + (s2[2] + s2[3])) + ((s3[0] + s3[1]) + (s3[2] + s3[3])));
          rs = 1.0f / sqrtf(ss * (1.f / 1024.f) + 1e-6f); ((float*)(ws + WS_RS))[t] = rs; }
        float gl[4];
#pragma unroll
        for (int j = 0; j < 4; ++j) gl[j] = lr[32 + j] * rs + a.in[27][j];
        int gi = 0; float gm = gl[0];
#pragma unroll
        for (int j = 1; j < 4; ++j) if (gl[j] > gm) { gm = gl[j]; gi = j; }
        float gs = 0.f;
#pragma unroll
        for (int j = 0; j < 4; ++j) gs += __expf(gl[j] - gm);
        const float gtop = 1.0f / gs;
        float el[8];
#pragma unroll
        for (int j = 0; j < 8; ++j) el[j] = lr[gi * 8 + j] * rs + a.in[29][gi * 8 + j];
        int i1 = 0; float e1 = el[0];
#pragma unroll
        for (int j = 1; j < 8; ++j) if (el[j] > e1) { e1 = el[j]; i1 = j; }
        int i2 = -1; float e2 = -3.0e38f;
#pragma unroll
        for (int j = 0; j < 8; ++j) if (j != i1 && el[j] > e2) { e2 = el[j]; i2 = j; }
        const float ex = __expf(e2 - e1); const float w1 = gtop / (1.0f + ex), w2 = gtop * ex / (1.0f + ex);
        const int x1 = gi * 8 + i1, x2 = gi * 8 + i2;
        toke[t * 2] = x1; toke[t * 2 + 1] = x2; tokw[t * 2] = w1; tokw[t * 2 + 1] = w2;
        atomicAdd((int*)&cnt[x1], 1); atomicAdd((int*)&cnt[x2], 1);
    }
    __syncthreads();
    if (tid < 32) tilecnt[pm * 32 + tid] = cnt[tid];
    __syncthreads();
}

__device__ __forceinline__ void phase9(const Args& a, LAS unsigned char* lds, int tid, int lane, int wave) {
    unsigned char* ws = a.ws;
    const int tile = blockIdx.x;
    if (tile >= 128) return;
    const int* tilecnt = (const int*)(ws + WS_TILECNT); const int* toke = (const int*)(ws + WS_TOKE); const float* tokw = (const float*)(ws + WS_TOKW);
    int* pos = (int*)(ws + WS_POS); float* roww = (float*)(ws + WS_ROWW); int* disp = (int*)(ws + WS_DISP); int* rowtok = (int*)(ws + WS_ROWTOK);
    LAS int* tc = (LAS int*)lds;
    LAS int* tot = tc + 4096;
    LAS int* bef = tot + 32;
    LAS int* base = bef + 32;
    LAS int* pst = base + 32;
    LAS int* earr = pst + 32;
    LAS int* parr = earr + 512;
    for (int i = tid; i < 4096; i += NTHR) tc[i] = tilecnt[i];
    earr[tid] = toke[tile * 512 + tid];
    __syncthreads();
    if (tid < 32) { int s = 0, b = 0; for (int t = 0; t < 128; ++t) { const int c = tc[t * 32 + tid]; s += c; if (t < tile) b += c; } tot[tid] = s; bef[tid] = b; }
    __syncthreads();
    if (tid == 0) { int p = 0; for (int e = 0; e < 32; ++e) { pst[e] = p; base[e] = p + bef[e]; const int nt = (tot[e] + 255) >> 8;
                        if (tile == 0) { for (int k = 0; k < nt; ++k) disp[16 + (p >> 8) + k] = e; disp[512 + e] = p; disp[576 + e] = tot[e]; }
                        p += nt << 8; }
                    if (tile == 0) disp[0] = p >> 8; }
    __syncthreads();
    for (int q = 0; q < 4; ++q) { const int e = wave * 4 + q; int running = 0;
        for (int c8 = 0; c8 < 8; ++c8) { const int ai = c8 * 64 + lane; const bool mt = earr[ai] == e; const unsigned long long mk = __ballot(mt);
            if (mt) parr[ai] = base[e] + running + __popcll(mk & ((1ull << lane) - 1ull));
            running += __popcll(mk); } }
    __syncthreads();
    { const int ai = tid, p = parr[ai], t = tile * 256 + (ai >> 1); pos[t * 2 + (ai & 1)] = p; roww[p] = tokw[t * 2 + (ai & 1)]; rowtok[p] = t; ((float*)(ws + WS_ROWRS))[p] = ((const float*)(ws + WS_RS))[t]; }
    if (tile < 32) { const int p0 = pst[tile] + tot[tile], p1 = pst[tile] + (((tot[tile] + 255) >> 8) << 8);
        for (int r = p0 + tid; r < p1; r += NTHR) { rowtok[r] = 0; roww[r] = 0.f; ((float*)(ws + WS_ROWRS))[r] = 0.f; } }
}

__device__ __forceinline__ void phase12(const Args& a, int tid, int lane, int wave, int vcu, int G) {
    unsigned char* ws = a.ws;
    const int gw = vcu * NWAVES + wave, NGW = G * NWAVES; const int gt = vcu * NTHR + tid, NGT = G * NTHR;
    const bf16* x1 = (const bf16*)a.out; bf16* x2 = (bf16*)(ws + WS_X2); const bf16* y2 = (const bf16*)(ws + WS_Y2); const int* pos = (const int*)(ws + WS_POS); const float* gain = a.in[33]; bf16* h3 = (bf16*)(ws + WS_H3);
    for (int m = gw; m < T; m += NGW) {
        const int pa = pos[m * 2], pb = pos[m * 2 + 1];
        const v2u* xr = (const v2u*)(x1 + (size_t)m * DM) + lane; v2u* xo = (v2u*)(x2 + (size_t)m * DM) + lane; const v2u* ya = (const v2u*)(y2 + (size_t)pa * 1024) + lane; const v2u* yb = (const v2u*)(y2 + (size_t)pb * 1024) + lane;
        f32x4 v[4]; float s = 0.f;
#pragma unroll
        for (int j = 0; j < 4; ++j) { const v2u wx = xr[64 * j], wa = ya[64 * j], wb = yb[64 * j];
            v[j].x = bflo(wx.x) + bflo(wa.x) + bflo(wb.x); v[j].y = bfhi(wx.x) + bfhi(wa.x) + bfhi(wb.x); v[j].z = bflo(wx.y) + bflo(wa.y) + bflo(wb.y); v[j].w = bfhi(wx.y) + bfhi(wa.y) + bfhi(wb.y);
            v2u o; o.x = pk2(v[j].x, v[j].y); o.y = pk2(v[j].z, v[j].w); xo[64 * j] = o;
            s += (v[j].x * v[j].x + v[j].y * v[j].y) + (v[j].z * v[j].z + v[j].w * v[j].w); }
        const float rstd = 1.0f / sqrtf(wave_sum(s) * (1.f / 1024.f) + 1e-6f);
        v2u* o8 = (v2u*)(h3 + (size_t)m * DM) + lane;
#pragma unroll
        for (int j = 0; j < 4; ++j) { const f32x4 g = ((const f32x4*)gain)[lane + 64 * j]; v2u o; o.x = pk2(v[j].x * rstd * g.x, v[j].y * rstd * g.y); o.y = pk2(v[j].z * rstd * g.z, v[j].w * rstd * g.w); o8[64 * j] = o; }
    }
    const f32x4* p = (const f32x4*)a.in[1]; v2u* p16 = (v2u*)(ws + WS_P16);
    for (int i = gt; i < T * 256 / 4; i += NGT) { const f32x4 v = p[i]; v2u o; o.x = pk2(v.x, v.y); o.y = pk2(v.z, v.w); p16[i] = o; }
}

#if defined(PROBE_PHASE) && (PROBE_PHASE == 200 || PROBE_PHASE == 201)
__device__ __forceinline__ float blk_sum(float v, LAS float* red, int tid) { v = wave_sum(v); __syncthreads(); if ((tid & 63) == 0) red[tid >> 6] = v; __syncthreads(); float s = 0.f; for (int i = 0; i < 8; ++i) s += red[i]; __syncthreads(); return s; }
__device__ __forceinline__ void check_moe(const Args& a, LAS unsigned char* lds, int tid, float* res) {
    unsigned char* ws = a.ws;
    LAS float* hb = (LAS float*)lds; LAS float* hf = hb + 1024; LAS float* act = hf + 1024; LAS float* lg = act + 512; LAS float* red = lg + 64; LAS int* sel = (LAS int*)(red + 16);
    const int* toke = (const int*)(ws + WS_TOKE); const float* tokw = (const float*)(ws + WS_TOKW); const int* pos = (const int*)(ws + WS_POS); const bf16* y2 = (const bf16*)(ws + WS_Y2);
    float errsum = 0.f, refsum = 0.f; int mism = 0;
    for (int si = 0; si < 24; ++si) { const int t = si * 1361 + 17;
        const bf16* xr = (const bf16*)a.out + (size_t)t * DM; const float x0 = __builtin_bit_cast(float, (unsigned)xr[tid] << 16), x1 = __builtin_bit_cast(float, (unsigned)xr[tid + 512] << 16);
        const float rstd = 1.0f / sqrtf(blk_sum(x0 * x0 + x1 * x1, red, tid) * (1.f / 1024.f) + 1e-6f);
        const float h0 = x0 * rstd * a.in[25][tid], h1 = x1 * rstd * a.in[25][tid + 512];
        hf[tid] = h0; hf[tid + 512] = h1; hb[tid] = __builtin_bit_cast(float, f2bf(h0) << 16); hb[tid + 512] = __builtin_bit_cast(float, f2bf(h1) << 16);
        __syncthreads();
        if (tid < 36) { float s = 0.f; for (int k = 0; k < 1024; ++k) s += hf[k] * (tid < 32 ? a.in[28][k * 32 + tid] : a.in[26][k * 4 + (tid - 32)]); lg[tid] = s + (tid < 32 ? a.in[29][tid] : a.in[27][tid - 32]); }
        __syncthreads();
        if (tid == 0) { int gi = 0; for (int j = 1; j < 4; ++j) if (lg[32 + j] > lg[32 + gi]) gi = j;
            int i1 = 0; for (int j = 1; j < 8; ++j) if (lg[gi * 8 + j] > lg[gi * 8 + i1]) i1 = j;
            int i2 = -1; for (int j = 0; j < 8; ++j) if (j != i1 && (i2 < 0 || lg[gi * 8 + j] > lg[gi * 8 + i2])) i2 = j;
            sel[0] = gi * 8 + i1; sel[1] = gi * 8 + i2; }
        __syncthreads();
        if (sel[0] != toke[t * 2] || sel[1] != toke[t * 2 + 1]) mism++;
        float o0 = 0.f, o1 = 0.f;
        for (int kx = 0; kx < 2; ++kx) { const int e = toke[t * 2 + kx]; const float w = tokw[t * 2 + kx];
            const float* Wg = a.in[30] + (size_t)e * 1024 * 512; const float* Wu = a.in[31] + (size_t)e * 1024 * 512; const float* Wd = a.in[32] + (size_t)e * 512 * 1024;
            float gg = 0.f, uu = 0.f; for (int k = 0; k < 1024; ++k) { const float hk = hb[k]; gg += hk * Wg[(size_t)k * 512 + tid]; uu += hk * Wu[(size_t)k * 512 + tid]; }
            __syncthreads(); act[tid] = gg / (1.0f + __expf(-gg)) * uu; __syncthreads();
            float s0 = 0.f, s1 = 0.f; for (int f = 0; f < 512; ++f) { const float af = act[f]; s0 += af * Wd[(size_t)f * 1024 + tid]; s1 += af * Wd[(size_t)f * 1024 + tid + 512]; }
            o0 += s0 * w; o1 += s1 * w; }
        const int pa = pos[t * 2], pb = pos[t * 2 + 1];
        const float m0 = __builtin_bit_cast(float, (unsigned)y2[(size_t)pa * 1024 + tid] << 16) + __builtin_bit_cast(float, (unsigned)y2[(size_t)pb * 1024 + tid] << 16);
        const float m1 = __builtin_bit_cast(float, (unsigned)y2[(size_t)pa * 1024 + tid + 512] << 16) + __builtin_bit_cast(float, (unsigned)y2[(size_t)pb * 1024 + tid + 512] << 16);
        errsum += (m0 - o0) * (m0 - o0) + (m1 - o1) * (m1 - o1); refsum += o0 * o0 + o1 * o1;
    }
    const float es = blk_sum(errsum, red, tid), rs = blk_sum(refsum, red, tid);
    if (tid == 0) *res = (PROBE_PHASE == 200) ? sqrtf(es / rs) : (float)mism / 24.f;
}
#endif

#ifndef PROBE_KAPPA
#define PROBE_KAPPA 0
#endif
#ifndef CHK_S0
#define CHK_S0 0
#define CHK_SN 4096
#endif
#if defined(PROBE_PHASE) && (PROBE_PHASE == 210 || PROBE_PHASE == 211 || PROBE_PHASE == 215)
__device__ __forceinline__ void check_attn(const Args& a, LAS unsigned char* lds, int tid, float* res) {
    unsigned char* ws = a.ws;
    const bf16* vt = (const bf16*)(ws + WS_VT);
    const bf16* odf = (const bf16*)((unsigned char*)a.out + OUT_ORWDF) + 512;
    LAS float* sc = (LAS float*)lds; LAS float* part = sc + 4096; LAS float* oc = part + 512; LAS float* red = oc + 256;
    const float d1 = wave_sum(a.in[17][tid & 63] * a.in[18][tid & 63]), d2 = wave_sum(a.in[19][tid & 63] * a.in[20][tid & 63]);
    const float lam = __expf(d1) - __expf(d2) + LAM_INIT;
    float errsum = 0.f, refsum = 0.f;
    for (int si = 0; si < 24; ++si) { const int b = si & 7, head = (PROBE_PHASE == 215) ? 0 : ((si >> 1) & 3), s = CHK_S0 + ((si * 977 + 31 * (si & 3)) % CHK_SN);
        for (int c = 0; c < 2; ++c) { const int vh = b * 8 + head * 2 + c;
            const bf16* qn = qn_ptr(ws, b); const bf16* kn = kn_ptr(ws, b); const bf16* qp = qn + ((size_t)(vh & 7) * SEQ + s) * 64; float mx = -3e38f;
            for (int j = tid; j <= s; j += NTHR) { const bf16* kp = kn + ((size_t)(vh & 7) * SEQ + j) * 64; float d = 0.f;
                for (int e = 0; e < 64; ++e) d += __builtin_bit_cast(float, (unsigned)qp[e] << 16) * __builtin_bit_cast(float, (unsigned)kp[e] << 16);
                sc[j] = d; mx = fmaxf(mx, d); }
            __syncthreads();
            for (int o = 1; o < 64; o <<= 1) mx = fmaxf(mx, __shfl_xor(mx, o));
            if ((tid & 63) == 0) red[tid >> 6] = mx;
            __syncthreads();
            mx = red[0]; for (int i = 1; i < 8; ++i) mx = fmaxf(mx, red[i]);
            __syncthreads();
            float ls = 0.f;
            for (int j = tid; j <= s; j += NTHR) { const float p = exp2f(sc[j] - mx); sc[j] = p; ls += p; }
            ls = wave_sum(ls); if ((tid & 63) == 0) red[tid >> 6] = ls;
            __syncthreads();
            float l = 0.f; for (int i = 0; i < 8; ++i) l += red[i];
            { const int dv = tid & 127, pr = tid >> 7; const bf16* vp = vt + (size_t)(head * 128 + dv) * T + (size_t)b * SEQ; float acc = 0.f;
              for (int j = pr; j <= s; j += 4) acc += sc[j] * __builtin_bit_cast(float, (unsigned)vp[j] << 16);
              part[tid] = acc; }
            __syncthreads();
            if (tid < 128) oc[c * 128 + tid] = (part[tid] + part[tid + 128] + part[tid + 256] + part[tid + 384]) / l;
            __syncthreads(); }
#if PROBE_PHASE == 215
        if (tid < 128) { const float ref = oc[tid]; const float got = __builtin_bit_cast(float, (unsigned)((const bf16*)(ws + 496 * MiB))[((size_t)b * SEQ + s) * 128 + tid] << 16); errsum += (PROBE_KAPPA ? got * ref : (got - ref) * (got - ref)); refsum += ref * ref; }
        __syncthreads(); continue;
#endif
        float dd = 0.f, sq = 0.f; if (tid < 128) { dd = oc[tid] - lam * oc[128 + tid]; sq = dd * dd; }
        sq = wave_sum(sq); __syncthreads(); if ((tid & 63) == 0) red[tid >> 6] = sq; __syncthreads();
        const float rs = (1.0f / sqrtf((red[0] + red[1]) * (1.f / 128.f) + 1e-6f)) * (1.0f - LAM_INIT);
        if (tid < 128) { const float ref = dd * rs * a.in[21][tid]; const float got = __builtin_bit_cast(float, (unsigned)odf[((size_t)b * SEQ + s) * 1024 + head * 128 + tid] << 16);
            errsum += (got - ref) * (got - ref); refsum += ref * ref; }
        __syncthreads(); }
    errsum = wave_sum(errsum); refsum = wave_sum(refsum);
    __syncthreads(); if ((tid & 63) == 0) { red[tid >> 6] = errsum; red[8 + (tid >> 6)] = refsum; } __syncthreads();
    if (tid == 0) *res = PROBE_KAPPA ? fabsf((red[0] + red[1]) / (red[8] + red[9])) : sqrtf((red[0] + red[1]) / (red[8] + red[9]));
}
__device__ __forceinline__ void check_scan(const Args& a, LAS unsigned char* lds, int tid, float* res) {
    unsigned char* ws = a.ws; const int b = 1, hd = 3, NS = 384;
    const bf16* rkv = (const bf16*)(ws + WS_RKV); const bf16* E = (const bf16*)(ws + WS_E); const bf16* Aa = (const bf16*)(ws + WS_A); const bf16* Y = y_ptr(a.out, b);
    LAS float* vw = (LAS float*)lds; LAS float* vaa = vw + 64; LAS float* vbb = vaa + 64; LAS float* vkm = vbb + 64; LAS float* vr = vkm + 64; LAS float* vv = vr + 64; LAS float* red = vv + 64;
    const int row = tid >> 3, cg = tid & 7; float st[8]; for (int j = 0; j < 8; ++j) st[j] = 0.f;
    float errsum = 0.f, refsum = 0.f;
    for (int s = 0; s < NS; ++s) { const size_t t = (size_t)b * SEQ + s;
        if (tid < 64) { const int ch = hd * 64 + tid;
            auto ld = [&](size_t tt, int off) { return __builtin_bit_cast(float, (unsigned)rkv[tt * 1536 + off + ch] << 16); };
            const float rc = ld(t, 0), kc = ld(t, 512), vc = ld(t, 1024); const float rp = s ? ld(t - 1, 0) : 0.f, kp = s ? ld(t - 1, 512) : 0.f, vp = s ? ld(t - 1, 1024) : 0.f;
            const float r = rc + (rp - rc) * a.in[4][ch], k = kc + (kp - kc) * a.in[4][512 + ch], v = vc + (vp - vc) * a.in[4][1024 + ch];
            const float e = __builtin_bit_cast(float, (unsigned)E[t * 512 + ch] << 16), av = __builtin_bit_cast(float, (unsigned)Aa[t * 512 + ch] << 16);
            float kk = k * a.in[10][ch]; const float nn = sqrtf(wave_sum(kk * kk)); kk = kk / fmaxf(nn, 1e-12f);
            vw[tid] = expf(-e); vaa[tid] = -kk; vbb[tid] = kk * av; vkm[tid] = k * (1.0f + (av - 1.0f) * a.in[11][ch]); vr[tid] = r; vv[tid] = v; }
        __syncthreads();
        float sa = 0.f; for (int j = 0; j < 8; ++j) sa += st[j] * vaa[cg * 8 + j];
        sa += __shfl_xor(sa, 1); sa += __shfl_xor(sa, 2); sa += __shfl_xor(sa, 4);
        float y = 0.f; for (int j = 0; j < 8; ++j) { const int c = cg * 8 + j; st[j] = st[j] * vw[c] + sa * vbb[c] + vv[row] * vkm[c]; y += st[j] * vr[c]; }
        y += __shfl_xor(y, 1); y += __shfl_xor(y, 2); y += __shfl_xor(y, 4);
        if (cg == 0) { const float got = __builtin_bit_cast(float, (unsigned)Y[(size_t)s * 512 + hd * 64 + row] << 16); errsum += (got - y) * (got - y); refsum += y * y; }
        __syncthreads(); }
    errsum = wave_sum(errsum); refsum = wave_sum(refsum);
    if ((tid & 63) == 0) { red[tid >> 6] = errsum; red[8 + (tid >> 6)] = refsum; } __syncthreads();
    if (tid == 0) { float es = 0.f, rs = 0.f; for (int i = 0; i < 8; ++i) { es += red[i]; rs += red[8 + i]; } *res = sqrtf(es / rs); }
}
#endif
#ifndef MK_N_LAUNCHES
#define MK_N_LAUNCHES 1
#endif
#ifndef SCAN_CHUNKED
#define SCAN_CHUNKED 1
#endif
constexpr int NSCAN = SCAN_CHUNKED ? 64 : 128;
constexpr int NGATE = 256;
constexpr int NPHASE = 15;
__global__ void __launch_bounds__(NTHR, 2) mk_fwd(Args args) {
    extern __shared__ __attribute__((aligned(16))) unsigned char lds_raw[];
    LAS unsigned char* lds = (LAS unsigned char*)lds_raw;
    const int tid = threadIdx.x, lane = tid & 63, wave = __builtin_amdgcn_readfirstlane(tid >> 6);
    const int G = gridDim.x; const int bx = blockIdx.x; const int vcu = (G % 8 == 0) ? (bx % 8) * (G / 8) + bx / 8 : bx;
    unsigned char* ws = args.ws;
    const int lo = args.ph_lo, hi = args.ph_hi;
#ifdef ONLY_PHASE
#define IN(k) ((k) == ONLY_PHASE && lo <= (k) && (k) < hi)
#else
#define IN(k) (lo <= (k) && (k) < hi)
#endif
#if MK_N_LAUNCHES == 1
    volatile LAS unsigned* MISC = (volatile LAS unsigned*)(lds + MISC_OFF);
    for (int u = tid; u < 64; u += NTHR) MISC[u] = 0u;
    __syncthreads();
    XcdBarrier xbar = xcd_barrier_post((unsigned*)(ws + WS_CTL) + CW_BAR, MISC + 8);
    if (lo < 0) { __threadfence(); cg::this_grid().sync(); }
#define SEAM(k) do { if (IN(k) && IN((k) + 1)) xcd_barrier(xbar); } while (0)
#else
#define SEAM(k) do { } while (0)
#endif
#ifdef PROBE_PHASE
    volatile LAS unsigned long long* ptw = (volatile LAS unsigned long long*)(lds + MISC_OFF + 1536);
#define pt0 ptw[0]
#define pt1 ptw[1]
    if (tid == 0) { pt0 = 0ull; pt1 = 0ull; }
#define PB(k) do { if ((k) == PROBE_PHASE && bx == 0 && tid == 0) pt0 = __builtin_amdgcn_s_memrealtime(); } while (0)
#define PE(k) do { if ((k) == PROBE_PHASE && bx == 0 && tid == 0) pt1 = __builtin_amdgcn_s_memrealtime(); } while (0)
#else
#define PB(k) do { } while (0)
#define PE(k) do { } while (0)
#endif
    typedef pg8::bf16_t pbf;
    int K256 = 256, K512 = 512, K1024 = 1024, K2048 = 2048;
    asm volatile("" : "+s"(K256), "+s"(K512), "+s"(K1024), "+s"(K2048));
    PB(0);
    if (IN(0)) { phase0(args, lds, tid, lane, wave, vcu, G); }
    SEAM(0); PE(0);
    PB(1);
    if (IN(1)) {
        { pg8::Gemm g{(const pbf*)(ws + WS_XN), (const pbf*)(ws + WS_WIN), T, 11 * 256, K1024}; pg8::StaticOrder S; S.init(T, 11 * 256, G, bx);
          pg8::EpiProj E{(pbf*)(ws + WS_RKV), (pbf*)(ws + WS_PROJB), (pbf*)(ws + WS_GATES)};
          pg8::gemm_phase<pg8::EpiProj, pg8::StaticOrder, true, true>(lds, g, S, E); }
        { pg8::Gemm g{(const pbf*)(ws + WS_WIN) + (size_t)2816 * 1024, (const pbf*)(ws + WS_XN), 512, T, K1024}; pg8::StaticOrder S; S.init(512, T, G, bx);
          pg8::EpiStore E{(pbf*)(ws + WS_VT), T};
          pg8::gemm_phase<pg8::EpiStore, pg8::StaticOrder, true, true>(lds, g, S, E); }
    }
    SEAM(1); PE(1);
    PB(2);
    if (IN(2)) { phase2(args, lds, tid, vcu, G); }
    SEAM(2); PE(2);
    PB(3);
    if (IN(3)) {
        pg8::Gemm g{(const pbf*)((unsigned char*)args.out + OUT_LA), (const pbf*)(ws + WS_WLORA), T, 1536, K256}; pg8::StaticOrder S; S.init(T, 1536, G, bx);
        pg8::EpiLora E{(pbf*)(ws + WS_E), (pbf*)(ws + WS_A), (pbf*)(ws + WS_G), args.in[5], args.in[7]};
        pg8::gemm_phase<pg8::EpiLora, pg8::StaticOrder, true, true>(lds, g, S, E);
    }
    SEAM(3); PE(3);
    PB(4);
    if (IN(4)) {
        unsigned* qhead = (unsigned*)(ws + WS_CTL) + CW_QUEUE; LAS unsigned* ubox = (LAS unsigned*)(lds + MISC_OFF);
        float* stash = (float*)((unsigned char*)args.out + OUT_STASH) + (size_t)bx * 64 * 512;
        for (;;) {
            __syncthreads();
            if (tid == 0) ubox[0] = atomicAdd(qhead, 1u);
            __syncthreads();
            const int u = (int)ubox[0];
            int oq = 0; asm volatile("" : "+v"(oq)); const int tq = tid + oq;
            if (u >= NSCAN + NGATE + 512 + NTRQ) break;
            if (u >= NSCAN + NGATE + 512) {
                if (tid == 0) { while (__hip_atomic_load(qhead + 1, __ATOMIC_ACQUIRE, __HIP_MEMORY_SCOPE_AGENT) < (unsigned)NGATE) __builtin_amdgcn_s_sleep(8); }
                __syncthreads();
                tr_wgu_qitem(args, lds, (tq & 63), wave, u - (NSCAN + NGATE + 512)); continue; }
#if defined(PROBE_PHASE) && PROBE_PHASE == 100
            if (u < NSCAN) { if (tid == 0) ptw[2] = __builtin_amdgcn_s_memrealtime(); if (SCAN_CHUNKED) scan_unit_chunked(args, lds, tq, u); else scan_unit(args, lds, tq, u);
                if (tid == 0) atomicMax((unsigned*)(ws + WS_CTL) + 96, (unsigned)(__builtin_amdgcn_s_memrealtime() - ptw[2])); }
#else
            if (u < NSCAN) { if (SCAN_CHUNKED) scan_unit_chunked(args, lds, tq, u); else scan_unit(args, lds, tq, u); }
#endif
#if defined(PROBE_PHASE) && PROBE_PHASE == 101
            else if (u < NSCAN + NGATE) { } else { const int au = u - NSCAN - NGATE; const unsigned long long q0 = __builtin_amdgcn_s_memrealtime(); attn_unit(args, lds, tid, (au & 31) >> 2, au & 3, 15 - (au >> 5), stash); const unsigned long long q1 = __builtin_amdgcn_s_memrealtime();
                if (tid == 0) atomicAdd((unsigned*)(ws + WS_CTL) + 96, (unsigned)(q1 - q0)); }
#else
            else if (u < NSCAN + NGATE) { const int it = u - NSCAN;
                pg8::Gemm g{(const pbf*)(ws + WS_XN), (const pbf*)(ws + WS_WIN) + (size_t)3328 * 1024, T, 2048, K1024}; pg8::OrderItem S{it >> 1, (it & 1) * 4, 4};
                pg8::EpiGates E{(pbf*)(ws + WS_GATES)};
                pg8::gemm_phase<pg8::EpiGates, pg8::OrderItem, true, true>(lds, g, S, E, oq);
                __syncthreads(); if (tid == 0) __hip_atomic_fetch_add(qhead + 1, 1u, __ATOMIC_RELEASE, __HIP_MEMORY_SCOPE_AGENT); }
            else { const int au = u - NSCAN - NGATE; attn_unit(args, lds, tq, (au & 31) >> 2, au & 3, 15 - (au >> 5), stash); }
#endif
        }
    }
    SEAM(4); PE(4);
#if defined(PROBE_PHASE) && (PROBE_PHASE == 210 || PROBE_PHASE == 211 || PROBE_PHASE == 215)
    if (bx == 0) { float* res = (float*)(ws + WS_CTL) + 100; if (PROBE_PHASE != 211) check_attn(args, lds, tid, res); else check_scan(args, lds, tid, res); __syncthreads(); if (tid == 0) { pt0 = 0ull; pt1 = (unsigned long long)(*(volatile float*)res * 1.0e6f); } }
    xcd_barrier(xbar);
#endif
#if defined(PROBE_PHASE) && PROBE_PHASE == 100
    if (bx == 0 && tid == 0) { pt0 = 0ull; pt1 = (unsigned long long)__hip_atomic_load((unsigned*)(ws + WS_CTL) + 96, __ATOMIC_RELAXED, __HIP_MEMORY_SCOPE_AGENT); }
#endif
#if defined(PROBE_PHASE) && PROBE_PHASE >= 300 && PROBE_PHASE < 310
    if (bx == 0 && tid == 0) { pt0 = 0ull; pt1 = (unsigned long long)__hip_atomic_load((unsigned*)(ws + WS_CTL) + 96, __ATOMIC_RELAXED, __HIP_MEMORY_SCOPE_AGENT) / 64ull; }
#endif
#if defined(PROBE_PHASE) && PROBE_PHASE == 101
    if (bx == 0 && tid == 0) { pt0 = 0ull; pt1 = (unsigned long long)__hip_atomic_load((unsigned*)(ws + WS_CTL) + 96, __ATOMIC_RELAXED, __HIP_MEMORY_SCOPE_AGENT) / 256ull; }
#endif
    PB(5);
    if (IN(5)) { phase_orw(args, lane, wave, vcu, G); }
    SEAM(5); PE(5);
    PB(6);
    if (IN(6)) {
        pg8::Gemm g{(const pbf*)((unsigned char*)args.out + OUT_ORWDF), (const pbf*)(ws + WS_WBRD), T, 1024, K1024}; pg8::StaticOrder S; S.init(T, 1024, G, bx);
        pg8::EpiMix E{(const pbf*)(ws + WS_GATES), (pbf*)(ws + WS_MIXED)};
        pg8::gemm_phase<pg8::EpiMix, pg8::StaticOrder, true, true>(lds, g, S, E);
    }
    SEAM(6); PE(6);
    PB(7);
    if (IN(7)) {
        pg8::Gemm g{(const pbf*)(ws + WS_MIXED), (const pbf*)(ws + WS_WO), T, 1024, K1024}; pg8::StaticOrder S; S.init(T, 1024, G, bx);
        pg8::EpiRes E{args.in[0], (pbf*)args.out, (float*)(ws + WS_SSQ)};
        pg8::gemm_phase<pg8::EpiRes, pg8::StaticOrder, true, true>(lds, g, S, E);
    }
    SEAM(7); PE(7);
    PB(9);
    if (IN(9)) {
        pg8::Gemm g{(const pbf*)args.out, (const pbf*)(ws + WS_WR), T, 256, K1024}; pg8::StaticOrder S; S.init(T, 256, G, bx);
        pg8::EpiLogits E{(float*)(ws + WS_LOGITS)};
        pg8::gemm_phase<pg8::EpiLogits, pg8::StaticOrder, true, true>(lds, g, S, E);
        VM_WAIT(); __syncthreads();
        pg8::Unit u;
        for (int i = 0; S.next(i, u); ++i) route_tile(args, lds, tid, u.pm);
        if (G <= 128) tr_wd_all(args, lds, lane, wave, bx * NWAVES + wave, G * NWAVES);
        else if (bx >= 128) tr_wd_all(args, lds, lane, wave, (bx - 128) * NWAVES + wave, (G - 128) * NWAVES);
    }
    SEAM(9); PE(9);
    PB(10);
    if (IN(10)) { phase9(args, lds, tid, lane, wave); }
    SEAM(10); PE(10);
    PB(11);
    if (IN(11) || IN(12)) {
        const int* disp = (const int*)(ws + WS_DISP); LAS int* tile_e = (LAS int*)(lds + MISC_OFF + 64);
        __syncthreads();
        const int NT = disp[0];
        for (int i = tid; i < NT && i < 320; i += NTHR) tile_e[i] = disp[16 + i];
        __syncthreads();
        if (IN(11)) {
            pg8::Gemm g{(const pbf*)args.out, (const pbf*)(ws + WS_WGU), T, NEXP * 1024, K1024}; pg8::OrderMoe S{NT * 4, G, bx, tile_e};
            pg8::EpiAct E{(pbf*)(ws + WS_ACT), (const float*)(ws + WS_ROWRS)};
            pg8::gemm_phase_gather<pg8::EpiAct, pg8::OrderMoe>(lds, g, (const int*)(ws + WS_ROWTOK), S, E);
        }
        SEAM(11); PE(11); PB(12);
        if (IN(12)) {
            pg8::Gemm g{(const pbf*)(ws + WS_ACT), (const pbf*)(ws + WS_WD), MAXROWS, NEXP * 1024, K512}; pg8::OrderMoe S{NT * 4, G, bx, tile_e};
            pg8::EpiDown E{(pbf*)(ws + WS_Y2), (const float*)(ws + WS_ROWW)};
            pg8::gemm_phase<pg8::EpiDown, pg8::OrderMoe, true, true>(lds, g, S, E);
        }
    }
    SEAM(12); PE(12);
#if defined(PROBE_PHASE) && (PROBE_PHASE == 200 || PROBE_PHASE == 201)
    if (bx == 0) { float* res = (float*)(ws + WS_CTL) + 100; check_moe(args, lds, tid, res); __syncthreads(); if (tid == 0) { pt0 = 0ull; pt1 = (unsigned long long)(*(volatile float*)res * 1.0e6f); } }
    xcd_barrier(xbar);
#endif
    PB(13);
    if (IN(13)) { phase12(args, tid, lane, wave, vcu, G); }
    SEAM(13); PE(13);
    PB(14);
    if (IN(14)) {
        { pg8::Gemm g{(const pbf*)(ws + WS_P16), (const pbf*)(ws + WS_WPP), T, 1024, K256}; pg8::StaticOrder S; S.init(T, 1024, G, bx);
          pg8::EpiStore E{(pbf*)(ws + WS_PP), 1024};
          pg8::gemm_phase<pg8::EpiStore, pg8::StaticOrder, true, true>(lds, g, S, E); }
        { pg8::Gemm g{(const pbf*)(ws + WS_H3), (const pbf*)(ws + WS_WPG), T, 1024, K1024}; pg8::StaticOrder S; S.init(T, 1024, G, bx);
          pg8::EpiFinal E{(const pbf*)(ws + WS_PP), (const pbf*)(ws + WS_X2), args.out};
          pg8::gemm_phase<pg8::EpiFinal, pg8::StaticOrder, true, true>(lds, g, S, E); }
    }
#ifdef PROBE_PHASE
    if (PROBE_PHASE == 14 && bx == 0 && tid == 0) { pt1 = __builtin_amdgcn_s_memrealtime(); }
    if (bx == 0 && tid == 0) { const unsigned long long te = __builtin_amdgcn_s_memrealtime(), w = (unsigned long long)PROBE_MULT * (pt1 - pt0);
        while (__builtin_amdgcn_s_memrealtime() - te < w) __builtin_amdgcn_s_sleep(32); }
#endif
#undef IN
#undef SEAM
}

extern "C" void kernel_launch(void* const* d_in, const int* in_sizes, int n_in, void* d_out, int out_size, void* d_ws, size_t ws_size, hipStream_t stream) {
    static int grid = 0;
    if (grid == 0) {
        if (n_in != 36 || in_sizes[0] != T * DM || out_size != T * DM || ws_size < WS_END) {
            fprintf(stderr, "kernel_launch: unexpected problem: n_in %d in0 %d out %d ws %zu (need %zu)\n", n_in, n_in > 0 ? in_sizes[0] : -1, out_size, ws_size, (size_t)WS_END); grid = -1; return; }
        int dev = 0, cus = 0, per_cu = 0;
        if (hipGetDevice(&dev) != hipSuccess || hipDeviceGetAttribute(&cus, hipDeviceAttributeMultiprocessorCount, dev) != hipSuccess) { grid = -1; return; }
        if (hipFuncSetAttribute((const void*)mk_fwd, hipFuncAttributeMaxDynamicSharedMemorySize, LDS_BYTES) != hipSuccess) { fprintf(stderr, "kernel_launch: hipFuncSetAttribute failed\n"); grid = -1; return; }
        if (hipOccupancyMaxActiveBlocksPerMultiprocessor(&per_cu, (const void*)mk_fwd, NTHR, LDS_BYTES) != hipSuccess || per_cu < 1) { fprintf(stderr, "kernel_launch: occupancy query says %d blocks per CU\n", per_cu); (void)hipGetLastError(); grid = -1; return; }
        grid = cus;
        if (grid > 256) grid = 256;
    }
    if (grid < 0) return;
    (void)hipMemsetAsync((char*)d_ws + WS_CTL, 0, CTL_ZERO_BYTES, stream);
    Args a{};
    for (int i = 0; i < 36; ++i) a.in[i] = (const float*)d_in[i];
    a.out = (float*)d_out; a.ws = (unsigned char*)d_ws;
#if MK_N_LAUNCHES == 1
    a.ph_lo = 0; a.ph_hi = NPHASE;
    void* kargs[] = {&a};
    const hipError_t e = hipLaunchCooperativeKernel((const void*)mk_fwd, dim3(grid), dim3(NTHR), kargs, LDS_BYTES, stream);
    if (e != hipSuccess) fprintf(stderr, "kernel_launch: cooperative launch failed: %s (grid %d)\n", hipGetErrorString(e), grid);
#else
    for (int ph = 0; ph < NPHASE; ++ph) { a.ph_lo = ph; a.ph_hi = ph + 1; hipLaunchKernelGGL(mk_fwd, dim3(grid), dim3(NTHR), LDS_BYTES, stream, a); }
#endif
}
```

```cpp
#include <hip/hip_runtime.h>
#include <hip/hip_cooperative_groups.h>
#include <cstdio>
#include <cstdint>
namespace cg = cooperative_groups;
namespace pg8 {
#define PG8_LAS __attribute__((address_space(3)))
typedef unsigned short bf16_t;
typedef short bf16x8 __attribute__((ext_vector_type(8)));
typedef float f32x4 __attribute__((ext_vector_type(4)));
typedef unsigned u32x4 __attribute__((ext_vector_type(4)));
constexpr int BM = 256, BK = 64, HALF = 128, HTB = HALF * BK * 2  , STAGE_BYTES = 8 * HTB, NXCD = 8, WGM = 8;

__host__ __device__ __forceinline__ int lds_byte(int r, int c) { const int st = (r >> 4) * 2 + (c >> 5), rr = r & 15, cc = c & 31, ob = rr * 64 + cc * 2; return st * 1024 + (ob ^ (((ob >> 9) & 1) << 5)); }
__host__ __device__ __forceinline__ void stage_rc(int b, int& R, int& C) { const int st = b / 1024, sb = b % 1024, swz = sb ^ (((sb >> 9) & 1) << 5); R = (st >> 1) * 16 + swz / 64; C = (st & 1) * 32 + (swz % 64) / 2; }
__host__ __device__ __forceinline__ int perm32(int rho) { const int n = rho >> 4, i = rho & 15; return 8 * (i >> 2) + 4 * n + (i & 3); }

struct Unit { int pm, pn; };
struct Gemm { const bf16_t* A; const bf16_t* Bt; int M, N, K; };

struct StaticOrder {
    int nM, nN, nwg, G, c;
    __host__ __device__ __forceinline__ void init(int M, int N, int G_, int c_) { nM = M / BM; nN = N / BM; nwg = nM * nN; G = G_; c = c_; }
    __host__ __device__ __forceinline__ bool next(int i, Unit& u) const {
        const long L = (long)i * G + c; if (L >= nwg) return false;
        int wgid = (int)L; { const int q = nwg / NXCD, r = nwg % NXCD, xcd = wgid % NXCD, off = wgid / NXCD; wgid = (xcd < r ? xcd * (q + 1) : r * (q + 1) + (xcd - r) * q) + off; }
        const int nig = WGM * nN, gid = wgid / nig, fm = gid * WGM, gsz = (nM - fm) < WGM ? (nM - fm) : WGM;
        u.pm = fm + ((wgid % nig) % gsz); u.pn = (wgid % nig) / gsz; return true;
    }
    __device__ __forceinline__ void a_ready(const Unit&) const {}
    __device__ __forceinline__ void done(const Unit&) const {}
};

__device__ __forceinline__ unsigned cvt_pk_bf16(float lo, float hi) { unsigned r; asm volatile("v_cvt_pk_bf16_f32 %0, %1, %2" : "=v"(r) : "v"(lo), "v"(hi)); return r; }
template <class Epi, class Sched, bool ALIGN_EPI = false, bool SP2 = false>
__device__ __forceinline__ void gemm_phase(PG8_LAS unsigned char* lds, const Gemm g, const Sched& S, const Epi& E, const int tz = 0  ) {
    const int tid = threadIdx.x + tz, wid = __builtin_amdgcn_readfirstlane(tid >> 6), lane = tid & 63, wr = wid >> 2, wc = wid & 3, fr = lane & 15, fq = lane >> 4;
    const int K = g.K, nt = K / BK;
    unsigned voffA[2], voffB[2];
#pragma unroll
    for (int i = 0; i < 2; ++i) { int R, C; stage_rc(tid * 16 + i * 8192, R, C); const int Rb = Epi::PERM ? ((R & ~31) + perm32(R & 31)) : R;
        voffA[i] = (unsigned)(R * K + C) * 2u; voffB[i] = (unsigned)(Rb * K + C) * 2u; }
    const size_t kstep = (size_t)(BK * 2);
    const size_t hstep = (size_t)HALF * K * 2;
    const size_t tstep = 2 * hstep;
    const unsigned ldsw = (unsigned)wid * 1024u;
    const int aoff = lds_byte(wr * 64 + fr, fq * 8), boff = lds_byte(wc * 32 + fr, fq * 8);
#define PG8_SA(b, h) (((b) * 2 + (h)) * HTB)
#define PG8_SB(b, h) ((4 + (b) * 2 + (h)) * HTB)
#define PG8_STAGE(bufoff, gbase, voff) do { _Pragma("unroll") for (int _i = 0; _i < 2; ++_i) \
        __builtin_amdgcn_global_load_lds((const unsigned*)((const char*)(gbase) + (voff)[_i]), (PG8_LAS unsigned*)(lds + (bufoff) + ldsw + _i * 8192), 16, 0, 0); } while (0)
#define PG8_LDA(dst, b, h) do { _Pragma("unroll") for (int m = 0; m < 4; ++m) _Pragma("unroll") for (int k = 0; k < 2; ++k) dst[m][k] = *(const PG8_LAS bf16x8*)(lds + PG8_SA(b, h) + aoff + m * 2048 + k * 1024); } while (0)
#define PG8_LDB(dst, b, h) do { _Pragma("unroll") for (int n = 0; n < 2; ++n) _Pragma("unroll") for (int k = 0; k < 2; ++k) dst[n][k] = *(const PG8_LAS bf16x8*)(lds + PG8_SB(b, h) + boff + n * 2048 + k * 1024); } while (0)
#define PG8_MMA(ai, bj, At, Bt) do { __builtin_amdgcn_s_setprio(1); _Pragma("unroll") for (int m = 0; m < 4; ++m) _Pragma("unroll") for (int n = 0; n < 2; ++n) _Pragma("unroll") for (int k = 0; k < 2; ++k) \
        acc[ai][bj][m][n] = __builtin_amdgcn_mfma_f32_16x16x32_bf16(Bt[n][k], At[m][k], acc[ai][bj][m][n], 0, 0, 0); __builtin_amdgcn_s_setprio(0); } while (0)
#define PG8_WAIT_V(n) asm volatile("s_waitcnt vmcnt(" #n ")" ::: "memory")
#define PG8_WAIT_L(n) asm volatile("s_waitcnt lgkmcnt(" #n ")" ::: "memory")
#define PG8_BAR __builtin_amdgcn_s_barrier()
#define PG8_SCHED __builtin_amdgcn_sched_barrier(0)
    Unit cur, nxt; int ui = 0;
    if (!S.next(0, cur)) return;
    f32x4 acc[2][2][4][2];
#pragma unroll
    for (int a = 0; a < 2; ++a)
#pragma unroll
        for (int b = 0; b < 2; ++b)
#pragma unroll
            for (int m = 0; m < 4; ++m)
#pragma unroll
                for (int n = 0; n < 2; ++n) acc[a][b][m][n] = (f32x4){0.f, 0.f, 0.f, 0.f};
    bf16x8 At[4][2], B0[2][2], B1[2][2];
    const char* cA = (const char*)g.A + (size_t)cur.pm * tstep; const char* cB = (const char*)g.Bt + (size_t)cur.pn * tstep;
    S.a_ready(cur);
    if constexpr (SP2) {
        PG8_STAGE(PG8_SB(0, 0), cB, voffB); PG8_STAGE(PG8_SB(0, 1), cB + hstep, voffB); PG8_STAGE(PG8_SA(0, 0), cA, voffA); PG8_STAGE(PG8_SA(0, 1), cA + hstep, voffA);
        if (wr == 1) PG8_BAR;
        PG8_WAIT_V(2); PG8_BAR;
        PG8_STAGE(PG8_SB(1, 0), cB + kstep, voffB); PG8_STAGE(PG8_SA(1, 0), cA + kstep, voffA); PG8_STAGE(PG8_SB(1, 1), cB + hstep + kstep, voffB);
        PG8_WAIT_V(6); PG8_BAR;
    } else {
        PG8_STAGE(PG8_SB(0, 0), cB, voffB); PG8_STAGE(PG8_SA(0, 0), cA, voffA); PG8_STAGE(PG8_SB(0, 1), cB + hstep, voffB); PG8_STAGE(PG8_SA(0, 1), cA + hstep, voffA);
        if (wr == 1) PG8_BAR;
        PG8_WAIT_V(4); PG8_BAR;
        PG8_STAGE(PG8_SB(1, 0), cB + kstep, voffB); PG8_STAGE(PG8_SA(1, 0), cA + kstep, voffA); PG8_STAGE(PG8_SB(1, 1), cB + hstep + kstep, voffB);
        PG8_WAIT_V(6); PG8_BAR;
    }
    for (;;) {
        const bool has_next = S.next(ui + 1, nxt);
        const char* nA = has_next ? (const char*)g.A + (size_t)nxt.pm * tstep : cA; const char* nB = has_next ? (const char*)g.Bt + (size_t)nxt.pn * tstep : cB;
        for (int t = 0; t < nt; t += 2) {
            if constexpr (Epi::HAS_MID) { if (t == (nt >> 1)) E.mid(acc, cur, wr, wc, fr, fq); }
            const bool last = (t == nt - 2);
            const char* a1 = cA + (size_t)(t + 1) * kstep;
            const char* a2 = last ? nA : cA + (size_t)(t + 2) * kstep; const char* b2 = last ? nB : cB + (size_t)(t + 2) * kstep;
            const char* a3 = a2 + kstep; const char* b3 = b2 + kstep;
            if (last && has_next) S.a_ready(nxt);
            if constexpr (SP2) {
            PG8_LDB(B0, 0, 0); PG8_LDB(B1, 0, 1); PG8_SCHED; PG8_LDA(At, 0, 0); PG8_STAGE(PG8_SA(1, 1), a1 + hstep, voffA);
            PG8_WAIT_V(8); PG8_WAIT_L(0); PG8_BAR; PG8_MMA(0, 0, At, B0); PG8_MMA(0, 1, At, B1); PG8_BAR; PG8_SCHED;
            PG8_LDA(At, 0, 1); PG8_STAGE(PG8_SB(0, 0), b2, voffB); PG8_STAGE(PG8_SB(0, 1), b2 + hstep, voffB); PG8_STAGE(PG8_SA(0, 0), a2, voffA);
            PG8_WAIT_V(8); PG8_WAIT_L(0); PG8_BAR; PG8_MMA(1, 0, At, B0); PG8_MMA(1, 1, At, B1); PG8_BAR; PG8_SCHED;
            PG8_LDB(B0, 1, 0); PG8_LDB(B1, 1, 1); PG8_SCHED; PG8_LDA(At, 1, 0); PG8_STAGE(PG8_SA(0, 1), a2 + hstep, voffA);
            PG8_WAIT_V(8); PG8_WAIT_L(0); PG8_BAR; PG8_MMA(0, 0, At, B0); PG8_MMA(0, 1, At, B1); PG8_BAR; PG8_SCHED;
            PG8_LDA(At, 1, 1); PG8_STAGE(PG8_SB(1, 0), b3, voffB); PG8_STAGE(PG8_SB(1, 1), b3 + hstep, voffB); PG8_STAGE(PG8_SA(1, 0), a3, voffA);
            PG8_WAIT_V(8); PG8_WAIT_L(0); PG8_BAR; PG8_MMA(1, 0, At, B0); PG8_MMA(1, 1, At, B1); PG8_BAR; PG8_SCHED;
            } else {
            PG8_LDB(B0, 0, 0); PG8_SCHED; PG8_LDA(At, 0, 0); PG8_STAGE(PG8_SA(1, 1), a1 + hstep, voffA);
            PG8_WAIT_L(8); PG8_BAR; PG8_WAIT_L(0); PG8_MMA(0, 0, At, B0); PG8_BAR; PG8_SCHED;
            PG8_LDB(B1, 0, 1); PG8_STAGE(PG8_SB(0, 0), b2, voffB);
            PG8_BAR; PG8_WAIT_L(0); PG8_MMA(0, 1, At, B1); PG8_BAR;
            PG8_LDA(At, 0, 1); PG8_STAGE(PG8_SA(0, 0), a2, voffA);
            PG8_BAR; PG8_WAIT_L(0); PG8_MMA(1, 0, At, B0); PG8_BAR; PG8_SCHED;
            PG8_STAGE(PG8_SB(0, 1), b2 + hstep, voffB);
            PG8_WAIT_V(6); PG8_BAR; PG8_MMA(1, 1, At, B1); PG8_BAR;
            PG8_LDB(B0, 1, 0); PG8_SCHED; PG8_LDA(At, 1, 0); PG8_STAGE(PG8_SA(0, 1), a2 + hstep, voffA);
            PG8_WAIT_L(8); PG8_BAR; PG8_WAIT_L(0); PG8_MMA(0, 0, At, B0); PG8_BAR; PG8_SCHED;
            PG8_LDB(B1, 1, 1); PG8_STAGE(PG8_SB(1, 0), b3, voffB);
            PG8_BAR; PG8_WAIT_L(0); PG8_MMA(0, 1, At, B1); PG8_BAR;
            PG8_LDA(At, 1, 1); PG8_STAGE(PG8_SA(1, 0), a3, voffA);
            PG8_BAR; PG8_WAIT_L(0); PG8_MMA(1, 0, At, B0); PG8_BAR; PG8_SCHED;
            PG8_STAGE(PG8_SB(1, 1), b3 + hstep, voffB);
            PG8_WAIT_V(6); PG8_BAR; PG8_MMA(1, 1, At, B1); PG8_BAR;
            }
        }
        if constexpr (ALIGN_EPI) { if (wr == 0) PG8_BAR; }
        if constexpr (!Epi::AFTER_DRAIN) { E(acc, cur, wr, wc, fr, fq); S.done(cur); }
        if (!has_next) break;
#pragma unroll
        for (int a = 0; a < 2; ++a)
#pragma unroll
            for (int b = 0; b < 2; ++b)
#pragma unroll
                for (int m = 0; m < 4; ++m)
#pragma unroll
                    for (int n = 0; n < 2; ++n) acc[a][b][m][n] = (f32x4){0.f, 0.f, 0.f, 0.f};
        cur = nxt; cA = nA; cB = nB; ++ui;
        if constexpr (ALIGN_EPI) { if (wr == 1) PG8_BAR; }
    }
    PG8_WAIT_V(0);
    if constexpr (!ALIGN_EPI) { if (wr == 0) PG8_BAR; }
    PG8_BAR;
    if constexpr (Epi::AFTER_DRAIN) { E.fused(acc, cur, wr, wc, fr, fq, lds, wid, lane); S.done(cur); }
#undef PG8_SA
#undef PG8_SB
#undef PG8_STAGE
#undef PG8_LDA
#undef PG8_LDB
#undef PG8_MMA
#undef PG8_WAIT_V
#undef PG8_WAIT_L
#undef PG8_BAR
#undef PG8_SCHED
}
template <class Epi, class Sched>
__device__ __forceinline__ void gemm_phase_gather(PG8_LAS unsigned char* lds, const Gemm g, const int* idx, const Sched& S, const Epi& E, const int tz = 0  ) {
    const int tid = threadIdx.x + tz, wid = __builtin_amdgcn_readfirstlane(tid >> 6), lane = tid & 63, wr = wid >> 2, wc = wid & 3, fr = lane & 15, fq = lane >> 4;
    const int K = g.K, nt = K / BK;
    unsigned voffA[2], voffB[2];
    int rowA[2];
#pragma unroll
    for (int i = 0; i < 2; ++i) { int R, C; stage_rc(tid * 16 + i * 8192, R, C); const int Rb = Epi::PERM ? ((R & ~31) + perm32(R & 31)) : R;
        voffA[i] = (unsigned)C * 2u; rowA[i] = R; voffB[i] = (unsigned)(Rb * K + C) * 2u; }
    unsigned vA0[2], vA1[2], vN0[2], vN1[2];
#define PG8_GOFF(dst0, dst1, pm_) do { _Pragma("unroll") for (int _i = 0; _i < 2; ++_i) { dst0[_i] = (unsigned)idx[(pm_) * BM + rowA[_i]] * (unsigned)(K * 2) + voffA[_i]; dst1[_i] = (unsigned)idx[(pm_) * BM + HALF + rowA[_i]] * (unsigned)(K * 2) + voffA[_i]; } } while (0)
    const size_t kstep = (size_t)(BK * 2);
    const size_t hstep = (size_t)HALF * K * 2;
    const size_t tstep = 2 * hstep;
    const unsigned ldsw = (unsigned)wid * 1024u;
    const int aoff = lds_byte(wr * 64 + fr, fq * 8), boff = lds_byte(wc * 32 + fr, fq * 8);
#define PG8_SA(b, h) (((b) * 2 + (h)) * HTB)
#define PG8_SB(b, h) ((4 + (b) * 2 + (h)) * HTB)
#define PG8_STAGE(bufoff, gbase, voff) do { _Pragma("unroll") for (int _i = 0; _i < 2; ++_i) \
        __builtin_amdgcn_global_load_lds((const unsigned*)((const char*)(gbase) + (voff)[_i]), (PG8_LAS unsigned*)(lds + (bufoff) + ldsw + _i * 8192), 16, 0, 0); } while (0)
#define PG8_LDA(dst, b, h) do { _Pragma("unroll") for (int m = 0; m < 4; ++m) _Pragma("unroll") for (int k = 0; k < 2; ++k) dst[m][k] = *(const PG8_LAS bf16x8*)(lds + PG8_SA(b, h) + aoff + m * 2048 + k * 1024); } while (0)
#define PG8_LDB(dst, b, h) do { _Pragma("unroll") for (int n = 0; n < 2; ++n) _Pragma("unroll") for (int k = 0; k < 2; ++k) dst[n][k] = *(const PG8_LAS bf16x8*)(lds + PG8_SB(b, h) + boff + n * 2048 + k * 1024); } while (0)
#define PG8_MMA(ai, bj, At, Bt) do { __builtin_amdgcn_s_setprio(1); _Pragma("unroll") for (int m = 0; m < 4; ++m) _Pragma("unroll") for (int n = 0; n < 2; ++n) _Pragma("unroll") for (int k = 0; k < 2; ++k) \
        acc[ai][bj][m][n] = __builtin_amdgcn_mfma_f32_16x16x32_bf16(Bt[n][k], At[m][k], acc[ai][bj][m][n], 0, 0, 0); __builtin_amdgcn_s_setprio(0); } while (0)
#define PG8_WAIT_V(n) asm volatile("s_waitcnt vmcnt(" #n ")" ::: "memory")
#define PG8_WAIT_L(n) asm volatile("s_waitcnt lgkmcnt(" #n ")" ::: "memory")
#define PG8_BAR __builtin_amdgcn_s_barrier()
#define PG8_SCHED __builtin_amdgcn_sched_barrier(0)
    Unit cur, nxt; int ui = 0;
    if (!S.next(0, cur)) return;
    f32x4 acc[2][2][4][2];
#pragma unroll
    for (int a = 0; a < 2; ++a)
#pragma unroll
        for (int b = 0; b < 2; ++b)
#pragma unroll
            for (int m = 0; m < 4; ++m)
#pragma unroll
                for (int n = 0; n < 2; ++n) acc[a][b][m][n] = (f32x4){0.f, 0.f, 0.f, 0.f};
    bf16x8 At[4][2], B0[2][2], B1[2][2];
    const char* cA = (const char*)g.A; PG8_GOFF(vA0, vA1, cur.pm); const char* cB = (const char*)g.Bt + (size_t)cur.pn * tstep;
    S.a_ready(cur);
    if constexpr (true) {
        PG8_STAGE(PG8_SB(0, 0), cB, voffB); PG8_STAGE(PG8_SB(0, 1), cB + hstep, voffB); PG8_STAGE(PG8_SA(0, 0), cA, vA0); PG8_STAGE(PG8_SA(0, 1), cA, vA1);
        if (wr == 1) PG8_BAR;
        PG8_WAIT_V(2); PG8_BAR;
        PG8_STAGE(PG8_SB(1, 0), cB + kstep, voffB); PG8_STAGE(PG8_SA(1, 0), cA + kstep, vA0); PG8_STAGE(PG8_SB(1, 1), cB + hstep + kstep, voffB);
        PG8_WAIT_V(6); PG8_BAR;
    } else {
        PG8_STAGE(PG8_SB(0, 0), cB, voffB); PG8_STAGE(PG8_SA(0, 0), cA, voffA); PG8_STAGE(PG8_SB(0, 1), cB + hstep, voffB); PG8_STAGE(PG8_SA(0, 1), cA + hstep, voffA);
        if (wr == 1) PG8_BAR;
        PG8_WAIT_V(4); PG8_BAR;
        PG8_STAGE(PG8_SB(1, 0), cB + kstep, voffB); PG8_STAGE(PG8_SA(1, 0), cA + kstep, vA0); PG8_STAGE(PG8_SB(1, 1), cB + hstep + kstep, voffB);
        PG8_WAIT_V(6); PG8_BAR;
    }
    for (;;) {
        const bool has_next = S.next(ui + 1, nxt);
        const char* nA = cA; if (has_next) PG8_GOFF(vN0, vN1, nxt.pm); else { vN0[0] = vA0[0]; vN0[1] = vA0[1]; vN1[0] = vA1[0]; vN1[1] = vA1[1]; } const char* nB = has_next ? (const char*)g.Bt + (size_t)nxt.pn * tstep : cB;
        for (int t = 0; t < nt; t += 2) {
            if constexpr (Epi::HAS_MID) { if (t == (nt >> 1)) E.mid(acc, cur, wr, wc, fr, fq); }
            const bool last = (t == nt - 2);
            const char* a1 = cA + (size_t)(t + 1) * kstep;
            const char* a2 = last ? nA : cA + (size_t)(t + 2) * kstep; unsigned x0[2], x1[2]; x0[0] = last ? vN0[0] : vA0[0]; x0[1] = last ? vN0[1] : vA0[1]; x1[0] = last ? vN1[0] : vA1[0]; x1[1] = last ? vN1[1] : vA1[1]; const char* b2 = last ? nB : cB + (size_t)(t + 2) * kstep;
            const char* a3 = a2 + kstep; const char* b3 = b2 + kstep;
            if (last && has_next) S.a_ready(nxt);
            if constexpr (true) {
            PG8_LDB(B0, 0, 0); PG8_LDB(B1, 0, 1); PG8_SCHED; PG8_LDA(At, 0, 0); PG8_STAGE(PG8_SA(1, 1), a1, vA1);
            PG8_WAIT_V(8); PG8_WAIT_L(0); PG8_BAR; PG8_MMA(0, 0, At, B0); PG8_MMA(0, 1, At, B1); PG8_BAR; PG8_SCHED;
            PG8_LDA(At, 0, 1); PG8_STAGE(PG8_SB(0, 0), b2, voffB); PG8_STAGE(PG8_SB(0, 1), b2 + hstep, voffB); PG8_STAGE(PG8_SA(0, 0), a2, x0);
            PG8_WAIT_V(8); PG8_WAIT_L(0); PG8_BAR; PG8_MMA(1, 0, At, B0); PG8_MMA(1, 1, At, B1); PG8_BAR; PG8_SCHED;
            PG8_LDB(B0, 1, 0); PG8_LDB(B1, 1, 1); PG8_SCHED; PG8_LDA(At, 1, 0); PG8_STAGE(PG8_SA(0, 1), a2, x1);
            PG8_WAIT_V(8); PG8_WAIT_L(0); PG8_BAR; PG8_MMA(0, 0, At, B0); PG8_MMA(0, 1, At, B1); PG8_BAR; PG8_SCHED;
            PG8_LDA(At, 1, 1); PG8_STAGE(PG8_SB(1, 0), b3, voffB); PG8_STAGE(PG8_SB(1, 1), b3 + hstep, voffB); PG8_STAGE(PG8_SA(1, 0), a3, x0);
            PG8_WAIT_V(8); PG8_WAIT_L(0); PG8_BAR; PG8_MMA(1, 0, At, B0); PG8_MMA(1, 1, At, B1); PG8_BAR; PG8_SCHED;
            } else {
            PG8_LDB(B0, 0, 0); PG8_SCHED; PG8_LDA(At, 0, 0); PG8_STAGE(PG8_SA(1, 1), a1, vA1);
            PG8_WAIT_L(8); PG8_BAR; PG8_WAIT_L(0); PG8_MMA(0, 0, At, B0); PG8_BAR; PG8_SCHED;
            PG8_LDB(B1, 0, 1); PG8_STAGE(PG8_SB(0, 0), b2, voffB);
            PG8_BAR; PG8_WAIT_L(0); PG8_MMA(0, 1, At, B1); PG8_BAR;
            PG8_LDA(At, 0, 1); PG8_STAGE(PG8_SA(0, 0), a2, x0);
            PG8_BAR; PG8_WAIT_L(0); PG8_MMA(1, 0, At, B0); PG8_BAR; PG8_SCHED;
            PG8_STAGE(PG8_SB(0, 1), b2 + hstep, voffB);
            PG8_WAIT_V(6); PG8_BAR; PG8_MMA(1, 1, At, B1); PG8_BAR;
            PG8_LDB(B0, 1, 0); PG8_SCHED; PG8_LDA(At, 1, 0); PG8_STAGE(PG8_SA(0, 1), a2, x1);
            PG8_WAIT_L(8); PG8_BAR; PG8_WAIT_L(0); PG8_MMA(0, 0, At, B0); PG8_BAR; PG8_SCHED;
            PG8_LDB(B1, 1, 1); PG8_STAGE(PG8_SB(1, 0), b3, voffB);
            PG8_BAR; PG8_WAIT_L(0); PG8_MMA(0, 1, At, B1); PG8_BAR;
            PG8_LDA(At, 1, 1); PG8_STAGE(PG8_SA(1, 0), a3, x0);
            PG8_BAR; PG8_WAIT_L(0); PG8_MMA(1, 0, At, B0); PG8_BAR; PG8_SCHED;
            PG8_STAGE(PG8_SB(1, 1), b3 + hstep, voffB);
            PG8_WAIT_V(6); PG8_BAR; PG8_MMA(1, 1, At, B1); PG8_BAR;
            }
        }
        if constexpr (true) { if (wr == 0) PG8_BAR; }
        if constexpr (!Epi::AFTER_DRAIN) { E(acc, cur, wr, wc, fr, fq); S.done(cur); }
        if (!has_next) break;
#pragma unroll
        for (int a = 0; a < 2; ++a)
#pragma unroll
            for (int b = 0; b < 2; ++b)
#pragma unroll
                for (int m = 0; m < 4; ++m)
#pragma unroll
                    for (int n = 0; n < 2; ++n) acc[a][b][m][n] = (f32x4){0.f, 0.f, 0.f, 0.f};
        cur = nxt; cA = nA; cB = nB; ++ui; vA0[0] = vN0[0]; vA0[1] = vN0[1]; vA1[0] = vN1[0]; vA1[1] = vN1[1];
        if constexpr (true) { if (wr == 1) PG8_BAR; }
    }
    PG8_WAIT_V(0);
    if constexpr (false) { if (wr == 0) PG8_BAR; }
    PG8_BAR;
    if constexpr (Epi::AFTER_DRAIN) { E.fused(acc, cur, wr, wc, fr, fq, lds, wid, lane); S.done(cur); }
#undef PG8_SA
#undef PG8_SB
#undef PG8_GOFF
#undef PG8_STAGE
#undef PG8_LDA
#undef PG8_LDB
#undef PG8_MMA
#undef PG8_WAIT_V
#undef PG8_WAIT_L
#undef PG8_BAR
#undef PG8_SCHED
}
}

constexpr int NB = 8, SEQ = 4096, DM = 1024, T = NB * SEQ;
constexpr int RW = 512, NHR = 8;
constexpr int NPROJ = 5376;
constexpr int FF = 512, NEXP = 32;
constexpr float C2 = 0.125f * 1.4426950408889634f;
constexpr float LAM_INIT = 0.2f;
constexpr int MAXROWS = 2 * T + NEXP * 256;

constexpr size_t MiB = 1u << 20;
constexpr size_t WS_CTL = 0, CTL_ZERO_BYTES = 1 * MiB;
constexpr size_t WS_WLORA = 1 * MiB;
constexpr size_t WS_WBRD = 2 * MiB;
constexpr size_t WS_WO = 4 * MiB;
constexpr size_t WS_WR = 6 * MiB;
constexpr size_t WS_WPG = 7 * MiB;
constexpr size_t WS_WPP = 9 * MiB;
constexpr size_t WS_TOKE = 10 * MiB;
constexpr size_t WS_TOKW = 10 * MiB + 256 * 1024;
constexpr size_t WS_POS = 10 * MiB + 512 * 1024;
constexpr size_t WS_ROWW = 10 * MiB + 768 * 1024;
constexpr size_t WS_TILECNT = 11 * MiB + 256 * 1024;
constexpr size_t WS_DISP = 11 * MiB + 512 * 1024;
constexpr size_t WS_BON = 12 * MiB;
constexpr size_t WS_ROWTOK = 13 * MiB;
constexpr size_t WS_RS = 13 * MiB + 512 * 1024;
constexpr size_t WS_ROWRS = 13 * MiB + 640 * 1024;
constexpr size_t WS_SSQ = 14 * MiB;
constexpr size_t WS_WIN = 16 * MiB;
constexpr size_t WS_LOGITS = 16 * MiB;
constexpr size_t WS_XN = 32 * MiB;
constexpr size_t WS_WGU = 32 * MiB;
constexpr size_t WS_RKV = 96 * MiB;
constexpr size_t WS_MIXED = 96 * MiB;
constexpr size_t WS_WD = 96 * MiB;
constexpr size_t WS_HS = 128 * MiB;
constexpr size_t WS_H3 = 128 * MiB;
constexpr size_t WS_PROJB = 192 * MiB;
constexpr size_t WS_E = 192 * MiB;
constexpr size_t WS_A = 224 * MiB;
constexpr size_t WS_G = 256 * MiB;
constexpr size_t WS_P16 = 192 * MiB;
constexpr size_t WS_PP = 208 * MiB;
constexpr size_t WS_Y2 = 272 * MiB;
constexpr size_t WS_GATES = 304 * MiB;
constexpr size_t WS_H2X = 304 * MiB;
constexpr size_t WS_VT = 432 * MiB;
constexpr size_t WS_ACT = 432 * MiB;
constexpr size_t WS_X2 = 432 * MiB;
constexpr size_t WS_PART = 176 * MiB;
constexpr size_t WS_END = 512 * MiB;
constexpr size_t OUT_STASH = 0, OUT_ORWDF = 32 * MiB, OUT_Y = 96 * MiB  , OUT_LA = 0  ;
static_assert(WS_ACT + (size_t)MAXROWS * 512 * 2 <= WS_END && WS_Y2 + (size_t)MAXROWS * 1024 * 2 <= WS_ACT && WS_HS + (size_t)MAXROWS * 1024 * 2 <= WS_Y2, "ws map");
static_assert(WS_PART + (size_t)T * 1024 * 4 <= WS_GATES && WS_MIXED + (size_t)T * 1024 * 2 <= WS_PART, "ws map");
constexpr int CW_QUEUE = 64;
constexpr int CW_MOECNT = 512;
constexpr int CW_BAR = 4096;

constexpr int RING_BYTES = 131072;
constexpr int MISC_OFF = 158720;
constexpr int LDS_BYTES = 160768;
constexpr int NWAVES = 8, NTHR = 512;

#define GAS __attribute__((address_space(1)))
#define LAS __attribute__((address_space(3)))
typedef unsigned short bf16;
typedef unsigned v4u __attribute__((ext_vector_type(4)));
typedef unsigned v2u __attribute__((ext_vector_type(2)));
typedef float f32x4 __attribute__((ext_vector_type(4)));
typedef float f32x16 __attribute__((ext_vector_type(16)));
typedef short s16x8 __attribute__((ext_vector_type(8)));
typedef short s16x4 __attribute__((ext_vector_type(4)));
#define LDS_WAIT() asm volatile("s_waitcnt lgkmcnt(0)" ::: "memory")
#define VM_WAIT() asm volatile("s_waitcnt vmcnt(0)" ::: "memory")

__device__ __forceinline__ bf16* y_ptr(float* out, int b) { return (bf16*)((unsigned char*)out + OUT_Y) + (size_t)b * SEQ * 512; }
__device__ __forceinline__ bf16* qn_ptr(unsigned char* ws, int b) { return (bf16*)(ws + (b < 4 ? (288 + 4 * (size_t)b) * MiB : (464 + 4 * (size_t)(b - 4)) * MiB)); }
__device__ __forceinline__ bf16* kn_ptr(unsigned char* ws, int b) { return (bf16*)(ws + (480 + 4 * (size_t)b) * MiB); }
__device__ __forceinline__ unsigned f2bf(float f) { unsigned u = __builtin_bit_cast(unsigned, f); return (u + 0x7fffu + ((u >> 16) & 1u)) >> 16; }
typedef float f32x2_t __attribute__((ext_vector_type(2))); typedef __bf16 bf16x2_t __attribute__((ext_vector_type(2)));
__device__ __forceinline__ unsigned pk2(float lo, float hi) { f32x2_t v = {lo, hi}; bf16x2_t b = __builtin_convertvector(v, bf16x2_t); return __builtin_bit_cast(unsigned, b); }
__device__ __forceinline__ float bflo(unsigned w) { return __builtin_bit_cast(float, w << 16); }
__device__ __forceinline__ float bfhi(unsigned w) { return __builtin_bit_cast(float, w & 0xffff0000u); }
__device__ __forceinline__ float sigm(float x) { return __builtin_amdgcn_rcpf(1.0f + __builtin_amdgcn_exp2f(-1.4426950408889634f * x)); }
template <int CTRL> __device__ __forceinline__ float dpp_mov(float v) { return __builtin_bit_cast(float, __builtin_amdgcn_update_dpp(0, __builtin_bit_cast(int, v), CTRL, 0xF, 0xF, false)); }
__device__ __forceinline__ float red8(float v) { v += dpp_mov<0xB1>(v); v += dpp_mov<0x4E>(v); v += dpp_mov<0x141>(v); return v; }
__device__ __forceinline__ float red16(float v) { v = red8(v); v += dpp_mov<0x140>(v); return v; }
__device__ __forceinline__ void swap32(unsigned& a, unsigned& b) { asm volatile("s_nop 1\n\tv_permlane32_swap_b32 %0, %1\n\ts_nop 1" : "+v"(a), "+v"(b)); }
__device__ __forceinline__ float xhalf_max(float m) { unsigned a = __builtin_bit_cast(unsigned, m), b = a; swap32(a, b); return fmaxf(__builtin_bit_cast(float, a), __builtin_bit_cast(float, b)); }
__device__ __forceinline__ float xhalf_sum(float m) { unsigned a = __builtin_bit_cast(unsigned, m), b = a; swap32(a, b); return __builtin_bit_cast(float, a) + __builtin_bit_cast(float, b); }
__device__ __forceinline__ float wave_sum(float v) { v = red16(v); v += __shfl_xor(v, 16); return xhalf_sum(v); }

namespace pg8 {
struct EpiStore {
    static constexpr bool PERM = true, AFTER_DRAIN = false, HAS_MID = false;
    bf16_t* O; int ldc;
    __device__ __forceinline__ void operator()(const f32x4 (&acc)[2][2][4][2], const Unit& u, int wr, int wc, int fr, int fq) const {
        const int row0 = u.pm * BM + wr * 64 + fr, col0 = u.pn * BM + wc * 32 + 8 * fq;
#pragma unroll
        for (int ai = 0; ai < 2; ++ai)
#pragma unroll
            for (int m = 0; m < 4; ++m) { bf16_t* rowp = O + (size_t)(row0 + ai * HALF + m * 16) * ldc + col0;
#pragma unroll
                for (int bj = 0; bj < 2; ++bj) { const f32x4 v0 = acc[ai][bj][m][0], v1 = acc[ai][bj][m][1]; u32x4 w;
                    w.x = cvt_pk_bf16(v0[0], v0[1]); w.y = cvt_pk_bf16(v0[2], v0[3]); w.z = cvt_pk_bf16(v1[0], v1[1]); w.w = cvt_pk_bf16(v1[2], v1[3]);
                    *(u32x4*)(rowp + bj * HALF) = w; } }
    }
};
struct EpiProj {
    static constexpr bool PERM = true, AFTER_DRAIN = false, HAS_MID = false;
    bf16_t *rkv, *projb, *gates;
    __device__ __forceinline__ void operator()(const f32x4 (&acc)[2][2][4][2], const Unit& u, int wr, int wc, int fr, int fq) const {
        bf16_t* base; int ldc, ct;
        if (u.pn < 6) { base = rkv; ldc = 1536; ct = u.pn; } else if (u.pn < 11) { base = projb; ldc = 1280; ct = u.pn - 6; } else { base = gates; ldc = 2048; ct = u.pn - 13; }
        const int row0 = u.pm * BM + wr * 64 + fr, col0 = ct * BM + wc * 32 + 8 * fq;
#pragma unroll
        for (int ai = 0; ai < 2; ++ai)
#pragma unroll
            for (int m = 0; m < 4; ++m) { bf16_t* rowp = base + (size_t)(row0 + ai * HALF + m * 16) * ldc + col0;
#pragma unroll
                for (int bj = 0; bj < 2; ++bj) { f32x4 v0 = acc[ai][bj][m][0], v1 = acc[ai][bj][m][1]; u32x4 w;
                    if (u.pn >= 13) {
#pragma unroll
                        for (int e = 0; e < 4; ++e) { v0[e] = fmaxf(sigm(v0[e]), 1e-6f); v1[e] = fmaxf(sigm(v1[e]), 1e-6f); } }
                    w.x = cvt_pk_bf16(v0[0], v0[1]); w.y = cvt_pk_bf16(v0[2], v0[3]); w.z = cvt_pk_bf16(v1[0], v1[1]); w.w = cvt_pk_bf16(v1[2], v1[3]);
                    *(u32x4*)(rowp + bj * HALF) = w; } }
    }
};
struct EpiLora {
    static constexpr bool PERM = true, AFTER_DRAIN = false, HAS_MID = false;
    bf16_t *E, *A, *G; const float *w0, *a0;
    template <int KIND> __device__ __forceinline__ void body(const f32x4 (&acc)[2][2][4][2], bf16_t* base, const float* bias, int row0, int col0) const {
#pragma unroll
        for (int bj = 0; bj < 2; ++bj)
#pragma unroll
            for (int ai = 0; ai < 2; ++ai)
#pragma unroll
                for (int m = 0; m < 4; ++m) { bf16_t* rowp = base + (size_t)(row0 + ai * HALF + m * 16) * 512 + col0 + bj * HALF;
                    f32x4 v0 = acc[ai][bj][m][0], v1 = acc[ai][bj][m][1];
                    if (KIND < 2) { const f32x4 b0 = *(const f32x4*)(bias + col0 + bj * HALF), b1 = *(const f32x4*)(bias + col0 + bj * HALF + 4); const float sc = KIND == 0 ? 0.60653065971263342f : 1.0f;
                        v0 += b0; v1 += b1;
#pragma unroll
                        for (int e = 0; e < 4; ++e) { v0[e] = sc * sigm(v0[e]); v1[e] = sc * sigm(v1[e]); } }
                    u32x4 w; w.x = cvt_pk_bf16(v0[0], v0[1]); w.y = cvt_pk_bf16(v0[2], v0[3]); w.z = cvt_pk_bf16(v1[0], v1[1]); w.w = cvt_pk_bf16(v1[2], v1[3]);
                    *(u32x4*)rowp = w; asm volatile("" ::: "memory"); }
    }
    __device__ __forceinline__ void operator()(const f32x4 (&acc)[2][2][4][2], const Unit& u, int wr, int wc, int fr, int fq) const {
        const int kind = u.pn >> 1; const int row0 = u.pm * BM + wr * 64 + fr, col0 = (u.pn & 1) * BM + wc * 32 + 8 * fq;
        if (kind == 0) body<0>(acc, E, w0, row0, col0); else if (kind == 1) body<1>(acc, A, a0, row0, col0); else body<2>(acc, G, w0, row0, col0);
    }
};
struct EpiMix {
    static constexpr bool PERM = true, AFTER_DRAIN = false, HAS_MID = true;
    const bf16_t* gates; bf16_t* mixed;
    __device__ __forceinline__ void mid(f32x4 (&acc)[2][2][4][2], const Unit& u, int wr, int wc, int fr, int fq) const {
        const int row0 = u.pm * BM + wr * 64 + fr, col0 = u.pn * BM + wc * 32 + 8 * fq;
#pragma unroll
        for (int ai = 0; ai < 2; ++ai)
#pragma unroll
            for (int m = 0; m < 4; ++m) { const size_t r = (size_t)(row0 + ai * HALF + m * 16);
#pragma unroll
                for (int bj = 0; bj < 2; ++bj) { const int c = col0 + bj * HALF;
                    const u32x4 gr = *(const u32x4*)(gates + r * 2048 + c), gd = *(const u32x4*)(gates + r * 2048 + 1024 + c);
                    f32x4& v0 = acc[ai][bj][m][0]; f32x4& v1 = acc[ai][bj][m][1];
                    v0[0] *= bflo(gr.x) * __builtin_amdgcn_rcpf(bflo(gd.x)); v0[1] *= bfhi(gr.x) * __builtin_amdgcn_rcpf(bfhi(gd.x)); v0[2] *= bflo(gr.y) * __builtin_amdgcn_rcpf(bflo(gd.y)); v0[3] *= bfhi(gr.y) * __builtin_amdgcn_rcpf(bfhi(gd.y));
                    v1[0] *= bflo(gr.z) * __builtin_amdgcn_rcpf(bflo(gd.z)); v1[1] *= bfhi(gr.z) * __builtin_amdgcn_rcpf(bfhi(gd.z)); v1[2] *= bflo(gr.w) * __builtin_amdgcn_rcpf(bflo(gd.w)); v1[3] *= bfhi(gr.w) * __builtin_amdgcn_rcpf(bfhi(gd.w)); }
                asm volatile("" ::: "memory"); }
    }
    __device__ __forceinline__ void operator()(const f32x4 (&acc)[2][2][4][2], const Unit& u, int wr, int wc, int fr, int fq) const {
        const int row0 = u.pm * BM + wr * 64 + fr, col0 = u.pn * BM + wc * 32 + 8 * fq;
#pragma unroll
        for (int ai = 0; ai < 2; ++ai)
#pragma unroll
            for (int m = 0; m < 4; ++m) { const size_t r = (size_t)(row0 + ai * HALF + m * 16);
#pragma unroll
                for (int bj = 0; bj < 2; ++bj) { const int c = col0 + bj * HALF;
                    const u32x4 gd = *(const u32x4*)(gates + r * 2048 + 1024 + c);
                    f32x4 v0 = acc[ai][bj][m][0], v1 = acc[ai][bj][m][1];
                    v0[0] *= bflo(gd.x); v0[1] *= bfhi(gd.x); v0[2] *= bflo(gd.y); v0[3] *= bfhi(gd.y); v1[0] *= bflo(gd.z); v1[1] *= bfhi(gd.z); v1[2] *= bflo(gd.w); v1[3] *= bfhi(gd.w);
                    u32x4 w; w.x = cvt_pk_bf16(v0[0], v0[1]); w.y = cvt_pk_bf16(v0[2], v0[3]); w.z = cvt_pk_bf16(v1[0], v1[1]); w.w = cvt_pk_bf16(v1[2], v1[3]);
                    *(u32x4*)(mixed + r * 1024 + c) = w; } }
    }
};
struct EpiRes {
    static constexpr bool PERM = true, AFTER_DRAIN = false, HAS_MID = false;
    const float* x; bf16_t* x1; float* ssq;
    __device__ __forceinline__ void operator()(const f32x4 (&acc)[2][2][4][2], const Unit& u, int wr, int wc, int fr, int fq) const {
        const int row0 = u.pm * BM + wr * 64 + fr, col0 = u.pn * BM + wc * 32 + 8 * fq;
#pragma unroll
        for (int ai = 0; ai < 2; ++ai)
#pragma unroll
            for (int m = 0; m < 4; ++m) { const size_t off = (size_t)(row0 + ai * HALF + m * 16) * 1024 + col0; float s = 0.f;
#pragma unroll
                for (int bj = 0; bj < 2; ++bj) { const f32x4 v0 = *(const f32x4*)(x + off + bj * HALF) + acc[ai][bj][m][0], v1 = *(const f32x4*)(x + off + bj * HALF + 4) + acc[ai][bj][m][1]; u32x4 w;
                    s += ((v0[0] * v0[0] + v0[1] * v0[1]) + (v0[2] * v0[2] + v0[3] * v0[3])) + ((v1[0] * v1[0] + v1[1] * v1[1]) + (v1[2] * v1[2] + v1[3] * v1[3]));
                    w.x = cvt_pk_bf16(v0[0], v0[1]); w.y = cvt_pk_bf16(v0[2], v0[3]); w.z = cvt_pk_bf16(v1[0], v1[1]); w.w = cvt_pk_bf16(v1[2], v1[3]);
                    *(u32x4*)(x1 + off + bj * HALF) = w; }
                s += __shfl_xor(s, 16); s = xhalf_sum(s);
                if (fq == 0) ssq[(size_t)(row0 + ai * HALF + m * 16) * 16 + u.pn * 4 + wc] = s; }
    }
};
struct EpiLogits {
    static constexpr bool PERM = false, AFTER_DRAIN = false, HAS_MID = false;
    float* L;
    __device__ __forceinline__ void operator()(const f32x4 (&acc)[2][2][4][2], const Unit& u, int wr, int wc, int fr, int fq) const {
        const int row0 = u.pm * BM + wr * 64 + fr, col0 = wc * 32 + 4 * fq;
#pragma unroll
        for (int ai = 0; ai < 2; ++ai)
#pragma unroll
            for (int m = 0; m < 4; ++m) { float* rowp = L + (size_t)(row0 + ai * HALF + m * 16) * 128 + col0;
#pragma unroll
                for (int n = 0; n < 2; ++n) *(f32x4*)(rowp + n * 16) = acc[ai][0][m][n]; }
    }
};
struct EpiAct {
    static constexpr bool PERM = true, AFTER_DRAIN = false, HAS_MID = false;
    bf16_t* act; const float* rowrs;
    __device__ __forceinline__ void operator()(const f32x4 (&acc)[2][2][4][2], const Unit& u, int wr, int wc, int fr, int fq) const {
        const int row0 = u.pm * BM + wr * 64 + fr, col0 = (u.pn & 3) * HALF + wc * 32 + 8 * fq;
#pragma unroll
        for (int ai = 0; ai < 2; ++ai)
#pragma unroll
            for (int m = 0; m < 4; ++m) { const int r = row0 + ai * HALF + m * 16; bf16_t* rowp = act + (size_t)r * 512 + col0; float o[8]; const float rs = rowrs[r];
#pragma unroll
                for (int n = 0; n < 2; ++n)
#pragma unroll
                    for (int e = 0; e < 4; ++e) { const float g = acc[ai][0][m][n][e] * rs, up = acc[ai][1][m][n][e] * rs; o[n * 4 + e] = g * sigm(g) * up; }
                u32x4 w; w.x = cvt_pk_bf16(o[0], o[1]); w.y = cvt_pk_bf16(o[2], o[3]); w.z = cvt_pk_bf16(o[4], o[5]); w.w = cvt_pk_bf16(o[6], o[7]);
                asm volatile("global_store_dwordx4 %0, %1, off sc1" :: "v"(rowp), "v"(w) : "memory"); }
    }
};
struct EpiDown {
    static constexpr bool PERM = true, AFTER_DRAIN = false, HAS_MID = false;
    bf16_t* y2; const float* roww;
    __device__ __forceinline__ void operator()(const f32x4 (&acc)[2][2][4][2], const Unit& u, int wr, int wc, int fr, int fq) const {
        const int row0 = u.pm * BM + wr * 64 + fr, col0 = (u.pn & 3) * BM + wc * 32 + 8 * fq;
#pragma unroll
        for (int ai = 0; ai < 2; ++ai)
#pragma unroll
            for (int m = 0; m < 4; ++m) { const int r = row0 + ai * HALF + m * 16; const float w8 = roww[r]; bf16_t* rowp = y2 + (size_t)r * 1024 + col0;
#pragma unroll
                for (int bj = 0; bj < 2; ++bj) { const f32x4 v0 = acc[ai][bj][m][0] * w8, v1 = acc[ai][bj][m][1] * w8; u32x4 w;
                    w.x = cvt_pk_bf16(v0[0], v0[1]); w.y = cvt_pk_bf16(v0[2], v0[3]); w.z = cvt_pk_bf16(v1[0], v1[1]); w.w = cvt_pk_bf16(v1[2], v1[3]);
                    *(u32x4*)(rowp + bj * HALF) = w; } }
    }
};
struct EpiFinal {
    static constexpr bool PERM = true, AFTER_DRAIN = false, HAS_MID = false;
    const bf16_t* pp; const bf16_t* x2; float* out; const float* rs3;
    __device__ __forceinline__ void operator()(const f32x4 (&acc)[2][2][4][2], const Unit& u, int wr, int wc, int fr, int fq) const {
        const int row0 = u.pm * BM + wr * 64 + fr, col0 = u.pn * BM + wc * 32 + 8 * fq;
#pragma unroll
        for (int ai = 0; ai < 2; ++ai)
#pragma unroll
            for (int m = 0; m < 4; ++m) { const size_t r = (size_t)(row0 + ai * HALF + m * 16); const float rs = rs3[r];
#pragma unroll
                for (int bj = 0; bj < 2; ++bj) { const int c = col0 + bj * HALF;
                    const u32x4 pw = *(const u32x4*)(pp + r * 1024 + c), xw = *(const u32x4*)(x2 + r * 1024 + c); float* op = out + r * 1024 + c;
                    const f32x4 a0 = acc[ai][bj][m][0] * rs, a1 = acc[ai][bj][m][1] * rs; f32x4 x0, x1;
                    x0[0] = bflo(xw.x) + sigm(a0[0]) * bflo(pw.x); x0[1] = bfhi(xw.x) + sigm(a0[1]) * bfhi(pw.x); x0[2] = bflo(xw.y) + sigm(a0[2]) * bflo(pw.y); x0[3] = bfhi(xw.y) + sigm(a0[3]) * bfhi(pw.y);
                    x1[0] = bflo(xw.z) + sigm(a1[0]) * bflo(pw.z); x1[1] = bfhi(xw.z) + sigm(a1[1]) * bfhi(pw.z); x1[2] = bflo(xw.w) + sigm(a1[2]) * bflo(pw.w); x1[3] = bfhi(xw.w) + sigm(a1[3]) * bfhi(pw.w);
                    *(f32x4*)op = x0; *(f32x4*)(op + 4) = x1; asm volatile("" ::: "memory"); } }
    }
};
struct EpiGates {
    static constexpr bool PERM = true, AFTER_DRAIN = false, HAS_MID = false;
    bf16_t* gates;
    __device__ __forceinline__ void operator()(const f32x4 (&acc)[2][2][4][2], const Unit& u, int wr, int wc, int fr, int fq) const {
        const int row0 = u.pm * BM + wr * 64 + fr, col0 = u.pn * BM + wc * 32 + 8 * fq;
#pragma unroll
        for (int ai = 0; ai < 2; ++ai)
#pragma unroll
            for (int m = 0; m < 4; ++m) { bf16_t* rowp = gates + (size_t)(row0 + ai * HALF + m * 16) * 2048 + col0;
#pragma unroll
                for (int bj = 0; bj < 2; ++bj) { f32x4 v0 = acc[ai][bj][m][0], v1 = acc[ai][bj][m][1]; u32x4 w;
#pragma unroll
                    for (int e = 0; e < 4; ++e) { v0[e] = fmaxf(sigm(v0[e]), 1e-6f); v1[e] = fmaxf(sigm(v1[e]), 1e-6f); }
                    w.x = cvt_pk_bf16(v0[0], v0[1]); w.y = cvt_pk_bf16(v0[2], v0[3]); w.z = cvt_pk_bf16(v1[0], v1[1]); w.w = cvt_pk_bf16(v1[2], v1[3]);
                    *(u32x4*)(rowp + bj * HALF) = w; } }
    }
};
struct OrderItem {
    int pm, pn0, n;
    __device__ __forceinline__ bool next(int i, Unit& u) const { if (i >= n) return false; u.pm = pm; u.pn = pn0 + i; return true; }
    __device__ __forceinline__ void a_ready(const Unit&) const {}
    __device__ __forceinline__ void done(const Unit&) const {}
};
struct OrderSkipV : StaticOrder {
    __device__ __forceinline__ bool next(int i, Unit& u) const { if (!StaticOrder::next(i, u)) return false; if (u.pn >= 11) u.pn += 2; return true; }
};
struct OrderPair : StaticOrder {
    __device__ __forceinline__ bool next(int i, Unit& u) const { if (!StaticOrder::next(i >> 1, u)) return false; if (i & 1) { u.pm += 128; u.pn += 4; } return true; }
};
struct OrderMoe {
    int nwg, G, c; const PG8_LAS int* tile_e;
    __device__ __forceinline__ bool next(int i, Unit& u) const { const long L = (long)i * G + c; if (L >= nwg) return false; const int rt = (int)(L >> 2); u.pm = rt; u.pn = tile_e[rt] * 4 + (int)(L & 3); return true; }
    __device__ __forceinline__ void a_ready(const Unit&) const {}
    __device__ __forceinline__ void done(const Unit&) const {}
};
struct OrderMoeUp : OrderMoe {
    unsigned* cnt;
    __device__ __forceinline__ void done(const Unit& u) const { asm volatile("s_waitcnt vmcnt(0)" ::: "memory");
        if ((threadIdx.x & 63) == 0) __hip_atomic_fetch_add(cnt + u.pm, 1u, __ATOMIC_RELAXED, __HIP_MEMORY_SCOPE_AGENT); }
};
struct OrderMoeDown : OrderMoe {
    unsigned* cnt;
    __device__ __forceinline__ void a_ready(const Unit& u) const { while (__hip_atomic_load(cnt + u.pm, __ATOMIC_RELAXED, __HIP_MEMORY_SCOPE_AGENT) < 32u) __builtin_amdgcn_s_sleep(2); }
};
}

struct Args { const float* in[36]; float* out; unsigned char* ws; int ph_lo, ph_hi; };

template <bool KG = false> __device__ __forceinline__ void tr_item(const float* W, int N, bf16* WT, int ld, int k0, int n0, size_t dst_row0, int k_off, LAS float* scr, int lane, const float* kg = nullptr) {
#pragma unroll 8
    for (int i = 0; i < 32; ++i) { const int kk = 2 * i + (lane >> 5); float w = W[(size_t)(k0 + kk) * N + n0 + (lane & 31)]; if (KG) w *= kg[k0 + kk]; scr[kk * 33 + (lane & 31)] = w; }
    LDS_WAIT(); asm volatile("" ::: "memory");
    const int c = lane & 7;
#pragma unroll
    for (int j = 0; j < 4; ++j) { const int n = (lane >> 3) + 8 * j; const LAS float* s = scr + (8 * c) * 33 + n;
        v4u o; o.x = pk2(s[0 * 33], s[1 * 33]); o.y = pk2(s[2 * 33], s[3 * 33]); o.z = pk2(s[4 * 33], s[5 * 33]); o.w = pk2(s[6 * 33], s[7 * 33]);
        *(v4u*)(WT + (dst_row0 + n) * ld + k_off + k0 + 8 * c) = o; }
    LDS_WAIT(); asm volatile("" ::: "memory");
}
template <bool KG = false> __device__ __forceinline__ void tr_matrix(const float* W, int K, int N, bf16* WT, int ld, size_t dst_row0, int k_off, LAS float* scr, int lane, int gw, int NGW, const float* kg = nullptr) {
    const int nblk = N / 32, nitems = (K / 64) * nblk;
    for (int it = gw; it < nitems; it += NGW) { const int kb = it / nblk, nb = it % nblk; tr_item<KG>(W, N, WT, ld, 64 * kb, 32 * nb, dst_row0 + 32 * nb, k_off, scr, lane, kg); }
}
__device__ __forceinline__ void rms_row_to_bf16(const float* xrow, const float* gain, bf16* orow, int lane) {
    const f32x4* xr = (const f32x4*)xrow + lane; f32x4 v[4]; float s = 0.f;
#pragma unroll
    for (int j = 0; j < 4; ++j) { v[j] = xr[64 * j]; s += (v[j].x * v[j].x + v[j].y * v[j].y) + (v[j].z * v[j].z + v[j].w * v[j].w); }
    const float rstd = 1.0f / sqrtf(wave_sum(s) * (1.f / 1024.f) + 1e-6f);
    v2u* o8 = (v2u*)orow + lane;
#pragma unroll
    for (int j = 0; j < 4; ++j) { const f32x4 g = ((const f32x4*)gain)[lane + 64 * j]; v2u o; o.x = pk2(v[j].x * rstd * g.x, v[j].y * rstd * g.y); o.y = pk2(v[j].z * rstd * g.z, v[j].w * rstd * g.w); o8[64 * j] = o; }
}

__device__ __forceinline__ void phase0(const Args& a, LAS unsigned char* lds, int tid, int lane, int wave, int vcu, int G) {
    unsigned char* ws = a.ws;
    LAS float* scr = (LAS float*)(lds + wave * 16384);
    const int gw = vcu * NWAVES + wave, NGW = G * NWAVES; const int gt = vcu * NTHR + tid, NGT = G * NTHR;
    tr_matrix(a.in[3], 1024, NPROJ, (bf16*)(ws + WS_WIN), 1024, 0, 0, scr, lane, gw, NGW);
    tr_matrix(a.in[6], 64, 512, (bf16*)(ws + WS_WLORA), 256, 0, 0, scr, lane, gw, NGW);
    tr_matrix(a.in[8], 64, 512, (bf16*)(ws + WS_WLORA), 256, 512, 64, scr, lane, gw, NGW);
    tr_matrix(a.in[9], 128, 512, (bf16*)(ws + WS_WLORA), 256, 1024, 128, scr, lane, gw, NGW);
    tr_matrix(a.in[22], 512, 1024, (bf16*)(ws + WS_WBRD), 1024, 0, 0, scr, lane, gw, NGW);
    tr_matrix(a.in[23], 512, 1024, (bf16*)(ws + WS_WBRD), 1024, 0, 512, scr, lane, gw, NGW);
    tr_matrix(a.in[24], 1024, 1024, (bf16*)(ws + WS_WO), 1024, 0, 0, scr, lane, gw, NGW);
    tr_matrix<true>(a.in[34], 1024, 1024, (bf16*)(ws + WS_WPG), 1024, 0, 0, scr, lane, gw, NGW, a.in[33]);
    tr_matrix(a.in[35], 256, 1024, (bf16*)(ws + WS_WPP), 256, 0, 0, scr, lane, gw, NGW);
    { v4u* wl = (v4u*)(ws + WS_WLORA); const v4u z = (v4u){0u, 0u, 0u, 0u};
      for (int i = gt; i < 1536 * 32; i += NGT) { const int row = i >> 5, kc = (i & 31) * 8; const int blk = row >> 9;
          const bool diag = blk == 0 ? (kc < 64) : (blk == 1 ? (kc >= 64 && kc < 128) : (kc >= 128)); if (!diag) wl[i] = z; } }
    { bf16* wr = (bf16*)(ws + WS_WR); const float* wg = a.in[26]; const float* we = a.in[28];
      for (int i = gt; i < 256 * 1024; i += NGT) { const int row = i >> 10, kk = i & 1023; unsigned short v = 0;
          if (row < 36) v = (unsigned short)f2bf((row < 32 ? we[kk * 32 + row] : wg[kk * 4 + (row - 32)]) * a.in[25][kk]);
          wr[(size_t)row * 1024 + kk] = v; } }
    for (int m = gw; m < T; m += NGW) rms_row_to_bf16(a.in[0] + (size_t)m * DM, a.in[2], (bf16*)(ws + WS_XN) + (size_t)m * DM, lane);
}

__device__ __forceinline__ void phase2(const Args& a, LAS unsigned char* lds, int tid, int vcu, int G) {
    unsigned char* ws = a.ws;
    const bf16* projb = (const bf16*)(ws + WS_PROJB); const float* mu = a.in[4];
    bf16* la = (bf16*)((unsigned char*)a.out + OUT_LA);
    LAS float* cs = (LAS float*)lds;
    for (int tile = vcu; tile < T / 64; tile += G) {
        const int t0 = tile * 64;
        __syncthreads();
#pragma unroll
        for (int i = 0; i < 4; ++i) { const int idx = tid + 512 * i, tok = idx >> 5, i32 = idx & 31; const int s = (t0 + tok) & (SEQ - 1);
            const float inv = exp2f(-(float)i32 * (13.287712379549449f / 32.0f)); const float ang = (float)s * inv;
            const float rev = ang * 0.15915494309189535f, fr = rev - floorf(rev);
            cs[(tok * 32 + i32) * 2] = __builtin_amdgcn_cosf(fr); cs[(tok * 32 + i32) * 2 + 1] = __builtin_amdgcn_sinf(fr); }
#pragma unroll
        for (int i = 0; i < 4; ++i) { const int idx = tid + 512 * i, tok = idx >> 5, ch = idx & 31, t = t0 + tok, j0 = ch * 8; const bool first = (t & (SEQ - 1)) == 0;
            const v4u cur = *(const v4u*)(projb + (size_t)t * 1280 + j0); v4u prv = (v4u){0u, 0u, 0u, 0u}; if (!first) prv = *(const v4u*)(projb + (size_t)(t - 1) * 1280 + j0);
            const f32x4 m0 = *(const f32x4*)(mu + 1536 + j0), m1 = *(const f32x4*)(mu + 1536 + j0 + 4);
            float x[8]; const unsigned cw[4] = {cur.x, cur.y, cur.z, cur.w}, pw[4] = {prv.x, prv.y, prv.z, prv.w}; const float mm[8] = {m0.x, m0.y, m0.z, m0.w, m1.x, m1.y, m1.z, m1.w};
#pragma unroll
            for (int e = 0; e < 4; ++e) { const float c0 = bflo(cw[e]), c1 = bfhi(cw[e]), p0 = bflo(pw[e]), p1 = bfhi(pw[e]); x[2 * e] = c0 + (p0 - c0) * mm[2 * e]; x[2 * e + 1] = c1 + (p1 - c1) * mm[2 * e + 1]; }
            if (ch < 8) {
#pragma unroll
                for (int e = 0; e < 8; ++e) x[e] = tanhf(x[e]);
            } else if (ch >= 16) {
#pragma unroll
                for (int e = 0; e < 8; ++e) x[e] = sigm(x[e]);
            }
            v4u o; o.x = pk2(x[0], x[1]); o.y = pk2(x[2], x[3]); o.z = pk2(x[4], x[5]); o.w = pk2(x[6], x[7]);
            *(v4u*)(la + (size_t)t * 256 + j0) = o; }
        __syncthreads();
        for (int i = 0; i < 16; ++i) { const int idx = tid + 512 * i, tok = idx >> 7, grp = (idx >> 3) & 15, l8 = idx & 7, t = t0 + tok;
            const bf16* src = projb + (size_t)t * 1280 + 256 + grp * 64 + l8 * 4;
            const v2u wl = *(const v2u*)src, wh = *(const v2u*)(src + 32);
            float xl[4] = {bflo(wl.x), bfhi(wl.x), bflo(wl.y), bfhi(wl.y)}, xh[4] = {bflo(wh.x), bfhi(wh.x), bflo(wh.y), bfhi(wh.y)};
            float ss = 0.f;
#pragma unroll
            for (int e = 0; e < 4; ++e) ss += xl[e] * xl[e] + xh[e] * xh[e];
            ss = red8(ss);
            const float rs = (1.0f / sqrtf(ss * (1.f / 64.f) + 1e-6f)) * (grp < 8 ? C2 : 1.f);
            const float* gn = (grp < 8 ? a.in[15] : a.in[16]) + l8 * 4;
            const f32x4 gl = *(const f32x4*)gn, gh = *(const f32x4*)(gn + 32);
            float ol[4], oh[4];
#pragma unroll
            for (int e = 0; e < 4; ++e) { const float yl = xl[e] * rs * gl[e], yh = xh[e] * rs * gh[e]; const int ci = (tok * 32 + l8 * 4 + e) * 2; const float c = cs[ci], sn = cs[ci + 1];
                ol[e] = yl * c - yh * sn; oh[e] = yh * c + yl * sn; }
            const int b = t >> 12, s = t & (SEQ - 1); bf16* dst = (grp < 8 ? qn_ptr(ws, b) : kn_ptr(ws, b)) + ((size_t)(grp & 7) * SEQ + s) * 64 + l8 * 4;
            *(v2u*)dst = (v2u){pk2(ol[0], ol[1]), pk2(ol[2], ol[3])}; *(v2u*)(dst + 32) = (v2u){pk2(oh[0], oh[1]), pk2(oh[2], oh[3])}; }
    }
}

constexpr int SC_NB = 32, SC_REC = 392;
constexpr int SC_BUF = SC_NB * SC_REC * 4;
constexpr int SC_YOFF = 2 * SC_BUF;
struct ScanIn { v2u r0, k0, v0, r1, k1, v1, e, av; };
__device__ __forceinline__ void scan_unit(const Args& a, LAS unsigned char* lds, int tid, int unit) {
    unsigned char* ws = a.ws;
    const int bh = unit >> 1, half = unit & 1, b = bh >> 3, hd = bh & 7;
    const bf16* rkv = (const bf16*)(ws + WS_RKV); const bf16* E = (const bf16*)(ws + WS_E); const bf16* Aa = (const bf16*)(ws + WS_A);
    float* bon = (float*)(ws + WS_BON); bf16* Y = y_ptr(a.out, b);
    const int st = tid >> 4, c4 = tid & 15, ch = hd * 64 + c4 * 4;
    const f32x4 mur = *(const f32x4*)(a.in[4] + ch), muk = *(const f32x4*)(a.in[4] + 512 + ch), muv = *(const f32x4*)(a.in[4] + 1024 + ch);
    const f32x4 kkw = *(const f32x4*)(a.in[10] + ch), kaw = *(const f32x4*)(a.in[11] + ch), rkw = *(const f32x4*)(a.in[12] + ch);
    f32x4 sA = (f32x4){0.f, 0.f, 0.f, 0.f};
    const size_t tb = (size_t)b * SEQ;
    auto load_batch = [&](int s0, ScanIn& L) {
        const size_t t = tb + s0 + st; const bool first = (s0 + st) == 0;
        L.r0 = *(const v2u*)(rkv + t * 1536 + ch); L.k0 = *(const v2u*)(rkv + t * 1536 + 512 + ch); L.v0 = *(const v2u*)(rkv + t * 1536 + 1024 + ch);
        const size_t tp = first ? t : t - 1;
        L.r1 = *(const v2u*)(rkv + tp * 1536 + ch); L.k1 = *(const v2u*)(rkv + tp * 1536 + 512 + ch); L.v1 = *(const v2u*)(rkv + tp * 1536 + 1024 + ch);
        if (first) { L.r1 = (v2u){0u, 0u}; L.k1 = L.r1; L.v1 = L.r1; }
        L.e = *(const v2u*)(E + t * 512 + ch); L.av = *(const v2u*)(Aa + t * 512 + ch);
    };
    auto convert = [&](const ScanIn& L, int buf, int s0) {
        const unsigned r0w[2] = {L.r0.x, L.r0.y}, r1w[2] = {L.r1.x, L.r1.y}, k0w[2] = {L.k0.x, L.k0.y}, k1w[2] = {L.k1.x, L.k1.y}, v0w[2] = {L.v0.x, L.v0.y}, v1w[2] = {L.v1.x, L.v1.y};
        const unsigned ew[2] = {L.e.x, L.e.y}, aw[2] = {L.av.x, L.av.y};
        float r[4], k[4], v[4], e[4], av[4], kk[4];
#pragma unroll
        for (int i = 0; i < 4; ++i) { const int w = i >> 1; const bool hi = i & 1;
            const float rc = hi ? bfhi(r0w[w]) : bflo(r0w[w]), rp = hi ? bfhi(r1w[w]) : bflo(r1w[w]);
            const float kc = hi ? bfhi(k0w[w]) : bflo(k0w[w]), kp = hi ? bfhi(k1w[w]) : bflo(k1w[w]);
            const float vc = hi ? bfhi(v0w[w]) : bflo(v0w[w]), vp = hi ? bfhi(v1w[w]) : bflo(v1w[w]);
            r[i] = rc + (rp - rc) * mur[i]; k[i] = kc + (kp - kc) * muk[i]; v[i] = vc + (vp - vc) * muv[i];
            e[i] = hi ? bfhi(ew[w]) : bflo(ew[w]); av[i] = hi ? bfhi(aw[w]) : bflo(aw[w]);
            kk[i] = k[i] * kkw[i]; }
        const float ss = red16(kk[0] * kk[0] + kk[1] * kk[1] + kk[2] * kk[2] + kk[3] * kk[3]);
        const float inv = 1.0f / fmaxf(sqrtf(ss), 1e-12f);
        f32x4 w4, aa4, bb4, km4, wr4, vv4; float br = 0.f, kr = 0.f, bo = 0.f;
#pragma unroll
        for (int i = 0; i < 4; ++i) { const float kki = kk[i] * inv; const float km = k[i] * (1.0f + (av[i] - 1.0f) * kaw[i]); const float w = __expf(-e[i]);
            w4[i] = w; aa4[i] = -kki; bb4[i] = kki * av[i]; km4[i] = km; wr4[i] = w * r[i]; vv4[i] = v[i];
            br += bb4[i] * r[i]; kr += km * r[i]; bo += r[i] * km * rkw[i]; }
        br = red16(br); kr = red16(kr); bo = red16(bo);
        LAS float* rec = (LAS float*)(lds + buf * SC_BUF) + st * SC_REC + c4 * 4;
        *(LAS f32x4*)(rec) = w4; *(LAS f32x4*)(rec + 64) = aa4; *(LAS f32x4*)(rec + 128) = bb4; *(LAS f32x4*)(rec + 192) = km4; *(LAS f32x4*)(rec + 256) = wr4; *(LAS f32x4*)(rec + 320) = vv4;
        if (c4 == 0) { rec[384] = br; rec[385] = kr; if (half == 0) bon[(tb + s0 + st) * 8 + hd] = bo; }
    };
    auto write_out = [&](int bi) {
        typedef float f32x2 __attribute__((ext_vector_type(2)));
        const LAS float* yp = (const LAS float*)(lds + SC_YOFF) + (bi & 1) * (SC_NB * 32) + st * 32 + c4 * 2;
        const f32x2 yv = *(const LAS f32x2*)yp; *(unsigned*)(Y + (size_t)(bi * SC_NB + st) * 512 + hd * 64 + 32 * half + 2 * c4) = pk2(yv[0], yv[1]); };
    constexpr int NBATCH = SEQ / SC_NB;
    ScanIn L; load_batch(0, L);
    __syncthreads();
    convert(L, 0, 0);
    load_batch(SC_NB, L);
    __syncthreads();
    for (int bi = 0; bi < NBATCH; ++bi) {
        const int cur = bi & 1;
        if (bi + 1 < NBATCH) convert(L, cur ^ 1, (bi + 1) * SC_NB);
        if (bi + 2 < NBATCH) load_batch((bi + 2) * SC_NB, L);
        if (bi > 0) write_out(bi - 1);
        LAS float* ybuf = (LAS float*)(lds + SC_YOFF) + cur * (SC_NB * 32);
        const LAS float* base = (const LAS float*)(lds + cur * SC_BUF) + c4 * 4;
        const LAS float* vbase = (const LAS float*)(lds + cur * SC_BUF) + 320 + 32 * half + st;
        const LAS float* sbase = (const LAS float*)(lds + cur * SC_BUF) + 384;
        f32x4 nw = *(const LAS f32x4*)(base), na = *(const LAS f32x4*)(base + 64), nb = *(const LAS f32x4*)(base + 128), nk = *(const LAS f32x4*)(base + 192), nq = *(const LAS f32x4*)(base + 256);
        float nvA = vbase[0]; typedef float f32x2 __attribute__((ext_vector_type(2))); f32x2 ns = *(const LAS f32x2*)(sbase);
        float ykA = 0.f;
#pragma unroll
        for (int i = 0; i < SC_NB; ++i) {
            const f32x4 w4 = nw, a4 = na, b4 = nb, k4 = nk, q4 = nq; const float vA = nvA, br = ns[0], kr = ns[1];
            if (i + 1 < SC_NB) { const LAS float* rec = base + (i + 1) * SC_REC;
                nw = *(const LAS f32x4*)(rec); na = *(const LAS f32x4*)(rec + 64); nb = *(const LAS f32x4*)(rec + 128); nk = *(const LAS f32x4*)(rec + 192); nq = *(const LAS f32x4*)(rec + 256);
                nvA = vbase[(i + 1) * SC_REC]; ns = *(const LAS f32x2*)(sbase + (i + 1) * SC_REC); }
            float saA = fmaf(sA[0], a4[0], fmaf(sA[1], a4[1], fmaf(sA[2], a4[2], sA[3] * a4[3])));
            float zA = fmaf(sA[0], q4[0], fmaf(sA[1], q4[1], fmaf(sA[2], q4[2], sA[3] * q4[3])));
            saA = red16(saA); zA = red16(zA);
            const float yA = zA + saA * br + vA * kr;
            ykA = (c4 == (i & 15)) ? yA : ykA;
            sA = sA * w4 + saA * b4 + vA * k4;
            if ((i & 15) == 15) ybuf[(i - 15 + c4) * 32 + st] = ykA;
        }
        __syncthreads();
    }
    write_out(NBATCH - 1);
}
namespace wkv {
constexpr int P = 144, PF = 272, U = 64 * P  , F = 64 * PF  ;
constexpr int O_S = 0, O_B = F;
constexpr int O_AT = O_B + 0 * U, O_BTL = O_B + 1 * U, O_KTL = O_B + 2 * U, O_RT = O_B + 3 * U, O_BHT = O_B + 4 * U, O_KHT = O_B + 5 * U, O_VRT = O_B + 6 * U, O_RHST = O_B + 7 * U  , O_MABH = O_B + 9 * U, O_MRB = O_B + 10 * U, O_MRK = O_B + 11 * U, O_Z2 = O_B + 12 * U;
constexpr int O_XT = O_AT  , O_G1 = O_MABH, O_Z1 = O_KTL, O_G2 = O_RHST  , O_EP = O_Z2  ;
constexpr int O_END = O_B + 13 * U;
constexpr int PO = 80, O_OUTB = O_END  , O_TII = O_OUTB + 8 * 16 * PO  , O_DIAG = O_TII + 4 * 16 * PO  , O_GC = O_DIAG + 4096  , O_CONST = O_GC + 256  , O_TOP = O_CONST + 1536;
static_assert(O_TOP <= 158720, "wkv LDS map");
typedef short bf16x8 __attribute__((ext_vector_type(8)));
__device__ __forceinline__ f32x4 mfma16(bf16x8 a, bf16x8 b, f32x4 c) { return __builtin_amdgcn_mfma_f32_16x16x32_bf16(a, b, c, 0, 0, 0); }
template <int K> __device__ __forceinline__ f32x4 mm_blk(LAS unsigned char* lds, int aoff, int pa, int boff, int pb, int m0, int n0, int lane, f32x4 acc) {
    const int r = lane & 15, kg = lane >> 4;
#pragma unroll
    for (int ks = 0; ks < K / 32; ++ks) { const bf16x8 a = *(const LAS bf16x8*)(lds + aoff + (m0 + r) * pa + (32 * ks + 8 * kg) * 2); const bf16x8 b = *(const LAS bf16x8*)(lds + boff + (n0 + r) * pb + (32 * ks + 8 * kg) * 2); acc = mfma16(a, b, acc); }
    return acc;
}
__device__ __forceinline__ void split8(const LAS float* p, bf16x8& hi, bf16x8& lo) {
    const f32x4 x0 = *(const LAS f32x4*)p, x1 = *(const LAS f32x4*)(p + 4); const float x[8] = {x0[0], x0[1], x0[2], x0[3], x1[0], x1[1], x1[2], x1[3]}; unsigned h[8], l[8];
#pragma unroll
    for (int i = 0; i < 8; ++i) { h[i] = f2bf(x[i]); l[i] = f2bf(x[i] - __builtin_bit_cast(float, h[i] << 16)); }
    hi = (bf16x8){(short)h[0], (short)h[1], (short)h[2], (short)h[3], (short)h[4], (short)h[5], (short)h[6], (short)h[7]}; lo = (bf16x8){(short)l[0], (short)l[1], (short)l[2], (short)l[3], (short)l[4], (short)l[5], (short)l[6], (short)l[7]};
}
__device__ __forceinline__ void st_bf(LAS unsigned char* lds, int off, float v) { *(LAS unsigned short*)(lds + off) = (unsigned short)f2bf(v); }
__device__ __forceinline__ float ld_bf(const LAS unsigned char* lds, int off) { return __builtin_bit_cast(float, (unsigned)*(const LAS unsigned short*)(lds + off) << 16); }
struct Raw { v4u r0, k0, v0, r1, k1, v1, e, av; };
}
__device__ __forceinline__ void st4_bf(LAS unsigned char* lds, int off, f32x4 v) { *(LAS v2u*)(lds + off) = (v2u){pk2(v[0], v[1]), pk2(v[2], v[3])}; }
__device__ __forceinline__ f32x4 ld4_bf(const LAS unsigned char* lds, int off) { const v2u w = *(const LAS v2u*)(lds + off); return (f32x4){bflo(w.x), bfhi(w.x), bflo(w.y), bfhi(w.y)}; }
__device__ __forceinline__ wkv::bf16x8 ident_frag(int n, int ks, int kg) { wkv::bf16x8 f; const int k0 = 32 * ks + 8 * kg;
#pragma unroll
    for (int j = 0; j < 8; ++j) f[j] = (k0 + j == n) ? (short)0x3F80 : (short)0; return f; }
__device__ __forceinline__ void scan_unit_chunked(const Args& a, LAS unsigned char* lds, int tid, int bh) {
    using namespace wkv;
    unsigned char* ws = a.ws;
    const int b = bh >> 3, hd = bh & 7, wave = __builtin_amdgcn_readfirstlane(tid >> 6);
    const bf16* rkv = (const bf16*)(ws + WS_RKV); const bf16* E = (const bf16*)(ws + WS_E); const bf16* Aa = (const bf16*)(ws + WS_A);
    float* bon = (float*)(ws + WS_BON); bf16* Y = y_ptr(a.out, b);
    const size_t tb = (size_t)b * SEQ;
    int oz = 0;
#define WKV_TAINT() asm volatile("" : "+v"(oz))
    const int gch = hd * 64 + (tid & 7) * 8;
    if (tid < 384) { const int vsel = tid >> 6, cc = tid & 63; const float* src = vsel == 0 ? a.in[4] : vsel == 1 ? a.in[4] + 512 : vsel == 2 ? a.in[4] + 1024 : vsel == 3 ? a.in[10] : vsel == 4 ? a.in[11] : a.in[12];
        ((LAS float*)(lds + O_CONST))[vsel * 64 + cc] = src[hd * 64 + cc]; }
    auto load_raw = [&](int c, Raw& L) { const int tt = tid >> 3; const size_t t = tb + c * 64 + tt; const bool first = (c * 64 + tt) == 0; const size_t tp = first ? t : t - 1;
        L.r0 = *(const v4u*)(rkv + t * 1536 + gch); L.k0 = *(const v4u*)(rkv + t * 1536 + 512 + gch); L.v0 = *(const v4u*)(rkv + t * 1536 + 1024 + gch);
        L.r1 = *(const v4u*)(rkv + tp * 1536 + gch); L.k1 = *(const v4u*)(rkv + tp * 1536 + 512 + gch); L.v1 = *(const v4u*)(rkv + tp * 1536 + 1024 + gch);
        if (first) { L.r1 = (v4u){0u, 0u, 0u, 0u}; L.k1 = L.r1; L.v1 = L.r1; }
        L.e = *(const v4u*)(E + t * 512 + gch); L.av = *(const v4u*)(Aa + t * 512 + gch); };
    const int mb = wave >> 1, nb0 = (wave & 1) * 2;
    WKV_TAINT();
#pragma unroll 1
    for (int i = tid + oz; i < 64 * 64; i += NTHR) *(LAS float*)(lds + O_S + (i >> 6) * PF + (i & 63) * 4) = 0.f;
#if defined(PROBE_PHASE) && PROBE_PHASE >= 300 && PROBE_PHASE < 310
    unsigned long long tlast = __builtin_amdgcn_s_memrealtime(); unsigned tacc[6] = {0u, 0u, 0u, 0u, 0u, 0u};
#define WKV_STAMP(k) do { const unsigned long long tn = __builtin_amdgcn_s_memrealtime(); tacc[k] += (unsigned)(tn - tlast); tlast = tn; } while (0)
#else
#define WKV_STAMP(k) do { } while (0)
#endif
    Raw L; load_raw(0, L);
    for (int c = 0; c < SEQ / 64; ++c) {
        __syncthreads();
        WKV_TAINT(); const int td0 = tid + oz, tt = td0 >> 3, kq = td0 & 7, ch0 = kq * 8;
        float e8[8], lr8[8], r8[8], k8[8], v8[8];
        { const unsigned ew[4] = {L.e.x, L.e.y, L.e.z, L.e.w}, aw[4] = {L.av.x, L.av.y, L.av.z, L.av.w};
          const unsigned r0[4] = {L.r0.x, L.r0.y, L.r0.z, L.r0.w}, r1[4] = {L.r1.x, L.r1.y, L.r1.z, L.r1.w}, k0[4] = {L.k0.x, L.k0.y, L.k0.z, L.k0.w}, k1[4] = {L.k1.x, L.k1.y, L.k1.z, L.k1.w}, v0[4] = {L.v0.x, L.v0.y, L.v0.z, L.v0.w}, v1[4] = {L.v1.x, L.v1.y, L.v1.z, L.v1.w};
#pragma unroll
          for (int i = 0; i < 8; ++i) { const int w = i >> 1; const bool hi = i & 1;
              e8[i] = hi ? bfhi(ew[w]) : bflo(ew[w]); lr8[i] = hi ? bfhi(aw[w]) : bflo(aw[w]);
              const float rc = hi ? bfhi(r0[w]) : bflo(r0[w]), rp = hi ? bfhi(r1[w]) : bflo(r1[w]), kc = hi ? bfhi(k0[w]) : bflo(k0[w]), kp = hi ? bfhi(k1[w]) : bflo(k1[w]), vc = hi ? bfhi(v0[w]) : bflo(v0[w]), vp = hi ? bfhi(v1[w]) : bflo(v1[w]);
              const LAS float* cst = (const LAS float*)(lds + O_CONST) + ch0 + i;
              r8[i] = rc + (rp - rc) * cst[0]; k8[i] = kc + (kp - kc) * cst[64]; v8[i] = vc + (vp - vc) * cst[128]; } }
        if (c + 1 < SEQ / 64) load_raw(c + 1, L);
        { LAS float* ep = (LAS float*)(lds + O_EP) + tt * 68 + ch0; *(LAS f32x4*)ep = (f32x4){e8[0], e8[1], e8[2], e8[3]}; *(LAS f32x4*)(ep + 4) = (f32x4){e8[4], e8[5], e8[6], e8[7]}; }
        __syncthreads();
        { const int k = td0 & 63, seg = td0 >> 6; LAS float* col = (LAS float*)(lds + O_EP) + (seg * 8) * 68 + k; float pre[8], run = 0.f;
#pragma unroll
          for (int i = 0; i < 8; ++i) { run += col[i * 68]; pre[i] = run; }
          LAS float* tots = (LAS float*)(lds + O_EP) + 64 * 68;
          tots[seg * 64 + k] = run;
          __syncthreads();
          float base = 0.f;
#pragma unroll
          for (int s2 = 0; s2 < 7; ++s2) base += (s2 < seg) ? tots[s2 * 64 + k] : 0.f;
#pragma unroll
          for (int i = 0; i < 8; ++i) col[i * 68] = pre[i] + base; }
        __syncthreads();
        float ce[8], cep[8], cec[8];
        { const LAS float* epb = (const LAS float*)(lds + O_EP);
          const f32x4 c0 = *(const LAS f32x4*)(epb + tt * 68 + ch0), c1 = *(const LAS f32x4*)(epb + tt * 68 + ch0 + 4);
          const int tq = tt > 0 ? tt - 1 : 0; f32x4 p0 = *(const LAS f32x4*)(epb + tq * 68 + ch0), p1 = *(const LAS f32x4*)(epb + tq * 68 + ch0 + 4); if (tt == 0) { p0 = (f32x4){0.f, 0.f, 0.f, 0.f}; p1 = p0; }
          const f32x4 q0 = *(const LAS f32x4*)(epb + 63 * 68 + ch0), q1 = *(const LAS f32x4*)(epb + 63 * 68 + ch0 + 4);
#pragma unroll
          for (int i = 0; i < 4; ++i) { ce[i] = c0[i]; ce[4 + i] = c1[i]; cep[i] = p0[i]; cep[4 + i] = p1[i]; cec[i] = q0[i]; cec[4 + i] = q1[i]; } }
        { float kk[8], ss = 0.f;
#pragma unroll
          for (int i = 0; i < 8; ++i) { kk[i] = k8[i] * ((const LAS float*)(lds + O_CONST))[192 + ch0 + i]; ss += kk[i] * kk[i]; }
          ss = red8(ss); const float inv = 1.0f / fmaxf(sqrtf(ss), 1e-12f);
          float at[8], bt[8], kt[8], rt[8], bh8[8], kh8[8], bo = 0.f;
#pragma unroll
          for (int i = 0; i < 8; ++i) { const float kaw_i = ((const LAS float*)(lds + O_CONST))[256 + ch0 + i], rkw_i = ((const LAS float*)(lds + O_CONST))[320 + ch0 + i];
              const float kki = kk[i] * inv, km = k8[i] * (1.0f + (lr8[i] - 1.0f) * kaw_i), bbv = kki * lr8[i];
              const float gp = __expf(-cep[i]), gi = __expf(ce[i]), gt = __expf(-ce[i]), gcj = __expf(ce[i] - cec[i]);
              at[i] = -kki * gp; bt[i] = bbv * gi; kt[i] = km * gi; rt[i] = r8[i] * gt; bh8[i] = bbv * gcj; kh8[i] = km * gcj; bo += r8[i] * km * rkw_i; }
          bo = red8(bo);
          if (kq == 0) bon[(tb + c * 64 + tt) * 8 + hd] = bo;
          if (tt == 63) { LAS float* gc = (LAS float*)(lds + O_GC) + ch0;
#pragma unroll
              for (int i = 0; i < 8; ++i) gc[i] = __expf(-cec[i]); }
          const int ro = tt * P + ch0 * 2;
          *(LAS v4u*)(lds + O_AT + ro) = (v4u){pk2(at[0], at[1]), pk2(at[2], at[3]), pk2(at[4], at[5]), pk2(at[6], at[7])};
          *(LAS v4u*)(lds + O_BTL + ro) = (v4u){pk2(bt[0], bt[1]), pk2(bt[2], bt[3]), pk2(bt[4], bt[5]), pk2(bt[6], bt[7])};
          *(LAS v4u*)(lds + O_KTL + ro) = (v4u){pk2(kt[0], kt[1]), pk2(kt[2], kt[3]), pk2(kt[4], kt[5]), pk2(kt[6], kt[7])};
          *(LAS v4u*)(lds + O_RT + ro) = (v4u){pk2(rt[0], rt[1]), pk2(rt[2], rt[3]), pk2(rt[4], rt[5]), pk2(rt[6], rt[7])};
          *(LAS v4u*)(lds + O_MABH + ro) = (v4u){pk2(bh8[0], bh8[1]), pk2(bh8[2], bh8[3]), pk2(bh8[4], bh8[5]), pk2(bh8[6], bh8[7])};
          *(LAS v4u*)(lds + O_MRB + ro) = (v4u){pk2(kh8[0], kh8[1]), pk2(kh8[2], kh8[3]), pk2(kh8[4], kh8[5]), pk2(kh8[6], kh8[7])};
          *(LAS v4u*)(lds + O_MRK + ro) = (v4u){pk2(v8[0], v8[1]), pk2(v8[2], v8[3]), pk2(v8[4], v8[5]), pk2(v8[6], v8[7])}; }
        __syncthreads();
        { WKV_TAINT(); const int lane = (tid & 63) + oz, c16 = lane & 15, rg = lane >> 4;
#pragma unroll
          for (int j = 0; j < 2; ++j) { const int nb = nb0 + j; f32x4 d0 = (f32x4){0.f, 0.f, 0.f, 0.f}, d1 = d0, d2 = d0, d3 = d0;
#pragma unroll
              for (int ks = 0; ks < 2; ++ks) { const bf16x8 idf = ident_frag(16 * nb + c16, ks, rg); const int ao = (16 * mb + c16) * P + (32 * ks + 8 * rg) * 2;
                  d0 = mfma16(*(const LAS bf16x8*)(lds + O_AT + ao), idf, d0); d1 = mfma16(*(const LAS bf16x8*)(lds + O_MABH + ao), idf, d1);
                  d2 = mfma16(*(const LAS bf16x8*)(lds + O_MRB + ao), idf, d2); d3 = mfma16(*(const LAS bf16x8*)(lds + O_MRK + ao), idf, d3); }
              const int to = (16 * nb + c16) * P + (16 * mb + 4 * rg) * 2;
              st4_bf(lds, O_RHST + to, d0); st4_bf(lds, O_BHT + to, d1); st4_bf(lds, O_KHT + to, d2); st4_bf(lds, O_VRT + to, d3); } }
        __syncthreads(); WKV_STAMP(0);
        { WKV_TAINT(); const int lane = (tid & 63) + oz, c16 = lane & 15, rg = lane >> 4; f32x4 acc[4][2];
#pragma unroll
          for (int j = 0; j < 2; ++j) { const int nb = nb0 + j; const f32x4 z = (f32x4){0.f, 0.f, 0.f, 0.f};
              acc[0][j] = mm_blk<64>(lds, O_BTL, P, O_AT, P, 16 * mb, 16 * nb, lane, z);
              acc[1][j] = mm_blk<64>(lds, O_AT, P, O_KTL, P, 16 * mb, 16 * nb, lane, z);
              acc[2][j] = mm_blk<64>(lds, O_BTL, P, O_RT, P, 16 * mb, 16 * nb, lane, z);
              acc[3][j] = mm_blk<64>(lds, O_KTL, P, O_RT, P, 16 * mb, 16 * nb, lane, z); }
#pragma unroll
          for (int j = 0; j < 2; ++j) { const int nb = nb0 + j, n = 16 * nb + c16, m0 = 16 * mb + 4 * rg; f32x4 mab, mak, mrb, mrk;
#pragma unroll
              for (int e = 0; e < 4; ++e) { const int m = m0 + e; mab[e] = m < n ? acc[0][j][e] : 0.f; mak[e] = n < m ? acc[1][j][e] : 0.f; mrb[e] = m <= n ? acc[2][j][e] : 0.f; mrk[e] = m <= n ? acc[3][j][e] : 0.f; }
              st4_bf(lds, O_MABH + n * P + m0 * 2, mab);
              if (mb == nb) *(LAS f32x4*)(lds + O_DIAG + ((mb * 16 + c16) * 16 + 4 * rg) * 4) = mab;
              st4_bf(lds, O_RHST + U + n * P + m0 * 2, mak);
              st4_bf(lds, O_MRB + n * P + m0 * 2, mrb); st4_bf(lds, O_MRK + n * P + m0 * 2, mrk); } }
        __syncthreads(); WKV_STAMP(1);
        WKV_TAINT();
        if (tid < 64) { const int td2 = tid + oz, blk = td2 >> 4, cc = td2 & 15; const LAS float* D = (const LAS float*)(lds + O_DIAG) + blk * 256; float Tc[16];
#pragma unroll
            for (int r4 = 0; r4 < 4; ++r4) { f32x4 dr[4][4];
#pragma unroll
                for (int rr = 0; rr < 4; ++rr)
#pragma unroll
                    for (int q = 0; q <= r4; ++q) dr[rr][q] = *(const LAS f32x4*)(D + (4 * r4 + rr) * 16 + 4 * q);
#pragma unroll
                for (int rr = 0; rr < 4; ++rr) { const int r = 4 * r4 + rr; float sacc = (r == cc) ? 1.f : 0.f;
#pragma unroll
                    for (int j = 0; j < r; ++j) sacc += dr[rr][j >> 2][j & 3] * Tc[j];
                    Tc[r] = sacc; } }
#pragma unroll
            for (int r4 = 0; r4 < 4; ++r4) { const f32x4 tv = (f32x4){Tc[4 * r4], Tc[4 * r4 + 1], Tc[4 * r4 + 2], Tc[4 * r4 + 3]};
                (void)tv; }
#pragma unroll
            for (int r = 0; r < 16; ++r) { st_bf(lds, O_TII + (blk * 16 + r) * PO + cc * 2, Tc[r]); st_bf(lds, O_TII + (blk * 16 + r) * PO + (16 + cc) * 2, 0.f); } }
        { const int lane = (tid & 63) + oz; const v4u z = (v4u){0u, 0u, 0u, 0u};
#pragma unroll
          for (int i = 0; i < 3; ++i) { const int idx = lane + 64 * i; if (idx < 16 * 9) *(LAS v4u*)(lds + O_XT + (16 * wave + idx / 9) * P + (idx % 9) * 16) = z; }
          if (lane < 32) *(LAS v4u*)(lds + O_OUTB + wave * 16 * PO + (lane >> 1) * PO + 32 + (lane & 1) * 16) = z; }
        __syncthreads(); WKV_STAMP(2);
#pragma unroll 1
        for (int i = 0; i < 4; ++i) { WKV_TAINT(); const int lane = (tid & 63) + oz, c16 = lane & 15, rg = lane >> 4;
            f32x4 acc = (f32x4){0.f, 0.f, 0.f, 0.f};
            if (i > 0) acc = mm_blk<64>(lds, O_MABH, P, O_XT, P, 16 * i, 16 * wave, lane, acc);
            acc += ld4_bf(lds, O_RHST + (16 * wave + c16) * P + (16 * i + 4 * rg) * 2);
            st4_bf(lds, O_OUTB + wave * 16 * PO + c16 * PO + (4 * rg) * 2, acc);
            LDS_WAIT();
            f32x4 x = mm_blk<32>(lds, O_TII + i * 16 * PO, PO, O_OUTB + wave * 16 * PO, PO, 0, 0, lane, (f32x4){0.f, 0.f, 0.f, 0.f});
            st4_bf(lds, O_XT + (16 * wave + c16) * P + (16 * i + 4 * rg) * 2, x);
            LDS_WAIT();
        }
        __syncthreads(); WKV_STAMP(3);
        { WKV_TAINT(); const int lane = (tid & 63) + oz, c16 = lane & 15, rg = lane >> 4; f32x4 acc[4][2];
#pragma unroll
          for (int j = 0; j < 2; ++j) { const int nb = nb0 + j; const f32x4 z = (f32x4){0.f, 0.f, 0.f, 0.f};
              acc[0][j] = mm_blk<64>(lds, O_XT, P, O_MRB, P, 16 * mb, 16 * nb, lane, z);
              acc[1][j] = mm_blk<64>(lds, O_XT + U, P, O_MRB, P, 16 * mb, 16 * nb, lane, z);
              acc[2][j] = mm_blk<64>(lds, O_XT, P, O_BHT, P, 16 * mb, 16 * nb, lane, z);
              acc[3][j] = mm_blk<64>(lds, O_XT + U, P, O_BHT, P, 16 * mb, 16 * nb, lane, z); }
#pragma unroll
          for (int j = 0; j < 2; ++j) { const int n = 16 * (nb0 + j) + c16, m0 = 16 * mb + 4 * rg; const int o = n * P + m0 * 2;
              acc[0][j] += ld4_bf(lds, O_RT + o); acc[1][j] += ld4_bf(lds, O_MRK + o); acc[3][j] += ld4_bf(lds, O_KHT + o);
              if (n >= m0 && n < m0 + 4) acc[2][j][n - m0] += *(const LAS float*)(lds + O_GC + n * 4); }
          __syncthreads();
#pragma unroll
          for (int j = 0; j < 2; ++j) { const int n = 16 * (nb0 + j) + c16, m0 = 16 * mb + 4 * rg; const int o = n * P + m0 * 2;
              st4_bf(lds, O_G1 + o, acc[0][j]); st4_bf(lds, O_Z1 + o, acc[1][j]); st4_bf(lds, O_Z2 + o, acc[3][j]);
              f32x4 hi4, lo4;
#pragma unroll
              for (int e = 0; e < 4; ++e) { hi4[e] = __builtin_bit_cast(float, f2bf(acc[2][j][e]) << 16); lo4[e] = acc[2][j][e] - hi4[e]; }
              st4_bf(lds, O_RT + o, hi4); st4_bf(lds, O_KHT + o, lo4); } }
        { WKV_TAINT(); const int td5 = tid + oz, v = td5 >> 3, kq5 = (td5 & 7) * 8; const LAS float* sp = (const LAS float*)(lds + O_S + v * PF) + kq5;
          const f32x4 x0 = *(const LAS f32x4*)sp, x1 = *(const LAS f32x4*)(sp + 4); f32x4 h0, h1, l0, l1;
#pragma unroll
          for (int e = 0; e < 4; ++e) { h0[e] = __builtin_bit_cast(float, f2bf(x0[e]) << 16); l0[e] = x0[e] - h0[e]; h1[e] = __builtin_bit_cast(float, f2bf(x1[e]) << 16); l1[e] = x1[e] - h1[e]; }
          st4_bf(lds, O_MRB + v * P + kq5 * 2, h0); st4_bf(lds, O_MRB + v * P + kq5 * 2 + 8, h1); st4_bf(lds, O_MRK + v * P + kq5 * 2, l0); st4_bf(lds, O_MRK + v * P + kq5 * 2 + 8, l1); }
        __syncthreads(); WKV_STAMP(4);
        { WKV_TAINT(); const int lane = (tid & 63) + oz, c16 = lane & 15, rg = lane >> 4; f32x4 ay[2], as[2];
#pragma unroll
          for (int j = 0; j < 2; ++j) { const int nb = nb0 + j; const f32x4 z = (f32x4){0.f, 0.f, 0.f, 0.f};
              ay[j] = mm_blk<64>(lds, O_VRT, P, O_Z1, P, 16 * mb, 16 * nb, lane, z);
              ay[j] = mm_blk<64>(lds, O_MRB, P, O_G1, P, 16 * mb, 16 * nb, lane, ay[j]);
              ay[j] = mm_blk<64>(lds, O_MRK, P, O_G1, P, 16 * mb, 16 * nb, lane, ay[j]);
              as[j] = mm_blk<64>(lds, O_Z2, P, O_VRT, P, 16 * mb, 16 * nb, lane, z);
              as[j] = mm_blk<64>(lds, O_RT, P, O_MRB, P, 16 * mb, 16 * nb, lane, as[j]);
              as[j] = mm_blk<64>(lds, O_KHT, P, O_MRB, P, 16 * mb, 16 * nb, lane, as[j]);
              as[j] = mm_blk<64>(lds, O_RT, P, O_MRK, P, 16 * mb, 16 * nb, lane, as[j]); }
#pragma unroll
          for (int j = 0; j < 2; ++j) { const int t = 16 * (nb0 + j) + c16, v0 = 16 * mb + 4 * rg;
              *(v2u*)(Y + (size_t)(c * 64 + t) * 512 + hd * 64 + v0) = (v2u){pk2(ay[j][0], ay[j][1]), pk2(ay[j][2], ay[j][3])};
              *(LAS f32x4*)(lds + O_S + t * PF + v0 * 4) = as[j]; } }
        WKV_STAMP(5);
    }
#if defined(PROBE_PHASE) && PROBE_PHASE >= 300 && PROBE_PHASE < 310
    if (tid == 0) atomicAdd((unsigned*)(ws + WS_CTL) + 96, tacc[PROBE_PHASE - 300]);
#endif
}
__device__ __forceinline__ void phase_orw(const Args& a, int lane, int wave, int vcu, int G) {
    unsigned char* ws = a.ws;
    const int gw = vcu * NWAVES + wave, NGW = G * NWAVES;
    const bf16* rkv = (const bf16*)(ws + WS_RKV); const bf16* Gg = (const bf16*)(ws + WS_G); const float* bon = (const float*)(ws + WS_BON);
    bf16* orw = (bf16*)((unsigned char*)a.out + OUT_ORWDF);
    const int ch = lane * 8;
    const f32x4 mv0 = *(const f32x4*)(a.in[4] + 1024 + ch), mv1 = *(const f32x4*)(a.in[4] + 1024 + ch + 4);
    const f32x4 lw0 = *(const f32x4*)(a.in[13] + ch), lw1 = *(const f32x4*)(a.in[13] + ch + 4), lb0 = *(const f32x4*)(a.in[14] + ch), lb1 = *(const f32x4*)(a.in[14] + ch + 4);
    const float muv[8] = {mv0[0], mv0[1], mv0[2], mv0[3], mv1[0], mv1[1], mv1[2], mv1[3]}, lnw[8] = {lw0[0], lw0[1], lw0[2], lw0[3], lw1[0], lw1[1], lw1[2], lw1[3]}, lnb[8] = {lb0[0], lb0[1], lb0[2], lb0[3], lb1[0], lb1[1], lb1[2], lb1[3]};
    for (int t = gw; t < T; t += NGW) {
        const int b = t >> 12, s = t & (SEQ - 1); const v4u yw = *(const v4u*)(y_ptr(a.out, b) + (size_t)s * 512 + ch);
        const f32x4 y0 = (f32x4){bflo(yw.x), bfhi(yw.x), bflo(yw.y), bfhi(yw.y)}, y1 = (f32x4){bflo(yw.z), bfhi(yw.z), bflo(yw.w), bfhi(yw.w)};
        const v4u vc = *(const v4u*)(rkv + (size_t)t * 1536 + 1024 + ch); v4u vp = (v4u){0u, 0u, 0u, 0u}; if (s != 0) vp = *(const v4u*)(rkv + (size_t)(t - 1) * 1536 + 1024 + ch);
        const v4u gw4 = *(const v4u*)(Gg + (size_t)t * 512 + ch); const float bo = bon[(size_t)t * 8 + (lane >> 3)];
        float y[8] = {y0[0], y0[1], y0[2], y0[3], y1[0], y1[1], y1[2], y1[3]};
        float sm = 0.f;
#pragma unroll
        for (int e = 0; e < 8; ++e) sm += y[e];
        const float mean = red8(sm) * (1.f / 64.f); float vs = 0.f;
#pragma unroll
        for (int e = 0; e < 8; ++e) { y[e] -= mean; vs += y[e] * y[e]; }
        const float rstd = 1.0f / sqrtf(red8(vs) * (1.f / 64.f) + 64e-5f);
        const unsigned vcw[4] = {vc.x, vc.y, vc.z, vc.w}, vpw[4] = {vp.x, vp.y, vp.z, vp.w}, gww[4] = {gw4.x, gw4.y, gw4.z, gw4.w}; float o[8];
#pragma unroll
        for (int e = 0; e < 8; ++e) { const int w = e >> 1; const bool hi = e & 1; const float c = hi ? bfhi(vcw[w]) : bflo(vcw[w]), p = hi ? bfhi(vpw[w]) : bflo(vpw[w]), g = hi ? bfhi(gww[w]) : bflo(gww[w]);
            const float v = c + (p - c) * muv[e]; o[e] = ((y[e] * rstd * lnw[e] + lnb[e]) + bo * v) * g; }
        v4u ov; ov.x = pk2(o[0], o[1]); ov.y = pk2(o[2], o[3]); ov.z = pk2(o[4], o[5]); ov.w = pk2(o[6], o[7]);
        *(v4u*)(orw + (size_t)t * 1024 + ch) = ov;
    }
}

__device__ __forceinline__ int crow(int r, int hi) { return (r & 3) + 8 * (r >> 2) + 4 * hi; }
constexpr int AT_BUF = 24576;
__device__ __forceinline__ int at_addr(int row, int ch) { return row * 128 + ((ch ^ ((row >> 1) & 7)) << 4); }
__device__ __forceinline__ void attn_pass(const bf16* qn, const bf16* kn, const bf16* vt, int b, int head, int c, int qb, LAS unsigned char* lds, int tid, f32x16 (&o)[4]) {
    const int lane = tid & 63, wave = __builtin_amdgcn_readfirstlane(tid >> 6), r32 = lane & 31, hi = lane >> 5;
    const int vh = b * 8 + head * 2 + c; const int q0 = qb * 256, qw0 = q0 + wave * 32, qrow = qw0 + r32;
    const bf16* Qp = qn + ((size_t)(vh & 7) * SEQ + qrow) * 64;
    s16x8 qf[4];
#pragma unroll
    for (int ks = 0; ks < 4; ++ks) qf[ks] = *(const s16x8*)(Qp + 16 * ks + 8 * hi);
    const int k_row = tid >> 3, k_ch = tid & 7;
    const bf16* ksrc = kn + (size_t)(vh & 7) * SEQ * 64 + k_row * 64 + k_ch * 8; const int kdst = at_addr(k_row, k_ch);
    const int dv0 = tid >> 3, dv1 = 64 + (tid >> 3);
    const bf16* vsrc0 = vt + (size_t)(head * 128 + dv0) * T + (size_t)b * SEQ + k_ch * 8; const bf16* vsrc1 = vsrc0 + (size_t)64 * T;
    const int vdst0 = 8192 + at_addr(dv0, k_ch), vdst1 = 8192 + at_addr(dv1, k_ch); const bool vsw0 = (dv0 & 16) != 0, vsw1 = (dv1 & 16) != 0;
    const int NT = 4 * qb + 4;
    v4u kreg = *(const v4u*)ksrc, vreg0 = *(const v4u*)vsrc0, vreg1 = *(const v4u*)vsrc1;
    __syncthreads();
    *(LAS v4u*)(lds + kdst) = kreg; *(LAS v4u*)(lds + vdst0) = vsw0 ? (v4u){vreg0.z, vreg0.w, vreg0.x, vreg0.y} : vreg0; *(LAS v4u*)(lds + vdst1) = vsw1 ? (v4u){vreg1.z, vreg1.w, vreg1.x, vreg1.y} : vreg1;
    __syncthreads();
    float m = -1e30f, l = 0.f;
#pragma unroll
    for (int db = 0; db < 4; ++db)
#pragma unroll
        for (int i = 0; i < 16; ++i) o[db][i] = 0.f;
    for (int j = 0; j < NT; ++j) {
        const int cur = (j & 1) * AT_BUF, nxt = AT_BUF - cur; const bool more = j + 1 < NT;
        if (more) { kreg = *(const v4u*)(ksrc + (size_t)(j + 1) * 64 * 64); vreg0 = *(const v4u*)(vsrc0 + (j + 1) * 64); vreg1 = *(const v4u*)(vsrc1 + (j + 1) * 64); }
        const int kv0 = j * 64;
        if (kv0 <= qw0 + 31) {
            f32x16 s0, s1;
#pragma unroll
            for (int i = 0; i < 16; ++i) { s0[i] = 0.f; s1[i] = 0.f; }
            __builtin_amdgcn_s_setprio(1);
#pragma unroll
            for (int ks = 0; ks < 4; ++ks) {
                const s16x8 a0 = *(const LAS s16x8*)(lds + cur + at_addr(r32, 2 * ks + hi));
                const s16x8 a1 = *(const LAS s16x8*)(lds + cur + at_addr(32 + r32, 2 * ks + hi));
                s0 = __builtin_amdgcn_mfma_f32_32x32x16_bf16(a0, qf[ks], s0, 0, 0, 0);
                s1 = __builtin_amdgcn_mfma_f32_32x32x16_bf16(a1, qf[ks], s1, 0, 0, 0);
            }
            __builtin_amdgcn_s_setprio(0);
            if (kv0 + 63 > qw0) {
#pragma unroll
                for (int i = 0; i < 16; ++i) { const int kv = kv0 + crow(i, hi); if (kv > qrow) s0[i] = -1e30f; if (kv + 32 > qrow) s1[i] = -1e30f; }
            }
            float rm = fmaxf(s0[0], s1[0]);
#pragma unroll
            for (int i = 1; i < 16; ++i) rm = fmaxf(rm, fmaxf(s0[i], s1[i]));
            rm = xhalf_max(rm);
            const float mn = fmaxf(m, rm); const float f = __builtin_amdgcn_exp2f(m - mn); m = mn;
            float ps = 0.f;
#pragma unroll
            for (int i = 0; i < 16; ++i) { s0[i] = __builtin_amdgcn_exp2f(s0[i] - mn); s1[i] = __builtin_amdgcn_exp2f(s1[i] - mn); ps += s0[i] + s1[i]; }
            l = l * f + ps;
            if (__any(f != 1.0f)) {
#pragma unroll
                for (int db = 0; db < 4; ++db)
#pragma unroll
                    for (int i = 0; i < 16; ++i) o[db][i] *= f;
            }
            v4u pw[4];
            pw[0] = (v4u){pk2(s0[0], s0[1]), pk2(s0[2], s0[3]), pk2(s0[4], s0[5]), pk2(s0[6], s0[7])};
            pw[1] = (v4u){pk2(s0[8], s0[9]), pk2(s0[10], s0[11]), pk2(s0[12], s0[13]), pk2(s0[14], s0[15])};
            pw[2] = (v4u){pk2(s1[0], s1[1]), pk2(s1[2], s1[3]), pk2(s1[4], s1[5]), pk2(s1[6], s1[7])};
            pw[3] = (v4u){pk2(s1[8], s1[9]), pk2(s1[10], s1[11]), pk2(s1[12], s1[13]), pk2(s1[14], s1[15])};
#pragma unroll
            for (int db = 0; db < 4; ++db) { const int dv = 32 * db + r32; const int vb = cur + 8192 + dv * 128 + 8 * (hi ^ ((dv >> 4) & 1)), sw = (dv >> 1) & 7;
#pragma unroll
                for (int s4 = 0; s4 < 4; ++s4) {
                    const s16x4 lo = *(const LAS s16x4*)(lds + vb + (((2 * s4) ^ sw) << 4));
                    const s16x4 hh = *(const LAS s16x4*)(lds + vb + (((2 * s4 + 1) ^ sw) << 4));
                    const s16x8 av = (s16x8){lo[0], lo[1], lo[2], lo[3], hh[0], hh[1], hh[2], hh[3]};
                    o[db] = __builtin_amdgcn_mfma_f32_32x32x16_bf16(av, __builtin_bit_cast(s16x8, pw[s4]), o[db], 0, 0, 0);
                }
                __builtin_amdgcn_sched_barrier(0); }
        }
        if (more) { *(LAS v4u*)(lds + nxt + kdst) = kreg; *(LAS v4u*)(lds + nxt + vdst0) = vsw0 ? (v4u){vreg0.z, vreg0.w, vreg0.x, vreg0.y} : vreg0; *(LAS v4u*)(lds + nxt + vdst1) = vsw1 ? (v4u){vreg1.z, vreg1.w, vreg1.x, vreg1.y} : vreg1; }
        __syncthreads();
    }
    l = xhalf_sum(l);
    const float il = 1.0f / l;
#pragma unroll
    for (int db = 0; db < 4; ++db)
#pragma unroll
        for (int i = 0; i < 16; ++i) o[db][i] *= il;
}
__device__ __forceinline__ void attn_unit(const Args& a, LAS unsigned char* lds, int tid, int b, int head, int qb, float* stash  ) {
    unsigned char* ws = a.ws;
    const bf16* qn = qn_ptr(ws, b); const bf16* kn = kn_ptr(ws, b); const bf16* vt = (const bf16*)(ws + WS_VT);
    bf16* odf = (bf16*)((unsigned char*)a.out + OUT_ORWDF) + 512;
    const int lane = tid & 63, wave = tid >> 6, r32 = lane & 31, hi = lane >> 5;
    int oz = 0; asm volatile("" : "+v"(oz)); const int ll = lane + oz;
    const float d1 = wave_sum(a.in[17][ll] * a.in[18][ll]), d2 = wave_sum(a.in[19][ll] * a.in[20][ll]);
    const float lam = __expf(d1) - __expf(d2) + LAM_INIT;
    f32x16 o[4];
    attn_pass(qn, kn, vt, b, head, 0, qb, lds, tid, o);
    float* st = stash + tid * 64;
#pragma unroll
    for (int db = 0; db < 4; ++db)
#pragma unroll
        for (int g = 0; g < 4; ++g) *(f32x4*)(st + db * 16 + g * 4) = (f32x4){o[db][4 * g], o[db][4 * g + 1], o[db][4 * g + 2], o[db][4 * g + 3]};
#if defined(PROBE_PHASE) && PROBE_PHASE == 215
    if (head == 0) { bf16* dbg = (bf16*)(ws + 496 * MiB); const size_t tq = (size_t)b * SEQ + qb * 256 + wave * 32 + r32;
#pragma unroll
        for (int db = 0; db < 4; ++db)
#pragma unroll
            for (int g = 0; g < 4; ++g) { const int dv = 32 * db + 8 * g + 4 * hi; v2u ov; ov.x = pk2(o[db][4 * g], o[db][4 * g + 1]); ov.y = pk2(o[db][4 * g + 2], o[db][4 * g + 3]); *(v2u*)(dbg + tq * 128 + dv) = ov; } }
#endif
    attn_pass(qn, kn, vt, b, head, 1, qb, lds, tid, o);
    float ss = 0.f;
#pragma unroll
    for (int db = 0; db < 4; ++db)
#pragma unroll
        for (int g = 0; g < 4; ++g) { const f32x4 s4 = *(const f32x4*)(st + db * 16 + g * 4);
#pragma unroll
            for (int e = 0; e < 4; ++e) { const float d = s4[e] - lam * o[db][4 * g + e]; o[db][4 * g + e] = d; ss += d * d; } }
    ss = xhalf_sum(ss);
    const float rs = (1.0f / sqrtf(ss * (1.f / 128.f) + 1e-6f)) * (1.0f - LAM_INIT);
    const size_t t = (size_t)b * SEQ + qb * 256 + wave * 32 + r32; const float* sw = a.in[21];
#pragma unroll
    for (int db = 0; db < 4; ++db)
#pragma unroll
        for (int g = 0; g < 4; ++g) { const int dv = 32 * db + 8 * g + 4 * hi; const f32x4 w4 = *(const f32x4*)(sw + dv);
            v2u ov; ov.x = pk2(o[db][4 * g] * rs * w4[0], o[db][4 * g + 1] * rs * w4[1]); ov.y = pk2(o[db][4 * g + 2] * rs * w4[2], o[db][4 * g + 3] * rs * w4[3]);
            *(v2u*)(odf + t * 1024 + head * 128 + dv) = ov; }
}
#define XB_TMO      128
#define XB_XCNT(j)  (256  + 64 * (j))
#define XB_XSUB(j)  (1280 + 64 * (j))
#define XB_XGEN(j)  (2304 + 64 * (j))
#define XB_TOP      3328
#define XB_TOPGEN   3392
#define XCD_BAR_WORDS 3456
#define XB_SPIN_CAP (1u << 18)

__device__ __forceinline__ unsigned xb_ld(unsigned* p)              { return __hip_atomic_load(p, __ATOMIC_RELAXED, __HIP_MEMORY_SCOPE_AGENT); }
__device__ __forceinline__ unsigned xb_add(unsigned* p, unsigned v) { return __hip_atomic_fetch_add(p, v, __ATOMIC_RELAXED, __HIP_MEMORY_SCOPE_AGENT); }
__device__ __forceinline__ unsigned xb_xcc_id() { return (unsigned)__builtin_amdgcn_s_getreg((3 << 11) | 20) & 0xFu; }
#define XB_SPIN(cond, bar) do { unsigned _sp = 0; while (cond) { __builtin_amdgcn_s_sleep(1); \
    if ((++_sp & 255u) == 0u) { if (xb_ld(&(bar)[XB_TMO])) break; if (_sp > XB_SPIN_CAP) { atomicAdd(&(bar)[XB_TMO], 1u); break; } } } } while (0)

struct XcdBarrier {
    unsigned* bar; unsigned x;
    volatile LAS unsigned* st;
};

__device__ __forceinline__ XcdBarrier xcd_barrier_post(unsigned* bar, volatile LAS unsigned* st) {
    XcdBarrier b; b.bar = bar; b.x = xb_xcc_id(); b.st = st;
    if (threadIdx.x == 0) (void)xb_add(&bar[XB_XCNT(b.x)], 1u);
    return b;
}
__device__ __forceinline__ void xcd_barrier_complete(unsigned* bar, unsigned x, unsigned& nloc, unsigned& nx) {
    const unsigned G = gridDim.x * gridDim.y * gridDim.z;
    unsigned sum, cnt, mine, sp = 0u;
    for (;;) {
        sum = 0u; cnt = 0u; mine = 0u;
#pragma unroll
        for (unsigned j = 0; j < 16; ++j) { const unsigned c = xb_ld(&bar[XB_XCNT(j)]); sum += c; cnt += (c > 0u) ? 1u : 0u; mine = (j == x) ? c : mine; }
        if (sum == G) break;
        __builtin_amdgcn_s_sleep(1);
        if ((++sp & 255u) == 0u) { if (xb_ld(&bar[XB_TMO])) break; if (sp > XB_SPIN_CAP) { atomicAdd(&bar[XB_TMO], 1u); break; } }
    }
    nloc = mine > 0u ? mine : 1u; nx = cnt > 0u ? cnt : 1u;
}

__device__ __forceinline__ void xcd_barrier(const XcdBarrier& b) {
    asm volatile("s_waitcnt vmcnt(0)" ::: "memory");
    __syncthreads();
    if (threadIdx.x == 0) {
        unsigned* bar = b.bar;
        __builtin_amdgcn_s_waitcnt(0);
        unsigned nloc = b.st[0], nx = b.st[1];
        if (nloc == 0u) { xcd_barrier_complete(bar, b.x, nloc, nx); b.st[0] = nloc; b.st[1] = nx; }
        const unsigned old = xb_add(&bar[XB_XSUB(b.x)], 1u);
        const unsigned gen = old / nloc;
        if (old + 1u == (gen + 1u) * nloc) {
            __builtin_amdgcn_fence(__ATOMIC_RELEASE, "agent");
            asm volatile("s_waitcnt vmcnt(0)" ::: "memory");
            const unsigned og = xb_add(&bar[XB_TOP], 1u);
            const unsigned tg = og / nx;
            if (og + 1u == (tg + 1u) * nx) xb_add(&bar[XB_TOPGEN], 1u);
            else XB_SPIN(xb_ld(&bar[XB_TOPGEN]) == tg, bar);
            __builtin_amdgcn_fence(__ATOMIC_ACQUIRE, "agent");
            xb_add(&bar[XB_XGEN(b.x)], 1u);
            asm volatile("s_waitcnt vmcnt(0)" ::: "memory");
        } else {
            XB_SPIN(xb_ld(&bar[XB_XGEN(b.x)]) == gen, bar);
            __builtin_amdgcn_fence(__ATOMIC_ACQUIRE, "agent");
            asm volatile("s_waitcnt vmcnt(0)" ::: "memory");
        }
    }
    __syncthreads();
}

constexpr int TR_IGU = (1024 / 64) * (512 / 32);
constexpr int TR_IDN = (512 / 64) * (1024 / 32);
constexpr int NTRQ = 256, TRQ_PER_WAVE = NEXP * 2 * TR_IGU / (NTRQ * NWAVES);
__device__ __forceinline__ void tr_wgu_qitem(const Args& a, LAS unsigned char* lds, int lane, int wave, int q) {
    LAS float* scr = (LAS float*)(lds + wave * 16384); bf16* wgu = (bf16*)(a.ws + WS_WGU);
#pragma unroll 1
    for (int j = 0; j < TRQ_PER_WAVE; ++j) { const int it = (q * NWAVES + wave) * TRQ_PER_WAVE + j; const int e = it / (2 * TR_IGU); int r = it % (2 * TR_IGU);
        const int up = r >= TR_IGU; if (up) r -= TR_IGU; const int kb = r / 16, nb = r % 16, n0 = 32 * nb;
        const float* W = (up ? a.in[31] : a.in[30]) + (size_t)e * 1024 * 512;
        tr_item<true>(W, 512, wgu, 1024, 64 * kb, n0, (size_t)e * 1024 + (n0 >> 7) * 256 + (up ? 128 : 0) + (n0 & 127), 0, scr, lane, a.in[25]); }
}
__device__ __forceinline__ void tr_wd_all(const Args& a, LAS unsigned char* lds, int lane, int wave, int w0, int nw) {
    LAS float* scr = (LAS float*)(lds + wave * 16384); bf16* wd = (bf16*)(a.ws + WS_WD);
#pragma unroll 1
    for (int it = w0; it < NEXP * TR_IDN; it += nw) { const int e = it / TR_IDN, r = it % TR_IDN, kb = r / 32, nb = r % 32;
        tr_item(a.in[32] + (size_t)e * 512 * 1024, 1024, wd, 512, 64 * kb, 32 * nb, (size_t)e * 1024 + 32 * nb, 0, scr, lane); }
}

__device__ __forceinline__ void route_tile(const Args& a, LAS unsigned char* lds, int tid, int pm) {
    unsigned char* ws = a.ws;
    const float* LG = (const float*)(ws + WS_LOGITS); int* toke = (int*)(ws + WS_TOKE); float* tokw = (float*)(ws + WS_TOKW); int* tilecnt = (int*)(ws + WS_TILECNT);
    LAS int* cnt = (LAS int*)lds;
    if (tid < 32) cnt[tid] = 0;
    __syncthreads();
    if (tid < 256) {
        const int t = pm * 256 + tid; const float* lr = LG + (size_t)t * 128;
        float rs;
        { const f32x4* sp = (const f32x4*)((const float*)(ws + WS_SSQ) + (size_t)t * 16); const f32x4 s0 = sp[0], s1 = sp[1], s2 = sp[2], s3 = sp[3];
          const float ss = (((s0[0] + s0[1]) + (s0[2] + s0[3])) + ((s1[0] + s1[1]) + (s1[2] + s1[3]))) + (((s2[0] + s2[1]) + (s2[2] + s2[3])) + ((s3[0] + s3[1]) + (s3[2] + s3[3])));
          rs = 1.0f / sqrtf(ss * (1.f / 1024.f) + 1e-6f); ((float*)(ws + WS_RS))[t] = rs; }
        float gl[4];
#pragma unroll
        for (int j = 0; j < 4; ++j) gl[j] = lr[32 + j] * rs + a.in[27][j];
        int gi = 0; float gm = gl[0];
#pragma unroll
        for (int j = 1; j < 4; ++j) if (gl[j] > gm) { gm = gl[j]; gi = j; }
        float gs = 0.f;
#pragma unroll
        for (int j = 0; j < 4; ++j) gs += __expf(gl[j] - gm);
        const float gtop = 1.0f / gs;
        float el[8];
#pragma unroll
        for (int j = 0; j < 8; ++j) el[j] = lr[gi * 8 + j] * rs + a.in[29][gi * 8 + j];
        int i1 = 0; float e1 = el[0];
#pragma unroll
        for (int j = 1; j < 8; ++j) if (el[j] > e1) { e1 = el[j]; i1 = j; }
        int i2 = -1; float e2 = -3.0e38f;
#pragma unroll
        for (int j = 0; j < 8; ++j) if (j != i1 && el[j] > e2) { e2 = el[j]; i2 = j; }
        const float ex = __expf(e2 - e1); const float w1 = gtop / (1.0f + ex), w2 = gtop * ex / (1.0f + ex);
        const int x1 = gi * 8 + i1, x2 = gi * 8 + i2;
        toke[t * 2] = x1; toke[t * 2 + 1] = x2; tokw[t * 2] = w1; tokw[t * 2 + 1] = w2;
        atomicAdd((int*)&cnt[x1], 1); atomicAdd((int*)&cnt[x2], 1);
    }
    __syncthreads();
    if (tid < 32) tilecnt[pm * 32 + tid] = cnt[tid];
    __syncthreads();
}

__device__ __forceinline__ void phase9(const Args& a, LAS unsigned char* lds, int tid, int lane, int wave) {
    unsigned char* ws = a.ws;
    const int tile = blockIdx.x;
    if (tile >= 128) return;
    const int* tilecnt = (const int*)(ws + WS_TILECNT); const int* toke = (const int*)(ws + WS_TOKE); const float* tokw = (const float*)(ws + WS_TOKW);
    int* pos = (int*)(ws + WS_POS); float* roww = (float*)(ws + WS_ROWW); int* disp = (int*)(ws + WS_DISP); int* rowtok = (int*)(ws + WS_ROWTOK);
    LAS int* tc = (LAS int*)lds;
    LAS int* tot = tc + 4096;
    LAS int* bef = tot + 32;
    LAS int* base = bef + 32;
    LAS int* pst = base + 32;
    LAS int* earr = pst + 32;
    LAS int* parr = earr + 512;
    for (int i = tid; i < 4096; i += NTHR) tc[i] = tilecnt[i];
    earr[tid] = toke[tile * 512 + tid];
    __syncthreads();
    if (tid < 32) { int s = 0, b = 0; for (int t = 0; t < 128; ++t) { const int c = tc[t * 32 + tid]; s += c; if (t < tile) b += c; } tot[tid] = s; bef[tid] = b; }
    __syncthreads();
    if (tid == 0) { int p = 0; for (int e = 0; e < 32; ++e) { pst[e] = p; base[e] = p + bef[e]; const int nt = (tot[e] + 255) >> 8;
                        if (tile == 0) { for (int k = 0; k < nt; ++k) disp[16 + (p >> 8) + k] = e; disp[512 + e] = p; disp[576 + e] = tot[e]; }
                        p += nt << 8; }
                    if (tile == 0) disp[0] = p >> 8; }
    __syncthreads();
    for (int q = 0; q < 4; ++q) { const int e = wave * 4 + q; int running = 0;
        for (int c8 = 0; c8 < 8; ++c8) { const int ai = c8 * 64 + lane; const bool mt = earr[ai] == e; const unsigned long long mk = __ballot(mt);
            if (mt) parr[ai] = base[e] + running + __popcll(mk & ((1ull << lane) - 1ull));
            running += __popcll(mk); } }
    __syncthreads();
    { const int ai = tid, p = parr[ai], t = tile * 256 + (ai >> 1); pos[t * 2 + (ai & 1)] = p; roww[p] = tokw[t * 2 + (ai & 1)]; rowtok[p] = t; ((float*)(ws + WS_ROWRS))[p] = ((const float*)(ws + WS_RS))[t]; }
    if (tile < 32) { const int p0 = pst[tile] + tot[tile], p1 = pst[tile] + (((tot[tile] + 255) >> 8) << 8);
        for (int r = p0 + tid; r < p1; r += NTHR) { rowtok[r] = 0; roww[r] = 0.f; ((float*)(ws + WS_ROWRS))[r] = 0.f; } }
}

__device__ __forceinline__ void phase12(const Args& a, int tid, int lane, int wave, int vcu, int G) {
    unsigned char* ws = a.ws;
    const int gw = vcu * NWAVES + wave, NGW = G * NWAVES;
    const bf16* x1 = (const bf16*)a.out; bf16* x2 = (bf16*)(ws + WS_X2); const bf16* y2 = (const bf16*)(ws + WS_Y2); const int* pos = (const int*)(ws + WS_POS); float* rs3 = (float*)(ws + WS_RS);
    for (int m = gw; m < T; m += NGW) {
        const int pa = pos[m * 2], pb = pos[m * 2 + 1];
        const v2u* xr = (const v2u*)(x1 + (size_t)m * DM) + lane; v2u* xo = (v2u*)(x2 + (size_t)m * DM) + lane; const v2u* ya = (const v2u*)(y2 + (size_t)pa * 1024) + lane; const v2u* yb = (const v2u*)(y2 + (size_t)pb * 1024) + lane;
        float s = 0.f;
#pragma unroll
        for (int j = 0; j < 4; ++j) { const v2u wx = xr[64 * j], wa = ya[64 * j], wb = yb[64 * j]; f32x4 v;
            v.x = bflo(wx.x) + bflo(wa.x) + bflo(wb.x); v.y = bfhi(wx.x) + bfhi(wa.x) + bfhi(wb.x); v.z = bflo(wx.y) + bflo(wa.y) + bflo(wb.y); v.w = bfhi(wx.y) + bfhi(wa.y) + bfhi(wb.y);
            v2u o; o.x = pk2(v.x, v.y); o.y = pk2(v.z, v.w); xo[64 * j] = o;
            s += (v.x * v.x + v.y * v.y) + (v.z * v.z + v.w * v.w); }
        const float rstd = 1.0f / sqrtf(wave_sum(s) * (1.f / 1024.f) + 1e-6f);
        if (lane == 0) rs3[m] = rstd;
    }
}
__device__ __forceinline__ void pp_tile(const Args& a, LAS unsigned char* lds, int tid0, int pm, int K256) {
    int oz = 0; asm volatile("" : "+v"(oz)); const int tid = tid0 + oz;
    unsigned char* ws = a.ws;
    const f32x4* p = (const f32x4*)a.in[1] + (size_t)pm * 256 * 64; v2u* p16 = (v2u*)(ws + WS_P16) + (size_t)pm * 256 * 64;
#pragma unroll 4
    for (int i = tid; i < 256 * 64; i += NTHR) { const f32x4 v = p[i]; v2u o; o.x = pk2(v.x, v.y); o.y = pk2(v.z, v.w); p16[i] = o; }
    VM_WAIT(); __syncthreads();
    pg8::Gemm g{(const pg8::bf16_t*)(ws + WS_P16), (const pg8::bf16_t*)(ws + WS_WPP), T, 1024, K256}; pg8::OrderItem S{pm, 0, 4};
    pg8::EpiStore E{(pg8::bf16_t*)(ws + WS_PP), 1024};
    pg8::gemm_phase<pg8::EpiStore, pg8::OrderItem, true, true>(lds, g, S, E, oz);
}

#if defined(PROBE_PHASE) && (PROBE_PHASE == 200 || PROBE_PHASE == 201)
__device__ __forceinline__ float blk_sum(float v, LAS float* red, int tid) { v = wave_sum(v); __syncthreads(); if ((tid & 63) == 0) red[tid >> 6] = v; __syncthreads(); float s = 0.f; for (int i = 0; i < 8; ++i) s += red[i]; __syncthreads(); return s; }
__device__ __forceinline__ void check_moe(const Args& a, LAS unsigned char* lds, int tid, float* res) {
    unsigned char* ws = a.ws;
    LAS float* hb = (LAS float*)lds; LAS float* hf = hb + 1024; LAS float* act = hf + 1024; LAS float* lg = act + 512; LAS float* red = lg + 64; LAS int* sel = (LAS int*)(red + 16);
    const int* toke = (const int*)(ws + WS_TOKE); const float* tokw = (const float*)(ws + WS_TOKW); const int* pos = (const int*)(ws + WS_POS); const bf16* y2 = (const bf16*)(ws + WS_Y2);
    float errsum = 0.f, refsum = 0.f; int mism = 0;
    for (int si = 0; si < 24; ++si) { const int t = si * 1361 + 17;
        const bf16* xr = (const bf16*)a.out + (size_t)t * DM; const float x0 = __builtin_bit_cast(float, (unsigned)xr[tid] << 16), x1 = __builtin_bit_cast(float, (unsigned)xr[tid + 512] << 16);
        const float rstd = 1.0f / sqrtf(blk_sum(x0 * x0 + x1 * x1, red, tid) * (1.f / 1024.f) + 1e-6f);
        const float h0 = x0 * rstd * a.in[25][tid], h1 = x1 * rstd * a.in[25][tid + 512];
        hf[tid] = h0; hf[tid + 512] = h1; hb[tid] = __builtin_bit_cast(float, f2bf(h0) << 16); hb[tid + 512] = __builtin_bit_cast(float, f2bf(h1) << 16);
        __syncthreads();
        if (tid < 36) { float s = 0.f; for (int k = 0; k < 1024; ++k) s += hf[k] * (tid < 32 ? a.in[28][k * 32 + tid] : a.in[26][k * 4 + (tid - 32)]); lg[tid] = s + (tid < 32 ? a.in[29][tid] : a.in[27][tid - 32]); }
        __syncthreads();
        if (tid == 0) { int gi = 0; for (int j = 1; j < 4; ++j) if (lg[32 + j] > lg[32 + gi]) gi = j;
            int i1 = 0; for (int j = 1; j < 8; ++j) if (lg[gi * 8 + j] > lg[gi * 8 + i1]) i1 = j;
            int i2 = -1; for (int j = 0; j < 8; ++j) if (j != i1 && (i2 < 0 || lg[gi * 8 + j] > lg[gi * 8 + i2])) i2 = j;
            sel[0] = gi * 8 + i1; sel[1] = gi * 8 + i2; }
        __syncthreads();
        if (sel[0] != toke[t * 2] || sel[1] != toke[t * 2 + 1]) mism++;
        float o0 = 0.f, o1 = 0.f;
        for (int kx = 0; kx < 2; ++kx) { const int e = toke[t * 2 + kx]; const float w = tokw[t * 2 + kx];
            const float* Wg = a.in[30] + (size_t)e * 1024 * 512; const float* Wu = a.in[31] + (size_t)e * 1024 * 512; const float* Wd = a.in[32] + (size_t)e * 512 * 1024;
            float gg = 0.f, uu = 0.f; for (int k = 0; k < 1024; ++k) { const float hk = hb[k]; gg += hk * Wg[(size_t)k * 512 + tid]; uu += hk * Wu[(size_t)k * 512 + tid]; }
            __syncthreads(); act[tid] = gg / (1.0f + __expf(-gg)) * uu; __syncthreads();
            float s0 = 0.f, s1 = 0.f; for (int f = 0; f < 512; ++f) { const float af = act[f]; s0 += af * Wd[(size_t)f * 1024 + tid]; s1 += af * Wd[(size_t)f * 1024 + tid + 512]; }
            o0 += s0 * w; o1 += s1 * w; }
        const int pa = pos[t * 2], pb = pos[t * 2 + 1];
        const float m0 = __builtin_bit_cast(float, (unsigned)y2[(size_t)pa * 1024 + tid] << 16) + __builtin_bit_cast(float, (unsigned)y2[(size_t)pb * 1024 + tid] << 16);
        const float m1 = __builtin_bit_cast(float, (unsigned)y2[(size_t)pa * 1024 + tid + 512] << 16) + __builtin_bit_cast(float, (unsigned)y2[(size_t)pb * 1024 + tid + 512] << 16);
        errsum += (m0 - o0) * (m0 - o0) + (m1 - o1) * (m1 - o1); refsum += o0 * o0 + o1 * o1;
    }
    const float es = blk_sum(errsum, red, tid), rs = blk_sum(refsum, red, tid);
    if (tid == 0) *res = (PROBE_PHASE == 200) ? sqrtf(es / rs) : (float)mism / 24.f;
}
#endif

#ifndef PROBE_KAPPA
#define PROBE_KAPPA 0
#endif
#ifndef CHK_S0
#define CHK_S0 0
#define CHK_SN 4096
#endif
#if defined(PROBE_PHASE) && (PROBE_PHASE == 210 || PROBE_PHASE == 211 || PROBE_PHASE == 215)
__device__ __forceinline__ void check_attn(const Args& a, LAS unsigned char* lds, int tid, float* res) {
    unsigned char* ws = a.ws;
    const bf16* vt = (const bf16*)(ws + WS_VT);
    const bf16* odf = (const bf16*)((unsigned char*)a.out + OUT_ORWDF) + 512;
    LAS float* sc = (LAS float*)lds; LAS float* part = sc + 4096; LAS float* oc = part + 512; LAS float* red = oc + 256;
    const float d1 = wave_sum(a.in[17][tid & 63] * a.in[18][tid & 63]), d2 = wave_sum(a.in[19][tid & 63] * a.in[20][tid & 63]);
    const float lam = __expf(d1) - __expf(d2) + LAM_INIT;
    float errsum = 0.f, refsum = 0.f;
    for (int si = 0; si < 24; ++si) { const int b = si & 7, head = (PROBE_PHASE == 215) ? 0 : ((si >> 1) & 3), s = CHK_S0 + ((si * 977 + 31 * (si & 3)) % CHK_SN);
        for (int c = 0; c < 2; ++c) { const int vh = b * 8 + head * 2 + c;
            const bf16* qn = qn_ptr(ws, b); const bf16* kn = kn_ptr(ws, b); const bf16* qp = qn + ((size_t)(vh & 7) * SEQ + s) * 64; float mx = -3e38f;
            for (int j = tid; j <= s; j += NTHR) { const bf16* kp = kn + ((size_t)(vh & 7) * SEQ + j) * 64; float d = 0.f;
                for (int e = 0; e < 64; ++e) d += __builtin_bit_cast(float, (unsigned)qp[e] << 16) * __builtin_bit_cast(float, (unsigned)kp[e] << 16);
                sc[j] = d; mx = fmaxf(mx, d); }
            __syncthreads();
            for (int o = 1; o < 64; o <<= 1) mx = fmaxf(mx, __shfl_xor(mx, o));
            if ((tid & 63) == 0) red[tid >> 6] = mx;
            __syncthreads();
            mx = red[0]; for (int i = 1; i < 8; ++i) mx = fmaxf(mx, red[i]);
            __syncthreads();
            float ls = 0.f;
            for (int j = tid; j <= s; j += NTHR) { const float p = exp2f(sc[j] - mx); sc[j] = p; ls += p; }
            ls = wave_sum(ls); if ((tid & 63) == 0) red[tid >> 6] = ls;
            __syncthreads();
            float l = 0.f; for (int i = 0; i < 8; ++i) l += red[i];
            { const int dv = tid & 127, pr = tid >> 7; const bf16* vp = vt + (size_t)(head * 128 + dv) * T + (size_t)b * SEQ; float acc = 0.f;
              for (int j = pr; j <= s; j += 4) acc += sc[j] * __builtin_bit_cast(float, (unsigned)vp[j] << 16);
              part[tid] = acc; }
            __syncthreads();
            if (tid < 128) oc[c * 128 + tid] = (part[tid] + part[tid + 128] + part[tid + 256] + part[tid + 384]) / l;
            __syncthreads(); }
#if PROBE_PHASE == 215
        if (tid < 128) { const float ref = oc[tid]; const float got = __builtin_bit_cast(float, (unsigned)((const bf16*)(ws + 496 * MiB))[((size_t)b * SEQ + s) * 128 + tid] << 16); errsum += (PROBE_KAPPA ? got * ref : (got - ref) * (got - ref)); refsum += ref * ref; }
        __syncthreads(); continue;
#endif
        float dd = 0.f, sq = 0.f; if (tid < 128) { dd = oc[tid] - lam * oc[128 + tid]; sq = dd * dd; }
        sq = wave_sum(sq); __syncthreads(); if ((tid & 63) == 0) red[tid >> 6] = sq; __syncthreads();
        const float rs = (1.0f / sqrtf((red[0] + red[1]) * (1.f / 128.f) + 1e-6f)) * (1.0f - LAM_INIT);
        if (tid < 128) { const float ref = dd * rs * a.in[21][tid]; const float got = __builtin_bit_cast(float, (unsigned)odf[((size_t)b * SEQ + s) * 1024 + head * 128 + tid] << 16);
            errsum += (got - ref) * (got - ref); refsum += ref * ref; }
        __syncthreads(); }
    errsum = wave_sum(errsum); refsum = wave_sum(refsum);
    __syncthreads(); if ((tid & 63) == 0) { red[tid >> 6] = errsum; red[8 + (tid >> 6)] = refsum; } __syncthreads();
    if (tid == 0) *res = PROBE_KAPPA ? fabsf((red[0] + red[1]) / (red[8] + red[9])) : sqrtf((red[0] + red[1]) / (red[8] + red[9]));
}
__device__ __forceinline__ void check_scan(const Args& a, LAS unsigned char* lds, int tid, float* res) {
    unsigned char* ws = a.ws; const int b = 1, hd = 3, NS = 384;
    const bf16* rkv = (const bf16*)(ws + WS_RKV); const bf16* E = (const bf16*)(ws + WS_E); const bf16* Aa = (const bf16*)(ws + WS_A); const bf16* Y = y_ptr(a.out, b);
    LAS float* vw = (LAS float*)lds; LAS float* vaa = vw + 64; LAS float* vbb = vaa + 64; LAS float* vkm = vbb + 64; LAS float* vr = vkm + 64; LAS float* vv = vr + 64; LAS float* red = vv + 64;
    const int row = tid >> 3, cg = tid & 7; float st[8]; for (int j = 0; j < 8; ++j) st[j] = 0.f;
    float errsum = 0.f, refsum = 0.f;
    for (int s = 0; s < NS; ++s) { const size_t t = (size_t)b * SEQ + s;
        if (tid < 64) { const int ch = hd * 64 + tid;
            auto ld = [&](size_t tt, int off) { return __builtin_bit_cast(float, (unsigned)rkv[tt * 1536 + off + ch] << 16); };
            const float rc = ld(t, 0), kc = ld(t, 512), vc = ld(t, 1024); const float rp = s ? ld(t - 1, 0) : 0.f, kp = s ? ld(t - 1, 512) : 0.f, vp = s ? ld(t - 1, 1024) : 0.f;
            const float r = rc + (rp - rc) * a.in[4][ch], k = kc + (kp - kc) * a.in[4][512 + ch], v = vc + (vp - vc) * a.in[4][1024 + ch];
            const float e = __builtin_bit_cast(float, (unsigned)E[t * 512 + ch] << 16), av = __builtin_bit_cast(float, (unsigned)Aa[t * 512 + ch] << 16);
            float kk = k * a.in[10][ch]; const float nn = sqrtf(wave_sum(kk * kk)); kk = kk / fmaxf(nn, 1e-12f);
            vw[tid] = expf(-e); vaa[tid] = -kk; vbb[tid] = kk * av; vkm[tid] = k * (1.0f + (av - 1.0f) * a.in[11][ch]); vr[tid] = r; vv[tid] = v; }
        __syncthreads();
        float sa = 0.f; for (int j = 0; j < 8; ++j) sa += st[j] * vaa[cg * 8 + j];
        sa += __shfl_xor(sa, 1); sa += __shfl_xor(sa, 2); sa += __shfl_xor(sa, 4);
        float y = 0.f; for (int j = 0; j < 8; ++j) { const int c = cg * 8 + j; st[j] = st[j] * vw[c] + sa * vbb[c] + vv[row] * vkm[c]; y += st[j] * vr[c]; }
        y += __shfl_xor(y, 1); y += __shfl_xor(y, 2); y += __shfl_xor(y, 4);
        if (cg == 0) { const float got = __builtin_bit_cast(float, (unsigned)Y[(size_t)s * 512 + hd * 64 + row] << 16); errsum += (got - y) * (got - y); refsum += y * y; }
        __syncthreads(); }
    errsum = wave_sum(errsum); refsum = wave_sum(refsum);
    if ((tid & 63) == 0) { red[tid >> 6] = errsum; red[8 + (tid >> 6)] = refsum; } __syncthreads();
    if (tid == 0) { float es = 0.f, rs = 0.f; for (int i = 0; i < 8; ++i) { es += red[i]; rs += red[8 + i]; } *res = sqrtf(es / rs); }
}
#endif
#ifndef MK_N_LAUNCHES
#define MK_N_LAUNCHES 1
#endif
#ifndef SCAN_CHUNKED
#define SCAN_CHUNKED 1
#endif
constexpr int NSCAN = SCAN_CHUNKED ? 64 : 128;
constexpr int NGATE = 256;
constexpr int NPHASE = 15;
__global__ void __launch_bounds__(NTHR, 2) mk_fwd(Args args) {
    extern __shared__ __attribute__((aligned(16))) unsigned char lds_raw[];
    LAS unsigned char* lds = (LAS unsigned char*)lds_raw;
    const int tid = threadIdx.x, lane = tid & 63, wave = __builtin_amdgcn_readfirstlane(tid >> 6);
    const int G = gridDim.x; const int bx = blockIdx.x; const int vcu = (G % 8 == 0) ? (bx % 8) * (G / 8) + bx / 8 : bx;
    unsigned char* ws = args.ws;
    const int lo = args.ph_lo, hi = args.ph_hi;
#ifdef ONLY_PHASE
#define IN(k) ((k) == ONLY_PHASE && lo <= (k) && (k) < hi)
#else
#define IN(k) (lo <= (k) && (k) < hi)
#endif
#if MK_N_LAUNCHES == 1
    volatile LAS unsigned* MISC = (volatile LAS unsigned*)(lds + MISC_OFF);
    for (int u = tid; u < 64; u += NTHR) MISC[u] = 0u;
    __syncthreads();
    XcdBarrier xbar = xcd_barrier_post((unsigned*)(ws + WS_CTL) + CW_BAR, MISC + 8);
    if (lo < 0) { __threadfence(); cg::this_grid().sync(); }
#define SEAM(k) do { if (IN(k) && IN((k) + 1)) xcd_barrier(xbar); } while (0)
#else
#define SEAM(k) do { } while (0)
#endif
#ifdef PROBE_PHASE
    volatile LAS unsigned long long* ptw = (volatile LAS unsigned long long*)(lds + MISC_OFF + 1536);
#define pt0 ptw[0]
#define pt1 ptw[1]
    if (tid == 0) { pt0 = 0ull; pt1 = 0ull; }
#define PB(k) do { if ((k) == PROBE_PHASE && bx == 0 && tid == 0) pt0 = __builtin_amdgcn_s_memrealtime(); } while (0)
#define PE(k) do { if ((k) == PROBE_PHASE && bx == 0 && tid == 0) pt1 = __builtin_amdgcn_s_memrealtime(); } while (0)
#else
#define PB(k) do { } while (0)
#define PE(k) do { } while (0)
#endif
    typedef pg8::bf16_t pbf;
    int K256 = 256, K512 = 512, K1024 = 1024, K2048 = 2048;
    asm volatile("" : "+s"(K256), "+s"(K512), "+s"(K1024), "+s"(K2048));
    PB(0);
    if (IN(0)) { phase0(args, lds, tid, lane, wave, vcu, G); }
    SEAM(0); PE(0);
    PB(1);
    if (IN(1)) {
        { pg8::Gemm g{(const pbf*)(ws + WS_XN), (const pbf*)(ws + WS_WIN), T, 11 * 256, K1024}; pg8::StaticOrder S; S.init(T, 11 * 256, G, bx);
          pg8::EpiProj E{(pbf*)(ws + WS_RKV), (pbf*)(ws + WS_PROJB), (pbf*)(ws + WS_GATES)};
          pg8::gemm_phase<pg8::EpiProj, pg8::StaticOrder, true, true>(lds, g, S, E); }
        { pg8::Gemm g{(const pbf*)(ws + WS_WIN) + (size_t)2816 * 1024, (const pbf*)(ws + WS_XN), 512, T, K1024}; pg8::StaticOrder S; S.init(512, T, G, bx);
          pg8::EpiStore E{(pbf*)(ws + WS_VT), T};
          pg8::gemm_phase<pg8::EpiStore, pg8::StaticOrder, true, true>(lds, g, S, E); }
    }
    SEAM(1); PE(1);
    PB(2);
    if (IN(2)) { phase2(args, lds, tid, vcu, G); }
    SEAM(2); PE(2);
    PB(3);
    if (IN(3)) {
        pg8::Gemm g{(const pbf*)((unsigned char*)args.out + OUT_LA), (const pbf*)(ws + WS_WLORA), T, 1536, K256}; pg8::StaticOrder S; S.init(T, 1536, G, bx);
        pg8::EpiLora E{(pbf*)(ws + WS_E), (pbf*)(ws + WS_A), (pbf*)(ws + WS_G), args.in[5], args.in[7]};
        pg8::gemm_phase<pg8::EpiLora, pg8::StaticOrder, true, true>(lds, g, S, E);
    }
    SEAM(3); PE(3);
    PB(4);
    if (IN(4)) {
        unsigned* qhead = (unsigned*)(ws + WS_CTL) + CW_QUEUE; LAS unsigned* ubox = (LAS unsigned*)(lds + MISC_OFF);
        float* stash = (float*)((unsigned char*)args.out + OUT_STASH) + (size_t)bx * 64 * 512;
        for (;;) {
            __syncthreads();
            if (tid == 0) ubox[0] = atomicAdd(qhead, 1u);
            __syncthreads();
            const int u = (int)ubox[0];
            int oq = 0; asm volatile("" : "+v"(oq)); const int tq = tid + oq;
            if (u >= NSCAN + NGATE + 512 + NTRQ) break;
            if (u >= NSCAN + NGATE + 512) {
                if (tid == 0) { while (__hip_atomic_load(qhead + 1, __ATOMIC_ACQUIRE, __HIP_MEMORY_SCOPE_AGENT) < (unsigned)NGATE) __builtin_amdgcn_s_sleep(8); }
                __syncthreads();
                tr_wgu_qitem(args, lds, (tq & 63), wave, u - (NSCAN + NGATE + 512)); continue; }
#if defined(PROBE_PHASE) && PROBE_PHASE == 100
            if (u < NSCAN) { if (tid == 0) ptw[2] = __builtin_amdgcn_s_memrealtime(); if (SCAN_CHUNKED) scan_unit_chunked(args, lds, tq, u); else scan_unit(args, lds, tq, u);
                if (tid == 0) atomicMax((unsigned*)(ws + WS_CTL) + 96, (unsigned)(__builtin_amdgcn_s_memrealtime() - ptw[2])); }
#else
            if (u < NSCAN) { if (SCAN_CHUNKED) scan_unit_chunked(args, lds, tq, u); else scan_unit(args, lds, tq, u); }
#endif
#if defined(PROBE_PHASE) && PROBE_PHASE == 101
            else if (u < NSCAN + NGATE) { } else { const int au = u - NSCAN - NGATE; const unsigned long long q0 = __builtin_amdgcn_s_memrealtime(); attn_unit(args, lds, tid, (au & 31) >> 2, au & 3, 15 - (au >> 5), stash); const unsigned long long q1 = __builtin_amdgcn_s_memrealtime();
                if (tid == 0) atomicAdd((unsigned*)(ws + WS_CTL) + 96, (unsigned)(q1 - q0)); }
#else
            else if (u < NSCAN + NGATE) { const int it = u - NSCAN;
                pg8::Gemm g{(const pbf*)(ws + WS_XN), (const pbf*)(ws + WS_WIN) + (size_t)3328 * 1024, T, 2048, K1024}; pg8::OrderItem S{it >> 1, (it & 1) * 4, 4};
                pg8::EpiGates E{(pbf*)(ws + WS_GATES)};
                pg8::gemm_phase<pg8::EpiGates, pg8::OrderItem, true, true>(lds, g, S, E, oq);
                __syncthreads(); if (tid == 0) __hip_atomic_fetch_add(qhead + 1, 1u, __ATOMIC_RELEASE, __HIP_MEMORY_SCOPE_AGENT); }
            else { const int au = u - NSCAN - NGATE; attn_unit(args, lds, tq, (au & 31) >> 2, au & 3, 15 - (au >> 5), stash); }
#endif
        }
    }
    SEAM(4); PE(4);
#if defined(PROBE_PHASE) && (PROBE_PHASE == 210 || PROBE_PHASE == 211 || PROBE_PHASE == 215)
    if (bx == 0) { float* res = (float*)(ws + WS_CTL) + 100; if (PROBE_PHASE != 211) check_attn(args, lds, tid, res); else check_scan(args, lds, tid, res); __syncthreads(); if (tid == 0) { pt0 = 0ull; pt1 = (unsigned long long)(*(volatile float*)res * 1.0e6f); } }
    xcd_barrier(xbar);
#endif
#if defined(PROBE_PHASE) && PROBE_PHASE == 100
    if (bx == 0 && tid == 0) { pt0 = 0ull; pt1 = (unsigned long long)__hip_atomic_load((unsigned*)(ws + WS_CTL) + 96, __ATOMIC_RELAXED, __HIP_MEMORY_SCOPE_AGENT); }
#endif
#if defined(PROBE_PHASE) && PROBE_PHASE >= 300 && PROBE_PHASE < 310
    if (bx == 0 && tid == 0) { pt0 = 0ull; pt1 = (unsigned long long)__hip_atomic_load((unsigned*)(ws + WS_CTL) + 96, __ATOMIC_RELAXED, __HIP_MEMORY_SCOPE_AGENT) / 64ull; }
#endif
#if defined(PROBE_PHASE) && PROBE_PHASE == 101
    if (bx == 0 && tid == 0) { pt0 = 0ull; pt1 = (unsigned long long)__hip_atomic_load((unsigned*)(ws + WS_CTL) + 96, __ATOMIC_RELAXED, __HIP_MEMORY_SCOPE_AGENT) / 256ull; }
#endif
    PB(5);
    if (IN(5)) { phase_orw(args, lane, wave, vcu, G); }
    SEAM(5); PE(5);
    PB(6);
    if (IN(6)) {
        pg8::Gemm g{(const pbf*)((unsigned char*)args.out + OUT_ORWDF), (const pbf*)(ws + WS_WBRD), T, 1024, K1024}; pg8::StaticOrder S; S.init(T, 1024, G, bx);
        pg8::EpiMix E{(const pbf*)(ws + WS_GATES), (pbf*)(ws + WS_MIXED)};
        pg8::gemm_phase<pg8::EpiMix, pg8::StaticOrder, true, true>(lds, g, S, E);
    }
    SEAM(6); PE(6);
    PB(7);
    if (IN(7)) {
        pg8::Gemm g{(const pbf*)(ws + WS_MIXED), (const pbf*)(ws + WS_WO), T, 1024, K1024}; pg8::StaticOrder S; S.init(T, 1024, G, bx);
        pg8::EpiRes E{args.in[0], (pbf*)args.out, (float*)(ws + WS_SSQ)};
        pg8::gemm_phase<pg8::EpiRes, pg8::StaticOrder, true, true>(lds, g, S, E);
    }
    SEAM(7); PE(7);
    PB(9);
    if (IN(9)) {
        pg8::Gemm g{(const pbf*)args.out, (const pbf*)(ws + WS_WR), T, 256, K1024}; pg8::StaticOrder S; S.init(T, 256, G, bx);
        pg8::EpiLogits E{(float*)(ws + WS_LOGITS)};
        pg8::gemm_phase<pg8::EpiLogits, pg8::StaticOrder, true, true>(lds, g, S, E);
        VM_WAIT(); __syncthreads();
        pg8::Unit u;
        for (int i = 0; S.next(i, u); ++i) route_tile(args, lds, tid, u.pm);
        { const int j0 = G > 128 ? bx - 128 : bx, nj = G > 128 ? G - 128 : G;
          if (j0 >= 0) { for (int pm = j0; pm < T / 256; pm += nj) { __syncthreads(); pp_tile(args, lds, tid, pm, K256); } } }
    }
    SEAM(9); PE(9);
    PB(10);
    if (IN(10)) { phase9(args, lds, tid, lane, wave);
        if (G <= 128) { __syncthreads(); tr_wd_all(args, lds, lane, wave, bx * NWAVES + wave, G * NWAVES); }
        else if (bx >= 128) tr_wd_all(args, lds, lane, wave, (bx - 128) * NWAVES + wave, (G - 128) * NWAVES); }
    SEAM(10); PE(10);
    PB(11);
    if (IN(11) || IN(12)) {
        const int* disp = (const int*)(ws + WS_DISP); LAS int* tile_e = (LAS int*)(lds + MISC_OFF + 64);
        __syncthreads();
        const int NT = disp[0];
        for (int i = tid; i < NT && i < 320; i += NTHR) tile_e[i] = disp[16 + i];
        __syncthreads();
        if (IN(11)) {
            pg8::Gemm g{(const pbf*)args.out, (const pbf*)(ws + WS_WGU), T, NEXP * 1024, K1024}; pg8::OrderMoeUp S{{NT * 4, G, bx, tile_e}, (unsigned*)(ws + WS_CTL) + CW_MOECNT};
            pg8::EpiAct E{(pbf*)(ws + WS_ACT), (const float*)(ws + WS_ROWRS)};
            pg8::gemm_phase_gather<pg8::EpiAct, pg8::OrderMoeUp>(lds, g, (const int*)(ws + WS_ROWTOK), S, E);
        }
        PE(11); PB(12);
        if (IN(12)) {
            pg8::Gemm g{(const pbf*)(ws + WS_ACT), (const pbf*)(ws + WS_WD), MAXROWS, NEXP * 1024, K512}; pg8::OrderMoeDown S{{NT * 4, G, G - 1 - bx, tile_e}, (unsigned*)(ws + WS_CTL) + CW_MOECNT};
            pg8::EpiDown E{(pbf*)(ws + WS_Y2), (const float*)(ws + WS_ROWW)};
            pg8::gemm_phase<pg8::EpiDown, pg8::OrderMoeDown, true, true>(lds, g, S, E);
        }
    }
    SEAM(12); PE(12);
#if defined(PROBE_PHASE) && (PROBE_PHASE == 200 || PROBE_PHASE == 201)
    if (bx == 0) { float* res = (float*)(ws + WS_CTL) + 100; check_moe(args, lds, tid, res); __syncthreads(); if (tid == 0) { pt0 = 0ull; pt1 = (unsigned long long)(*(volatile float*)res * 1.0e6f); } }
    xcd_barrier(xbar);
#endif
    PB(13);
    if (IN(13)) { phase12(args, tid, lane, wave, vcu, G); }
    SEAM(13); PE(13);
    PB(14);
    if (IN(14)) {
        { pg8::Gemm g{(const pbf*)(ws + WS_X2), (const pbf*)(ws + WS_WPG), T, 1024, K1024}; pg8::StaticOrder S; S.init(T, 1024, G, bx);
          pg8::EpiFinal E{(const pbf*)(ws + WS_PP), (const pbf*)(ws + WS_X2), args.out, (const float*)(ws + WS_RS)};
          pg8::gemm_phase<pg8::EpiFinal, pg8::StaticOrder, true, true>(lds, g, S, E); }
    }
#ifdef PROBE_PHASE
    if (PROBE_PHASE == 14 && bx == 0 && tid == 0) { pt1 = __builtin_amdgcn_s_memrealtime(); }
    if (bx == 0 && tid == 0) { const unsigned long long te = __builtin_amdgcn_s_memrealtime(), w = (unsigned long long)PROBE_MULT * (pt1 - pt0);
        while (__builtin_amdgcn_s_memrealtime() - te < w) __builtin_amdgcn_s_sleep(32); }
#endif
#undef IN
#undef SEAM
}

extern "C" void kernel_launch(void* const* d_in, const int* in_sizes, int n_in, void* d_out, int out_size, void* d_ws, size_t ws_size, hipStream_t stream) {
    static int grid = 0;
    if (grid == 0) {
        if (n_in != 36 || in_sizes[0] != T * DM || out_size != T * DM || ws_size < WS_END) {
            fprintf(stderr, "kernel_launch: unexpected problem: n_in %d in0 %d out %d ws %zu (need %zu)\n", n_in, n_in > 0 ? in_sizes[0] : -1, out_size, ws_size, (size_t)WS_END); grid = -1; return; }
        int dev = 0, cus = 0, per_cu = 0;
        if (hipGetDevice(&dev) != hipSuccess || hipDeviceGetAttribute(&cus, hipDeviceAttributeMultiprocessorCount, dev) != hipSuccess) { grid = -1; return; }
        if (hipFuncSetAttribute((const void*)mk_fwd, hipFuncAttributeMaxDynamicSharedMemorySize, LDS_BYTES) != hipSuccess) { fprintf(stderr, "kernel_launch: hipFuncSetAttribute failed\n"); grid = -1; return; }
        if (hipOccupancyMaxActiveBlocksPerMultiprocessor(&per_cu, (const void*)mk_fwd, NTHR, LDS_BYTES) != hipSuccess || per_cu < 1) { fprintf(stderr, "kernel_launch: occupancy query says %d blocks per CU\n", per_cu); (void)hipGetLastError(); grid = -1; return; }
        grid = cus;
        if (grid > 256) grid = 256;
    }
    if (grid < 0) return;
    (void)hipMemsetAsync((char*)d_ws + WS_CTL, 0, CTL_ZERO_BYTES, stream);
    Args a{};
    for (int i = 0; i < 36; ++i) a.in[i] = (const float*)d_in[i];
    a.out = (float*)d_out; a.ws = (unsigned char*)d_ws;
#if MK_N_LAUNCHES == 1
    a.ph_lo = 0; a.ph_hi = NPHASE;
    void* kargs[] = {&a};
    const hipError_t e = hipLaunchCooperativeKernel((const void*)mk_fwd, dim3(grid), dim3(NTHR), kargs, LDS_BYTES, stream);
    if (e != hipSuccess) fprintf(stderr, "kernel_launch: cooperative launch failed: %s (grid %d)\n", hipGetErrorString(e), grid);
#else
    for (int ph = 0; ph < NPHASE; ++ph) { a.ph_lo = ph; a.ph_hi = ph + 1; hipLaunchKernelGGL(mk_fwd, dim3(grid), dim3(NTHR), LDS_BYTES, stream, a); }
#endif
}
```

```cpp
#include <hip/hip_runtime.h>
#include <hip/hip_cooperative_groups.h>
#include <cstdio>
#include <cstdint>
namespace cg = cooperative_groups;
namespace pg8 {
#define PG8_LAS __attribute__((address_space(3)))
typedef unsigned short bf16_t;
typedef short bf16x8 __attribute__((ext_vector_type(8)));
typedef float f32x4 __attribute__((ext_vector_type(4)));
typedef unsigned u32x4 __attribute__((ext_vector_type(4)));
constexpr int BM = 256, BK = 64, HALF = 128, HTB = HALF * BK * 2  , STAGE_BYTES = 8 * HTB, NXCD = 8, WGM = 8;

__host__ __device__ __forceinline__ int lds_byte(int r, int c) { const int st = (r >> 4) * 2 + (c >> 5), rr = r & 15, cc = c & 31, ob = rr * 64 + cc * 2; return st * 1024 + (ob ^ (((ob >> 9) & 1) << 5)); }
__host__ __device__ __forceinline__ void stage_rc(int b, int& R, int& C) { const int st = b / 1024, sb = b % 1024, swz = sb ^ (((sb >> 9) & 1) << 5); R = (st >> 1) * 16 + swz / 64; C = (st & 1) * 32 + (swz % 64) / 2; }
__host__ __device__ __forceinline__ int perm32(int rho) { const int n = rho >> 4, i = rho & 15; return 8 * (i >> 2) + 4 * n + (i & 3); }

struct Unit { int pm, pn; };
struct Gemm { const bf16_t* A; const bf16_t* Bt; int M, N, K; };

struct StaticOrder {
    int nM, nN, nwg, G, c;
    __host__ __device__ __forceinline__ void init(int M, int N, int G_, int c_) { nM = M / BM; nN = N / BM; nwg = nM * nN; G = G_; c = c_; }
    __host__ __device__ __forceinline__ bool next(int i, Unit& u) const {
        const long L = (long)i * G + c; if (L >= nwg) return false;
        int wgid = (int)L; { const int q = nwg / NXCD, r = nwg % NXCD, xcd = wgid % NXCD, off = wgid / NXCD; wgid = (xcd < r ? xcd * (q + 1) : r * (q + 1) + (xcd - r) * q) + off; }
        const int nig = WGM * nN, gid = wgid / nig, fm = gid * WGM, gsz = (nM - fm) < WGM ? (nM - fm) : WGM;
        u.pm = fm + ((wgid % nig) % gsz); u.pn = (wgid % nig) / gsz; return true;
    }
    __device__ __forceinline__ void a_ready(const Unit&) const {}
    __device__ __forceinline__ void done(const Unit&) const {}
};

__device__ __forceinline__ unsigned cvt_pk_bf16(float lo, float hi) { unsigned r; asm volatile("v_cvt_pk_bf16_f32 %0, %1, %2" : "=v"(r) : "v"(lo), "v"(hi)); return r; }
template <class Epi, class Sched, bool ALIGN_EPI = false, bool SP2 = false>
__device__ __forceinline__ void gemm_phase(PG8_LAS unsigned char* lds, const Gemm g, const Sched& S, const Epi& E, const int tz = 0  ) {
    const int tid = threadIdx.x + tz, wid = __builtin_amdgcn_readfirstlane(tid >> 6), lane = tid & 63, wr = wid >> 2, wc = wid & 3, fr = lane & 15, fq = lane >> 4;
    const int K = g.K, nt = K / BK;
    unsigned voffA[2], voffB[2];
#pragma unroll
    for (int i = 0; i < 2; ++i) { int R, C; stage_rc(tid * 16 + i * 8192, R, C); const int Rb = Epi::PERM ? ((R & ~31) + perm32(R & 31)) : R;
        voffA[i] = (unsigned)(R * K + C) * 2u; voffB[i] = (unsigned)(Rb * K + C) * 2u; }
    const size_t kstep = (size_t)(BK * 2);
    const size_t hstep = (size_t)HALF * K * 2;
    const size_t tstep = 2 * hstep;
    const unsigned ldsw = (unsigned)wid * 1024u;
    const int aoff = lds_byte(wr * 64 + fr, fq * 8), boff = lds_byte(wc * 32 + fr, fq * 8);
#define PG8_SA(b, h) (((b) * 2 + (h)) * HTB)
#define PG8_SB(b, h) ((4 + (b) * 2 + (h)) * HTB)
#define PG8_STAGE(bufoff, gbase, voff) do { _Pragma("unroll") for (int _i = 0; _i < 2; ++_i) \
        __builtin_amdgcn_global_load_lds((const unsigned*)((const char*)(gbase) + (voff)[_i]), (PG8_LAS unsigned*)(lds + (bufoff) + ldsw + _i * 8192), 16, 0, 0); } while (0)
#define PG8_LDA(dst, b, h) do { _Pragma("unroll") for (int m = 0; m < 4; ++m) _Pragma("unroll") for (int k = 0; k < 2; ++k) dst[m][k] = *(const PG8_LAS bf16x8*)(lds + PG8_SA(b, h) + aoff + m * 2048 + k * 1024); } while (0)
#define PG8_LDB(dst, b, h) do { _Pragma("unroll") for (int n = 0; n < 2; ++n) _Pragma("unroll") for (int k = 0; k < 2; ++k) dst[n][k] = *(const PG8_LAS bf16x8*)(lds + PG8_SB(b, h) + boff + n * 2048 + k * 1024); } while (0)
#define PG8_MMA(ai, bj, At, Bt) do { __builtin_amdgcn_s_setprio(1); _Pragma("unroll") for (int m = 0; m < 4; ++m) _Pragma("unroll") for (int n = 0; n < 2; ++n) _Pragma("unroll") for (int k = 0; k < 2; ++k) \
        acc[ai][bj][m][n] = __builtin_amdgcn_mfma_f32_16x16x32_bf16(Bt[n][k], At[m][k], acc[ai][bj][m][n], 0, 0, 0); __builtin_amdgcn_s_setprio(0); } while (0)
#define PG8_WAIT_V(n) asm volatile("s_waitcnt vmcnt(" #n ")" ::: "memory")
#define PG8_WAIT_L(n) asm volatile("s_waitcnt lgkmcnt(" #n ")" ::: "memory")
#define PG8_BAR __builtin_amdgcn_s_barrier()
#define PG8_SCHED __builtin_amdgcn_sched_barrier(0)
    Unit cur, nxt; int ui = 0;
    if (!S.next(0, cur)) return;
    f32x4 acc[2][2][4][2];
#pragma unroll
    for (int a = 0; a < 2; ++a)
#pragma unroll
        for (int b = 0; b < 2; ++b)
#pragma unroll
            for (int m = 0; m < 4; ++m)
#pragma unroll
                for (int n = 0; n < 2; ++n) acc[a][b][m][n] = (f32x4){0.f, 0.f, 0.f, 0.f};
    bf16x8 At[4][2], B0[2][2], B1[2][2];
    const char* cA = (const char*)g.A + (size_t)cur.pm * tstep; const char* cB = (const char*)g.Bt + (size_t)cur.pn * tstep;
    S.a_ready(cur);
    if constexpr (SP2) {
        PG8_STAGE(PG8_SB(0, 0), cB, voffB); PG8_STAGE(PG8_SB(0, 1), cB + hstep, voffB); PG8_STAGE(PG8_SA(0, 0), cA, voffA); PG8_STAGE(PG8_SA(0, 1), cA + hstep, voffA);
        if (wr == 1) PG8_BAR;
        PG8_WAIT_V(2); PG8_BAR;
        PG8_STAGE(PG8_SB(1, 0), cB + kstep, voffB); PG8_STAGE(PG8_SA(1, 0), cA + kstep, voffA); PG8_STAGE(PG8_SB(1, 1), cB + hstep + kstep, voffB);
        PG8_WAIT_V(6); PG8_BAR;
    } else {
        PG8_STAGE(PG8_SB(0, 0), cB, voffB); PG8_STAGE(PG8_SA(0, 0), cA, voffA); PG8_STAGE(PG8_SB(0, 1), cB + hstep, voffB); PG8_STAGE(PG8_SA(0, 1), cA + hstep, voffA);
        if (wr == 1) PG8_BAR;
        PG8_WAIT_V(4); PG8_BAR;
        PG8_STAGE(PG8_SB(1, 0), cB + kstep, voffB); PG8_STAGE(PG8_SA(1, 0), cA + kstep, voffA); PG8_STAGE(PG8_SB(1, 1), cB + hstep + kstep, voffB);
        PG8_WAIT_V(6); PG8_BAR;
    }
    for (;;) {
        const bool has_next = S.next(ui + 1, nxt);
        const char* nA = has_next ? (const char*)g.A + (size_t)nxt.pm * tstep : cA; const char* nB = has_next ? (const char*)g.Bt + (size_t)nxt.pn * tstep : cB;
        for (int t = 0; t < nt; t += 2) {
            if constexpr (Epi::HAS_MID) { if (t == (nt >> 1)) E.mid(acc, cur, wr, wc, fr, fq); }
            const bool last = (t == nt - 2);
            const char* a1 = cA + (size_t)(t + 1) * kstep;
            const char* a2 = last ? nA : cA + (size_t)(t + 2) * kstep; const char* b2 = last ? nB : cB + (size_t)(t + 2) * kstep;
            const char* a3 = a2 + kstep; const char* b3 = b2 + kstep;
            if (last && has_next) S.a_ready(nxt);
            if constexpr (SP2) {
            PG8_LDB(B0, 0, 0); PG8_LDB(B1, 0, 1); PG8_SCHED; PG8_LDA(At, 0, 0); PG8_STAGE(PG8_SA(1, 1), a1 + hstep, voffA);
            PG8_WAIT_V(8); PG8_WAIT_L(0); PG8_BAR; PG8_MMA(0, 0, At, B0); PG8_MMA(0, 1, At, B1); PG8_BAR; PG8_SCHED;
            PG8_LDA(At, 0, 1); PG8_STAGE(PG8_SB(0, 0), b2, voffB); PG8_STAGE(PG8_SB(0, 1), b2 + hstep, voffB); PG8_STAGE(PG8_SA(0, 0), a2, voffA);
            PG8_WAIT_V(8); PG8_WAIT_L(0); PG8_BAR; PG8_MMA(1, 0, At, B0); PG8_MMA(1, 1, At, B1); PG8_BAR; PG8_SCHED;
            PG8_LDB(B0, 1, 0); PG8_LDB(B1, 1, 1); PG8_SCHED; PG8_LDA(At, 1, 0); PG8_STAGE(PG8_SA(0, 1), a2 + hstep, voffA);
            PG8_WAIT_V(8); PG8_WAIT_L(0); PG8_BAR; PG8_MMA(0, 0, At, B0); PG8_MMA(0, 1, At, B1); PG8_BAR; PG8_SCHED;
            PG8_LDA(At, 1, 1); PG8_STAGE(PG8_SB(1, 0), b3, voffB); PG8_STAGE(PG8_SB(1, 1), b3 + hstep, voffB); PG8_STAGE(PG8_SA(1, 0), a3, voffA);
            PG8_WAIT_V(8); PG8_WAIT_L(0); PG8_BAR; PG8_MMA(1, 0, At, B0); PG8_MMA(1, 1, At, B1); PG8_BAR; PG8_SCHED;
            } else {
            PG8_LDB(B0, 0, 0); PG8_SCHED; PG8_LDA(At, 0, 0); PG8_STAGE(PG8_SA(1, 1), a1 + hstep, voffA);
            PG8_WAIT_L(8); PG8_BAR; PG8_WAIT_L(0); PG8_MMA(0, 0, At, B0); PG8_BAR; PG8_SCHED;
            PG8_LDB(B1, 0, 1); PG8_STAGE(PG8_SB(0, 0), b2, voffB);
            PG8_BAR; PG8_WAIT_L(0); PG8_MMA(0, 1, At, B1); PG8_BAR;
            PG8_LDA(At, 0, 1); PG8_STAGE(PG8_SA(0, 0), a2, voffA);
            PG8_BAR; PG8_WAIT_L(0); PG8_MMA(1, 0, At, B0); PG8_BAR; PG8_SCHED;
            PG8_STAGE(PG8_SB(0, 1), b2 + hstep, voffB);
            PG8_WAIT_V(6); PG8_BAR; PG8_MMA(1, 1, At, B1); PG8_BAR;
            PG8_LDB(B0, 1, 0); PG8_SCHED; PG8_LDA(At, 1, 0); PG8_STAGE(PG8_SA(0, 1), a2 + hstep, voffA);
            PG8_WAIT_L(8); PG8_BAR; PG8_WAIT_L(0); PG8_MMA(0, 0, At, B0); PG8_BAR; PG8_SCHED;
            PG8_LDB(B1, 1, 1); PG8_STAGE(PG8_SB(1, 0), b3, voffB);
            PG8_BAR; PG8_WAIT_L(0); PG8_MMA(0, 1, At, B1); PG8_BAR;
            PG8_LDA(At, 1, 1); PG8_STAGE(PG8_SA(1, 0), a3, voffA);
            PG8_BAR; PG8_WAIT_L(0); PG8_MMA(1, 0, At, B0); PG8_BAR; PG8_SCHED;
            PG8_STAGE(PG8_SB(1, 1), b3 + hstep, voffB);
            PG8_WAIT_V(6); PG8_BAR; PG8_MMA(1, 1, At, B1); PG8_BAR;
            }
        }
        if constexpr (ALIGN_EPI) { if (wr == 0) PG8_BAR; }
        if constexpr (!Epi::AFTER_DRAIN) { E(acc, cur, wr, wc, fr, fq); S.done(cur); }
        if (!has_next) break;
#pragma unroll
        for (int a = 0; a < 2; ++a)
#pragma unroll
            for (int b = 0; b < 2; ++b)
#pragma unroll
                for (int m = 0; m < 4; ++m)
#pragma unroll
                    for (int n = 0; n < 2; ++n) acc[a][b][m][n] = (f32x4){0.f, 0.f, 0.f, 0.f};
        cur = nxt; cA = nA; cB = nB; ++ui;
        if constexpr (ALIGN_EPI) { if (wr == 1) PG8_BAR; }
    }
    PG8_WAIT_V(0);
    if constexpr (!ALIGN_EPI) { if (wr == 0) PG8_BAR; }
    PG8_BAR;
    if constexpr (Epi::AFTER_DRAIN) { E.fused(acc, cur, wr, wc, fr, fq, lds, wid, lane); S.done(cur); }
#undef PG8_SA
#undef PG8_SB
#undef PG8_STAGE
#undef PG8_LDA
#undef PG8_LDB
#undef PG8_MMA
#undef PG8_WAIT_V
#undef PG8_WAIT_L
#undef PG8_BAR
#undef PG8_SCHED
}
template <class Epi, class Sched>
__device__ __forceinline__ void gemm_phase_gather(PG8_LAS unsigned char* lds, const Gemm g, const int* idx, const Sched& S, const Epi& E, const int tz = 0  ) {
    const int tid = threadIdx.x + tz, wid = __builtin_amdgcn_readfirstlane(tid >> 6), lane = tid & 63, wr = wid >> 2, wc = wid & 3, fr = lane & 15, fq = lane >> 4;
    const int K = g.K, nt = K / BK;
    unsigned voffA[2], voffB[2];
    int rowA[2];
#pragma unroll
    for (int i = 0; i < 2; ++i) { int R, C; stage_rc(tid * 16 + i * 8192, R, C); const int Rb = Epi::PERM ? ((R & ~31) + perm32(R & 31)) : R;
        voffA[i] = (unsigned)C * 2u; rowA[i] = R; voffB[i] = (unsigned)(Rb * K + C) * 2u; }
    unsigned vA0[2], vA1[2], vN0[2], vN1[2];
#define PG8_GOFF(dst0, dst1, pm_) do { _Pragma("unroll") for (int _i = 0; _i < 2; ++_i) { dst0[_i] = (unsigned)idx[(pm_) * BM + rowA[_i]] * (unsigned)(K * 2) + voffA[_i]; dst1[_i] = (unsigned)idx[(pm_) * BM + HALF + rowA[_i]] * (unsigned)(K * 2) + voffA[_i]; } } while (0)
    const size_t kstep = (size_t)(BK * 2);
    const size_t hstep = (size_t)HALF * K * 2;
    const size_t tstep = 2 * hstep;
    const unsigned ldsw = (unsigned)wid * 1024u;
    const int aoff = lds_byte(wr * 64 + fr, fq * 8), boff = lds_byte(wc * 32 + fr, fq * 8);
#define PG8_SA(b, h) (((b) * 2 + (h)) * HTB)
#define PG8_SB(b, h) ((4 + (b) * 2 + (h)) * HTB)
#define PG8_STAGE(bufoff, gbase, voff) do { _Pragma("unroll") for (int _i = 0; _i < 2; ++_i) \
        __builtin_amdgcn_global_load_lds((const unsigned*)((const char*)(gbase) + (voff)[_i]), (PG8_LAS unsigned*)(lds + (bufoff) + ldsw + _i * 8192), 16, 0, 0); } while (0)
#define PG8_LDA(dst, b, h) do { _Pragma("unroll") for (int m = 0; m < 4; ++m) _Pragma("unroll") for (int k = 0; k < 2; ++k) dst[m][k] = *(const PG8_LAS bf16x8*)(lds + PG8_SA(b, h) + aoff + m * 2048 + k * 1024); } while (0)
#define PG8_LDB(dst, b, h) do { _Pragma("unroll") for (int n = 0; n < 2; ++n) _Pragma("unroll") for (int k = 0; k < 2; ++k) dst[n][k] = *(const PG8_LAS bf16x8*)(lds + PG8_SB(b, h) + boff + n * 2048 + k * 1024); } while (0)
#define PG8_MMA(ai, bj, At, Bt) do { __builtin_amdgcn_s_setprio(1); _Pragma("unroll") for (int m = 0; m < 4; ++m) _Pragma("unroll") for (int n = 0; n < 2; ++n) _Pragma("unroll") for (int k = 0; k < 2; ++k) \
        acc[ai][bj][m][n] = __builtin_amdgcn_mfma_f32_16x16x32_bf16(Bt[n][k], At[m][k], acc[ai][bj][m][n], 0, 0, 0); __builtin_amdgcn_s_setprio(0); } while (0)
#define PG8_WAIT_V(n) asm volatile("s_waitcnt vmcnt(" #n ")" ::: "memory")
#define PG8_WAIT_L(n) asm volatile("s_waitcnt lgkmcnt(" #n ")" ::: "memory")
#define PG8_BAR __builtin_amdgcn_s_barrier()
#define PG8_SCHED __builtin_amdgcn_sched_barrier(0)
    Unit cur, nxt; int ui = 0;
    if (!S.next(0, cur)) return;
    f32x4 acc[2][2][4][2];
#pragma unroll
    for (int a = 0; a < 2; ++a)
#pragma unroll
        for (int b = 0; b < 2; ++b)
#pragma unroll
            for (int m = 0; m < 4; ++m)
#pragma unroll
                for (int n = 0; n < 2; ++n) acc[a][b][m][n] = (f32x4){0.f, 0.f, 0.f, 0.f};
    bf16x8 At[4][2], B0[2][2], B1[2][2];
    const char* cA = (const char*)g.A; PG8_GOFF(vA0, vA1, cur.pm); const char* cB = (const char*)g.Bt + (size_t)cur.pn * tstep;
    S.a_ready(cur);
    if constexpr (true) {
        PG8_STAGE(PG8_SB(0, 0), cB, voffB); PG8_STAGE(PG8_SB(0, 1), cB + hstep, voffB); PG8_STAGE(PG8_SA(0, 0), cA, vA0); PG8_STAGE(PG8_SA(0, 1), cA, vA1);
        if (wr == 1) PG8_BAR;
        PG8_WAIT_V(2); PG8_BAR;
        PG8_STAGE(PG8_SB(1, 0), cB + kstep, voffB); PG8_STAGE(PG8_SA(1, 0), cA + kstep, vA0); PG8_STAGE(PG8_SB(1, 1), cB + hstep + kstep, voffB);
        PG8_WAIT_V(6); PG8_BAR;
    } else {
        PG8_STAGE(PG8_SB(0, 0), cB, voffB); PG8_STAGE(PG8_SA(0, 0), cA, voffA); PG8_STAGE(PG8_SB(0, 1), cB + hstep, voffB); PG8_STAGE(PG8_SA(0, 1), cA + hstep, voffA);
        if (wr == 1) PG8_BAR;
        PG8_WAIT_V(4); PG8_BAR;
        PG8_STAGE(PG8_SB(1, 0), cB + kstep, voffB); PG8_STAGE(PG8_SA(1, 0), cA + kstep, vA0); PG8_STAGE(PG8_SB(1, 1), cB + hstep + kstep, voffB);
        PG8_WAIT_V(6); PG8_BAR;
    }
    for (;;) {
        const bool has_next = S.next(ui + 1, nxt);
        const char* nA = cA; if (has_next) PG8_GOFF(vN0, vN1, nxt.pm); else { vN0[0] = vA0[0]; vN0[1] = vA0[1]; vN1[0] = vA1[0]; vN1[1] = vA1[1]; } const char* nB = has_next ? (const char*)g.Bt + (size_t)nxt.pn * tstep : cB;
        for (int t = 0; t < nt; t += 2) {
            if constexpr (Epi::HAS_MID) { if (t == (nt >> 1)) E.mid(acc, cur, wr, wc, fr, fq); }
            const bool last = (t == nt - 2);
            const char* a1 = cA + (size_t)(t + 1) * kstep;
            const char* a2 = last ? nA : cA + (size_t)(t + 2) * kstep; unsigned x0[2], x1[2]; x0[0] = last ? vN0[0] : vA0[0]; x0[1] = last ? vN0[1] : vA0[1]; x1[0] = last ? vN1[0] : vA1[0]; x1[1] = last ? vN1[1] : vA1[1]; const char* b2 = last ? nB : cB + (size_t)(t + 2) * kstep;
            const char* a3 = a2 + kstep; const char* b3 = b2 + kstep;
            if (last && has_next) S.a_ready(nxt);
            if constexpr (true) {
            PG8_LDB(B0, 0, 0); PG8_LDB(B1, 0, 1); PG8_SCHED; PG8_LDA(At, 0, 0); PG8_STAGE(PG8_SA(1, 1), a1, vA1);
            PG8_WAIT_V(8); PG8_WAIT_L(0); PG8_BAR; PG8_MMA(0, 0, At, B0); PG8_MMA(0, 1, At, B1); PG8_BAR; PG8_SCHED;
            PG8_LDA(At, 0, 1); PG8_STAGE(PG8_SB(0, 0), b2, voffB); PG8_STAGE(PG8_SB(0, 1), b2 + hstep, voffB); PG8_STAGE(PG8_SA(0, 0), a2, x0);
            PG8_WAIT_V(8); PG8_WAIT_L(0); PG8_BAR; PG8_MMA(1, 0, At, B0); PG8_MMA(1, 1, At, B1); PG8_BAR; PG8_SCHED;
            PG8_LDB(B0, 1, 0); PG8_LDB(B1, 1, 1); PG8_SCHED; PG8_LDA(At, 1, 0); PG8_STAGE(PG8_SA(0, 1), a2, x1);
            PG8_WAIT_V(8); PG8_WAIT_L(0); PG8_BAR; PG8_MMA(0, 0, At, B0); PG8_MMA(0, 1, At, B1); PG8_BAR; PG8_SCHED;
            PG8_LDA(At, 1, 1); PG8_STAGE(PG8_SB(1, 0), b3, voffB); PG8_STAGE(PG8_SB(1, 1), b3 + hstep, voffB); PG8_STAGE(PG8_SA(1, 0), a3, x0);
            PG8_WAIT_V(8); PG8_WAIT_L(0); PG8_BAR; PG8_MMA(1, 0, At, B0); PG8_MMA(1, 1, At, B1); PG8_BAR; PG8_SCHED;
            } else {
            PG8_LDB(B0, 0, 0); PG8_SCHED; PG8_LDA(At, 0, 0); PG8_STAGE(PG8_SA(1, 1), a1, vA1);
            PG8_WAIT_L(8); PG8_BAR; PG8_WAIT_L(0); PG8_MMA(0, 0, At, B0); PG8_BAR; PG8_SCHED;
            PG8_LDB(B1, 0, 1); PG8_STAGE(PG8_SB(0, 0), b2, voffB);
            PG8_BAR; PG8_WAIT_L(0); PG8_MMA(0, 1, At, B1); PG8_BAR;
            PG8_LDA(At, 0, 1); PG8_STAGE(PG8_SA(0, 0), a2, x0);
            PG8_BAR; PG8_WAIT_L(0); PG8_MMA(1, 0, At, B0); PG8_BAR; PG8_SCHED;
            PG8_STAGE(PG8_SB(0, 1), b2 + hstep, voffB);
            PG8_WAIT_V(6); PG8_BAR; PG8_MMA(1, 1, At, B1); PG8_BAR;
            PG8_LDB(B0, 1, 0); PG8_SCHED; PG8_LDA(At, 1, 0); PG8_STAGE(PG8_SA(0, 1), a2, x1);
            PG8_WAIT_L(8); PG8_BAR; PG8_WAIT_L(0); PG8_MMA(0, 0, At, B0); PG8_BAR; PG8_SCHED;
            PG8_LDB(B1, 1, 1); PG8_STAGE(PG8_SB(1, 0), b3, voffB);
            PG8_BAR; PG8_WAIT_L(0); PG8_MMA(0, 1, At, B1); PG8_BAR;
            PG8_LDA(At, 1, 1); PG8_STAGE(PG8_SA(1, 0), a3, x0);
            PG8_BAR; PG8_WAIT_L(0); PG8_MMA(1, 0, At, B0); PG8_BAR; PG8_SCHED;
            PG8_STAGE(PG8_SB(1, 1), b3 + hstep, voffB);
            PG8_WAIT_V(6); PG8_BAR; PG8_MMA(1, 1, At, B1); PG8_BAR;
            }
        }
        if constexpr (true) { if (wr == 0) PG8_BAR; }
        if constexpr (!Epi::AFTER_DRAIN) { E(acc, cur, wr, wc, fr, fq); S.done(cur); }
        if (!has_next) break;
#pragma unroll
        for (int a = 0; a < 2; ++a)
#pragma unroll
            for (int b = 0; b < 2; ++b)
#pragma unroll
                for (int m = 0; m < 4; ++m)
#pragma unroll
                    for (int n = 0; n < 2; ++n) acc[a][b][m][n] = (f32x4){0.f, 0.f, 0.f, 0.f};
        cur = nxt; cA = nA; cB = nB; ++ui; vA0[0] = vN0[0]; vA0[1] = vN0[1]; vA1[0] = vN1[0]; vA1[1] = vN1[1];
        if constexpr (true) { if (wr == 1) PG8_BAR; }
    }
    PG8_WAIT_V(0);
    if constexpr (false) { if (wr == 0) PG8_BAR; }
    PG8_BAR;
    if constexpr (Epi::AFTER_DRAIN) { E.fused(acc, cur, wr, wc, fr, fq, lds, wid, lane); S.done(cur); }
#undef PG8_SA
#undef PG8_SB
#undef PG8_GOFF
#undef PG8_STAGE
#undef PG8_LDA
#undef PG8_LDB
#undef PG8_MMA
#undef PG8_WAIT_V
#undef PG8_WAIT_L
#undef PG8_BAR
#undef PG8_SCHED
}
}

constexpr int NB = 8, SEQ = 4096, DM = 1024, T = NB * SEQ;
constexpr int RW = 512, NHR = 8;
constexpr int NPROJ = 5376;
constexpr int FF = 512, NEXP = 32;
constexpr float C2 = 0.125f * 1.4426950408889634f;
constexpr float LAM_INIT = 0.2f;
constexpr int MAXROWS = 2 * T + NEXP * 256;

constexpr size_t MiB = 1u << 20;
constexpr size_t WS_CTL = 0, CTL_ZERO_BYTES = 1 * MiB;
constexpr size_t WS_WLORA = 1 * MiB;
constexpr size_t WS_WBRD = 2 * MiB;
constexpr size_t WS_WO = 4 * MiB;
constexpr size_t WS_WR = 6 * MiB;
constexpr size_t WS_WPG = 7 * MiB;
constexpr size_t WS_WPP = 9 * MiB;
constexpr size_t WS_TOKE = 10 * MiB;
constexpr size_t WS_TOKW = 10 * MiB + 256 * 1024;
constexpr size_t WS_POS = 10 * MiB + 512 * 1024;
constexpr size_t WS_ROWW = 10 * MiB + 768 * 1024;
constexpr size_t WS_TILECNT = 11 * MiB + 256 * 1024;
constexpr size_t WS_DISP = 11 * MiB + 512 * 1024;
constexpr size_t WS_BON = 12 * MiB;
constexpr size_t WS_ROWTOK = 13 * MiB;
constexpr size_t WS_RS = 13 * MiB + 512 * 1024;
constexpr size_t WS_ROWRS = 13 * MiB + 640 * 1024;
constexpr size_t WS_SSQ = 14 * MiB;
constexpr size_t WS_WIN = 16 * MiB;
constexpr size_t WS_LOGITS = 16 * MiB;
constexpr size_t WS_XN = 32 * MiB;
constexpr size_t WS_WGU = 32 * MiB;
constexpr size_t WS_RKV = 96 * MiB;
constexpr size_t WS_MIXED = 96 * MiB;
constexpr size_t WS_WD = 96 * MiB;
constexpr size_t WS_HS = 128 * MiB;
constexpr size_t WS_H3 = 128 * MiB;
constexpr size_t WS_PROJB = 192 * MiB;
constexpr size_t WS_E = 192 * MiB;
constexpr size_t WS_A = 224 * MiB;
constexpr size_t WS_G = 256 * MiB;
constexpr size_t WS_P16 = 192 * MiB;
constexpr size_t WS_PP = 208 * MiB;
constexpr size_t WS_Y2 = 272 * MiB;
constexpr size_t WS_GATES = 304 * MiB;
constexpr size_t WS_H2X = 304 * MiB;
constexpr size_t WS_VT = 432 * MiB;
constexpr size_t WS_ACT = 432 * MiB;
constexpr size_t WS_X2 = 432 * MiB;
constexpr size_t WS_PART = 176 * MiB;
constexpr size_t WS_END = 512 * MiB;
constexpr size_t OUT_STASH = 0, OUT_ORWDF = 32 * MiB, OUT_Y = 96 * MiB  , OUT_LA = 0  ;
static_assert(WS_ACT + (size_t)MAXROWS * 512 * 2 <= WS_END && WS_Y2 + (size_t)MAXROWS * 1024 * 2 <= WS_ACT && WS_HS + (size_t)MAXROWS * 1024 * 2 <= WS_Y2, "ws map");
static_assert(WS_PART + (size_t)T * 1024 * 4 <= WS_GATES && WS_MIXED + (size_t)T * 1024 * 2 <= WS_PART, "ws map");
constexpr int CW_QUEUE = 64;
constexpr int CW_MOECNT = 512;
constexpr int CW_BAR = 4096;

constexpr int RING_BYTES = 131072;
constexpr int MISC_OFF = 158720;
constexpr int LDS_BYTES = 160768;
constexpr int NWAVES = 8, NTHR = 512;

#define GAS __attribute__((address_space(1)))
#define LAS __attribute__((address_space(3)))
typedef unsigned short bf16;
typedef unsigned v4u __attribute__((ext_vector_type(4)));
typedef unsigned v2u __attribute__((ext_vector_type(2)));
typedef float f32x4 __attribute__((ext_vector_type(4)));
typedef float f32x16 __attribute__((ext_vector_type(16)));
typedef short s16x8 __attribute__((ext_vector_type(8)));
typedef short s16x4 __attribute__((ext_vector_type(4)));
#define LDS_WAIT() asm volatile("s_waitcnt lgkmcnt(0)" ::: "memory")
#define VM_WAIT() asm volatile("s_waitcnt vmcnt(0)" ::: "memory")

__device__ __forceinline__ bf16* y_ptr(float* out, int b) { return (bf16*)((unsigned char*)out + OUT_Y) + (size_t)b * SEQ * 512; }
__device__ __forceinline__ bf16* qn_ptr(unsigned char* ws, int b) { return (bf16*)(ws + (b < 4 ? (288 + 4 * (size_t)b) * MiB : (464 + 4 * (size_t)(b - 4)) * MiB)); }
__device__ __forceinline__ bf16* kn_ptr(unsigned char* ws, int b) { return (bf16*)(ws + (480 + 4 * (size_t)b) * MiB); }
__device__ __forceinline__ unsigned f2bf(float f) { unsigned u = __builtin_bit_cast(unsigned, f); return (u + 0x7fffu + ((u >> 16) & 1u)) >> 16; }
typedef float f32x2_t __attribute__((ext_vector_type(2))); typedef __bf16 bf16x2_t __attribute__((ext_vector_type(2)));
__device__ __forceinline__ unsigned pk2(float lo, float hi) { f32x2_t v = {lo, hi}; bf16x2_t b = __builtin_convertvector(v, bf16x2_t); return __builtin_bit_cast(unsigned, b); }
__device__ __forceinline__ float bflo(unsigned w) { return __builtin_bit_cast(float, w << 16); }
__device__ __forceinline__ float bfhi(unsigned w) { return __builtin_bit_cast(float, w & 0xffff0000u); }
__device__ __forceinline__ float sigm(float x) { return __builtin_amdgcn_rcpf(1.0f + __builtin_amdgcn_exp2f(-1.4426950408889634f * x)); }
template <int CTRL> __device__ __forceinline__ float dpp_mov(float v) { return __builtin_bit_cast(float, __builtin_amdgcn_update_dpp(0, __builtin_bit_cast(int, v), CTRL, 0xF, 0xF, false)); }
__device__ __forceinline__ float red8(float v) { v += dpp_mov<0xB1>(v); v += dpp_mov<0x4E>(v); v += dpp_mov<0x141>(v); return v; }
__device__ __forceinline__ float red16(float v) { v = red8(v); v += dpp_mov<0x140>(v); return v; }
__device__ __forceinline__ void swap32(unsigned& a, unsigned& b) { asm volatile("s_nop 1\n\tv_permlane32_swap_b32 %0, %1\n\ts_nop 1" : "+v"(a), "+v"(b)); }
__device__ __forceinline__ float xhalf_max(float m) { unsigned a = __builtin_bit_cast(unsigned, m), b = a; swap32(a, b); return fmaxf(__builtin_bit_cast(float, a), __builtin_bit_cast(float, b)); }
__device__ __forceinline__ float xhalf_sum(float m) { unsigned a = __builtin_bit_cast(unsigned, m), b = a; swap32(a, b); return __builtin_bit_cast(float, a) + __builtin_bit_cast(float, b); }
__device__ __forceinline__ float wave_sum(float v) { v = red16(v); v += __shfl_xor(v, 16); return xhalf_sum(v); }

namespace pg8 {
struct EpiStore {
    static constexpr bool PERM = true, AFTER_DRAIN = false, HAS_MID = false;
    bf16_t* O; int ldc;
    __device__ __forceinline__ void operator()(const f32x4 (&acc)[2][2][4][2], const Unit& u, int wr, int wc, int fr, int fq) const {
        const int row0 = u.pm * BM + wr * 64 + fr, col0 = u.pn * BM + wc * 32 + 8 * fq;
#pragma unroll
        for (int ai = 0; ai < 2; ++ai)
#pragma unroll
            for (int m = 0; m < 4; ++m) { bf16_t* rowp = O + (size_t)(row0 + ai * HALF + m * 16) * ldc + col0;
#pragma unroll
                for (int bj = 0; bj < 2; ++bj) { const f32x4 v0 = acc[ai][bj][m][0], v1 = acc[ai][bj][m][1]; u32x4 w;
                    w.x = cvt_pk_bf16(v0[0], v0[1]); w.y = cvt_pk_bf16(v0[2], v0[3]); w.z = cvt_pk_bf16(v1[0], v1[1]); w.w = cvt_pk_bf16(v1[2], v1[3]);
                    *(u32x4*)(rowp + bj * HALF) = w; } }
    }
};
struct EpiProj {
    static constexpr bool PERM = true, AFTER_DRAIN = false, HAS_MID = false;
    bf16_t *rkv, *projb, *gates;
    __device__ __forceinline__ void operator()(const f32x4 (&acc)[2][2][4][2], const Unit& u, int wr, int wc, int fr, int fq) const {
        bf16_t* base; int ldc, ct;
        if (u.pn < 6) { base = rkv; ldc = 1536; ct = u.pn; } else if (u.pn < 11) { base = projb; ldc = 1280; ct = u.pn - 6; } else { base = gates; ldc = 2048; ct = u.pn - 13; }
        const int row0 = u.pm * BM + wr * 64 + fr, col0 = ct * BM + wc * 32 + 8 * fq;
#pragma unroll
        for (int ai = 0; ai < 2; ++ai)
#pragma unroll
            for (int m = 0; m < 4; ++m) { bf16_t* rowp = base + (size_t)(row0 + ai * HALF + m * 16) * ldc + col0;
#pragma unroll
                for (int bj = 0; bj < 2; ++bj) { f32x4 v0 = acc[ai][bj][m][0], v1 = acc[ai][bj][m][1]; u32x4 w;
                    if (u.pn >= 13) {
#pragma unroll
                        for (int e = 0; e < 4; ++e) { v0[e] = fmaxf(sigm(v0[e]), 1e-6f); v1[e] = fmaxf(sigm(v1[e]), 1e-6f); } }
                    w.x = cvt_pk_bf16(v0[0], v0[1]); w.y = cvt_pk_bf16(v0[2], v0[3]); w.z = cvt_pk_bf16(v1[0], v1[1]); w.w = cvt_pk_bf16(v1[2], v1[3]);
                    *(u32x4*)(rowp + bj * HALF) = w; } }
    }
};
struct EpiLora {
    static constexpr bool PERM = true, AFTER_DRAIN = false, HAS_MID = false;
    bf16_t *E, *A, *G; const float *w0, *a0;
    template <int KIND> __device__ __forceinline__ void body(const f32x4 (&acc)[2][2][4][2], bf16_t* base, const float* bias, int row0, int col0) const {
#pragma unroll
        for (int bj = 0; bj < 2; ++bj)
#pragma unroll
            for (int ai = 0; ai < 2; ++ai)
#pragma unroll
                for (int m = 0; m < 4; ++m) { bf16_t* rowp = base + (size_t)(row0 + ai * HALF + m * 16) * 512 + col0 + bj * HALF;
                    f32x4 v0 = acc[ai][bj][m][0], v1 = acc[ai][bj][m][1];
                    if (KIND < 2) { const f32x4 b0 = *(const f32x4*)(bias + col0 + bj * HALF), b1 = *(const f32x4*)(bias + col0 + bj * HALF + 4); const float sc = KIND == 0 ? 0.60653065971263342f : 1.0f;
                        v0 += b0; v1 += b1;
#pragma unroll
                        for (int e = 0; e < 4; ++e) { v0[e] = sc * sigm(v0[e]); v1[e] = sc * sigm(v1[e]); } }
                    u32x4 w; w.x = cvt_pk_bf16(v0[0], v0[1]); w.y = cvt_pk_bf16(v0[2], v0[3]); w.z = cvt_pk_bf16(v1[0], v1[1]); w.w = cvt_pk_bf16(v1[2], v1[3]);
                    *(u32x4*)rowp = w; asm volatile("" ::: "memory"); }
    }
    __device__ __forceinline__ void operator()(const f32x4 (&acc)[2][2][4][2], const Unit& u, int wr, int wc, int fr, int fq) const {
        const int kind = u.pn >> 1; const int row0 = u.pm * BM + wr * 64 + fr, col0 = (u.pn & 1) * BM + wc * 32 + 8 * fq;
        if (kind == 0) body<0>(acc, E, w0, row0, col0); else if (kind == 1) body<1>(acc, A, a0, row0, col0); else body<2>(acc, G, w0, row0, col0);
    }
};
struct EpiMix {
    static constexpr bool PERM = true, AFTER_DRAIN = false, HAS_MID = true;
    const bf16_t* gates; bf16_t* mixed;
    __device__ __forceinline__ void mid(f32x4 (&acc)[2][2][4][2], const Unit& u, int wr, int wc, int fr, int fq) const {
        const int row0 = u.pm * BM + wr * 64 + fr, col0 = u.pn * BM + wc * 32 + 8 * fq;
#pragma unroll
        for (int ai = 0; ai < 2; ++ai)
#pragma unroll
            for (int m = 0; m < 4; ++m) { const size_t r = (size_t)(row0 + ai * HALF + m * 16);
#pragma unroll
                for (int bj = 0; bj < 2; ++bj) { const int c = col0 + bj * HALF;
                    const u32x4 gr = *(const u32x4*)(gates + r * 2048 + c), gd = *(const u32x4*)(gates + r * 2048 + 1024 + c);
                    f32x4& v0 = acc[ai][bj][m][0]; f32x4& v1 = acc[ai][bj][m][1];
                    v0[0] *= bflo(gr.x) * __builtin_amdgcn_rcpf(bflo(gd.x)); v0[1] *= bfhi(gr.x) * __builtin_amdgcn_rcpf(bfhi(gd.x)); v0[2] *= bflo(gr.y) * __builtin_amdgcn_rcpf(bflo(gd.y)); v0[3] *= bfhi(gr.y) * __builtin_amdgcn_rcpf(bfhi(gd.y));
                    v1[0] *= bflo(gr.z) * __builtin_amdgcn_rcpf(bflo(gd.z)); v1[1] *= bfhi(gr.z) * __builtin_amdgcn_rcpf(bfhi(gd.z)); v1[2] *= bflo(gr.w) * __builtin_amdgcn_rcpf(bflo(gd.w)); v1[3] *= bfhi(gr.w) * __builtin_amdgcn_rcpf(bfhi(gd.w)); }
                asm volatile("" ::: "memory"); }
    }
    __device__ __forceinline__ void operator()(const f32x4 (&acc)[2][2][4][2], const Unit& u, int wr, int wc, int fr, int fq) const {
        const int row0 = u.pm * BM + wr * 64 + fr, col0 = u.pn * BM + wc * 32 + 8 * fq;
#pragma unroll
        for (int ai = 0; ai < 2; ++ai)
#pragma unroll
            for (int m = 0; m < 4; ++m) { const size_t r = (size_t)(row0 + ai * HALF + m * 16);
#pragma unroll
                for (int bj = 0; bj < 2; ++bj) { const int c = col0 + bj * HALF;
                    const u32x4 gd = *(const u32x4*)(gates + r * 2048 + 1024 + c);
                    f32x4 v0 = acc[ai][bj][m][0], v1 = acc[ai][bj][m][1];
                    v0[0] *= bflo(gd.x); v0[1] *= bfhi(gd.x); v0[2] *= bflo(gd.y); v0[3] *= bfhi(gd.y); v1[0] *= bflo(gd.z); v1[1] *= bfhi(gd.z); v1[2] *= bflo(gd.w); v1[3] *= bfhi(gd.w);
                    u32x4 w; w.x = cvt_pk_bf16(v0[0], v0[1]); w.y = cvt_pk_bf16(v0[2], v0[3]); w.z = cvt_pk_bf16(v1[0], v1[1]); w.w = cvt_pk_bf16(v1[2], v1[3]);
                    *(u32x4*)(mixed + r * 1024 + c) = w; } }
    }
};
struct EpiRes {
    static constexpr bool PERM = true, AFTER_DRAIN = false, HAS_MID = false;
    const float* x; bf16_t* x1; float* ssq;
    __device__ __forceinline__ void operator()(const f32x4 (&acc)[2][2][4][2], const Unit& u, int wr, int wc, int fr, int fq) const {
        const int row0 = u.pm * BM + wr * 64 + fr, col0 = u.pn * BM + wc * 32 + 8 * fq;
#pragma unroll
        for (int ai = 0; ai < 2; ++ai)
#pragma unroll
            for (int m = 0; m < 4; ++m) { const size_t off = (size_t)(row0 + ai * HALF + m * 16) * 1024 + col0; float s = 0.f;
#pragma unroll
                for (int bj = 0; bj < 2; ++bj) { const f32x4 v0 = *(const f32x4*)(x + off + bj * HALF) + acc[ai][bj][m][0], v1 = *(const f32x4*)(x + off + bj * HALF + 4) + acc[ai][bj][m][1]; u32x4 w;
                    s += ((v0[0] * v0[0] + v0[1] * v0[1]) + (v0[2] * v0[2] + v0[3] * v0[3])) + ((v1[0] * v1[0] + v1[1] * v1[1]) + (v1[2] * v1[2] + v1[3] * v1[3]));
                    w.x = cvt_pk_bf16(v0[0], v0[1]); w.y = cvt_pk_bf16(v0[2], v0[3]); w.z = cvt_pk_bf16(v1[0], v1[1]); w.w = cvt_pk_bf16(v1[2], v1[3]);
                    *(u32x4*)(x1 + off + bj * HALF) = w; }
                s += __shfl_xor(s, 16); s = xhalf_sum(s);
                if (fq == 0) ssq[(size_t)(row0 + ai * HALF + m * 16) * 16 + u.pn * 4 + wc] = s; }
    }
};
struct EpiLogits {
    static constexpr bool PERM = false, AFTER_DRAIN = false, HAS_MID = false;
    float* L;
    __device__ __forceinline__ void operator()(const f32x4 (&acc)[2][2][4][2], const Unit& u, int wr, int wc, int fr, int fq) const {
        const int row0 = u.pm * BM + wr * 64 + fr, col0 = wc * 32 + 4 * fq;
#pragma unroll
        for (int ai = 0; ai < 2; ++ai)
#pragma unroll
            for (int m = 0; m < 4; ++m) { float* rowp = L + (size_t)(row0 + ai * HALF + m * 16) * 128 + col0;
#pragma unroll
                for (int n = 0; n < 2; ++n) *(f32x4*)(rowp + n * 16) = acc[ai][0][m][n]; }
    }
};
struct EpiAct {
    static constexpr bool PERM = true, AFTER_DRAIN = false, HAS_MID = false;
    bf16_t* act; const float* rowrs;
    __device__ __forceinline__ void operator()(const f32x4 (&acc)[2][2][4][2], const Unit& u, int wr, int wc, int fr, int fq) const {
        const int row0 = u.pm * BM + wr * 64 + fr, col0 = (u.pn & 3) * HALF + wc * 32 + 8 * fq;
#pragma unroll
        for (int ai = 0; ai < 2; ++ai)
#pragma unroll
            for (int m = 0; m < 4; ++m) { const int r = row0 + ai * HALF + m * 16; bf16_t* rowp = act + (size_t)r * 512 + col0; float o[8]; const float rs = rowrs[r];
#pragma unroll
                for (int n = 0; n < 2; ++n)
#pragma unroll
                    for (int e = 0; e < 4; ++e) { const float g = acc[ai][0][m][n][e] * rs, up = acc[ai][1][m][n][e] * rs; o[n * 4 + e] = g * sigm(g) * up; }
                u32x4 w; w.x = cvt_pk_bf16(o[0], o[1]); w.y = cvt_pk_bf16(o[2], o[3]); w.z = cvt_pk_bf16(o[4], o[5]); w.w = cvt_pk_bf16(o[6], o[7]);
                asm volatile("global_store_dwordx4 %0, %1, off sc1" :: "v"(rowp), "v"(w) : "memory"); }
    }
};
struct EpiDown {
    static constexpr bool PERM = true, AFTER_DRAIN = false, HAS_MID = false;
    bf16_t* y2; const float* roww;
    __device__ __forceinline__ void operator()(const f32x4 (&acc)[2][2][4][2], const Unit& u, int wr, int wc, int fr, int fq) const {
        const int row0 = u.pm * BM + wr * 64 + fr, col0 = (u.pn & 3) * BM + wc * 32 + 8 * fq;
#pragma unroll
        for (int ai = 0; ai < 2; ++ai)
#pragma unroll
            for (int m = 0; m < 4; ++m) { const int r = row0 + ai * HALF + m * 16; const float w8 = roww[r]; bf16_t* rowp = y2 + (size_t)r * 1024 + col0;
#pragma unroll
                for (int bj = 0; bj < 2; ++bj) { const f32x4 v0 = acc[ai][bj][m][0] * w8, v1 = acc[ai][bj][m][1] * w8; u32x4 w;
                    w.x = cvt_pk_bf16(v0[0], v0[1]); w.y = cvt_pk_bf16(v0[2], v0[3]); w.z = cvt_pk_bf16(v1[0], v1[1]); w.w = cvt_pk_bf16(v1[2], v1[3]);
                    *(u32x4*)(rowp + bj * HALF) = w; } }
    }
};
struct EpiFinal {
    static constexpr bool PERM = true, AFTER_DRAIN = false, HAS_MID = false;
    const bf16_t* pp; const bf16_t* x2; float* out; const float* rs3;
    __device__ __forceinline__ void operator()(const f32x4 (&acc)[2][2][4][2], const Unit& u, int wr, int wc, int fr, int fq) const {
        const int row0 = u.pm * BM + wr * 64 + fr, col0 = u.pn * BM + wc * 32 + 8 * fq;
#pragma unroll
        for (int ai = 0; ai < 2; ++ai)
#pragma unroll
            for (int m = 0; m < 4; ++m) { const size_t r = (size_t)(row0 + ai * HALF + m * 16); const float rs = rs3[r];
#pragma unroll
                for (int bj = 0; bj < 2; ++bj) { const int c = col0 + bj * HALF;
                    const u32x4 pw = *(const u32x4*)(pp + r * 1024 + c), xw = *(const u32x4*)(x2 + r * 1024 + c); float* op = out + r * 1024 + c;
                    const f32x4 a0 = acc[ai][bj][m][0] * rs, a1 = acc[ai][bj][m][1] * rs; f32x4 x0, x1;
                    x0[0] = bflo(xw.x) + sigm(a0[0]) * bflo(pw.x); x0[1] = bfhi(xw.x) + sigm(a0[1]) * bfhi(pw.x); x0[2] = bflo(xw.y) + sigm(a0[2]) * bflo(pw.y); x0[3] = bfhi(xw.y) + sigm(a0[3]) * bfhi(pw.y);
                    x1[0] = bflo(xw.z) + sigm(a1[0]) * bflo(pw.z); x1[1] = bfhi(xw.z) + sigm(a1[1]) * bfhi(pw.z); x1[2] = bflo(xw.w) + sigm(a1[2]) * bflo(pw.w); x1[3] = bfhi(xw.w) + sigm(a1[3]) * bfhi(pw.w);
                    *(f32x4*)op = x0; *(f32x4*)(op + 4) = x1; asm volatile("" ::: "memory"); } }
    }
};
struct EpiGates {
    static constexpr bool PERM = true, AFTER_DRAIN = false, HAS_MID = false;
    bf16_t* gates;
    __device__ __forceinline__ void operator()(const f32x4 (&acc)[2][2][4][2], const Unit& u, int wr, int wc, int fr, int fq) const {
        const int row0 = u.pm * BM + wr * 64 + fr, col0 = u.pn * BM + wc * 32 + 8 * fq;
#pragma unroll
        for (int ai = 0; ai < 2; ++ai)
#pragma unroll
            for (int m = 0; m < 4; ++m) { bf16_t* rowp = gates + (size_t)(row0 + ai * HALF + m * 16) * 2048 + col0;
#pragma unroll
                for (int bj = 0; bj < 2; ++bj) { f32x4 v0 = acc[ai][bj][m][0], v1 = acc[ai][bj][m][1]; u32x4 w;
#pragma unroll
                    for (int e = 0; e < 4; ++e) { v0[e] = fmaxf(sigm(v0[e]), 1e-6f); v1[e] = fmaxf(sigm(v1[e]), 1e-6f); }
                    w.x = cvt_pk_bf16(v0[0], v0[1]); w.y = cvt_pk_bf16(v0[2], v0[3]); w.z = cvt_pk_bf16(v1[0], v1[1]); w.w = cvt_pk_bf16(v1[2], v1[3]);
                    *(u32x4*)(rowp + bj * HALF) = w; } }
    }
};
struct OrderItem {
    int pm, pn0, n;
    __device__ __forceinline__ bool next(int i, Unit& u) const { if (i >= n) return false; u.pm = pm; u.pn = pn0 + i; return true; }
    __device__ __forceinline__ void a_ready(const Unit&) const {}
    __device__ __forceinline__ void done(const Unit&) const {}
};
struct OrderSkipV : StaticOrder {
    __device__ __forceinline__ bool next(int i, Unit& u) const { if (!StaticOrder::next(i, u)) return false; if (u.pn >= 11) u.pn += 2; return true; }
};
struct OrderPair : StaticOrder {
    __device__ __forceinline__ bool next(int i, Unit& u) const { if (!StaticOrder::next(i >> 1, u)) return false; if (i & 1) { u.pm += 128; u.pn += 4; } return true; }
};
struct OrderMoe {
    int nwg, G, c; const PG8_LAS int* tile_e;
    __device__ __forceinline__ bool next(int i, Unit& u) const { const long L = (long)i * G + c; if (L >= nwg) return false; const int rt = (int)(L >> 2); u.pm = rt; u.pn = tile_e[rt] * 4 + (int)(L & 3); return true; }
    __device__ __forceinline__ void a_ready(const Unit&) const {}
    __device__ __forceinline__ void done(const Unit&) const {}
};
struct OrderMoeUp : OrderMoe {
    unsigned* cnt;
    __device__ __forceinline__ void done(const Unit& u) const { asm volatile("s_waitcnt vmcnt(0)" ::: "memory");
        if ((threadIdx.x & 63) == 0) __hip_atomic_fetch_add(cnt + u.pm, 1u, __ATOMIC_RELAXED, __HIP_MEMORY_SCOPE_AGENT); }
};
struct OrderMoeDown : OrderMoe {
    unsigned* cnt;
    __device__ __forceinline__ void a_ready(const Unit& u) const { while (__hip_atomic_load(cnt + u.pm, __ATOMIC_RELAXED, __HIP_MEMORY_SCOPE_AGENT) < 32u) __builtin_amdgcn_s_sleep(2); }
};
}

struct Args { const float* in[36]; float* out; unsigned char* ws; int ph_lo, ph_hi; };

template <bool KG = false> __device__ __forceinline__ void tr_item(const float* W, int N, bf16* WT, int ld, int k0, int n0, size_t dst_row0, int k_off, LAS float* scr, int lane, const float* kg = nullptr) {
#pragma unroll 8
    for (int i = 0; i < 32; ++i) { const int kk = 2 * i + (lane >> 5); float w = W[(size_t)(k0 + kk) * N + n0 + (lane & 31)]; if (KG) w *= kg[k0 + kk]; scr[kk * 33 + (lane & 31)] = w; }
    LDS_WAIT(); asm volatile("" ::: "memory");
    const int c = lane & 7;
#pragma unroll
    for (int j = 0; j < 4; ++j) { const int n = (lane >> 3) + 8 * j; const LAS float* s = scr + (8 * c) * 33 + n;
        v4u o; o.x = pk2(s[0 * 33], s[1 * 33]); o.y = pk2(s[2 * 33], s[3 * 33]); o.z = pk2(s[4 * 33], s[5 * 33]); o.w = pk2(s[6 * 33], s[7 * 33]);
        *(v4u*)(WT + (dst_row0 + n) * ld + k_off + k0 + 8 * c) = o; }
    LDS_WAIT(); asm volatile("" ::: "memory");
}
template <bool KG = false> __device__ __forceinline__ void tr_matrix(const float* W, int K, int N, bf16* WT, int ld, size_t dst_row0, int k_off, LAS float* scr, int lane, int gw, int NGW, const float* kg = nullptr) {
    const int nblk = N / 32, nitems = (K / 64) * nblk;
    for (int it = gw; it < nitems; it += NGW) { const int kb = it / nblk, nb = it % nblk; tr_item<KG>(W, N, WT, ld, 64 * kb, 32 * nb, dst_row0 + 32 * nb, k_off, scr, lane, kg); }
}
__device__ __forceinline__ void rms_row_to_bf16(const float* xrow, const float* gain, bf16* orow, int lane) {
    const f32x4* xr = (const f32x4*)xrow + lane; f32x4 v[4]; float s = 0.f;
#pragma unroll
    for (int j = 0; j < 4; ++j) { v[j] = xr[64 * j]; s += (v[j].x * v[j].x + v[j].y * v[j].y) + (v[j].z * v[j].z + v[j].w * v[j].w); }
    const float rstd = 1.0f / sqrtf(wave_sum(s) * (1.f / 1024.f) + 1e-6f);
    v2u* o8 = (v2u*)orow + lane;
#pragma unroll
    for (int j = 0; j < 4; ++j) { const f32x4 g = ((const f32x4*)gain)[lane + 64 * j]; v2u o; o.x = pk2(v[j].x * rstd * g.x, v[j].y * rstd * g.y); o.y = pk2(v[j].z * rstd * g.z, v[j].w * rstd * g.w); o8[64 * j] = o; }
}

__device__ __forceinline__ void phase0(const Args& a, LAS unsigned char* lds, int tid, int lane, int wave, int vcu, int G) {
    unsigned char* ws = a.ws;
    LAS float* scr = (LAS float*)(lds + wave * 16384);
    const int gw = vcu * NWAVES + wave, NGW = G * NWAVES; const int gt = vcu * NTHR + tid, NGT = G * NTHR;
    tr_matrix(a.in[3], 1024, NPROJ, (bf16*)(ws + WS_WIN), 1024, 0, 0, scr, lane, gw, NGW);
    tr_matrix(a.in[6], 64, 512, (bf16*)(ws + WS_WLORA), 256, 0, 0, scr, lane, gw, NGW);
    tr_matrix(a.in[8], 64, 512, (bf16*)(ws + WS_WLORA), 256, 512, 64, scr, lane, gw, NGW);
    tr_matrix(a.in[9], 128, 512, (bf16*)(ws + WS_WLORA), 256, 1024, 128, scr, lane, gw, NGW);
    tr_matrix(a.in[22], 512, 1024, (bf16*)(ws + WS_WBRD), 1024, 0, 0, scr, lane, gw, NGW);
    tr_matrix(a.in[23], 512, 1024, (bf16*)(ws + WS_WBRD), 1024, 0, 512, scr, lane, gw, NGW);
    tr_matrix(a.in[24], 1024, 1024, (bf16*)(ws + WS_WO), 1024, 0, 0, scr, lane, gw, NGW);
    tr_matrix<true>(a.in[34], 1024, 1024, (bf16*)(ws + WS_WPG), 1024, 0, 0, scr, lane, gw, NGW, a.in[33]);
    tr_matrix(a.in[35], 256, 1024, (bf16*)(ws + WS_WPP), 256, 0, 0, scr, lane, gw, NGW);
    { v4u* wl = (v4u*)(ws + WS_WLORA); const v4u z = (v4u){0u, 0u, 0u, 0u};
      for (int i = gt; i < 1536 * 32; i += NGT) { const int row = i >> 5, kc = (i & 31) * 8; const int blk = row >> 9;
          const bool diag = blk == 0 ? (kc < 64) : (blk == 1 ? (kc >= 64 && kc < 128) : (kc >= 128)); if (!diag) wl[i] = z; } }
    { bf16* wr = (bf16*)(ws + WS_WR); const float* wg = a.in[26]; const float* we = a.in[28];
      for (int i = gt; i < 256 * 1024; i += NGT) { const int row = i >> 10, kk = i & 1023; unsigned short v = 0;
          if (row < 36) v = (unsigned short)f2bf((row < 32 ? we[kk * 32 + row] : wg[kk * 4 + (row - 32)]) * a.in[25][kk]);
          wr[(size_t)row * 1024 + kk] = v; } }
    for (int m = gw; m < T; m += NGW) rms_row_to_bf16(a.in[0] + (size_t)m * DM, a.in[2], (bf16*)(ws + WS_XN) + (size_t)m * DM, lane);
}

__device__ __forceinline__ void phase2(const Args& a, LAS unsigned char* lds, int tid, int vcu, int G) {
    unsigned char* ws = a.ws;
    const bf16* projb = (const bf16*)(ws + WS_PROJB); const float* mu = a.in[4];
    bf16* la = (bf16*)((unsigned char*)a.out + OUT_LA);
    LAS float* cs = (LAS float*)lds;
    for (int tile = vcu; tile < T / 64; tile += G) {
        const int t0 = tile * 64;
        __syncthreads();
#pragma unroll
        for (int i = 0; i < 4; ++i) { const int idx = tid + 512 * i, tok = idx >> 5, i32 = idx & 31; const int s = (t0 + tok) & (SEQ - 1);
            const float inv = exp2f(-(float)i32 * (13.287712379549449f / 32.0f)); const float ang = (float)s * inv;
            const float rev = ang * 0.15915494309189535f, fr = rev - floorf(rev);
            cs[(tok * 32 + i32) * 2] = __builtin_amdgcn_cosf(fr); cs[(tok * 32 + i32) * 2 + 1] = __builtin_amdgcn_sinf(fr); }
#pragma unroll
        for (int i = 0; i < 4; ++i) { const int idx = tid + 512 * i, tok = idx >> 5, ch = idx & 31, t = t0 + tok, j0 = ch * 8; const bool first = (t & (SEQ - 1)) == 0;
            const v4u cur = *(const v4u*)(projb + (size_t)t * 1280 + j0); v4u prv = (v4u){0u, 0u, 0u, 0u}; if (!first) prv = *(const v4u*)(projb + (size_t)(t - 1) * 1280 + j0);
            const f32x4 m0 = *(const f32x4*)(mu + 1536 + j0), m1 = *(const f32x4*)(mu + 1536 + j0 + 4);
            float x[8]; const unsigned cw[4] = {cur.x, cur.y, cur.z, cur.w}, pw[4] = {prv.x, prv.y, prv.z, prv.w}; const float mm[8] = {m0.x, m0.y, m0.z, m0.w, m1.x, m1.y, m1.z, m1.w};
#pragma unroll
            for (int e = 0; e < 4; ++e) { const float c0 = bflo(cw[e]), c1 = bfhi(cw[e]), p0 = bflo(pw[e]), p1 = bfhi(pw[e]); x[2 * e] = c0 + (p0 - c0) * mm[2 * e]; x[2 * e + 1] = c1 + (p1 - c1) * mm[2 * e + 1]; }
            if (ch < 8) {
#pragma unroll
                for (int e = 0; e < 8; ++e) x[e] = tanhf(x[e]);
            } else if (ch >= 16) {
#pragma unroll
                for (int e = 0; e < 8; ++e) x[e] = sigm(x[e]);
            }
            v4u o; o.x = pk2(x[0], x[1]); o.y = pk2(x[2], x[3]); o.z = pk2(x[4], x[5]); o.w = pk2(x[6], x[7]);
            *(v4u*)(la + (size_t)t * 256 + j0) = o; }
        __syncthreads();
        for (int i = 0; i < 16; ++i) { const int idx = tid + 512 * i, tok = idx >> 7, grp = (idx >> 3) & 15, l8 = idx & 7, t = t0 + tok;
            const bf16* src = projb + (size_t)t * 1280 + 256 + grp * 64 + l8 * 4;
            const v2u wl = *(const v2u*)src, wh = *(const v2u*)(src + 32);
            float xl[4] = {bflo(wl.x), bfhi(wl.x), bflo(wl.y), bfhi(wl.y)}, xh[4] = {bflo(wh.x), bfhi(wh.x), bflo(wh.y), bfhi(wh.y)};
            float ss = 0.f;
#pragma unroll
            for (int e = 0; e < 4; ++e) ss += xl[e] * xl[e] + xh[e] * xh[e];
            ss = red8(ss);
            const float rs = (1.0f / sqrtf(ss * (1.f / 64.f) + 1e-6f)) * (grp < 8 ? C2 : 1.f);
            const float* gn = (grp < 8 ? a.in[15] : a.in[16]) + l8 * 4;
            const f32x4 gl = *(const f32x4*)gn, gh = *(const f32x4*)(gn + 32);
            float ol[4], oh[4];
#pragma unroll
            for (int e = 0; e < 4; ++e) { const float yl = xl[e] * rs * gl[e], yh = xh[e] * rs * gh[e]; const int ci = (tok * 32 + l8 * 4 + e) * 2; const float c = cs[ci], sn = cs[ci + 1];
                ol[e] = yl * c - yh * sn; oh[e] = yh * c + yl * sn; }
            const int b = t >> 12, s = t & (SEQ - 1); bf16* dst = (grp < 8 ? qn_ptr(ws, b) : kn_ptr(ws, b)) + ((size_t)(grp & 7) * SEQ + s) * 64 + l8 * 4;
            *(v2u*)dst = (v2u){pk2(ol[0], ol[1]), pk2(ol[2], ol[3])}; *(v2u*)(dst + 32) = (v2u){pk2(oh[0], oh[1]), pk2(oh[2], oh[3])}; }
    }
}

constexpr int SC_NB = 32, SC_REC = 392;
constexpr int SC_BUF = SC_NB * SC_REC * 4;
constexpr int SC_YOFF = 2 * SC_BUF;
struct ScanIn { v2u r0, k0, v0, r1, k1, v1, e, av; };
__device__ __forceinline__ void scan_unit(const Args& a, LAS unsigned char* lds, int tid, int unit) {
    unsigned char* ws = a.ws;
    const int bh = unit >> 1, half = unit & 1, b = bh >> 3, hd = bh & 7;
    const bf16* rkv = (const bf16*)(ws + WS_RKV); const bf16* E = (const bf16*)(ws + WS_E); const bf16* Aa = (const bf16*)(ws + WS_A);
    float* bon = (float*)(ws + WS_BON); bf16* Y = y_ptr(a.out, b);
    const int st = tid >> 4, c4 = tid & 15, ch = hd * 64 + c4 * 4;
    const f32x4 mur = *(const f32x4*)(a.in[4] + ch), muk = *(const f32x4*)(a.in[4] + 512 + ch), muv = *(const f32x4*)(a.in[4] + 1024 + ch);
    const f32x4 kkw = *(const f32x4*)(a.in[10] + ch), kaw = *(const f32x4*)(a.in[11] + ch), rkw = *(const f32x4*)(a.in[12] + ch);
    f32x4 sA = (f32x4){0.f, 0.f, 0.f, 0.f};
    const size_t tb = (size_t)b * SEQ;
    auto load_batch = [&](int s0, ScanIn& L) {
        const size_t t = tb + s0 + st; const bool first = (s0 + st) == 0;
        L.r0 = *(const v2u*)(rkv + t * 1536 + ch); L.k0 = *(const v2u*)(rkv + t * 1536 + 512 + ch); L.v0 = *(const v2u*)(rkv + t * 1536 + 1024 + ch);
        const size_t tp = first ? t : t - 1;
        L.r1 = *(const v2u*)(rkv + tp * 1536 + ch); L.k1 = *(const v2u*)(rkv + tp * 1536 + 512 + ch); L.v1 = *(const v2u*)(rkv + tp * 1536 + 1024 + ch);
        if (first) { L.r1 = (v2u){0u, 0u}; L.k1 = L.r1; L.v1 = L.r1; }
        L.e = *(const v2u*)(E + t * 512 + ch); L.av = *(const v2u*)(Aa + t * 512 + ch);
    };
    auto convert = [&](const ScanIn& L, int buf, int s0) {
        const unsigned r0w[2] = {L.r0.x, L.r0.y}, r1w[2] = {L.r1.x, L.r1.y}, k0w[2] = {L.k0.x, L.k0.y}, k1w[2] = {L.k1.x, L.k1.y}, v0w[2] = {L.v0.x, L.v0.y}, v1w[2] = {L.v1.x, L.v1.y};
        const unsigned ew[2] = {L.e.x, L.e.y}, aw[2] = {L.av.x, L.av.y};
        float r[4], k[4], v[4], e[4], av[4], kk[4];
#pragma unroll
        for (int i = 0; i < 4; ++i) { const int w = i >> 1; const bool hi = i & 1;
            const float rc = hi ? bfhi(r0w[w]) : bflo(r0w[w]), rp = hi ? bfhi(r1w[w]) : bflo(r1w[w]);
            const float kc = hi ? bfhi(k0w[w]) : bflo(k0w[w]), kp = hi ? bfhi(k1w[w]) : bflo(k1w[w]);
            const float vc = hi ? bfhi(v0w[w]) : bflo(v0w[w]), vp = hi ? bfhi(v1w[w]) : bflo(v1w[w]);
            r[i] = rc + (rp - rc) * mur[i]; k[i] = kc + (kp - kc) * muk[i]; v[i] = vc + (vp - vc) * muv[i];
            e[i] = hi ? bfhi(ew[w]) : bflo(ew[w]); av[i] = hi ? bfhi(aw[w]) : bflo(aw[w]);
            kk[i] = k[i] * kkw[i]; }
        const float ss = red16(kk[0] * kk[0] + kk[1] * kk[1] + kk[2] * kk[2] + kk[3] * kk[3]);
        const float inv = 1.0f / fmaxf(sqrtf(ss), 1e-12f);
        f32x4 w4, aa4, bb4, km4, wr4, vv4; float br = 0.f, kr = 0.f, bo = 0.f;
#pragma unroll
        for (int i = 0; i < 4; ++i) { const float kki = kk[i] * inv; const float km = k[i] * (1.0f + (av[i] - 1.0f) * kaw[i]); const float w = __expf(-e[i]);
            w4[i] = w; aa4[i] = -kki; bb4[i] = kki * av[i]; km4[i] = km; wr4[i] = w * r[i]; vv4[i] = v[i];
            br += bb4[i] * r[i]; kr += km * r[i]; bo += r[i] * km * rkw[i]; }
        br = red16(br); kr = red16(kr); bo = red16(bo);
        LAS float* rec = (LAS float*)(lds + buf * SC_BUF) + st * SC_REC + c4 * 4;
        *(LAS f32x4*)(rec) = w4; *(LAS f32x4*)(rec + 64) = aa4; *(LAS f32x4*)(rec + 128) = bb4; *(LAS f32x4*)(rec + 192) = km4; *(LAS f32x4*)(rec + 256) = wr4; *(LAS f32x4*)(rec + 320) = vv4;
        if (c4 == 0) { rec[384] = br; rec[385] = kr; if (half == 0) bon[(tb + s0 + st) * 8 + hd] = bo; }
    };
    auto write_out = [&](int bi) {
        typedef float f32x2 __attribute__((ext_vector_type(2)));
        const LAS float* yp = (const LAS float*)(lds + SC_YOFF) + (bi & 1) * (SC_NB * 32) + st * 32 + c4 * 2;
        const f32x2 yv = *(const LAS f32x2*)yp; *(unsigned*)(Y + (size_t)(bi * SC_NB + st) * 512 + hd * 64 + 32 * half + 2 * c4) = pk2(yv[0], yv[1]); };
    constexpr int NBATCH = SEQ / SC_NB;
    ScanIn L; load_batch(0, L);
    __syncthreads();
    convert(L, 0, 0);
    load_batch(SC_NB, L);
    __syncthreads();
    for (int bi = 0; bi < NBATCH; ++bi) {
        const int cur = bi & 1;
        if (bi + 1 < NBATCH) convert(L, cur ^ 1, (bi + 1) * SC_NB);
        if (bi + 2 < NBATCH) load_batch((bi + 2) * SC_NB, L);
        if (bi > 0) write_out(bi - 1);
        LAS float* ybuf = (LAS float*)(lds + SC_YOFF) + cur * (SC_NB * 32);
        const LAS float* base = (const LAS float*)(lds + cur * SC_BUF) + c4 * 4;
        const LAS float* vbase = (const LAS float*)(lds + cur * SC_BUF) + 320 + 32 * half + st;
        const LAS float* sbase = (const LAS float*)(lds + cur * SC_BUF) + 384;
        f32x4 nw = *(const LAS f32x4*)(base), na = *(const LAS f32x4*)(base + 64), nb = *(const LAS f32x4*)(base + 128), nk = *(const LAS f32x4*)(base + 192), nq = *(const LAS f32x4*)(base + 256);
        float nvA = vbase[0]; typedef float f32x2 __attribute__((ext_vector_type(2))); f32x2 ns = *(const LAS f32x2*)(sbase);
        float ykA = 0.f;
#pragma unroll
        for (int i = 0; i < SC_NB; ++i) {
            const f32x4 w4 = nw, a4 = na, b4 = nb, k4 = nk, q4 = nq; const float vA = nvA, br = ns[0], kr = ns[1];
            if (i + 1 < SC_NB) { const LAS float* rec = base + (i + 1) * SC_REC;
                nw = *(const LAS f32x4*)(rec); na = *(const LAS f32x4*)(rec + 64); nb = *(const LAS f32x4*)(rec + 128); nk = *(const LAS f32x4*)(rec + 192); nq = *(const LAS f32x4*)(rec + 256);
                nvA = vbase[(i + 1) * SC_REC]; ns = *(const LAS f32x2*)(sbase + (i + 1) * SC_REC); }
            float saA = fmaf(sA[0], a4[0], fmaf(sA[1], a4[1], fmaf(sA[2], a4[2], sA[3] * a4[3])));
            float zA = fmaf(sA[0], q4[0], fmaf(sA[1], q4[1], fmaf(sA[2], q4[2], sA[3] * q4[3])));
            saA = red16(saA); zA = red16(zA);
            const float yA = zA + saA * br + vA * kr;
            ykA = (c4 == (i & 15)) ? yA : ykA;
            sA = sA * w4 + saA * b4 + vA * k4;
            if ((i & 15) == 15) ybuf[(i - 15 + c4) * 32 + st] = ykA;
        }
        __syncthreads();
    }
    write_out(NBATCH - 1);
}
namespace wkv {
constexpr int P = 144, PF = 272, U = 64 * P  , F = 64 * PF  ;
constexpr int O_S = 0, O_B = F;
constexpr int O_AT = O_B + 0 * U, O_BTL = O_B + 1 * U, O_KTL = O_B + 2 * U, O_RT = O_B + 3 * U, O_BHT = O_B + 4 * U, O_KHT = O_B + 5 * U, O_VRT = O_B + 6 * U, O_RHST = O_B + 7 * U  , O_MABH = O_B + 9 * U, O_MRB = O_B + 10 * U, O_MRK = O_B + 11 * U, O_Z2 = O_B + 12 * U;
constexpr int O_XT = O_AT  , O_G1 = O_MABH, O_Z1 = O_KTL, O_G2 = O_RHST  , O_EP = O_Z2  ;
constexpr int O_END = O_B + 13 * U;
constexpr int PO = 80, O_OUTB = O_END  , O_TII = O_OUTB + 8 * 16 * PO  , O_DIAG = O_TII + 4 * 16 * PO  , O_GC = O_DIAG + 4096  , O_CONST = O_GC + 256  , O_TOP = O_CONST + 1536;
static_assert(O_TOP <= 158720, "wkv LDS map");
typedef short bf16x8 __attribute__((ext_vector_type(8)));
__device__ __forceinline__ f32x4 mfma16(bf16x8 a, bf16x8 b, f32x4 c) { return __builtin_amdgcn_mfma_f32_16x16x32_bf16(a, b, c, 0, 0, 0); }
template <int K> __device__ __forceinline__ f32x4 mm_blk(LAS unsigned char* lds, int aoff, int pa, int boff, int pb, int m0, int n0, int lane, f32x4 acc) {
    const int r = lane & 15, kg = lane >> 4;
#pragma unroll
    for (int ks = 0; ks < K / 32; ++ks) { const bf16x8 a = *(const LAS bf16x8*)(lds + aoff + (m0 + r) * pa + (32 * ks + 8 * kg) * 2); const bf16x8 b = *(const LAS bf16x8*)(lds + boff + (n0 + r) * pb + (32 * ks + 8 * kg) * 2); acc = mfma16(a, b, acc); }
    return acc;
}
__device__ __forceinline__ void split8(const LAS float* p, bf16x8& hi, bf16x8& lo) {
    const f32x4 x0 = *(const LAS f32x4*)p, x1 = *(const LAS f32x4*)(p + 4); const float x[8] = {x0[0], x0[1], x0[2], x0[3], x1[0], x1[1], x1[2], x1[3]}; unsigned h[8], l[8];
#pragma unroll
    for (int i = 0; i < 8; ++i) { h[i] = f2bf(x[i]); l[i] = f2bf(x[i] - __builtin_bit_cast(float, h[i] << 16)); }
    hi = (bf16x8){(short)h[0], (short)h[1], (short)h[2], (short)h[3], (short)h[4], (short)h[5], (short)h[6], (short)h[7]}; lo = (bf16x8){(short)l[0], (short)l[1], (short)l[2], (short)l[3], (short)l[4], (short)l[5], (short)l[6], (short)l[7]};
}
__device__ __forceinline__ void st_bf(LAS unsigned char* lds, int off, float v) { *(LAS unsigned short*)(lds + off) = (unsigned short)f2bf(v); }
__device__ __forceinline__ float ld_bf(const LAS unsigned char* lds, int off) { return __builtin_bit_cast(float, (unsigned)*(const LAS unsigned short*)(lds + off) << 16); }
struct Raw { v4u r0, k0, v0, r1, k1, v1, e, av; };
}
__device__ __forceinline__ void st4_bf(LAS unsigned char* lds, int off, f32x4 v) { *(LAS v2u*)(lds + off) = (v2u){pk2(v[0], v[1]), pk2(v[2], v[3])}; }
__device__ __forceinline__ f32x4 ld4_bf(const LAS unsigned char* lds, int off) { const v2u w = *(const LAS v2u*)(lds + off); return (f32x4){bflo(w.x), bfhi(w.x), bflo(w.y), bfhi(w.y)}; }
__device__ __forceinline__ wkv::bf16x8 ident_frag(int n, int ks, int kg) { wkv::bf16x8 f; const int k0 = 32 * ks + 8 * kg;
#pragma unroll
    for (int j = 0; j < 8; ++j) f[j] = (k0 + j == n) ? (short)0x3F80 : (short)0; return f; }
__device__ __forceinline__ void scan_unit_chunked(const Args& a, LAS unsigned char* lds, int tid, int bh) {
    using namespace wkv;
    unsigned char* ws = a.ws;
    const int b = bh >> 3, hd = bh & 7, wave = __builtin_amdgcn_readfirstlane(tid >> 6);
    const bf16* rkv = (const bf16*)(ws + WS_RKV); const bf16* E = (const bf16*)(ws + WS_E); const bf16* Aa = (const bf16*)(ws + WS_A);
    float* bon = (float*)(ws + WS_BON); bf16* Y = y_ptr(a.out, b);
    const size_t tb = (size_t)b * SEQ;
    int oz = 0;
#define WKV_TAINT() asm volatile("" : "+v"(oz))
    const int gch = hd * 64 + (tid & 7) * 8;
    if (tid < 384) { const int vsel = tid >> 6, cc = tid & 63; const float* src = vsel == 0 ? a.in[4] : vsel == 1 ? a.in[4] + 512 : vsel == 2 ? a.in[4] + 1024 : vsel == 3 ? a.in[10] : vsel == 4 ? a.in[11] : a.in[12];
        ((LAS float*)(lds + O_CONST))[vsel * 64 + cc] = src[hd * 64 + cc]; }
    auto load_raw = [&](int c, Raw& L) { const int tt = tid >> 3; const size_t t = tb + c * 64 + tt; const bool first = (c * 64 + tt) == 0; const size_t tp = first ? t : t - 1;
        L.r0 = *(const v4u*)(rkv + t * 1536 + gch); L.k0 = *(const v4u*)(rkv + t * 1536 + 512 + gch); L.v0 = *(const v4u*)(rkv + t * 1536 + 1024 + gch);
        L.r1 = *(const v4u*)(rkv + tp * 1536 + gch); L.k1 = *(const v4u*)(rkv + tp * 1536 + 512 + gch); L.v1 = *(const v4u*)(rkv + tp * 1536 + 1024 + gch);
        L.e = *(const v4u*)(E + t * 512 + gch); L.av = *(const v4u*)(Aa + t * 512 + gch); };
    const int mb = wave >> 1, nb0 = (wave & 1) * 2;
    WKV_TAINT();
#pragma unroll 1
    for (int i = tid + oz; i < 64 * 64; i += NTHR) *(LAS float*)(lds + O_S + (i >> 6) * PF + (i & 63) * 4) = 0.f;
#if defined(PROBE_PHASE) && PROBE_PHASE >= 300 && PROBE_PHASE < 320
    unsigned long long tlast = __builtin_amdgcn_s_memrealtime(); unsigned tacc[12] = {0u, 0u, 0u, 0u, 0u, 0u, 0u, 0u, 0u, 0u, 0u, 0u};
#define WKV_STAMP(k) do { const unsigned long long tn = __builtin_amdgcn_s_memrealtime(); tacc[k] += (unsigned)(tn - tlast); tlast = tn; } while (0)
#else
#define WKV_STAMP(k) do { } while (0)
#endif
    Raw L; load_raw(0, L);
    v2u ypk[2] = {(v2u){0u, 0u}, (v2u){0u, 0u}};
    auto store_y = [&](int c) { const int lane = (tid & 63) + oz, c16 = lane & 15, rg = lane >> 4;
#pragma unroll
        for (int j = 0; j < 2; ++j) { const int t = 16 * (nb0 + j) + c16, v0 = 16 * mb + 4 * rg; *(v2u*)(Y + (size_t)(c * 64 + t) * 512 + hd * 64 + v0) = ypk[j]; } };
    for (int c = 0; c < SEQ / 64; ++c) {
        __syncthreads();
        WKV_STAMP(10);
        WKV_TAINT(); const int td0 = tid + oz, tt = td0 >> 3, kq = td0 & 7, ch0 = kq * 8;
        float e8[8], lr8[8], r8[8], k8[8], v8[8];
        { const unsigned ew[4] = {L.e.x, L.e.y, L.e.z, L.e.w}, aw[4] = {L.av.x, L.av.y, L.av.z, L.av.w};
          const unsigned r0[4] = {L.r0.x, L.r0.y, L.r0.z, L.r0.w}, r1[4] = {L.r1.x, L.r1.y, L.r1.z, L.r1.w}, k0[4] = {L.k0.x, L.k0.y, L.k0.z, L.k0.w}, k1[4] = {L.k1.x, L.k1.y, L.k1.z, L.k1.w}, v0[4] = {L.v0.x, L.v0.y, L.v0.z, L.v0.w}, v1[4] = {L.v1.x, L.v1.y, L.v1.z, L.v1.w};
#pragma unroll
          for (int i = 0; i < 8; ++i) { const int w = i >> 1; const bool hi = i & 1;
              e8[i] = hi ? bfhi(ew[w]) : bflo(ew[w]); lr8[i] = hi ? bfhi(aw[w]) : bflo(aw[w]);
              const float rc = hi ? bfhi(r0[w]) : bflo(r0[w]), kc = hi ? bfhi(k0[w]) : bflo(k0[w]), vc = hi ? bfhi(v0[w]) : bflo(v0[w]);
              float rp = hi ? bfhi(r1[w]) : bflo(r1[w]), kp = hi ? bfhi(k1[w]) : bflo(k1[w]), vp = hi ? bfhi(v1[w]) : bflo(v1[w]);
              if (c == 0 && tt == 0) { rp = 0.f; kp = 0.f; vp = 0.f; }
              const LAS float* cst = (const LAS float*)(lds + O_CONST) + ch0 + i;
              r8[i] = rc + (rp - rc) * cst[0]; k8[i] = kc + (kp - kc) * cst[64]; v8[i] = vc + (vp - vc) * cst[128]; } }
        if (c > 0) store_y(c - 1);
        if (c + 1 < SEQ / 64) load_raw(c + 1, L);
        { LAS float* ep = (LAS float*)(lds + O_EP) + tt * 68 + ch0; *(LAS f32x4*)ep = (f32x4){e8[0], e8[1], e8[2], e8[3]}; *(LAS f32x4*)(ep + 4) = (f32x4){e8[4], e8[5], e8[6], e8[7]}; }
        __syncthreads(); WKV_STAMP(6);
        { const int k = td0 & 63, seg = td0 >> 6; LAS float* col = (LAS float*)(lds + O_EP) + (seg * 8) * 68 + k; float pre[8], run = 0.f;
#pragma unroll
          for (int i = 0; i < 8; ++i) { run += col[i * 68]; pre[i] = run; }
          LAS float* tots = (LAS float*)(lds + O_EP) + 64 * 68;
          tots[seg * 64 + k] = run;
          __syncthreads(); WKV_STAMP(7);
          float base = 0.f;
#pragma unroll
          for (int s2 = 0; s2 < 7; ++s2) base += (s2 < seg) ? tots[s2 * 64 + k] : 0.f;
#pragma unroll
          for (int i = 0; i < 8; ++i) col[i * 68] = pre[i] + base; }
        __syncthreads(); WKV_STAMP(8);
        float ce[8], cep[8], cec[8];
        { const LAS float* epb = (const LAS float*)(lds + O_EP);
          const f32x4 c0 = *(const LAS f32x4*)(epb + tt * 68 + ch0), c1 = *(const LAS f32x4*)(epb + tt * 68 + ch0 + 4);
          const int tq = tt > 0 ? tt - 1 : 0; f32x4 p0 = *(const LAS f32x4*)(epb + tq * 68 + ch0), p1 = *(const LAS f32x4*)(epb + tq * 68 + ch0 + 4); if (tt == 0) { p0 = (f32x4){0.f, 0.f, 0.f, 0.f}; p1 = p0; }
          const f32x4 q0 = *(const LAS f32x4*)(epb + 63 * 68 + ch0), q1 = *(const LAS f32x4*)(epb + 63 * 68 + ch0 + 4);
#pragma unroll
          for (int i = 0; i < 4; ++i) { ce[i] = c0[i]; ce[4 + i] = c1[i]; cep[i] = p0[i]; cep[4 + i] = p1[i]; cec[i] = q0[i]; cec[4 + i] = q1[i]; } }
        { float kk[8], ss = 0.f;
#pragma unroll
          for (int i = 0; i < 8; ++i) { kk[i] = k8[i] * ((const LAS float*)(lds + O_CONST))[192 + ch0 + i]; ss += kk[i] * kk[i]; }
          ss = red8(ss); const float inv = 1.0f / fmaxf(sqrtf(ss), 1e-12f);
          float at[8], bt[8], kt[8], rt[8], bh8[8], kh8[8], bo = 0.f;
#pragma unroll
          for (int i = 0; i < 8; ++i) { const float kaw_i = ((const LAS float*)(lds + O_CONST))[256 + ch0 + i], rkw_i = ((const LAS float*)(lds + O_CONST))[320 + ch0 + i];
              const float kki = kk[i] * inv, km = k8[i] * (1.0f + (lr8[i] - 1.0f) * kaw_i), bbv = kki * lr8[i];
              const float gp = __expf(-cep[i]), gi = __expf(ce[i]), gt = __expf(-ce[i]), gcj = __expf(ce[i] - cec[i]);
              at[i] = -kki * gp; bt[i] = bbv * gi; kt[i] = km * gi; rt[i] = r8[i] * gt; bh8[i] = bbv * gcj; kh8[i] = km * gcj; bo += r8[i] * km * rkw_i; }
          bo = red8(bo);
          if (kq == 0) bon[(tb + c * 64 + tt) * 8 + hd] = bo;
          if (tt == 63) { LAS float* gc = (LAS float*)(lds + O_GC) + ch0;
#pragma unroll
              for (int i = 0; i < 8; ++i) gc[i] = __expf(-cec[i]); }
          const int ro = tt * P + ch0 * 2;
          *(LAS v4u*)(lds + O_AT + ro) = (v4u){pk2(at[0], at[1]), pk2(at[2], at[3]), pk2(at[4], at[5]), pk2(at[6], at[7])};
          *(LAS v4u*)(lds + O_BTL + ro) = (v4u){pk2(bt[0], bt[1]), pk2(bt[2], bt[3]), pk2(bt[4], bt[5]), pk2(bt[6], bt[7])};
          *(LAS v4u*)(lds + O_KTL + ro) = (v4u){pk2(kt[0], kt[1]), pk2(kt[2], kt[3]), pk2(kt[4], kt[5]), pk2(kt[6], kt[7])};
          *(LAS v4u*)(lds + O_RT + ro) = (v4u){pk2(rt[0], rt[1]), pk2(rt[2], rt[3]), pk2(rt[4], rt[5]), pk2(rt[6], rt[7])};
          *(LAS v4u*)(lds + O_MABH + ro) = (v4u){pk2(bh8[0], bh8[1]), pk2(bh8[2], bh8[3]), pk2(bh8[4], bh8[5]), pk2(bh8[6], bh8[7])};
          *(LAS v4u*)(lds + O_MRB + ro) = (v4u){pk2(kh8[0], kh8[1]), pk2(kh8[2], kh8[3]), pk2(kh8[4], kh8[5]), pk2(kh8[6], kh8[7])};
          *(LAS v4u*)(lds + O_MRK + ro) = (v4u){pk2(v8[0], v8[1]), pk2(v8[2], v8[3]), pk2(v8[4], v8[5]), pk2(v8[6], v8[7])}; }
        __syncthreads(); WKV_STAMP(9);
        { WKV_TAINT(); const int lane = (tid & 63) + oz, c16 = lane & 15, rg = lane >> 4;
#pragma unroll
          for (int j = 0; j < 2; ++j) { const int nb = nb0 + j; f32x4 d0 = (f32x4){0.f, 0.f, 0.f, 0.f}, d1 = d0, d2 = d0, d3 = d0;
#pragma unroll
              for (int ks = 0; ks < 2; ++ks) { const bf16x8 idf = ident_frag(16 * nb + c16, ks, rg); const int ao = (16 * mb + c16) * P + (32 * ks + 8 * rg) * 2;
                  d0 = mfma16(*(const LAS bf16x8*)(lds + O_AT + ao), idf, d0); d1 = mfma16(*(const LAS bf16x8*)(lds + O_MABH + ao), idf, d1);
                  d2 = mfma16(*(const LAS bf16x8*)(lds + O_MRB + ao), idf, d2); d3 = mfma16(*(const LAS bf16x8*)(lds + O_MRK + ao), idf, d3); }
              const int to = (16 * nb + c16) * P + (16 * mb + 4 * rg) * 2;
              st4_bf(lds, O_RHST + to, d0); st4_bf(lds, O_BHT + to, d1); st4_bf(lds, O_KHT + to, d2); st4_bf(lds, O_VRT + to, d3); }
          if (wave < 4) { const int m0 = 16 * wave + 4 * rg; f32x4 d = mm_blk<64>(lds, O_BTL, P, O_AT, P, 16 * wave, 16 * wave, lane, (f32x4){0.f, 0.f, 0.f, 0.f});
#pragma unroll
              for (int e = 0; e < 4; ++e) d[e] = (m0 + e < 16 * wave + c16) ? d[e] : 0.f;
              *(LAS f32x4*)(lds + O_DIAG + ((wave * 16 + c16) * 16 + 4 * rg) * 4) = d; } }
        __syncthreads(); WKV_STAMP(0);
        WKV_TAINT();
        if (wave == 0) { const int td2 = (tid & 63) + oz, blk = td2 >> 4, cc = td2 & 15; const LAS float* D = (const LAS float*)(lds + O_DIAG) + blk * 256; float Tc[16];
            f32x4 dr[16][4];
#pragma unroll
            for (int r = 1; r < 16; ++r)
#pragma unroll
                for (int q = 0; q <= ((r - 1) >> 2); ++q) dr[r][q] = *(const LAS f32x4*)(D + r * 16 + 4 * q);
            asm volatile("s_waitcnt lgkmcnt(0)" ::: "memory");
            Tc[0] = (cc == 0) ? 1.f : 0.f;
#pragma unroll
            for (int r = 1; r < 16; ++r) { float sacc = (r == cc) ? 1.f : 0.f;
#pragma unroll
                for (int j = 0; j < r; ++j) sacc += dr[r][j >> 2][j & 3] * Tc[j];
                Tc[r] = sacc; }
#pragma unroll
            for (int r = 0; r < 16; ++r) { st_bf(lds, O_TII + (blk * 16 + r) * PO + cc * 2, Tc[r]); st_bf(lds, O_TII + (blk * 16 + r) * PO + (16 + cc) * 2, 0.f); }
        } else { const int lane = (tid & 63) + oz, c16 = lane & 15, rg = lane >> 4;
            constexpr unsigned PA = 0u | (0u << 2) | (0u << 4) | (0u << 6) | (1u << 8) | (1u << 10) | (1u << 12) | (2u << 14) | (2u << 16) | (3u << 18);
            constexpr unsigned PB = 0u | (1u << 2) | (2u << 4) | (3u << 6) | (1u << 8) | (2u << 10) | (3u << 12) | (2u << 14) | (3u << 16) | (3u << 18);
            constexpr unsigned ZA = 1u | (2u << 2) | (3u << 4) | (2u << 6) | (3u << 8) | (3u << 10), ZB = 0u | (0u << 2) | (0u << 4) | (1u << 6) | (1u << 8) | (2u << 10);
            bf16x8 fa[6][2], fb[6][2]; int oo[6], sg[6], th[6], dd[6];
#pragma unroll
            for (int k = 0; k < 6; ++k) { int it = wave - 1 + 7 * k; it = it < 40 ? it : 39; const int pr = it / 10, q = it - 10 * pr;
                const int lo = (PA >> (2 * q)) & 3, hb = (PB >> (2 * q)) & 3; const int mb1 = (pr == 1) ? hb : lo, nb1 = (pr == 1) ? lo : hb;
                const int aimg = (pr == 1) ? O_AT : (pr == 3) ? O_KTL : O_BTL, bimg = (pr == 0) ? O_AT : (pr == 1) ? O_KTL : O_RT;
                const int oimg = (pr == 0) ? O_MABH : (pr == 1) ? O_RHST + U : (pr == 2) ? O_MRB : O_MRK;
                const int ao = aimg + (16 * mb1 + c16) * P + 16 * rg, bo = bimg + (16 * nb1 + c16) * P + 16 * rg;
                fa[k][0] = *(const LAS bf16x8*)(lds + ao); fa[k][1] = *(const LAS bf16x8*)(lds + ao + 64); fb[k][0] = *(const LAS bf16x8*)(lds + bo); fb[k][1] = *(const LAS bf16x8*)(lds + bo + 64);
                oo[k] = oimg + (16 * nb1 + c16) * P + (16 * mb1 + 4 * rg) * 2; dd[k] = (16 * mb1 + 4 * rg) - (16 * nb1 + c16);
                sg[k] = (pr == 1) ? -1 : 1; th[k] = (pr >= 2) ? 1 : 0; }
            f32x4 rr[6];
#pragma unroll
            for (int k = 0; k < 6; ++k) { rr[k] = mfma16(fa[k][0], fb[k][0], (f32x4){0.f, 0.f, 0.f, 0.f}); rr[k] = mfma16(fa[k][1], fb[k][1], rr[k]); }
#pragma unroll
            for (int k = 0; k < 6; ++k) {
#pragma unroll
                for (int e = 0; e < 4; ++e) rr[k][e] = (sg[k] * (dd[k] + e) < th[k]) ? rr[k][e] : 0.f;
                st4_bf(lds, oo[k], rr[k]); }
#pragma unroll
            for (int k = 0; k < 4; ++k) { int zi = wave - 1 + 7 * k; zi = zi < 24 ? zi : 23; const int pr = zi / 6, q = zi - 6 * pr;
                const int hb = (ZA >> (2 * q)) & 3, lo = (ZB >> (2 * q)) & 3; const int mb1 = (pr == 1) ? lo : hb, nb1 = (pr == 1) ? hb : lo;
                const int oimg = (pr == 0) ? O_MABH : (pr == 1) ? O_RHST + U : (pr == 2) ? O_MRB : O_MRK;
                st4_bf(lds, oimg + (16 * nb1 + c16) * P + (16 * mb1 + 4 * rg) * 2, (f32x4){0.f, 0.f, 0.f, 0.f}); } }
        __syncthreads(); WKV_STAMP(1); WKV_STAMP(2);
        { WKV_TAINT(); const int lane = (tid & 63) + oz; const v4u z = (v4u){0u, 0u, 0u, 0u};
#pragma unroll
          for (int i = 0; i < 3; ++i) { const int idx = lane + 64 * i; if (idx < 16 * 9) *(LAS v4u*)(lds + O_XT + (16 * wave + idx / 9) * P + (idx % 9) * 16) = z; }
          if (lane < 32) *(LAS v4u*)(lds + O_OUTB + wave * 16 * PO + (lane >> 1) * PO + 32 + (lane & 1) * 16) = z;
          LDS_WAIT(); }
#pragma unroll 1
        for (int i = 0; i < 4; ++i) { WKV_TAINT(); const int lane = (tid & 63) + oz, c16 = lane & 15, rg = lane >> 4;
            f32x4 acc = (f32x4){0.f, 0.f, 0.f, 0.f};
            if (i > 0) acc = mm_blk<64>(lds, O_MABH, P, O_XT, P, 16 * i, 16 * wave, lane, acc);
            acc += ld4_bf(lds, O_RHST + (16 * wave + c16) * P + (16 * i + 4 * rg) * 2);
            st4_bf(lds, O_OUTB + wave * 16 * PO + c16 * PO + (4 * rg) * 2, acc);
            LDS_WAIT();
            f32x4 x = mm_blk<32>(lds, O_TII + i * 16 * PO, PO, O_OUTB + wave * 16 * PO, PO, 0, 0, lane, (f32x4){0.f, 0.f, 0.f, 0.f});
            st4_bf(lds, O_XT + (16 * wave + c16) * P + (16 * i + 4 * rg) * 2, x);
            LDS_WAIT();
        }
        __syncthreads(); WKV_STAMP(3);
        { WKV_TAINT(); const int lane = (tid & 63) + oz, c16 = lane & 15, rg = lane >> 4; f32x4 acc[4][2];
#pragma unroll
          for (int j = 0; j < 2; ++j) { const int nb = nb0 + j; const f32x4 z = (f32x4){0.f, 0.f, 0.f, 0.f};
              acc[0][j] = mm_blk<64>(lds, O_XT, P, O_MRB, P, 16 * mb, 16 * nb, lane, z);
              acc[1][j] = mm_blk<64>(lds, O_XT + U, P, O_MRB, P, 16 * mb, 16 * nb, lane, z);
              acc[2][j] = mm_blk<64>(lds, O_XT, P, O_BHT, P, 16 * mb, 16 * nb, lane, z);
              acc[3][j] = mm_blk<64>(lds, O_XT + U, P, O_BHT, P, 16 * mb, 16 * nb, lane, z); }
#pragma unroll
          for (int j = 0; j < 2; ++j) { const int n = 16 * (nb0 + j) + c16, m0 = 16 * mb + 4 * rg; const int o = n * P + m0 * 2;
              acc[0][j] += ld4_bf(lds, O_RT + o); acc[1][j] += ld4_bf(lds, O_MRK + o); acc[3][j] += ld4_bf(lds, O_KHT + o);
              if (n >= m0 && n < m0 + 4) acc[2][j][n - m0] += *(const LAS float*)(lds + O_GC + n * 4); }
          __syncthreads();
#pragma unroll
          for (int j = 0; j < 2; ++j) { const int n = 16 * (nb0 + j) + c16, m0 = 16 * mb + 4 * rg; const int o = n * P + m0 * 2;
              st4_bf(lds, O_G1 + o, acc[0][j]); st4_bf(lds, O_Z1 + o, acc[1][j]); st4_bf(lds, O_Z2 + o, acc[3][j]);
              f32x4 hi4, lo4;
#pragma unroll
              for (int e = 0; e < 4; ++e) { hi4[e] = __builtin_bit_cast(float, f2bf(acc[2][j][e]) << 16); lo4[e] = acc[2][j][e] - hi4[e]; }
              st4_bf(lds, O_RT + o, hi4); st4_bf(lds, O_KHT + o, lo4); } }
        { WKV_TAINT(); const int td5 = tid + oz, v = td5 >> 3, kq5 = (td5 & 7) * 8; const LAS float* sp = (const LAS float*)(lds + O_S + v * PF) + kq5;
          const f32x4 x0 = *(const LAS f32x4*)sp, x1 = *(const LAS f32x4*)(sp + 4); f32x4 h0, h1, l0, l1;
#pragma unroll
          for (int e = 0; e < 4; ++e) { h0[e] = __builtin_bit_cast(float, f2bf(x0[e]) << 16); l0[e] = x0[e] - h0[e]; h1[e] = __builtin_bit_cast(float, f2bf(x1[e]) << 16); l1[e] = x1[e] - h1[e]; }
          st4_bf(lds, O_MRB + v * P + kq5 * 2, h0); st4_bf(lds, O_MRB + v * P + kq5 * 2 + 8, h1); st4_bf(lds, O_MRK + v * P + kq5 * 2, l0); st4_bf(lds, O_MRK + v * P + kq5 * 2 + 8, l1); }
        __syncthreads(); WKV_STAMP(4);
        { WKV_TAINT(); const int lane = (tid & 63) + oz, c16 = lane & 15, rg = lane >> 4; f32x4 ay[2], as[2];
#pragma unroll
          for (int j = 0; j < 2; ++j) { const int nb = nb0 + j; const f32x4 z = (f32x4){0.f, 0.f, 0.f, 0.f};
              ay[j] = mm_blk<64>(lds, O_VRT, P, O_Z1, P, 16 * mb, 16 * nb, lane, z);
              ay[j] = mm_blk<64>(lds, O_MRB, P, O_G1, P, 16 * mb, 16 * nb, lane, ay[j]);
              ay[j] = mm_blk<64>(lds, O_MRK, P, O_G1, P, 16 * mb, 16 * nb, lane, ay[j]);
              as[j] = mm_blk<64>(lds, O_Z2, P, O_VRT, P, 16 * mb, 16 * nb, lane, z);
              as[j] = mm_blk<64>(lds, O_RT, P, O_MRB, P, 16 * mb, 16 * nb, lane, as[j]);
              as[j] = mm_blk<64>(lds, O_KHT, P, O_MRB, P, 16 * mb, 16 * nb, lane, as[j]);
              as[j] = mm_blk<64>(lds, O_RT, P, O_MRK, P, 16 * mb, 16 * nb, lane, as[j]); }
#pragma unroll
          for (int j = 0; j < 2; ++j) { const int t = 16 * (nb0 + j) + c16, v0 = 16 * mb + 4 * rg;
              ypk[j] = (v2u){pk2(ay[j][0], ay[j][1]), pk2(ay[j][2], ay[j][3])};
              *(LAS f32x4*)(lds + O_S + t * PF + v0 * 4) = as[j]; } }
        WKV_STAMP(5);
    }
    WKV_TAINT(); store_y(SEQ / 64 - 1);
#if defined(PROBE_PHASE) && PROBE_PHASE >= 300 && PROBE_PHASE < 320
    if (tid == 0) atomicAdd((unsigned*)(ws + WS_CTL) + 96, tacc[PROBE_PHASE - 300]);
#endif
}
__device__ __forceinline__ void phase_orw(const Args& a, int lane, int wave, int vcu, int G) {
    unsigned char* ws = a.ws;
    const int gw = vcu * NWAVES + wave, NGW = G * NWAVES;
    const bf16* rkv = (const bf16*)(ws + WS_RKV); const bf16* Gg = (const bf16*)(ws + WS_G); const float* bon = (const float*)(ws + WS_BON);
    bf16* orw = (bf16*)((unsigned char*)a.out + OUT_ORWDF);
    const int ch = lane * 8;
    const f32x4 mv0 = *(const f32x4*)(a.in[4] + 1024 + ch), mv1 = *(const f32x4*)(a.in[4] + 1024 + ch + 4);
    const f32x4 lw0 = *(const f32x4*)(a.in[13] + ch), lw1 = *(const f32x4*)(a.in[13] + ch + 4), lb0 = *(const f32x4*)(a.in[14] + ch), lb1 = *(const f32x4*)(a.in[14] + ch + 4);
    const float muv[8] = {mv0[0], mv0[1], mv0[2], mv0[3], mv1[0], mv1[1], mv1[2], mv1[3]}, lnw[8] = {lw0[0], lw0[1], lw0[2], lw0[3], lw1[0], lw1[1], lw1[2], lw1[3]}, lnb[8] = {lb0[0], lb0[1], lb0[2], lb0[3], lb1[0], lb1[1], lb1[2], lb1[3]};
    for (int t = gw; t < T; t += NGW) {
        const int b = t >> 12, s = t & (SEQ - 1); const v4u yw = *(const v4u*)(y_ptr(a.out, b) + (size_t)s * 512 + ch);
        const f32x4 y0 = (f32x4){bflo(yw.x), bfhi(yw.x), bflo(yw.y), bfhi(yw.y)}, y1 = (f32x4){bflo(yw.z), bfhi(yw.z), bflo(yw.w), bfhi(yw.w)};
        const v4u vc = *(const v4u*)(rkv + (size_t)t * 1536 + 1024 + ch); v4u vp = (v4u){0u, 0u, 0u, 0u}; if (s != 0) vp = *(const v4u*)(rkv + (size_t)(t - 1) * 1536 + 1024 + ch);
        const v4u gw4 = *(const v4u*)(Gg + (size_t)t * 512 + ch); const float bo = bon[(size_t)t * 8 + (lane >> 3)];
        float y[8] = {y0[0], y0[1], y0[2], y0[3], y1[0], y1[1], y1[2], y1[3]};
        float sm = 0.f;
#pragma unroll
        for (int e = 0; e < 8; ++e) sm += y[e];
        const float mean = red8(sm) * (1.f / 64.f); float vs = 0.f;
#pragma unroll
        for (int e = 0; e < 8; ++e) { y[e] -= mean; vs += y[e] * y[e]; }
        const float rstd = 1.0f / sqrtf(red8(vs) * (1.f / 64.f) + 64e-5f);
        const unsigned vcw[4] = {vc.x, vc.y, vc.z, vc.w}, vpw[4] = {vp.x, vp.y, vp.z, vp.w}, gww[4] = {gw4.x, gw4.y, gw4.z, gw4.w}; float o[8];
#pragma unroll
        for (int e = 0; e < 8; ++e) { const int w = e >> 1; const bool hi = e & 1; const float c = hi ? bfhi(vcw[w]) : bflo(vcw[w]), p = hi ? bfhi(vpw[w]) : bflo(vpw[w]), g = hi ? bfhi(gww[w]) : bflo(gww[w]);
            const float v = c + (p - c) * muv[e]; o[e] = ((y[e] * rstd * lnw[e] + lnb[e]) + bo * v) * g; }
        v4u ov; ov.x = pk2(o[0], o[1]); ov.y = pk2(o[2], o[3]); ov.z = pk2(o[4], o[5]); ov.w = pk2(o[6], o[7]);
        *(v4u*)(orw + (size_t)t * 1024 + ch) = ov;
    }
}

__device__ __forceinline__ int crow(int r, int hi) { return (r & 3) + 8 * (r >> 2) + 4 * hi; }
constexpr int AT_BUF = 24576;
__device__ __forceinline__ int at_addr(int row, int ch) { return row * 128 + ((ch ^ ((row >> 1) & 7)) << 4); }
__device__ __forceinline__ void attn_pass(const bf16* qn, const bf16* kn, const bf16* vt, int b, int head, int c, int qb, LAS unsigned char* lds, int tid, f32x16 (&o)[4]) {
    const int lane = tid & 63, wave = __builtin_amdgcn_readfirstlane(tid >> 6), r32 = lane & 31, hi = lane >> 5;
    const int vh = b * 8 + head * 2 + c; const int q0 = qb * 256, qw0 = q0 + wave * 32, qrow = qw0 + r32;
    const bf16* Qp = qn + ((size_t)(vh & 7) * SEQ + qrow) * 64;
    s16x8 qf[4];
#pragma unroll
    for (int ks = 0; ks < 4; ++ks) qf[ks] = *(const s16x8*)(Qp + 16 * ks + 8 * hi);
    const int k_row = tid >> 3, k_ch = tid & 7;
    const bf16* ksrc = kn + (size_t)(vh & 7) * SEQ * 64 + k_row * 64 + k_ch * 8; const int kdst = at_addr(k_row, k_ch);
    const int dv0 = tid >> 3, dv1 = 64 + (tid >> 3);
    const bf16* vsrc0 = vt + (size_t)(head * 128 + dv0) * T + (size_t)b * SEQ + k_ch * 8; const bf16* vsrc1 = vsrc0 + (size_t)64 * T;
    const int vdst0 = 8192 + at_addr(dv0, k_ch), vdst1 = 8192 + at_addr(dv1, k_ch); const bool vsw0 = (dv0 & 16) != 0, vsw1 = (dv1 & 16) != 0;
    const int NT = 4 * qb + 4;
    v4u kreg = *(const v4u*)ksrc, vreg0 = *(const v4u*)vsrc0, vreg1 = *(const v4u*)vsrc1;
    __syncthreads();
    *(LAS v4u*)(lds + kdst) = kreg; *(LAS v4u*)(lds + vdst0) = vsw0 ? (v4u){vreg0.z, vreg0.w, vreg0.x, vreg0.y} : vreg0; *(LAS v4u*)(lds + vdst1) = vsw1 ? (v4u){vreg1.z, vreg1.w, vreg1.x, vreg1.y} : vreg1;
    __syncthreads();
    float m = -1e30f, l = 0.f;
#pragma unroll
    for (int db = 0; db < 4; ++db)
#pragma unroll
        for (int i = 0; i < 16; ++i) o[db][i] = 0.f;
    for (int j = 0; j < NT; ++j) {
        const int cur = (j & 1) * AT_BUF, nxt = AT_BUF - cur; const bool more = j + 1 < NT;
        if (more) { kreg = *(const v4u*)(ksrc + (size_t)(j + 1) * 64 * 64); vreg0 = *(const v4u*)(vsrc0 + (j + 1) * 64); vreg1 = *(const v4u*)(vsrc1 + (j + 1) * 64); }
        const int kv0 = j * 64;
        if (kv0 <= qw0 + 31) {
            f32x16 s0, s1;
#pragma unroll
            for (int i = 0; i < 16; ++i) { s0[i] = 0.f; s1[i] = 0.f; }
            __builtin_amdgcn_s_setprio(1);
#pragma unroll
            for (int ks = 0; ks < 4; ++ks) {
                const s16x8 a0 = *(const LAS s16x8*)(lds + cur + at_addr(r32, 2 * ks + hi));
                const s16x8 a1 = *(const LAS s16x8*)(lds + cur + at_addr(32 + r32, 2 * ks + hi));
                s0 = __builtin_amdgcn_mfma_f32_32x32x16_bf16(a0, qf[ks], s0, 0, 0, 0);
                s1 = __builtin_amdgcn_mfma_f32_32x32x16_bf16(a1, qf[ks], s1, 0, 0, 0);
            }
            __builtin_amdgcn_s_setprio(0);
            if (kv0 + 63 > qw0) {
#pragma unroll
                for (int i = 0; i < 16; ++i) { const int kv = kv0 + crow(i, hi); if (kv > qrow) s0[i] = -1e30f; if (kv + 32 > qrow) s1[i] = -1e30f; }
            }
            float rm = fmaxf(s0[0], s1[0]);
#pragma unroll
            for (int i = 1; i < 16; ++i) rm = fmaxf(rm, fmaxf(s0[i], s1[i]));
            rm = xhalf_max(rm);
            const float mn = fmaxf(m, rm); const float f = __builtin_amdgcn_exp2f(m - mn); m = mn;
            float ps = 0.f;
#pragma unroll
            for (int i = 0; i < 16; ++i) { s0[i] = __builtin_amdgcn_exp2f(s0[i] - mn); s1[i] = __builtin_amdgcn_exp2f(s1[i] - mn); ps += s0[i] + s1[i]; }
            l = l * f + ps;
            if (__any(f != 1.0f)) {
#pragma unroll
                for (int db = 0; db < 4; ++db)
#pragma unroll
                    for (int i = 0; i < 16; ++i) o[db][i] *= f;
            }
            v4u pw[4];
            pw[0] = (v4u){pk2(s0[0], s0[1]), pk2(s0[2], s0[3]), pk2(s0[4], s0[5]), pk2(s0[6], s0[7])};
            pw[1] = (v4u){pk2(s0[8], s0[9]), pk2(s0[10], s0[11]), pk2(s0[12], s0[13]), pk2(s0[14], s0[15])};
            pw[2] = (v4u){pk2(s1[0], s1[1]), pk2(s1[2], s1[3]), pk2(s1[4], s1[5]), pk2(s1[6], s1[7])};
            pw[3] = (v4u){pk2(s1[8], s1[9]), pk2(s1[10], s1[11]), pk2(s1[12], s1[13]), pk2(s1[14], s1[15])};
#pragma unroll
            for (int db = 0; db < 4; ++db) { const int dv = 32 * db + r32; const int vb = cur + 8192 + dv * 128 + 8 * (hi ^ ((dv >> 4) & 1)), sw = (dv >> 1) & 7;
#pragma unroll
                for (int s4 = 0; s4 < 4; ++s4) {
                    const s16x4 lo = *(const LAS s16x4*)(lds + vb + (((2 * s4) ^ sw) << 4));
                    const s16x4 hh = *(const LAS s16x4*)(lds + vb + (((2 * s4 + 1) ^ sw) << 4));
                    const s16x8 av = (s16x8){lo[0], lo[1], lo[2], lo[3], hh[0], hh[1], hh[2], hh[3]};
                    o[db] = __builtin_amdgcn_mfma_f32_32x32x16_bf16(av, __builtin_bit_cast(s16x8, pw[s4]), o[db], 0, 0, 0);
                }
                __builtin_amdgcn_sched_barrier(0); }
        }
        if (more) { *(LAS v4u*)(lds + nxt + kdst) = kreg; *(LAS v4u*)(lds + nxt + vdst0) = vsw0 ? (v4u){vreg0.z, vreg0.w, vreg0.x, vreg0.y} : vreg0; *(LAS v4u*)(lds + nxt + vdst1) = vsw1 ? (v4u){vreg1.z, vreg1.w, vreg1.x, vreg1.y} : vreg1; }
        __syncthreads();
    }
    l = xhalf_sum(l);
    const float il = 1.0f / l;
#pragma unroll
    for (int db = 0; db < 4; ++db)
#pragma unroll
        for (int i = 0; i < 16; ++i) o[db][i] *= il;
}
__device__ __forceinline__ void attn_unit(const Args& a, LAS unsigned char* lds, int tid, int b, int head, int qb, float* stash  ) {
    unsigned char* ws = a.ws;
    const bf16* qn = qn_ptr(ws, b); const bf16* kn = kn_ptr(ws, b); const bf16* vt = (const bf16*)(ws + WS_VT);
    bf16* odf = (bf16*)((unsigned char*)a.out + OUT_ORWDF) + 512;
    const int lane = tid & 63, wave = tid >> 6, r32 = lane & 31, hi = lane >> 5;
    int oz = 0; asm volatile("" : "+v"(oz)); const int ll = lane + oz;
    const float d1 = wave_sum(a.in[17][ll] * a.in[18][ll]), d2 = wave_sum(a.in[19][ll] * a.in[20][ll]);
    const float lam = __expf(d1) - __expf(d2) + LAM_INIT;
    f32x16 o[4];
    attn_pass(qn, kn, vt, b, head, 0, qb, lds, tid, o);
    float* st = stash + tid * 64;
#pragma unroll
    for (int db = 0; db < 4; ++db)
#pragma unroll
        for (int g = 0; g < 4; ++g) *(f32x4*)(st + db * 16 + g * 4) = (f32x4){o[db][4 * g], o[db][4 * g + 1], o[db][4 * g + 2], o[db][4 * g + 3]};
#if defined(PROBE_PHASE) && PROBE_PHASE == 215
    if (head == 0) { bf16* dbg = (bf16*)(ws + 496 * MiB); const size_t tq = (size_t)b * SEQ + qb * 256 + wave * 32 + r32;
#pragma unroll
        for (int db = 0; db < 4; ++db)
#pragma unroll
            for (int g = 0; g < 4; ++g) { const int dv = 32 * db + 8 * g + 4 * hi; v2u ov; ov.x = pk2(o[db][4 * g], o[db][4 * g + 1]); ov.y = pk2(o[db][4 * g + 2], o[db][4 * g + 3]); *(v2u*)(dbg + tq * 128 + dv) = ov; } }
#endif
    attn_pass(qn, kn, vt, b, head, 1, qb, lds, tid, o);
    float ss = 0.f;
#pragma unroll
    for (int db = 0; db < 4; ++db)
#pragma unroll
        for (int g = 0; g < 4; ++g) { const f32x4 s4 = *(const f32x4*)(st + db * 16 + g * 4);
#pragma unroll
            for (int e = 0; e < 4; ++e) { const float d = s4[e] - lam * o[db][4 * g + e]; o[db][4 * g + e] = d; ss += d * d; } }
    ss = xhalf_sum(ss);
    const float rs = (1.0f / sqrtf(ss * (1.f / 128.f) + 1e-6f)) * (1.0f - LAM_INIT);
    const size_t t = (size_t)b * SEQ + qb * 256 + wave * 32 + r32; const float* sw = a.in[21];
#pragma unroll
    for (int db = 0; db < 4; ++db)
#pragma unroll
        for (int g = 0; g < 4; ++g) { const int dv = 32 * db + 8 * g + 4 * hi; const f32x4 w4 = *(const f32x4*)(sw + dv);
            v2u ov; ov.x = pk2(o[db][4 * g] * rs * w4[0], o[db][4 * g + 1] * rs * w4[1]); ov.y = pk2(o[db][4 * g + 2] * rs * w4[2], o[db][4 * g + 3] * rs * w4[3]);
            *(v2u*)(odf + t * 1024 + head * 128 + dv) = ov; }
}
#define XB_TMO      128
#define XB_XCNT(j)  (256  + 64 * (j))
#define XB_XSUB(j)  (1280 + 64 * (j))
#define XB_XGEN(j)  (2304 + 64 * (j))
#define XB_TOP      3328
#define XB_TOPGEN   3392
#define XCD_BAR_WORDS 3456
#define XB_SPIN_CAP (1u << 18)

__device__ __forceinline__ unsigned xb_ld(unsigned* p)              { return __hip_atomic_load(p, __ATOMIC_RELAXED, __HIP_MEMORY_SCOPE_AGENT); }
__device__ __forceinline__ unsigned xb_add(unsigned* p, unsigned v) { return __hip_atomic_fetch_add(p, v, __ATOMIC_RELAXED, __HIP_MEMORY_SCOPE_AGENT); }
__device__ __forceinline__ unsigned xb_xcc_id() { return (unsigned)__builtin_amdgcn_s_getreg((3 << 11) | 20) & 0xFu; }
#define XB_SPIN(cond, bar) do { unsigned _sp = 0; while (cond) { __builtin_amdgcn_s_sleep(1); \
    if ((++_sp & 255u) == 0u) { if (xb_ld(&(bar)[XB_TMO])) break; if (_sp > XB_SPIN_CAP) { atomicAdd(&(bar)[XB_TMO], 1u); break; } } } } while (0)

struct XcdBarrier {
    unsigned* bar; unsigned x;
    volatile LAS unsigned* st;
};

__device__ __forceinline__ XcdBarrier xcd_barrier_post(unsigned* bar, volatile LAS unsigned* st) {
    XcdBarrier b; b.bar = bar; b.x = xb_xcc_id(); b.st = st;
    if (threadIdx.x == 0) (void)xb_add(&bar[XB_XCNT(b.x)], 1u);
    return b;
}
__device__ __forceinline__ void xcd_barrier_complete(unsigned* bar, unsigned x, unsigned& nloc, unsigned& nx) {
    const unsigned G = gridDim.x * gridDim.y * gridDim.z;
    unsigned sum, cnt, mine, sp = 0u;
    for (;;) {
        sum = 0u; cnt = 0u; mine = 0u;
#pragma unroll
        for (unsigned j = 0; j < 16; ++j) { const unsigned c = xb_ld(&bar[XB_XCNT(j)]); sum += c; cnt += (c > 0u) ? 1u : 0u; mine = (j == x) ? c : mine; }
        if (sum == G) break;
        __builtin_amdgcn_s_sleep(1);
        if ((++sp & 255u) == 0u) { if (xb_ld(&bar[XB_TMO])) break; if (sp > XB_SPIN_CAP) { atomicAdd(&bar[XB_TMO], 1u); break; } }
    }
    nloc = mine > 0u ? mine : 1u; nx = cnt > 0u ? cnt : 1u;
}

__device__ __forceinline__ void xcd_barrier(const XcdBarrier& b) {
    asm volatile("s_waitcnt vmcnt(0)" ::: "memory");
    __syncthreads();
    if (threadIdx.x == 0) {
        unsigned* bar = b.bar;
        __builtin_amdgcn_s_waitcnt(0);
        unsigned nloc = b.st[0], nx = b.st[1];
        if (nloc == 0u) { xcd_barrier_complete(bar, b.x, nloc, nx); b.st[0] = nloc; b.st[1] = nx; }
        const unsigned old = xb_add(&bar[XB_XSUB(b.x)], 1u);
        const unsigned gen = old / nloc;
        if (old + 1u == (gen + 1u) * nloc) {
            __builtin_amdgcn_fence(__ATOMIC_RELEASE, "agent");
            asm volatile("s_waitcnt vmcnt(0)" ::: "memory");
            const unsigned og = xb_add(&bar[XB_TOP], 1u);
            const unsigned tg = og / nx;
            if (og + 1u == (tg + 1u) * nx) xb_add(&bar[XB_TOPGEN], 1u);
            else XB_SPIN(xb_ld(&bar[XB_TOPGEN]) == tg, bar);
            __builtin_amdgcn_fence(__ATOMIC_ACQUIRE, "agent");
            xb_add(&bar[XB_XGEN(b.x)], 1u);
            asm volatile("s_waitcnt vmcnt(0)" ::: "memory");
        } else {
            XB_SPIN(xb_ld(&bar[XB_XGEN(b.x)]) == gen, bar);
            __builtin_amdgcn_fence(__ATOMIC_ACQUIRE, "agent");
            asm volatile("s_waitcnt vmcnt(0)" ::: "memory");
        }
    }
    __syncthreads();
}

constexpr int TR_IGU = (1024 / 64) * (512 / 32);
constexpr int TR_IDN = (512 / 64) * (1024 / 32);
constexpr int NTRQ = 256, TRQ_PER_WAVE = NEXP * 2 * TR_IGU / (NTRQ * NWAVES);
__device__ __forceinline__ void tr_wgu_qitem(const Args& a, LAS unsigned char* lds, int lane, int wave, int q) {
    LAS float* scr = (LAS float*)(lds + wave * 16384); bf16* wgu = (bf16*)(a.ws + WS_WGU);
#pragma unroll 1
    for (int j = 0; j < TRQ_PER_WAVE; ++j) { const int it = (q * NWAVES + wave) * TRQ_PER_WAVE + j; const int e = it / (2 * TR_IGU); int r = it % (2 * TR_IGU);
        const int up = r >= TR_IGU; if (up) r -= TR_IGU; const int kb = r / 16, nb = r % 16, n0 = 32 * nb;
        const float* W = (up ? a.in[31] : a.in[30]) + (size_t)e * 1024 * 512;
        tr_item<true>(W, 512, wgu, 1024, 64 * kb, n0, (size_t)e * 1024 + (n0 >> 7) * 256 + (up ? 128 : 0) + (n0 & 127), 0, scr, lane, a.in[25]); }
}
__device__ __forceinline__ void tr_wd_all(const Args& a, LAS unsigned char* lds, int lane, int wave, int w0, int nw) {
    LAS float* scr = (LAS float*)(lds + wave * 16384); bf16* wd = (bf16*)(a.ws + WS_WD);
#pragma unroll 1
    for (int it = w0; it < NEXP * TR_IDN; it += nw) { const int e = it / TR_IDN, r = it % TR_IDN, kb = r / 32, nb = r % 32;
        tr_item(a.in[32] + (size_t)e * 512 * 1024, 1024, wd, 512, 64 * kb, 32 * nb, (size_t)e * 1024 + 32 * nb, 0, scr, lane); }
}

__device__ __forceinline__ void route_tile(const Args& a, LAS unsigned char* lds, int tid, int pm) {
    unsigned char* ws = a.ws;
    const float* LG = (const float*)(ws + WS_LOGITS); int* toke = (int*)(ws + WS_TOKE); float* tokw = (float*)(ws + WS_TOKW); int* tilecnt = (int*)(ws + WS_TILECNT);
    LAS int* cnt = (LAS int*)lds;
    if (tid < 32) cnt[tid] = 0;
    __syncthreads();
    if (tid < 256) {
        const int t = pm * 256 + tid; const float* lr = LG + (size_t)t * 128;
        float rs;
        { const f32x4* sp = (const f32x4*)((const float*)(ws + WS_SSQ) + (size_t)t * 16); const f32x4 s0 = sp[0], s1 = sp[1], s2 = sp[2], s3 = sp[3];
          const float ss = (((s0[0] + s0[1]) + (s0[2] + s0[3])) + ((s1[0] + s1[1]) + (s1[2] + s1[3]))) + (((s2[0] + s2[1]) + (s2[2] + s2[3])) + ((s3[0] + s3[1]) + (s3[2] + s3[3])));
          rs = 1.0f / sqrtf(ss * (1.f / 1024.f) + 1e-6f); ((float*)(ws + WS_RS))[t] = rs; }
        float gl[4];
#pragma unroll
        for (int j = 0; j < 4; ++j) gl[j] = lr[32 + j] * rs + a.in[27][j];
        int gi = 0; float gm = gl[0];
#pragma unroll
        for (int j = 1; j < 4; ++j) if (gl[j] > gm) { gm = gl[j]; gi = j; }
        float gs = 0.f;
#pragma unroll
        for (int j = 0; j < 4; ++j) gs += __expf(gl[j] - gm);
        const float gtop = 1.0f / gs;
        float el[8];
#pragma unroll
        for (int j = 0; j < 8; ++j) el[j] = lr[gi * 8 + j] * rs + a.in[29][gi * 8 + j];
        int i1 = 0; float e1 = el[0];
#pragma unroll
        for (int j = 1; j < 8; ++j) if (el[j] > e1) { e1 = el[j]; i1 = j; }
        int i2 = -1; float e2 = -3.0e38f;
#pragma unroll
        for (int j = 0; j < 8; ++j) if (j != i1 && el[j] > e2) { e2 = el[j]; i2 = j; }
        const float ex = __expf(e2 - e1); const float w1 = gtop / (1.0f + ex), w2 = gtop * ex / (1.0f + ex);
        const int x1 = gi * 8 + i1, x2 = gi * 8 + i2;
        toke[t * 2] = x1; toke[t * 2 + 1] = x2; tokw[t * 2] = w1; tokw[t * 2 + 1] = w2;
        atomicAdd((int*)&cnt[x1], 1); atomicAdd((int*)&cnt[x2], 1);
    }
    __syncthreads();
    if (tid < 32) tilecnt[pm * 32 + tid] = cnt[tid];
    __syncthreads();
}

__device__ __forceinline__ void phase9(const Args& a, LAS unsigned char* lds, int tid, int lane, int wave) {
    unsigned char* ws = a.ws;
    const int tile = blockIdx.x;
    if (tile >= 128) return;
    const int* tilecnt = (const int*)(ws + WS_TILECNT); const int* toke = (const int*)(ws + WS_TOKE); const float* tokw = (const float*)(ws + WS_TOKW);
    int* pos = (int*)(ws + WS_POS); float* roww = (float*)(ws + WS_ROWW); int* disp = (int*)(ws + WS_DISP); int* rowtok = (int*)(ws + WS_ROWTOK);
    LAS int* tc = (LAS int*)lds;
    LAS int* tot = tc + 4096;
    LAS int* bef = tot + 32;
    LAS int* base = bef + 32;
    LAS int* pst = base + 32;
    LAS int* earr = pst + 32;
    LAS int* parr = earr + 512;
    for (int i = tid; i < 4096; i += NTHR) tc[i] = tilecnt[i];
    earr[tid] = toke[tile * 512 + tid];
    __syncthreads();
    if (tid < 32) { int s = 0, b = 0; for (int t = 0; t < 128; ++t) { const int c = tc[t * 32 + tid]; s += c; if (t < tile) b += c; } tot[tid] = s; bef[tid] = b; }
    __syncthreads();
    if (tid == 0) { int p = 0; for (int e = 0; e < 32; ++e) { pst[e] = p; base[e] = p + bef[e]; const int nt = (tot[e] + 255) >> 8;
                        if (tile == 0) { for (int k = 0; k < nt; ++k) disp[16 + (p >> 8) + k] = e; disp[512 + e] = p; disp[576 + e] = tot[e]; }
                        p += nt << 8; }
                    if (tile == 0) disp[0] = p >> 8; }
    __syncthreads();
    for (int q = 0; q < 4; ++q) { const int e = wave * 4 + q; int running = 0;
        for (int c8 = 0; c8 < 8; ++c8) { const int ai = c8 * 64 + lane; const bool mt = earr[ai] == e; const unsigned long long mk = __ballot(mt);
            if (mt) parr[ai] = base[e] + running + __popcll(mk & ((1ull << lane) - 1ull));
            running += __popcll(mk); } }
    __syncthreads();
    { const int ai = tid, p = parr[ai], t = tile * 256 + (ai >> 1); pos[t * 2 + (ai & 1)] = p; roww[p] = tokw[t * 2 + (ai & 1)]; rowtok[p] = t; ((float*)(ws + WS_ROWRS))[p] = ((const float*)(ws + WS_RS))[t]; }
    if (tile < 32) { const int p0 = pst[tile] + tot[tile], p1 = pst[tile] + (((tot[tile] + 255) >> 8) << 8);
        for (int r = p0 + tid; r < p1; r += NTHR) { rowtok[r] = 0; roww[r] = 0.f; ((float*)(ws + WS_ROWRS))[r] = 0.f; } }
}

__device__ __forceinline__ void phase12(const Args& a, int tid, int lane, int wave, int vcu, int G) {
    unsigned char* ws = a.ws;
    const int gw = vcu * NWAVES + wave, NGW = G * NWAVES;
    const bf16* x1 = (const bf16*)a.out; bf16* x2 = (bf16*)(ws + WS_X2); const bf16* y2 = (const bf16*)(ws + WS_Y2); const int* pos = (const int*)(ws + WS_POS); float* rs3 = (float*)(ws + WS_RS);
    for (int m = gw; m < T; m += NGW) {
        const int pa = pos[m * 2], pb = pos[m * 2 + 1];
        const v2u* xr = (const v2u*)(x1 + (size_t)m * DM) + lane; v2u* xo = (v2u*)(x2 + (size_t)m * DM) + lane; const v2u* ya = (const v2u*)(y2 + (size_t)pa * 1024) + lane; const v2u* yb = (const v2u*)(y2 + (size_t)pb * 1024) + lane;
        float s = 0.f;
#pragma unroll
        for (int j = 0; j < 4; ++j) { const v2u wx = xr[64 * j], wa = ya[64 * j], wb = yb[64 * j]; f32x4 v;
            v.x = bflo(wx.x) + bflo(wa.x) + bflo(wb.x); v.y = bfhi(wx.x) + bfhi(wa.x) + bfhi(wb.x); v.z = bflo(wx.y) + bflo(wa.y) + bflo(wb.y); v.w = bfhi(wx.y) + bfhi(wa.y) + bfhi(wb.y);
            v2u o; o.x = pk2(v.x, v.y); o.y = pk2(v.z, v.w); xo[64 * j] = o;
            s += (v.x * v.x + v.y * v.y) + (v.z * v.z + v.w * v.w); }
        const float rstd = 1.0f / sqrtf(wave_sum(s) * (1.f / 1024.f) + 1e-6f);
        if (lane == 0) rs3[m] = rstd;
    }
}
__device__ __forceinline__ void pp_tile(const Args& a, LAS unsigned char* lds, int tid0, int pm, int K256) {
    int oz = 0; asm volatile("" : "+v"(oz)); const int tid = tid0 + oz;
    unsigned char* ws = a.ws;
    const f32x4* p = (const f32x4*)a.in[1] + (size_t)pm * 256 * 64; v2u* p16 = (v2u*)(ws + WS_P16) + (size_t)pm * 256 * 64;
#pragma unroll 4
    for (int i = tid; i < 256 * 64; i += NTHR) { const f32x4 v = p[i]; v2u o; o.x = pk2(v.x, v.y); o.y = pk2(v.z, v.w); p16[i] = o; }
    VM_WAIT(); __syncthreads();
    pg8::Gemm g{(const pg8::bf16_t*)(ws + WS_P16), (const pg8::bf16_t*)(ws + WS_WPP), T, 1024, K256}; pg8::OrderItem S{pm, 0, 4};
    pg8::EpiStore E{(pg8::bf16_t*)(ws + WS_PP), 1024};
    pg8::gemm_phase<pg8::EpiStore, pg8::OrderItem, true, true>(lds, g, S, E, oz);
}

#if defined(PROBE_PHASE) && (PROBE_PHASE == 200 || PROBE_PHASE == 201)
__device__ __forceinline__ float blk_sum(float v, LAS float* red, int tid) { v = wave_sum(v); __syncthreads(); if ((tid & 63) == 0) red[tid >> 6] = v; __syncthreads(); float s = 0.f; for (int i = 0; i < 8; ++i) s += red[i]; __syncthreads(); return s; }
__device__ __forceinline__ void check_moe(const Args& a, LAS unsigned char* lds, int tid, float* res) {
    unsigned char* ws = a.ws;
    LAS float* hb = (LAS float*)lds; LAS float* hf = hb + 1024; LAS float* act = hf + 1024; LAS float* lg = act + 512; LAS float* red = lg + 64; LAS int* sel = (LAS int*)(red + 16);
    const int* toke = (const int*)(ws + WS_TOKE); const float* tokw = (const float*)(ws + WS_TOKW); const int* pos = (const int*)(ws + WS_POS); const bf16* y2 = (const bf16*)(ws + WS_Y2);
    float errsum = 0.f, refsum = 0.f; int mism = 0;
    for (int si = 0; si < 24; ++si) { const int t = si * 1361 + 17;
        const bf16* xr = (const bf16*)a.out + (size_t)t * DM; const float x0 = __builtin_bit_cast(float, (unsigned)xr[tid] << 16), x1 = __builtin_bit_cast(float, (unsigned)xr[tid + 512] << 16);
        const float rstd = 1.0f / sqrtf(blk_sum(x0 * x0 + x1 * x1, red, tid) * (1.f / 1024.f) + 1e-6f);
        const float h0 = x0 * rstd * a.in[25][tid], h1 = x1 * rstd * a.in[25][tid + 512];
        hf[tid] = h0; hf[tid + 512] = h1; hb[tid] = __builtin_bit_cast(float, f2bf(h0) << 16); hb[tid + 512] = __builtin_bit_cast(float, f2bf(h1) << 16);
        __syncthreads();
        if (tid < 36) { float s = 0.f; for (int k = 0; k < 1024; ++k) s += hf[k] * (tid < 32 ? a.in[28][k * 32 + tid] : a.in[26][k * 4 + (tid - 32)]); lg[tid] = s + (tid < 32 ? a.in[29][tid] : a.in[27][tid - 32]); }
        __syncthreads();
        if (tid == 0) { int gi = 0; for (int j = 1; j < 4; ++j) if (lg[32 + j] > lg[32 + gi]) gi = j;
            int i1 = 0; for (int j = 1; j < 8; ++j) if (lg[gi * 8 + j] > lg[gi * 8 + i1]) i1 = j;
            int i2 = -1; for (int j = 0; j < 8; ++j) if (j != i1 && (i2 < 0 || lg[gi * 8 + j] > lg[gi * 8 + i2])) i2 = j;
            sel[0] = gi * 8 + i1; sel[1] = gi * 8 + i2; }
        __syncthreads();
        if (sel[0] != toke[t * 2] || sel[1] != toke[t * 2 + 1]) mism++;
        float o0 = 0.f, o1 = 0.f;
        for (int kx = 0; kx < 2; ++kx) { const int e = toke[t * 2 + kx]; const float w = tokw[t * 2 + kx];
            const float* Wg = a.in[30] + (size_t)e * 1024 * 512; const float* Wu = a.in[31] + (size_t)e * 1024 * 512; const float* Wd = a.in[32] + (size_t)e * 512 * 1024;
            float gg = 0.f, uu = 0.f; for (int k = 0; k < 1024; ++k) { const float hk = hb[k]; gg += hk * Wg[(size_t)k * 512 + tid]; uu += hk * Wu[(size_t)k * 512 + tid]; }
            __syncthreads(); act[tid] = gg / (1.0f + __expf(-gg)) * uu; __syncthreads();
            float s0 = 0.f, s1 = 0.f; for (int f = 0; f < 512; ++f) { const float af = act[f]; s0 += af * Wd[(size_t)f * 1024 + tid]; s1 += af * Wd[(size_t)f * 1024 + tid + 512]; }
            o0 += s0 * w; o1 += s1 * w; }
        const int pa = pos[t * 2], pb = pos[t * 2 + 1];
        const float m0 = __builtin_bit_cast(float, (unsigned)y2[(size_t)pa * 1024 + tid] << 16) + __builtin_bit_cast(float, (unsigned)y2[(size_t)pb * 1024 + tid] << 16);
        const float m1 = __builtin_bit_cast(float, (unsigned)y2[(size_t)pa * 1024 + tid + 512] << 16) + __builtin_bit_cast(float, (unsigned)y2[(size_t)pb * 1024 + tid + 512] << 16);
        errsum += (m0 - o0) * (m0 - o0) + (m1 - o1) * (m1 - o1); refsum += o0 * o0 + o1 * o1;
    }
    const float es = blk_sum(errsum, red, tid), rs = blk_sum(refsum, red, tid);
    if (tid == 0) *res = (PROBE_PHASE == 200) ? sqrtf(es / rs) : (float)mism / 24.f;
}
#endif

#ifndef PROBE_KAPPA
#define PROBE_KAPPA 0
#endif
#ifndef CHK_S0
#define CHK_S0 0
#define CHK_SN 4096
#endif
#if defined(PROBE_PHASE) && (PROBE_PHASE == 210 || PROBE_PHASE == 211 || PROBE_PHASE == 215)
__device__ __forceinline__ void check_attn(const Args& a, LAS unsigned char* lds, int tid, float* res) {
    unsigned char* ws = a.ws;
    const bf16* vt = (const bf16*)(ws + WS_VT);
    const bf16* odf = (const bf16*)((unsigned char*)a.out + OUT_ORWDF) + 512;
    LAS float* sc = (LAS float*)lds; LAS float* part = sc + 4096; LAS float* oc = part + 512; LAS float* red = oc + 256;
    const float d1 = wave_sum(a.in[17][tid & 63] * a.in[18][tid & 63]), d2 = wave_sum(a.in[19][tid & 63] * a.in[20][tid & 63]);
    const float lam = __expf(d1) - __expf(d2) + LAM_INIT;
    float errsum = 0.f, refsum = 0.f;
    for (int si = 0; si < 24; ++si) { const int b = si & 7, head = (PROBE_PHASE == 215) ? 0 : ((si >> 1) & 3), s = CHK_S0 + ((si * 977 + 31 * (si & 3)) % CHK_SN);
        for (int c = 0; c < 2; ++c) { const int vh = b * 8 + head * 2 + c;
            const bf16* qn = qn_ptr(ws, b); const bf16* kn = kn_ptr(ws, b); const bf16* qp = qn + ((size_t)(vh & 7) * SEQ + s) * 64; float mx = -3e38f;
            for (int j = tid; j <= s; j += NTHR) { const bf16* kp = kn + ((size_t)(vh & 7) * SEQ + j) * 64; float d = 0.f;
                for (int e = 0; e < 64; ++e) d += __builtin_bit_cast(float, (unsigned)qp[e] << 16) * __builtin_bit_cast(float, (unsigned)kp[e] << 16);
                sc[j] = d; mx = fmaxf(mx, d); }
            __syncthreads();
            for (int o = 1; o < 64; o <<= 1) mx = fmaxf(mx, __shfl_xor(mx, o));
            if ((tid & 63) == 0) red[tid >> 6] = mx;
            __syncthreads();
            mx = red[0]; for (int i = 1; i < 8; ++i) mx = fmaxf(mx, red[i]);
            __syncthreads();
            float ls = 0.f;
            for (int j = tid; j <= s; j += NTHR) { const float p = exp2f(sc[j] - mx); sc[j] = p; ls += p; }
            ls = wave_sum(ls); if ((tid & 63) == 0) red[tid >> 6] = ls;
            __syncthreads();
            float l = 0.f; for (int i = 0; i < 8; ++i) l += red[i];
            { const int dv = tid & 127, pr = tid >> 7; const bf16* vp = vt + (size_t)(head * 128 + dv) * T + (size_t)b * SEQ; float acc = 0.f;
              for (int j = pr; j <= s; j += 4) acc += sc[j] * __builtin_bit_cast(float, (unsigned)vp[j] << 16);
              part[tid] = acc; }
            __syncthreads();
            if (tid < 128) oc[c * 128 + tid] = (part[tid] + part[tid + 128] + part[tid + 256] + part[tid + 384]) / l;
            __syncthreads(); }
#if PROBE_PHASE == 215
        if (tid < 128) { const float ref = oc[tid]; const float got = __builtin_bit_cast(float, (unsigned)((const bf16*)(ws + 496 * MiB))[((size_t)b * SEQ + s) * 128 + tid] << 16); errsum += (PROBE_KAPPA ? got * ref : (got - ref) * (got - ref)); refsum += ref * ref; }
        __syncthreads(); continue;
#endif
        float dd = 0.f, sq = 0.f; if (tid < 128) { dd = oc[tid] - lam * oc[128 + tid]; sq = dd * dd; }
        sq = wave_sum(sq); __syncthreads(); if ((tid & 63) == 0) red[tid >> 6] = sq; __syncthreads();
        const float rs = (1.0f / sqrtf((red[0] + red[1]) * (1.f / 128.f) + 1e-6f)) * (1.0f - LAM_INIT);
        if (tid < 128) { const float ref = dd * rs * a.in[21][tid]; const float got = __builtin_bit_cast(float, (unsigned)odf[((size_t)b * SEQ + s) * 1024 + head * 128 + tid] << 16);
            errsum += (got - ref) * (got - ref); refsum += ref * ref; }
        __syncthreads(); }
    errsum = wave_sum(errsum); refsum = wave_sum(refsum);
    __syncthreads(); if ((tid & 63) == 0) { red[tid >> 6] = errsum; red[8 + (tid >> 6)] = refsum; } __syncthreads();
    if (tid == 0) *res = PROBE_KAPPA ? fabsf((red[0] + red[1]) / (red[8] + red[9])) : sqrtf((red[0] + red[1]) / (red[8] + red[9]));
}
__device__ __forceinline__ void check_scan(const Args& a, LAS unsigned char* lds, int tid, float* res) {
    unsigned char* ws = a.ws; const int b = 1, hd = 3, NS = 384;
    const bf16* rkv = (const bf16*)(ws + WS_RKV); const bf16* E = (const bf16*)(ws + WS_E); const bf16* Aa = (const bf16*)(ws + WS_A); const bf16* Y = y_ptr(a.out, b);
    LAS float* vw = (LAS float*)lds; LAS float* vaa = vw + 64; LAS float* vbb = vaa + 64; LAS float* vkm = vbb + 64; LAS float* vr = vkm + 64; LAS float* vv = vr + 64; LAS float* red = vv + 64;
    const int row = tid >> 3, cg = tid & 7; float st[8]; for (int j = 0; j < 8; ++j) st[j] = 0.f;
    float errsum = 0.f, refsum = 0.f;
    for (int s = 0; s < NS; ++s) { const size_t t = (size_t)b * SEQ + s;
        if (tid < 64) { const int ch = hd * 64 + tid;
            auto ld = [&](size_t tt, int off) { return __builtin_bit_cast(float, (unsigned)rkv[tt * 1536 + off + ch] << 16); };
            const float rc = ld(t, 0), kc = ld(t, 512), vc = ld(t, 1024); const float rp = s ? ld(t - 1, 0) : 0.f, kp = s ? ld(t - 1, 512) : 0.f, vp = s ? ld(t - 1, 1024) : 0.f;
            const float r = rc + (rp - rc) * a.in[4][ch], k = kc + (kp - kc) * a.in[4][512 + ch], v = vc + (vp - vc) * a.in[4][1024 + ch];
            const float e = __builtin_bit_cast(float, (unsigned)E[t * 512 + ch] << 16), av = __builtin_bit_cast(float, (unsigned)Aa[t * 512 + ch] << 16);
            float kk = k * a.in[10][ch]; const float nn = sqrtf(wave_sum(kk * kk)); kk = kk / fmaxf(nn, 1e-12f);
            vw[tid] = expf(-e); vaa[tid] = -kk; vbb[tid] = kk * av; vkm[tid] = k * (1.0f + (av - 1.0f) * a.in[11][ch]); vr[tid] = r; vv[tid] = v; }
        __syncthreads();
        float sa = 0.f; for (int j = 0; j < 8; ++j) sa += st[j] * vaa[cg * 8 + j];
        sa += __shfl_xor(sa, 1); sa += __shfl_xor(sa, 2); sa += __shfl_xor(sa, 4);
        float y = 0.f; for (int j = 0; j < 8; ++j) { const int c = cg * 8 + j; st[j] = st[j] * vw[c] + sa * vbb[c] + vv[row] * vkm[c]; y += st[j] * vr[c]; }
        y += __shfl_xor(y, 1); y += __shfl_xor(y, 2); y += __shfl_xor(y, 4);
        if (cg == 0) { const float got = __builtin_bit_cast(float, (unsigned)Y[(size_t)s * 512 + hd * 64 + row] << 16); errsum += (got - y) * (got - y); refsum += y * y; }
        __syncthreads(); }
    errsum = wave_sum(errsum); refsum = wave_sum(refsum);
    if ((tid & 63) == 0) { red[tid >> 6] = errsum; red[8 + (tid >> 6)] = refsum; } __syncthreads();
    if (tid == 0) { float es = 0.f, rs = 0.f; for (int i = 0; i < 8; ++i) { es += red[i]; rs += red[8 + i]; } *res = sqrtf(es / rs); }
}
#endif
#ifndef MK_N_LAUNCHES
#define MK_N_LAUNCHES 1
#endif
#ifndef SCAN_CHUNKED
#define SCAN_CHUNKED 1
#endif
constexpr int NSCAN = SCAN_CHUNKED ? 64 : 128;
constexpr int NGATE = 256;
constexpr int NPHASE = 15;
__global__ void __launch_bounds__(NTHR, 2) mk_fwd(Args args) {
    extern __shared__ __attribute__((aligned(16))) unsigned char lds_raw[];
    LAS unsigned char* lds = (LAS unsigned char*)lds_raw;
    const int tid = threadIdx.x, lane = tid & 63, wave = __builtin_amdgcn_readfirstlane(tid >> 6);
    const int G = gridDim.x; const int bx = blockIdx.x; const int vcu = (G % 8 == 0) ? (bx % 8) * (G / 8) + bx / 8 : bx;
    unsigned char* ws = args.ws;
    const int lo = args.ph_lo, hi = args.ph_hi;
#ifdef ONLY_PHASE
#define IN(k) ((k) == ONLY_PHASE && lo <= (k) && (k) < hi)
#else
#define IN(k) (lo <= (k) && (k) < hi)
#endif
#if MK_N_LAUNCHES == 1
    volatile LAS unsigned* MISC = (volatile LAS unsigned*)(lds + MISC_OFF);
    for (int u = tid; u < 64; u += NTHR) MISC[u] = 0u;
    __syncthreads();
    XcdBarrier xbar = xcd_barrier_post((unsigned*)(ws + WS_CTL) + CW_BAR, MISC + 8);
    if (lo < 0) { __threadfence(); cg::this_grid().sync(); }
#define SEAM(k) do { if (IN(k) && IN((k) + 1)) xcd_barrier(xbar); } while (0)
#else
#define SEAM(k) do { } while (0)
#endif
#ifdef PROBE_PHASE
    volatile LAS unsigned long long* ptw = (volatile LAS unsigned long long*)(lds + MISC_OFF + 1536);
#define pt0 ptw[0]
#define pt1 ptw[1]
    if (tid == 0) { pt0 = 0ull; pt1 = 0ull; }
#define PB(k) do { if ((k) == PROBE_PHASE && bx == 0 && tid == 0) pt0 = __builtin_amdgcn_s_memrealtime(); } while (0)
#define PE(k) do { if ((k) == PROBE_PHASE && bx == 0 && tid == 0) pt1 = __builtin_amdgcn_s_memrealtime(); } while (0)
#else
#define PB(k) do { } while (0)
#define PE(k) do { } while (0)
#endif
    typedef pg8::bf16_t pbf;
    int K256 = 256, K512 = 512, K1024 = 1024, K2048 = 2048;
    asm volatile("" : "+s"(K256), "+s"(K512), "+s"(K1024), "+s"(K2048));
    PB(0);
    if (IN(0)) { phase0(args, lds, tid, lane, wave, vcu, G); }
    SEAM(0); PE(0);
    PB(1);
    if (IN(1)) {
        { pg8::Gemm g{(const pbf*)(ws + WS_XN), (const pbf*)(ws + WS_WIN), T, 11 * 256, K1024}; pg8::StaticOrder S; S.init(T, 11 * 256, G, bx);
          pg8::EpiProj E{(pbf*)(ws + WS_RKV), (pbf*)(ws + WS_PROJB), (pbf*)(ws + WS_GATES)};
          pg8::gemm_phase<pg8::EpiProj, pg8::StaticOrder, true, true>(lds, g, S, E); }
        { pg8::Gemm g{(const pbf*)(ws + WS_WIN) + (size_t)2816 * 1024, (const pbf*)(ws + WS_XN), 512, T, K1024}; pg8::StaticOrder S; S.init(512, T, G, bx);
          pg8::EpiStore E{(pbf*)(ws + WS_VT), T};
          pg8::gemm_phase<pg8::EpiStore, pg8::StaticOrder, true, true>(lds, g, S, E); }
    }
    SEAM(1); PE(1);
    PB(2);
    if (IN(2)) { phase2(args, lds, tid, vcu, G); }
    SEAM(2); PE(2);
    PB(3);
    if (IN(3)) {
        pg8::Gemm g{(const pbf*)((unsigned char*)args.out + OUT_LA), (const pbf*)(ws + WS_WLORA), T, 1536, K256}; pg8::StaticOrder S; S.init(T, 1536, G, bx);
        pg8::EpiLora E{(pbf*)(ws + WS_E), (pbf*)(ws + WS_A), (pbf*)(ws + WS_G), args.in[5], args.in[7]};
        pg8::gemm_phase<pg8::EpiLora, pg8::StaticOrder, true, true>(lds, g, S, E);
    }
    SEAM(3); PE(3);
    PB(4);
    if (IN(4)) {
        unsigned* qhead = (unsigned*)(ws + WS_CTL) + CW_QUEUE; LAS unsigned* ubox = (LAS unsigned*)(lds + MISC_OFF);
        float* stash = (float*)((unsigned char*)args.out + OUT_STASH) + (size_t)bx * 64 * 512;
        for (;;) {
            __syncthreads();
            if (tid == 0) ubox[0] = atomicAdd(qhead, 1u);
            __syncthreads();
            const int u = (int)ubox[0];
            int oq = 0; asm volatile("" : "+v"(oq)); const int tq = tid + oq;
            if (u >= NSCAN + NGATE + 512 + NTRQ) break;
            if (u >= NSCAN + NGATE + 512) {
                if (tid == 0) { while (__hip_atomic_load(qhead + 1, __ATOMIC_ACQUIRE, __HIP_MEMORY_SCOPE_AGENT) < (unsigned)NGATE) __builtin_amdgcn_s_sleep(8); }
                __syncthreads();
                tr_wgu_qitem(args, lds, (tq & 63), wave, u - (NSCAN + NGATE + 512)); continue; }
#if defined(PROBE_PHASE) && PROBE_PHASE == 100
            if (u < NSCAN) { if (tid == 0) ptw[2] = __builtin_amdgcn_s_memrealtime(); if (SCAN_CHUNKED) scan_unit_chunked(args, lds, tq, u); else scan_unit(args, lds, tq, u);
                if (tid == 0) atomicMax((unsigned*)(ws + WS_CTL) + 96, (unsigned)(__builtin_amdgcn_s_memrealtime() - ptw[2])); }
#else
            if (u < NSCAN) { if (SCAN_CHUNKED) scan_unit_chunked(args, lds, tq, u); else scan_unit(args, lds, tq, u); }
#endif
#if defined(PROBE_PHASE) && PROBE_PHASE == 101
            else if (u < NSCAN + NGATE) { } else { const int au = u - NSCAN - NGATE; const unsigned long long q0 = __builtin_amdgcn_s_memrealtime(); attn_unit(args, lds, tid, (au & 31) >> 2, au & 3, 15 - (au >> 5), stash); const unsigned long long q1 = __builtin_amdgcn_s_memrealtime();
                if (tid == 0) atomicAdd((unsigned*)(ws + WS_CTL) + 96, (unsigned)(q1 - q0)); }
#else
            else if (u < NSCAN + NGATE) { const int it = u - NSCAN;
                pg8::Gemm g{(const pbf*)(ws + WS_XN), (const pbf*)(ws + WS_WIN) + (size_t)3328 * 1024, T, 2048, K1024}; pg8::OrderItem S{it >> 1, (it & 1) * 4, 4};
                pg8::EpiGates E{(pbf*)(ws + WS_GATES)};
                pg8::gemm_phase<pg8::EpiGates, pg8::OrderItem, true, true>(lds, g, S, E, oq);
                __syncthreads(); if (tid == 0) __hip_atomic_fetch_add(qhead + 1, 1u, __ATOMIC_RELEASE, __HIP_MEMORY_SCOPE_AGENT); }
            else { const int au = u - NSCAN - NGATE; attn_unit(args, lds, tq, (au & 31) >> 2, au & 3, 15 - (au >> 5), stash); }
#endif
        }
    }
    SEAM(4); PE(4);
#if defined(PROBE_PHASE) && (PROBE_PHASE == 210 || PROBE_PHASE == 211 || PROBE_PHASE == 215)
    if (bx == 0) { float* res = (float*)(ws + WS_CTL) + 100; if (PROBE_PHASE != 211) check_attn(args, lds, tid, res); else check_scan(args, lds, tid, res); __syncthreads(); if (tid == 0) { pt0 = 0ull; pt1 = (unsigned long long)(*(volatile float*)res * 1.0e6f); } }
    xcd_barrier(xbar);
#endif
#if defined(PROBE_PHASE) && PROBE_PHASE == 100
    if (bx == 0 && tid == 0) { pt0 = 0ull; pt1 = (unsigned long long)__hip_atomic_load((unsigned*)(ws + WS_CTL) + 96, __ATOMIC_RELAXED, __HIP_MEMORY_SCOPE_AGENT); }
#endif
#if defined(PROBE_PHASE) && PROBE_PHASE >= 300 && PROBE_PHASE < 320
    if (bx == 0 && tid == 0) { pt0 = 0ull; pt1 = (unsigned long long)__hip_atomic_load((unsigned*)(ws + WS_CTL) + 96, __ATOMIC_RELAXED, __HIP_MEMORY_SCOPE_AGENT) / 64ull; }
#endif
#if defined(PROBE_PHASE) && PROBE_PHASE == 101
    if (bx == 0 && tid == 0) { pt0 = 0ull; pt1 = (unsigned long long)__hip_atomic_load((unsigned*)(ws + WS_CTL) + 96, __ATOMIC_RELAXED, __HIP_MEMORY_SCOPE_AGENT) / 256ull; }
#endif
    PB(5);
    if (IN(5)) { phase_orw(args, lane, wave, vcu, G); }
    SEAM(5); PE(5);
    PB(6);
    if (IN(6)) {
        pg8::Gemm g{(const pbf*)((unsigned char*)args.out + OUT_ORWDF), (const pbf*)(ws + WS_WBRD), T, 1024, K1024}; pg8::StaticOrder S; S.init(T, 1024, G, bx);
        pg8::EpiMix E{(const pbf*)(ws + WS_GATES), (pbf*)(ws + WS_MIXED)};
        pg8::gemm_phase<pg8::EpiMix, pg8::StaticOrder, true, true>(lds, g, S, E);
    }
    SEAM(6); PE(6);
    PB(7);
    if (IN(7)) {
        pg8::Gemm g{(const pbf*)(ws + WS_MIXED), (const pbf*)(ws + WS_WO), T, 1024, K1024}; pg8::StaticOrder S; S.init(T, 1024, G, bx);
        pg8::EpiRes E{args.in[0], (pbf*)args.out, (float*)(ws + WS_SSQ)};
        pg8::gemm_phase<pg8::EpiRes, pg8::StaticOrder, true, true>(lds, g, S, E);
    }
    SEAM(7); PE(7);
    PB(9);
    if (IN(9)) {
        pg8::Gemm g{(const pbf*)args.out, (const pbf*)(ws + WS_WR), T, 256, K1024}; pg8::StaticOrder S; S.init(T, 256, G, bx);
        pg8::EpiLogits E{(float*)(ws + WS_LOGITS)};
        pg8::gemm_phase<pg8::EpiLogits, pg8::StaticOrder, true, true>(lds, g, S, E);
        VM_WAIT(); __syncthreads();
        pg8::Unit u;
        for (int i = 0; S.next(i, u); ++i) route_tile(args, lds, tid, u.pm);
        { const int j0 = G > 128 ? bx - 128 : bx, nj = G > 128 ? G - 128 : G;
          if (j0 >= 0) { for (int pm = j0; pm < T / 256; pm += nj) { __syncthreads(); pp_tile(args, lds, tid, pm, K256); } } }
    }
    SEAM(9); PE(9);
    PB(10);
    if (IN(10)) { phase9(args, lds, tid, lane, wave);
        if (G <= 128) { __syncthreads(); tr_wd_all(args, lds, lane, wave, bx * NWAVES + wave, G * NWAVES); }
        else if (bx >= 128) tr_wd_all(args, lds, lane, wave, (bx - 128) * NWAVES + wave, (G - 128) * NWAVES); }
    SEAM(10); PE(10);
    PB(11);
    if (IN(11) || IN(12)) {
        const int* disp = (const int*)(ws + WS_DISP); LAS int* tile_e = (LAS int*)(lds + MISC_OFF + 64);
        __syncthreads();
        const int NT = disp[0];
        for (int i = tid; i < NT && i < 320; i += NTHR) tile_e[i] = disp[16 + i];
        __syncthreads();
        if (IN(11)) {
            pg8::Gemm g{(const pbf*)args.out, (const pbf*)(ws + WS_WGU), T, NEXP * 1024, K1024}; pg8::OrderMoeUp S{{NT * 4, G, bx, tile_e}, (unsigned*)(ws + WS_CTL) + CW_MOECNT};
            pg8::EpiAct E{(pbf*)(ws + WS_ACT), (const float*)(ws + WS_ROWRS)};
            pg8::gemm_phase_gather<pg8::EpiAct, pg8::OrderMoeUp>(lds, g, (const int*)(ws + WS_ROWTOK), S, E);
        }
        PE(11); PB(12);
        if (IN(12)) {
            pg8::Gemm g{(const pbf*)(ws + WS_ACT), (const pbf*)(ws + WS_WD), MAXROWS, NEXP * 1024, K512}; pg8::OrderMoeDown S{{NT * 4, G, G - 1 - bx, tile_e}, (unsigned*)(ws + WS_CTL) + CW_MOECNT};
            pg8::EpiDown E{(pbf*)(ws + WS_Y2), (const float*)(ws + WS_ROWW)};
            pg8::gemm_phase<pg8::EpiDown, pg8::OrderMoeDown, true, true>(lds, g, S, E);
        }
    }
    SEAM(12); PE(12);
#if defined(PROBE_PHASE) && (PROBE_PHASE == 200 || PROBE_PHASE == 201)
    if (bx == 0) { float* res = (float*)(ws + WS_CTL) + 100; check_moe(args, lds, tid, res); __syncthreads(); if (tid == 0) { pt0 = 0ull; pt1 = (unsigned long long)(*(volatile float*)res * 1.0e6f); } }
    xcd_barrier(xbar);
#endif
    PB(13);
    if (IN(13)) { phase12(args, tid, lane, wave, vcu, G); }
    SEAM(13); PE(13);
    PB(14);
    if (IN(14)) {
        { pg8::Gemm g{(const pbf*)(ws + WS_X2), (const pbf*)(ws + WS_WPG), T, 1024, K1024}; pg8::StaticOrder S; S.init(T, 1024, G, bx);
          pg8::EpiFinal E{(const pbf*)(ws + WS_PP), (const pbf*)(ws + WS_X2), args.out, (const float*)(ws + WS_RS)};
          pg8::gemm_phase<pg8::EpiFinal, pg8::StaticOrder, true, true>(lds, g, S, E); }
    }
#ifdef PROBE_PHASE
    if (PROBE_PHASE == 14 && bx == 0 && tid == 0) { pt1 = __builtin_amdgcn_s_memrealtime(); }
    if (bx == 0 && tid == 0) { const unsigned long long te = __builtin_amdgcn_s_memrealtime(), w = (unsigned long long)PROBE_MULT * (pt1 - pt0);
        while (__builtin_amdgcn_s_memrealtime() - te < w) __builtin_amdgcn_s_sleep(32); }
#endif
#undef IN
#undef SEAM
}

extern "C" void kernel_launch(void* const* d_in, const int* in_sizes, int n_in, void* d_out, int out_size, void* d_ws, size_t ws_size, hipStream_t stream) {
    static int grid = 0;
    if (grid == 0) {
        if (n_in != 36 || in_sizes[0] != T * DM || out_size != T * DM || ws_size < WS_END) {
            fprintf(stderr, "kernel_launch: unexpected problem: n_in %d in0 %d out %d ws %zu (need %zu)\n", n_in, n_in > 0 ? in_sizes[0] : -1, out_size, ws_size, (size_t)WS_END); grid = -1; return; }
        int dev = 0, cus = 0, per_cu = 0;
        if (hipGetDevice(&dev) != hipSuccess || hipDeviceGetAttribute(&cus, hipDeviceAttributeMultiprocessorCount, dev) != hipSuccess) { grid = -1; return; }
        if (hipFuncSetAttribute((const void*)mk_fwd, hipFuncAttributeMaxDynamicSharedMemorySize, LDS_BYTES) != hipSuccess) { fprintf(stderr, "kernel_launch: hipFuncSetAttribute failed\n"); grid = -1; return; }
        if (hipOccupancyMaxActiveBlocksPerMultiprocessor(&per_cu, (const void*)mk_fwd, NTHR, LDS_BYTES) != hipSuccess || per_cu < 1) { fprintf(stderr, "kernel_launch: occupancy query says %d blocks per CU\n", per_cu); (void)hipGetLastError(); grid = -1; return; }
        grid = cus;
        if (grid > 256) grid = 256;
    }
    if (grid < 0) return;
    (void)hipMemsetAsync((char*)d_ws + WS_CTL, 0, CTL_ZERO_BYTES, stream);
    Args a{};
    for (int i = 0; i < 36; ++i) a.in[i] = (const float*)d_in[i];
    a.out = (float*)d_out; a.ws = (unsigned char*)d_ws;
#if MK_N_LAUNCHES == 1
    a.ph_lo = 0; a.ph_hi = NPHASE;
    void* kargs[] = {&a};
    const hipError_t e = hipLaunchCooperativeKernel((const void*)mk_fwd, dim3(grid), dim3(NTHR), kargs, LDS_BYTES, stream);
    if (e != hipSuccess) fprintf(stderr, "kernel_launch: cooperative launch failed: %s (grid %d)\n", hipGetErrorString(e), grid);
#else
    for (int ph = 0; ph < NPHASE; ++ph) { a.ph_lo = ph; a.ph_hi = ph + 1; hipLaunchKernelGGL(mk_fwd, dim3(grid), dim3(NTHR), LDS_BYTES, stream, a); }
#endif
}
```

```cpp
#include <hip/hip_runtime.h>
#include <hip/hip_cooperative_groups.h>
#include <cstdio>
#include <cstdint>
namespace cg = cooperative_groups;
namespace pg8 {
#define PG8_LAS __attribute__((address_space(3)))
typedef unsigned short bf16_t;
typedef short bf16x8 __attribute__((ext_vector_type(8)));
typedef float f32x4 __attribute__((ext_vector_type(4)));
typedef unsigned u32x4 __attribute__((ext_vector_type(4)));
constexpr int BM = 256, BK = 64, HALF = 128, HTB = HALF * BK * 2  , STAGE_BYTES = 8 * HTB, NXCD = 8, WGM = 8;

__host__ __device__ __forceinline__ int lds_byte(int r, int c) { const int st = (r >> 4) * 2 + (c >> 5), rr = r & 15, cc = c & 31, ob = rr * 64 + cc * 2; return st * 1024 + (ob ^ (((ob >> 9) & 1) << 5)); }
__host__ __device__ __forceinline__ void stage_rc(int b, int& R, int& C) { const int st = b / 1024, sb = b % 1024, swz = sb ^ (((sb >> 9) & 1) << 5); R = (st >> 1) * 16 + swz / 64; C = (st & 1) * 32 + (swz % 64) / 2; }
__host__ __device__ __forceinline__ int perm32(int rho) { const int n = rho >> 4, i = rho & 15; return 8 * (i >> 2) + 4 * n + (i & 3); }

struct Unit { int pm, pn; };
struct Gemm { const bf16_t* A; const bf16_t* Bt; int M, N, K; };

struct StaticOrder {
    int nM, nN, nwg, G, c;
    __host__ __device__ __forceinline__ void init(int M, int N, int G_, int c_) { nM = M / BM; nN = N / BM; nwg = nM * nN; G = G_; c = c_; }
    __host__ __device__ __forceinline__ bool next(int i, Unit& u) const {
        const long L = (long)i * G + c; if (L >= nwg) return false;
        int wgid = (int)L; { const int q = nwg / NXCD, r = nwg % NXCD, xcd = wgid % NXCD, off = wgid / NXCD; wgid = (xcd < r ? xcd * (q + 1) : r * (q + 1) + (xcd - r) * q) + off; }
        const int nig = WGM * nN, gid = wgid / nig, fm = gid * WGM, gsz = (nM - fm) < WGM ? (nM - fm) : WGM;
        u.pm = fm + ((wgid % nig) % gsz); u.pn = (wgid % nig) / gsz; return true;
    }
    __device__ __forceinline__ void a_ready(const Unit&) const {}
    __device__ __forceinline__ void done(const Unit&) const {}
};

__device__ __forceinline__ unsigned cvt_pk_bf16(float lo, float hi) { unsigned r; asm volatile("v_cvt_pk_bf16_f32 %0, %1, %2" : "=v"(r) : "v"(lo), "v"(hi)); return r; }
template <class Epi, class Sched, bool ALIGN_EPI = false, bool SP2 = false>
__device__ __forceinline__ void gemm_phase(PG8_LAS unsigned char* lds, const Gemm g, const Sched& S, const Epi& E, const int tid_in  ) {
    const int tid = tid_in, wid = __builtin_amdgcn_readfirstlane(tid >> 6), lane = tid & 63, wr = wid >> 2, wc = wid & 3, fr = lane & 15, fq = lane >> 4;
    const int K = g.K, nt = K / BK;
    unsigned voffA[2], voffB[2];
#pragma unroll
    for (int i = 0; i < 2; ++i) { int R, C; stage_rc(tid * 16 + i * 8192, R, C); const int Rb = Epi::PERM ? ((R & ~31) + perm32(R & 31)) : R;
        voffA[i] = (unsigned)(R * K + C) * 2u; voffB[i] = (unsigned)(Rb * K + C) * 2u; }
    const size_t kstep = (size_t)(BK * 2);
    const size_t hstep = (size_t)HALF * K * 2;
    const size_t tstep = 2 * hstep;
    const unsigned ldsw = (unsigned)wid * 1024u;
    const int aoff = lds_byte(wr * 64 + fr, fq * 8), boff = lds_byte(wc * 32 + fr, fq * 8);
#define PG8_SA(b, h) (((b) * 2 + (h)) * HTB)
#define PG8_SB(b, h) ((4 + (b) * 2 + (h)) * HTB)
#define PG8_STAGE(bufoff, gbase, voff) do { _Pragma("unroll") for (int _i = 0; _i < 2; ++_i) \
        __builtin_amdgcn_global_load_lds((const unsigned*)((const char*)(gbase) + (voff)[_i]), (PG8_LAS unsigned*)(lds + (bufoff) + ldsw + _i * 8192), 16, 0, 0); } while (0)
#define PG8_LDA(dst, b, h) do { _Pragma("unroll") for (int m = 0; m < 4; ++m) _Pragma("unroll") for (int k = 0; k < 2; ++k) dst[m][k] = *(const PG8_LAS bf16x8*)(lds + PG8_SA(b, h) + aoff + m * 2048 + k * 1024); } while (0)
#define PG8_LDB(dst, b, h) do { _Pragma("unroll") for (int n = 0; n < 2; ++n) _Pragma("unroll") for (int k = 0; k < 2; ++k) dst[n][k] = *(const PG8_LAS bf16x8*)(lds + PG8_SB(b, h) + boff + n * 2048 + k * 1024); } while (0)
#define PG8_MMA(ai, bj, At, Bt) do { __builtin_amdgcn_s_setprio(1); _Pragma("unroll") for (int m = 0; m < 4; ++m) _Pragma("unroll") for (int n = 0; n < 2; ++n) _Pragma("unroll") for (int k = 0; k < 2; ++k) \
        acc[ai][bj][m][n] = __builtin_amdgcn_mfma_f32_16x16x32_bf16(Bt[n][k], At[m][k], acc[ai][bj][m][n], 0, 0, 0); __builtin_amdgcn_s_setprio(0); } while (0)
#define PG8_WAIT_V(n) asm volatile("s_waitcnt vmcnt(" #n ")" ::: "memory")
#define PG8_WAIT_L(n) asm volatile("s_waitcnt lgkmcnt(" #n ")" ::: "memory")
#define PG8_BAR __builtin_amdgcn_s_barrier()
#define PG8_SCHED __builtin_amdgcn_sched_barrier(0)
    Unit cur, nxt; int ui = 0;
    if (!S.next(0, cur)) return;
    f32x4 acc[2][2][4][2];
#pragma unroll
    for (int a = 0; a < 2; ++a)
#pragma unroll
        for (int b = 0; b < 2; ++b)
#pragma unroll
            for (int m = 0; m < 4; ++m)
#pragma unroll
                for (int n = 0; n < 2; ++n) acc[a][b][m][n] = (f32x4){0.f, 0.f, 0.f, 0.f};
    bf16x8 At[4][2], B0[2][2], B1[2][2];
    const char* cA = (const char*)g.A + (size_t)cur.pm * tstep; const char* cB = (const char*)g.Bt + (size_t)cur.pn * tstep;
    S.a_ready(cur);
    if constexpr (SP2) {
        PG8_STAGE(PG8_SB(0, 0), cB, voffB); PG8_STAGE(PG8_SB(0, 1), cB + hstep, voffB); PG8_STAGE(PG8_SA(0, 0), cA, voffA); PG8_STAGE(PG8_SA(0, 1), cA + hstep, voffA);
        if (wr == 1) PG8_BAR;
        PG8_WAIT_V(2); PG8_BAR;
        PG8_STAGE(PG8_SB(1, 0), cB + kstep, voffB); PG8_STAGE(PG8_SA(1, 0), cA + kstep, voffA); PG8_STAGE(PG8_SB(1, 1), cB + hstep + kstep, voffB);
        PG8_WAIT_V(6); PG8_BAR;
    } else {
        PG8_STAGE(PG8_SB(0, 0), cB, voffB); PG8_STAGE(PG8_SA(0, 0), cA, voffA); PG8_STAGE(PG8_SB(0, 1), cB + hstep, voffB); PG8_STAGE(PG8_SA(0, 1), cA + hstep, voffA);
        if (wr == 1) PG8_BAR;
        PG8_WAIT_V(4); PG8_BAR;
        PG8_STAGE(PG8_SB(1, 0), cB + kstep, voffB); PG8_STAGE(PG8_SA(1, 0), cA + kstep, voffA); PG8_STAGE(PG8_SB(1, 1), cB + hstep + kstep, voffB);
        PG8_WAIT_V(6); PG8_BAR;
    }
    for (;;) {
        const bool has_next = S.next(ui + 1, nxt);
        const char* nA = has_next ? (const char*)g.A + (size_t)nxt.pm * tstep : cA; const char* nB = has_next ? (const char*)g.Bt + (size_t)nxt.pn * tstep : cB;
        for (int t = 0; t < nt; t += 2) {
            if constexpr (Epi::HAS_MID) { if (t == (nt >> 1)) E.mid(acc, cur, wr, wc, fr, fq); }
            const bool last = (t == nt - 2);
            const char* a1 = cA + (size_t)(t + 1) * kstep;
            const char* a2 = last ? nA : cA + (size_t)(t + 2) * kstep; const char* b2 = last ? nB : cB + (size_t)(t + 2) * kstep;
            const char* a3 = a2 + kstep; const char* b3 = b2 + kstep;
            if (last && has_next) S.a_ready(nxt);
            if constexpr (SP2) {
            PG8_LDB(B0, 0, 0); PG8_LDB(B1, 0, 1); PG8_SCHED; PG8_LDA(At, 0, 0); PG8_STAGE(PG8_SA(1, 1), a1 + hstep, voffA);
            PG8_WAIT_V(8); PG8_WAIT_L(0); PG8_BAR; PG8_MMA(0, 0, At, B0); PG8_MMA(0, 1, At, B1); PG8_BAR; PG8_SCHED;
            PG8_LDA(At, 0, 1); PG8_STAGE(PG8_SB(0, 0), b2, voffB); PG8_STAGE(PG8_SB(0, 1), b2 + hstep, voffB); PG8_STAGE(PG8_SA(0, 0), a2, voffA);
            PG8_WAIT_V(8); PG8_WAIT_L(0); PG8_BAR; PG8_MMA(1, 0, At, B0); PG8_MMA(1, 1, At, B1); PG8_BAR; PG8_SCHED;
            PG8_LDB(B0, 1, 0); PG8_LDB(B1, 1, 1); PG8_SCHED; PG8_LDA(At, 1, 0); PG8_STAGE(PG8_SA(0, 1), a2 + hstep, voffA);
            PG8_WAIT_V(8); PG8_WAIT_L(0); PG8_BAR; PG8_MMA(0, 0, At, B0); PG8_MMA(0, 1, At, B1); PG8_BAR; PG8_SCHED;
            PG8_LDA(At, 1, 1); PG8_STAGE(PG8_SB(1, 0), b3, voffB); PG8_STAGE(PG8_SB(1, 1), b3 + hstep, voffB); PG8_STAGE(PG8_SA(1, 0), a3, voffA);
            PG8_WAIT_V(8); PG8_WAIT_L(0); PG8_BAR; PG8_MMA(1, 0, At, B0); PG8_MMA(1, 1, At, B1); PG8_BAR; PG8_SCHED;
            } else {
            PG8_LDB(B0, 0, 0); PG8_SCHED; PG8_LDA(At, 0, 0); PG8_STAGE(PG8_SA(1, 1), a1 + hstep, voffA);
            PG8_WAIT_L(8); PG8_BAR; PG8_WAIT_L(0); PG8_MMA(0, 0, At, B0); PG8_BAR; PG8_SCHED;
            PG8_LDB(B1, 0, 1); PG8_STAGE(PG8_SB(0, 0), b2, voffB);
            PG8_BAR; PG8_WAIT_L(0); PG8_MMA(0, 1, At, B1); PG8_BAR;
            PG8_LDA(At, 0, 1); PG8_STAGE(PG8_SA(0, 0), a2, voffA);
            PG8_BAR; PG8_WAIT_L(0); PG8_MMA(1, 0, At, B0); PG8_BAR; PG8_SCHED;
            PG8_STAGE(PG8_SB(0, 1), b2 + hstep, voffB);
            PG8_WAIT_V(6); PG8_BAR; PG8_MMA(1, 1, At, B1); PG8_BAR;
            PG8_LDB(B0, 1, 0); PG8_SCHED; PG8_LDA(At, 1, 0); PG8_STAGE(PG8_SA(0, 1), a2 + hstep, voffA);
            PG8_WAIT_L(8); PG8_BAR; PG8_WAIT_L(0); PG8_MMA(0, 0, At, B0); PG8_BAR; PG8_SCHED;
            PG8_LDB(B1, 1, 1); PG8_STAGE(PG8_SB(1, 0), b3, voffB);
            PG8_BAR; PG8_WAIT_L(0); PG8_MMA(0, 1, At, B1); PG8_BAR;
            PG8_LDA(At, 1, 1); PG8_STAGE(PG8_SA(1, 0), a3, voffA);
            PG8_BAR; PG8_WAIT_L(0); PG8_MMA(1, 0, At, B0); PG8_BAR; PG8_SCHED;
            PG8_STAGE(PG8_SB(1, 1), b3 + hstep, voffB);
            PG8_WAIT_V(6); PG8_BAR; PG8_MMA(1, 1, At, B1); PG8_BAR;
            }
        }
        if constexpr (ALIGN_EPI) { if (wr == 0) PG8_BAR; }
        if constexpr (!Epi::AFTER_DRAIN) { E(acc, cur, wr, wc, fr, fq); S.done(cur); }
        if (!has_next) break;
#pragma unroll
        for (int a = 0; a < 2; ++a)
#pragma unroll
            for (int b = 0; b < 2; ++b)
#pragma unroll
                for (int m = 0; m < 4; ++m)
#pragma unroll
                    for (int n = 0; n < 2; ++n) acc[a][b][m][n] = (f32x4){0.f, 0.f, 0.f, 0.f};
        cur = nxt; cA = nA; cB = nB; ++ui;
        if constexpr (ALIGN_EPI) { if (wr == 1) PG8_BAR; }
    }
    PG8_WAIT_V(0);
    if constexpr (!ALIGN_EPI) { if (wr == 0) PG8_BAR; }
    PG8_BAR;
    if constexpr (Epi::AFTER_DRAIN) { E.fused(acc, cur, wr, wc, fr, fq, lds, wid, lane); S.done(cur); }
#undef PG8_SA
#undef PG8_SB
#undef PG8_STAGE
#undef PG8_LDA
#undef PG8_LDB
#undef PG8_MMA
#undef PG8_WAIT_V
#undef PG8_WAIT_L
#undef PG8_BAR
#undef PG8_SCHED
}
template <class Epi, class Sched>
__device__ __forceinline__ void gemm_phase_gather(PG8_LAS unsigned char* lds, const Gemm g, const int* idx, const Sched& S, const Epi& E, const int tid_in  ) {
    const int tid = tid_in, wid = __builtin_amdgcn_readfirstlane(tid >> 6), lane = tid & 63, wr = wid >> 2, wc = wid & 3, fr = lane & 15, fq = lane >> 4;
    const int K = g.K, nt = K / BK;
    unsigned voffA[2], voffB[2];
    int rowA[2];
#pragma unroll
    for (int i = 0; i < 2; ++i) { int R, C; stage_rc(tid * 16 + i * 8192, R, C); const int Rb = Epi::PERM ? ((R & ~31) + perm32(R & 31)) : R;
        voffA[i] = (unsigned)C * 2u; rowA[i] = R; voffB[i] = (unsigned)(Rb * K + C) * 2u; }
    unsigned vA0[2], vA1[2], vN0[2], vN1[2];
#define PG8_GOFF(dst0, dst1, pm_) do { _Pragma("unroll") for (int _i = 0; _i < 2; ++_i) { dst0[_i] = (unsigned)idx[(pm_) * BM + rowA[_i]] * (unsigned)(K * 2) + voffA[_i]; dst1[_i] = (unsigned)idx[(pm_) * BM + HALF + rowA[_i]] * (unsigned)(K * 2) + voffA[_i]; } } while (0)
    const size_t kstep = (size_t)(BK * 2);
    const size_t hstep = (size_t)HALF * K * 2;
    const size_t tstep = 2 * hstep;
    const unsigned ldsw = (unsigned)wid * 1024u;
    const int aoff = lds_byte(wr * 64 + fr, fq * 8), boff = lds_byte(wc * 32 + fr, fq * 8);
#define PG8_SA(b, h) (((b) * 2 + (h)) * HTB)
#define PG8_SB(b, h) ((4 + (b) * 2 + (h)) * HTB)
#define PG8_STAGE(bufoff, gbase, voff) do { _Pragma("unroll") for (int _i = 0; _i < 2; ++_i) \
        __builtin_amdgcn_global_load_lds((const unsigned*)((const char*)(gbase) + (voff)[_i]), (PG8_LAS unsigned*)(lds + (bufoff) + ldsw + _i * 8192), 16, 0, 0); } while (0)
#define PG8_LDA(dst, b, h) do { _Pragma("unroll") for (int m = 0; m < 4; ++m) _Pragma("unroll") for (int k = 0; k < 2; ++k) dst[m][k] = *(const PG8_LAS bf16x8*)(lds + PG8_SA(b, h) + aoff + m * 2048 + k * 1024); } while (0)
#define PG8_LDB(dst, b, h) do { _Pragma("unroll") for (int n = 0; n < 2; ++n) _Pragma("unroll") for (int k = 0; k < 2; ++k) dst[n][k] = *(const PG8_LAS bf16x8*)(lds + PG8_SB(b, h) + boff + n * 2048 + k * 1024); } while (0)
#define PG8_MMA(ai, bj, At, Bt) do { __builtin_amdgcn_s_setprio(1); _Pragma("unroll") for (int m = 0; m < 4; ++m) _Pragma("unroll") for (int n = 0; n < 2; ++n) _Pragma("unroll") for (int k = 0; k < 2; ++k) \
        acc[ai][bj][m][n] = __builtin_amdgcn_mfma_f32_16x16x32_bf16(Bt[n][k], At[m][k], acc[ai][bj][m][n], 0, 0, 0); __builtin_amdgcn_s_setprio(0); } while (0)
#define PG8_WAIT_V(n) asm volatile("s_waitcnt vmcnt(" #n ")" ::: "memory")
#define PG8_WAIT_L(n) asm volatile("s_waitcnt lgkmcnt(" #n ")" ::: "memory")
#define PG8_BAR __builtin_amdgcn_s_barrier()
#define PG8_SCHED __builtin_amdgcn_sched_barrier(0)
    Unit cur, nxt; int ui = 0;
    if (!S.next(0, cur)) return;
    f32x4 acc[2][2][4][2];
#pragma unroll
    for (int a = 0; a < 2; ++a)
#pragma unroll
        for (int b = 0; b < 2; ++b)
#pragma unroll
            for (int m = 0; m < 4; ++m)
#pragma unroll
                for (int n = 0; n < 2; ++n) acc[a][b][m][n] = (f32x4){0.f, 0.f, 0.f, 0.f};
    bf16x8 At[4][2], B0[2][2], B1[2][2];
    const char* cA = (const char*)g.A; PG8_GOFF(vA0, vA1, cur.pm); const char* cB = (const char*)g.Bt + (size_t)cur.pn * tstep;
    S.a_ready(cur);
    if constexpr (true) {
        PG8_STAGE(PG8_SB(0, 0), cB, voffB); PG8_STAGE(PG8_SB(0, 1), cB + hstep, voffB); PG8_STAGE(PG8_SA(0, 0), cA, vA0); PG8_STAGE(PG8_SA(0, 1), cA, vA1);
        if (wr == 1) PG8_BAR;
        PG8_WAIT_V(2); PG8_BAR;
        PG8_STAGE(PG8_SB(1, 0), cB + kstep, voffB); PG8_STAGE(PG8_SA(1, 0), cA + kstep, vA0); PG8_STAGE(PG8_SB(1, 1), cB + hstep + kstep, voffB);
        PG8_WAIT_V(6); PG8_BAR;
    } else {
        PG8_STAGE(PG8_SB(0, 0), cB, voffB); PG8_STAGE(PG8_SA(0, 0), cA, voffA); PG8_STAGE(PG8_SB(0, 1), cB + hstep, voffB); PG8_STAGE(PG8_SA(0, 1), cA + hstep, voffA);
        if (wr == 1) PG8_BAR;
        PG8_WAIT_V(4); PG8_BAR;
        PG8_STAGE(PG8_SB(1, 0), cB + kstep, voffB); PG8_STAGE(PG8_SA(1, 0), cA + kstep, vA0); PG8_STAGE(PG8_SB(1, 1), cB + hstep + kstep, voffB);
        PG8_WAIT_V(6); PG8_BAR;
    }
    for (;;) {
        const bool has_next = S.next(ui + 1, nxt);
        const char* nA = cA; if (has_next) PG8_GOFF(vN0, vN1, nxt.pm); else { vN0[0] = vA0[0]; vN0[1] = vA0[1]; vN1[0] = vA1[0]; vN1[1] = vA1[1]; } const char* nB = has_next ? (const char*)g.Bt + (size_t)nxt.pn * tstep : cB;
        for (int t = 0; t < nt; t += 2) {
            if constexpr (Epi::HAS_MID) { if (t == (nt >> 1)) E.mid(acc, cur, wr, wc, fr, fq); }
            const bool last = (t == nt - 2);
            const char* a1 = cA + (size_t)(t + 1) * kstep;
            const char* a2 = last ? nA : cA + (size_t)(t + 2) * kstep; unsigned x0[2], x1[2]; x0[0] = last ? vN0[0] : vA0[0]; x0[1] = last ? vN0[1] : vA0[1]; x1[0] = last ? vN1[0] : vA1[0]; x1[1] = last ? vN1[1] : vA1[1]; const char* b2 = last ? nB : cB + (size_t)(t + 2) * kstep;
            const char* a3 = a2 + kstep; const char* b3 = b2 + kstep;
            if (last && has_next) S.a_ready(nxt);
            if constexpr (true) {
            PG8_LDB(B0, 0, 0); PG8_LDB(B1, 0, 1); PG8_SCHED; PG8_LDA(At, 0, 0); PG8_STAGE(PG8_SA(1, 1), a1, vA1);
            PG8_WAIT_V(8); PG8_WAIT_L(0); PG8_BAR; PG8_MMA(0, 0, At, B0); PG8_MMA(0, 1, At, B1); PG8_BAR; PG8_SCHED;
            PG8_LDA(At, 0, 1); PG8_STAGE(PG8_SB(0, 0), b2, voffB); PG8_STAGE(PG8_SB(0, 1), b2 + hstep, voffB); PG8_STAGE(PG8_SA(0, 0), a2, x0);
            PG8_WAIT_V(8); PG8_WAIT_L(0); PG8_BAR; PG8_MMA(1, 0, At, B0); PG8_MMA(1, 1, At, B1); PG8_BAR; PG8_SCHED;
            PG8_LDB(B0, 1, 0); PG8_LDB(B1, 1, 1); PG8_SCHED; PG8_LDA(At, 1, 0); PG8_STAGE(PG8_SA(0, 1), a2, x1);
            PG8_WAIT_V(8); PG8_WAIT_L(0); PG8_BAR; PG8_MMA(0, 0, At, B0); PG8_MMA(0, 1, At, B1); PG8_BAR; PG8_SCHED;
            PG8_LDA(At, 1, 1); PG8_STAGE(PG8_SB(1, 0), b3, voffB); PG8_STAGE(PG8_SB(1, 1), b3 + hstep, voffB); PG8_STAGE(PG8_SA(1, 0), a3, x0);
            PG8_WAIT_V(8); PG8_WAIT_L(0); PG8_BAR; PG8_MMA(1, 0, At, B0); PG8_MMA(1, 1, At, B1); PG8_BAR; PG8_SCHED;
            } else {
            PG8_LDB(B0, 0, 0); PG8_SCHED; PG8_LDA(At, 0, 0); PG8_STAGE(PG8_SA(1, 1), a1, vA1);
            PG8_WAIT_L(8); PG8_BAR; PG8_WAIT_L(0); PG8_MMA(0, 0, At, B0); PG8_BAR; PG8_SCHED;
            PG8_LDB(B1, 0, 1); PG8_STAGE(PG8_SB(0, 0), b2, voffB);
            PG8_BAR; PG8_WAIT_L(0); PG8_MMA(0, 1, At, B1); PG8_BAR;
            PG8_LDA(At, 0, 1); PG8_STAGE(PG8_SA(0, 0), a2, x0);
            PG8_BAR; PG8_WAIT_L(0); PG8_MMA(1, 0, At, B0); PG8_BAR; PG8_SCHED;
            PG8_STAGE(PG8_SB(0, 1), b2 + hstep, voffB);
            PG8_WAIT_V(6); PG8_BAR; PG8_MMA(1, 1, At, B1); PG8_BAR;
            PG8_LDB(B0, 1, 0); PG8_SCHED; PG8_LDA(At, 1, 0); PG8_STAGE(PG8_SA(0, 1), a2, x1);
            PG8_WAIT_L(8); PG8_BAR; PG8_WAIT_L(0); PG8_MMA(0, 0, At, B0); PG8_BAR; PG8_SCHED;
            PG8_LDB(B1, 1, 1); PG8_STAGE(PG8_SB(1, 0), b3, voffB);
            PG8_BAR; PG8_WAIT_L(0); PG8_MMA(0, 1, At, B1); PG8_BAR;
            PG8_LDA(At, 1, 1); PG8_STAGE(PG8_SA(1, 0), a3, x0);
            PG8_BAR; PG8_WAIT_L(0); PG8_MMA(1, 0, At, B0); PG8_BAR; PG8_SCHED;
            PG8_STAGE(PG8_SB(1, 1), b3 + hstep, voffB);
            PG8_WAIT_V(6); PG8_BAR; PG8_MMA(1, 1, At, B1); PG8_BAR;
            }
        }
        if constexpr (true) { if (wr == 0) PG8_BAR; }
        if constexpr (!Epi::AFTER_DRAIN) { E(acc, cur, wr, wc, fr, fq); S.done(cur); }
        if (!has_next) break;
#pragma unroll
        for (int a = 0; a < 2; ++a)
#pragma unroll
            for (int b = 0; b < 2; ++b)
#pragma unroll
                for (int m = 0; m < 4; ++m)
#pragma unroll
                    for (int n = 0; n < 2; ++n) acc[a][b][m][n] = (f32x4){0.f, 0.f, 0.f, 0.f};
        cur = nxt; cA = nA; cB = nB; ++ui; vA0[0] = vN0[0]; vA0[1] = vN0[1]; vA1[0] = vN1[0]; vA1[1] = vN1[1];
        if constexpr (true) { if (wr == 1) PG8_BAR; }
    }
    PG8_WAIT_V(0);
    if constexpr (false) { if (wr == 0) PG8_BAR; }
    PG8_BAR;
    if constexpr (Epi::AFTER_DRAIN) { E.fused(acc, cur, wr, wc, fr, fq, lds, wid, lane); S.done(cur); }
#undef PG8_SA
#undef PG8_SB
#undef PG8_GOFF
#undef PG8_STAGE
#undef PG8_LDA
#undef PG8_LDB
#undef PG8_MMA
#undef PG8_WAIT_V
#undef PG8_WAIT_L
#undef PG8_BAR
#undef PG8_SCHED
}
}

constexpr int NB = 8, SEQ = 4096, DM = 1024, T = NB * SEQ;
constexpr int RW = 512, NHR = 8;
constexpr int NPROJ = 5376;
constexpr int FF = 512, NEXP = 32;
constexpr float C2 = 0.125f * 1.4426950408889634f;
constexpr float LAM_INIT = 0.2f;
constexpr int MAXROWS = 2 * T + NEXP * 256;

constexpr size_t MiB = 1u << 20;
constexpr size_t WS_CTL = 0, CTL_ZERO_BYTES = 1 * MiB;
constexpr size_t WS_WLORA = 1 * MiB;
constexpr size_t WS_WBRD = 2 * MiB;
constexpr size_t WS_WO = 4 * MiB;
constexpr size_t WS_WR = 6 * MiB;
constexpr size_t WS_WPG = 7 * MiB;
constexpr size_t WS_WPP = 9 * MiB;
constexpr size_t WS_TOKE = 10 * MiB;
constexpr size_t WS_TOKW = 10 * MiB + 256 * 1024;
constexpr size_t WS_POS = 10 * MiB + 512 * 1024;
constexpr size_t WS_ROWW = 10 * MiB + 768 * 1024;
constexpr size_t WS_TILECNT = 11 * MiB + 256 * 1024;
constexpr size_t WS_DISP = 11 * MiB + 512 * 1024;
constexpr size_t WS_BON = 12 * MiB;
constexpr size_t WS_ROWTOK = 13 * MiB;
constexpr size_t WS_RS = 13 * MiB + 512 * 1024;
constexpr size_t WS_ROWRS = 13 * MiB + 640 * 1024;
constexpr size_t WS_SSQ = 14 * MiB;
constexpr size_t WS_HALO = 14 * MiB;
constexpr size_t WS_GCB = 10 * MiB;
constexpr size_t WS_WIN = 16 * MiB;
constexpr size_t WS_LOGITS = 16 * MiB;
constexpr size_t WS_XN = 32 * MiB;
constexpr size_t WS_WGU = 32 * MiB;
constexpr size_t WS_RKV = 96 * MiB;
constexpr size_t WS_MIXED = 96 * MiB;
constexpr size_t WS_WD = 96 * MiB;
constexpr size_t WS_HS = 128 * MiB;
constexpr size_t WS_H3 = 128 * MiB;
constexpr size_t WS_PROJB = 192 * MiB;
constexpr size_t WS_E = 192 * MiB;
constexpr size_t WS_A = 224 * MiB;
constexpr size_t WS_G = 256 * MiB;
constexpr size_t WS_P16 = 192 * MiB;
constexpr size_t WS_PP = 208 * MiB;
constexpr size_t WS_Y2 = 272 * MiB;
constexpr size_t WS_GATES = 304 * MiB;
constexpr size_t WS_H2X = 304 * MiB;
constexpr size_t WS_VT = 432 * MiB;
constexpr size_t WS_ACT = 432 * MiB;
constexpr size_t WS_X2 = 432 * MiB;
constexpr size_t WS_PART = 176 * MiB;
constexpr size_t WS_END = 512 * MiB;
constexpr size_t OUT_STASH = 0, OUT_ORWDF = 32 * MiB, OUT_Y = 96 * MiB  , OUT_LA = 0  ;
static_assert(WS_ACT + (size_t)MAXROWS * 512 * 2 <= WS_END && WS_Y2 + (size_t)MAXROWS * 1024 * 2 <= WS_ACT && WS_HS + (size_t)MAXROWS * 1024 * 2 <= WS_Y2, "ws map");
static_assert(WS_PART + (size_t)T * 1024 * 4 <= WS_GATES && WS_MIXED + (size_t)T * 1024 * 2 <= WS_PART, "ws map");
constexpr int CW_QUEUE = 64;
constexpr int CW_RTDONE = 22016;
constexpr int CW_P2CNT = 21504;
constexpr int CW_P2Q = 21760;
constexpr int CW_SDONE = 20480;
constexpr int CW_PREP = 16384;
constexpr int CW_MOECNT = 512;
constexpr int CW_BAR = 4096;

constexpr int RING_BYTES = 131072;
constexpr int MISC_OFF = 158720;
constexpr int LDS_BYTES = 160768;
constexpr int NWAVES = 8, NTHR = 512;

#define GAS __attribute__((address_space(1)))
#define LAS __attribute__((address_space(3)))
typedef unsigned short bf16;
typedef unsigned v4u __attribute__((ext_vector_type(4)));
typedef unsigned v2u __attribute__((ext_vector_type(2)));
typedef float f32x4 __attribute__((ext_vector_type(4)));
typedef float f32x16 __attribute__((ext_vector_type(16)));
typedef short s16x8 __attribute__((ext_vector_type(8)));
typedef short s16x4 __attribute__((ext_vector_type(4)));
__device__ __forceinline__ int opaque_zero() { int z; asm volatile("v_mov_b32 %0, 0" : "=v"(z)); return z; }
__device__ __forceinline__ int mk_lane_v() { int l; asm volatile("v_mbcnt_lo_u32_b32 %0, -1, 0\n\tv_mbcnt_hi_u32_b32 %0, -1, %0" : "=v"(l)); return l; }
#define LDS_WAIT() asm volatile("s_waitcnt lgkmcnt(0)" ::: "memory")
#define VM_WAIT() asm volatile("s_waitcnt vmcnt(0)" ::: "memory")

__device__ __forceinline__ bf16* y_ptr(float* out, int b) { return (bf16*)((unsigned char*)out + OUT_Y) + (size_t)b * SEQ * 512; }
__device__ __forceinline__ bf16* qn_ptr(unsigned char* ws, int b) { return (bf16*)(ws + (b < 4 ? (288 + 4 * (size_t)b) * MiB : (464 + 4 * (size_t)(b - 4)) * MiB)); }
__device__ __forceinline__ bf16* kn_ptr(unsigned char* ws, int b) { return (bf16*)(ws + (480 + 4 * (size_t)b) * MiB); }
__device__ __forceinline__ unsigned f2bf(float f) { unsigned u = __builtin_bit_cast(unsigned, f); return (u + 0x7fffu + ((u >> 16) & 1u)) >> 16; }
typedef float f32x2_t __attribute__((ext_vector_type(2))); typedef __bf16 bf16x2_t __attribute__((ext_vector_type(2)));
__device__ __forceinline__ unsigned pk2(float lo, float hi) { f32x2_t v = {lo, hi}; bf16x2_t b = __builtin_convertvector(v, bf16x2_t); return __builtin_bit_cast(unsigned, b); }
__device__ __forceinline__ float bflo(unsigned w) { return __builtin_bit_cast(float, w << 16); }
__device__ __forceinline__ float bfhi(unsigned w) { return __builtin_bit_cast(float, w & 0xffff0000u); }
__device__ __forceinline__ float sigm(float x) { return __builtin_amdgcn_rcpf(1.0f + __builtin_amdgcn_exp2f(-1.4426950408889634f * x)); }
template <int CTRL> __device__ __forceinline__ float dpp_mov(float v) { return __builtin_bit_cast(float, __builtin_amdgcn_update_dpp(0, __builtin_bit_cast(int, v), CTRL, 0xF, 0xF, false)); }
__device__ __forceinline__ float red8(float v) { v += dpp_mov<0xB1>(v); v += dpp_mov<0x4E>(v); v += dpp_mov<0x141>(v); return v; }
__device__ __forceinline__ float red16(float v) { v = red8(v); v += dpp_mov<0x140>(v); return v; }
__device__ __forceinline__ void swap32(unsigned& a, unsigned& b) { asm volatile("s_nop 1\n\tv_permlane32_swap_b32 %0, %1\n\ts_nop 1" : "+v"(a), "+v"(b)); }
__device__ __forceinline__ float xhalf_max(float m) { unsigned a = __builtin_bit_cast(unsigned, m), b = a; swap32(a, b); return fmaxf(__builtin_bit_cast(float, a), __builtin_bit_cast(float, b)); }
__device__ __forceinline__ float xhalf_sum(float m) { unsigned a = __builtin_bit_cast(unsigned, m), b = a; swap32(a, b); return __builtin_bit_cast(float, a) + __builtin_bit_cast(float, b); }
__device__ __forceinline__ float xor16(float v) { return __builtin_bit_cast(float, __builtin_amdgcn_ds_swizzle(__builtin_bit_cast(int, v), 0x401F)); }
__device__ __forceinline__ float wave_sum(float v) { v = red16(v); v += xor16(v); return xhalf_sum(v); }

namespace pg8 {
struct EpiStore {
    static constexpr bool PERM = true, AFTER_DRAIN = false, HAS_MID = false;
    bf16_t* O; int ldc;
    __device__ __forceinline__ void operator()(const f32x4 (&acc)[2][2][4][2], const Unit& u, int wr, int wc, int fr, int fq) const {
        const int row0 = u.pm * BM + wr * 64 + fr, col0 = u.pn * BM + wc * 32 + 8 * fq;
#pragma unroll
        for (int ai = 0; ai < 2; ++ai)
#pragma unroll
            for (int m = 0; m < 4; ++m) { bf16_t* rowp = O + (size_t)(row0 + ai * HALF + m * 16) * ldc + col0;
#pragma unroll
                for (int bj = 0; bj < 2; ++bj) { const f32x4 v0 = acc[ai][bj][m][0], v1 = acc[ai][bj][m][1]; u32x4 w;
                    w.x = cvt_pk_bf16(v0[0], v0[1]); w.y = cvt_pk_bf16(v0[2], v0[3]); w.z = cvt_pk_bf16(v1[0], v1[1]); w.w = cvt_pk_bf16(v1[2], v1[3]);
                    *(u32x4*)(rowp + bj * HALF) = w; } }
    }
};
struct EpiProj {
    static constexpr bool PERM = true, AFTER_DRAIN = false, HAS_MID = false;
    bf16_t *rkv, *projb, *gates;
    __device__ __forceinline__ void operator()(const f32x4 (&acc)[2][2][4][2], const Unit& u, int wr, int wc, int fr, int fq) const {
        bf16_t* base; int ldc, ct;
        if (u.pn < 6) { base = rkv; ldc = 1536; ct = u.pn; } else if (u.pn < 11) { base = projb; ldc = 1280; ct = u.pn - 6; } else { base = gates; ldc = 2048; ct = u.pn - 13; }
        const int row0 = u.pm * BM + wr * 64 + fr, col0 = ct * BM + wc * 32 + 8 * fq;
#pragma unroll
        for (int ai = 0; ai < 2; ++ai)
#pragma unroll
            for (int m = 0; m < 4; ++m) { bf16_t* rowp = base + (size_t)(row0 + ai * HALF + m * 16) * ldc + col0;
#pragma unroll
                for (int bj = 0; bj < 2; ++bj) { f32x4 v0 = acc[ai][bj][m][0], v1 = acc[ai][bj][m][1]; u32x4 w;
                    if (u.pn >= 13) {
#pragma unroll
                        for (int e = 0; e < 4; ++e) { v0[e] = fmaxf(sigm(v0[e]), 1e-6f); v1[e] = fmaxf(sigm(v1[e]), 1e-6f); } }
                    w.x = cvt_pk_bf16(v0[0], v0[1]); w.y = cvt_pk_bf16(v0[2], v0[3]); w.z = cvt_pk_bf16(v1[0], v1[1]); w.w = cvt_pk_bf16(v1[2], v1[3]);
                    if (u.pn >= 6 && u.pn < 11) asm volatile("global_store_dwordx4 %0, %1, off sc1\n\ts_nop 4" :: "v"(rowp + bj * HALF), "v"(w) : "memory");
                    else *(u32x4*)(rowp + bj * HALF) = w; } }
    }
};
struct EpiLora {
    static constexpr bool PERM = true, AFTER_DRAIN = false, HAS_MID = false;
    bf16_t *E, *A, *G; const float *w0, *a0;
    template <int KIND> __device__ __forceinline__ void body(const f32x4 (&acc)[2][2][4][2], bf16_t* base, const float* bias, int row0, int col0) const {
#pragma unroll
        for (int bj = 0; bj < 2; ++bj)
#pragma unroll
            for (int ai = 0; ai < 2; ++ai)
#pragma unroll
                for (int m = 0; m < 4; ++m) { bf16_t* rowp = base + (size_t)(row0 + ai * HALF + m * 16) * 512 + col0 + bj * HALF;
                    f32x4 v0 = acc[ai][bj][m][0], v1 = acc[ai][bj][m][1];
                    if (KIND < 2) { const f32x4 b0 = *(const f32x4*)(bias + col0 + bj * HALF), b1 = *(const f32x4*)(bias + col0 + bj * HALF + 4); const float sc = KIND == 0 ? 0.60653065971263342f : 1.0f;
                        v0 += b0; v1 += b1;
#pragma unroll
                        for (int e = 0; e < 4; ++e) { v0[e] = sc * sigm(v0[e]); v1[e] = sc * sigm(v1[e]); } }
                    u32x4 w; w.x = cvt_pk_bf16(v0[0], v0[1]); w.y = cvt_pk_bf16(v0[2], v0[3]); w.z = cvt_pk_bf16(v1[0], v1[1]); w.w = cvt_pk_bf16(v1[2], v1[3]);
                    *(u32x4*)rowp = w; asm volatile("" ::: "memory"); }
    }
    __device__ __forceinline__ void operator()(const f32x4 (&acc)[2][2][4][2], const Unit& u, int wr, int wc, int fr, int fq) const {
        const int kind = u.pn >> 1; const int row0 = u.pm * BM + wr * 64 + fr, col0 = (u.pn & 1) * BM + wc * 32 + 8 * fq;
        if (kind == 0) body<0>(acc, E, w0, row0, col0); else if (kind == 1) body<1>(acc, A, a0, row0, col0); else body<2>(acc, G, w0, row0, col0);
    }
};
struct EpiMix {
    static constexpr bool PERM = true, AFTER_DRAIN = false, HAS_MID = true;
    const bf16_t* gates; bf16_t* mixed;
    __device__ __forceinline__ void mid(f32x4 (&acc)[2][2][4][2], const Unit& u, int wr, int wc, int fr, int fq) const {
        const int row0 = u.pm * BM + wr * 64 + fr, col0 = u.pn * BM + wc * 32 + 8 * fq;
#pragma unroll
        for (int ai = 0; ai < 2; ++ai)
#pragma unroll
            for (int m = 0; m < 4; ++m) { const size_t r = (size_t)(row0 + ai * HALF + m * 16);
#pragma unroll
                for (int bj = 0; bj < 2; ++bj) { const int c = col0 + bj * HALF;
                    const u32x4 gr = *(const u32x4*)(gates + r * 2048 + c), gd = *(const u32x4*)(gates + r * 2048 + 1024 + c);
                    f32x4& v0 = acc[ai][bj][m][0]; f32x4& v1 = acc[ai][bj][m][1];
                    v0[0] *= bflo(gr.x) * __builtin_amdgcn_rcpf(bflo(gd.x)); v0[1] *= bfhi(gr.x) * __builtin_amdgcn_rcpf(bfhi(gd.x)); v0[2] *= bflo(gr.y) * __builtin_amdgcn_rcpf(bflo(gd.y)); v0[3] *= bfhi(gr.y) * __builtin_amdgcn_rcpf(bfhi(gd.y));
                    v1[0] *= bflo(gr.z) * __builtin_amdgcn_rcpf(bflo(gd.z)); v1[1] *= bfhi(gr.z) * __builtin_amdgcn_rcpf(bfhi(gd.z)); v1[2] *= bflo(gr.w) * __builtin_amdgcn_rcpf(bflo(gd.w)); v1[3] *= bfhi(gr.w) * __builtin_amdgcn_rcpf(bfhi(gd.w)); }
                asm volatile("" ::: "memory"); }
    }
    __device__ __forceinline__ void operator()(const f32x4 (&acc)[2][2][4][2], const Unit& u, int wr, int wc, int fr, int fq) const {
        const int row0 = u.pm * BM + wr * 64 + fr, col0 = u.pn * BM + wc * 32 + 8 * fq;
#pragma unroll
        for (int ai = 0; ai < 2; ++ai)
#pragma unroll
            for (int m = 0; m < 4; ++m) { const size_t r = (size_t)(row0 + ai * HALF + m * 16);
#pragma unroll
                for (int bj = 0; bj < 2; ++bj) { const int c = col0 + bj * HALF;
                    const u32x4 gd = *(const u32x4*)(gates + r * 2048 + 1024 + c);
                    f32x4 v0 = acc[ai][bj][m][0], v1 = acc[ai][bj][m][1];
                    v0[0] *= bflo(gd.x); v0[1] *= bfhi(gd.x); v0[2] *= bflo(gd.y); v0[3] *= bfhi(gd.y); v1[0] *= bflo(gd.z); v1[1] *= bfhi(gd.z); v1[2] *= bflo(gd.w); v1[3] *= bfhi(gd.w);
                    u32x4 w; w.x = cvt_pk_bf16(v0[0], v0[1]); w.y = cvt_pk_bf16(v0[2], v0[3]); w.z = cvt_pk_bf16(v1[0], v1[1]); w.w = cvt_pk_bf16(v1[2], v1[3]);
                    *(u32x4*)(mixed + r * 1024 + c) = w; } }
    }
};
struct EpiRes {
    static constexpr bool PERM = true, AFTER_DRAIN = false, HAS_MID = false;
    const float* x; bf16_t* x1; float* ssq;
    __device__ __forceinline__ void operator()(const f32x4 (&acc)[2][2][4][2], const Unit& u, int wr, int wc, int fr, int fq) const {
        const int row0 = u.pm * BM + wr * 64 + fr, col0 = u.pn * BM + wc * 32 + 8 * fq;
#pragma unroll
        for (int ai = 0; ai < 2; ++ai) { f32x4 xv[4][2][2];
#pragma unroll
            for (int m = 0; m < 4; ++m)
#pragma unroll
                for (int bj = 0; bj < 2; ++bj) { const float* xp = x + (size_t)(row0 + ai * HALF + m * 16) * 1024 + col0 + bj * HALF; xv[m][bj][0] = *(const f32x4*)xp; xv[m][bj][1] = *(const f32x4*)(xp + 4); }
            asm volatile("" ::: "memory");
#pragma unroll
            for (int m = 0; m < 4; ++m) { const size_t off = (size_t)(row0 + ai * HALF + m * 16) * 1024 + col0; float s = 0.f;
#pragma unroll
                for (int bj = 0; bj < 2; ++bj) { const f32x4 v0 = xv[m][bj][0] + acc[ai][bj][m][0], v1 = xv[m][bj][1] + acc[ai][bj][m][1]; u32x4 w;
                    s += ((v0[0] * v0[0] + v0[1] * v0[1]) + (v0[2] * v0[2] + v0[3] * v0[3])) + ((v1[0] * v1[0] + v1[1] * v1[1]) + (v1[2] * v1[2] + v1[3] * v1[3]));
                    w.x = cvt_pk_bf16(v0[0], v0[1]); w.y = cvt_pk_bf16(v0[2], v0[3]); w.z = cvt_pk_bf16(v1[0], v1[1]); w.w = cvt_pk_bf16(v1[2], v1[3]);
                    *(u32x4*)(x1 + off + bj * HALF) = w; }
                s += xor16(s); s = xhalf_sum(s);
                if (fq == 0) ssq[(size_t)(row0 + ai * HALF + m * 16) * 16 + u.pn * 4 + wc] = s; } }
    }
};
struct EpiLogits {
    static constexpr bool PERM = false, AFTER_DRAIN = false, HAS_MID = false;
    float* L;
    __device__ __forceinline__ void operator()(const f32x4 (&acc)[2][2][4][2], const Unit& u, int wr, int wc, int fr, int fq) const {
        const int row0 = u.pm * BM + wr * 64 + fr, col0 = wc * 32 + 4 * fq;
#pragma unroll
        for (int ai = 0; ai < 2; ++ai)
#pragma unroll
            for (int m = 0; m < 4; ++m) { float* rowp = L + (size_t)(row0 + ai * HALF + m * 16) * 128 + col0;
#pragma unroll
                for (int n = 0; n < 2; ++n) *(f32x4*)(rowp + n * 16) = acc[ai][0][m][n]; }
    }
};
struct EpiAct {
    static constexpr bool PERM = true, AFTER_DRAIN = false, HAS_MID = false;
    bf16_t* act; const float* rowrs;
    __device__ __forceinline__ void operator()(const f32x4 (&acc)[2][2][4][2], const Unit& u, int wr, int wc, int fr, int fq) const {
        const int row0 = u.pm * BM + wr * 64 + fr, col0 = (u.pn & 3) * HALF + wc * 32 + 8 * fq;
#pragma unroll
        for (int ai = 0; ai < 2; ++ai)
#pragma unroll
            for (int m = 0; m < 4; ++m) { const int r = row0 + ai * HALF + m * 16; bf16_t* rowp = act + (size_t)r * 512 + col0; float o[8]; const float rs = rowrs[r];
#pragma unroll
                for (int n = 0; n < 2; ++n)
#pragma unroll
                    for (int e = 0; e < 4; ++e) { const float g = acc[ai][0][m][n][e] * rs, up = acc[ai][1][m][n][e] * rs; o[n * 4 + e] = g * sigm(g) * up; }
                u32x4 w; w.x = cvt_pk_bf16(o[0], o[1]); w.y = cvt_pk_bf16(o[2], o[3]); w.z = cvt_pk_bf16(o[4], o[5]); w.w = cvt_pk_bf16(o[6], o[7]);
                asm volatile("global_store_dwordx4 %0, %1, off sc1\n\ts_nop 4" :: "v"(rowp), "v"(w) : "memory"); }
    }
};
struct EpiDown {
    static constexpr bool PERM = true, AFTER_DRAIN = false, HAS_MID = false;
    bf16_t* y2; const float* roww;
    __device__ __forceinline__ void operator()(const f32x4 (&acc)[2][2][4][2], const Unit& u, int wr, int wc, int fr, int fq) const {
        const int row0 = u.pm * BM + wr * 64 + fr, col0 = (u.pn & 3) * BM + wc * 32 + 8 * fq;
#pragma unroll
        for (int ai = 0; ai < 2; ++ai)
#pragma unroll
            for (int m = 0; m < 4; ++m) { const int r = row0 + ai * HALF + m * 16; const float w8 = roww[r]; bf16_t* rowp = y2 + (size_t)r * 1024 + col0;
#pragma unroll
                for (int bj = 0; bj < 2; ++bj) { const f32x4 v0 = acc[ai][bj][m][0] * w8, v1 = acc[ai][bj][m][1] * w8; u32x4 w;
                    w.x = cvt_pk_bf16(v0[0], v0[1]); w.y = cvt_pk_bf16(v0[2], v0[3]); w.z = cvt_pk_bf16(v1[0], v1[1]); w.w = cvt_pk_bf16(v1[2], v1[3]);
                    *(u32x4*)(rowp + bj * HALF) = w; } }
    }
};
struct EpiFinal {
    static constexpr bool PERM = true, AFTER_DRAIN = false, HAS_MID = false;
    const bf16_t* pp; const bf16_t* x2; float* out; const float* rs3;
    __device__ __forceinline__ void operator()(const f32x4 (&acc)[2][2][4][2], const Unit& u, int wr, int wc, int fr, int fq) const {
        const int row0 = u.pm * BM + wr * 64 + fr, col0 = u.pn * BM + wc * 32 + 8 * fq;
#pragma unroll
        for (int ai = 0; ai < 2; ++ai)
#pragma unroll
            for (int m = 0; m < 4; ++m) { const size_t r = (size_t)(row0 + ai * HALF + m * 16); const float rs = rs3[r];
#pragma unroll
                for (int bj = 0; bj < 2; ++bj) { const int c = col0 + bj * HALF;
                    const u32x4 pw = *(const u32x4*)(pp + r * 1024 + c), xw = *(const u32x4*)(x2 + r * 1024 + c); float* op = out + r * 1024 + c;
                    const f32x4 a0 = acc[ai][bj][m][0] * rs, a1 = acc[ai][bj][m][1] * rs; f32x4 x0, x1;
                    x0[0] = bflo(xw.x) + sigm(a0[0]) * bflo(pw.x); x0[1] = bfhi(xw.x) + sigm(a0[1]) * bfhi(pw.x); x0[2] = bflo(xw.y) + sigm(a0[2]) * bflo(pw.y); x0[3] = bfhi(xw.y) + sigm(a0[3]) * bfhi(pw.y);
                    x1[0] = bflo(xw.z) + sigm(a1[0]) * bflo(pw.z); x1[1] = bfhi(xw.z) + sigm(a1[1]) * bfhi(pw.z); x1[2] = bflo(xw.w) + sigm(a1[2]) * bflo(pw.w); x1[3] = bfhi(xw.w) + sigm(a1[3]) * bfhi(pw.w);
                    *(f32x4*)op = x0; *(f32x4*)(op + 4) = x1; asm volatile("" ::: "memory"); } }
    }
};
struct EpiGates {
    static constexpr bool PERM = true, AFTER_DRAIN = false, HAS_MID = false;
    bf16_t* gates;
    __device__ __forceinline__ void operator()(const f32x4 (&acc)[2][2][4][2], const Unit& u, int wr, int wc, int fr, int fq) const {
        const int row0 = u.pm * BM + wr * 64 + fr, col0 = u.pn * BM + wc * 32 + 8 * fq;
#pragma unroll
        for (int ai = 0; ai < 2; ++ai)
#pragma unroll
            for (int m = 0; m < 4; ++m) { bf16_t* rowp = gates + (size_t)(row0 + ai * HALF + m * 16) * 2048 + col0;
#pragma unroll
                for (int bj = 0; bj < 2; ++bj) { f32x4 v0 = acc[ai][bj][m][0], v1 = acc[ai][bj][m][1]; u32x4 w;
#pragma unroll
                    for (int e = 0; e < 4; ++e) { v0[e] = fmaxf(sigm(v0[e]), 1e-6f); v1[e] = fmaxf(sigm(v1[e]), 1e-6f); }
                    w.x = cvt_pk_bf16(v0[0], v0[1]); w.y = cvt_pk_bf16(v0[2], v0[3]); w.z = cvt_pk_bf16(v1[0], v1[1]); w.w = cvt_pk_bf16(v1[2], v1[3]);
                    *(u32x4*)(rowp + bj * HALF) = w; } }
    }
};
struct OrderItem {
    int pm, pn0, n;
    __device__ __forceinline__ bool next(int i, Unit& u) const { if (i >= n) return false; u.pm = pm; u.pn = pn0 + i; return true; }
    __device__ __forceinline__ void a_ready(const Unit&) const {}
    __device__ __forceinline__ void done(const Unit&) const {}
};
struct OrderProj : StaticOrder {
    unsigned* cnt;
    __device__ __forceinline__ void done(const Unit& u) const { if (u.pn >= 6 && u.pn < 11) { asm volatile("s_waitcnt vmcnt(0)" ::: "memory");
            if (__builtin_amdgcn_mbcnt_hi(~0u, __builtin_amdgcn_mbcnt_lo(~0u, 0u)) == 0) __hip_atomic_fetch_add(cnt + u.pm, 1u, __ATOMIC_RELAXED, __HIP_MEMORY_SCOPE_AGENT); } }
};
struct OrderSkipV : StaticOrder {
    __device__ __forceinline__ bool next(int i, Unit& u) const { if (!StaticOrder::next(i, u)) return false; if (u.pn >= 11) u.pn += 2; return true; }
};
struct OrderPair : StaticOrder {
    __device__ __forceinline__ bool next(int i, Unit& u) const { if (!StaticOrder::next(i >> 1, u)) return false; if (i & 1) { u.pm += 128; u.pn += 4; } return true; }
};
struct OrderMoe {
    int nwg, G, c; const PG8_LAS int* tile_e;
    __device__ __forceinline__ bool next(int i, Unit& u) const { const long L = (long)i * G + c; if (L >= nwg) return false; const int rt = (int)(L >> 2); u.pm = rt; u.pn = tile_e[rt] * 4 + (int)(L & 3); return true; }
    __device__ __forceinline__ void a_ready(const Unit&) const {}
    __device__ __forceinline__ void done(const Unit&) const {}
};
struct OrderMoeUp : OrderMoe {
    unsigned* cnt;
    __device__ __forceinline__ void done(const Unit& u) const { asm volatile("s_waitcnt vmcnt(0)" ::: "memory");
        if (__builtin_amdgcn_mbcnt_hi(~0u, __builtin_amdgcn_mbcnt_lo(~0u, 0u)) == 0) __hip_atomic_fetch_add(cnt + u.pm, 1u, __ATOMIC_RELAXED, __HIP_MEMORY_SCOPE_AGENT); }
};
struct OrderMoeDown : OrderMoe {
    unsigned* cnt;
    __device__ __forceinline__ void a_ready(const Unit& u) const { while (__hip_atomic_load(cnt + u.pm, __ATOMIC_RELAXED, __HIP_MEMORY_SCOPE_AGENT) < 32u) __builtin_amdgcn_s_sleep(2); asm volatile("" ::: "memory"); }
};
}

struct Args { const float* in[36]; float* out; unsigned char* ws; int ph_lo, ph_hi; };

template <bool KG = false> __device__ __forceinline__ void tr_item(const float* W, int N, bf16* WT, int ld, int k0, int n0, size_t dst_row0, int k_off, LAS float* scr, int lane, const float* kg = nullptr) {
    float wv[32];
#pragma unroll
    for (int i = 0; i < 32; ++i) { const int kk = 2 * i + (lane >> 5); wv[i] = W[(size_t)(k0 + kk) * N + n0 + (lane & 31)]; }
#pragma unroll
    for (int i = 0; i < 32; ++i) { const int kk = 2 * i + (lane >> 5); float w = wv[i]; if (KG) w *= kg[k0 + kk]; scr[kk * 33 + (lane & 31)] = w; }
    LDS_WAIT(); asm volatile("" ::: "memory");
    const int c = lane & 7;
#pragma unroll
    for (int j = 0; j < 4; ++j) { const int n = (lane >> 3) + 8 * j; const LAS float* s = scr + (8 * c) * 33 + n;
        v4u o; o.x = pk2(s[0 * 33], s[1 * 33]); o.y = pk2(s[2 * 33], s[3 * 33]); o.z = pk2(s[4 * 33], s[5 * 33]); o.w = pk2(s[6 * 33], s[7 * 33]);
        *(v4u*)(WT + (dst_row0 + n) * ld + k_off + k0 + 8 * c) = o; }
    LDS_WAIT(); asm volatile("" ::: "memory");
}
template <bool KG = false> __device__ __forceinline__ void tr_matrix(const float* W, int K, int N, bf16* WT, int ld, size_t dst_row0, int k_off, LAS float* scr, int lane, int gw, int NGW, int& base, const float* kg = nullptr) {
    const int nblk = N / 32, nitems = (K / 64) * nblk;
    int first = (gw - base) % NGW; if (first < 0) first += NGW; base += nitems;
    for (int it = first; it < nitems; it += NGW) { const int kb = it / nblk, nb = it % nblk; tr_item<KG>(W, N, WT, ld, 64 * kb, 32 * nb, dst_row0 + 32 * nb, k_off, scr, lane, kg); }
}
__device__ __forceinline__ void rms_row_to_bf16(const float* xrow, const float* gain, bf16* orow, int lane) {
    const f32x4* xr = (const f32x4*)xrow + lane; f32x4 v[4]; float s = 0.f;
#pragma unroll
    for (int j = 0; j < 4; ++j) { v[j] = xr[64 * j]; s += (v[j].x * v[j].x + v[j].y * v[j].y) + (v[j].z * v[j].z + v[j].w * v[j].w); }
    const float rstd = 1.0f / sqrtf(wave_sum(s) * (1.f / 1024.f) + 1e-6f);
    v2u* o8 = (v2u*)orow + lane;
#pragma unroll
    for (int j = 0; j < 4; ++j) { const f32x4 g = ((const f32x4*)gain)[lane + 64 * j]; v2u o; o.x = pk2(v[j].x * rstd * g.x, v[j].y * rstd * g.y); o.y = pk2(v[j].z * rstd * g.z, v[j].w * rstd * g.w); o8[64 * j] = o; }
}

__device__ __forceinline__ void phase0(const Args& a, LAS unsigned char* lds, int tid, int lane, int wave, int vcu, int G) {
    unsigned char* ws = a.ws;
    LAS float* scr = (LAS float*)(lds + wave * 16384);
    const int gw = vcu * NWAVES + wave, NGW = G * NWAVES; const int gt = vcu * NTHR + tid, NGT = G * NTHR;
    const bool trw = wave >= 6; const int gwt = vcu * 2 + (wave - 6), NGWT = G * 2, gwn = vcu * 6 + wave, NGWN = G * 6;
    if (trw) {
    const int gw = gwt, NGW = NGWT;
    int ibase = 0;
    tr_matrix(a.in[3], 1024, NPROJ, (bf16*)(ws + WS_WIN), 1024, 0, 0, scr, lane, gw, NGW, ibase);
    tr_matrix(a.in[6], 64, 512, (bf16*)(ws + WS_WLORA), 256, 0, 0, scr, lane, gw, NGW, ibase);
    tr_matrix(a.in[8], 64, 512, (bf16*)(ws + WS_WLORA), 256, 512, 64, scr, lane, gw, NGW, ibase);
    tr_matrix(a.in[9], 128, 512, (bf16*)(ws + WS_WLORA), 256, 1024, 128, scr, lane, gw, NGW, ibase);
    tr_matrix(a.in[22], 512, 1024, (bf16*)(ws + WS_WBRD), 1024, 0, 0, scr, lane, gw, NGW, ibase);
    tr_matrix(a.in[23], 512, 1024, (bf16*)(ws + WS_WBRD), 1024, 0, 512, scr, lane, gw, NGW, ibase);
    tr_matrix(a.in[24], 1024, 1024, (bf16*)(ws + WS_WO), 1024, 0, 0, scr, lane, gw, NGW, ibase);
    tr_matrix<true>(a.in[34], 1024, 1024, (bf16*)(ws + WS_WPG), 1024, 0, 0, scr, lane, gw, NGW, ibase, a.in[33]);
    tr_matrix(a.in[35], 256, 1024, (bf16*)(ws + WS_WPP), 256, 0, 0, scr, lane, gw, NGW, ibase);
    }
#if defined(PROBE_PHASE) && PROBE_PHASE == 20
    if (blockIdx.x == 0 && tid == 0) ((volatile LAS unsigned long long*)(lds + MISC_OFF + 1536))[1] = __builtin_amdgcn_s_memrealtime();
#endif
    { v4u* wl = (v4u*)(ws + WS_WLORA); const v4u z = (v4u){0u, 0u, 0u, 0u};
      for (int i = gt; i < 1536 * 32; i += NGT) { const int row = i >> 5, kc = (i & 31) * 8; const int blk = row >> 9;
          const bool diag = blk == 0 ? (kc < 64) : (blk == 1 ? (kc >= 64 && kc < 128) : (kc >= 128)); if (!diag) wl[i] = z; } }
    { bf16* wr = (bf16*)(ws + WS_WR); const float* wg = a.in[26]; const float* we = a.in[28];
      for (int i = gt; i < 256 * 1024; i += NGT) { const int row = i >> 10, kk = i & 1023; unsigned short v = 0;
          if (row < 36) v = (unsigned short)f2bf((row < 32 ? we[kk * 32 + row] : wg[kk * 4 + (row - 32)]) * a.in[25][kk]);
          wr[(size_t)row * 1024 + kk] = v; } }
#if defined(PROBE_PHASE) && PROBE_PHASE == 21
    if (blockIdx.x == 0 && tid == 0) ((volatile LAS unsigned long long*)(lds + MISC_OFF + 1536))[1] = __builtin_amdgcn_s_memrealtime();
#endif
    if (!trw) { const int gw = gwn, NGW = NGWN; constexpr int U = 8;
      f32x4 g4[4];
#pragma unroll
      for (int j = 0; j < 4; ++j) g4[j] = ((const f32x4*)a.in[2])[lane + 64 * j];
      for (int m0 = gw; m0 < T; m0 += NGW * U) { f32x4 v[U][4];
#pragma unroll
          for (int u = 0; u < U; ++u) { const int m = m0 + u * NGW; if (m < T) { const f32x4* xr = (const f32x4*)(a.in[0] + (size_t)m * DM) + lane;
#pragma unroll
              for (int j = 0; j < 4; ++j) v[u][j] = xr[64 * j]; } }
#pragma unroll
          for (int u = 0; u < U; ++u) { const int m = m0 + u * NGW; if (m < T) { float sq = 0.f;
#pragma unroll
              for (int j = 0; j < 4; ++j) sq += (v[u][j].x * v[u][j].x + v[u][j].y * v[u][j].y) + (v[u][j].z * v[u][j].z + v[u][j].w * v[u][j].w);
              const float rstd = 1.0f / sqrtf(wave_sum(sq) * (1.f / 1024.f) + 1e-6f);
              v2u* o8 = (v2u*)((bf16*)(ws + WS_XN) + (size_t)m * DM) + lane;
#pragma unroll
              for (int j = 0; j < 4; ++j) { v2u o; o.x = pk2(v[u][j].x * rstd * g4[j].x, v[u][j].y * rstd * g4[j].y); o.y = pk2(v[u][j].z * rstd * g4[j].z, v[u][j].w * rstd * g4[j].w); o8[64 * j] = o; } } } } }
}

__device__ __forceinline__ void phase2(const Args& a, LAS unsigned char* lds, int tid, int vcu, int G) {
    unsigned char* ws = a.ws;
    const bf16* projb = (const bf16*)(ws + WS_PROJB); const float* mu = a.in[4];
    bf16* la = (bf16*)((unsigned char*)a.out + OUT_LA);
    LAS float* cs = (LAS float*)lds;
    unsigned* ctl = (unsigned*)(ws + WS_CTL); LAS unsigned* tbox = (LAS unsigned*)(lds + MISC_OFF) + 1;
    for (;;) {
        __syncthreads();
        if (tid == 0) { const unsigned tl = atomicAdd(ctl + CW_P2Q, 1u); tbox[0] = tl;
            if (tl < (unsigned)(T / 64)) { while (__hip_atomic_load(ctl + CW_P2CNT + (tl >> 2), __ATOMIC_RELAXED, __HIP_MEMORY_SCOPE_AGENT) < 40u) __builtin_amdgcn_s_sleep(4); } }
        __syncthreads();
        asm volatile("" ::: "memory");
        const int tile = (int)tbox[0]; if (tile >= T / 64) break;
        const int t0 = tile * 64;
#pragma unroll
        for (int i = 0; i < 4; ++i) { const int idx = tid + 512 * i, tok = idx >> 5, i32 = idx & 31; const int s = (t0 + tok) & (SEQ - 1);
            const float inv = exp2f(-(float)i32 * (13.287712379549449f / 32.0f)); const float ang = (float)s * inv;
            const float rev = ang * 0.15915494309189535f, fr = rev - floorf(rev);
            cs[(tok * 32 + i32) * 2] = __builtin_amdgcn_cosf(fr); cs[(tok * 32 + i32) * 2 + 1] = __builtin_amdgcn_sinf(fr); }
#pragma unroll
        for (int i = 0; i < 4; ++i) { const int idx = tid + 512 * i, tok = idx >> 5, ch = idx & 31, t = t0 + tok, j0 = ch * 8; const bool first = (t & (SEQ - 1)) == 0;
            const v4u cur = *(const v4u*)(projb + (size_t)t * 1280 + j0); v4u prv = (v4u){0u, 0u, 0u, 0u}; if (!first) prv = *(const v4u*)(projb + (size_t)(t - 1) * 1280 + j0);
            const f32x4 m0 = *(const f32x4*)(mu + 1536 + j0), m1 = *(const f32x4*)(mu + 1536 + j0 + 4);
            float x[8]; const unsigned cw[4] = {cur.x, cur.y, cur.z, cur.w}, pw[4] = {prv.x, prv.y, prv.z, prv.w}; const float mm[8] = {m0.x, m0.y, m0.z, m0.w, m1.x, m1.y, m1.z, m1.w};
#pragma unroll
            for (int e = 0; e < 4; ++e) { const float c0 = bflo(cw[e]), c1 = bfhi(cw[e]), p0 = bflo(pw[e]), p1 = bfhi(pw[e]); x[2 * e] = c0 + (p0 - c0) * mm[2 * e]; x[2 * e + 1] = c1 + (p1 - c1) * mm[2 * e + 1]; }
            if (ch < 8) {
#pragma unroll
                for (int e = 0; e < 8; ++e) x[e] = 1.0f - 2.0f * __builtin_amdgcn_rcpf(1.0f + __builtin_amdgcn_exp2f(2.8853900817779268f * x[e]));
            } else if (ch >= 16) {
#pragma unroll
                for (int e = 0; e < 8; ++e) x[e] = sigm(x[e]);
            }
            v4u o; o.x = pk2(x[0], x[1]); o.y = pk2(x[2], x[3]); o.z = pk2(x[4], x[5]); o.w = pk2(x[6], x[7]);
            *(v4u*)(la + (size_t)t * 256 + j0) = o; }
        __syncthreads();
        for (int i0 = 0; i0 < 16; i0 += 8) { v2u wlv[8], whv[8];
#pragma unroll
          for (int u = 0; u < 8; ++u) { const int idx = tid + 512 * (i0 + u), tok = idx >> 7, grp = (idx >> 3) & 15, l8 = idx & 7, t = t0 + tok;
            const bf16* src = projb + (size_t)t * 1280 + 256 + grp * 64 + l8 * 4; wlv[u] = *(const v2u*)src; whv[u] = *(const v2u*)(src + 32); }
#pragma unroll
          for (int u = 0; u < 8; ++u) { const int idx = tid + 512 * (i0 + u), tok = idx >> 7, grp = (idx >> 3) & 15, l8 = idx & 7, t = t0 + tok;
            const v2u wl = wlv[u], wh = whv[u];
            float xl[4] = {bflo(wl.x), bfhi(wl.x), bflo(wl.y), bfhi(wl.y)}, xh[4] = {bflo(wh.x), bfhi(wh.x), bflo(wh.y), bfhi(wh.y)};
            float ss = 0.f;
#pragma unroll
            for (int e = 0; e < 4; ++e) ss += xl[e] * xl[e] + xh[e] * xh[e];
            ss = red8(ss);
            const float rs = (1.0f / sqrtf(ss * (1.f / 64.f) + 1e-6f)) * (grp < 8 ? C2 : 1.f);
            const float* gn = (grp < 8 ? a.in[15] : a.in[16]) + l8 * 4;
            const f32x4 gl = *(const f32x4*)gn, gh = *(const f32x4*)(gn + 32);
            float ol[4], oh[4];
#pragma unroll
            for (int e = 0; e < 4; ++e) { const float yl = xl[e] * rs * gl[e], yh = xh[e] * rs * gh[e]; const int ci = (tok * 32 + l8 * 4 + e) * 2; const float c = cs[ci], sn = cs[ci + 1];
                ol[e] = yl * c - yh * sn; oh[e] = yh * c + yl * sn; }
            const int b = t >> 12, s = t & (SEQ - 1); bf16* dst = (grp < 8 ? qn_ptr(ws, b) : kn_ptr(ws, b)) + ((size_t)(grp & 7) * SEQ + s) * 64 + l8 * 4;
            *(v2u*)dst = (v2u){pk2(ol[0], ol[1]), pk2(ol[2], ol[3])}; *(v2u*)(dst + 32) = (v2u){pk2(oh[0], oh[1]), pk2(oh[2], oh[3])}; } }
    }
}

__device__ __forceinline__ void halo_rows(const Args& a, int tid, int vcu, int G) {
    unsigned char* ws = a.ws;
    { const v4u* rk = (const v4u*)(ws + WS_RKV); v4u* hl = (v4u*)(ws + WS_HALO);
      for (int i = vcu * NTHR + tid; i < NB * 64 * 192; i += G * NTHR) { const int bc = i / 192, q = i - bc * 192, c = bc & 63, b = bc >> 6;
          v4u v = (v4u){0u, 0u, 0u, 0u}; if (c) v = rk[((size_t)b * SEQ + c * 64 - 1) * 192 + q]; hl[i] = v; } }
}
constexpr int SC_NB = 32, SC_REC = 392;
constexpr int SC_BUF = SC_NB * SC_REC * 4;
constexpr int SC_YOFF = 2 * SC_BUF;
struct ScanIn { v2u r0, k0, v0, r1, k1, v1, e, av; };
__device__ __forceinline__ void scan_unit(const Args& a, LAS unsigned char* lds, int tid, int unit) {
    unsigned char* ws = a.ws;
    const int bh = unit >> 1, half = unit & 1, b = bh >> 3, hd = bh & 7;
    const bf16* rkv = (const bf16*)(ws + WS_RKV); const bf16* E = (const bf16*)(ws + WS_E); const bf16* Aa = (const bf16*)(ws + WS_A);
    float* bon = (float*)(ws + WS_BON); bf16* Y = y_ptr(a.out, b);
    const int st = tid >> 4, c4 = tid & 15, ch = hd * 64 + c4 * 4;
    const f32x4 mur = *(const f32x4*)(a.in[4] + ch), muk = *(const f32x4*)(a.in[4] + 512 + ch), muv = *(const f32x4*)(a.in[4] + 1024 + ch);
    const f32x4 kkw = *(const f32x4*)(a.in[10] + ch), kaw = *(const f32x4*)(a.in[11] + ch), rkw = *(const f32x4*)(a.in[12] + ch);
    f32x4 sA = (f32x4){0.f, 0.f, 0.f, 0.f};
    const size_t tb = (size_t)b * SEQ;
    auto load_batch = [&](int s0, ScanIn& L) {
        const size_t t = tb + s0 + st; const bool first = (s0 + st) == 0;
        L.r0 = *(const v2u*)(rkv + t * 1536 + ch); L.k0 = *(const v2u*)(rkv + t * 1536 + 512 + ch); L.v0 = *(const v2u*)(rkv + t * 1536 + 1024 + ch);
        const size_t tp = first ? t : t - 1;
        L.r1 = *(const v2u*)(rkv + tp * 1536 + ch); L.k1 = *(const v2u*)(rkv + tp * 1536 + 512 + ch); L.v1 = *(const v2u*)(rkv + tp * 1536 + 1024 + ch);
        if (first) { L.r1 = (v2u){0u, 0u}; L.k1 = L.r1; L.v1 = L.r1; }
        L.e = *(const v2u*)(E + t * 512 + ch); L.av = *(const v2u*)(Aa + t * 512 + ch);
    };
    auto convert = [&](const ScanIn& L, int buf, int s0) {
        const unsigned r0w[2] = {L.r0.x, L.r0.y}, r1w[2] = {L.r1.x, L.r1.y}, k0w[2] = {L.k0.x, L.k0.y}, k1w[2] = {L.k1.x, L.k1.y}, v0w[2] = {L.v0.x, L.v0.y}, v1w[2] = {L.v1.x, L.v1.y};
        const unsigned ew[2] = {L.e.x, L.e.y}, aw[2] = {L.av.x, L.av.y};
        float r[4], k[4], v[4], e[4], av[4], kk[4];
#pragma unroll
        for (int i = 0; i < 4; ++i) { const int w = i >> 1; const bool hi = i & 1;
            const float rc = hi ? bfhi(r0w[w]) : bflo(r0w[w]), rp = hi ? bfhi(r1w[w]) : bflo(r1w[w]);
            const float kc = hi ? bfhi(k0w[w]) : bflo(k0w[w]), kp = hi ? bfhi(k1w[w]) : bflo(k1w[w]);
            const float vc = hi ? bfhi(v0w[w]) : bflo(v0w[w]), vp = hi ? bfhi(v1w[w]) : bflo(v1w[w]);
            r[i] = rc + (rp - rc) * mur[i]; k[i] = kc + (kp - kc) * muk[i]; v[i] = vc + (vp - vc) * muv[i];
            e[i] = hi ? bfhi(ew[w]) : bflo(ew[w]); av[i] = hi ? bfhi(aw[w]) : bflo(aw[w]);
            kk[i] = k[i] * kkw[i]; }
        const float ss = red16(kk[0] * kk[0] + kk[1] * kk[1] + kk[2] * kk[2] + kk[3] * kk[3]);
        const float inv = 1.0f / fmaxf(sqrtf(ss), 1e-12f);
        f32x4 w4, aa4, bb4, km4, wr4, vv4; float br = 0.f, kr = 0.f, bo = 0.f;
#pragma unroll
        for (int i = 0; i < 4; ++i) { const float kki = kk[i] * inv; const float km = k[i] * (1.0f + (av[i] - 1.0f) * kaw[i]); const float w = __expf(-e[i]);
            w4[i] = w; aa4[i] = -kki; bb4[i] = kki * av[i]; km4[i] = km; wr4[i] = w * r[i]; vv4[i] = v[i];
            br += bb4[i] * r[i]; kr += km * r[i]; bo += r[i] * km * rkw[i]; }
        br = red16(br); kr = red16(kr); bo = red16(bo);
        LAS float* rec = (LAS float*)(lds + buf * SC_BUF) + st * SC_REC + c4 * 4;
        *(LAS f32x4*)(rec) = w4; *(LAS f32x4*)(rec + 64) = aa4; *(LAS f32x4*)(rec + 128) = bb4; *(LAS f32x4*)(rec + 192) = km4; *(LAS f32x4*)(rec + 256) = wr4; *(LAS f32x4*)(rec + 320) = vv4;
        if (c4 == 0) { rec[384] = br; rec[385] = kr; if (half == 0) bon[(tb + s0 + st) * 8 + hd] = bo; }
    };
    auto write_out = [&](int bi) {
        typedef float f32x2 __attribute__((ext_vector_type(2)));
        const LAS float* yp = (const LAS float*)(lds + SC_YOFF) + (bi & 1) * (SC_NB * 32) + st * 32 + c4 * 2;
        const f32x2 yv = *(const LAS f32x2*)yp; *(unsigned*)(Y + (size_t)(bi * SC_NB + st) * 512 + hd * 64 + 32 * half + 2 * c4) = pk2(yv[0], yv[1]); };
    constexpr int NBATCH = SEQ / SC_NB;
    ScanIn L; load_batch(0, L);
    __syncthreads();
    convert(L, 0, 0);
    load_batch(SC_NB, L);
    __syncthreads();
    for (int bi = 0; bi < NBATCH; ++bi) {
        const int cur = bi & 1;
        if (bi + 1 < NBATCH) convert(L, cur ^ 1, (bi + 1) * SC_NB);
        if (bi + 2 < NBATCH) load_batch((bi + 2) * SC_NB, L);
        if (bi > 0) write_out(bi - 1);
        LAS float* ybuf = (LAS float*)(lds + SC_YOFF) + cur * (SC_NB * 32);
        const LAS float* base = (const LAS float*)(lds + cur * SC_BUF) + c4 * 4;
        const LAS float* vbase = (const LAS float*)(lds + cur * SC_BUF) + 320 + 32 * half + st;
        const LAS float* sbase = (const LAS float*)(lds + cur * SC_BUF) + 384;
        f32x4 nw = *(const LAS f32x4*)(base), na = *(const LAS f32x4*)(base + 64), nb = *(const LAS f32x4*)(base + 128), nk = *(const LAS f32x4*)(base + 192), nq = *(const LAS f32x4*)(base + 256);
        float nvA = vbase[0]; typedef float f32x2 __attribute__((ext_vector_type(2))); f32x2 ns = *(const LAS f32x2*)(sbase);
        float ykA = 0.f;
#pragma unroll
        for (int i = 0; i < SC_NB; ++i) {
            const f32x4 w4 = nw, a4 = na, b4 = nb, k4 = nk, q4 = nq; const float vA = nvA, br = ns[0], kr = ns[1];
            if (i + 1 < SC_NB) { const LAS float* rec = base + (i + 1) * SC_REC;
                nw = *(const LAS f32x4*)(rec); na = *(const LAS f32x4*)(rec + 64); nb = *(const LAS f32x4*)(rec + 128); nk = *(const LAS f32x4*)(rec + 192); nq = *(const LAS f32x4*)(rec + 256);
                nvA = vbase[(i + 1) * SC_REC]; ns = *(const LAS f32x2*)(sbase + (i + 1) * SC_REC); }
            float saA = fmaf(sA[0], a4[0], fmaf(sA[1], a4[1], fmaf(sA[2], a4[2], sA[3] * a4[3])));
            float zA = fmaf(sA[0], q4[0], fmaf(sA[1], q4[1], fmaf(sA[2], q4[2], sA[3] * q4[3])));
            saA = red16(saA); zA = red16(zA);
            const float yA = zA + saA * br + vA * kr;
            ykA = (c4 == (i & 15)) ? yA : ykA;
            sA = sA * w4 + saA * b4 + vA * k4;
            if ((i & 15) == 15) ybuf[(i - 15 + c4) * 32 + st] = ykA;
        }
        __syncthreads();
    }
    write_out(NBATCH - 1);
}
namespace wkv {
constexpr int P = 144, PF = 272, U = 64 * P  , F = 64 * PF  ;
constexpr int O_S = 0, O_B = F;
constexpr int O_AT = O_B + 0 * U, O_BTL = O_B + 1 * U, O_KTL = O_B + 2 * U, O_RT = O_B + 3 * U, O_BHT = O_B + 4 * U, O_KHT = O_B + 5 * U, O_VRT = O_B + 6 * U, O_RHST = O_B + 7 * U  , O_MABH = O_B + 9 * U, O_MRB = O_B + 10 * U, O_MRK = O_B + 11 * U, O_Z2 = O_B + 12 * U;
constexpr int O_XT = O_AT  , O_G1 = O_MABH, O_Z1 = O_KTL, O_G2 = O_RHST  , O_EP = O_Z2  ;
constexpr int O_END = O_B + 13 * U;
constexpr int PO = 80, O_OUTB = O_END  , O_TII = O_OUTB + 8 * 16 * PO  , O_DIAG = O_TII + 4 * 16 * PO  , O_GC = O_DIAG + 4096  , O_CONST = O_GC + 256  , O_TOP = O_CONST + 1536;
static_assert(O_TOP <= 158720, "wkv LDS map");
typedef short bf16x8 __attribute__((ext_vector_type(8)));
__device__ __forceinline__ f32x4 mfma16(bf16x8 a, bf16x8 b, f32x4 c) { return __builtin_amdgcn_mfma_f32_16x16x32_bf16(a, b, c, 0, 0, 0); }
template <int K> __device__ __forceinline__ f32x4 mm_blk(LAS unsigned char* lds, int aoff, int pa, int boff, int pb, int m0, int n0, int lane, f32x4 acc) {
    const int r = lane & 15, kg = lane >> 4;
#pragma unroll
    for (int ks = 0; ks < K / 32; ++ks) { const bf16x8 a = *(const LAS bf16x8*)(lds + aoff + (m0 + r) * pa + (32 * ks + 8 * kg) * 2); const bf16x8 b = *(const LAS bf16x8*)(lds + boff + (n0 + r) * pb + (32 * ks + 8 * kg) * 2); acc = mfma16(a, b, acc); }
    return acc;
}
__device__ __forceinline__ void split8(const LAS float* p, bf16x8& hi, bf16x8& lo) {
    const f32x4 x0 = *(const LAS f32x4*)p, x1 = *(const LAS f32x4*)(p + 4); const float x[8] = {x0[0], x0[1], x0[2], x0[3], x1[0], x1[1], x1[2], x1[3]}; unsigned h[8], l[8];
#pragma unroll
    for (int i = 0; i < 8; ++i) { h[i] = f2bf(x[i]); l[i] = f2bf(x[i] - __builtin_bit_cast(float, h[i] << 16)); }
    hi = (bf16x8){(short)h[0], (short)h[1], (short)h[2], (short)h[3], (short)h[4], (short)h[5], (short)h[6], (short)h[7]}; lo = (bf16x8){(short)l[0], (short)l[1], (short)l[2], (short)l[3], (short)l[4], (short)l[5], (short)l[6], (short)l[7]};
}
__device__ __forceinline__ void st_bf(LAS unsigned char* lds, int off, float v) { *(LAS unsigned short*)(lds + off) = (unsigned short)f2bf(v); }
__device__ __forceinline__ float ld_bf(const LAS unsigned char* lds, int off) { return __builtin_bit_cast(float, (unsigned)*(const LAS unsigned short*)(lds + off) << 16); }
struct Raw { v4u r0, k0, v0, r1, k1, v1, e, av; };
}
__device__ __forceinline__ void st4_bf(LAS unsigned char* lds, int off, f32x4 v) { *(LAS v2u*)(lds + off) = (v2u){pk2(v[0], v[1]), pk2(v[2], v[3])}; }
__device__ __forceinline__ f32x4 ld4_bf(const LAS unsigned char* lds, int off) { const v2u w = *(const LAS v2u*)(lds + off); return (f32x4){bflo(w.x), bfhi(w.x), bflo(w.y), bfhi(w.y)}; }
__device__ __forceinline__ wkv::bf16x8 ident_frag(int n, int ks, int kg) { wkv::bf16x8 f; const int k0 = 32 * ks + 8 * kg;
#pragma unroll
    for (int j = 0; j < 8; ++j) f[j] = (k0 + j == n) ? (short)0x3F80 : (short)0; return f; }
__device__ __forceinline__ void st16_wt(void* p, v4u w) { asm volatile("global_store_dwordx4 %0, %1, off sc1\n\ts_nop 4" :: "v"(p), "v"(w) : "memory"); }
__device__ __forceinline__ void scan_prep_item(const Args& a, LAS unsigned char* lds, int tid, int item) {
    using namespace wkv;
    unsigned char* ws = a.ws;
    const int p = item >> 6, bh = item & 63, b = bh >> 3, hd = bh & 7;
    bf16* rkv = (bf16*)(ws + WS_RKV); bf16* E = (bf16*)(ws + WS_E); bf16* Aa = (bf16*)(ws + WS_A); const bf16* halo = (const bf16*)(ws + WS_HALO);
    float* bon = (float*)(ws + WS_BON); float* gcb = (float*)(ws + WS_GCB);
    const size_t tb = (size_t)b * SEQ;
#ifdef SHADOW_DBG
    bf16* orkv = b == 0 ? (bf16*)(ws + 368 * MiB) : rkv; bf16* oE = b == 0 ? (bf16*)(ws + 380 * MiB) : E; bf16* oA = b == 0 ? (bf16*)(ws + 384 * MiB) : Aa;
#else
    bf16* orkv = rkv; bf16* oE = E; bf16* oA = Aa;
#endif
    const int tt = tid >> 3, kq = tid & 7, ch0 = kq * 8, gch = hd * 64 + ch0;
    if (tid < 384) { const int vsel = tid >> 6, cc = tid & 63; const float* src = vsel == 0 ? a.in[4] : vsel == 1 ? a.in[4] + 512 : vsel == 2 ? a.in[4] + 1024 : vsel == 3 ? a.in[10] : vsel == 4 ? a.in[11] : a.in[12];
        ((LAS float*)(lds + O_CONST))[vsel * 64 + cc] = src[hd * 64 + cc]; }
    v4u Qr0[2], Qk0[2], Qv0[2], Qr1[2], Qk1[2], Qv1[2], Qe[2], Qav[2];
#pragma unroll
    for (int u = 0; u < 2; ++u) { const int c = 2 * p + u; const size_t t = tb + c * 64 + tt; const bf16* prow = (tt == 0) ? halo + (size_t)(b * 64 + c) * 1536 : rkv + (t - 1) * 1536;
        Qr0[u] = *(const v4u*)(rkv + t * 1536 + gch); Qk0[u] = *(const v4u*)(rkv + t * 1536 + 512 + gch); Qv0[u] = *(const v4u*)(rkv + t * 1536 + 1024 + gch);
        Qr1[u] = *(const v4u*)(prow + gch); Qk1[u] = *(const v4u*)(prow + 512 + gch); Qv1[u] = *(const v4u*)(prow + 1024 + gch);
        Qe[u] = *(const v4u*)(E + t * 512 + gch); Qav[u] = *(const v4u*)(Aa + t * 512 + gch); }
#pragma unroll
    for (int u = 0; u < 2; ++u) { const int c = 2 * p + u;
        const size_t t = tb + c * 64 + tt;
        const v4u Lr0 = Qr0[u], Lk0 = Qk0[u], Lv0 = Qv0[u], Lr1 = Qr1[u], Lk1 = Qk1[u], Lv1 = Qv1[u], Le = Qe[u], Lav = Qav[u];
        __syncthreads();
        float e8[8], lr8[8], r8[8], k8[8], v8[8];
        { const unsigned ew[4] = {Le.x, Le.y, Le.z, Le.w}, aw[4] = {Lav.x, Lav.y, Lav.z, Lav.w};
          const unsigned r0[4] = {Lr0.x, Lr0.y, Lr0.z, Lr0.w}, r1[4] = {Lr1.x, Lr1.y, Lr1.z, Lr1.w}, k0[4] = {Lk0.x, Lk0.y, Lk0.z, Lk0.w}, k1[4] = {Lk1.x, Lk1.y, Lk1.z, Lk1.w}, v0[4] = {Lv0.x, Lv0.y, Lv0.z, Lv0.w}, v1[4] = {Lv1.x, Lv1.y, Lv1.z, Lv1.w};
#pragma unroll
          for (int i = 0; i < 8; ++i) { const int w = i >> 1; const bool hi = i & 1;
              e8[i] = hi ? bfhi(ew[w]) : bflo(ew[w]); lr8[i] = hi ? bfhi(aw[w]) : bflo(aw[w]);
              const float rc = hi ? bfhi(r0[w]) : bflo(r0[w]), kc = hi ? bfhi(k0[w]) : bflo(k0[w]), vc = hi ? bfhi(v0[w]) : bflo(v0[w]);
              const float rp = hi ? bfhi(r1[w]) : bflo(r1[w]), kp = hi ? bfhi(k1[w]) : bflo(k1[w]), vp = hi ? bfhi(v1[w]) : bflo(v1[w]);
              const LAS float* cst = (const LAS float*)(lds + O_CONST) + ch0 + i;
              r8[i] = rc + (rp - rc) * cst[0]; k8[i] = kc + (kp - kc) * cst[64]; v8[i] = vc + (vp - vc) * cst[128]; } }
        { LAS float* ep = (LAS float*)(lds + O_EP) + tt * 68 + ch0; *(LAS f32x4*)ep = (f32x4){e8[0], e8[1], e8[2], e8[3]}; *(LAS f32x4*)(ep + 4) = (f32x4){e8[4], e8[5], e8[6], e8[7]}; }
        __syncthreads();
        { const int k = tid & 63, seg = tid >> 6; LAS float* col = (LAS float*)(lds + O_EP) + (seg * 8) * 68 + k; float pre[8], run = 0.f;
#pragma unroll
          for (int i = 0; i < 8; ++i) { run += col[i * 68]; pre[i] = run; }
          LAS float* tots = (LAS float*)(lds + O_EP) + 64 * 68;
          tots[seg * 64 + k] = run;
          __syncthreads();
          float base = 0.f;
#pragma unroll
          for (int s2 = 0; s2 < 7; ++s2) base += (s2 < seg) ? tots[s2 * 64 + k] : 0.f;
#pragma unroll
          for (int i = 0; i < 8; ++i) col[i * 68] = pre[i] + base; }
        VM_WAIT();
        __syncthreads();
        float ce[8], cep[8], cec[8];
        { const LAS float* epb = (const LAS float*)(lds + O_EP);
          const f32x4 c0 = *(const LAS f32x4*)(epb + tt * 68 + ch0), c1 = *(const LAS f32x4*)(epb + tt * 68 + ch0 + 4);
          const int tq = tt > 0 ? tt - 1 : 0; f32x4 p0 = *(const LAS f32x4*)(epb + tq * 68 + ch0), p1 = *(const LAS f32x4*)(epb + tq * 68 + ch0 + 4); if (tt == 0) { p0 = (f32x4){0.f, 0.f, 0.f, 0.f}; p1 = p0; }
          const f32x4 q0 = *(const LAS f32x4*)(epb + 63 * 68 + ch0), q1 = *(const LAS f32x4*)(epb + 63 * 68 + ch0 + 4);
#pragma unroll
          for (int i = 0; i < 4; ++i) { ce[i] = c0[i]; ce[4 + i] = c1[i]; cep[i] = p0[i]; cep[4 + i] = p1[i]; cec[i] = q0[i]; cec[4 + i] = q1[i]; } }
        { float kk[8], ss = 0.f;
#pragma unroll
          for (int i = 0; i < 8; ++i) { kk[i] = k8[i] * ((const LAS float*)(lds + O_CONST))[192 + ch0 + i]; ss += kk[i] * kk[i]; }
          ss = red8(ss); const float inv = 1.0f / fmaxf(sqrtf(ss), 1e-12f);
          float at[8], bt[8], kt[8], rt[8], bo = 0.f;
#pragma unroll
          for (int i = 0; i < 8; ++i) { const float kaw_i = ((const LAS float*)(lds + O_CONST))[256 + ch0 + i], rkw_i = ((const LAS float*)(lds + O_CONST))[320 + ch0 + i];
              const float kki = kk[i] * inv, km = k8[i] * (1.0f + (lr8[i] - 1.0f) * kaw_i), bbv = kki * lr8[i];
              const float gp = __expf(-cep[i]), gi = __expf(ce[i]), gt = __expf(-ce[i]);
              at[i] = -kki * gp; bt[i] = bbv * gi; kt[i] = km * gi; rt[i] = r8[i] * gt; bo += r8[i] * km * rkw_i; }
          bo = red8(bo);
          const int oz2 = opaque_zero(); const size_t t = tb + c * 64 + (tid >> 3) + oz2;
          if (kq == 0) __hip_atomic_store(bon + t * 8 + hd, bo, __ATOMIC_RELAXED, __HIP_MEMORY_SCOPE_AGENT);
          if (tt == 63) { float* gc = gcb + ((size_t)(b * 64 + c) * 8 + hd) * 64 + ch0; v4u g0, g1;
              g0.x = __builtin_bit_cast(unsigned, __expf(-cec[0])); g0.y = __builtin_bit_cast(unsigned, __expf(-cec[1])); g0.z = __builtin_bit_cast(unsigned, __expf(-cec[2])); g0.w = __builtin_bit_cast(unsigned, __expf(-cec[3]));
              g1.x = __builtin_bit_cast(unsigned, __expf(-cec[4])); g1.y = __builtin_bit_cast(unsigned, __expf(-cec[5])); g1.z = __builtin_bit_cast(unsigned, __expf(-cec[6])); g1.w = __builtin_bit_cast(unsigned, __expf(-cec[7]));
              st16_wt(gc, g0); st16_wt(gc + 4, g1); }
          st16_wt(orkv + t * 1536 + gch, (v4u){pk2(rt[0], rt[1]), pk2(rt[2], rt[3]), pk2(rt[4], rt[5]), pk2(rt[6], rt[7])});
          st16_wt(orkv + t * 1536 + 512 + gch, (v4u){pk2(kt[0], kt[1]), pk2(kt[2], kt[3]), pk2(kt[4], kt[5]), pk2(kt[6], kt[7])});
          st16_wt(orkv + t * 1536 + 1024 + gch, (v4u){pk2(v8[0], v8[1]), pk2(v8[2], v8[3]), pk2(v8[4], v8[5]), pk2(v8[6], v8[7])});
          st16_wt(oE + t * 512 + gch, (v4u){pk2(at[0], at[1]), pk2(at[2], at[3]), pk2(at[4], at[5]), pk2(at[6], at[7])});
          st16_wt(oA + t * 512 + gch, (v4u){pk2(bt[0], bt[1]), pk2(bt[2], bt[3]), pk2(bt[4], bt[5]), pk2(bt[6], bt[7])}); }
    }
    VM_WAIT(); __syncthreads();
    if (tid == 0) __hip_atomic_store((unsigned*)(ws + WS_CTL) + CW_PREP + bh * 32 + p, 1u, __ATOMIC_RELAXED, __HIP_MEMORY_SCOPE_AGENT);
}
__device__ __forceinline__ void scan_unit_chunked(const Args& a, LAS unsigned char* lds, int tid, int bh) {
    using namespace wkv;
    unsigned char* ws = a.ws;
    const int b = bh >> 3, hd = bh & 7, wave = __builtin_amdgcn_readfirstlane(tid >> 6);
#ifdef SHADOW_DBG
    const bf16* rkv = b == 0 ? (const bf16*)(ws + 368 * MiB) : (const bf16*)(ws + WS_RKV); const bf16* E = b == 0 ? (const bf16*)(ws + 380 * MiB) : (const bf16*)(ws + WS_E); const bf16* Aa = b == 0 ? (const bf16*)(ws + 384 * MiB) : (const bf16*)(ws + WS_A);
#else
    const bf16* rkv = (const bf16*)(ws + WS_RKV); const bf16* E = (const bf16*)(ws + WS_E); const bf16* Aa = (const bf16*)(ws + WS_A);
#endif
    float* bon = (float*)(ws + WS_BON); bf16* Y = y_ptr(a.out, b);
    const size_t tb = (size_t)b * SEQ;
    int oz = opaque_zero();
#define WKV_TAINT() asm volatile("" : "+v"(oz))
    const int gch = hd * 64 + (tid & 7) * 8;
    const float* gcb = (const float*)(ws + WS_GCB); const unsigned* flags = (const unsigned*)(ws + WS_CTL) + CW_PREP + bh * 32;
    auto flag_ld = [&](int pair) { return __hip_atomic_load(flags + pair, __ATOMIC_RELAXED, __HIP_MEMORY_SCOPE_AGENT); };
    f32x4 gA, gB;
    auto load_raw = [&](int c, Raw& L) { const int tt = tid >> 3; const size_t t = tb + c * 64 + tt;
        L.r0 = *(const v4u*)(rkv + t * 1536 + gch); L.k0 = *(const v4u*)(rkv + t * 1536 + 512 + gch); L.v0 = *(const v4u*)(rkv + t * 1536 + 1024 + gch);
        L.e = *(const v4u*)(E + t * 512 + gch); L.av = *(const v4u*)(Aa + t * 512 + gch);
        const float* g = gcb + ((size_t)(b * 64 + c) * 8 + hd) * 64 + (tid & 7) * 8; gA = *(const f32x4*)g; gB = *(const f32x4*)(g + 4); };
    const int mb = wave >> 1, nb0 = (wave & 1) * 2;
    WKV_TAINT();
#pragma unroll 1
    for (int i = tid + oz; i < 64 * 64; i += NTHR) *(LAS float*)(lds + O_S + (i >> 6) * PF + (i & 63) * 4) = 0.f;
#if defined(PROBE_PHASE) && PROBE_PHASE >= 300 && PROBE_PHASE < 320
    unsigned long long tlast = __builtin_amdgcn_s_memrealtime(); unsigned tacc[12] = {0u, 0u, 0u, 0u, 0u, 0u, 0u, 0u, 0u, 0u, 0u, 0u};
#define WKV_STAMP(k) do { const unsigned long long tn = __builtin_amdgcn_s_memrealtime(); tacc[k] += (unsigned)(tn - tlast); tlast = tn; } while (0)
#else
#define WKV_STAMP(k) do { } while (0)
#endif
    while (flag_ld(0) == 0u) __builtin_amdgcn_s_sleep(4);
    asm volatile("" ::: "memory");
    Raw L; load_raw(0, L);
    unsigned fl = flag_ld(1);
    v2u ypk[2] = {(v2u){0u, 0u}, (v2u){0u, 0u}};
    auto store_y = [&](int c) { const int lane = (tid & 63) + oz, c16 = lane & 15, rg = lane >> 4;
#pragma unroll
        for (int j = 0; j < 2; ++j) { const int t = 16 * (nb0 + j) + c16, v0 = 16 * mb + 4 * rg;
            asm volatile("global_store_dwordx2 %0, %1, off sc1\n\ts_nop 4" :: "v"(Y + (size_t)(c * 64 + t) * 512 + hd * 64 + v0), "v"(ypk[j]) : "memory"); } };
    for (int c = 0; c < SEQ / 64; ++c) {
        __syncthreads();
        WKV_STAMP(10);
        WKV_TAINT(); const int td0 = tid + oz, tt = td0 >> 3, kq = td0 & 7, ch0 = kq * 8;
        { const int ro = tt * P + ch0 * 2;
          const float g8[8] = {gA[0], gA[1], gA[2], gA[3], gB[0], gB[1], gB[2], gB[3]};
          const unsigned bw[4] = {L.av.x, L.av.y, L.av.z, L.av.w}, kw[4] = {L.k0.x, L.k0.y, L.k0.z, L.k0.w}; unsigned bh4[4], kh4[4];
#pragma unroll
          for (int w = 0; w < 4; ++w) { bh4[w] = pk2(bflo(bw[w]) * g8[2 * w], bfhi(bw[w]) * g8[2 * w + 1]); kh4[w] = pk2(bflo(kw[w]) * g8[2 * w], bfhi(kw[w]) * g8[2 * w + 1]); }
          *(LAS v4u*)(lds + O_AT + ro) = L.e; *(LAS v4u*)(lds + O_BTL + ro) = L.av; *(LAS v4u*)(lds + O_KTL + ro) = L.k0; *(LAS v4u*)(lds + O_RT + ro) = L.r0;
          *(LAS v4u*)(lds + O_MABH + ro) = (v4u){bh4[0], bh4[1], bh4[2], bh4[3]}; *(LAS v4u*)(lds + O_MRB + ro) = (v4u){kh4[0], kh4[1], kh4[2], kh4[3]}; *(LAS v4u*)(lds + O_MRK + ro) = L.v0;
          if (tt == 0) { LAS float* gc = (LAS float*)(lds + O_GC) + ch0; *(LAS f32x4*)gc = (f32x4){g8[0], g8[1], g8[2], g8[3]}; *(LAS f32x4*)(gc + 4) = (f32x4){g8[4], g8[5], g8[6], g8[7]}; } }
        asm volatile("" :: "v"(L.r0), "v"(L.k0), "v"(L.v0), "v"(gA), "v"(gB), "v"(L.e), "v"(L.av) : "memory");
        if (c > 0) store_y(c - 1);
        if (c + 1 < SEQ / 64) { const int n = c + 1;
            if ((n & 1) == 0) { while (fl == 0u) { __builtin_amdgcn_s_sleep(4); fl = flag_ld(n >> 1); } }
            asm volatile("" ::: "memory");
            load_raw(n, L);
            if ((n & 1) == 0 && n + 2 < SEQ / 64) fl = flag_ld((n >> 1) + 1); }
        __syncthreads(); WKV_STAMP(9);
        { WKV_TAINT(); const int lane = (tid & 63) + oz, c16 = lane & 15, rg = lane >> 4;
#pragma unroll
          for (int j = 0; j < 2; ++j) { const int nb = nb0 + j; f32x4 d0 = (f32x4){0.f, 0.f, 0.f, 0.f}, d1 = d0, d2 = d0, d3 = d0;
#pragma unroll
              for (int ks = 0; ks < 2; ++ks) { const bf16x8 idf = ident_frag(16 * nb + c16, ks, rg); const int ao = (16 * mb + c16) * P + (32 * ks + 8 * rg) * 2;
                  d0 = mfma16(*(const LAS bf16x8*)(lds + O_AT + ao), idf, d0); d1 = mfma16(*(const LAS bf16x8*)(lds + O_MABH + ao), idf, d1);
                  d2 = mfma16(*(const LAS bf16x8*)(lds + O_MRB + ao), idf, d2); d3 = mfma16(*(const LAS bf16x8*)(lds + O_MRK + ao), idf, d3); }
              const int to = (16 * nb + c16) * P + (16 * mb + 4 * rg) * 2;
              st4_bf(lds, O_RHST + to, d0); st4_bf(lds, O_BHT + to, d1); st4_bf(lds, O_KHT + to, d2); st4_bf(lds, O_VRT + to, d3); }
          if (wave < 4) { const int m0 = 16 * wave + 4 * rg; f32x4 d = mm_blk<64>(lds, O_BTL, P, O_AT, P, 16 * wave, 16 * wave, lane, (f32x4){0.f, 0.f, 0.f, 0.f});
#pragma unroll
              for (int e = 0; e < 4; ++e) d[e] = (m0 + e < 16 * wave + c16) ? d[e] : 0.f;
              *(LAS f32x4*)(lds + O_DIAG + ((wave * 16 + c16) * 16 + 4 * rg) * 4) = d; } }
        __syncthreads(); WKV_STAMP(0);
        WKV_TAINT();
        if (wave == 0) { const int td2 = (tid & 63) + oz, blk = td2 >> 4, cc = td2 & 15; const LAS float* D = (const LAS float*)(lds + O_DIAG) + blk * 256; float Tc[16];
#pragma unroll
            for (int r4 = 0; r4 < 4; ++r4) { f32x4 dr[4][4];
#pragma unroll
                for (int rr = 0; rr < 4; ++rr)
#pragma unroll
                    for (int q = 0; q <= r4; ++q) dr[rr][q] = *(const LAS f32x4*)(D + (4 * r4 + rr) * 16 + 4 * q);
#pragma unroll
                for (int rr = 0; rr < 4; ++rr) { const int r = 4 * r4 + rr; float sacc = (r == cc) ? 1.f : 0.f;
#pragma unroll
                    for (int j = 0; j < r; ++j) sacc += dr[rr][j >> 2][j & 3] * Tc[j];
                    Tc[r] = sacc; } }
#pragma unroll
            for (int r = 0; r < 16; ++r) { st_bf(lds, O_TII + (blk * 16 + r) * PO + cc * 2, Tc[r]); st_bf(lds, O_TII + (blk * 16 + r) * PO + (16 + cc) * 2, 0.f); }
        } else { const int lane = (tid & 63) + oz, c16 = lane & 15, rg = lane >> 4;
            constexpr unsigned PA = 0u | (0u << 2) | (0u << 4) | (0u << 6) | (1u << 8) | (1u << 10) | (1u << 12) | (2u << 14) | (2u << 16) | (3u << 18);
            constexpr unsigned PB = 0u | (1u << 2) | (2u << 4) | (3u << 6) | (1u << 8) | (2u << 10) | (3u << 12) | (2u << 14) | (3u << 16) | (3u << 18);
            constexpr unsigned ZA = 1u | (2u << 2) | (3u << 4) | (2u << 6) | (3u << 8) | (3u << 10), ZB = 0u | (0u << 2) | (0u << 4) | (1u << 6) | (1u << 8) | (2u << 10);
            bf16x8 fa[6][2], fb[6][2]; int oo[6], sg[6], th[6], dd[6];
#pragma unroll
            for (int k = 0; k < 6; ++k) { int it = wave - 1 + 7 * k; it = it < 40 ? it : 39; const int pr = it / 10, q = it - 10 * pr;
                const int lo = (PA >> (2 * q)) & 3, hb = (PB >> (2 * q)) & 3; const int mb1 = (pr == 1) ? hb : lo, nb1 = (pr == 1) ? lo : hb;
                const int aimg = (pr == 1) ? O_AT : (pr == 3) ? O_KTL : O_BTL, bimg = (pr == 0) ? O_AT : (pr == 1) ? O_KTL : O_RT;
                const int oimg = (pr == 0) ? O_MABH : (pr == 1) ? O_RHST + U : (pr == 2) ? O_MRB : O_MRK;
                const int ao = aimg + (16 * mb1 + c16) * P + 16 * rg, bo = bimg + (16 * nb1 + c16) * P + 16 * rg;
                fa[k][0] = *(const LAS bf16x8*)(lds + ao); fa[k][1] = *(const LAS bf16x8*)(lds + ao + 64); fb[k][0] = *(const LAS bf16x8*)(lds + bo); fb[k][1] = *(const LAS bf16x8*)(lds + bo + 64);
                oo[k] = oimg + (16 * nb1 + c16) * P + (16 * mb1 + 4 * rg) * 2; dd[k] = (16 * mb1 + 4 * rg) - (16 * nb1 + c16);
                sg[k] = (pr == 1) ? -1 : 1; th[k] = (pr >= 2) ? 1 : 0; }
            f32x4 rr[6];
#pragma unroll
            for (int k = 0; k < 6; ++k) { rr[k] = mfma16(fa[k][0], fb[k][0], (f32x4){0.f, 0.f, 0.f, 0.f}); rr[k] = mfma16(fa[k][1], fb[k][1], rr[k]); }
#pragma unroll
            for (int k = 0; k < 6; ++k) {
#pragma unroll
                for (int e = 0; e < 4; ++e) rr[k][e] = (sg[k] * (dd[k] + e) < th[k]) ? rr[k][e] : 0.f;
                st4_bf(lds, oo[k], rr[k]); }
#pragma unroll
            for (int k = 0; k < 4; ++k) { int zi = wave - 1 + 7 * k; zi = zi < 24 ? zi : 23; const int pr = zi / 6, q = zi - 6 * pr;
                const int hb = (ZA >> (2 * q)) & 3, lo = (ZB >> (2 * q)) & 3; const int mb1 = (pr == 1) ? lo : hb, nb1 = (pr == 1) ? hb : lo;
                const int oimg = (pr == 0) ? O_MABH : (pr == 1) ? O_RHST + U : (pr == 2) ? O_MRB : O_MRK;
                st4_bf(lds, oimg + (16 * nb1 + c16) * P + (16 * mb1 + 4 * rg) * 2, (f32x4){0.f, 0.f, 0.f, 0.f}); } }
        __syncthreads(); WKV_STAMP(1); WKV_STAMP(2);
        { WKV_TAINT(); const int lane = (tid & 63) + oz; const v4u z = (v4u){0u, 0u, 0u, 0u};
#pragma unroll
          for (int i = 0; i < 3; ++i) { const int idx = lane + 64 * i; if (idx < 16 * 9) *(LAS v4u*)(lds + O_XT + (16 * wave + idx / 9) * P + (idx % 9) * 16) = z; }
          if (lane < 32) *(LAS v4u*)(lds + O_OUTB + wave * 16 * PO + (lane >> 1) * PO + 32 + (lane & 1) * 16) = z;
          LDS_WAIT(); }
#pragma unroll 1
        for (int i = 0; i < 4; ++i) { WKV_TAINT(); const int lane = (tid & 63) + oz, c16 = lane & 15, rg = lane >> 4;
            f32x4 acc = (f32x4){0.f, 0.f, 0.f, 0.f};
            if (i > 0) acc = mm_blk<64>(lds, O_MABH, P, O_XT, P, 16 * i, 16 * wave, lane, acc);
            acc += ld4_bf(lds, O_RHST + (16 * wave + c16) * P + (16 * i + 4 * rg) * 2);
            st4_bf(lds, O_OUTB + wave * 16 * PO + c16 * PO + (4 * rg) * 2, acc);
            LDS_WAIT();
            f32x4 x = mm_blk<32>(lds, O_TII + i * 16 * PO, PO, O_OUTB + wave * 16 * PO, PO, 0, 0, lane, (f32x4){0.f, 0.f, 0.f, 0.f});
            st4_bf(lds, O_XT + (16 * wave + c16) * P + (16 * i + 4 * rg) * 2, x);
            LDS_WAIT();
        }
        __syncthreads(); WKV_STAMP(3);
        { WKV_TAINT(); const int lane = (tid & 63) + oz, c16 = lane & 15, rg = lane >> 4; f32x4 acc[4][2];
#pragma unroll
          for (int j = 0; j < 2; ++j) { const int nb = nb0 + j; const f32x4 z = (f32x4){0.f, 0.f, 0.f, 0.f};
              acc[0][j] = mm_blk<64>(lds, O_XT, P, O_MRB, P, 16 * mb, 16 * nb, lane, z);
              acc[1][j] = mm_blk<64>(lds, O_XT + U, P, O_MRB, P, 16 * mb, 16 * nb, lane, z);
              acc[2][j] = mm_blk<64>(lds, O_XT, P, O_BHT, P, 16 * mb, 16 * nb, lane, z);
              acc[3][j] = mm_blk<64>(lds, O_XT + U, P, O_BHT, P, 16 * mb, 16 * nb, lane, z); }
#pragma unroll
          for (int j = 0; j < 2; ++j) { const int n = 16 * (nb0 + j) + c16, m0 = 16 * mb + 4 * rg; const int o = n * P + m0 * 2;
              acc[0][j] += ld4_bf(lds, O_RT + o); acc[1][j] += ld4_bf(lds, O_MRK + o); acc[3][j] += ld4_bf(lds, O_KHT + o);
              if (n >= m0 && n < m0 + 4) acc[2][j][n - m0] += *(const LAS float*)(lds + O_GC + n * 4); }
          __syncthreads();
#pragma unroll
          for (int j = 0; j < 2; ++j) { const int n = 16 * (nb0 + j) + c16, m0 = 16 * mb + 4 * rg; const int o = n * P + m0 * 2;
              st4_bf(lds, O_G1 + o, acc[0][j]); st4_bf(lds, O_Z1 + o, acc[1][j]); st4_bf(lds, O_Z2 + o, acc[3][j]);
              f32x4 hi4, lo4;
#pragma unroll
              for (int e = 0; e < 4; ++e) { hi4[e] = __builtin_bit_cast(float, f2bf(acc[2][j][e]) << 16); lo4[e] = acc[2][j][e] - hi4[e]; }
              st4_bf(lds, O_RT + o, hi4); st4_bf(lds, O_KHT + o, lo4); } }
        { WKV_TAINT(); const int td5 = tid + oz, v = td5 >> 3, kq5 = (td5 & 7) * 8; const LAS float* sp = (const LAS float*)(lds + O_S + v * PF) + kq5;
          const f32x4 x0 = *(const LAS f32x4*)sp, x1 = *(const LAS f32x4*)(sp + 4); f32x4 h0, h1, l0, l1;
#pragma unroll
          for (int e = 0; e < 4; ++e) { h0[e] = __builtin_bit_cast(float, f2bf(x0[e]) << 16); l0[e] = x0[e] - h0[e]; h1[e] = __builtin_bit_cast(float, f2bf(x1[e]) << 16); l1[e] = x1[e] - h1[e]; }
          st4_bf(lds, O_MRB + v * P + kq5 * 2, h0); st4_bf(lds, O_MRB + v * P + kq5 * 2 + 8, h1); st4_bf(lds, O_MRK + v * P + kq5 * 2, l0); st4_bf(lds, O_MRK + v * P + kq5 * 2 + 8, l1); }
        __syncthreads(); WKV_STAMP(4);
        { WKV_TAINT(); const int lane = (tid & 63) + oz, c16 = lane & 15, rg = lane >> 4; f32x4 ay[2], as[2];
#pragma unroll
          for (int j = 0; j < 2; ++j) { const int nb = nb0 + j; const f32x4 z = (f32x4){0.f, 0.f, 0.f, 0.f};
              ay[j] = mm_blk<64>(lds, O_VRT, P, O_Z1, P, 16 * mb, 16 * nb, lane, z);
              ay[j] = mm_blk<64>(lds, O_MRB, P, O_G1, P, 16 * mb, 16 * nb, lane, ay[j]);
              ay[j] = mm_blk<64>(lds, O_MRK, P, O_G1, P, 16 * mb, 16 * nb, lane, ay[j]);
              as[j] = mm_blk<64>(lds, O_Z2, P, O_VRT, P, 16 * mb, 16 * nb, lane, z);
              as[j] = mm_blk<64>(lds, O_RT, P, O_MRB, P, 16 * mb, 16 * nb, lane, as[j]);
              as[j] = mm_blk<64>(lds, O_KHT, P, O_MRB, P, 16 * mb, 16 * nb, lane, as[j]);
              as[j] = mm_blk<64>(lds, O_RT, P, O_MRK, P, 16 * mb, 16 * nb, lane, as[j]); }
#pragma unroll
          for (int j = 0; j < 2; ++j) { const int t = 16 * (nb0 + j) + c16, v0 = 16 * mb + 4 * rg;
              ypk[j] = (v2u){pk2(ay[j][0], ay[j][1]), pk2(ay[j][2], ay[j][3])};
              *(LAS f32x4*)(lds + O_S + t * PF + v0 * 4) = as[j]; } }
        WKV_STAMP(5);
    }
    WKV_TAINT(); store_y(SEQ / 64 - 1);
    VM_WAIT(); __syncthreads();
    if (tid == 0) __hip_atomic_store((unsigned*)(ws + WS_CTL) + CW_SDONE + bh, 1u, __ATOMIC_RELAXED, __HIP_MEMORY_SCOPE_AGENT);
#if defined(PROBE_PHASE) && PROBE_PHASE >= 300 && PROBE_PHASE < 320
    if (tid == 0) atomicAdd((unsigned*)(ws + WS_CTL) + 96, tacc[PROBE_PHASE - 300]);
#endif
}
__device__ __forceinline__ void phase_orw(const Args& a, int lane, int wave, int vcu, int G) {
    unsigned char* ws = a.ws;
    const int gw = vcu * NWAVES + wave, NGW = G * NWAVES;
    const bf16* rkv = (const bf16*)(ws + WS_RKV); const bf16* Gg = (const bf16*)(ws + WS_G); const float* bon = (const float*)(ws + WS_BON);
    bf16* orw = (bf16*)((unsigned char*)a.out + OUT_ORWDF);
    const int ch = lane * 8;
    const f32x4 mv0 = *(const f32x4*)(a.in[4] + 1024 + ch), mv1 = *(const f32x4*)(a.in[4] + 1024 + ch + 4);
    const f32x4 lw0 = *(const f32x4*)(a.in[13] + ch), lw1 = *(const f32x4*)(a.in[13] + ch + 4), lb0 = *(const f32x4*)(a.in[14] + ch), lb1 = *(const f32x4*)(a.in[14] + ch + 4);
    const float muv[8] = {mv0[0], mv0[1], mv0[2], mv0[3], mv1[0], mv1[1], mv1[2], mv1[3]}, lnw[8] = {lw0[0], lw0[1], lw0[2], lw0[3], lw1[0], lw1[1], lw1[2], lw1[3]}, lnb[8] = {lb0[0], lb0[1], lb0[2], lb0[3], lb1[0], lb1[1], lb1[2], lb1[3]};
    constexpr int U = 4;
    for (int t0 = gw; t0 < T; t0 += NGW * U) {
        v4u ywv[U], vcv[U], vpv[U], gwv[U]; float bov[U];
#pragma unroll
        for (int u = 0; u < U; ++u) { const int t = t0 + u * NGW; if (t < T) { const int b = t >> 12, s = t & (SEQ - 1);
            ywv[u] = *(const v4u*)(y_ptr(a.out, b) + (size_t)s * 512 + ch); vcv[u] = *(const v4u*)(rkv + (size_t)t * 1536 + 1024 + ch);
            vpv[u] = vcv[u];
            gwv[u] = *(const v4u*)(Gg + (size_t)t * 512 + ch); bov[u] = bon[(size_t)t * 8 + (lane >> 3)]; } }
#pragma unroll
        for (int u = 0; u < U; ++u) { const int t = t0 + u * NGW; if (t < T) { const v4u yw = ywv[u], vc = vcv[u], vp = vpv[u], gw4 = gwv[u]; const float bo = bov[u];
        const f32x4 y0 = (f32x4){bflo(yw.x), bfhi(yw.x), bflo(yw.y), bfhi(yw.y)}, y1 = (f32x4){bflo(yw.z), bfhi(yw.z), bflo(yw.w), bfhi(yw.w)};
        float y[8] = {y0[0], y0[1], y0[2], y0[3], y1[0], y1[1], y1[2], y1[3]};
#ifdef BIS_SANITIZE
#pragma unroll
        for (int e = 0; e < 8; ++e) if (!(fabsf(y[e]) < 1e30f)) y[e] = 0.f;
#endif
        float sm = 0.f;
#pragma unroll
        for (int e = 0; e < 8; ++e) sm += y[e];
        const float mean = red8(sm) * (1.f / 64.f); float vs = 0.f;
#pragma unroll
        for (int e = 0; e < 8; ++e) { y[e] -= mean; vs += y[e] * y[e]; }
        const float rstd = 1.0f / sqrtf(red8(vs) * (1.f / 64.f) + 64e-5f);
        const unsigned vcw[4] = {vc.x, vc.y, vc.z, vc.w}, vpw[4] = {vp.x, vp.y, vp.z, vp.w}, gww[4] = {gw4.x, gw4.y, gw4.z, gw4.w}; float o[8];
#pragma unroll
        for (int e = 0; e < 8; ++e) { const int w = e >> 1; const bool hi = e & 1; const float c = hi ? bfhi(vcw[w]) : bflo(vcw[w]), p = hi ? bfhi(vpw[w]) : bflo(vpw[w]), g = hi ? bfhi(gww[w]) : bflo(gww[w]);
            const float v = c + (p - c) * muv[e]; o[e] = ((y[e] * rstd * lnw[e] + lnb[e]) + bo * v) * g; }
        v4u ov; ov.x = pk2(o[0], o[1]); ov.y = pk2(o[2], o[3]); ov.z = pk2(o[4], o[5]); ov.w = pk2(o[6], o[7]);
        *(v4u*)(orw + (size_t)t * 1024 + ch) = ov; } }
    }
}

__device__ __forceinline__ void orw_item(const Args& a, int tid, int bh, int part  ) {
    unsigned char* ws = a.ws; const int b = bh >> 3, hd = bh & 7;
    const int lane = tid & 63, wave = tid >> 6, sub = lane >> 3, kq = lane & 7, ch = hd * 64 + kq * 8;
    const bf16* rkv = (const bf16*)(ws + WS_RKV); const bf16* Gg = (const bf16*)(ws + WS_G); const float* bon = (const float*)(ws + WS_BON); const bf16* Y = y_ptr(a.out, b);
    bf16* orw = (bf16*)((unsigned char*)a.out + OUT_ORWDF);
    const f32x4 lw0 = *(const f32x4*)(a.in[13] + ch), lw1 = *(const f32x4*)(a.in[13] + ch + 4), lb0 = *(const f32x4*)(a.in[14] + ch), lb1 = *(const f32x4*)(a.in[14] + ch + 4);
    const float lnw[8] = {lw0[0], lw0[1], lw0[2], lw0[3], lw1[0], lw1[1], lw1[2], lw1[3]}, lnb[8] = {lb0[0], lb0[1], lb0[2], lb0[3], lb1[0], lb1[1], lb1[2], lb1[3]};
    constexpr int U = 8;
#pragma unroll 1
    for (int s0 = part * (SEQ / 4) + wave * 8 + sub; s0 < (part + 1) * (SEQ / 4); s0 += 64 * U) {
        v4u ywv[U], vcv[U], gwv[U]; float bov[U];
#pragma unroll
        for (int u = 0; u < U; ++u) { const int s = s0 + 64 * u; const size_t t = (size_t)b * SEQ + s;
            ywv[u] = *(const v4u*)(Y + (size_t)s * 512 + ch); vcv[u] = *(const v4u*)(rkv + t * 1536 + 1024 + ch); gwv[u] = *(const v4u*)(Gg + t * 512 + ch); bov[u] = bon[t * 8 + hd]; }
#pragma unroll
        for (int u = 0; u < U; ++u) { const int s = s0 + 64 * u; const size_t t = (size_t)b * SEQ + s; const v4u yw = ywv[u], vc = vcv[u], gw4 = gwv[u]; const float bo = bov[u];
            float y[8] = {bflo(yw.x), bfhi(yw.x), bflo(yw.y), bfhi(yw.y), bflo(yw.z), bfhi(yw.z), bflo(yw.w), bfhi(yw.w)};
            float sm = 0.f;
#pragma unroll
            for (int e = 0; e < 8; ++e) sm += y[e];
            const float mean = red8(sm) * (1.f / 64.f); float vs = 0.f;
#pragma unroll
            for (int e = 0; e < 8; ++e) { y[e] -= mean; vs += y[e] * y[e]; }
            const float rstd = 1.0f / sqrtf(red8(vs) * (1.f / 64.f) + 64e-5f);
            const unsigned vcw[4] = {vc.x, vc.y, vc.z, vc.w}, gww[4] = {gw4.x, gw4.y, gw4.z, gw4.w}; float o[8];
#pragma unroll
            for (int e = 0; e < 8; ++e) { const int w = e >> 1; const bool hi = e & 1; const float v = hi ? bfhi(vcw[w]) : bflo(vcw[w]), g = hi ? bfhi(gww[w]) : bflo(gww[w]);
                o[e] = ((y[e] * rstd * lnw[e] + lnb[e]) + bo * v) * g; }
            v4u ov; ov.x = pk2(o[0], o[1]); ov.y = pk2(o[2], o[3]); ov.z = pk2(o[4], o[5]); ov.w = pk2(o[6], o[7]);
            *(v4u*)(orw + t * 1024 + ch) = ov; }
    }
}

__device__ __forceinline__ int crow(int r, int hi) { return (r & 3) + 8 * (r >> 2) + 4 * hi; }
constexpr int AT_BUF = 24576;
__device__ __forceinline__ int at_addr(int row, int ch) { return row * 128 + ((ch ^ ((row >> 1) & 7)) << 4); }
__device__ __forceinline__ void attn_pass(const bf16* qn, const bf16* kn, const bf16* vt, int b, int head, int c, int qb, LAS unsigned char* lds, int tid, f32x16 (&o)[4]) {
    const int lane = tid & 63, wave = __builtin_amdgcn_readfirstlane(tid >> 6), r32 = lane & 31, hi = lane >> 5;
    const int vh = b * 8 + head * 2 + c; const int q0 = qb * 256, qw0 = q0 + wave * 32, qrow = qw0 + r32;
    const bf16* Qp = qn + ((size_t)(vh & 7) * SEQ + qrow) * 64;
    s16x8 qf[4];
#pragma unroll
    for (int ks = 0; ks < 4; ++ks) qf[ks] = *(const s16x8*)(Qp + 16 * ks + 8 * hi);
    const int k_row = tid >> 3, k_ch = tid & 7;
    const bf16* ksrc = kn + (size_t)(vh & 7) * SEQ * 64 + k_row * 64 + k_ch * 8; const int kdst = at_addr(k_row, k_ch);
    const int dv0 = tid >> 3, dv1 = 64 + (tid >> 3);
    const bf16* vsrc0 = vt + (size_t)(head * 128 + dv0) * T + (size_t)b * SEQ + k_ch * 8; const bf16* vsrc1 = vsrc0 + (size_t)64 * T;
    constexpr int VB = 16384;
    const int vdst0 = at_addr(dv0, k_ch), vdst1 = at_addr(dv1, k_ch); const bool vsw0 = (dv0 & 16) != 0, vsw1 = (dv1 & 16) != 0;
    const int NT = 4 * qb + 4;
    const bool late = wave >= 4;
    v4u kreg = *(const v4u*)ksrc, vreg0 = *(const v4u*)vsrc0, vreg1 = *(const v4u*)vsrc1;
    __syncthreads();
    *(LAS v4u*)(lds + kdst) = kreg; *(LAS v4u*)(lds + VB + vdst0) = vsw0 ? (v4u){vreg0.z, vreg0.w, vreg0.x, vreg0.y} : vreg0; *(LAS v4u*)(lds + VB + vdst1) = vsw1 ? (v4u){vreg1.z, vreg1.w, vreg1.x, vreg1.y} : vreg1;
    __syncthreads();
    float m = 0.f, l = 0.f;
#pragma unroll
    for (int db = 0; db < 4; ++db)
#pragma unroll
        for (int i = 0; i < 16; ++i) o[db][i] = 0.f;
    v4u pw[4]; bool pend = false;
    auto pv = [&](int vbase) {
        auto ldv = [&](int db, s16x8 (&av)[4]) { const int dv = 32 * db + r32; const int vb = vbase + dv * 128 + 8 * (hi ^ ((dv >> 4) & 1)), sw = (dv >> 1) & 7;
#pragma unroll
            for (int s4 = 0; s4 < 4; ++s4) { const s16x4 lo = *(const LAS s16x4*)(lds + vb + (((2 * s4) ^ sw) << 4)); const s16x4 hh = *(const LAS s16x4*)(lds + vb + (((2 * s4 + 1) ^ sw) << 4));
                av[s4] = (s16x8){lo[0], lo[1], lo[2], lo[3], hh[0], hh[1], hh[2], hh[3]}; } };
        s16x8 avA[4], avB[4];
        ldv(0, avA);
        __builtin_amdgcn_sched_barrier(0);
#pragma unroll
        for (int db = 0; db < 4; ++db) {
            if (db < 3) { if (db & 1) ldv(db + 1, avA); else ldv(db + 1, avB); }
#pragma unroll
            for (int s4 = 0; s4 < 4; ++s4) o[db] = __builtin_amdgcn_mfma_f32_32x32x16_bf16((db & 1) ? avB[s4] : avA[s4], __builtin_bit_cast(s16x8, pw[s4]), o[db], 0, 0, 0);
            __builtin_amdgcn_sched_barrier(0); } };
    int vi = 0;
    for (int j = 0; j < NT; ++j) {
        const int kcur = (j & 1) * 8192, knxt = 8192 - kcur; const int vin = (vi == 2) ? 0 : vi + 1, vip = (vi == 0) ? 2 : vi - 1;
        const int vcur = VB + vi * 16384, vnxt = VB + vin * 16384, vprev = VB + vip * 16384; const bool more = j + 1 < NT;
        if (more) { kreg = *(const v4u*)(ksrc + (size_t)(j + 1) * 64 * 64); vreg0 = *(const v4u*)(vsrc0 + (j + 1) * 64); vreg1 = *(const v4u*)(vsrc1 + (j + 1) * 64); }
        if (pend) { pv(vprev); pend = false; }
        const int kv0 = j * 64;
        if (kv0 <= qw0 + 31) {
            f32x16 s0, s1;
            const float nm = -m;
            f32x16 sinit;
#pragma unroll
            for (int i = 0; i < 16; ++i) sinit[i] = nm;
            __builtin_amdgcn_s_setprio(1);
#pragma unroll
            for (int ks = 0; ks < 4; ++ks) {
                const s16x8 a0 = *(const LAS s16x8*)(lds + kcur + at_addr(r32, 2 * ks + hi));
                const s16x8 a1 = *(const LAS s16x8*)(lds + kcur + at_addr(32 + r32, 2 * ks + hi));
                s0 = __builtin_amdgcn_mfma_f32_32x32x16_bf16(a0, qf[ks], ks == 0 ? sinit : s0, 0, 0, 0);
                s1 = __builtin_amdgcn_mfma_f32_32x32x16_bf16(a1, qf[ks], ks == 0 ? sinit : s1, 0, 0, 0);
            }
            __builtin_amdgcn_s_setprio(0);
            if (kv0 + 63 > qw0) {
#pragma unroll
                for (int i = 0; i < 16; ++i) { const int kv = kv0 + crow(i, hi); if (kv > qrow) s0[i] = -1e30f; if (kv + 32 > qrow) s1[i] = -1e30f; }
            }
            float rm = fmaxf(s0[0], s1[0]);
            float rm2 = fmaxf(s0[1], s1[1]);
#pragma unroll
            for (int i = 2; i < 16; i += 2) { rm = fmaxf(fmaxf(rm, s0[i]), s1[i]); rm2 = fmaxf(fmaxf(rm2, s0[i + 1]), s1[i + 1]); }
            rm = fmaxf(rm, rm2);
            if (j == 0 || __any(rm > 8.f)) { rm = xhalf_max(rm);
                const float d = (j == 0) ? rm : fmaxf(rm, 0.f); const float f = (j == 0) ? 1.0f : __builtin_amdgcn_exp2f(-d); m += d; l *= f;
#pragma unroll
                for (int i = 0; i < 16; ++i) { s0[i] -= d; s1[i] -= d; }
#pragma unroll
                for (int db = 0; db < 4; ++db)
#pragma unroll
                    for (int i = 0; i < 16; ++i) o[db][i] *= f;
            }
            float ps = 0.f;
#pragma unroll
            for (int i = 0; i < 16; ++i) { s0[i] = __builtin_amdgcn_exp2f(s0[i]); s1[i] = __builtin_amdgcn_exp2f(s1[i]); ps += s0[i] + s1[i]; }
            l += ps;
            pw[0] = (v4u){pk2(s0[0], s0[1]), pk2(s0[2], s0[3]), pk2(s0[4], s0[5]), pk2(s0[6], s0[7])};
            pw[1] = (v4u){pk2(s0[8], s0[9]), pk2(s0[10], s0[11]), pk2(s0[12], s0[13]), pk2(s0[14], s0[15])};
            pw[2] = (v4u){pk2(s1[0], s1[1]), pk2(s1[2], s1[3]), pk2(s1[4], s1[5]), pk2(s1[6], s1[7])};
            pw[3] = (v4u){pk2(s1[8], s1[9]), pk2(s1[10], s1[11]), pk2(s1[12], s1[13]), pk2(s1[14], s1[15])};
            if (late) pend = true; else pv(vcur);
        }
        if (more) { *(LAS v4u*)(lds + knxt + kdst) = kreg; *(LAS v4u*)(lds + vnxt + vdst0) = vsw0 ? (v4u){vreg0.z, vreg0.w, vreg0.x, vreg0.y} : vreg0; *(LAS v4u*)(lds + vnxt + vdst1) = vsw1 ? (v4u){vreg1.z, vreg1.w, vreg1.x, vreg1.y} : vreg1; }
        __syncthreads();
        vi = vin;
    }
    if (pend) pv(VB + ((vi == 0) ? 2 : vi - 1) * 16384);
    l = xhalf_sum(l);
    const float il = 1.0f / l;
#pragma unroll
    for (int db = 0; db < 4; ++db)
#pragma unroll
        for (int i = 0; i < 16; ++i) o[db][i] *= il;
}
__device__ __forceinline__ void attn_unit(const Args& a, LAS unsigned char* lds, int tid, int b, int head, int qb, float* stash  ) {
    unsigned char* ws = a.ws;
    const bf16* qn = qn_ptr(ws, b); const bf16* kn = kn_ptr(ws, b); const bf16* vt = (const bf16*)(ws + WS_VT);
    bf16* odf = (bf16*)((unsigned char*)a.out + OUT_ORWDF) + 512;
    const int lane = tid & 63, wave = tid >> 6, r32 = lane & 31, hi = lane >> 5;
    const int oz = opaque_zero(); const int ll = lane + oz;
    const float d1 = wave_sum(a.in[17][ll] * a.in[18][ll]), d2 = wave_sum(a.in[19][ll] * a.in[20][ll]);
    const float lam = __expf(d1) - __expf(d2) + LAM_INIT;
    f32x16 o[4];
    attn_pass(qn, kn, vt, b, head, 0, qb, lds, tid, o);
    float* st = stash + tid * 64;
#pragma unroll
    for (int db = 0; db < 4; ++db)
#pragma unroll
        for (int g = 0; g < 4; ++g) *(f32x4*)(st + db * 16 + g * 4) = (f32x4){o[db][4 * g], o[db][4 * g + 1], o[db][4 * g + 2], o[db][4 * g + 3]};
#if defined(PROBE_PHASE) && PROBE_PHASE == 215
    if (head == 0) { bf16* dbg = (bf16*)(ws + 496 * MiB); const size_t tq = (size_t)b * SEQ + qb * 256 + wave * 32 + r32;
#pragma unroll
        for (int db = 0; db < 4; ++db)
#pragma unroll
            for (int g = 0; g < 4; ++g) { const int dv = 32 * db + 8 * g + 4 * hi; v2u ov; ov.x = pk2(o[db][4 * g], o[db][4 * g + 1]); ov.y = pk2(o[db][4 * g + 2], o[db][4 * g + 3]); *(v2u*)(dbg + tq * 128 + dv) = ov; } }
#endif
    attn_pass(qn, kn, vt, b, head, 1, qb, lds, tid, o);
    float ss = 0.f;
#pragma unroll
    for (int db = 0; db < 4; ++db)
#pragma unroll
        for (int g = 0; g < 4; ++g) { const f32x4 s4 = *(const f32x4*)(st + db * 16 + g * 4);
#pragma unroll
            for (int e = 0; e < 4; ++e) { const float d = s4[e] - lam * o[db][4 * g + e]; o[db][4 * g + e] = d; ss += d * d; } }
    ss = xhalf_sum(ss);
    const float rs = (1.0f / sqrtf(ss * (1.f / 128.f) + 1e-6f)) * (1.0f - LAM_INIT);
    const size_t t = (size_t)b * SEQ + qb * 256 + wave * 32 + r32; const float* sw = a.in[21];
#pragma unroll
    for (int db = 0; db < 4; ++db)
#pragma unroll
        for (int g = 0; g < 4; ++g) { const int dv = 32 * db + 8 * g + 4 * hi; const f32x4 w4 = *(const f32x4*)(sw + dv);
            v2u ov; ov.x = pk2(o[db][4 * g] * rs * w4[0], o[db][4 * g + 1] * rs * w4[1]); ov.y = pk2(o[db][4 * g + 2] * rs * w4[2], o[db][4 * g + 3] * rs * w4[3]);
            *(v2u*)(odf + t * 1024 + head * 128 + dv) = ov; }
}
#define XB_TMO      128
#define XB_XCNT(j)  (256  + 64 * (j))
#define XB_XSUB(j)  (1280 + 64 * (j))
#define XB_XGEN(j)  (2304 + 64 * (j))
#define XB_TOP      3328
#define XB_TOPGEN   3392
#define XCD_BAR_WORDS 3456
#define XB_SPIN_CAP (1u << 18)

__device__ __forceinline__ unsigned xb_ld(unsigned* p)              { return __hip_atomic_load(p, __ATOMIC_RELAXED, __HIP_MEMORY_SCOPE_AGENT); }
__device__ __forceinline__ unsigned xb_add(unsigned* p, unsigned v) { return __hip_atomic_fetch_add(p, v, __ATOMIC_RELAXED, __HIP_MEMORY_SCOPE_AGENT); }
__device__ __forceinline__ unsigned xb_xcc_id() { return (unsigned)__builtin_amdgcn_s_getreg((3 << 11) | 20) & 0xFu; }
#define XB_SPIN(cond, bar) do { unsigned _sp = 0; while (cond) { __builtin_amdgcn_s_sleep(1); \
    if ((++_sp & 255u) == 0u) { if (xb_ld(&(bar)[XB_TMO])) break; if (_sp > XB_SPIN_CAP) { atomicAdd(&(bar)[XB_TMO], 1u); break; } } } } while (0)

struct XcdBarrier {
    unsigned* bar; unsigned x;
    volatile LAS unsigned* st;
};

__device__ __forceinline__ XcdBarrier xcd_barrier_post(unsigned* bar, volatile LAS unsigned* st, int tid) {
    XcdBarrier b; b.bar = bar; b.x = xb_xcc_id(); b.st = st;
    if (tid == 0) (void)xb_add(&bar[XB_XCNT(b.x)], 1u);
    return b;
}
__device__ __forceinline__ void xcd_barrier_complete(unsigned* bar, unsigned x, unsigned& nloc, unsigned& nx) {
    const unsigned G = gridDim.x * gridDim.y * gridDim.z;
    unsigned sum, cnt, mine, sp = 0u;
    for (;;) {
        sum = 0u; cnt = 0u; mine = 0u;
#pragma unroll
        for (unsigned j = 0; j < 16; ++j) { const unsigned c = xb_ld(&bar[XB_XCNT(j)]); sum += c; cnt += (c > 0u) ? 1u : 0u; mine = (j == x) ? c : mine; }
        if (sum == G) break;
        __builtin_amdgcn_s_sleep(1);
        if ((++sp & 255u) == 0u) { if (xb_ld(&bar[XB_TMO])) break; if (sp > XB_SPIN_CAP) { atomicAdd(&bar[XB_TMO], 1u); break; } }
    }
    nloc = mine > 0u ? mine : 1u; nx = cnt > 0u ? cnt : 1u;
}

__device__ __forceinline__ void xcd_barrier(const XcdBarrier& b, int tid) {
    asm volatile("s_waitcnt vmcnt(0)" ::: "memory");
    __syncthreads();
    if (tid == 0) {
        unsigned* bar = b.bar;
        __builtin_amdgcn_s_waitcnt(0);
        unsigned nloc = b.st[0], nx = b.st[1];
        if (nloc == 0u) { xcd_barrier_complete(bar, b.x, nloc, nx); b.st[0] = nloc; b.st[1] = nx; }
        const unsigned old = xb_add(&bar[XB_XSUB(b.x)], 1u);
        const unsigned gen = old / nloc;
        if (old + 1u == (gen + 1u) * nloc) {
            __builtin_amdgcn_fence(__ATOMIC_RELEASE, "agent");
            asm volatile("s_waitcnt vmcnt(0)" ::: "memory");
            const unsigned og = xb_add(&bar[XB_TOP], 1u);
            const unsigned tg = og / nx;
            if (og + 1u == (tg + 1u) * nx) xb_add(&bar[XB_TOPGEN], 1u);
            else XB_SPIN(xb_ld(&bar[XB_TOPGEN]) == tg, bar);
            __builtin_amdgcn_fence(__ATOMIC_ACQUIRE, "agent");
            xb_add(&bar[XB_XGEN(b.x)], 1u);
            asm volatile("s_waitcnt vmcnt(0)" ::: "memory");
        } else {
            XB_SPIN(xb_ld(&bar[XB_XGEN(b.x)]) == gen, bar);
            __builtin_amdgcn_fence(__ATOMIC_ACQUIRE, "agent");
            asm volatile("s_waitcnt vmcnt(0)" ::: "memory");
        }
    }
    __syncthreads();
}

constexpr int TR_IGU = (1024 / 64) * (512 / 32);
constexpr int TR_IDN = (512 / 64) * (1024 / 32);
constexpr int WD_IDLE_END = 3584;
constexpr int WD_SPLIT = 0;
constexpr int NTRQ = 256, TRQ_PER_WAVE = NEXP * 2 * TR_IGU / (NTRQ * NWAVES);
__device__ __forceinline__ void tr_wgu_qitem(const Args& a, LAS unsigned char* lds, int lane, int wave, int q) {
    LAS float* scr = (LAS float*)(lds + wave * 16384); bf16* wgu = (bf16*)(a.ws + WS_WGU);
#pragma unroll 1
    for (int j = 0; j < TRQ_PER_WAVE; ++j) { const int it = (q * NWAVES + wave) * TRQ_PER_WAVE + j; const int e = it / (2 * TR_IGU); int r = it % (2 * TR_IGU);
        const int up = r >= TR_IGU; if (up) r -= TR_IGU; const int kb = r / 16, nb = r % 16, n0 = 32 * nb;
        const float* W = (up ? a.in[31] : a.in[30]) + (size_t)e * 1024 * 512;
        tr_item<true>(W, 512, wgu, 1024, 64 * kb, n0, (size_t)e * 1024 + (n0 >> 7) * 256 + (up ? 128 : 0) + (n0 & 127), 0, scr, lane, a.in[25]); }
}
__device__ __forceinline__ void tr_wd_all(const Args& a, LAS unsigned char* lds, int lane, int wave, int w0, int nw, int i0, int i1) {
    LAS float* scr = (LAS float*)(lds + wave * 16384); bf16* wd = (bf16*)(a.ws + WS_WD);
#pragma unroll 1
    for (int it = i0 + w0; it < i1; it += nw) { const int e = it / TR_IDN, r = it % TR_IDN, kb = r / 32, nb = r % 32;
        tr_item(a.in[32] + (size_t)e * 512 * 1024, 1024, wd, 512, 64 * kb, 32 * nb, (size_t)e * 1024 + 32 * nb, 0, scr, lane); }
}

__device__ __forceinline__ void route_tile(const Args& a, LAS unsigned char* lds, int tid, int pm) {
    unsigned char* ws = a.ws;
    const float* LG = (const float*)(ws + WS_LOGITS); int* toke = (int*)(ws + WS_TOKE); float* tokw = (float*)(ws + WS_TOKW); int* tilecnt = (int*)(ws + WS_TILECNT);
    LAS int* cnt = (LAS int*)lds;
    if (tid < 32) cnt[tid] = 0;
    __syncthreads();
    if (tid < 256) {
        const int t = pm * 256 + tid; const float* lr = LG + (size_t)t * 128;
        float rs;
        { const f32x4* sp = (const f32x4*)((const float*)(ws + WS_SSQ) + (size_t)t * 16); const f32x4 s0 = sp[0], s1 = sp[1], s2 = sp[2], s3 = sp[3];
          const float ss = (((s0[0] + s0[1]) + (s0[2] + s0[3])) + ((s1[0] + s1[1]) + (s1[2] + s1[3]))) + (((s2[0] + s2[1]) + (s2[2] + s2[3])) + ((s3[0] + s3[1]) + (s3[2] + s3[3])));
          rs = 1.0f / sqrtf(ss * (1.f / 1024.f) + 1e-6f); __hip_atomic_store((float*)(ws + WS_RS) + t, rs, __ATOMIC_RELAXED, __HIP_MEMORY_SCOPE_AGENT); }
        float gl[4];
#pragma unroll
        for (int j = 0; j < 4; ++j) gl[j] = lr[32 + j] * rs + a.in[27][j];
        int gi = 0; float gm = gl[0];
#pragma unroll
        for (int j = 1; j < 4; ++j) if (gl[j] > gm) { gm = gl[j]; gi = j; }
        float gs = 0.f;
#pragma unroll
        for (int j = 0; j < 4; ++j) gs += __expf(gl[j] - gm);
        const float gtop = 1.0f / gs;
        float el[8];
#pragma unroll
        for (int j = 0; j < 8; ++j) el[j] = lr[gi * 8 + j] * rs + a.in[29][gi * 8 + j];
        int i1 = 0; float e1 = el[0];
#pragma unroll
        for (int j = 1; j < 8; ++j) if (el[j] > e1) { e1 = el[j]; i1 = j; }
        int i2 = -1; float e2 = -3.0e38f;
#pragma unroll
        for (int j = 0; j < 8; ++j) if (j != i1 && el[j] > e2) { e2 = el[j]; i2 = j; }
        const float ex = __expf(e2 - e1); const float w1 = gtop / (1.0f + ex), w2 = gtop * ex / (1.0f + ex);
        const int x1 = gi * 8 + i1, x2 = gi * 8 + i2;
        __hip_atomic_store(toke + t * 2, x1, __ATOMIC_RELAXED, __HIP_MEMORY_SCOPE_AGENT); __hip_atomic_store(toke + t * 2 + 1, x2, __ATOMIC_RELAXED, __HIP_MEMORY_SCOPE_AGENT);
        __hip_atomic_store(tokw + t * 2, w1, __ATOMIC_RELAXED, __HIP_MEMORY_SCOPE_AGENT); __hip_atomic_store(tokw + t * 2 + 1, w2, __ATOMIC_RELAXED, __HIP_MEMORY_SCOPE_AGENT);
        atomicAdd((int*)&cnt[x1], 1); atomicAdd((int*)&cnt[x2], 1);
    }
    __syncthreads();
    if (tid < 32) __hip_atomic_store(tilecnt + pm * 32 + tid, cnt[tid], __ATOMIC_RELAXED, __HIP_MEMORY_SCOPE_AGENT);
    VM_WAIT(); __syncthreads();
    if (tid == 0) __hip_atomic_fetch_add((unsigned*)(ws + WS_CTL) + CW_RTDONE, 1u, __ATOMIC_RELAXED, __HIP_MEMORY_SCOPE_AGENT);
}

__device__ __forceinline__ void phase9(const Args& a, LAS unsigned char* lds, int tid, int lane, int wave) {
    unsigned char* ws = a.ws;
    const int tile = blockIdx.x;
    if (tile >= 128) return;
    if (tid == 0) { while (__hip_atomic_load((unsigned*)(ws + WS_CTL) + CW_RTDONE, __ATOMIC_RELAXED, __HIP_MEMORY_SCOPE_AGENT) < 128u) __builtin_amdgcn_s_sleep(4);
        __builtin_amdgcn_fence(__ATOMIC_ACQUIRE, "agent"); }
    __syncthreads();
    const int* tilecnt = (const int*)(ws + WS_TILECNT); const int* toke = (const int*)(ws + WS_TOKE); const float* tokw = (const float*)(ws + WS_TOKW);
    int* pos = (int*)(ws + WS_POS); float* roww = (float*)(ws + WS_ROWW); int* disp = (int*)(ws + WS_DISP); int* rowtok = (int*)(ws + WS_ROWTOK);
    LAS int* tc = (LAS int*)lds;
    LAS int* tot = tc + 4096;
    LAS int* bef = tot + 32;
    LAS int* base = bef + 32;
    LAS int* pst = base + 32;
    LAS int* earr = pst + 32;
    LAS int* parr = earr + 512;
    for (int i = tid; i < 4096; i += NTHR) tc[i] = tilecnt[i];
    earr[tid] = toke[tile * 512 + tid];
    __syncthreads();
    if (tid < 32) { int s = 0, b = 0; for (int t = 0; t < 128; ++t) { const int c = tc[t * 32 + tid]; s += c; if (t < tile) b += c; } tot[tid] = s; bef[tid] = b; }
    __syncthreads();
    if (tid == 0) { int p = 0; for (int e = 0; e < 32; ++e) { pst[e] = p; base[e] = p + bef[e]; const int nt = (tot[e] + 255) >> 8;
                        if (tile == 0) { for (int k = 0; k < nt; ++k) disp[16 + (p >> 8) + k] = e; disp[512 + e] = p; disp[576 + e] = tot[e]; }
                        p += nt << 8; }
                    if (tile == 0) disp[0] = p >> 8; }
    __syncthreads();
    for (int q = 0; q < 4; ++q) { const int e = wave * 4 + q; int running = 0;
        for (int c8 = 0; c8 < 8; ++c8) { const int ai = c8 * 64 + lane; const bool mt = earr[ai] == e; const unsigned long long mk = __ballot(mt);
            if (mt) parr[ai] = base[e] + running + __popcll(mk & ((1ull << lane) - 1ull));
            running += __popcll(mk); } }
    __syncthreads();
    { const int ai = tid, p = parr[ai], t = tile * 256 + (ai >> 1); pos[t * 2 + (ai & 1)] = p; roww[p] = tokw[t * 2 + (ai & 1)]; rowtok[p] = t; ((float*)(ws + WS_ROWRS))[p] = ((const float*)(ws + WS_RS))[t]; }
    if (tile < 32) { const int p0 = pst[tile] + tot[tile], p1 = pst[tile] + (((tot[tile] + 255) >> 8) << 8);
        for (int r = p0 + tid; r < p1; r += NTHR) { rowtok[r] = 0; roww[r] = 0.f; ((float*)(ws + WS_ROWRS))[r] = 0.f; } }
}

__device__ __forceinline__ void phase12(const Args& a, int tid, int lane, int wave, int vcu, int G) {
    unsigned char* ws = a.ws;
    const int gw = vcu * NWAVES + wave, NGW = G * NWAVES;
    const bf16* x1 = (const bf16*)a.out; bf16* x2 = (bf16*)(ws + WS_X2); const bf16* y2 = (const bf16*)(ws + WS_Y2); const int* pos = (const int*)(ws + WS_POS); float* rs3 = (float*)(ws + WS_RS);
    constexpr int U = 4;
    for (int m0 = gw; m0 < T; m0 += NGW * U) {
        int pa[U], pb[U]; v2u wx[U][4], wa[U][4], wb[U][4];
#pragma unroll
        for (int u = 0; u < U; ++u) { const int m = m0 + u * NGW; pa[u] = 0; pb[u] = 0; if (m < T) { pa[u] = pos[m * 2]; pb[u] = pos[m * 2 + 1]; } }
#pragma unroll
        for (int u = 0; u < U; ++u) { const int m = m0 + u * NGW; if (m < T) {
            const v2u* xr = (const v2u*)(x1 + (size_t)m * DM) + lane; const v2u* ya = (const v2u*)(y2 + (size_t)pa[u] * 1024) + lane; const v2u* yb = (const v2u*)(y2 + (size_t)pb[u] * 1024) + lane;
#pragma unroll
            for (int j = 0; j < 4; ++j) { wx[u][j] = xr[64 * j]; wa[u][j] = ya[64 * j]; wb[u][j] = yb[64 * j]; } } }
#pragma unroll
        for (int u = 0; u < U; ++u) { const int m = m0 + u * NGW; if (m < T) { v2u* xo = (v2u*)(x2 + (size_t)m * DM) + lane; float s = 0.f;
#pragma unroll
            for (int j = 0; j < 4; ++j) { const v2u x = wx[u][j], ya = wa[u][j], yb = wb[u][j]; f32x4 v;
                v.x = bflo(x.x) + bflo(ya.x) + bflo(yb.x); v.y = bfhi(x.x) + bfhi(ya.x) + bfhi(yb.x); v.z = bflo(x.y) + bflo(ya.y) + bflo(yb.y); v.w = bfhi(x.y) + bfhi(ya.y) + bfhi(yb.y);
                v2u o; o.x = pk2(v.x, v.y); o.y = pk2(v.z, v.w); xo[64 * j] = o;
                s += (v.x * v.x + v.y * v.y) + (v.z * v.z + v.w * v.w); }
            const float rstd = 1.0f / sqrtf(wave_sum(s) * (1.f / 1024.f) + 1e-6f);
            if (lane == 0) rs3[m] = rstd; } }
    }
}
__device__ __forceinline__ void pp_tile(const Args& a, LAS unsigned char* lds, int tid0, int pm, int K256, int pn0, int npn, bool conv) {
    const int oz = opaque_zero(); const int tid = tid0 + oz;
    unsigned char* ws = a.ws;
    const f32x4* p = (const f32x4*)a.in[1] + (size_t)pm * 256 * 64; v2u* p16 = (v2u*)(ws + WS_P16) + (size_t)pm * 256 * 64;
    if (conv) {
#pragma unroll 8
        for (int i = tid; i < 256 * 64; i += NTHR) { const f32x4 v = p[i]; v2u o; o.x = pk2(v.x, v.y); o.y = pk2(v.z, v.w); p16[i] = o; }
        VM_WAIT(); __syncthreads(); }
    pg8::Gemm g{(const pg8::bf16_t*)(ws + WS_P16), (const pg8::bf16_t*)(ws + WS_WPP), T, 1024, K256}; pg8::OrderItem S{pm, pn0, npn};
    pg8::EpiStore E{(pg8::bf16_t*)(ws + WS_PP), 1024};
    pg8::gemm_phase<pg8::EpiStore, pg8::OrderItem, true, true>(lds, g, S, E, tid);
}

#if defined(PROBE_PHASE) && (PROBE_PHASE == 200 || PROBE_PHASE == 201)
__device__ __forceinline__ float blk_sum(float v, LAS float* red, int tid) { v = wave_sum(v); __syncthreads(); if ((tid & 63) == 0) red[tid >> 6] = v; __syncthreads(); float s = 0.f; for (int i = 0; i < 8; ++i) s += red[i]; __syncthreads(); return s; }
__device__ __forceinline__ void check_moe(const Args& a, LAS unsigned char* lds, int tid, float* res) {
    unsigned char* ws = a.ws;
    LAS float* hb = (LAS float*)lds; LAS float* hf = hb + 1024; LAS float* act = hf + 1024; LAS float* lg = act + 512; LAS float* red = lg + 64; LAS int* sel = (LAS int*)(red + 16);
    const int* toke = (const int*)(ws + WS_TOKE); const float* tokw = (const float*)(ws + WS_TOKW); const int* pos = (const int*)(ws + WS_POS); const bf16* y2 = (const bf16*)(ws + WS_Y2);
    float errsum = 0.f, refsum = 0.f; int mism = 0;
    for (int si = 0; si < 24; ++si) { const int t = si * 1361 + 17;
        const bf16* xr = (const bf16*)a.out + (size_t)t * DM; const float x0 = __builtin_bit_cast(float, (unsigned)xr[tid] << 16), x1 = __builtin_bit_cast(float, (unsigned)xr[tid + 512] << 16);
        const float rstd = 1.0f / sqrtf(blk_sum(x0 * x0 + x1 * x1, red, tid) * (1.f / 1024.f) + 1e-6f);
        const float h0 = x0 * rstd * a.in[25][tid], h1 = x1 * rstd * a.in[25][tid + 512];
        hf[tid] = h0; hf[tid + 512] = h1; hb[tid] = __builtin_bit_cast(float, f2bf(h0) << 16); hb[tid + 512] = __builtin_bit_cast(float, f2bf(h1) << 16);
        __syncthreads();
        if (tid < 36) { float s = 0.f; for (int k = 0; k < 1024; ++k) s += hf[k] * (tid < 32 ? a.in[28][k * 32 + tid] : a.in[26][k * 4 + (tid - 32)]); lg[tid] = s + (tid < 32 ? a.in[29][tid] : a.in[27][tid - 32]); }
        __syncthreads();
        if (tid == 0) { int gi = 0; for (int j = 1; j < 4; ++j) if (lg[32 + j] > lg[32 + gi]) gi = j;
            int i1 = 0; for (int j = 1; j < 8; ++j) if (lg[gi * 8 + j] > lg[gi * 8 + i1]) i1 = j;
            int i2 = -1; for (int j = 0; j < 8; ++j) if (j != i1 && (i2 < 0 || lg[gi * 8 + j] > lg[gi * 8 + i2])) i2 = j;
            sel[0] = gi * 8 + i1; sel[1] = gi * 8 + i2; }
        __syncthreads();
        if (sel[0] != toke[t * 2] || sel[1] != toke[t * 2 + 1]) mism++;
        float o0 = 0.f, o1 = 0.f;
        for (int kx = 0; kx < 2; ++kx) { const int e = toke[t * 2 + kx]; const float w = tokw[t * 2 + kx];
            const float* Wg = a.in[30] + (size_t)e * 1024 * 512; const float* Wu = a.in[31] + (size_t)e * 1024 * 512; const float* Wd = a.in[32] + (size_t)e * 512 * 1024;
            float gg = 0.f, uu = 0.f; for (int k = 0; k < 1024; ++k) { const float hk = hb[k]; gg += hk * Wg[(size_t)k * 512 + tid]; uu += hk * Wu[(size_t)k * 512 + tid]; }
            __syncthreads(); act[tid] = gg / (1.0f + __expf(-gg)) * uu; __syncthreads();
            float s0 = 0.f, s1 = 0.f; for (int f = 0; f < 512; ++f) { const float af = act[f]; s0 += af * Wd[(size_t)f * 1024 + tid]; s1 += af * Wd[(size_t)f * 1024 + tid + 512]; }
            o0 += s0 * w; o1 += s1 * w; }
        const int pa = pos[t * 2], pb = pos[t * 2 + 1];
        const float m0 = __builtin_bit_cast(float, (unsigned)y2[(size_t)pa * 1024 + tid] << 16) + __builtin_bit_cast(float, (unsigned)y2[(size_t)pb * 1024 + tid] << 16);
        const float m1 = __builtin_bit_cast(float, (unsigned)y2[(size_t)pa * 1024 + tid + 512] << 16) + __builtin_bit_cast(float, (unsigned)y2[(size_t)pb * 1024 + tid + 512] << 16);
        errsum += (m0 - o0) * (m0 - o0) + (m1 - o1) * (m1 - o1); refsum += o0 * o0 + o1 * o1;
    }
    const float es = blk_sum(errsum, red, tid), rs = blk_sum(refsum, red, tid);
    if (tid == 0) *res = (PROBE_PHASE == 200) ? sqrtf(es / rs) : (float)mism / 24.f;
}
#endif

#ifndef PROBE_KAPPA
#define PROBE_KAPPA 0
#endif
#ifndef CHK_S0
#define CHK_S0 0
#define CHK_SN 4096
#endif
#if defined(PROBE_PHASE) && (PROBE_PHASE == 210 || PROBE_PHASE == 211 || PROBE_PHASE == 215)
__device__ __forceinline__ void check_attn(const Args& a, LAS unsigned char* lds, int tid, float* res) {
    unsigned char* ws = a.ws;
    const bf16* vt = (const bf16*)(ws + WS_VT);
    const bf16* odf = (const bf16*)((unsigned char*)a.out + OUT_ORWDF) + 512;
    LAS float* sc = (LAS float*)lds; LAS float* part = sc + 4096; LAS float* oc = part + 512; LAS float* red = oc + 256;
    const float d1 = wave_sum(a.in[17][tid & 63] * a.in[18][tid & 63]), d2 = wave_sum(a.in[19][tid & 63] * a.in[20][tid & 63]);
    const float lam = __expf(d1) - __expf(d2) + LAM_INIT;
    float errsum = 0.f, refsum = 0.f;
    for (int si = 0; si < 24; ++si) { const int b = si & 7, head = (PROBE_PHASE == 215) ? 0 : ((si >> 1) & 3), s = CHK_S0 + ((si * 977 + 31 * (si & 3)) % CHK_SN);
        for (int c = 0; c < 2; ++c) { const int vh = b * 8 + head * 2 + c;
            const bf16* qn = qn_ptr(ws, b); const bf16* kn = kn_ptr(ws, b); const bf16* qp = qn + ((size_t)(vh & 7) * SEQ + s) * 64; float mx = -3e38f;
            for (int j = tid; j <= s; j += NTHR) { const bf16* kp = kn + ((size_t)(vh & 7) * SEQ + j) * 64; float d = 0.f;
                for (int e = 0; e < 64; ++e) d += __builtin_bit_cast(float, (unsigned)qp[e] << 16) * __builtin_bit_cast(float, (unsigned)kp[e] << 16);
                sc[j] = d; mx = fmaxf(mx, d); }
            __syncthreads();
            for (int o = 1; o < 64; o <<= 1) mx = fmaxf(mx, __shfl_xor(mx, o));
            if ((tid & 63) == 0) red[tid >> 6] = mx;
            __syncthreads();
            mx = red[0]; for (int i = 1; i < 8; ++i) mx = fmaxf(mx, red[i]);
            __syncthreads();
            float ls = 0.f;
            for (int j = tid; j <= s; j += NTHR) { const float p = exp2f(sc[j] - mx); sc[j] = p; ls += p; }
            ls = wave_sum(ls); if ((tid & 63) == 0) red[tid >> 6] = ls;
            __syncthreads();
            float l = 0.f; for (int i = 0; i < 8; ++i) l += red[i];
            { const int dv = tid & 127, pr = tid >> 7; const bf16* vp = vt + (size_t)(head * 128 + dv) * T + (size_t)b * SEQ; float acc = 0.f;
              for (int j = pr; j <= s; j += 4) acc += sc[j] * __builtin_bit_cast(float, (unsigned)vp[j] << 16);
              part[tid] = acc; }
            __syncthreads();
            if (tid < 128) oc[c * 128 + tid] = (part[tid] + part[tid + 128] + part[tid + 256] + part[tid + 384]) / l;
            __syncthreads(); }
#if PROBE_PHASE == 215
        if (tid < 128) { const float ref = oc[tid]; const float got = __builtin_bit_cast(float, (unsigned)((const bf16*)(ws + 496 * MiB))[((size_t)b * SEQ + s) * 128 + tid] << 16); errsum += (PROBE_KAPPA ? got * ref : (got - ref) * (got - ref)); refsum += ref * ref; }
        __syncthreads(); continue;
#endif
        float dd = 0.f, sq = 0.f; if (tid < 128) { dd = oc[tid] - lam * oc[128 + tid]; sq = dd * dd; }
        sq = wave_sum(sq); __syncthreads(); if ((tid & 63) == 0) red[tid >> 6] = sq; __syncthreads();
        const float rs = (1.0f / sqrtf((red[0] + red[1]) * (1.f / 128.f) + 1e-6f)) * (1.0f - LAM_INIT);
        if (tid < 128) { const float ref = dd * rs * a.in[21][tid]; const float got = __builtin_bit_cast(float, (unsigned)odf[((size_t)b * SEQ + s) * 1024 + head * 128 + tid] << 16);
            errsum += (got - ref) * (got - ref); refsum += ref * ref; }
        __syncthreads(); }
    errsum = wave_sum(errsum); refsum = wave_sum(refsum);
    __syncthreads(); if ((tid & 63) == 0) { red[tid >> 6] = errsum; red[8 + (tid >> 6)] = refsum; } __syncthreads();
    if (tid == 0) *res = PROBE_KAPPA ? fabsf((red[0] + red[1]) / (red[8] + red[9])) : sqrtf((red[0] + red[1]) / (red[8] + red[9]));
}
__device__ __forceinline__ void check_scan(const Args& a, LAS unsigned char* lds, int tid, float* res) {
#ifdef SHADOW_DBG
    unsigned char* ws = a.ws; const int b = 0, hd = 3, NS = 384;
#else
    unsigned char* ws = a.ws; const int b = 1, hd = 3, NS = 384;
#endif
    const bf16* rkv = (const bf16*)(ws + WS_RKV); const bf16* E = (const bf16*)(ws + WS_E); const bf16* Aa = (const bf16*)(ws + WS_A); const bf16* Y = y_ptr(a.out, b);
    LAS float* vw = (LAS float*)lds; LAS float* vaa = vw + 64; LAS float* vbb = vaa + 64; LAS float* vkm = vbb + 64; LAS float* vr = vkm + 64; LAS float* vv = vr + 64; LAS float* red = vv + 64;
    const int row = tid >> 3, cg = tid & 7; float st[8]; for (int j = 0; j < 8; ++j) st[j] = 0.f;
    float errsum = 0.f, refsum = 0.f;
    for (int s = 0; s < NS; ++s) { const size_t t = (size_t)b * SEQ + s;
        if (tid < 64) { const int ch = hd * 64 + tid;
            auto ld = [&](size_t tt, int off) { return __builtin_bit_cast(float, (unsigned)rkv[tt * 1536 + off + ch] << 16); };
            const float rc = ld(t, 0), kc = ld(t, 512), vc = ld(t, 1024); const float rp = s ? ld(t - 1, 0) : 0.f, kp = s ? ld(t - 1, 512) : 0.f, vp = s ? ld(t - 1, 1024) : 0.f;
            const float r = rc + (rp - rc) * a.in[4][ch], k = kc + (kp - kc) * a.in[4][512 + ch], v = vc + (vp - vc) * a.in[4][1024 + ch];
            const float e = __builtin_bit_cast(float, (unsigned)E[t * 512 + ch] << 16), av = __builtin_bit_cast(float, (unsigned)Aa[t * 512 + ch] << 16);
            float kk = k * a.in[10][ch]; const float nn = sqrtf(wave_sum(kk * kk)); kk = kk / fmaxf(nn, 1e-12f);
            vw[tid] = expf(-e); vaa[tid] = -kk; vbb[tid] = kk * av; vkm[tid] = k * (1.0f + (av - 1.0f) * a.in[11][ch]); vr[tid] = r; vv[tid] = v; }
        __syncthreads();
        float sa = 0.f; for (int j = 0; j < 8; ++j) sa += st[j] * vaa[cg * 8 + j];
        sa += __shfl_xor(sa, 1); sa += __shfl_xor(sa, 2); sa += __shfl_xor(sa, 4);
        float y = 0.f; for (int j = 0; j < 8; ++j) { const int c = cg * 8 + j; st[j] = st[j] * vw[c] + sa * vbb[c] + vv[row] * vkm[c]; y += st[j] * vr[c]; }
        y += __shfl_xor(y, 1); y += __shfl_xor(y, 2); y += __shfl_xor(y, 4);
        if (cg == 0) { const float got = __builtin_bit_cast(float, (unsigned)Y[(size_t)s * 512 + hd * 64 + row] << 16); errsum += (got - y) * (got - y); refsum += y * y; }
        __syncthreads(); }
    errsum = wave_sum(errsum); refsum = wave_sum(refsum);
    if ((tid & 63) == 0) { red[tid >> 6] = errsum; red[8 + (tid >> 6)] = refsum; } __syncthreads();
    if (tid == 0) { float es = 0.f, rs = 0.f; for (int i = 0; i < 8; ++i) { es += red[i]; rs += red[8 + i]; } *res = sqrtf(es / rs); }
}
#endif
#ifndef MK_N_LAUNCHES
#define MK_N_LAUNCHES 1
#endif
#ifndef SCAN_CHUNKED
#define SCAN_CHUNKED 1
#endif
constexpr int NSCAN = SCAN_CHUNKED ? 64 : 128;
constexpr int NPREP = 64 * 32;
constexpr int NORW = 256;
constexpr int NGATE = 256;
constexpr int NPHASE = 15;
__global__ void __launch_bounds__(NTHR, 2) mk_fwd(Args args) {
    extern __shared__ __attribute__((aligned(16))) unsigned char lds_raw[];
    LAS unsigned char* lds = (LAS unsigned char*)lds_raw;
    const int tid = threadIdx.x, lane = tid & 63, wave = __builtin_amdgcn_readfirstlane(tid >> 6);
    const int G = gridDim.x; const int bx = blockIdx.x; const int vcu = (G % 8 == 0) ? (bx % 8) * (G / 8) + bx / 8 : bx;
    unsigned char* ws = args.ws;
    const int lo = args.ph_lo, hi = args.ph_hi;
#ifdef ONLY_PHASE
#define IN(k) ((k) == ONLY_PHASE && lo <= (k) && (k) < hi)
#else
#define IN(k) (lo <= (k) && (k) < hi)
#endif
#if MK_N_LAUNCHES == 1
    volatile LAS unsigned* MISC = (volatile LAS unsigned*)(lds + MISC_OFF);
    for (int u = tid; u < 64; u += NTHR) MISC[u] = 0u;
    __syncthreads();
    XcdBarrier xbar = xcd_barrier_post((unsigned*)(ws + WS_CTL) + CW_BAR, MISC + 8, tid);
    if (lo < 0) { __threadfence(); cg::this_grid().sync(); }
#define SEAM(k) do { if (IN(k) && IN((k) + 1)) xcd_barrier(xbar, tid); } while (0)
#else
#define SEAM(k) do { } while (0)
#endif
#ifdef PROBE_PHASE
    volatile LAS unsigned long long* ptw = (volatile LAS unsigned long long*)(lds + MISC_OFF + 1536);
#define pt0 ptw[0]
#define pt1 ptw[1]
    if (tid == 0) { pt0 = 0ull; pt1 = 0ull; }
#define PB(k) do { if ((k) == PROBE_PHASE && bx == 0 && tid == 0) pt0 = __builtin_amdgcn_s_memrealtime(); } while (0)
#define PE(k) do { if ((k) == PROBE_PHASE && bx == 0 && tid == 0) pt1 = __builtin_amdgcn_s_memrealtime(); } while (0)
#else
#define PB(k) do { } while (0)
#define PE(k) do { } while (0)
#endif
    typedef pg8::bf16_t pbf;
    int K256 = 256, K512 = 512, K1024 = 1024, K2048 = 2048;
    asm volatile("" : "+s"(K256), "+s"(K512), "+s"(K1024), "+s"(K2048));
    PB(0);
#if defined(PROBE_PHASE) && (PROBE_PHASE == 20 || PROBE_PHASE == 21)
    if (bx == 0 && tid == 0) pt0 = __builtin_amdgcn_s_memrealtime();
#endif
    if (IN(0)) { phase0(args, lds, tid, lane, wave, vcu, G); }
    SEAM(0); PE(0);
    PB(1);
    if (IN(1)) {
#ifdef STAGGER_TICKS
        if (bx >= (11 * 128) % G) { const unsigned long long t0 = __builtin_amdgcn_s_memrealtime(); while (__builtin_amdgcn_s_memrealtime() - t0 < STAGGER_TICKS) __builtin_amdgcn_s_sleep(16); }
#endif
        { pg8::Gemm g{(const pbf*)(ws + WS_XN), (const pbf*)(ws + WS_WIN), T, 11 * 256, K1024}; pg8::OrderProj S; S.init(T, 11 * 256, G, bx); S.cnt = (unsigned*)(ws + WS_CTL) + CW_P2CNT;
          pg8::EpiProj E{(pbf*)(ws + WS_RKV), (pbf*)(ws + WS_PROJB), (pbf*)(ws + WS_GATES)};
          pg8::gemm_phase<pg8::EpiProj, pg8::OrderProj, true, true>(lds, g, S, E, tid); }
        { pg8::Gemm g{(const pbf*)(ws + WS_WIN) + (size_t)2816 * 1024, (const pbf*)(ws + WS_XN), 512, T, K1024}; pg8::StaticOrder S; S.init(512, T, G, bx);
          pg8::EpiStore E{(pbf*)(ws + WS_VT), T};
          pg8::gemm_phase<pg8::EpiStore, pg8::StaticOrder, true, true>(lds, g, S, E, tid); }
    }
    PE(1);
    PB(2);
    if (IN(2)) { phase2(args, lds, tid, vcu, G); }
    SEAM(2); PE(2);
    PB(3);
    if (IN(3)) { halo_rows(args, tid, vcu, G); }
    if (IN(3)) {
        pg8::Gemm g{(const pbf*)((unsigned char*)args.out + OUT_LA), (const pbf*)(ws + WS_WLORA), T, 1536, K256}; pg8::StaticOrder S; S.init(T, 1536, G, bx);
        pg8::EpiLora E{(pbf*)(ws + WS_E), (pbf*)(ws + WS_A), (pbf*)(ws + WS_G), args.in[5], args.in[7]};
        pg8::gemm_phase<pg8::EpiLora, pg8::StaticOrder, true, true>(lds, g, S, E, tid);
    }
    SEAM(3); PE(3);
    PB(4);
#if defined(PROBE_PHASE) && PROBE_PHASE == 102
    if (bx == 0 && tid == 0) ptw[3] = __builtin_amdgcn_s_memrealtime();
#endif
    if (IN(4)) {
        unsigned* qhead = (unsigned*)(ws + WS_CTL) + CW_QUEUE; LAS unsigned* ubox = (LAS unsigned*)(lds + MISC_OFF);
        float* stash = (float*)((unsigned char*)args.out + OUT_STASH) + (size_t)bx * 64 * 512;
#ifdef BIS_PREP_FIRST
        for (int it = bx; it < NPREP; it += G) { const int tq = wave * 64 + mk_lane_v(); __syncthreads(); scan_prep_item(args, lds, tq, it); }
        xcd_barrier(xbar, wave * 64 + mk_lane_v());
#endif
        for (;;) {
            const int tq = wave * 64 + mk_lane_v();
            __syncthreads();
            if (tq == 0) ubox[0] = atomicAdd(qhead, 1u);
            __syncthreads();
            int u = (int)ubox[0];
            if (G < 128) u = (u < NPREP) ? u + NSCAN : (u < NPREP + NSCAN ? u - NPREP : u);
            if (u >= NSCAN + NPREP + NGATE + 512 + NTRQ) break;
#ifdef BIS_PREP_FIRST
            if (u >= NSCAN && u < NSCAN + NPREP) continue;
#else
            if (u >= NSCAN && u < NSCAN + NPREP) { scan_prep_item(args, lds, tq, u - NSCAN); continue; }
#endif
            if (u >= NSCAN) u -= NPREP;
            if (u >= NSCAN + NGATE + 512) {
                if (tq == 0) { while (__hip_atomic_load(qhead + 1, __ATOMIC_RELAXED, __HIP_MEMORY_SCOPE_AGENT) < (unsigned)NGATE) __builtin_amdgcn_s_sleep(8); }
                asm volatile("" ::: "memory");
                __syncthreads();
                tr_wgu_qitem(args, lds, (tq & 63), wave, u - (NSCAN + NGATE + 512)); continue; }
#if defined(PROBE_PHASE) && PROBE_PHASE == 100
            if (u < NSCAN) { if (tq == 0) ptw[2] = __builtin_amdgcn_s_memrealtime(); if (SCAN_CHUNKED) scan_unit_chunked(args, lds, tq, u); else scan_unit(args, lds, tq, u);
                if (tq == 0) atomicMax((unsigned*)(ws + WS_CTL) + 96, (unsigned)(__builtin_amdgcn_s_memrealtime() - ptw[2])); }
#else
            if (u < NSCAN) { if (SCAN_CHUNKED) scan_unit_chunked(args, lds, tq, u); else scan_unit(args, lds, tq, u); }
#endif
#if defined(PROBE_PHASE) && PROBE_PHASE == 101
            else if (u < NSCAN + NGATE) { } else { const int au = u - NSCAN - NGATE; const unsigned long long q0 = __builtin_amdgcn_s_memrealtime(); attn_unit(args, lds, tq, (au & 31) >> 2, au & 3, 15 - (au >> 5), stash); const unsigned long long q1 = __builtin_amdgcn_s_memrealtime();
                if (tq == 0) atomicAdd((unsigned*)(ws + WS_CTL) + 96, (unsigned)(q1 - q0)); }
#else
#ifdef SHADOW_DBG
            else if (u < NSCAN + NGATE) { __syncthreads(); if (tq == 0) __hip_atomic_fetch_add(qhead + 1, 1u, __ATOMIC_RELEASE, __HIP_MEMORY_SCOPE_AGENT); }
#endif
            else if (u < NSCAN + NGATE) { const int it = u - NSCAN;
                pg8::Gemm g{(const pbf*)(ws + WS_XN), (const pbf*)(ws + WS_WIN) + (size_t)3328 * 1024, T, 2048, K1024}; pg8::OrderItem S{it >> 1, (it & 1) * 4, 4};
                pg8::EpiGates E{(pbf*)(ws + WS_GATES)};
                pg8::gemm_phase<pg8::EpiGates, pg8::OrderItem, true, true>(lds, g, S, E, tq);
                VM_WAIT(); __syncthreads(); if (tq == 0) __hip_atomic_fetch_add(qhead + 1, 1u, __ATOMIC_RELAXED, __HIP_MEMORY_SCOPE_AGENT); }
            else { const int au = u - NSCAN - NGATE; attn_unit(args, lds, tq, (au & 31) >> 2, au & 3, 15 - (au >> 5), stash); }
#endif
#if defined(PROBE_PHASE) && PROBE_PHASE == 102
            if (u >= NSCAN) { __syncthreads(); if (tq == 0) atomicMax((unsigned*)(ws + WS_CTL) + 96, (unsigned)__builtin_amdgcn_s_memrealtime()); }
#endif
        }
        for (int it = bx; it < NORW; it += G) { const int tq = wave * 64 + mk_lane_v(); const int ub = it >> 2;
            if (tq == 0) { while (__hip_atomic_load((unsigned*)(ws + WS_CTL) + CW_SDONE + ub, __ATOMIC_RELAXED, __HIP_MEMORY_SCOPE_AGENT) == 0u) __builtin_amdgcn_s_sleep(8);
                __builtin_amdgcn_fence(__ATOMIC_ACQUIRE, "agent"); }
            __syncthreads();
            orw_item(args, tq, ub, it & 3); }
    }
    {
    const int lane = mk_lane_v(), tid = wave * 64 + lane;
    SEAM(4); PE(4);
#if defined(PROBE_PHASE) && (PROBE_PHASE == 210 || PROBE_PHASE == 211 || PROBE_PHASE == 215)
    if (bx == 0) { float* res = (float*)(ws + WS_CTL) + 100; if (PROBE_PHASE != 211) check_attn(args, lds, tid, res); else check_scan(args, lds, tid, res); __syncthreads(); if (tid == 0) { pt0 = 0ull; pt1 = (unsigned long long)(*(volatile float*)res * 1.0e6f); } }
    xcd_barrier(xbar, tid);
#endif
#if defined(PROBE_PHASE) && PROBE_PHASE == 100
    if (bx == 0 && tid == 0) { pt0 = 0ull; pt1 = (unsigned long long)__hip_atomic_load((unsigned*)(ws + WS_CTL) + 96, __ATOMIC_RELAXED, __HIP_MEMORY_SCOPE_AGENT); }
#endif
#if defined(PROBE_PHASE) && PROBE_PHASE >= 300 && PROBE_PHASE < 320
    if (bx == 0 && tid == 0) { pt0 = 0ull; pt1 = (unsigned long long)__hip_atomic_load((unsigned*)(ws + WS_CTL) + 96, __ATOMIC_RELAXED, __HIP_MEMORY_SCOPE_AGENT) / 64ull; }
#endif
#if defined(PROBE_PHASE) && PROBE_PHASE == 101
    if (bx == 0 && tid == 0) { pt0 = 0ull; pt1 = (unsigned long long)__hip_atomic_load((unsigned*)(ws + WS_CTL) + 96, __ATOMIC_RELAXED, __HIP_MEMORY_SCOPE_AGENT) / 256ull; }
#endif
#if defined(PROBE_PHASE) && PROBE_PHASE == 102
    if (bx == 0 && tid == 0) { pt0 = (unsigned long long)(unsigned)ptw[3]; pt1 = (unsigned long long)__hip_atomic_load((unsigned*)(ws + WS_CTL) + 96, __ATOMIC_RELAXED, __HIP_MEMORY_SCOPE_AGENT); if (pt1 < pt0) pt1 = pt0; }
#endif
    PB(6);
    if (IN(6)) {
        pg8::Gemm g{(const pbf*)((unsigned char*)args.out + OUT_ORWDF), (const pbf*)(ws + WS_WBRD), T, 1024, K1024}; pg8::StaticOrder S; S.init(T, 1024, G, bx);
        pg8::EpiMix E{(const pbf*)(ws + WS_GATES), (pbf*)(ws + WS_MIXED)};
        pg8::gemm_phase<pg8::EpiMix, pg8::StaticOrder, true, true>(lds, g, S, E, tid);
    }
    SEAM(6); PE(6);
    PB(7);
    if (IN(7)) {
        pg8::Gemm g{(const pbf*)(ws + WS_MIXED), (const pbf*)(ws + WS_WO), T, 1024, K1024}; pg8::StaticOrder S; S.init(T, 1024, G, bx);
        pg8::EpiRes E{args.in[0], (pbf*)args.out, (float*)(ws + WS_SSQ)};
        pg8::gemm_phase<pg8::EpiRes, pg8::StaticOrder, true, true>(lds, g, S, E, tid);
    }
    SEAM(7); PE(7);
    PB(9);
    if (IN(9)) {
        pg8::Gemm g{(const pbf*)args.out, (const pbf*)(ws + WS_WR), T, 256, K1024}; pg8::StaticOrder S; S.init(T, 256, G, bx);
        pg8::EpiLogits E{(float*)(ws + WS_LOGITS)};
        pg8::gemm_phase<pg8::EpiLogits, pg8::StaticOrder, true, true>(lds, g, S, E, tid);
        VM_WAIT(); __syncthreads();
        pg8::Unit u;
        for (int i = 0; S.next(i, u); ++i) route_tile(args, lds, tid, u.pm);
        { const int j0 = G > 128 ? bx - 128 : bx, nj = G > 128 ? G - 128 : G;
          if (j0 >= 0) { for (int pm = j0; pm < T / 256; pm += nj) { __syncthreads(); pp_tile(args, lds, tid, pm, K256, 0, 4, true); }
              __syncthreads(); tr_wd_all(args, lds, lane, wave, j0 * NWAVES + wave, nj * NWAVES, 0, WD_SPLIT); } }
    }
    PE(9);
    PB(10);
    if (IN(10)) { phase9(args, lds, tid, lane, wave);
        if (G <= 128) { __syncthreads(); tr_wd_all(args, lds, lane, wave, bx * NWAVES + wave, G * NWAVES, WD_SPLIT, NEXP * TR_IDN); }
        else if (bx >= 128) tr_wd_all(args, lds, lane, wave, (bx - 128) * NWAVES + wave, (G - 128) * NWAVES, WD_SPLIT, WD_IDLE_END);
        else { __syncthreads(); tr_wd_all(args, lds, lane, wave, bx * NWAVES + wave, 128 * NWAVES, WD_IDLE_END, NEXP * TR_IDN); } }
    SEAM(10); PE(10);
    PB(11);
    if (IN(11) || IN(12)) {
        const int* disp = (const int*)(ws + WS_DISP); LAS int* tile_e = (LAS int*)(lds + MISC_OFF + 64);
        __syncthreads();
        const int NT = disp[0];
        for (int i = tid; i < NT && i < 320; i += NTHR) tile_e[i] = disp[16 + i];
        __syncthreads();
        if (IN(11)) {
            pg8::Gemm g{(const pbf*)args.out, (const pbf*)(ws + WS_WGU), T, NEXP * 1024, K1024}; pg8::OrderMoeUp S{{NT * 4, G, bx, tile_e}, (unsigned*)(ws + WS_CTL) + CW_MOECNT};
            pg8::EpiAct E{(pbf*)(ws + WS_ACT), (const float*)(ws + WS_ROWRS)};
            pg8::gemm_phase_gather<pg8::EpiAct, pg8::OrderMoeUp>(lds, g, (const int*)(ws + WS_ROWTOK), S, E, tid);
        }
        PE(11); PB(12);
        if (IN(12)) {
            pg8::Gemm g{(const pbf*)(ws + WS_ACT), (const pbf*)(ws + WS_WD), MAXROWS, NEXP * 1024, K512}; pg8::OrderMoeDown S{{NT * 4, G, G - 1 - bx, tile_e}, (unsigned*)(ws + WS_CTL) + CW_MOECNT};
            pg8::EpiDown E{(pbf*)(ws + WS_Y2), (const float*)(ws + WS_ROWW)};
            pg8::gemm_phase<pg8::EpiDown, pg8::OrderMoeDown, true, true>(lds, g, S, E, tid);
        }
    }
    SEAM(12); PE(12);
#if defined(PROBE_PHASE) && (PROBE_PHASE == 200 || PROBE_PHASE == 201)
    if (bx == 0) { float* res = (float*)(ws + WS_CTL) + 100; check_moe(args, lds, tid, res); __syncthreads(); if (tid == 0) { pt0 = 0ull; pt1 = (unsigned long long)(*(volatile float*)res * 1.0e6f); } }
    xcd_barrier(xbar, tid);
#endif
    PB(13);
    if (IN(13)) { phase12(args, tid, lane, wave, vcu, G); }
    SEAM(13); PE(13);
    PB(14);
    if (IN(14)) {
        if (G <= 128) for (int it = bx; it < 0; it += G) { }
        { pg8::Gemm g{(const pbf*)(ws + WS_X2), (const pbf*)(ws + WS_WPG), T, 1024, K1024}; pg8::StaticOrder S; S.init(T, 1024, G, bx);
          pg8::EpiFinal E{(const pbf*)(ws + WS_PP), (const pbf*)(ws + WS_X2), args.out, (const float*)(ws + WS_RS)};
          pg8::gemm_phase<pg8::EpiFinal, pg8::StaticOrder, true, true>(lds, g, S, E, tid); }
    }
#ifdef PROBE_PHASE
    if (PROBE_PHASE == 14 && bx == 0 && tid == 0) { pt1 = __builtin_amdgcn_s_memrealtime(); }
    if (bx == 0 && tid == 0) { const unsigned long long te = __builtin_amdgcn_s_memrealtime(), w = (unsigned long long)PROBE_MULT * (pt1 - pt0);
        while (__builtin_amdgcn_s_memrealtime() - te < w) __builtin_amdgcn_s_sleep(32); }
#endif
    }
#undef IN
#undef SEAM
}

extern "C" void kernel_launch(void* const* d_in, const int* in_sizes, int n_in, void* d_out, int out_size, void* d_ws, size_t ws_size, hipStream_t stream) {
    static int grid = 0;
    if (grid == 0) {
        if (n_in != 36 || in_sizes[0] != T * DM || out_size != T * DM || ws_size < WS_END) {
            fprintf(stderr, "kernel_launch: unexpected problem: n_in %d in0 %d out %d ws %zu (need %zu)\n", n_in, n_in > 0 ? in_sizes[0] : -1, out_size, ws_size, (size_t)WS_END); grid = -1; return; }
        int dev = 0, cus = 0, per_cu = 0;
        if (hipGetDevice(&dev) != hipSuccess || hipDeviceGetAttribute(&cus, hipDeviceAttributeMultiprocessorCount, dev) != hipSuccess) { grid = -1; return; }
        if (hipFuncSetAttribute((const void*)mk_fwd, hipFuncAttributeMaxDynamicSharedMemorySize, LDS_BYTES) != hipSuccess) { fprintf(stderr, "kernel_launch: hipFuncSetAttribute failed\n"); grid = -1; return; }
        if (hipOccupancyMaxActiveBlocksPerMultiprocessor(&per_cu, (const void*)mk_fwd, NTHR, LDS_BYTES) != hipSuccess || per_cu < 1) { fprintf(stderr, "kernel_launch: occupancy query says %d blocks per CU\n", per_cu); (void)hipGetLastError(); grid = -1; return; }
        grid = cus;
        if (grid > 256) grid = 256;
    }
    if (grid < 0) return;
    (void)hipMemsetAsync((char*)d_ws + WS_CTL, 0, CTL_ZERO_BYTES, stream);
    Args a{};
    for (int i = 0; i < 36; ++i) a.in[i] = (const float*)d_in[i];
    a.out = (float*)d_out; a.ws = (unsigned char*)d_ws;
#if MK_N_LAUNCHES == 1
    a.ph_lo = 0; a.ph_hi = NPHASE;
#ifdef BIS_PH_HI
    a.ph_hi = BIS_PH_HI;
#endif
    void* kargs[] = {&a};
    const hipError_t e = hipLaunchCooperativeKernel((const void*)mk_fwd, dim3(grid), dim3(NTHR), kargs, LDS_BYTES, stream);
    if (e != hipSuccess) fprintf(stderr, "kernel_launch: cooperative launch failed: %s (grid %d)\n", hipGetErrorString(e), grid);
#else
    for (int ph = 0; ph < NPHASE; ++ph) { a.ph_lo = ph; a.ph_hi = ph + 1; hipLaunchKernelGGL(mk_fwd, dim3(grid), dim3(NTHR), LDS_BYTES, stream, a); }
#endif
}
```
